# Optimizing an MI355X kernel written in HIP

```python
import math
import jax, jax.numpy as jnp
from jax import lax
import numpy as np

D_MODEL = 1024
BATCH = 8
SEQ = 2048
DEPTH = 4
DEC_BATCH = 128
DEC_SEQ = 8
PAST_LEN = 16384
PAGE_SIZE = 128

N_MIXERS = 3
N_LAYERS_A = (DEPTH + 2) // 3
N_LAYERS_B = (DEPTH + 1) // 3
N_LAYERS_C = DEPTH // 3
D_FF = 4 * D_MODEL
CONV_W = 4
NORM_EPS = 1e-6

D_LRU = D_MODEL
LRU_BLOCKS = 8
LRU_BLOCK = D_LRU // LRU_BLOCKS
LRU_C = 8.0

D_SSM = 2 * D_MODEL
SSM_HEADDIM = 64
SSM_HEADS = D_SSM // SSM_HEADDIM
SSM_GROUPS = 8
SSM_HPG = SSM_HEADS // SSM_GROUPS
SSM_STATE = 128
SSM_CONV_DIM = D_SSM + 2 * SSM_GROUPS * SSM_STATE
SSM_IN = D_SSM + SSM_CONV_DIM + SSM_HEADS
SSM_CHUNK = 128
SSM_NORM_EPS = 1e-5

RWKV_HEAD = 64
RWKV_HEADS = D_MODEL // RWKV_HEAD
D_DECAY_LORA = 64
D_AAA_LORA = 64
D_GATE_LORA = 128
GN_EPS = 64e-5

kernel_name = "hybrid_rglru_ssd_rwkv7_step"


def rmsnorm(x, w):
    xf = x.astype(jnp.float32)
    y = xf * lax.rsqrt(jnp.mean(xf * xf, axis=-1, keepdims=True) + NORM_EPS)
    return (y * w.astype(jnp.float32)).astype(x.dtype)


def causal_conv(x, buf, w, b):
    L = x.shape[1]
    xp = jnp.concatenate([buf.astype(x.dtype), x], axis=1)
    y = b + xp[:, 0:L] * w[0]
    for k in range(1, CONV_W):
        y = y + xp[:, k:k + L] * w[k]
    return y, xp[:, -(CONV_W - 1):]


def _lin_combine(e1, e2):
    a1, b1 = e1
    a2, b2 = e2
    return a1 * a2, a2 * b1 + b2


def rglru_mixer(u, conv_buf, h0, start_pos, w_in, conv_w, conv_b, w_r, b_r, w_i, b_i, lam, w_out):
    bsz, L, _ = u.shape
    f32 = jnp.float32
    xb, gate = jnp.split(u @ w_in, 2, axis=-1)
    xc, new_buf = causal_conv(xb, conv_buf, conv_w, conv_b)
    xblk = xc.reshape(bsz, L, LRU_BLOCKS, LRU_BLOCK)
    r = jax.nn.sigmoid(jnp.einsum("blhi,hij->blhj", xblk, w_r).reshape(bsz, L, D_LRU) + b_r)
    i = jax.nn.sigmoid(jnp.einsum("blhi,hij->blhj", xblk, w_i).reshape(bsz, L, D_LRU) + b_i)
    log_a = -LRU_C * r.astype(f32) * jax.nn.softplus(-lam.astype(f32))
    reset = ((start_pos + jnp.arange(L)) == 0)[None, :, None]
    a = jnp.where(reset, 0.0, jnp.exp(log_a))
    mult = jnp.where(reset, 1.0, jnp.sqrt(-jnp.expm1(2.0 * log_a)))
    bterm = mult * (i * xc).astype(f32)
    bterm = bterm.at[:, 0].add(a[:, 0] * h0.astype(f32))
    _, h = lax.associative_scan(_lin_combine, (a, bterm), axis=1)
    y = (h * jax.nn.gelu(gate.astype(f32))).astype(u.dtype)
    return y @ w_out, new_buf, h[:, -1].astype(h0.dtype)


def ssd_chunked(x, dt, A, B, C, s0):
    f32 = jnp.float32
    bsz, L = x.shape[:2]
    q = SSM_CHUNK if L % SSM_CHUNK == 0 else L
    nc = L // q
    xc = x.reshape(bsz, nc, q, SSM_GROUPS, SSM_HPG, SSM_HEADDIM).astype(f32)
    dtc = dt.reshape(bsz, nc, q, SSM_GROUPS, SSM_HPG).astype(f32)
    Bc = B.reshape(bsz, nc, q, SSM_GROUPS, SSM_STATE).astype(f32)
    Cc = C.reshape(bsz, nc, q, SSM_GROUPS, SSM_STATE).astype(f32)
    acs = jnp.cumsum(dtc * A, axis=2)
    xdt = xc * dtc[..., None]
    seg = acs[:, :, :, None] - acs[:, :, None, :]
    mask = jnp.tril(jnp.ones((q, q), bool))[:, :, None, None]
    Ldec = jnp.exp(jnp.where(mask, seg, -jnp.inf))
    CB = jnp.einsum("bcign,bcjgn->bcijg", Cc, Bc)
    y_diag = jnp.einsum("bcijg,bcijge,bcjgep->bcigep", CB, Ldec, xdt)
    decay_end = jnp.exp(acs[:, :, -1:] - acs)
    st = jnp.einsum("bcjgn,bcjge,bcjgep->bcgepn", Bc, decay_end, xdt)
    chunk_decay = jnp.exp(acs[:, :, -1])

    def step(s, inp):
        dec, st_c = inp
        return s * dec[..., None, None] + st_c, s

    s_fin, s_start = lax.scan(step, s0.astype(f32),
                              (jnp.moveaxis(chunk_decay, 1, 0), jnp.moveaxis(st, 1, 0)))
    s_start = jnp.moveaxis(s_start, 0, 1)
    y_off = jnp.einsum("bcign,bcige,bcgepn->bcigep", Cc, jnp.exp(acs), s_start)
    y = (y_diag + y_off).reshape(bsz, L, SSM_GROUPS, SSM_HPG, SSM_HEADDIM)
    return y, s_fin


def mamba2_mixer(u, conv_buf, ssm0, w_in, conv_w, conv_b, dt_bias, a_log, d_skip, norm_w, w_out):
    bsz, L, _ = u.shape
    f32 = jnp.float32
    z, xbc, dt = jnp.split(u @ w_in, [D_SSM, D_SSM + SSM_CONV_DIM], axis=-1)
    xbc, new_buf = causal_conv(xbc, conv_buf, conv_w, conv_b)
    xbc = jax.nn.silu(xbc)
    xs, Bm, Cm = jnp.split(xbc, [D_SSM, D_SSM + SSM_GROUPS * SSM_STATE], axis=-1)
    xs = xs.reshape(bsz, L, SSM_GROUPS, SSM_HPG, SSM_HEADDIM)
    Bm = Bm.reshape(bsz, L, SSM_GROUPS, SSM_STATE)
    Cm = Cm.reshape(bsz, L, SSM_GROUPS, SSM_STATE)
    dt = jax.nn.softplus(dt.astype(f32) + dt_bias.astype(f32)).reshape(bsz, L, SSM_GROUPS, SSM_HPG)
    A = -jnp.exp(a_log.astype(f32)).reshape(SSM_GROUPS, SSM_HPG)
    s0 = ssm0.reshape(bsz, SSM_GROUPS, SSM_HPG, SSM_HEADDIM, SSM_STATE)
    y, s_fin = ssd_chunked(xs, dt, A, Bm, Cm, s0)
    y = y + d_skip.astype(f32).reshape(SSM_GROUPS, SSM_HPG, 1) * xs.astype(f32)
    yg = (y.reshape(bsz, L, D_SSM) * jax.nn.silu(z.astype(f32))).reshape(bsz, L, SSM_GROUPS, D_SSM // SSM_GROUPS)
    yg = yg * lax.rsqrt(jnp.mean(yg * yg, axis=-1, keepdims=True) + SSM_NORM_EPS)
    yg = (yg.reshape(bsz, L, D_SSM) * norm_w.astype(f32)).astype(u.dtype)
    s_fin = s_fin.reshape(bsz, SSM_HEADS, SSM_HEADDIM, SSM_STATE).astype(ssm0.dtype)
    return yg @ w_out, new_buf, s_fin


def rwkv7_mixer(u, shift0, wkv0, mu, w_rkv, w0, w_w1, w_w2, a0, w_a1, w_a2, w_g1, w_g2,
                k_k, k_a, r_k, lnx_w, lnx_b, w_out):
    bsz, L, _ = u.shape
    f32 = jnp.float32
    prev = jnp.concatenate([shift0[:, None].astype(u.dtype), u[:, :-1]], axis=1)
    xm = u[None] + (prev - u)[None] * mu[:, None, None, :]
    r, k, v = jnp.einsum("sbld,sde->sble", xm[:3], w_rkv)
    xw, xa, xg = xm[3], xm[4], xm[5]
    w_log = -jax.nn.softplus(-(w0 + jnp.tanh(xw @ w_w1) @ w_w2)) - 0.5
    decay = jnp.exp(-jnp.exp(w_log.astype(f32)))
    a = jax.nn.sigmoid(a0 + (xa @ w_a1) @ w_a2)
    g = jax.nn.sigmoid(xg @ w_g1) @ w_g2

    def heads(t):
        return t.reshape(bsz, L, RWKV_HEADS, RWKV_HEAD).astype(f32)

    kk = heads(k * k_k)
    kk = kk / jnp.maximum(jnp.linalg.norm(kk, axis=-1, keepdims=True), 1e-12)
    k = k * (1.0 + (a - 1.0) * k_a)
    r_h, k_h, v_h, a_h, w_h = heads(r), heads(k), heads(v), heads(a), heads(decay)

    def step(S, inp):
        r_t, k_t, v_t, kk_t, a_t, w_t = inp
        sa = jnp.einsum("bhvk,bhk->bhv", S, kk_t)
        S = (S * w_t[:, :, None, :] - sa[..., None] * (kk_t * a_t)[:, :, None, :]
             + v_t[..., None] * k_t[:, :, None, :])
        return S, jnp.einsum("bhvk,bhk->bhv", S, r_t)

    seq = tuple(jnp.moveaxis(t, 1, 0) for t in (r_h, k_h, v_h, kk, a_h, w_h))
    S_fin, o = lax.scan(step, wkv0.astype(f32), seq)
    o = jnp.moveaxis(o, 0, 1)
    mean = jnp.mean(o, axis=-1, keepdims=True)
    var = jnp.mean(jnp.square(o - mean), axis=-1, keepdims=True)
    o = ((o - mean) * lax.rsqrt(var + GN_EPS)).reshape(bsz, L, D_MODEL) * lnx_w + lnx_b
    bonus = (jnp.sum(r_h * k_h * r_k, axis=-1, keepdims=True) * v_h).reshape(bsz, L, D_MODEL)
    out = ((o + bonus) * g).astype(u.dtype)
    return out @ w_out, u[:, -1], S_fin.astype(wkv0.dtype)


def sqrelu_mlp(u, w1, w2):
    return jnp.square(jax.nn.relu(u @ w1)) @ w2


def run_trunk(x, lru_conv, lru_h, ssm_conv, ssm_state, rw_shift, rw_wkv, start_pos, p):
    n_lc, n_lh, n_sc, n_ss, n_rs, n_rw = [], [], [], [], [], []
    ia = ib = ic = 0
    for layer in range(DEPTH):
        u = rmsnorm(x, p["norm_mix"][layer])
        kind = layer % N_MIXERS
        if kind == 0:
            out, cb, h = rglru_mixer(u, lru_conv[ia], lru_h[ia], start_pos,
                                     p["lru_w_in"][ia], p["lru_conv_w"][ia], p["lru_conv_b"][ia],
                                     p["lru_w_r"][ia], p["lru_b_r"][ia], p["lru_w_i"][ia], p["lru_b_i"][ia],
                                     p["lru_lambda"][ia], p["lru_w_out"][ia])
            n_lc.append(cb)
            n_lh.append(h)
            ia += 1
        elif kind == 1:
            out, cb, s = mamba2_mixer(u, ssm_conv[ib], ssm_state[ib],
                                      p["ssm_w_in"][ib], p["ssm_conv_w"][ib], p["ssm_conv_b"][ib],
                                      p["ssm_dt_bias"][ib], p["ssm_a_log"][ib], p["ssm_d"][ib],
                                      p["ssm_norm_w"][ib], p["ssm_w_out"][ib])
            n_sc.append(cb)
            n_ss.append(s)
            ib += 1
        else:
            out, sh, S = rwkv7_mixer(u, rw_shift[ic], rw_wkv[ic],
                                     p["rwkv_mu"][ic], p["rwkv_w_rkv"][ic], p["rwkv_w0"][ic],
                                     p["rwkv_w_w1"][ic], p["rwkv_w_w2"][ic], p["rwkv_a0"][ic],
                                     p["rwkv_w_a1"][ic], p["rwkv_w_a2"][ic], p["rwkv_w_g1"][ic],
                                     p["rwkv_w_g2"][ic], p["rwkv_k_k"][ic], p["rwkv_k_a"][ic],
                                     p["rwkv_r_k"][ic], p["rwkv_lnx_w"][ic], p["rwkv_lnx_b"][ic],
                                     p["rwkv_w_out"][ic])
            n_rs.append(sh)
            n_rw.append(S)
            ic += 1
        x = x + out.astype(x.dtype)
        x = x + sqrelu_mlp(rmsnorm(x, p["norm_ffn"][layer]), p["ffn_w1"][layer], p["ffn_w2"][layer]).astype(x.dtype)
    y = rmsnorm(x, p["norm_final"])
    return (y, jnp.stack(n_lc), jnp.stack(n_lh), jnp.stack(n_sc), jnp.stack(n_ss),
            jnp.stack(n_rs), jnp.stack(n_rw))


def setup_inputs(seed: int = 0) -> dict:
    key = jax.random.key(seed)
    ks = iter(jax.random.split(key, 64))
    f32 = jnp.float32

    def nrm(shape, scale):
        return jax.random.normal(next(ks), shape, f32) * scale

    def uni(shape, lo, hi):
        return jax.random.uniform(next(ks), shape, f32, lo, hi)

    nA, nB, nC = N_LAYERS_A, N_LAYERS_B, N_LAYERS_C
    a_init = uni((nA, D_LRU), 0.9, 0.999)
    s = a_init ** (1.0 / LRU_C)
    lru_lambda = jnp.log(s) - jnp.log1p(-s)
    dt_init = jnp.exp(uni((nB, SSM_HEADS), math.log(1e-3), math.log(1e-1)))
    ssm_dt_bias = dt_init + jnp.log(-jnp.expm1(-dt_init))
    return {
        "x_prompt": nrm((BATCH, SEQ, D_MODEL), 1.0),
        "x_sample": nrm((DEC_BATCH, DEC_SEQ, D_MODEL), 1.0),
        "state_lru_conv": nrm((nA, DEC_BATCH, CONV_W - 1, D_LRU), 1.0),
        "state_lru_h": nrm((nA, DEC_BATCH, D_LRU), 0.5),
        "state_ssm_conv": nrm((nB, DEC_BATCH, CONV_W - 1, SSM_CONV_DIM), 1.0),
        "state_ssm": nrm((nB, DEC_BATCH, SSM_HEADS, SSM_HEADDIM, SSM_STATE), 0.1),
        "state_rwkv_shift": nrm((nC, DEC_BATCH, D_MODEL), 1.0),
        "state_rwkv_wkv": nrm((nC, DEC_BATCH, RWKV_HEADS, RWKV_HEAD, RWKV_HEAD), 0.1),
        "norm_mix": 1.0 + nrm((DEPTH, D_MODEL), 0.01),
        "norm_ffn": 1.0 + nrm((DEPTH, D_MODEL), 0.01),
        "norm_final": 1.0 + nrm((D_MODEL,), 0.01),
        "lru_w_in": nrm((nA, D_MODEL, 2 * D_LRU), D_MODEL ** -0.5),
        "lru_conv_w": nrm((nA, CONV_W, D_LRU), CONV_W ** -0.5),
        "lru_conv_b": nrm((nA, D_LRU), 0.01),
        "lru_w_r": nrm((nA, LRU_BLOCKS, LRU_BLOCK, LRU_BLOCK), LRU_BLOCK ** -0.5),
        "lru_b_r": nrm((nA, D_LRU), 0.01),
        "lru_w_i": nrm((nA, LRU_BLOCKS, LRU_BLOCK, LRU_BLOCK), LRU_BLOCK ** -0.5),
        "lru_b_i": nrm((nA, D_LRU), 0.01),
        "lru_lambda": lru_lambda,
        "lru_w_out": nrm((nA, D_LRU, D_MODEL), D_LRU ** -0.5),
        "ssm_w_in": nrm((nB, D_MODEL, SSM_IN), D_MODEL ** -0.5),
        "ssm_conv_w": nrm((nB, CONV_W, SSM_CONV_DIM), CONV_W ** -0.5),
        "ssm_conv_b": nrm((nB, SSM_CONV_DIM), 0.01),
        "ssm_dt_bias": ssm_dt_bias,
        "ssm_a_log": jnp.log(uni((nB, SSM_HEADS), 1.0, 16.0)),
        "ssm_d": 1.0 + nrm((nB, SSM_HEADS), 0.01),
        "ssm_norm_w": 1.0 + nrm((nB, D_SSM), 0.01),
        "ssm_w_out": nrm((nB, D_SSM, D_MODEL), D_SSM ** -0.5),
        "rwkv_mu": uni((nC, 6, D_MODEL), 0.0, 1.0),
        "rwkv_w_rkv": nrm((nC, 3, D_MODEL, D_MODEL), D_MODEL ** -0.5),
        "rwkv_w0": -1.0 + nrm((nC, D_MODEL), 0.5),
        "rwkv_w_w1": nrm((nC, D_MODEL, D_DECAY_LORA), D_MODEL ** -0.5),
        "rwkv_w_w2": nrm((nC, D_DECAY_LORA, D_MODEL), 0.1 * D_DECAY_LORA ** -0.5),
        "rwkv_a0": nrm((nC, D_MODEL), 0.1),
        "rwkv_w_a1": nrm((nC, D_MODEL, D_AAA_LORA), D_MODEL ** -0.5),
        "rwkv_w_a2": nrm((nC, D_AAA_LORA, D_MODEL), 0.1 * D_AAA_LORA ** -0.5),
        "rwkv_w_g1": nrm((nC, D_MODEL, D_GATE_LORA), D_MODEL ** -0.5),
        "rwkv_w_g2": nrm((nC, D_GATE_LORA, D_MODEL), D_GATE_LORA ** -0.5),
        "rwkv_k_k": 1.0 + nrm((nC, D_MODEL), 0.1),
        "rwkv_k_a": 1.0 + nrm((nC, D_MODEL), 0.1),
        "rwkv_r_k": nrm((nC, RWKV_HEADS, RWKV_HEAD), 0.1),
        "rwkv_lnx_w": 1.0 + nrm((nC, D_MODEL), 0.01),
        "rwkv_lnx_b": nrm((nC, D_MODEL), 0.01),
        "rwkv_w_out": nrm((nC, D_MODEL, D_MODEL), D_MODEL ** -0.5),
        "ffn_w1": nrm((DEPTH, D_MODEL, D_FF), D_MODEL ** -0.5),
        "ffn_w2": nrm((DEPTH, D_FF, D_MODEL), 0.5 * D_FF ** -0.5),
    }


def reference(x_prompt, x_sample, state_lru_conv, state_lru_h, state_ssm_conv, state_ssm,
              state_rwkv_shift, state_rwkv_wkv, norm_mix, norm_ffn, norm_final,
              lru_w_in, lru_conv_w, lru_conv_b, lru_w_r, lru_b_r, lru_w_i, lru_b_i, lru_lambda, lru_w_out,
              ssm_w_in, ssm_conv_w, ssm_conv_b, ssm_dt_bias, ssm_a_log, ssm_d, ssm_norm_w, ssm_w_out,
              rwkv_mu, rwkv_w_rkv, rwkv_w0, rwkv_w_w1, rwkv_w_w2, rwkv_a0, rwkv_w_a1, rwkv_w_a2,
              rwkv_w_g1, rwkv_w_g2, rwkv_k_k, rwkv_k_a, rwkv_r_k, rwkv_lnx_w, rwkv_lnx_b, rwkv_w_out,
              ffn_w1, ffn_w2):
    p = dict(norm_mix=norm_mix, norm_ffn=norm_ffn, norm_final=norm_final,
             lru_w_in=lru_w_in, lru_conv_w=lru_conv_w, lru_conv_b=lru_conv_b, lru_w_r=lru_w_r,
             lru_b_r=lru_b_r, lru_w_i=lru_w_i, lru_b_i=lru_b_i, lru_lambda=lru_lambda, lru_w_out=lru_w_out,
             ssm_w_in=ssm_w_in, ssm_conv_w=ssm_conv_w, ssm_conv_b=ssm_conv_b, ssm_dt_bias=ssm_dt_bias,
             ssm_a_log=ssm_a_log, ssm_d=ssm_d, ssm_norm_w=ssm_norm_w, ssm_w_out=ssm_w_out,
             rwkv_mu=rwkv_mu, rwkv_w_rkv=rwkv_w_rkv, rwkv_w0=rwkv_w0, rwkv_w_w1=rwkv_w_w1,
             rwkv_w_w2=rwkv_w_w2, rwkv_a0=rwkv_a0, rwkv_w_a1=rwkv_w_a1, rwkv_w_a2=rwkv_w_a2,
             rwkv_w_g1=rwkv_w_g1, rwkv_w_g2=rwkv_w_g2, rwkv_k_k=rwkv_k_k, rwkv_k_a=rwkv_k_a,
             rwkv_r_k=rwkv_r_k, rwkv_lnx_w=rwkv_lnx_w, rwkv_lnx_b=rwkv_lnx_b, rwkv_w_out=rwkv_w_out,
             ffn_w1=ffn_w1, ffn_w2=ffn_w2)
    bp = x_prompt.shape[0]
    sdt = state_lru_h.dtype
    y_prompt, lc_p, lh_p, sc_p, ss_p, rs_p, rw_p = run_trunk(
        x_prompt,
        jnp.zeros((N_LAYERS_A, bp, CONV_W - 1, D_LRU), sdt),
        jnp.zeros((N_LAYERS_A, bp, D_LRU), sdt),
        jnp.zeros((N_LAYERS_B, bp, CONV_W - 1, SSM_CONV_DIM), sdt),
        jnp.zeros((N_LAYERS_B, bp, SSM_HEADS, SSM_HEADDIM, SSM_STATE), sdt),
        jnp.zeros((N_LAYERS_C, bp, D_MODEL), sdt),
        jnp.zeros((N_LAYERS_C, bp, RWKV_HEADS, RWKV_HEAD, RWKV_HEAD), sdt),
        0, p)
    y_sample, lc_s, lh_s, sc_s, ss_s, rs_s, rw_s = run_trunk(
        x_sample, state_lru_conv, state_lru_h, state_ssm_conv, state_ssm,
        state_rwkv_shift, state_rwkv_wkv, PAST_LEN, p)
    return (y_prompt, y_sample, lc_p, lc_s, lh_p, lh_s, sc_p, sc_s, ss_p, ss_s, rs_p, rs_s, rw_p, rw_s)
```

```cpp
#include <hip/hip_runtime.h>
#include <hip/hip_cooperative_groups.h>
#include <stdint.h>
#include <stdio.h>
#include <string.h>
namespace cg = cooperative_groups;

typedef unsigned short bf16_t;
typedef __attribute__((ext_vector_type(8))) short bf16x8;
typedef __attribute__((ext_vector_type(16))) float f32x16;

#define DI __device__ __forceinline__

constexpr int T_ = 17408;
constexpr int TP_ = 16384;
constexpr int NTHR = 256;
constexpr int MT_ = T_ / 128;

enum {
  I_XP = 0, I_XS, I_ST_LC, I_ST_LH, I_ST_SC, I_ST_SS, I_ST_RS, I_ST_RW,
  I_NMIX, I_NFFN, I_NFIN,
  I_LRU_WIN, I_LRU_CW, I_LRU_CB, I_LRU_WR, I_LRU_BR, I_LRU_WI, I_LRU_BI, I_LRU_LAM, I_LRU_WOUT,
  I_SSM_WIN, I_SSM_CW, I_SSM_CB, I_SSM_DTB, I_SSM_ALOG, I_SSM_D, I_SSM_NW, I_SSM_WOUT,
  I_RW_MU, I_RW_WRKV, I_RW_W0, I_RW_WW1, I_RW_WW2, I_RW_A0, I_RW_WA1, I_RW_WA2, I_RW_WG1, I_RW_WG2,
  I_RW_KK, I_RW_KA, I_RW_RK, I_RW_LNW, I_RW_LNB, I_RW_WOUT,
  I_FFN_W1, I_FFN_W2, N_IN
};

constexpr size_t O_Y = 0;
constexpr size_t O_LC_P = O_Y + (size_t)T_ * 1024;
constexpr size_t O_LC_S = O_LC_P + 2 * 8 * 3 * 1024;
constexpr size_t O_LH_P = O_LC_S + 2 * 128 * 3 * 1024;
constexpr size_t O_LH_S = O_LH_P + 2 * 8 * 1024;
constexpr size_t O_SC_P = O_LH_S + 2 * 128 * 1024;
constexpr size_t O_SC_S = O_SC_P + 8 * 3 * 4096;
constexpr size_t O_SS_P = O_SC_S + 128 * 3 * 4096;
constexpr size_t O_SS_S = O_SS_P + (size_t)8 * 32 * 64 * 128;
constexpr size_t O_RS_P = O_SS_S + (size_t)128 * 32 * 64 * 128;
constexpr size_t O_RS_S = O_RS_P + 8 * 1024;
constexpr size_t O_RW_P = O_RS_S + 128 * 1024;
constexpr size_t O_RW_S = O_RW_P + 8 * 16 * 64 * 64;

constexpr size_t W_X = 0;
constexpr size_t W_U = W_X + (size_t)T_ * 1024 * 4;
constexpr size_t W_WT = W_U + (size_t)T_ * 1024 * 2;
constexpr size_t WA_IN = 0;
constexpr size_t WA_G = WA_IN + 2 * 2048 * 1024;
constexpr size_t WA_OUT = WA_G + 2 * 2048 * 128;
constexpr size_t WB_XBC = WA_OUT + 2 * 1024 * 1024;
constexpr size_t WB_Z = WB_XBC + 4128 * 1024;
constexpr size_t WB_OUT = WB_Z + 2048 * 1024;
constexpr size_t WC_RKV = WB_OUT + 1024 * 2048;
constexpr size_t WC_L1 = WC_RKV + 3 * 1024 * 1024;
constexpr size_t WC_W2 = WC_L1 + 256 * 1024;
constexpr size_t WC_A2 = WC_W2 + 1024 * 64;
constexpr size_t WC_G2 = WC_A2 + 1024 * 64;
constexpr size_t WC_OUT = WC_G2 + 1024 * 128;
constexpr size_t WF_1 = WC_OUT + 1024 * 1024;
constexpr size_t WF_2 = WF_1 + (size_t)4 * 4096 * 1024;
constexpr size_t W_WT_ELEMS = WF_2 + (size_t)4 * 4096 * 1024;
constexpr size_t W_S = W_WT + W_WT_ELEMS * 2;
constexpr size_t SZ_TD2 = (size_t)T_ * 1024 * 2;
constexpr size_t SZ_TD4 = (size_t)T_ * 1024 * 4;
constexpr size_t S_HB = W_S;
constexpr size_t SA_XB = W_S;
constexpr size_t SA_GT = SA_XB + SZ_TD2;
constexpr size_t SA_XC = SA_GT + SZ_TD2;
constexpr size_t SA_AA = SA_XC + SZ_TD2;
constexpr size_t SA_BB = SA_AA + SZ_TD4;
constexpr size_t SA_CP = SA_BB + SZ_TD4;
constexpr size_t SA_CS = SA_CP + 8 * 64 * 1024 * 4;
constexpr size_t SB_XBCP = W_S;
constexpr size_t SB_Y = W_S;
constexpr size_t SB_XBC = SB_XBCP + SZ_TD2 * 4;
constexpr size_t SB_DT = SB_XBC + SZ_TD2 * 4;
constexpr size_t SC_UP = W_S;
constexpr size_t SC_O = W_S;
constexpr size_t SC_R = SC_UP + SZ_TD2;
constexpr size_t SC_K = SC_R + SZ_TD2;
constexpr size_t SC_V = SC_K + SZ_TD2;
constexpr size_t SC_LH = SC_V + SZ_TD2;
constexpr size_t SC_WD = SC_LH + (size_t)T_ * 256 * 2;
constexpr size_t SC_AA = SC_WD + SZ_TD4;
constexpr size_t SC_G = SC_AA + SZ_TD2;
constexpr size_t SC_END = SC_G + SZ_TD2;
static_assert(SC_END <= (size_t)536870912, "ws overflow C");
static_assert(SB_DT + (size_t)T_ * 32 * 4 <= (size_t)536870912, "ws overflow B");
static_assert(SA_CS + 8 * 64 * 1024 * 4 <= (size_t)536870912, "ws overflow A");

constexpr int SMEM_BYTES = 80384;

struct Params {
  const float* in[N_IN];
  float* out;
  char* ws;
  int ph_begin, ph_end;
};

DI float bf2f(bf16_t h) { return __uint_as_float(((unsigned)h) << 16); }
DI bf16_t f2bf(float f) {
  unsigned u = __float_as_uint(f);
  u += 0x7FFFu + ((u >> 16) & 1u);
  return (bf16_t)(u >> 16);
}
DI unsigned pack2(float a, float b) { return (unsigned)f2bf(a) | ((unsigned)f2bf(b) << 16); }
DI void unpack8(const uint4 v, float (&f)[8]) {
  f[0] = __uint_as_float(v.x << 16); f[1] = __uint_as_float(v.x & 0xFFFF0000u);
  f[2] = __uint_as_float(v.y << 16); f[3] = __uint_as_float(v.y & 0xFFFF0000u);
  f[4] = __uint_as_float(v.z << 16); f[5] = __uint_as_float(v.z & 0xFFFF0000u);
  f[6] = __uint_as_float(v.w << 16); f[7] = __uint_as_float(v.w & 0xFFFF0000u);
}
DI uint4 pack8(const float (&f)[8]) {
  return make_uint4(pack2(f[0], f[1]), pack2(f[2], f[3]), pack2(f[4], f[5]), pack2(f[6], f[7]));
}
DI void load8f(const float* p, float (&f)[8]) {
  float4 a = *(const float4*)p, b = *(const float4*)(p + 4);
  f[0] = a.x; f[1] = a.y; f[2] = a.z; f[3] = a.w; f[4] = b.x; f[5] = b.y; f[6] = b.z; f[7] = b.w;
}
DI void store8f(float* p, const float (&f)[8]) {
  *(float4*)p = make_float4(f[0], f[1], f[2], f[3]);
  *(float4*)(p + 4) = make_float4(f[4], f[5], f[6], f[7]);
}
DI float sigmoidf_(float x) { return 1.f / (1.f + __expf(-x)); }
DI float siluf_(float x) { return x / (1.f + __expf(-x)); }
DI float tanhf_(float y) { return 1.f - 2.f / (1.f + __expf(2.f * y)); }
DI float geluf_(float x) { return 0.5f * x * (1.f + tanhf_(0.7978845608028654f * (x + 0.044715f * x * x * x))); }
DI float softplusf_(float x) { return fmaxf(x, 0.f) + log1pf(__expf(-fabsf(x))); }
DI float wave_sum(float v) {
#pragma unroll
  for (int o = 32; o >= 1; o >>= 1) v += __shfl_xor(v, o, 64);
  return v;
}
template <int CTRL> DI float dppf(float x) {
  return __int_as_float(__builtin_amdgcn_update_dpp(0, __float_as_int(x), CTRL, 0xf, 0xf, false));
}
template <int N> DI float red_lanes(float x) {
  x += dppf<0xB1>(x);
  x += dppf<0x4E>(x);
  if (N >= 8) x += dppf<0x141>(x);
  if (N >= 16) x += dppf<0x140>(x);
  return x;
}
DI void tok_info(int t, int& seq, int& l, int& L) {
  if (t < TP_) { seq = t >> 11; l = t & 2047; L = 2048; }
  else { int u = t - TP_; seq = 8 + (u >> 3); l = u & 7; L = 8; }
}
DI int opq(int x) { asm volatile("" : "+v"(x)); return x; }
#define TIDX opq((int)threadIdx.x)
DI f32x16 mfma32(bf16x8 a, bf16x8 b, f32x16 c) { return __builtin_amdgcn_mfma_f32_32x32x16_bf16(a, b, c, 0, 0, 0); }

struct GJob {
  const bf16_t* A; const bf16_t* A2; const float* mu; const bf16_t* Bt;
  int lda, ldb, K, nvalid;
  void* o0; void* o1; const float* x0; const float* x1; const float* x2;
  int ldo, act;
};
enum { EPI_LRU_IN = 0, EPI_GATES, EPI_RESID, EPI_SSM_XBC, EPI_SSM_Z, EPI_FFN1, EPI_ST, EPI_DECAY, EPI_SIGB };

template <int EPI> DI void epi_elem(const GJob& j, int row, int col, float v) {
  if (EPI == EPI_LRU_IN) {
    if (col < 1024) ((bf16_t*)j.o0)[(size_t)row * 1024 + col] = f2bf(v);
    else ((bf16_t*)j.o1)[(size_t)row * 1024 + col - 1024] = f2bf(geluf_(v));
  } else if (EPI == EPI_RESID) {
    float* x = (float*)j.o0 + (size_t)row * 1024 + col;
    *x = *x + v;
  } else if (EPI == EPI_SSM_XBC) {
    if (col < 4096) ((bf16_t*)j.o0)[(size_t)row * 4096 + col] = f2bf(v);
    else if (col < 4128) ((float*)j.o1)[(size_t)row * 32 + col - 4096] = softplusf_(v + j.x0[col - 4096]);
  } else if (EPI == EPI_SSM_Z) {
    bf16_t* y = (bf16_t*)j.o0 + (size_t)row * 2048 + col;
    *y = f2bf(bf2f(*y) * siluf_(v));
  } else if (EPI == EPI_FFN1) {
    float r = fmaxf(v, 0.f);
    ((bf16_t*)j.o0)[(size_t)row * 4096 + col] = f2bf(r * r);
  } else if (EPI == EPI_ST) {
    if (col < j.nvalid) {
      float r = v;
      if (j.act == 1) r = tanhf_(v); else if (j.act == 2) r = sigmoidf_(v);
      ((bf16_t*)j.o0)[(size_t)row * j.ldo + col] = f2bf(r);
    }
  } else if (EPI == EPI_DECAY) {
    float wl = -softplusf_(-(j.x0[col] + v)) - 0.5f;
    ((float*)j.o0)[(size_t)row * 1024 + col] = __expf(-__expf(wl));
  } else if (EPI == EPI_SIGB) {
    ((bf16_t*)j.o0)[(size_t)row * 1024 + col] = f2bf(sigmoidf_(j.x0[col] + v));
  }
}

template <int EPI, bool MIX>
DI void gemm_tile(const GJob& j, int m0, int n0, char* smem) {
  const int tid = TIDX, lane = tid & 63, w = tid >> 6;
  const int wm = w >> 1, wn = w & 1, r32 = lane & 31, hh = lane >> 5;
  const int lrow = tid >> 3, kc = tid & 7;
  f32x16 acc[2][2];
#pragma unroll
  for (int a = 0; a < 2; ++a)
#pragma unroll
    for (int b = 0; b < 2; ++b)
#pragma unroll
      for (int r = 0; r < 16; ++r) acc[a][b][r] = 0.f;
  uint4 ra[4], rb[4], ra2[4];
  const int nk = j.K >> 6;
  const bf16_t* Ap = j.A + (size_t)(m0 + lrow) * j.lda + kc * 8;
  const bf16_t* A2p = MIX ? (j.A2 + (size_t)(m0 + lrow) * j.lda + kc * 8) : nullptr;
  const bf16_t* Bp = j.Bt + (size_t)(n0 + lrow) * j.ldb + kc * 8;
  const size_t astep = (size_t)32 * j.lda, bstep = (size_t)32 * j.ldb;

#define GLOAD(kt)                                                                     \
  {                                                                                   \
    _Pragma("unroll") for (int i = 0; i < 4; ++i) {                                   \
      ra[i] = *(const uint4*)(Ap + i * astep + (kt) * 64);                            \
      if (MIX) ra2[i] = *(const uint4*)(A2p + i * astep + (kt) * 64);                 \
      if (n0 + lrow + 32 * i < j.nvalid) rb[i] = *(const uint4*)(Bp + i * bstep + (kt) * 64); \
      else rb[i] = make_uint4(0, 0, 0, 0);                                            \
    }                                                                                 \
  }
#define SSTORE(kt, buf)                                                               \
  {                                                                                   \
    char* As_ = smem + (buf) * 36864; char* Bs_ = As_ + 18432;                        \
    if (MIX) {                                                                        \
      float mu8[8]; load8f(j.mu + (kt) * 64 + kc * 8, mu8);                           \
      _Pragma("unroll") for (int i = 0; i < 4; ++i) {                                 \
        float f1[8], f2[8]; unpack8(ra[i], f1); unpack8(ra2[i], f2);                  \
        _Pragma("unroll") for (int e = 0; e < 8; ++e) f1[e] = f1[e] + (f2[e] - f1[e]) * mu8[e]; \
        ra[i] = pack8(f1);                                                            \
      }                                                                               \
    }                                                                                 \
    _Pragma("unroll") for (int i = 0; i < 4; ++i) {                                   \
      *(uint4*)(As_ + (lrow + 32 * i) * 144 + kc * 16) = ra[i];                       \
      *(uint4*)(Bs_ + (lrow + 32 * i) * 144 + kc * 16) = rb[i];                       \
    }                                                                                 \
  }

  GLOAD(0);
  SSTORE(0, 0);
  __syncthreads();
  for (int kt = 0; kt < nk; ++kt) {
    const bool more = (kt + 1 < nk);
    if (more) GLOAD(kt + 1);
    {
      const char* As_ = smem + (kt & 1) * 36864; const char* Bs_ = As_ + 18432;
      const char* ap = As_ + (wm * 64 + r32) * 144 + hh * 16;
      const char* bp = Bs_ + (wn * 64 + r32) * 144 + hh * 16;
#pragma unroll
      for (int ks = 0; ks < 4; ++ks) {
        bf16x8 a0 = *(const bf16x8*)(ap + ks * 32);
        bf16x8 a1 = *(const bf16x8*)(ap + 32 * 144 + ks * 32);
        bf16x8 b0 = *(const bf16x8*)(bp + ks * 32);
        bf16x8 b1 = *(const bf16x8*)(bp + 32 * 144 + ks * 32);
        acc[0][0] = mfma32(a0, b0, acc[0][0]);
        acc[0][1] = mfma32(a0, b1, acc[0][1]);
        acc[1][0] = mfma32(a1, b0, acc[1][0]);
        acc[1][1] = mfma32(a1, b1, acc[1][1]);
      }
    }
    if (more) SSTORE(kt + 1, (kt + 1) & 1);
    __syncthreads();
  }
#undef GLOAD
#undef SSTORE

  if (EPI == EPI_GATES) {
    const int ch = (n0 >> 7) * 64 + wn * 32 + r32;
    const float br = j.x0[ch], bi = j.x1[ch];
    const float spl = softplusf_(-j.x2[ch]);
    const bf16_t* XC = (const bf16_t*)j.o1;
    float* AA = (float*)j.o0;
    float* BBp = AA + (size_t)T_ * 1024;
#pragma unroll
    for (int mi = 0; mi < 2; ++mi)
#pragma unroll
      for (int r = 0; r < 16; ++r) {
        const int row = m0 + wm * 64 + mi * 32 + (r & 3) + 8 * (r >> 2) + 4 * hh;
        const float rg = sigmoidf_(acc[mi][0][r] + br);
        const float ig = sigmoidf_(acc[mi][1][r] + bi);
        const float la = -8.f * rg * spl;
        const float xc = bf2f(XC[(size_t)row * 1024 + ch]);
        const bool reset = (row < TP_) && ((row & 2047) == 0);
        const float a = reset ? 0.f : __expf(la);
        const float mult = reset ? 1.f : sqrtf(fmaxf(-expm1f(2.f * la), 0.f));
        AA[(size_t)row * 1024 + ch] = a;
        BBp[(size_t)row * 1024 + ch] = mult * ig * xc;
      }
  } else {
#pragma unroll
    for (int mi = 0; mi < 2; ++mi)
#pragma unroll
      for (int ni = 0; ni < 2; ++ni)
#pragma unroll
        for (int r = 0; r < 16; ++r) {
          const int row = m0 + wm * 64 + mi * 32 + (r & 3) + 8 * (r >> 2) + 4 * hh;
          const int col = n0 + wn * 64 + ni * 32 + r32;
          epi_elem<EPI>(j, row, col, acc[mi][ni][r]);
        }
  }
}

template <int EPI, bool MIX>
DI void gemm_run(const GJob& j, int ntn, int& toff, char* smem) {
  const int G = gridDim.x;
  const int ntiles = MT_ * ntn;
  const int start = (int)(((int)blockIdx.x - (toff % G) + G) % G);
  for (int tile = start; tile < ntiles; tile += G) {
    const int mt = tile / ntn, nt = tile - mt * ntn;
    gemm_tile<EPI, MIX>(j, mt * 128, nt * 128, smem);
  }
  toff += ntiles;
}

DI GJob mkjob(const bf16_t* A, int lda, const bf16_t* Bt, int ldb, int K, int nvalid) {
  GJob j;
  j.A = A; j.A2 = nullptr; j.mu = nullptr; j.Bt = Bt; j.lda = lda; j.ldb = ldb; j.K = K; j.nvalid = nvalid;
  j.o0 = nullptr; j.o1 = nullptr; j.x0 = nullptr; j.x1 = nullptr; j.x2 = nullptr; j.ldo = 0; j.act = 0;
  return j;
}

struct TJob { const float* src; bf16_t* dst; int K, N, src_ld, kind, n_off; };

DI TJob get_tjob(const Params& p, int j) {
  bf16_t* wt = (bf16_t*)(p.ws + W_WT);
  TJob o; o.kind = 0; o.n_off = 0;
  if (j < 36) {
    const int ia = j / 18, r = j % 18;
    if (r == 0) { o.src = p.in[I_LRU_WIN] + (size_t)ia * 1024 * 2048; o.dst = wt + WA_IN + (size_t)ia * 2048 * 1024; o.K = 1024; o.N = 2048; o.src_ld = 2048; }
    else if (r == 1) { o.src = p.in[I_LRU_WOUT] + (size_t)ia * 1024 * 1024; o.dst = wt + WA_OUT + (size_t)ia * 1024 * 1024; o.K = 1024; o.N = 1024; o.src_ld = 1024; }
    else {
      const int isI = (r >= 10) ? 1 : 0; const int h = (r - 2) & 7;
      o.src = p.in[isI ? I_LRU_WI : I_LRU_WR] + ((size_t)ia * 8 + h) * 128 * 128;
      o.dst = wt + WA_G + (size_t)ia * 2048 * 128; o.K = 128; o.N = 128; o.src_ld = 128; o.kind = 1 + isI; o.n_off = h * 128;
    }
  } else if (j == 36) { o.src = p.in[I_SSM_WIN] + 2048; o.dst = wt + WB_XBC; o.K = 1024; o.N = 4128; o.src_ld = 6176; }
  else if (j == 37) { o.src = p.in[I_SSM_WIN]; o.dst = wt + WB_Z; o.K = 1024; o.N = 2048; o.src_ld = 6176; }
  else if (j == 38) { o.src = p.in[I_SSM_WOUT]; o.dst = wt + WB_OUT; o.K = 2048; o.N = 1024; o.src_ld = 1024; }
  else if (j < 42) { const int s = j - 39; o.src = p.in[I_RW_WRKV] + (size_t)s * 1024 * 1024; o.dst = wt + WC_RKV + (size_t)s * 1024 * 1024; o.K = 1024; o.N = 1024; o.src_ld = 1024; }
  else if (j == 42) { o.src = p.in[I_RW_WW1]; o.dst = wt + WC_L1; o.K = 1024; o.N = 64; o.src_ld = 64; }
  else if (j == 43) { o.src = p.in[I_RW_WA1]; o.dst = wt + WC_L1 + 64 * 1024; o.K = 1024; o.N = 64; o.src_ld = 64; }
  else if (j == 44) { o.src = p.in[I_RW_WG1]; o.dst = wt + WC_L1 + 128 * 1024; o.K = 1024; o.N = 128; o.src_ld = 128; }
  else if (j == 45) { o.src = p.in[I_RW_WW2]; o.dst = wt + WC_W2; o.K = 64; o.N = 1024; o.src_ld = 1024; }
  else if (j == 46) { o.src = p.in[I_RW_WA2]; o.dst = wt + WC_A2; o.K = 64; o.N = 1024; o.src_ld = 1024; }
  else if (j == 47) { o.src = p.in[I_RW_WG2]; o.dst = wt + WC_G2; o.K = 128; o.N = 1024; o.src_ld = 1024; }
  else if (j == 48) { o.src = p.in[I_RW_WOUT]; o.dst = wt + WC_OUT; o.K = 1024; o.N = 1024; o.src_ld = 1024; }
  else {
    const int l = (j - 49) >> 1, which = (j - 49) & 1;
    if (!which) { o.src = p.in[I_FFN_W1] + (size_t)l * 1024 * 4096; o.dst = wt + WF_1 + (size_t)l * 4096 * 1024; o.K = 1024; o.N = 4096; o.src_ld = 4096; }
    else { o.src = p.in[I_FFN_W2] + (size_t)l * 4096 * 1024; o.dst = wt + WF_2 + (size_t)l * 4096 * 1024; o.K = 4096; o.N = 1024; o.src_ld = 1024; }
  }
  return o;
}
constexpr int N_TJOBS = 57;

DI void ph_prologue(const Params& p, char* smem) {
  const int tid = TIDX, G = gridDim.x;
  {
    const float4* xp = (const float4*)p.in[I_XP];
    const float4* xs = (const float4*)p.in[I_XS];
    float4* X = (float4*)(p.ws + W_X);
    const size_t np = (size_t)TP_ * 256, nt = (size_t)T_ * 256;
    for (size_t i = (size_t)blockIdx.x * NTHR + tid; i < nt; i += (size_t)G * NTHR)
      X[i] = (i < np) ? xp[i] : xs[i - np];
  }
  float* tile = (float*)smem;
  int toff = 0;
  for (int jn = 0; jn < N_TJOBS; ++jn) {
    const TJob tj = get_tjob(p, jn);
    const int nkt = tj.K >> 6, nnt = (tj.N + 63) >> 6;
    const int ntiles = nkt * nnt;
    const int start = (((int)blockIdx.x - (toff % G)) + G) % G;
    for (int t = start; t < ntiles; t += G) {
      const int kt = t / nnt, nt = t - kt * nnt;
      const int k0 = kt * 64, n0 = nt * 64;
      __syncthreads();
#pragma unroll 4
      for (int i = 0; i < 16; ++i) {
        const int k = i * 4 + (tid >> 6), n = tid & 63;
        float v = 0.f;
        if (n0 + n < tj.N) v = tj.src[(size_t)(k0 + k) * tj.src_ld + n0 + n];
        tile[k * 65 + n] = v;
      }
      __syncthreads();
      const int n = tid >> 2, kq = tid & 3;
      if (n0 + n < tj.N) {
        int nrow = n0 + n;
        if (tj.kind) {
          const int ch = tj.n_off + n0 + n;
          nrow = (ch >> 6) * 128 + ((ch >> 5) & 1) * 64 + (tj.kind - 1) * 32 + (ch & 31);
        }
        float f[8], g[8];
#pragma unroll
        for (int e = 0; e < 8; ++e) { f[e] = tile[(kq * 16 + e) * 65 + n]; g[e] = tile[(kq * 16 + 8 + e) * 65 + n]; }
        uint4* d = (uint4*)(tj.dst + (size_t)nrow * tj.K + k0 + kq * 16);
        d[0] = pack8(f); d[1] = pack8(g);
      }
    }
    toff += ntiles;
  }
}

DI void ph_rmsnorm(const Params& p, int mode, const float* w) {
  const int tid_ = TIDX; const int lane = tid_ & 63;
  const int gw = blockIdx.x * 4 + (tid_ >> 6), nw = gridDim.x * 4;
  const float* X = (const float*)(p.ws + W_X);
  bf16_t* U = (bf16_t*)(p.ws + W_U);
  bf16_t* UP = (bf16_t*)(p.ws + SC_UP);
  float4 wv[4];
#pragma unroll
  for (int i = 0; i < 4; ++i) wv[i] = ((const float4*)w)[lane + 64 * i];
  for (int row = gw; row < T_; row += nw) {
    const float4* xr = (const float4*)(X + (size_t)row * 1024);
    float4 v[4]; float ss = 0.f;
#pragma unroll
    for (int i = 0; i < 4; ++i) { v[i] = xr[lane + 64 * i]; ss += v[i].x * v[i].x + v[i].y * v[i].y + v[i].z * v[i].z + v[i].w * v[i].w; }
    ss = wave_sum(ss);
    const float rstd = rsqrtf(ss * (1.f / 1024.f) + 1e-6f);
    int seq, l, L; tok_info(row, seq, l, L);
#pragma unroll
    for (int i = 0; i < 4; ++i) {
      const int c = 4 * (lane + 64 * i);
      float4 y = make_float4(v[i].x * rstd * wv[i].x, v[i].y * rstd * wv[i].y, v[i].z * rstd * wv[i].z, v[i].w * rstd * wv[i].w);
      if (mode == 2) {
        *(float4*)(p.out + O_Y + (size_t)row * 1024 + c) = y;
      } else {
        uint2 pk = make_uint2(pack2(y.x, y.y), pack2(y.z, y.w));
        *(uint2*)(U + (size_t)row * 1024 + c) = pk;
        if (mode == 1) {
          if (l + 1 < L) *(uint2*)(UP + (size_t)(row + 1) * 1024 + c) = pk;
          if (l == 0) {
            uint2 pz = make_uint2(0, 0);
            if (seq >= 8) { float4 s = *(const float4*)(p.in[I_ST_RS] + (size_t)(seq - 8) * 1024 + c); pz = make_uint2(pack2(s.x, s.y), pack2(s.z, s.w)); }
            *(uint2*)(UP + (size_t)row * 1024 + c) = pz;
          }
          if (l == L - 1) {
            float* o = (seq < 8) ? (p.out + O_RS_P + (size_t)seq * 1024 + c) : (p.out + O_RS_S + (size_t)(seq - 8) * 1024 + c);
            *(float4*)o = y;
          }
        }
      }
    }
  }
}

template <int C, bool SILU>
DI void ph_conv(const bf16_t* src, bf16_t* dst, const float* cw, const float* cb, const float* state,
                float* out_p, float* out_s) {
  constexpr int GR = C / 8;
  const size_t total = (size_t)T_ * GR;
  for (size_t idx = (size_t)blockIdx.x * NTHR + TIDX; idx < total; idx += (size_t)gridDim.x * NTHR) {
    const int t = (int)(idx / GR), c = (int)(idx % GR) * 8;
    int seq, l, L; tok_info(t, seq, l, L);
    float acc[8]; load8f(cb + c, acc);
    float xcur[8];
#pragma unroll
    for (int jj = 0; jj < 4; ++jj) {
      const int ls = l - 3 + jj;
      float xv[8];
      if (ls >= 0) { unpack8(*(const uint4*)(src + (size_t)(t - 3 + jj) * C + c), xv); }
      else if (seq >= 8) { load8f(state + ((size_t)(seq - 8) * 3 + (ls + 3)) * C + c, xv); }
      else {
#pragma unroll
        for (int e = 0; e < 8; ++e) xv[e] = 0.f;
      }
      float w8[8]; load8f(cw + (size_t)jj * C + c, w8);
#pragma unroll
      for (int e = 0; e < 8; ++e) acc[e] += w8[e] * xv[e];
      if (jj == 3) {
#pragma unroll
        for (int e = 0; e < 8; ++e) xcur[e] = xv[e];
      }
    }
    if (SILU) {
#pragma unroll
      for (int e = 0; e < 8; ++e) acc[e] = siluf_(acc[e]);
    }
    *(uint4*)(dst + (size_t)t * C + c) = pack8(acc);
    if (l >= L - 3) {
      const int r = l - (L - 3);
      float* o = (seq < 8) ? (out_p + ((size_t)seq * 3 + r) * C + c) : (out_s + ((size_t)(seq - 8) * 3 + r) * C + c);
      store8f(o, xcur);
    }
  }
}

DI void ph_lru_scan1(const Params& p) {
  const float* AA = (const float*)(p.ws + SA_AA);
  const float* BB = (const float*)(p.ws + SA_BB);
  float* CP = (float*)(p.ws + SA_CP);
  float* CS = (float*)(p.ws + SA_CS);
  const int total = 8 * 64 * 1024;
  for (int idx = blockIdx.x * NTHR + TIDX; idx < total; idx += gridDim.x * NTHR) {
    const int ch = idx & 1023, c = (idx >> 10) & 63, b = idx >> 16;
    const size_t base = ((size_t)b * 2048 + c * 32) * 1024 + ch;
    float P = 1.f, S = 0.f;
#pragma unroll 8
    for (int s = 0; s < 32; ++s) {
      const float a = AA[base + (size_t)s * 1024], bb = BB[base + (size_t)s * 1024];
      S = a * S + bb; P *= a;
    }
    CP[idx] = P; CS[idx] = S;
  }
}
DI void ph_lru_scan2(const Params& p, int ia) {
  const float* AA = (const float*)(p.ws + SA_AA);
  const float* BB = (const float*)(p.ws + SA_BB);
  const float* CP = (const float*)(p.ws + SA_CP);
  const float* CS = (const float*)(p.ws + SA_CS);
  bf16_t* GT = (bf16_t*)(p.ws + SA_GT);
  const int nP = 8 * 64 * 1024, total = nP + 128 * 1024;
  for (int idx = blockIdx.x * NTHR + TIDX; idx < total; idx += gridDim.x * NTHR) {
    if (idx < nP) {
      const int ch = idx & 1023, c = (idx >> 10) & 63, b = idx >> 16;
      float h = 0.f;
      for (int c2 = 0; c2 < c; ++c2) {
        const int ci = ((b * 64 + c2) << 10) + ch;
        h = CP[ci] * h + CS[ci];
      }
      const size_t base = ((size_t)b * 2048 + c * 32) * 1024 + ch;
#pragma unroll 8
      for (int s = 0; s < 32; ++s) {
        const size_t o = base + (size_t)s * 1024;
        h = AA[o] * h + BB[o];
        GT[o] = f2bf(h * bf2f(GT[o]));
      }
      if (c == 63) p.out[O_LH_P + ((size_t)ia * 8 + b) * 1024 + ch] = h;
    } else {
      const int u = idx - nP; const int ch = u & 1023, s = u >> 10;
      float h = p.in[I_ST_LH][((size_t)ia * 128 + s) * 1024 + ch];
      const size_t base = ((size_t)TP_ + s * 8) * 1024 + ch;
#pragma unroll
      for (int q = 0; q < 8; ++q) {
        const size_t o = base + (size_t)q * 1024;
        h = AA[o] * h + BB[o];
        GT[o] = f2bf(h * bf2f(GT[o]));
      }
      p.out[O_LH_S + ((size_t)ia * 128 + s) * 1024 + ch] = h;
    }
  }
}

DI void ssd_item(const Params& p, char* smem, int seq, int h) {
  const int tid = TIDX, lane = tid & 63, w = tid >> 6, r32 = lane & 31, hh = lane >> 5;
  bf16_t* Cs = (bf16_t*)smem;
  bf16_t* Bs = Cs + 64 * 136;
  bf16_t* Sb = Bs + 64 * 136;
  bf16_t* Xt = Sb + 64 * 136;
  bf16_t* Btr = Xt + 64 * 72;
  float* dts = (float*)(Btr + 128 * 72);
  float* acs = dts + 64;
  bf16_t* Ws = Bs;
  const bf16_t* XBC = (const bf16_t*)(p.ws + SB_XBC);
  const float* DT = (const float*)(p.ws + SB_DT);
  bf16_t* Y = (bf16_t*)(p.ws + SB_Y);
  const bool prompt = seq < 8;
  const int nchunk = prompt ? 32 : 1, Lv = prompt ? 64 : 8;
  const int tbase = prompt ? seq * 2048 : TP_ + (seq - 8) * 8;
  const int g = h >> 2;
  const float Ah = -__expf(p.in[I_SSM_ALOG][h]);
  const float Dh = p.in[I_SSM_D][h];
  f32x16 accS[2];
  {
    const float* s0 = p.in[I_ST_SS] + ((size_t)(seq - 8) * 32 + h) * 64 * 128;
#pragma unroll
    for (int mi = 0; mi < 2; ++mi)
#pragma unroll
      for (int r = 0; r < 16; ++r) {
        const int prow = mi * 32 + (r & 3) + 8 * (r >> 2) + 4 * hh, n = 32 * w + r32;
        accS[mi][r] = prompt ? 0.f : s0[(size_t)prow * 128 + n];
      }
  }
  __syncthreads();
#pragma unroll
  for (int mi = 0; mi < 2; ++mi)
#pragma unroll
    for (int r = 0; r < 16; ++r) {
      const int prow = mi * 32 + (r & 3) + 8 * (r >> 2) + 4 * hh, n = 32 * w + r32;
      Sb[prow * 136 + n] = f2bf(accS[mi][r]);
    }
  for (int c = 0; c < nchunk; ++c) {
    const int t0 = tbase + c * 64;
    __syncthreads();
    if (tid < 64) {
      const float dtv = (tid < Lv) ? DT[(size_t)(t0 + tid) * 32 + h] : 0.f;
      float x = dtv * Ah;
#pragma unroll
      for (int o = 1; o < 64; o <<= 1) { const float y = __shfl_up(x, o, 64); if (lane >= o) x += y; }
      dts[tid] = dtv; acs[tid] = x;
    }
    __syncthreads();
    const float aend = acs[63];
#pragma unroll
    for (int i = 0; i < 4; ++i) {
      const int id = tid + 256 * i, row = id >> 4, ch = id & 15;
      uint4 cv = make_uint4(0, 0, 0, 0), bv = make_uint4(0, 0, 0, 0);
      if (row < Lv) {
        const bf16_t* src = XBC + (size_t)(t0 + row) * 4096 + g * 128 + ch * 8;
        bv = *(const uint4*)(src + 2048);
        cv = *(const uint4*)(src + 3072);
      }
      *(uint4*)(Cs + row * 136 + ch * 8) = cv;
      *(uint4*)(Bs + row * 136 + ch * 8) = bv;
      float f[8]; unpack8(bv, f);
      const float sc = __expf(aend - acs[row]);
#pragma unroll
      for (int e = 0; e < 8; ++e) Btr[(ch * 8 + e) * 72 + row] = f2bf(f[e] * sc);
    }
#pragma unroll
    for (int i = 0; i < 2; ++i) {
      const int id = tid + 256 * i, row = id >> 3, ch = id & 7;
      uint4 xv = make_uint4(0, 0, 0, 0);
      if (row < Lv) xv = *(const uint4*)(XBC + (size_t)(t0 + row) * 4096 + h * 64 + ch * 8);
      float f[8]; unpack8(xv, f);
      const float sc = dts[row];
#pragma unroll
      for (int e = 0; e < 8; ++e) Xt[(ch * 8 + e) * 72 + row] = f2bf(f[e] * sc);
    }
    __syncthreads();
    const int it = w >> 1, jt = w & 1;
    f32x16 cb;
#pragma unroll
    for (int r = 0; r < 16; ++r) cb[r] = 0.f;
    if (jt <= it) {
#pragma unroll
      for (int ks = 0; ks < 8; ++ks) {
        bf16x8 a = *(const bf16x8*)(Cs + (it * 32 + r32) * 136 + ks * 16 + hh * 8);
        bf16x8 b = *(const bf16x8*)(Bs + (jt * 32 + r32) * 136 + ks * 16 + hh * 8);
        cb = mfma32(a, b, cb);
      }
    }
    __syncthreads();
    {
      const int jj = jt * 32 + r32; const float aj = acs[jj];
#pragma unroll
      for (int r = 0; r < 16; ++r) {
        const int ii = it * 32 + (r & 3) + 8 * (r >> 2) + 4 * hh;
        const float v = (jj <= ii) ? cb[r] * __expf(acs[ii] - aj) : 0.f;
        Ws[ii * 72 + jj] = f2bf(v);
      }
    }
    __syncthreads();
    {
      const int pt = w & 1;
      f32x16 yd, yo;
#pragma unroll
      for (int r = 0; r < 16; ++r) { yd[r] = 0.f; yo[r] = 0.f; }
#pragma unroll
      for (int ks = 0; ks < 4; ++ks) {
        bf16x8 a = *(const bf16x8*)(Ws + (it * 32 + r32) * 72 + ks * 16 + hh * 8);
        bf16x8 b = *(const bf16x8*)(Xt + (pt * 32 + r32) * 72 + ks * 16 + hh * 8);
        yd = mfma32(a, b, yd);
      }
#pragma unroll
      for (int ks = 0; ks < 8; ++ks) {
        bf16x8 a = *(const bf16x8*)(Cs + (it * 32 + r32) * 136 + ks * 16 + hh * 8);
        bf16x8 b = *(const bf16x8*)(Sb + (pt * 32 + r32) * 136 + ks * 16 + hh * 8);
        yo = mfma32(a, b, yo);
      }
      const int pp = pt * 32 + r32;
#pragma unroll
      for (int r = 0; r < 16; ++r) {
        const int ii = it * 32 + (r & 3) + 8 * (r >> 2) + 4 * hh;
        if (ii < Lv) {
          const size_t t = (size_t)(t0 + ii);
          const float xv = bf2f(XBC[t * 4096 + h * 64 + pp]);
          const float yv = yd[r] + __expf(acs[ii]) * yo[r] + Dh * xv;
          Y[t * 2048 + h * 64 + pp] = f2bf(yv);
        }
      }
    }
    {
      const float dec = __expf(aend);
#pragma unroll
      for (int mi = 0; mi < 2; ++mi)
#pragma unroll
        for (int r = 0; r < 16; ++r) accS[mi][r] *= dec;
#pragma unroll
      for (int ks = 0; ks < 4; ++ks) {
        bf16x8 b = *(const bf16x8*)(Btr + (32 * w + r32) * 72 + ks * 16 + hh * 8);
        bf16x8 a0 = *(const bf16x8*)(Xt + (r32) * 72 + ks * 16 + hh * 8);
        bf16x8 a1 = *(const bf16x8*)(Xt + (32 + r32) * 72 + ks * 16 + hh * 8);
        accS[0] = mfma32(a0, b, accS[0]);
        accS[1] = mfma32(a1, b, accS[1]);
      }
    }
    __syncthreads();
#pragma unroll
    for (int mi = 0; mi < 2; ++mi)
#pragma unroll
      for (int r = 0; r < 16; ++r) {
        const int prow = mi * 32 + (r & 3) + 8 * (r >> 2) + 4 * hh, n = 32 * w + r32;
        Sb[prow * 136 + n] = f2bf(accS[mi][r]);
      }
  }
  float* dst = prompt ? (p.out + O_SS_P + ((size_t)seq * 32 + h) * 64 * 128)
                      : (p.out + O_SS_S + ((size_t)(seq - 8) * 32 + h) * 64 * 128);
#pragma unroll
  for (int mi = 0; mi < 2; ++mi)
#pragma unroll
    for (int r = 0; r < 16; ++r) {
      const int prow = mi * 32 + (r & 3) + 8 * (r >> 2) + 4 * hh, n = 32 * w + r32;
      dst[(size_t)prow * 128 + n] = accS[mi][r];
    }
}

DI void ph_ssd(const Params& p, char* smem) {
  const int G = gridDim.x, bid = blockIdx.x;
  int it = bid, step = G;
  if (G >= 512) { if (bid < 256) { step = 1 << 30; } else { step = G - 256; } }
#pragma nounroll
  for (; it < 256 + 4096; it += step) {
    const int seq = (it < 256) ? (it >> 5) : (8 + ((it - 256) >> 5));
    ssd_item(p, smem, seq, it & 31);
  }
}

DI void ph_gnorm(const Params& p) {
  const int tid_ = TIDX; const int lane = tid_ & 63;
  const int gw = blockIdx.x * 4 + (tid_ >> 6), nw = gridDim.x * 4;
  bf16_t* Y = (bf16_t*)(p.ws + SB_Y);
  const float* nwt = p.in[I_SSM_NW];
  for (int item = gw; item < T_ * 8; item += nw) {
    const int t = item >> 3, g = item & 7;
    bf16_t* yp = Y + (size_t)t * 2048 + g * 256 + lane * 4;
    const uint2 v = *(const uint2*)yp;
    const float f0 = __uint_as_float(v.x << 16), f1 = __uint_as_float(v.x & 0xFFFF0000u);
    const float f2 = __uint_as_float(v.y << 16), f3 = __uint_as_float(v.y & 0xFFFF0000u);
    const float ss = wave_sum(f0 * f0 + f1 * f1 + f2 * f2 + f3 * f3);
    const float rstd = rsqrtf(ss * (1.f / 256.f) + 1e-5f);
    const float4 wv = *(const float4*)(nwt + g * 256 + lane * 4);
    *(uint2*)yp = make_uint2(pack2(f0 * rstd * wv.x, f1 * rstd * wv.y), pack2(f2 * rstd * wv.z, f3 * rstd * wv.w));
  }
}

template <int LPR>
DI void wkv_item(const Params& p, char* smem, int seq, int head, int part) {
  constexpr int ROWS = 256 / LPR, KPL = 64 / LPR;
  const int tid = TIDX;
  float* sR = (float*)smem;
  float* sK = sR + 2048;
  float* sKK = sK + 2048;
  float* sBB = sKK + 2048;
  float* sW = sBB + 2048;
  float* sV = sW + 2048;
  float* sO = sV + 2048;
  const bf16_t* R = (const bf16_t*)(p.ws + SC_R);
  const bf16_t* K = (const bf16_t*)(p.ws + SC_K);
  const bf16_t* V = (const bf16_t*)(p.ws + SC_V);
  const bf16_t* AAc = (const bf16_t*)(p.ws + SC_AA);
  const float* WD = (const float*)(p.ws + SC_WD);
  bf16_t* O = (bf16_t*)(p.ws + SC_O);
  const bool prompt = seq < 8;
  const int nch = prompt ? 64 : 1, nvalid = prompt ? 32 : 8;
  const int tbase = prompt ? seq * 2048 : TP_ + (seq - 8) * 8;
  const int row_l = tid / LPR, q = tid % LPR, row = part * ROWS + row_l;
  float S[KPL];
  {
    const float* s0 = p.in[I_ST_RW] + (((size_t)(seq - 8) * 16 + head) * 64 + row) * 64 + q * KPL;
#pragma unroll
    for (int e = 0; e < KPL; ++e) S[e] = prompt ? 0.f : s0[e];
  }
  const int pst = tid >> 3, pk0 = (tid & 7) * 8, pcol = head * 64 + pk0;
  float kk8[8], ka8[8];
  load8f(p.in[I_RW_KK] + pcol, kk8);
  load8f(p.in[I_RW_KA] + pcol, ka8);
  for (int c = 0; c < nch; ++c) {
    const int t0 = tbase + c * 32;
    __syncthreads();
    if (pst < nvalid) {
      const size_t o = (size_t)(t0 + pst) * 1024 + pcol;
      float r8[8], k8[8], v8[8], a8[8], w8[8];
      unpack8(*(const uint4*)(R + o), r8);
      unpack8(*(const uint4*)(K + o), k8);
      unpack8(*(const uint4*)(V + o), v8);
      unpack8(*(const uint4*)(AAc + o), a8);
      load8f(WD + o, w8);
      float kr[8], ss = 0.f;
#pragma unroll
      for (int e = 0; e < 8; ++e) { kr[e] = k8[e] * kk8[e]; ss += kr[e] * kr[e]; }
      ss = red_lanes<8>(ss);
      const float inv = 1.f / fmaxf(sqrtf(ss), 1e-12f);
      float kp[8], bb[8];
#pragma unroll
      for (int e = 0; e < 8; ++e) { kr[e] *= inv; kp[e] = k8[e] * (1.f + (a8[e] - 1.f) * ka8[e]); bb[e] = kr[e] * a8[e]; }
      const int lo = pst * 64 + pk0;
      store8f(sR + lo, r8); store8f(sK + lo, kp); store8f(sKK + lo, kr); store8f(sBB + lo, bb);
      store8f(sW + lo, w8); store8f(sV + lo, v8);
    }
    __syncthreads();
    for (int st = 0; st < nvalid; ++st) {
      const int lo = st * 64 + q * KPL;
      float kk[KPL], ww[KPL], bb[KPL], kp[KPL], rr[KPL];
#pragma unroll
      for (int e = 0; e < KPL; e += 4) {
        const float4 a = *(const float4*)(sKK + lo + e); kk[e] = a.x; kk[e + 1] = a.y; kk[e + 2] = a.z; kk[e + 3] = a.w;
        const float4 b = *(const float4*)(sW + lo + e); ww[e] = b.x; ww[e + 1] = b.y; ww[e + 2] = b.z; ww[e + 3] = b.w;
        const float4 d = *(const float4*)(sBB + lo + e); bb[e] = d.x; bb[e + 1] = d.y; bb[e + 2] = d.z; bb[e + 3] = d.w;
        const float4 f = *(const float4*)(sK + lo + e); kp[e] = f.x; kp[e + 1] = f.y; kp[e + 2] = f.z; kp[e + 3] = f.w;
        const float4 g = *(const float4*)(sR + lo + e); rr[e] = g.x; rr[e + 1] = g.y; rr[e + 2] = g.z; rr[e + 3] = g.w;
      }
      const float vv = sV[st * 64 + row];
      float sa = 0.f;
#pragma unroll
      for (int e = 0; e < KPL; ++e) sa += S[e] * kk[e];
      sa = red_lanes<LPR>(sa);
      float oo = 0.f;
#pragma unroll
      for (int e = 0; e < KPL; ++e) {
        S[e] = S[e] * ww[e] - sa * bb[e] + vv * kp[e];
        oo += S[e] * rr[e];
      }
      oo = red_lanes<LPR>(oo);
      if (q == 0) sO[st * ROWS + row_l] = oo;
    }
    __syncthreads();
    for (int i = tid; i < nvalid * ROWS; i += NTHR) {
      const int st = i / ROWS, rr = i % ROWS;
      O[(size_t)(t0 + st) * 1024 + head * 64 + part * ROWS + rr] = f2bf(sO[i]);
    }
  }
  float* dst = prompt ? (p.out + O_RW_P + (((size_t)seq * 16 + head) * 64 + row) * 64 + q * KPL)
                      : (p.out + O_RW_S + (((size_t)(seq - 8) * 16 + head) * 64 + row) * 64 + q * KPL);
#pragma unroll
  for (int e = 0; e < KPL; ++e) dst[e] = S[e];
}

template <int LPR>
DI void ph_wkv(const Params& p, char* smem) {
  constexpr int NPART = 64 / (256 / LPR);
  const int G = gridDim.x, bid = blockIdx.x;
  const int nP = 128 * NPART, nS = 2048 * NPART;
  for (int it = bid; it < nP + nS; it += G) {
    int seq, head, part;
    if (it < nP) { part = it % NPART; const int sh = it / NPART; seq = sh >> 4; head = sh & 15; }
    else { const int u = it - nP; part = u % NPART; const int sh = u / NPART; seq = 8 + (sh >> 4); head = sh & 15; }
    wkv_item<LPR>(p, smem, seq, head, part);
  }
}

DI void ph_wkv_post(const Params& p) {
  const int tid_ = TIDX; const int lane = tid_ & 63;
  const int gw = blockIdx.x * 4 + (tid_ >> 6), nw = gridDim.x * 4;
  const bf16_t* R = (const bf16_t*)(p.ws + SC_R);
  const bf16_t* K = (const bf16_t*)(p.ws + SC_K);
  const bf16_t* V = (const bf16_t*)(p.ws + SC_V);
  const bf16_t* AAc = (const bf16_t*)(p.ws + SC_AA);
  const bf16_t* Gg = (const bf16_t*)(p.ws + SC_G);
  const bf16_t* O = (const bf16_t*)(p.ws + SC_O);
  bf16_t* U = (bf16_t*)(p.ws + W_U);
  for (int item = gw; item < T_ * 16; item += nw) {
    const int t = item >> 4, head = item & 15, col = head * 64 + lane;
    const size_t o = (size_t)t * 1024 + col;
    const float ov = bf2f(O[o]);
    const float mean = wave_sum(ov) * (1.f / 64.f);
    const float d = ov - mean;
    const float var = wave_sum(d * d) * (1.f / 64.f);
    const float on = d * rsqrtf(var + 64e-5f) * p.in[I_RW_LNW][col] + p.in[I_RW_LNB][col];
    const float r = bf2f(R[o]), k = bf2f(K[o]), a = bf2f(AAc[o]), v = bf2f(V[o]);
    const float kp = k * (1.f + (a - 1.f) * p.in[I_RW_KA][col]);
    const float s = wave_sum(r * kp * p.in[I_RW_RK][col]);
    U[o] = f2bf((on + s * v) * bf2f(Gg[o]));
  }
}

constexpr int NPH = 40;

__global__ void __launch_bounds__(NTHR, 2) mega(Params p) {
  __shared__ __attribute__((aligned(16))) char smem[SMEM_BYTES];
  cg::grid_group grid = cg::this_grid();
  int ph = 0;
#define PH(...)                                                     \
  {                                                                 \
    if (ph >= p.ph_begin && ph < p.ph_end) {                        \
      __VA_ARGS__;                                                  \
      grid.sync();                                                  \
    }                                                               \
    ++ph;                                                           \
  }
#define PH_LAST(...)                                                \
  {                                                                 \
    if (ph >= p.ph_begin && ph < p.ph_end) { __VA_ARGS__; }         \
    ++ph;                                                           \
  }
  bf16_t* wt = (bf16_t*)(p.ws + W_WT);
  bf16_t* U = (bf16_t*)(p.ws + W_U);
  float* X = (float*)(p.ws + W_X);

  PH(ph_prologue(p, smem));

#pragma nounroll
  for (int layer = 0; layer < 4; ++layer) {
    const int kind = layer % 3;
    PH(ph_rmsnorm(p, kind == 2 ? 1 : 0, p.in[I_NMIX] + layer * 1024));
    if (kind == 0) {
      const int ia = layer / 3;
      PH({
        GJob j = mkjob(U, 1024, wt + WA_IN + (size_t)ia * 2048 * 1024, 1024, 1024, 2048);
        j.o0 = p.ws + SA_XB; j.o1 = p.ws + SA_GT;
        int toff = 0; gemm_run<EPI_LRU_IN, false>(j, 16, toff, smem);
      });
      PH((ph_conv<1024, false>((const bf16_t*)(p.ws + SA_XB), (bf16_t*)(p.ws + SA_XC),
                               p.in[I_LRU_CW] + (size_t)ia * 4 * 1024, p.in[I_LRU_CB] + (size_t)ia * 1024,
                               p.in[I_ST_LC] + (size_t)ia * 128 * 3 * 1024,
                               p.out + O_LC_P + (size_t)ia * 8 * 3 * 1024, p.out + O_LC_S + (size_t)ia * 128 * 3 * 1024)));
      PH({
        const int G = gridDim.x;
        for (int tile = blockIdx.x; tile < MT_ * 16; tile += G) {
          const int mt = tile >> 4, jt = tile & 15;
          GJob j = mkjob((const bf16_t*)(p.ws + SA_XC) + (jt >> 1) * 128, 1024,
                         wt + WA_G + (size_t)ia * 2048 * 128, 128, 128, 2048);
          j.o0 = p.ws + SA_AA; j.o1 = p.ws + SA_XC;
          j.x0 = p.in[I_LRU_BR] + ia * 1024; j.x1 = p.in[I_LRU_BI] + ia * 1024; j.x2 = p.in[I_LRU_LAM] + ia * 1024;
          gemm_tile<EPI_GATES, false>(j, mt * 128, jt * 128, smem);
        }
      });
      PH(ph_lru_scan1(p));
      PH(ph_lru_scan2(p, ia));
      PH({
        GJob j = mkjob((const bf16_t*)(p.ws + SA_GT), 1024, wt + WA_OUT + (size_t)ia * 1024 * 1024, 1024, 1024, 1024);
        j.o0 = X;
        int toff = 0; gemm_run<EPI_RESID, false>(j, 8, toff, smem);
      });
    } else if (kind == 1) {
      PH({
        GJob j = mkjob(U, 1024, wt + WB_XBC, 1024, 1024, 4128);
        j.o0 = p.ws + SB_XBCP; j.o1 = p.ws + SB_DT; j.x0 = p.in[I_SSM_DTB];
        int toff = 0; gemm_run<EPI_SSM_XBC, false>(j, 33, toff, smem);
      });
      PH((ph_conv<4096, true>((const bf16_t*)(p.ws + SB_XBCP), (bf16_t*)(p.ws + SB_XBC),
                              p.in[I_SSM_CW], p.in[I_SSM_CB], p.in[I_ST_SC],
                              p.out + O_SC_P, p.out + O_SC_S)));
      PH(ph_ssd(p, smem));
      PH({
        GJob j = mkjob(U, 1024, wt + WB_Z, 1024, 1024, 2048);
        j.o0 = p.ws + SB_Y;
        int toff = 0; gemm_run<EPI_SSM_Z, false>(j, 16, toff, smem);
      });
      PH(ph_gnorm(p));
      PH({
        GJob j = mkjob((const bf16_t*)(p.ws + SB_Y), 2048, wt + WB_OUT, 2048, 2048, 1024);
        j.o0 = X;
        int toff = 0; gemm_run<EPI_RESID, false>(j, 8, toff, smem);
      });
    } else {
      PH({
        int toff = 0;
        for (int s = 0; s < 3; ++s) {
          GJob j = mkjob(U, 1024, wt + WC_RKV + (size_t)s * 1024 * 1024, 1024, 1024, 1024);
          j.A2 = (const bf16_t*)(p.ws + SC_UP); j.mu = p.in[I_RW_MU] + s * 1024;
          j.o0 = p.ws + SC_R + (size_t)s * SZ_TD2; j.ldo = 1024; j.act = 0;
          gemm_run<EPI_ST, true>(j, 8, toff, smem);
        }
        for (int s = 0; s < 3; ++s) {
          const int nv = (s == 2) ? 128 : 64;
          GJob j = mkjob(U, 1024, wt + WC_L1 + (size_t)s * 64 * 1024, 1024, 1024, nv);
          j.A2 = (const bf16_t*)(p.ws + SC_UP); j.mu = p.in[I_RW_MU] + (3 + s) * 1024;
          j.o0 = p.ws + SC_LH + (size_t)s * 64 * 2; j.ldo = 256; j.act = (s == 0) ? 1 : (s == 2 ? 2 : 0);
          gemm_run<EPI_ST, true>(j, 1, toff, smem);
        }
      });
      PH({
        int toff = 0;
        const bf16_t* LH = (const bf16_t*)(p.ws + SC_LH);
        {
          GJob j = mkjob(LH, 256, wt + WC_W2, 64, 64, 1024);
          j.o0 = p.ws + SC_WD; j.x0 = p.in[I_RW_W0];
          gemm_run<EPI_DECAY, false>(j, 8, toff, smem);
        }
        {
          GJob j = mkjob(LH + 64, 256, wt + WC_A2, 64, 64, 1024);
          j.o0 = p.ws + SC_AA; j.x0 = p.in[I_RW_A0];
          gemm_run<EPI_SIGB, false>(j, 8, toff, smem);
        }
        {
          GJob j = mkjob(LH + 128, 256, wt + WC_G2, 128, 128, 1024);
          j.o0 = p.ws + SC_G; j.ldo = 1024; j.act = 0;
          gemm_run<EPI_ST, false>(j, 8, toff, smem);
        }
      });
      PH(ph_wkv<8>(p, smem));
      PH(ph_wkv_post(p));
      PH({
        GJob j = mkjob(U, 1024, wt + WC_OUT, 1024, 1024, 1024);
        j.o0 = X;
        int toff = 0; gemm_run<EPI_RESID, false>(j, 8, toff, smem);
      });
    }
    PH(ph_rmsnorm(p, 0, p.in[I_NFFN] + layer * 1024));
    PH({
      GJob j = mkjob(U, 1024, wt + WF_1 + (size_t)layer * 4096 * 1024, 1024, 1024, 4096);
      j.o0 = p.ws + S_HB;
      int toff = 0; gemm_run<EPI_FFN1, false>(j, 32, toff, smem);
    });
    PH({
      GJob j = mkjob((const bf16_t*)(p.ws + S_HB), 4096, wt + WF_2 + (size_t)layer * 4096 * 1024, 4096, 4096, 1024);
      j.o0 = X;
      int toff = 0; gemm_run<EPI_RESID, false>(j, 8, toff, smem);
    });
  }
  PH_LAST(ph_rmsnorm(p, 2, p.in[I_NFIN]));
#undef PH
#undef PH_LAST
}

extern "C" void kernel_launch(void* const* d_in, const int* in_sizes, int n_in, void* d_out, int out_size,
                              void* d_ws, size_t ws_size, hipStream_t stream) {
  Params p;
  memset(&p, 0, sizeof(p));
  for (int i = 0; i < N_IN; ++i) p.in[i] = (const float*)d_in[i];
  p.out = (float*)d_out;
  p.ws = (char*)d_ws;
  p.ph_begin = 0;
  p.ph_end = 1000;
  static int grid_blocks = 0;
  if (!grid_blocks) {
    int dev = 0, cus = 0, per_cu = 0;
    hipGetDevice(&dev);
    hipDeviceGetAttribute(&cus, hipDeviceAttributeMultiprocessorCount, dev);
    hipOccupancyMaxActiveBlocksPerMultiprocessor(&per_cu, mega, NTHR, 0);
    if (per_cu > 2) per_cu = 2;
    if (per_cu < 1) per_cu = 1;
    grid_blocks = cus * per_cu;
  }
  void* args[] = {&p};
  hipError_t e = hipLaunchCooperativeKernel((void*)mega, dim3(grid_blocks), dim3(NTHR), args, 0, stream);
  if (e != hipSuccess) fprintf(stderr, "cooperative launch failed: %s (grid %d)\n", hipGetErrorString(e), grid_blocks);
}
```

```cpp
#include <hip/hip_runtime.h>
#include <hip/hip_cooperative_groups.h>
#include <stdint.h>
#include <stdio.h>
#include <string.h>
namespace cg = cooperative_groups;

typedef unsigned short bf16_t;
typedef __attribute__((ext_vector_type(8))) short bf16x8;
typedef __attribute__((ext_vector_type(16))) float f32x16;

#define DI __device__ __forceinline__

constexpr int T_ = 17408;
constexpr int TP_ = 16384;
constexpr int NTHR = 256;
constexpr int MT_ = T_ / 128;

enum {
  I_XP = 0, I_XS, I_ST_LC, I_ST_LH, I_ST_SC, I_ST_SS, I_ST_RS, I_ST_RW,
  I_NMIX, I_NFFN, I_NFIN,
  I_LRU_WIN, I_LRU_CW, I_LRU_CB, I_LRU_WR, I_LRU_BR, I_LRU_WI, I_LRU_BI, I_LRU_LAM, I_LRU_WOUT,
  I_SSM_WIN, I_SSM_CW, I_SSM_CB, I_SSM_DTB, I_SSM_ALOG, I_SSM_D, I_SSM_NW, I_SSM_WOUT,
  I_RW_MU, I_RW_WRKV, I_RW_W0, I_RW_WW1, I_RW_WW2, I_RW_A0, I_RW_WA1, I_RW_WA2, I_RW_WG1, I_RW_WG2,
  I_RW_KK, I_RW_KA, I_RW_RK, I_RW_LNW, I_RW_LNB, I_RW_WOUT,
  I_FFN_W1, I_FFN_W2, N_IN
};

constexpr size_t O_Y = 0;
constexpr size_t O_LC_P = O_Y + (size_t)T_ * 1024;
constexpr size_t O_LC_S = O_LC_P + 2 * 8 * 3 * 1024;
constexpr size_t O_LH_P = O_LC_S + 2 * 128 * 3 * 1024;
constexpr size_t O_LH_S = O_LH_P + 2 * 8 * 1024;
constexpr size_t O_SC_P = O_LH_S + 2 * 128 * 1024;
constexpr size_t O_SC_S = O_SC_P + 8 * 3 * 4096;
constexpr size_t O_SS_P = O_SC_S + 128 * 3 * 4096;
constexpr size_t O_SS_S = O_SS_P + (size_t)8 * 32 * 64 * 128;
constexpr size_t O_RS_P = O_SS_S + (size_t)128 * 32 * 64 * 128;
constexpr size_t O_RS_S = O_RS_P + 8 * 1024;
constexpr size_t O_RW_P = O_RS_S + 128 * 1024;
constexpr size_t O_RW_S = O_RW_P + 8 * 16 * 64 * 64;

constexpr size_t W_X = 0;
constexpr size_t W_U = W_X + (size_t)T_ * 1024 * 4;
constexpr size_t W_WT = W_U + (size_t)T_ * 1024 * 2;
constexpr size_t WA_IN = 0;
constexpr size_t WA_G = WA_IN + 2 * 2048 * 1024;
constexpr size_t WA_OUT = WA_G + 2 * 2048 * 128;
constexpr size_t WB_XBC = WA_OUT + 2 * 1024 * 1024;
constexpr size_t WB_Z = WB_XBC + 4128 * 1024;
constexpr size_t WB_OUT = WB_Z + 2048 * 1024;
constexpr size_t WC_RKV = WB_OUT + 1024 * 2048;
constexpr size_t WC_L1 = WC_RKV + 3 * 1024 * 1024;
constexpr size_t WC_W2 = WC_L1 + 256 * 1024;
constexpr size_t WC_A2 = WC_W2 + 1024 * 64;
constexpr size_t WC_G2 = WC_A2 + 1024 * 64;
constexpr size_t WC_OUT = WC_G2 + 1024 * 128;
constexpr size_t WF_1 = WC_OUT + 1024 * 1024;
constexpr size_t WF_2 = WF_1 + (size_t)4 * 4096 * 1024;
constexpr size_t W_WT_ELEMS = WF_2 + (size_t)4 * 4096 * 1024;
constexpr size_t W_S = W_WT + W_WT_ELEMS * 2;
constexpr size_t SZ_TD2 = (size_t)T_ * 1024 * 2;
constexpr size_t SZ_TD4 = (size_t)T_ * 1024 * 4;
constexpr size_t S_HB = W_S;
constexpr size_t SA_XB = W_S;
constexpr size_t SA_GT = SA_XB + SZ_TD2;
constexpr size_t SA_XC = SA_GT + SZ_TD2;
constexpr size_t SA_AA = SA_XC + SZ_TD2;
constexpr size_t SA_BB = SA_AA + SZ_TD4;
constexpr size_t SA_CP = SA_BB + SZ_TD4;
constexpr size_t SA_CS = SA_CP + 8 * 64 * 1024 * 4;
constexpr size_t SB_XBCP = W_S;
constexpr size_t SB_Y = W_S;
constexpr size_t SB_XBC = SB_XBCP + SZ_TD2 * 4;
constexpr size_t SB_DT = SB_XBC + SZ_TD2 * 4;
constexpr size_t SC_UP = W_S;
constexpr size_t SC_O = W_S;
constexpr size_t SC_R = SC_UP + SZ_TD2;
constexpr size_t SC_K = SC_R + SZ_TD2;
constexpr size_t SC_V = SC_K + SZ_TD2;
constexpr size_t SC_LH = SC_V + SZ_TD2;
constexpr size_t SC_WD = SC_LH + (size_t)T_ * 256 * 2;
constexpr size_t SC_AA = SC_WD + SZ_TD4;
constexpr size_t SC_G = SC_AA + SZ_TD2;
constexpr size_t SC_END = SC_G + SZ_TD2;
static_assert(SC_END <= (size_t)536870912, "ws overflow C");
static_assert(SB_DT + (size_t)T_ * 32 * 4 <= (size_t)536870912, "ws overflow B");
static_assert(SA_CS + 8 * 64 * 1024 * 4 <= (size_t)536870912, "ws overflow A");

constexpr int SMEM_BYTES = 80384;
constexpr size_t W_BAR = (size_t)536870912 - 65536;

struct Params {
  const float* in[N_IN];
  float* out;
  char* ws;
  int ph_begin, ph_end;
};

DI float bf2f(bf16_t h) { return __uint_as_float(((unsigned)h) << 16); }
DI bf16_t f2bf(float f) {
  unsigned u = __float_as_uint(f);
  u += 0x7FFFu + ((u >> 16) & 1u);
  return (bf16_t)(u >> 16);
}
DI unsigned pack2(float a, float b) { return (unsigned)f2bf(a) | ((unsigned)f2bf(b) << 16); }
DI void unpack8(const uint4 v, float (&f)[8]) {
  f[0] = __uint_as_float(v.x << 16); f[1] = __uint_as_float(v.x & 0xFFFF0000u);
  f[2] = __uint_as_float(v.y << 16); f[3] = __uint_as_float(v.y & 0xFFFF0000u);
  f[4] = __uint_as_float(v.z << 16); f[5] = __uint_as_float(v.z & 0xFFFF0000u);
  f[6] = __uint_as_float(v.w << 16); f[7] = __uint_as_float(v.w & 0xFFFF0000u);
}
DI uint4 pack8(const float (&f)[8]) {
  return make_uint4(pack2(f[0], f[1]), pack2(f[2], f[3]), pack2(f[4], f[5]), pack2(f[6], f[7]));
}
DI void load8f(const float* p, float (&f)[8]) {
  float4 a = *(const float4*)p, b = *(const float4*)(p + 4);
  f[0] = a.x; f[1] = a.y; f[2] = a.z; f[3] = a.w; f[4] = b.x; f[5] = b.y; f[6] = b.z; f[7] = b.w;
}
DI void store8f(float* p, const float (&f)[8]) {
  *(float4*)p = make_float4(f[0], f[1], f[2], f[3]);
  *(float4*)(p + 4) = make_float4(f[4], f[5], f[6], f[7]);
}
DI float sigmoidf_(float x) { return 1.f / (1.f + __expf(-x)); }
DI float siluf_(float x) { return x / (1.f + __expf(-x)); }
DI float tanhf_(float y) { return 1.f - 2.f / (1.f + __expf(2.f * y)); }
DI float geluf_(float x) { return 0.5f * x * (1.f + tanhf_(0.7978845608028654f * (x + 0.044715f * x * x * x))); }
DI float softplusf_(float x) { return fmaxf(x, 0.f) + log1pf(__expf(-fabsf(x))); }
DI float wave_sum(float v) {
#pragma unroll
  for (int o = 32; o >= 1; o >>= 1) v += __shfl_xor(v, o, 64);
  return v;
}
template <int CTRL> DI float dppf(float x) {
  return __int_as_float(__builtin_amdgcn_update_dpp(0, __float_as_int(x), CTRL, 0xf, 0xf, false));
}
template <int N> DI float red_lanes(float x) {
  x += dppf<0xB1>(x);
  x += dppf<0x4E>(x);
  if (N >= 8) x += dppf<0x141>(x);
  if (N >= 16) x += dppf<0x140>(x);
  return x;
}
DI void tok_info(int t, int& seq, int& l, int& L) {
  if (t < TP_) { seq = t >> 11; l = t & 2047; L = 2048; }
  else { int u = t - TP_; seq = 8 + (u >> 3); l = u & 7; L = 8; }
}
DI int opq(int x) { asm volatile("" : "+v"(x)); return x; }
#define TIDX opq((int)threadIdx.x)
DI f32x16 mfma32(bf16x8 a, bf16x8 b, f32x16 c) { return __builtin_amdgcn_mfma_f32_32x32x16_bf16(a, b, c, 0, 0, 0); }


#define XB_TMO      128
#define XB_XCNT(j)  (256  + 64 * (j))
#define XB_XSUB(j)  (1280 + 64 * (j))
#define XB_XGEN(j)  (2304 + 64 * (j))
#define XB_TOP      3328
#define XB_TOPGEN   3392
#define XCD_BAR_WORDS 3456
#define XB_SPIN_CAP (1u << 22)
#define LAS __attribute__((address_space(3)))
DI unsigned xb_ld(unsigned* p) { return __hip_atomic_load(p, __ATOMIC_RELAXED, __HIP_MEMORY_SCOPE_AGENT); }
DI unsigned xb_add(unsigned* p, unsigned v) { return __hip_atomic_fetch_add(p, v, __ATOMIC_RELAXED, __HIP_MEMORY_SCOPE_AGENT); }
DI unsigned xb_xcc_id() { return (unsigned)__builtin_amdgcn_s_getreg((3 << 11) | 20) & 0xFu; }
#define XB_SPIN(cond, bar) do { unsigned _sp = 0; while (cond) { __builtin_amdgcn_s_sleep(1); \
    if ((++_sp & 255u) == 0u) { if (xb_ld(&(bar)[XB_TMO])) break; if (_sp > XB_SPIN_CAP) { atomicAdd(&(bar)[XB_TMO], 1u); break; } } } } while (0)
struct XcdBarrier { unsigned* bar; unsigned x; volatile LAS unsigned* st; };
DI XcdBarrier xcd_barrier_post(unsigned* bar, volatile LAS unsigned* st) {
  XcdBarrier b; b.bar = bar; b.x = xb_xcc_id(); b.st = st;
  if (threadIdx.x == 0) (void)xb_add(&bar[XB_XCNT(b.x)], 1u);
  return b;
}
DI void xcd_barrier_complete(unsigned* bar, unsigned x, unsigned& nloc, unsigned& nx) {
  const unsigned G = gridDim.x * gridDim.y * gridDim.z;
  unsigned sum, cnt, mine, sp = 0u;
  for (;;) {
    sum = 0u; cnt = 0u; mine = 0u;
#pragma unroll
    for (unsigned j = 0; j < 16; ++j) { const unsigned c = xb_ld(&bar[XB_XCNT(j)]); sum += c; cnt += (c > 0u) ? 1u : 0u; mine = (j == x) ? c : mine; }
    if (sum == G) break;
    __builtin_amdgcn_s_sleep(1);
    if ((++sp & 255u) == 0u) { if (xb_ld(&bar[XB_TMO])) break; if (sp > XB_SPIN_CAP) { atomicAdd(&bar[XB_TMO], 1u); break; } }
  }
  nloc = mine > 0u ? mine : 1u; nx = cnt > 0u ? cnt : 1u;
}
DI void xcd_barrier(const XcdBarrier& b) {
  asm volatile("s_waitcnt vmcnt(0)" ::: "memory");
  __syncthreads();
  if (threadIdx.x == 0) {
    unsigned* bar = b.bar;
    __builtin_amdgcn_s_waitcnt(0);
    unsigned nloc = b.st[0], nx = b.st[1];
    if (nloc == 0u) { xcd_barrier_complete(bar, b.x, nloc, nx); b.st[0] = nloc; b.st[1] = nx; }
    const unsigned old = xb_add(&bar[XB_XSUB(b.x)], 1u);
    const unsigned gen = old / nloc;
    if (old + 1u == (gen + 1u) * nloc) {
      __builtin_amdgcn_fence(__ATOMIC_RELEASE, "agent");
      asm volatile("s_waitcnt vmcnt(0)" ::: "memory");
      const unsigned og = xb_add(&bar[XB_TOP], 1u);
      const unsigned tg = og / nx;
      if (og + 1u == (tg + 1u) * nx) xb_add(&bar[XB_TOPGEN], 1u);
      else XB_SPIN(xb_ld(&bar[XB_TOPGEN]) == tg, bar);
      __builtin_amdgcn_fence(__ATOMIC_ACQUIRE, "agent");
      xb_add(&bar[XB_XGEN(b.x)], 1u);
      asm volatile("s_waitcnt vmcnt(0)" ::: "memory");
    } else {
      XB_SPIN(xb_ld(&bar[XB_XGEN(b.x)]) == gen, bar);
      __builtin_amdgcn_fence(__ATOMIC_ACQUIRE, "agent");
      asm volatile("s_waitcnt vmcnt(0)" ::: "memory");
    }
  }
  __syncthreads();
}

struct GJob {
  const bf16_t* A; const bf16_t* A2; const float* mu; const bf16_t* Bt;
  int lda, ldb, K, nvalid;
  void* o0; void* o1; const float* x0; const float* x1; const float* x2;
  int ldo, act;
};
enum { EPI_LRU_IN = 0, EPI_GATES, EPI_RESID, EPI_SSM_XBC, EPI_SSM_Z, EPI_FFN1, EPI_ST, EPI_DECAY, EPI_SIGB };

template <int EPI> DI void epi_elem(const GJob& j, int row, int col, float v) {
  if (EPI == EPI_LRU_IN) {
    if (col < 1024) ((bf16_t*)j.o0)[(size_t)row * 1024 + col] = f2bf(v);
    else ((bf16_t*)j.o1)[(size_t)row * 1024 + col - 1024] = f2bf(geluf_(v));
  } else if (EPI == EPI_RESID) {
    float* x = (float*)j.o0 + (size_t)row * 1024 + col;
    *x = *x + v;
  } else if (EPI == EPI_SSM_XBC) {
    if (col < 4096) ((bf16_t*)j.o0)[(size_t)row * 4096 + col] = f2bf(v);
    else if (col < 4128) ((float*)j.o1)[(size_t)row * 32 + col - 4096] = softplusf_(v + j.x0[col - 4096]);
  } else if (EPI == EPI_SSM_Z) {
    bf16_t* y = (bf16_t*)j.o0 + (size_t)row * 2048 + col;
    *y = f2bf(bf2f(*y) * siluf_(v));
  } else if (EPI == EPI_FFN1) {
    float r = fmaxf(v, 0.f);
    ((bf16_t*)j.o0)[(size_t)row * 4096 + col] = f2bf(r * r);
  } else if (EPI == EPI_ST) {
    if (col < j.nvalid) {
      float r = v;
      if (j.act == 1) r = tanhf_(v); else if (j.act == 2) r = sigmoidf_(v);
      ((bf16_t*)j.o0)[(size_t)row * j.ldo + col] = f2bf(r);
    }
  } else if (EPI == EPI_DECAY) {
    float wl = -softplusf_(-(j.x0[col] + v)) - 0.5f;
    ((float*)j.o0)[(size_t)row * 1024 + col] = __expf(-__expf(wl));
  } else if (EPI == EPI_SIGB) {
    ((bf16_t*)j.o0)[(size_t)row * 1024 + col] = f2bf(sigmoidf_(j.x0[col] + v));
  }
}

template <int EPI, bool MIX>
DI void gemm_tile(const GJob& j, int m0, int n0, char* smem) {
  const int tid = TIDX, lane = tid & 63, w = tid >> 6;
  const int wm = w >> 1, wn = w & 1, r32 = lane & 31, hh = lane >> 5;
  const int lrow = tid >> 3, kc = tid & 7;
  f32x16 acc[2][2];
#pragma unroll
  for (int a = 0; a < 2; ++a)
#pragma unroll
    for (int b = 0; b < 2; ++b)
#pragma unroll
      for (int r = 0; r < 16; ++r) acc[a][b][r] = 0.f;
  uint4 ra[4], rb[4], ra2[4];
  const int nk = j.K >> 6;
  const bf16_t* Ap = j.A + (size_t)(m0 + lrow) * j.lda + kc * 8;
  const bf16_t* A2p = MIX ? (j.A2 + (size_t)(m0 + lrow) * j.lda + kc * 8) : nullptr;
  const bf16_t* Bp = j.Bt + (size_t)(n0 + lrow) * j.ldb + kc * 8;
  const size_t astep = (size_t)32 * j.lda, bstep = (size_t)32 * j.ldb;

#define GLOAD(kt)                                                                     \
  {                                                                                   \
    _Pragma("unroll") for (int i = 0; i < 4; ++i) {                                   \
      ra[i] = *(const uint4*)(Ap + i * astep + (kt) * 64);                            \
      if (MIX) ra2[i] = *(const uint4*)(A2p + i * astep + (kt) * 64);                 \
      if (n0 + lrow + 32 * i < j.nvalid) rb[i] = *(const uint4*)(Bp + i * bstep + (kt) * 64); \
      else rb[i] = make_uint4(0, 0, 0, 0);                                            \
    }                                                                                 \
  }
#define SSTORE(kt, buf)                                                               \
  {                                                                                   \
    char* As_ = smem + (buf) * 36864; char* Bs_ = As_ + 18432;                        \
    if (MIX) {                                                                        \
      float mu8[8]; load8f(j.mu + (kt) * 64 + kc * 8, mu8);                           \
      _Pragma("unroll") for (int i = 0; i < 4; ++i) {                                 \
        float f1[8], f2[8]; unpack8(ra[i], f1); unpack8(ra2[i], f2);                  \
        _Pragma("unroll") for (int e = 0; e < 8; ++e) f1[e] = f1[e] + (f2[e] - f1[e]) * mu8[e]; \
        ra[i] = pack8(f1);                                                            \
      }                                                                               \
    }                                                                                 \
    _Pragma("unroll") for (int i = 0; i < 4; ++i) {                                   \
      *(uint4*)(As_ + (lrow + 32 * i) * 144 + kc * 16) = ra[i];                       \
      *(uint4*)(Bs_ + (lrow + 32 * i) * 144 + kc * 16) = rb[i];                       \
    }                                                                                 \
  }

  GLOAD(0);
  SSTORE(0, 0);
  __syncthreads();
  for (int kt = 0; kt < nk; ++kt) {
    const bool more = (kt + 1 < nk);
    if (more) GLOAD(kt + 1);
    {
      const char* As_ = smem + (kt & 1) * 36864; const char* Bs_ = As_ + 18432;
      const char* ap = As_ + (wm * 64 + r32) * 144 + hh * 16;
      const char* bp = Bs_ + (wn * 64 + r32) * 144 + hh * 16;
#pragma unroll
      for (int ks = 0; ks < 4; ++ks) {
        bf16x8 a0 = *(const bf16x8*)(ap + ks * 32);
        bf16x8 a1 = *(const bf16x8*)(ap + 32 * 144 + ks * 32);
        bf16x8 b0 = *(const bf16x8*)(bp + ks * 32);
        bf16x8 b1 = *(const bf16x8*)(bp + 32 * 144 + ks * 32);
        acc[0][0] = mfma32(a0, b0, acc[0][0]);
        acc[0][1] = mfma32(a0, b1, acc[0][1]);
        acc[1][0] = mfma32(a1, b0, acc[1][0]);
        acc[1][1] = mfma32(a1, b1, acc[1][1]);
      }
    }
    if (more) SSTORE(kt + 1, (kt + 1) & 1);
    __syncthreads();
  }
#undef GLOAD
#undef SSTORE

  if (EPI == EPI_GATES) {
    const int ch = (n0 >> 7) * 64 + wn * 32 + r32;
    const float br = j.x0[ch], bi = j.x1[ch];
    const float spl = softplusf_(-j.x2[ch]);
    const bf16_t* XC = (const bf16_t*)j.o1;
    float* AA = (float*)j.o0;
    float* BBp = AA + (size_t)T_ * 1024;
#pragma unroll
    for (int mi = 0; mi < 2; ++mi)
#pragma unroll
      for (int r = 0; r < 16; ++r) {
        const int row = m0 + wm * 64 + mi * 32 + (r & 3) + 8 * (r >> 2) + 4 * hh;
        const float rg = sigmoidf_(acc[mi][0][r] + br);
        const float ig = sigmoidf_(acc[mi][1][r] + bi);
        const float la = -8.f * rg * spl;
        const float xc = bf2f(XC[(size_t)row * 1024 + ch]);
        const bool reset = (row < TP_) && ((row & 2047) == 0);
        const float a = reset ? 0.f : __expf(la);
        const float mult = reset ? 1.f : sqrtf(fmaxf(-expm1f(2.f * la), 0.f));
        AA[(size_t)row * 1024 + ch] = a;
        BBp[(size_t)row * 1024 + ch] = mult * ig * xc;
      }
  } else {
#pragma unroll
    for (int mi = 0; mi < 2; ++mi)
#pragma unroll
      for (int ni = 0; ni < 2; ++ni)
#pragma unroll
        for (int r = 0; r < 16; ++r) {
          const int row = m0 + wm * 64 + mi * 32 + (r & 3) + 8 * (r >> 2) + 4 * hh;
          const int col = n0 + wn * 64 + ni * 32 + r32;
          epi_elem<EPI>(j, row, col, acc[mi][ni][r]);
        }
  }
}

template <int EPI, bool MIX>
DI void gemm_run(const GJob& j, int ntn, int& toff, char* smem) {
  const int G = gridDim.x;
  const int ntiles = MT_ * ntn;
  const int start = (int)(((int)blockIdx.x - (toff % G) + G) % G);
  for (int tile = start; tile < ntiles; tile += G) {
    const int mt = tile / ntn, nt = tile - mt * ntn;
    gemm_tile<EPI, MIX>(j, mt * 128, nt * 128, smem);
  }
  toff += ntiles;
}

DI GJob mkjob(const bf16_t* A, int lda, const bf16_t* Bt, int ldb, int K, int nvalid) {
  GJob j;
  j.A = A; j.A2 = nullptr; j.mu = nullptr; j.Bt = Bt; j.lda = lda; j.ldb = ldb; j.K = K; j.nvalid = nvalid;
  j.o0 = nullptr; j.o1 = nullptr; j.x0 = nullptr; j.x1 = nullptr; j.x2 = nullptr; j.ldo = 0; j.act = 0;
  return j;
}

struct TJob { const float* src; bf16_t* dst; int K, N, src_ld, kind, n_off; };

DI TJob get_tjob(const Params& p, int j) {
  bf16_t* wt = (bf16_t*)(p.ws + W_WT);
  TJob o; o.kind = 0; o.n_off = 0;
  if (j < 36) {
    const int ia = j / 18, r = j % 18;
    if (r == 0) { o.src = p.in[I_LRU_WIN] + (size_t)ia * 1024 * 2048; o.dst = wt + WA_IN + (size_t)ia * 2048 * 1024; o.K = 1024; o.N = 2048; o.src_ld = 2048; }
    else if (r == 1) { o.src = p.in[I_LRU_WOUT] + (size_t)ia * 1024 * 1024; o.dst = wt + WA_OUT + (size_t)ia * 1024 * 1024; o.K = 1024; o.N = 1024; o.src_ld = 1024; }
    else {
      const int isI = (r >= 10) ? 1 : 0; const int h = (r - 2) & 7;
      o.src = p.in[isI ? I_LRU_WI : I_LRU_WR] + ((size_t)ia * 8 + h) * 128 * 128;
      o.dst = wt + WA_G + (size_t)ia * 2048 * 128; o.K = 128; o.N = 128; o.src_ld = 128; o.kind = 1 + isI; o.n_off = h * 128;
    }
  } else if (j == 36) { o.src = p.in[I_SSM_WIN] + 2048; o.dst = wt + WB_XBC; o.K = 1024; o.N = 4128; o.src_ld = 6176; }
  else if (j == 37) { o.src = p.in[I_SSM_WIN]; o.dst = wt + WB_Z; o.K = 1024; o.N = 2048; o.src_ld = 6176; }
  else if (j == 38) { o.src = p.in[I_SSM_WOUT]; o.dst = wt + WB_OUT; o.K = 2048; o.N = 1024; o.src_ld = 1024; }
  else if (j < 42) { const int s = j - 39; o.src = p.in[I_RW_WRKV] + (size_t)s * 1024 * 1024; o.dst = wt + WC_RKV + (size_t)s * 1024 * 1024; o.K = 1024; o.N = 1024; o.src_ld = 1024; }
  else if (j == 42) { o.src = p.in[I_RW_WW1]; o.dst = wt + WC_L1; o.K = 1024; o.N = 64; o.src_ld = 64; }
  else if (j == 43) { o.src = p.in[I_RW_WA1]; o.dst = wt + WC_L1 + 64 * 1024; o.K = 1024; o.N = 64; o.src_ld = 64; }
  else if (j == 44) { o.src = p.in[I_RW_WG1]; o.dst = wt + WC_L1 + 128 * 1024; o.K = 1024; o.N = 128; o.src_ld = 128; }
  else if (j == 45) { o.src = p.in[I_RW_WW2]; o.dst = wt + WC_W2; o.K = 64; o.N = 1024; o.src_ld = 1024; }
  else if (j == 46) { o.src = p.in[I_RW_WA2]; o.dst = wt + WC_A2; o.K = 64; o.N = 1024; o.src_ld = 1024; }
  else if (j == 47) { o.src = p.in[I_RW_WG2]; o.dst = wt + WC_G2; o.K = 128; o.N = 1024; o.src_ld = 1024; }
  else if (j == 48) { o.src = p.in[I_RW_WOUT]; o.dst = wt + WC_OUT; o.K = 1024; o.N = 1024; o.src_ld = 1024; }
  else {
    const int l = (j - 49) >> 1, which = (j - 49) & 1;
    if (!which) { o.src = p.in[I_FFN_W1] + (size_t)l * 1024 * 4096; o.dst = wt + WF_1 + (size_t)l * 4096 * 1024; o.K = 1024; o.N = 4096; o.src_ld = 4096; }
    else { o.src = p.in[I_FFN_W2] + (size_t)l * 4096 * 1024; o.dst = wt + WF_2 + (size_t)l * 4096 * 1024; o.K = 4096; o.N = 1024; o.src_ld = 1024; }
  }
  return o;
}
constexpr int N_TJOBS = 57;

DI void ph_prologue(const Params& p, char* smem) {
  const int tid = TIDX, G = gridDim.x;
  {
    const float4* xp = (const float4*)p.in[I_XP];
    const float4* xs = (const float4*)p.in[I_XS];
    float4* X = (float4*)(p.ws + W_X);
    const size_t np = (size_t)TP_ * 256, nt = (size_t)T_ * 256;
    for (size_t i = (size_t)blockIdx.x * NTHR + tid; i < nt; i += (size_t)G * NTHR)
      X[i] = (i < np) ? xp[i] : xs[i - np];
  }
  float* tile = (float*)smem;
  int toff = 0;
  for (int jn = 0; jn < N_TJOBS; ++jn) {
    const TJob tj = get_tjob(p, jn);
    const int nkt = tj.K >> 6, nnt = (tj.N + 63) >> 6;
    const int ntiles = nkt * nnt;
    const int start = (((int)blockIdx.x - (toff % G)) + G) % G;
    for (int t = start; t < ntiles; t += G) {
      const int kt = t / nnt, nt = t - kt * nnt;
      const int k0 = kt * 64, n0 = nt * 64;
      __syncthreads();
#pragma unroll 4
      for (int i = 0; i < 16; ++i) {
        const int k = i * 4 + (tid >> 6), n = tid & 63;
        float v = 0.f;
        if (n0 + n < tj.N) v = tj.src[(size_t)(k0 + k) * tj.src_ld + n0 + n];
        tile[k * 65 + n] = v;
      }
      __syncthreads();
      const int n = tid >> 2, kq = tid & 3;
      if (n0 + n < tj.N) {
        int nrow = n0 + n;
        if (tj.kind) {
          const int ch = tj.n_off + n0 + n;
          nrow = (ch >> 6) * 128 + ((ch >> 5) & 1) * 64 + (tj.kind - 1) * 32 + (ch & 31);
        }
        float f[8], g[8];
#pragma unroll
        for (int e = 0; e < 8; ++e) { f[e] = tile[(kq * 16 + e) * 65 + n]; g[e] = tile[(kq * 16 + 8 + e) * 65 + n]; }
        uint4* d = (uint4*)(tj.dst + (size_t)nrow * tj.K + k0 + kq * 16);
        d[0] = pack8(f); d[1] = pack8(g);
      }
    }
    toff += ntiles;
  }
}

DI void ph_rmsnorm(const Params& p, int mode, const float* w) {
  const int tid_ = TIDX; const int lane = tid_ & 63;
  const int gw = blockIdx.x * 4 + (tid_ >> 6), nw = gridDim.x * 4;
  const float* X = (const float*)(p.ws + W_X);
  bf16_t* U = (bf16_t*)(p.ws + W_U);
  bf16_t* UP = (bf16_t*)(p.ws + SC_UP);
  float4 wv[4];
#pragma unroll
  for (int i = 0; i < 4; ++i) wv[i] = ((const float4*)w)[lane + 64 * i];
  for (int row = gw; row < T_; row += nw) {
    const float4* xr = (const float4*)(X + (size_t)row * 1024);
    float4 v[4]; float ss = 0.f;
#pragma unroll
    for (int i = 0; i < 4; ++i) { v[i] = xr[lane + 64 * i]; ss += v[i].x * v[i].x + v[i].y * v[i].y + v[i].z * v[i].z + v[i].w * v[i].w; }
    ss = wave_sum(ss);
    const float rstd = rsqrtf(ss * (1.f / 1024.f) + 1e-6f);
    int seq, l, L; tok_info(row, seq, l, L);
#pragma unroll
    for (int i = 0; i < 4; ++i) {
      const int c = 4 * (lane + 64 * i);
      float4 y = make_float4(v[i].x * rstd * wv[i].x, v[i].y * rstd * wv[i].y, v[i].z * rstd * wv[i].z, v[i].w * rstd * wv[i].w);
      if (mode == 2) {
        *(float4*)(p.out + O_Y + (size_t)row * 1024 + c) = y;
      } else {
        uint2 pk = make_uint2(pack2(y.x, y.y), pack2(y.z, y.w));
        *(uint2*)(U + (size_t)row * 1024 + c) = pk;
        if (mode == 1) {
          if (l + 1 < L) *(uint2*)(UP + (size_t)(row + 1) * 1024 + c) = pk;
          if (l == 0) {
            uint2 pz = make_uint2(0, 0);
            if (seq >= 8) { float4 s = *(const float4*)(p.in[I_ST_RS] + (size_t)(seq - 8) * 1024 + c); pz = make_uint2(pack2(s.x, s.y), pack2(s.z, s.w)); }
            *(uint2*)(UP + (size_t)row * 1024 + c) = pz;
          }
          if (l == L - 1) {
            float* o = (seq < 8) ? (p.out + O_RS_P + (size_t)seq * 1024 + c) : (p.out + O_RS_S + (size_t)(seq - 8) * 1024 + c);
            *(float4*)o = y;
          }
        }
      }
    }
  }
}

template <int C, bool SILU>
DI void ph_conv(const bf16_t* src, bf16_t* dst, const float* cw, const float* cb, const float* state,
                float* out_p, float* out_s) {
  constexpr int GR = C / 8;
  const size_t total = (size_t)T_ * GR;
  for (size_t idx = (size_t)blockIdx.x * NTHR + TIDX; idx < total; idx += (size_t)gridDim.x * NTHR) {
    const int t = (int)(idx / GR), c = (int)(idx % GR) * 8;
    int seq, l, L; tok_info(t, seq, l, L);
    float acc[8]; load8f(cb + c, acc);
    float xcur[8];
#pragma unroll
    for (int jj = 0; jj < 4; ++jj) {
      const int ls = l - 3 + jj;
      float xv[8];
      if (ls >= 0) { unpack8(*(const uint4*)(src + (size_t)(t - 3 + jj) * C + c), xv); }
      else if (seq >= 8) { load8f(state + ((size_t)(seq - 8) * 3 + (ls + 3)) * C + c, xv); }
      else {
#pragma unroll
        for (int e = 0; e < 8; ++e) xv[e] = 0.f;
      }
      float w8[8]; load8f(cw + (size_t)jj * C + c, w8);
#pragma unroll
      for (int e = 0; e < 8; ++e) acc[e] += w8[e] * xv[e];
      if (jj == 3) {
#pragma unroll
        for (int e = 0; e < 8; ++e) xcur[e] = xv[e];
      }
    }
    if (SILU) {
#pragma unroll
      for (int e = 0; e < 8; ++e) acc[e] = siluf_(acc[e]);
    }
    *(uint4*)(dst + (size_t)t * C + c) = pack8(acc);
    if (l >= L - 3) {
      const int r = l - (L - 3);
      float* o = (seq < 8) ? (out_p + ((size_t)seq * 3 + r) * C + c) : (out_s + ((size_t)(seq - 8) * 3 + r) * C + c);
      store8f(o, xcur);
    }
  }
}

DI void ph_lru_scan1(const Params& p) {
  const float* AA = (const float*)(p.ws + SA_AA);
  const float* BB = (const float*)(p.ws + SA_BB);
  float* CP = (float*)(p.ws + SA_CP);
  float* CS = (float*)(p.ws + SA_CS);
  const int total = 8 * 64 * 1024;
  for (int idx = blockIdx.x * NTHR + TIDX; idx < total; idx += gridDim.x * NTHR) {
    const int ch = idx & 1023, c = (idx >> 10) & 63, b = idx >> 16;
    const size_t base = ((size_t)b * 2048 + c * 32) * 1024 + ch;
    float P = 1.f, S = 0.f;
#pragma unroll 8
    for (int s = 0; s < 32; ++s) {
      const float a = AA[base + (size_t)s * 1024], bb = BB[base + (size_t)s * 1024];
      S = a * S + bb; P *= a;
    }
    CP[idx] = P; CS[idx] = S;
  }
}
DI void ph_lru_scan2(const Params& p, int ia) {
  const float* AA = (const float*)(p.ws + SA_AA);
  const float* BB = (const float*)(p.ws + SA_BB);
  const float* CP = (const float*)(p.ws + SA_CP);
  const float* CS = (const float*)(p.ws + SA_CS);
  bf16_t* GT = (bf16_t*)(p.ws + SA_GT);
  const int nP = 8 * 64 * 1024, total = nP + 128 * 1024;
  for (int idx = blockIdx.x * NTHR + TIDX; idx < total; idx += gridDim.x * NTHR) {
    if (idx < nP) {
      const int ch = idx & 1023, c = (idx >> 10) & 63, b = idx >> 16;
      float h = 0.f;
      for (int c2 = 0; c2 < c; ++c2) {
        const int ci = ((b * 64 + c2) << 10) + ch;
        h = CP[ci] * h + CS[ci];
      }
      const size_t base = ((size_t)b * 2048 + c * 32) * 1024 + ch;
#pragma unroll 8
      for (int s = 0; s < 32; ++s) {
        const size_t o = base + (size_t)s * 1024;
        h = AA[o] * h + BB[o];
        GT[o] = f2bf(h * bf2f(GT[o]));
      }
      if (c == 63) p.out[O_LH_P + ((size_t)ia * 8 + b) * 1024 + ch] = h;
    } else {
      const int u = idx - nP; const int ch = u & 1023, s = u >> 10;
      float h = p.in[I_ST_LH][((size_t)ia * 128 + s) * 1024 + ch];
      const size_t base = ((size_t)TP_ + s * 8) * 1024 + ch;
#pragma unroll
      for (int q = 0; q < 8; ++q) {
        const size_t o = base + (size_t)q * 1024;
        h = AA[o] * h + BB[o];
        GT[o] = f2bf(h * bf2f(GT[o]));
      }
      p.out[O_LH_S + ((size_t)ia * 128 + s) * 1024 + ch] = h;
    }
  }
}

DI void ssd_item(const Params& p, char* smem, int seq, int h) {
  const int tid = TIDX, lane = tid & 63, w = tid >> 6, r32 = lane & 31, hh = lane >> 5;
  bf16_t* Cs = (bf16_t*)smem;
  bf16_t* Bs = Cs + 64 * 136;
  bf16_t* Sb = Bs + 64 * 136;
  bf16_t* Xt = Sb + 64 * 136;
  bf16_t* Btr = Xt + 64 * 72;
  float* dts = (float*)(Btr + 128 * 72);
  float* acs = dts + 64;
  bf16_t* Ws = Bs;
  const bf16_t* XBC = (const bf16_t*)(p.ws + SB_XBC);
  const float* DT = (const float*)(p.ws + SB_DT);
  bf16_t* Y = (bf16_t*)(p.ws + SB_Y);
  const bool prompt = seq < 8;
  const int nchunk = prompt ? 32 : 1, Lv = prompt ? 64 : 8;
  const int tbase = prompt ? seq * 2048 : TP_ + (seq - 8) * 8;
  const int g = h >> 2;
  const float Ah = -__expf(p.in[I_SSM_ALOG][h]);
  const float Dh = p.in[I_SSM_D][h];
  f32x16 accS[2];
  {
    const float* s0 = p.in[I_ST_SS] + ((size_t)(seq - 8) * 32 + h) * 64 * 128;
#pragma unroll
    for (int mi = 0; mi < 2; ++mi)
#pragma unroll
      for (int r = 0; r < 16; ++r) {
        const int prow = mi * 32 + (r & 3) + 8 * (r >> 2) + 4 * hh, n = 32 * w + r32;
        accS[mi][r] = prompt ? 0.f : s0[(size_t)prow * 128 + n];
      }
  }
  __syncthreads();
#pragma unroll
  for (int mi = 0; mi < 2; ++mi)
#pragma unroll
    for (int r = 0; r < 16; ++r) {
      const int prow = mi * 32 + (r & 3) + 8 * (r >> 2) + 4 * hh, n = 32 * w + r32;
      Sb[prow * 136 + n] = f2bf(accS[mi][r]);
    }
  for (int c = 0; c < nchunk; ++c) {
    const int t0 = tbase + c * 64;
    __syncthreads();
    if (tid < 64) {
      const float dtv = (tid < Lv) ? DT[(size_t)(t0 + tid) * 32 + h] : 0.f;
      float x = dtv * Ah;
#pragma unroll
      for (int o = 1; o < 64; o <<= 1) { const float y = __shfl_up(x, o, 64); if (lane >= o) x += y; }
      dts[tid] = dtv; acs[tid] = x;
    }
    __syncthreads();
    const float aend = acs[63];
#pragma unroll
    for (int i = 0; i < 4; ++i) {
      const int id = tid + 256 * i, row = id >> 4, ch = id & 15;
      uint4 cv = make_uint4(0, 0, 0, 0), bv = make_uint4(0, 0, 0, 0);
      if (row < Lv) {
        const bf16_t* src = XBC + (size_t)(t0 + row) * 4096 + g * 128 + ch * 8;
        bv = *(const uint4*)(src + 2048);
        cv = *(const uint4*)(src + 3072);
      }
      *(uint4*)(Cs + row * 136 + ch * 8) = cv;
      *(uint4*)(Bs + row * 136 + ch * 8) = bv;
      float f[8]; unpack8(bv, f);
      const float sc = __expf(aend - acs[row]);
#pragma unroll
      for (int e = 0; e < 8; ++e) Btr[(ch * 8 + e) * 72 + row] = f2bf(f[e] * sc);
    }
#pragma unroll
    for (int i = 0; i < 2; ++i) {
      const int id = tid + 256 * i, row = id >> 3, ch = id & 7;
      uint4 xv = make_uint4(0, 0, 0, 0);
      if (row < Lv) xv = *(const uint4*)(XBC + (size_t)(t0 + row) * 4096 + h * 64 + ch * 8);
      float f[8]; unpack8(xv, f);
      const float sc = dts[row];
#pragma unroll
      for (int e = 0; e < 8; ++e) Xt[(ch * 8 + e) * 72 + row] = f2bf(f[e] * sc);
    }
    __syncthreads();
    const int it = w >> 1, jt = w & 1;
    f32x16 cb;
#pragma unroll
    for (int r = 0; r < 16; ++r) cb[r] = 0.f;
    if (jt <= it) {
#pragma unroll
      for (int ks = 0; ks < 8; ++ks) {
        bf16x8 a = *(const bf16x8*)(Cs + (it * 32 + r32) * 136 + ks * 16 + hh * 8);
        bf16x8 b = *(const bf16x8*)(Bs + (jt * 32 + r32) * 136 + ks * 16 + hh * 8);
        cb = mfma32(a, b, cb);
      }
    }
    __syncthreads();
    {
      const int jj = jt * 32 + r32; const float aj = acs[jj];
#pragma unroll
      for (int r = 0; r < 16; ++r) {
        const int ii = it * 32 + (r & 3) + 8 * (r >> 2) + 4 * hh;
        const float v = (jj <= ii) ? cb[r] * __expf(acs[ii] - aj) : 0.f;
        Ws[ii * 72 + jj] = f2bf(v);
      }
    }
    __syncthreads();
    {
      const int pt = w & 1;
      f32x16 yd, yo;
#pragma unroll
      for (int r = 0; r < 16; ++r) { yd[r] = 0.f; yo[r] = 0.f; }
#pragma unroll
      for (int ks = 0; ks < 4; ++ks) {
        bf16x8 a = *(const bf16x8*)(Ws + (it * 32 + r32) * 72 + ks * 16 + hh * 8);
        bf16x8 b = *(const bf16x8*)(Xt + (pt * 32 + r32) * 72 + ks * 16 + hh * 8);
        yd = mfma32(a, b, yd);
      }
#pragma unroll
      for (int ks = 0; ks < 8; ++ks) {
        bf16x8 a = *(const bf16x8*)(Cs + (it * 32 + r32) * 136 + ks * 16 + hh * 8);
        bf16x8 b = *(const bf16x8*)(Sb + (pt * 32 + r32) * 136 + ks * 16 + hh * 8);
        yo = mfma32(a, b, yo);
      }
      const int pp = pt * 32 + r32;
#pragma unroll
      for (int r = 0; r < 16; ++r) {
        const int ii = it * 32 + (r & 3) + 8 * (r >> 2) + 4 * hh;
        if (ii < Lv) {
          const size_t t = (size_t)(t0 + ii);
          const float xv = bf2f(XBC[t * 4096 + h * 64 + pp]);
          const float yv = yd[r] + __expf(acs[ii]) * yo[r] + Dh * xv;
          Y[t * 2048 + h * 64 + pp] = f2bf(yv);
        }
      }
    }
    {
      const float dec = __expf(aend);
#pragma unroll
      for (int mi = 0; mi < 2; ++mi)
#pragma unroll
        for (int r = 0; r < 16; ++r) accS[mi][r] *= dec;
#pragma unroll
      for (int ks = 0; ks < 4; ++ks) {
        bf16x8 b = *(const bf16x8*)(Btr + (32 * w + r32) * 72 + ks * 16 + hh * 8);
        bf16x8 a0 = *(const bf16x8*)(Xt + (r32) * 72 + ks * 16 + hh * 8);
        bf16x8 a1 = *(const bf16x8*)(Xt + (32 + r32) * 72 + ks * 16 + hh * 8);
        accS[0] = mfma32(a0, b, accS[0]);
        accS[1] = mfma32(a1, b, accS[1]);
      }
    }
    __syncthreads();
#pragma unroll
    for (int mi = 0; mi < 2; ++mi)
#pragma unroll
      for (int r = 0; r < 16; ++r) {
        const int prow = mi * 32 + (r & 3) + 8 * (r >> 2) + 4 * hh, n = 32 * w + r32;
        Sb[prow * 136 + n] = f2bf(accS[mi][r]);
      }
  }
  float* dst = prompt ? (p.out + O_SS_P + ((size_t)seq * 32 + h) * 64 * 128)
                      : (p.out + O_SS_S + ((size_t)(seq - 8) * 32 + h) * 64 * 128);
#pragma unroll
  for (int mi = 0; mi < 2; ++mi)
#pragma unroll
    for (int r = 0; r < 16; ++r) {
      const int prow = mi * 32 + (r & 3) + 8 * (r >> 2) + 4 * hh, n = 32 * w + r32;
      dst[(size_t)prow * 128 + n] = accS[mi][r];
    }
}

DI void ph_ssd(const Params& p, char* smem) {
  const int G = gridDim.x, bid = blockIdx.x;
  int it = bid, step = G;
  if (G >= 512) { if (bid < 256) { step = 1 << 30; } else { step = G - 256; } }
#pragma nounroll
  for (; it < 256 + 4096; it += step) {
    const int seq = (it < 256) ? (it >> 5) : (8 + ((it - 256) >> 5));
    ssd_item(p, smem, seq, it & 31);
  }
}

DI void ph_gnorm(const Params& p) {
  const int tid_ = TIDX; const int lane = tid_ & 63;
  const int gw = blockIdx.x * 4 + (tid_ >> 6), nw = gridDim.x * 4;
  bf16_t* Y = (bf16_t*)(p.ws + SB_Y);
  const float* nwt = p.in[I_SSM_NW];
  for (int item = gw; item < T_ * 8; item += nw) {
    const int t = item >> 3, g = item & 7;
    bf16_t* yp = Y + (size_t)t * 2048 + g * 256 + lane * 4;
    const uint2 v = *(const uint2*)yp;
    const float f0 = __uint_as_float(v.x << 16), f1 = __uint_as_float(v.x & 0xFFFF0000u);
    const float f2 = __uint_as_float(v.y << 16), f3 = __uint_as_float(v.y & 0xFFFF0000u);
    const float ss = wave_sum(f0 * f0 + f1 * f1 + f2 * f2 + f3 * f3);
    const float rstd = rsqrtf(ss * (1.f / 256.f) + 1e-5f);
    const float4 wv = *(const float4*)(nwt + g * 256 + lane * 4);
    *(uint2*)yp = make_uint2(pack2(f0 * rstd * wv.x, f1 * rstd * wv.y), pack2(f2 * rstd * wv.z, f3 * rstd * wv.w));
  }
}

template <int LPR>
DI void wkv_item(const Params& p, char* smem, int seq, int head, int part) {
  constexpr int ROWS = 256 / LPR, KPL = 64 / LPR;
  const int tid = TIDX;
  float* sR = (float*)smem;
  float* sK = sR + 2048;
  float* sKK = sK + 2048;
  float* sBB = sKK + 2048;
  float* sW = sBB + 2048;
  float* sV = sW + 2048;
  float* sO = sV + 2048;
  const bf16_t* R = (const bf16_t*)(p.ws + SC_R);
  const bf16_t* K = (const bf16_t*)(p.ws + SC_K);
  const bf16_t* V = (const bf16_t*)(p.ws + SC_V);
  const bf16_t* AAc = (const bf16_t*)(p.ws + SC_AA);
  const float* WD = (const float*)(p.ws + SC_WD);
  bf16_t* O = (bf16_t*)(p.ws + SC_O);
  const bool prompt = seq < 8;
  const int nch = prompt ? 64 : 1, nvalid = prompt ? 32 : 8;
  const int tbase = prompt ? seq * 2048 : TP_ + (seq - 8) * 8;
  const int row_l = tid / LPR, q = tid % LPR, row = part * ROWS + row_l;
  float S[KPL];
  {
    const float* s0 = p.in[I_ST_RW] + (((size_t)(seq - 8) * 16 + head) * 64 + row) * 64 + q * KPL;
#pragma unroll
    for (int e = 0; e < KPL; ++e) S[e] = prompt ? 0.f : s0[e];
  }
  const int pst = tid >> 3, pk0 = (tid & 7) * 8, pcol = head * 64 + pk0;
  float kk8[8], ka8[8];
  load8f(p.in[I_RW_KK] + pcol, kk8);
  load8f(p.in[I_RW_KA] + pcol, ka8);
  for (int c = 0; c < nch; ++c) {
    const int t0 = tbase + c * 32;
    __syncthreads();
    if (pst < nvalid) {
      const size_t o = (size_t)(t0 + pst) * 1024 + pcol;
      float r8[8], k8[8], v8[8], a8[8], w8[8];
      unpack8(*(const uint4*)(R + o), r8);
      unpack8(*(const uint4*)(K + o), k8);
      unpack8(*(const uint4*)(V + o), v8);
      unpack8(*(const uint4*)(AAc + o), a8);
      load8f(WD + o, w8);
      float kr[8], ss = 0.f;
#pragma unroll
      for (int e = 0; e < 8; ++e) { kr[e] = k8[e] * kk8[e]; ss += kr[e] * kr[e]; }
      ss = red_lanes<8>(ss);
      const float inv = 1.f / fmaxf(sqrtf(ss), 1e-12f);
      float kp[8], bb[8];
#pragma unroll
      for (int e = 0; e < 8; ++e) { kr[e] *= inv; kp[e] = k8[e] * (1.f + (a8[e] - 1.f) * ka8[e]); bb[e] = kr[e] * a8[e]; }
      const int lo = pst * 64 + pk0;
      store8f(sR + lo, r8); store8f(sK + lo, kp); store8f(sKK + lo, kr); store8f(sBB + lo, bb);
      store8f(sW + lo, w8); store8f(sV + lo, v8);
    }
    __syncthreads();
    for (int st = 0; st < nvalid; ++st) {
      const int lo = st * 64 + q * KPL;
      float kk[KPL], ww[KPL], bb[KPL], kp[KPL], rr[KPL];
#pragma unroll
      for (int e = 0; e < KPL; e += 4) {
        const float4 a = *(const float4*)(sKK + lo + e); kk[e] = a.x; kk[e + 1] = a.y; kk[e + 2] = a.z; kk[e + 3] = a.w;
        const float4 b = *(const float4*)(sW + lo + e); ww[e] = b.x; ww[e + 1] = b.y; ww[e + 2] = b.z; ww[e + 3] = b.w;
        const float4 d = *(const float4*)(sBB + lo + e); bb[e] = d.x; bb[e + 1] = d.y; bb[e + 2] = d.z; bb[e + 3] = d.w;
        const float4 f = *(const float4*)(sK + lo + e); kp[e] = f.x; kp[e + 1] = f.y; kp[e + 2] = f.z; kp[e + 3] = f.w;
        const float4 g = *(const float4*)(sR + lo + e); rr[e] = g.x; rr[e + 1] = g.y; rr[e + 2] = g.z; rr[e + 3] = g.w;
      }
      const float vv = sV[st * 64 + row];
      float sa = 0.f;
#pragma unroll
      for (int e = 0; e < KPL; ++e) sa += S[e] * kk[e];
      sa = red_lanes<LPR>(sa);
      float oo = 0.f;
#pragma unroll
      for (int e = 0; e < KPL; ++e) {
        S[e] = S[e] * ww[e] - sa * bb[e] + vv * kp[e];
        oo += S[e] * rr[e];
      }
      oo = red_lanes<LPR>(oo);
      if (q == 0) sO[st * ROWS + row_l] = oo;
    }
    __syncthreads();
    for (int i = tid; i < nvalid * ROWS; i += NTHR) {
      const int st = i / ROWS, rr = i % ROWS;
      O[(size_t)(t0 + st) * 1024 + head * 64 + part * ROWS + rr] = f2bf(sO[i]);
    }
  }
  float* dst = prompt ? (p.out + O_RW_P + (((size_t)seq * 16 + head) * 64 + row) * 64 + q * KPL)
                      : (p.out + O_RW_S + (((size_t)(seq - 8) * 16 + head) * 64 + row) * 64 + q * KPL);
#pragma unroll
  for (int e = 0; e < KPL; ++e) dst[e] = S[e];
}

template <int LPR>
DI void ph_wkv(const Params& p, char* smem) {
  constexpr int NPART = 64 / (256 / LPR);
  const int G = gridDim.x, bid = blockIdx.x;
  const int nP = 128 * NPART, nS = 2048 * NPART;
  for (int it = bid; it < nP + nS; it += G) {
    int seq, head, part;
    if (it < nP) { part = it % NPART; const int sh = it / NPART; seq = sh >> 4; head = sh & 15; }
    else { const int u = it - nP; part = u % NPART; const int sh = u / NPART; seq = 8 + (sh >> 4); head = sh & 15; }
    wkv_item<LPR>(p, smem, seq, head, part);
  }
}

DI void ph_wkv_post(const Params& p) {
  const int tid_ = TIDX; const int lane = tid_ & 63;
  const int gw = blockIdx.x * 4 + (tid_ >> 6), nw = gridDim.x * 4;
  const bf16_t* R = (const bf16_t*)(p.ws + SC_R);
  const bf16_t* K = (const bf16_t*)(p.ws + SC_K);
  const bf16_t* V = (const bf16_t*)(p.ws + SC_V);
  const bf16_t* AAc = (const bf16_t*)(p.ws + SC_AA);
  const bf16_t* Gg = (const bf16_t*)(p.ws + SC_G);
  const bf16_t* O = (const bf16_t*)(p.ws + SC_O);
  bf16_t* U = (bf16_t*)(p.ws + W_U);
  for (int item = gw; item < T_ * 16; item += nw) {
    const int t = item >> 4, head = item & 15, col = head * 64 + lane;
    const size_t o = (size_t)t * 1024 + col;
    const float ov = bf2f(O[o]);
    const float mean = wave_sum(ov) * (1.f / 64.f);
    const float d = ov - mean;
    const float var = wave_sum(d * d) * (1.f / 64.f);
    const float on = d * rsqrtf(var + 64e-5f) * p.in[I_RW_LNW][col] + p.in[I_RW_LNB][col];
    const float r = bf2f(R[o]), k = bf2f(K[o]), a = bf2f(AAc[o]), v = bf2f(V[o]);
    const float kp = k * (1.f + (a - 1.f) * p.in[I_RW_KA][col]);
    const float s = wave_sum(r * kp * p.in[I_RW_RK][col]);
    U[o] = f2bf((on + s * v) * bf2f(Gg[o]));
  }
}

constexpr int NPH = 40;
#ifndef REP_GEMM
#define REP_GEMM 1
#endif
#ifndef REP_SSD
#define REP_SSD 1
#endif
#ifndef REP_WKV
#define REP_WKV 1
#endif
#ifndef REP_MISC
#define REP_MISC 1
#endif

__global__ void __launch_bounds__(NTHR, 2) mega(Params p) {
  __shared__ __attribute__((aligned(16))) char smem[SMEM_BYTES];
  __shared__ uint4 xb_words;
  cg::grid_group grid = cg::this_grid();
  if (threadIdx.x == 0) xb_words = make_uint4(0u, 0u, 0u, 0u);
  __syncthreads();
  XcdBarrier xb = xcd_barrier_post((unsigned*)(p.ws + W_BAR), (volatile LAS unsigned*)&xb_words);
  int ph = 0;
#define PH(...)                                                     \
  {                                                                 \
    if (ph >= p.ph_begin && ph < p.ph_end) {                        \
      __VA_ARGS__;                                                  \
      xcd_barrier(xb);                                              \
    }                                                               \
    ++ph;                                                           \
  }
#define PHR(rep, ...)                                               \
  {                                                                 \
    if (ph >= p.ph_begin && ph < p.ph_end) {                        \
      for (int rep_ = 0; rep_ < (rep); ++rep_) {                    \
        __VA_ARGS__;                                                \
        xcd_barrier(xb);                                            \
      }                                                             \
    }                                                               \
    ++ph;                                                           \
  }
#define PH_LAST(...)                                                \
  {                                                                 \
    if (ph >= p.ph_begin && ph < p.ph_end) { __VA_ARGS__; }         \
    ++ph;                                                           \
  }
  bf16_t* wt = (bf16_t*)(p.ws + W_WT);
  bf16_t* U = (bf16_t*)(p.ws + W_U);
  float* X = (float*)(p.ws + W_X);

  {
    if (ph >= p.ph_begin && ph < p.ph_end) { ph_prologue(p, smem); grid.sync(); }
    ++ph;
  }

#pragma nounroll
  for (int layer = 0; layer < 4; ++layer) {
    const int kind = layer % 3;
    PHR(REP_MISC, ph_rmsnorm(p, kind == 2 ? 1 : 0, p.in[I_NMIX] + layer * 1024));
    if (kind == 0) {
      const int ia = layer / 3;
      PHR(REP_GEMM, {
        GJob j = mkjob(U, 1024, wt + WA_IN + (size_t)ia * 2048 * 1024, 1024, 1024, 2048);
        j.o0 = p.ws + SA_XB; j.o1 = p.ws + SA_GT;
        int toff = 0; gemm_run<EPI_LRU_IN, false>(j, 16, toff, smem);
      });
      PHR(REP_MISC, (ph_conv<1024, false>((const bf16_t*)(p.ws + SA_XB), (bf16_t*)(p.ws + SA_XC),
                               p.in[I_LRU_CW] + (size_t)ia * 4 * 1024, p.in[I_LRU_CB] + (size_t)ia * 1024,
                               p.in[I_ST_LC] + (size_t)ia * 128 * 3 * 1024,
                               p.out + O_LC_P + (size_t)ia * 8 * 3 * 1024, p.out + O_LC_S + (size_t)ia * 128 * 3 * 1024)));
      PHR(REP_GEMM, {
        const int G = gridDim.x;
        for (int tile = blockIdx.x; tile < MT_ * 16; tile += G) {
          const int mt = tile >> 4, jt = tile & 15;
          GJob j = mkjob((const bf16_t*)(p.ws + SA_XC) + (jt >> 1) * 128, 1024,
                         wt + WA_G + (size_t)ia * 2048 * 128, 128, 128, 2048);
          j.o0 = p.ws + SA_AA; j.o1 = p.ws + SA_XC;
          j.x0 = p.in[I_LRU_BR] + ia * 1024; j.x1 = p.in[I_LRU_BI] + ia * 1024; j.x2 = p.in[I_LRU_LAM] + ia * 1024;
          gemm_tile<EPI_GATES, false>(j, mt * 128, jt * 128, smem);
        }
      });
      PHR(REP_MISC, ph_lru_scan1(p));
      PH(ph_lru_scan2(p, ia));
      PH({
        GJob j = mkjob((const bf16_t*)(p.ws + SA_GT), 1024, wt + WA_OUT + (size_t)ia * 1024 * 1024, 1024, 1024, 1024);
        j.o0 = X;
        int toff = 0; gemm_run<EPI_RESID, false>(j, 8, toff, smem);
      });
    } else if (kind == 1) {
      PHR(REP_GEMM, {
        GJob j = mkjob(U, 1024, wt + WB_XBC, 1024, 1024, 4128);
        j.o0 = p.ws + SB_XBCP; j.o1 = p.ws + SB_DT; j.x0 = p.in[I_SSM_DTB];
        int toff = 0; gemm_run<EPI_SSM_XBC, false>(j, 33, toff, smem);
      });
      PHR(REP_MISC, (ph_conv<4096, true>((const bf16_t*)(p.ws + SB_XBCP), (bf16_t*)(p.ws + SB_XBC),
                              p.in[I_SSM_CW], p.in[I_SSM_CB], p.in[I_ST_SC],
                              p.out + O_SC_P, p.out + O_SC_S)));
      PHR(REP_SSD, ph_ssd(p, smem));
      PH({
        GJob j = mkjob(U, 1024, wt + WB_Z, 1024, 1024, 2048);
        j.o0 = p.ws + SB_Y;
        int toff = 0; gemm_run<EPI_SSM_Z, false>(j, 16, toff, smem);
      });
      PH(ph_gnorm(p));
      PH({
        GJob j = mkjob((const bf16_t*)(p.ws + SB_Y), 2048, wt + WB_OUT, 2048, 2048, 1024);
        j.o0 = X;
        int toff = 0; gemm_run<EPI_RESID, false>(j, 8, toff, smem);
      });
    } else {
      PHR(REP_GEMM, {
        int toff = 0;
        for (int s = 0; s < 3; ++s) {
          GJob j = mkjob(U, 1024, wt + WC_RKV + (size_t)s * 1024 * 1024, 1024, 1024, 1024);
          j.A2 = (const bf16_t*)(p.ws + SC_UP); j.mu = p.in[I_RW_MU] + s * 1024;
          j.o0 = p.ws + SC_R + (size_t)s * SZ_TD2; j.ldo = 1024; j.act = 0;
          gemm_run<EPI_ST, true>(j, 8, toff, smem);
        }
        for (int s = 0; s < 3; ++s) {
          const int nv = (s == 2) ? 128 : 64;
          GJob j = mkjob(U, 1024, wt + WC_L1 + (size_t)s * 64 * 1024, 1024, 1024, nv);
          j.A2 = (const bf16_t*)(p.ws + SC_UP); j.mu = p.in[I_RW_MU] + (3 + s) * 1024;
          j.o0 = p.ws + SC_LH + (size_t)s * 64 * 2; j.ldo = 256; j.act = (s == 0) ? 1 : (s == 2 ? 2 : 0);
          gemm_run<EPI_ST, true>(j, 1, toff, smem);
        }
      });
      PHR(REP_GEMM, {
        int toff = 0;
        const bf16_t* LH = (const bf16_t*)(p.ws + SC_LH);
        {
          GJob j = mkjob(LH, 256, wt + WC_W2, 64, 64, 1024);
          j.o0 = p.ws + SC_WD; j.x0 = p.in[I_RW_W0];
          gemm_run<EPI_DECAY, false>(j, 8, toff, smem);
        }
        {
          GJob j = mkjob(LH + 64, 256, wt + WC_A2, 64, 64, 1024);
          j.o0 = p.ws + SC_AA; j.x0 = p.in[I_RW_A0];
          gemm_run<EPI_SIGB, false>(j, 8, toff, smem);
        }
        {
          GJob j = mkjob(LH + 128, 256, wt + WC_G2, 128, 128, 1024);
          j.o0 = p.ws + SC_G; j.ldo = 1024; j.act = 0;
          gemm_run<EPI_ST, false>(j, 8, toff, smem);
        }
      });
      PHR(REP_WKV, ph_wkv<8>(p, smem));
      PHR(REP_MISC, ph_wkv_post(p));
      PH({
        GJob j = mkjob(U, 1024, wt + WC_OUT, 1024, 1024, 1024);
        j.o0 = X;
        int toff = 0; gemm_run<EPI_RESID, false>(j, 8, toff, smem);
      });
    }
    PHR(REP_MISC, ph_rmsnorm(p, 0, p.in[I_NFFN] + layer * 1024));
    PHR(REP_GEMM, {
      GJob j = mkjob(U, 1024, wt + WF_1 + (size_t)layer * 4096 * 1024, 1024, 1024, 4096);
      j.o0 = p.ws + S_HB;
      int toff = 0; gemm_run<EPI_FFN1, false>(j, 32, toff, smem);
    });
    PH({
      GJob j = mkjob((const bf16_t*)(p.ws + S_HB), 4096, wt + WF_2 + (size_t)layer * 4096 * 1024, 4096, 4096, 1024);
      j.o0 = X;
      int toff = 0; gemm_run<EPI_RESID, false>(j, 8, toff, smem);
    });
  }
  PH_LAST(ph_rmsnorm(p, 2, p.in[I_NFIN]));
#undef PH
#undef PH_LAST
}

extern "C" void kernel_launch(void* const* d_in, const int* in_sizes, int n_in, void* d_out, int out_size,
                              void* d_ws, size_t ws_size, hipStream_t stream) {
  Params p;
  memset(&p, 0, sizeof(p));
  for (int i = 0; i < N_IN; ++i) p.in[i] = (const float*)d_in[i];
  p.out = (float*)d_out;
  p.ws = (char*)d_ws;
  p.ph_begin = 0;
  p.ph_end = 1000;
  static int grid_blocks = 0;
  if (!grid_blocks) {
    int dev = 0, cus = 0, per_cu = 0;
    hipGetDevice(&dev);
    hipDeviceGetAttribute(&cus, hipDeviceAttributeMultiprocessorCount, dev);
    hipOccupancyMaxActiveBlocksPerMultiprocessor(&per_cu, mega, NTHR, 0);
    if (per_cu > 2) per_cu = 2;
    if (per_cu < 1) per_cu = 1;
    grid_blocks = cus * per_cu;
  }
  if (ws_size < (size_t)536870912) fprintf(stderr, "workspace too small: %zu\n", ws_size);
  (void)hipMemsetAsync((char*)d_ws + W_BAR, 0, XCD_BAR_WORDS * 4, stream);
  void* args[] = {&p};
  hipError_t e = hipLaunchCooperativeKernel((void*)mega, dim3(grid_blocks), dim3(NTHR), args, 0, stream);
  if (e != hipSuccess) fprintf(stderr, "cooperative launch failed: %s (grid %d)\n", hipGetErrorString(e), grid_blocks);
}
```

```cpp
#include <hip/hip_runtime.h>
#include <hip/hip_cooperative_groups.h>
#include <stdint.h>
#include <stdio.h>
#include <string.h>
namespace cg = cooperative_groups;

typedef unsigned short bf16_t;
typedef __attribute__((ext_vector_type(8))) short bf16x8;
typedef __attribute__((ext_vector_type(16))) float f32x16;

#define DI __device__ __forceinline__

constexpr int T_ = 17408;
constexpr int TP_ = 16384;
constexpr int NTHR = 256;
constexpr int MT_ = T_ / 128;

enum {
  I_XP = 0, I_XS, I_ST_LC, I_ST_LH, I_ST_SC, I_ST_SS, I_ST_RS, I_ST_RW,
  I_NMIX, I_NFFN, I_NFIN,
  I_LRU_WIN, I_LRU_CW, I_LRU_CB, I_LRU_WR, I_LRU_BR, I_LRU_WI, I_LRU_BI, I_LRU_LAM, I_LRU_WOUT,
  I_SSM_WIN, I_SSM_CW, I_SSM_CB, I_SSM_DTB, I_SSM_ALOG, I_SSM_D, I_SSM_NW, I_SSM_WOUT,
  I_RW_MU, I_RW_WRKV, I_RW_W0, I_RW_WW1, I_RW_WW2, I_RW_A0, I_RW_WA1, I_RW_WA2, I_RW_WG1, I_RW_WG2,
  I_RW_KK, I_RW_KA, I_RW_RK, I_RW_LNW, I_RW_LNB, I_RW_WOUT,
  I_FFN_W1, I_FFN_W2, N_IN
};

constexpr size_t O_Y = 0;
constexpr size_t O_LC_P = O_Y + (size_t)T_ * 1024;
constexpr size_t O_LC_S = O_LC_P + 2 * 8 * 3 * 1024;
constexpr size_t O_LH_P = O_LC_S + 2 * 128 * 3 * 1024;
constexpr size_t O_LH_S = O_LH_P + 2 * 8 * 1024;
constexpr size_t O_SC_P = O_LH_S + 2 * 128 * 1024;
constexpr size_t O_SC_S = O_SC_P + 8 * 3 * 4096;
constexpr size_t O_SS_P = O_SC_S + 128 * 3 * 4096;
constexpr size_t O_SS_S = O_SS_P + (size_t)8 * 32 * 64 * 128;
constexpr size_t O_RS_P = O_SS_S + (size_t)128 * 32 * 64 * 128;
constexpr size_t O_RS_S = O_RS_P + 8 * 1024;
constexpr size_t O_RW_P = O_RS_S + 128 * 1024;
constexpr size_t O_RW_S = O_RW_P + 8 * 16 * 64 * 64;

constexpr size_t W_X = 0;
constexpr size_t W_U = W_X + (size_t)T_ * 1024 * 4;
constexpr size_t W_WT = W_U + (size_t)T_ * 1024 * 2;
constexpr size_t WA_IN = 0;
constexpr size_t WA_G = WA_IN + 2 * 2048 * 1024;
constexpr size_t WA_OUT = WA_G + 2 * 2048 * 128;
constexpr size_t WB_XBC = WA_OUT + 2 * 1024 * 1024;
constexpr size_t WB_Z = WB_XBC + 4128 * 1024;
constexpr size_t WB_OUT = WB_Z + 2048 * 1024;
constexpr size_t WC_RKV = WB_OUT + 1024 * 2048;
constexpr size_t WC_L1 = WC_RKV + 3 * 1024 * 1024;
constexpr size_t WC_W2 = WC_L1 + 256 * 1024;
constexpr size_t WC_A2 = WC_W2 + 1024 * 64;
constexpr size_t WC_G2 = WC_A2 + 1024 * 64;
constexpr size_t WC_OUT = WC_G2 + 1024 * 128;
constexpr size_t WF_1 = WC_OUT + 1024 * 1024;
constexpr size_t WF_2 = WF_1 + (size_t)4 * 4096 * 1024;
constexpr size_t W_WT_ELEMS = WF_2 + (size_t)4 * 4096 * 1024;
constexpr size_t W_S = W_WT + W_WT_ELEMS * 2;
constexpr size_t SZ_TD2 = (size_t)T_ * 1024 * 2;
constexpr size_t SZ_TD4 = (size_t)T_ * 1024 * 4;
constexpr size_t S_HB = W_S;
constexpr size_t SA_XB = W_S;
constexpr size_t SA_GT = SA_XB + SZ_TD2;
constexpr size_t SA_XC = SA_GT + SZ_TD2;
constexpr size_t SA_AA = SA_XC + SZ_TD2;
constexpr size_t SA_BB = SA_AA + SZ_TD4;
constexpr size_t SA_CP = SA_BB + SZ_TD4;
constexpr size_t SA_CS = SA_CP + 8 * 64 * 1024 * 4;
constexpr size_t SB_XBCP = W_S;
constexpr size_t SB_Y = W_S;
constexpr size_t SB_XBC = SB_XBCP + SZ_TD2 * 4;
constexpr size_t SB_DT = SB_XBC + SZ_TD2 * 4;
constexpr size_t SC_UP = W_S;
constexpr size_t SC_O = W_S;
constexpr size_t SC_R = SC_UP + SZ_TD2;
constexpr size_t SC_K = SC_R + SZ_TD2;
constexpr size_t SC_V = SC_K + SZ_TD2;
constexpr size_t SC_LH = SC_V + SZ_TD2;
constexpr size_t SC_WD = SC_LH + (size_t)T_ * 256 * 2;
constexpr size_t SC_AA = SC_WD + SZ_TD4;
constexpr size_t SC_G = SC_AA + SZ_TD2;
constexpr size_t SC_END = SC_G + SZ_TD2;
static_assert(SC_END <= (size_t)536870912, "ws overflow C");
static_assert(SB_DT + (size_t)T_ * 32 * 4 <= (size_t)536870912, "ws overflow B");
static_assert(SA_CS + 8 * 64 * 1024 * 4 <= (size_t)536870912, "ws overflow A");

constexpr int SMEM_BYTES = 80384;
constexpr size_t W_BAR = (size_t)536870912 - 65536;

struct Params {
  const float* in[N_IN];
  float* out;
  char* ws;
  int ph_begin, ph_end;
};

DI float bf2f(bf16_t h) { return __uint_as_float(((unsigned)h) << 16); }
DI bf16_t f2bf(float f) {
  unsigned u = __float_as_uint(f);
  u += 0x7FFFu + ((u >> 16) & 1u);
  return (bf16_t)(u >> 16);
}
DI unsigned pack2(float a, float b) { return (unsigned)f2bf(a) | ((unsigned)f2bf(b) << 16); }
DI void unpack8(const uint4 v, float (&f)[8]) {
  f[0] = __uint_as_float(v.x << 16); f[1] = __uint_as_float(v.x & 0xFFFF0000u);
  f[2] = __uint_as_float(v.y << 16); f[3] = __uint_as_float(v.y & 0xFFFF0000u);
  f[4] = __uint_as_float(v.z << 16); f[5] = __uint_as_float(v.z & 0xFFFF0000u);
  f[6] = __uint_as_float(v.w << 16); f[7] = __uint_as_float(v.w & 0xFFFF0000u);
}
DI uint4 pack8(const float (&f)[8]) {
  return make_uint4(pack2(f[0], f[1]), pack2(f[2], f[3]), pack2(f[4], f[5]), pack2(f[6], f[7]));
}
DI void load8f(const float* p, float (&f)[8]) {
  float4 a = *(const float4*)p, b = *(const float4*)(p + 4);
  f[0] = a.x; f[1] = a.y; f[2] = a.z; f[3] = a.w; f[4] = b.x; f[5] = b.y; f[6] = b.z; f[7] = b.w;
}
DI void store8f(float* p, const float (&f)[8]) {
  *(float4*)p = make_float4(f[0], f[1], f[2], f[3]);
  *(float4*)(p + 4) = make_float4(f[4], f[5], f[6], f[7]);
}
DI float sigmoidf_(float x) { return 1.f / (1.f + __expf(-x)); }
DI float siluf_(float x) { return x / (1.f + __expf(-x)); }
DI float tanhf_(float y) { return 1.f - 2.f / (1.f + __expf(2.f * y)); }
DI float geluf_(float x) { return 0.5f * x * (1.f + tanhf_(0.7978845608028654f * (x + 0.044715f * x * x * x))); }
DI float softplusf_(float x) { return fmaxf(x, 0.f) + log1pf(__expf(-fabsf(x))); }
DI float wave_sum(float v) {
#pragma unroll
  for (int o = 32; o >= 1; o >>= 1) v += __shfl_xor(v, o, 64);
  return v;
}
template <int CTRL> DI float dppf(float x) {
  return __int_as_float(__builtin_amdgcn_update_dpp(0, __float_as_int(x), CTRL, 0xf, 0xf, false));
}
template <int N> DI float red_lanes(float x) {
  x += dppf<0xB1>(x);
  x += dppf<0x4E>(x);
  if (N >= 8) x += dppf<0x141>(x);
  if (N >= 16) x += dppf<0x140>(x);
  return x;
}
DI void tok_info(int t, int& seq, int& l, int& L) {
  if (t < TP_) { seq = t >> 11; l = t & 2047; L = 2048; }
  else { int u = t - TP_; seq = 8 + (u >> 3); l = u & 7; L = 8; }
}
DI int opq(int x) { asm volatile("" : "+v"(x)); return x; }
#define TIDX opq((int)threadIdx.x)
DI f32x16 mfma32(bf16x8 a, bf16x8 b, f32x16 c) { return __builtin_amdgcn_mfma_f32_32x32x16_bf16(a, b, c, 0, 0, 0); }


#define XB_TMO      128
#define XB_XCNT(j)  (256  + 64 * (j))
#define XB_XSUB(j)  (1280 + 64 * (j))
#define XB_XGEN(j)  (2304 + 64 * (j))
#define XB_TOP      3328
#define XB_TOPGEN   3392
#define XCD_BAR_WORDS 3456
#define XB_SPIN_CAP (1u << 22)
#define LAS __attribute__((address_space(3)))
DI unsigned xb_ld(unsigned* p) { return __hip_atomic_load(p, __ATOMIC_RELAXED, __HIP_MEMORY_SCOPE_AGENT); }
DI unsigned xb_add(unsigned* p, unsigned v) { return __hip_atomic_fetch_add(p, v, __ATOMIC_RELAXED, __HIP_MEMORY_SCOPE_AGENT); }
DI unsigned xb_xcc_id() { return (unsigned)__builtin_amdgcn_s_getreg((3 << 11) | 20) & 0xFu; }
#define XB_SPIN(cond, bar) do { unsigned _sp = 0; while (cond) { __builtin_amdgcn_s_sleep(1); \
    if ((++_sp & 255u) == 0u) { if (xb_ld(&(bar)[XB_TMO])) break; if (_sp > XB_SPIN_CAP) { atomicAdd(&(bar)[XB_TMO], 1u); break; } } } } while (0)
struct XcdBarrier { unsigned* bar; unsigned x; volatile LAS unsigned* st; };
DI XcdBarrier xcd_barrier_post(unsigned* bar, volatile LAS unsigned* st) {
  XcdBarrier b; b.bar = bar; b.x = xb_xcc_id(); b.st = st;
  if (threadIdx.x == 0) (void)xb_add(&bar[XB_XCNT(b.x)], 1u);
  return b;
}
DI void xcd_barrier_complete(unsigned* bar, unsigned x, unsigned& nloc, unsigned& nx) {
  const unsigned G = gridDim.x * gridDim.y * gridDim.z;
  unsigned sum, cnt, mine, sp = 0u;
  for (;;) {
    sum = 0u; cnt = 0u; mine = 0u;
#pragma unroll
    for (unsigned j = 0; j < 16; ++j) { const unsigned c = xb_ld(&bar[XB_XCNT(j)]); sum += c; cnt += (c > 0u) ? 1u : 0u; mine = (j == x) ? c : mine; }
    if (sum == G) break;
    __builtin_amdgcn_s_sleep(1);
    if ((++sp & 255u) == 0u) { if (xb_ld(&bar[XB_TMO])) break; if (sp > XB_SPIN_CAP) { atomicAdd(&bar[XB_TMO], 1u); break; } }
  }
  nloc = mine > 0u ? mine : 1u; nx = cnt > 0u ? cnt : 1u;
}
DI void xcd_barrier(const XcdBarrier& b) {
  asm volatile("s_waitcnt vmcnt(0)" ::: "memory");
  __syncthreads();
  if (threadIdx.x == 0) {
    unsigned* bar = b.bar;
    __builtin_amdgcn_s_waitcnt(0);
    unsigned nloc = b.st[0], nx = b.st[1];
    if (nloc == 0u) { xcd_barrier_complete(bar, b.x, nloc, nx); b.st[0] = nloc; b.st[1] = nx; }
    const unsigned old = xb_add(&bar[XB_XSUB(b.x)], 1u);
    const unsigned gen = old / nloc;
    if (old + 1u == (gen + 1u) * nloc) {
      __builtin_amdgcn_fence(__ATOMIC_RELEASE, "agent");
      asm volatile("s_waitcnt vmcnt(0)" ::: "memory");
      const unsigned og = xb_add(&bar[XB_TOP], 1u);
      const unsigned tg = og / nx;
      if (og + 1u == (tg + 1u) * nx) xb_add(&bar[XB_TOPGEN], 1u);
      else XB_SPIN(xb_ld(&bar[XB_TOPGEN]) == tg, bar);
      __builtin_amdgcn_fence(__ATOMIC_ACQUIRE, "agent");
      xb_add(&bar[XB_XGEN(b.x)], 1u);
      asm volatile("s_waitcnt vmcnt(0)" ::: "memory");
    } else {
      XB_SPIN(xb_ld(&bar[XB_XGEN(b.x)]) == gen, bar);
      __builtin_amdgcn_fence(__ATOMIC_ACQUIRE, "agent");
      asm volatile("s_waitcnt vmcnt(0)" ::: "memory");
    }
  }
  __syncthreads();
}

struct GJob {
  const bf16_t* A; const bf16_t* A2; const float* mu; const bf16_t* Bt;
  int lda, ldb, K, nvalid;
  void* o0; void* o1; const float* x0; const float* x1; const float* x2;
  int ldo, act;
};
enum { EPI_LRU_IN = 0, EPI_GATES, EPI_RESID, EPI_SSM_XBC, EPI_SSM_Z, EPI_FFN1, EPI_ST, EPI_DECAY, EPI_SIGB };

template <int EPI> DI void epi_elem(const GJob& j, int row, int col, float v) {
  if (EPI == EPI_LRU_IN) {
    if (col < 1024) ((bf16_t*)j.o0)[(size_t)row * 1024 + col] = f2bf(v);
    else ((bf16_t*)j.o1)[(size_t)row * 1024 + col - 1024] = f2bf(geluf_(v));
  } else if (EPI == EPI_RESID) {
    unsafeAtomicAdd((float*)j.o0 + (size_t)row * 1024 + col, v);
  } else if (EPI == EPI_SSM_XBC) {
    if (col < 4096) ((bf16_t*)j.o0)[(size_t)row * 4096 + col] = f2bf(v);
    else if (col < 4128) ((float*)j.o1)[(size_t)row * 32 + col - 4096] = softplusf_(v + j.x0[col - 4096]);
  } else if (EPI == EPI_SSM_Z) {
    bf16_t* y = (bf16_t*)j.o0 + (size_t)row * 2048 + col;
    *y = f2bf(bf2f(*y) * siluf_(v));
  } else if (EPI == EPI_FFN1) {
    float r = fmaxf(v, 0.f);
    ((bf16_t*)j.o0)[(size_t)row * 4096 + col] = f2bf(r * r);
  } else if (EPI == EPI_ST) {
    if (col < j.nvalid) {
      float r = v;
      if (j.act == 1) r = tanhf_(v); else if (j.act == 2) r = sigmoidf_(v);
      ((bf16_t*)j.o0)[(size_t)row * j.ldo + col] = f2bf(r);
    }
  } else if (EPI == EPI_DECAY) {
    float wl = -softplusf_(-(j.x0[col] + v)) - 0.5f;
    ((float*)j.o0)[(size_t)row * 1024 + col] = __expf(-__expf(wl));
  } else if (EPI == EPI_SIGB) {
    ((bf16_t*)j.o0)[(size_t)row * 1024 + col] = f2bf(sigmoidf_(j.x0[col] + v));
  }
}

template <int EPI, bool MIX>
DI void gemm_tile(const GJob& j, int m0, int n0, int kt0, int kt1, char* smem) {
  const int tid = TIDX, lane = tid & 63, w = tid >> 6;
  const int wm = w >> 1, wn = w & 1, r32 = lane & 31, hh = lane >> 5;
  const int lrow = tid >> 3, kc = tid & 7;
  f32x16 acc[2][2];
#pragma unroll
  for (int a = 0; a < 2; ++a)
#pragma unroll
    for (int b = 0; b < 2; ++b)
#pragma unroll
      for (int r = 0; r < 16; ++r) acc[a][b][r] = 0.f;
  uint4 qa00, qa01, qa02, qa03, qb00, qb01, qb02, qb03, qc00, qc01, qc02, qc03;
  uint4 qa10, qa11, qa12, qa13, qb10, qb11, qb12, qb13, qc10, qc11, qc12, qc13;
  qc00 = qc01 = qc02 = qc03 = qc10 = qc11 = qc12 = qc13 = make_uint4(0, 0, 0, 0);
  const int nk = kt1 - kt0;
  const bf16_t* Ap = j.A + (size_t)(m0 + lrow) * j.lda + kc * 8 + (size_t)kt0 * 64;
  const bf16_t* A2p = MIX ? (j.A2 + (size_t)(m0 + lrow) * j.lda + kc * 8 + (size_t)kt0 * 64) : nullptr;
  const bf16_t* Bp = j.Bt + (size_t)(n0 + lrow) * j.ldb + kc * 8 + (size_t)kt0 * 64;
  const size_t astep = (size_t)32 * j.lda, bstep = (size_t)32 * j.ldb;
  const bool bv0 = (n0 + lrow) < j.nvalid, bv1 = (n0 + lrow + 32) < j.nvalid;
  const bool bv2 = (n0 + lrow + 64) < j.nvalid, bv3 = (n0 + lrow + 96) < j.nvalid;
  const uint4 z4 = make_uint4(0, 0, 0, 0);

#define LD1(s, i, kt)                                                                 \
  qa##s##i = *(const uint4*)(Ap + i * astep + (kt) * 64);                             \
  if (MIX) qc##s##i = *(const uint4*)(A2p + i * astep + (kt) * 64);                   \
  qb##s##i = z4;                                                                      \
  if (bv##i) qb##s##i = *(const uint4*)(Bp + i * bstep + (kt) * 64);
#define GLOAD(s, kt) { LD1(s, 0, kt) LD1(s, 1, kt) LD1(s, 2, kt) LD1(s, 3, kt) }
#define ST1(s, i, As_, Bs_)                                                           \
  if (MIX) {                                                                          \
    float f1[8], f2[8]; unpack8(qa##s##i, f1); unpack8(qc##s##i, f2);                 \
    _Pragma("unroll") for (int e = 0; e < 8; ++e) f1[e] = f1[e] + (f2[e] - f1[e]) * mu8[e]; \
    qa##s##i = pack8(f1);                                                             \
  }                                                                                   \
  *(uint4*)(As_ + (lrow + 32 * i) * 144 + kc * 16) = qa##s##i;                        \
  *(uint4*)(Bs_ + (lrow + 32 * i) * 144 + kc * 16) = qb##s##i;
#define SSTORE(s, kt, buf)                                                            \
  {                                                                                   \
    char* As_ = smem + (buf) * 36864; char* Bs_ = As_ + 18432;                        \
    float mu8[8];                                                                     \
    if (MIX) load8f(j.mu + (kt0 + (kt)) * 64 + kc * 8, mu8);                          \
    ST1(s, 0, As_, Bs_) ST1(s, 1, As_, Bs_) ST1(s, 2, As_, Bs_) ST1(s, 3, As_, Bs_)   \
  }
#define COMPUTE(buf)                                                                  \
  {                                                                                   \
    const char* As_ = smem + (buf) * 36864; const char* Bs_ = As_ + 18432;            \
    const char* ap = As_ + (wm * 64 + r32) * 144 + hh * 16;                           \
    const char* bp = Bs_ + (wn * 64 + r32) * 144 + hh * 16;                           \
    _Pragma("unroll") for (int ks = 0; ks < 4; ++ks) {                                \
      bf16x8 a0 = *(const bf16x8*)(ap + ks * 32);                                     \
      bf16x8 a1 = *(const bf16x8*)(ap + 32 * 144 + ks * 32);                          \
      bf16x8 b0 = *(const bf16x8*)(bp + ks * 32);                                     \
      bf16x8 b1 = *(const bf16x8*)(bp + 32 * 144 + ks * 32);                          \
      acc[0][0] = mfma32(a0, b0, acc[0][0]);                                          \
      acc[0][1] = mfma32(a0, b1, acc[0][1]);                                          \
      acc[1][0] = mfma32(a1, b0, acc[1][0]);                                          \
      acc[1][1] = mfma32(a1, b1, acc[1][1]);                                          \
    }                                                                                 \
  }

  qa10 = qa11 = qa12 = qa13 = qb10 = qb11 = qb12 = qb13 = z4;
  GLOAD(0, 0);
  if (nk > 1) GLOAD(1, 1);
  SSTORE(0, 0, 0);
  __syncthreads();
  for (int i = 0; i < nk; i += 2) {
    if (!MIX && i + 2 < nk) GLOAD(0, i + 2);
    COMPUTE(0);
    if (i + 1 < nk) SSTORE(1, i + 1, 1);
    if (MIX && i + 2 < nk) GLOAD(0, i + 2);
    __syncthreads();
    if (i + 1 >= nk) break;
    if (!MIX && i + 3 < nk) GLOAD(1, i + 3);
    COMPUTE(1);
    if (i + 2 < nk) SSTORE(0, i + 2, 0);
    if (MIX && i + 3 < nk) GLOAD(1, i + 3);
    __syncthreads();
  }
#undef LD1
#undef ST1
#undef GLOAD
#undef SSTORE
#undef COMPUTE

  if (EPI == EPI_GATES) {
    const int ch = (n0 >> 7) * 64 + wn * 32 + r32;
    const float br = j.x0[ch], bi = j.x1[ch];
    const float spl = softplusf_(-j.x2[ch]);
    const bf16_t* XC = (const bf16_t*)j.o1;
    float* AA = (float*)j.o0;
    float* BBp = AA + (size_t)T_ * 1024;
#pragma unroll
    for (int mi = 0; mi < 2; ++mi)
#pragma unroll
      for (int r = 0; r < 16; ++r) {
        const int row = m0 + wm * 64 + mi * 32 + (r & 3) + 8 * (r >> 2) + 4 * hh;
        const float rg = sigmoidf_(acc[mi][0][r] + br);
        const float ig = sigmoidf_(acc[mi][1][r] + bi);
        const float la = -8.f * rg * spl;
        const float xc = bf2f(XC[(size_t)row * 1024 + ch]);
        const bool reset = (row < TP_) && ((row & 2047) == 0);
        const float a = reset ? 0.f : __expf(la);
        const float mult = reset ? 1.f : sqrtf(fmaxf(-expm1f(2.f * la), 0.f));
        AA[(size_t)row * 1024 + ch] = a;
        BBp[(size_t)row * 1024 + ch] = mult * ig * xc;
      }
  } else {
#pragma unroll
    for (int mi = 0; mi < 2; ++mi)
#pragma unroll
      for (int ni = 0; ni < 2; ++ni)
#pragma unroll
        for (int r = 0; r < 16; ++r) {
          const int row = m0 + wm * 64 + mi * 32 + (r & 3) + 8 * (r >> 2) + 4 * hh;
          const int col = n0 + wn * 64 + ni * 32 + r32;
          epi_elem<EPI>(j, row, col, acc[mi][ni][r]);
        }
  }
}

DI int vblock() {
  const int G = gridDim.x, b = blockIdx.x;
  return ((G & 7) == 0) ? ((b & 7) * (G >> 3) + (b >> 3)) : b;
}
DI void tile_map(int L, int ntn, int& mt, int& nt) {
  if ((ntn & 7) == 0) {
    const int grp = L >> 6, loc = L & 63, gpr = ntn >> 3;
    const int gm = grp / gpr, gn = grp - gm * gpr;
    mt = gm * 8 + (loc >> 3); nt = gn * 8 + (loc & 7);
  } else { mt = L / ntn; nt = L - mt * ntn; }
}

template <int EPI, bool MIX>
DI void gemm_run(const GJob& j, int ntn, int& toff, char* smem) {
  const int G = gridDim.x;
  const int ntiles = MT_ * ntn;
  const int start = (int)((vblock() - (toff % G) + G) % G);
  const int nk = j.K >> 6;
  for (int tile = start; tile < ntiles; tile += G) {
    int mt, nt; tile_map(tile, ntn, mt, nt);
    gemm_tile<EPI, MIX>(j, mt * 128, nt * 128, 0, nk, smem);
  }
  toff += ntiles;
}

template <int EPI>
DI void gemm_streamk(const GJob& j, int ntn, char* smem) {
  const int G = gridDim.x;
  const int nk = j.K >> 6;
  const int total = MT_ * ntn * nk;
  const int per = (total + G - 1) / G;
  int s0 = vblock() * per;
  const int s1 = min(s0 + per, total);
  while (s0 < s1) {
    const int tile = s0 / nk, k0 = s0 - tile * nk;
    const int k1 = min(nk, k0 + (s1 - s0));
    int mt, nt; tile_map(tile, ntn, mt, nt);
    gemm_tile<EPI, false>(j, mt * 128, nt * 128, k0, k1, smem);
    s0 += k1 - k0;
  }
}

DI GJob mkjob(const bf16_t* A, int lda, const bf16_t* Bt, int ldb, int K, int nvalid) {
  GJob j;
  j.A = A; j.A2 = nullptr; j.mu = nullptr; j.Bt = Bt; j.lda = lda; j.ldb = ldb; j.K = K; j.nvalid = nvalid;
  j.o0 = nullptr; j.o1 = nullptr; j.x0 = nullptr; j.x1 = nullptr; j.x2 = nullptr; j.ldo = 0; j.act = 0;
  return j;
}

struct TJob { const float* src; bf16_t* dst; int K, N, src_ld, kind, n_off; };

DI TJob get_tjob(const Params& p, int j) {
  bf16_t* wt = (bf16_t*)(p.ws + W_WT);
  TJob o; o.kind = 0; o.n_off = 0;
  if (j < 36) {
    const int ia = j / 18, r = j % 18;
    if (r == 0) { o.src = p.in[I_LRU_WIN] + (size_t)ia * 1024 * 2048; o.dst = wt + WA_IN + (size_t)ia * 2048 * 1024; o.K = 1024; o.N = 2048; o.src_ld = 2048; }
    else if (r == 1) { o.src = p.in[I_LRU_WOUT] + (size_t)ia * 1024 * 1024; o.dst = wt + WA_OUT + (size_t)ia * 1024 * 1024; o.K = 1024; o.N = 1024; o.src_ld = 1024; }
    else {
      const int isI = (r >= 10) ? 1 : 0; const int h = (r - 2) & 7;
      o.src = p.in[isI ? I_LRU_WI : I_LRU_WR] + ((size_t)ia * 8 + h) * 128 * 128;
      o.dst = wt + WA_G + (size_t)ia * 2048 * 128; o.K = 128; o.N = 128; o.src_ld = 128; o.kind = 1 + isI; o.n_off = h * 128;
    }
  } else if (j == 36) { o.src = p.in[I_SSM_WIN] + 2048; o.dst = wt + WB_XBC; o.K = 1024; o.N = 4128; o.src_ld = 6176; }
  else if (j == 37) { o.src = p.in[I_SSM_WIN]; o.dst = wt + WB_Z; o.K = 1024; o.N = 2048; o.src_ld = 6176; }
  else if (j == 38) { o.src = p.in[I_SSM_WOUT]; o.dst = wt + WB_OUT; o.K = 2048; o.N = 1024; o.src_ld = 1024; }
  else if (j < 42) { const int s = j - 39; o.src = p.in[I_RW_WRKV] + (size_t)s * 1024 * 1024; o.dst = wt + WC_RKV + (size_t)s * 1024 * 1024; o.K = 1024; o.N = 1024; o.src_ld = 1024; }
  else if (j == 42) { o.src = p.in[I_RW_WW1]; o.dst = wt + WC_L1; o.K = 1024; o.N = 64; o.src_ld = 64; }
  else if (j == 43) { o.src = p.in[I_RW_WA1]; o.dst = wt + WC_L1 + 64 * 1024; o.K = 1024; o.N = 64; o.src_ld = 64; }
  else if (j == 44) { o.src = p.in[I_RW_WG1]; o.dst = wt + WC_L1 + 128 * 1024; o.K = 1024; o.N = 128; o.src_ld = 128; }
  else if (j == 45) { o.src = p.in[I_RW_WW2]; o.dst = wt + WC_W2; o.K = 64; o.N = 1024; o.src_ld = 1024; }
  else if (j == 46) { o.src = p.in[I_RW_WA2]; o.dst = wt + WC_A2; o.K = 64; o.N = 1024; o.src_ld = 1024; }
  else if (j == 47) { o.src = p.in[I_RW_WG2]; o.dst = wt + WC_G2; o.K = 128; o.N = 1024; o.src_ld = 1024; }
  else if (j == 48) { o.src = p.in[I_RW_WOUT]; o.dst = wt + WC_OUT; o.K = 1024; o.N = 1024; o.src_ld = 1024; }
  else {
    const int l = (j - 49) >> 1, which = (j - 49) & 1;
    if (!which) { o.src = p.in[I_FFN_W1] + (size_t)l * 1024 * 4096; o.dst = wt + WF_1 + (size_t)l * 4096 * 1024; o.K = 1024; o.N = 4096; o.src_ld = 4096; }
    else { o.src = p.in[I_FFN_W2] + (size_t)l * 4096 * 1024; o.dst = wt + WF_2 + (size_t)l * 4096 * 1024; o.K = 4096; o.N = 1024; o.src_ld = 1024; }
  }
  return o;
}
constexpr int N_TJOBS = 57;

DI void ph_prologue(const Params& p, char* smem) {
  const int tid = TIDX, G = gridDim.x;
  {
    const float4* xp = (const float4*)p.in[I_XP];
    const float4* xs = (const float4*)p.in[I_XS];
    float4* X = (float4*)(p.ws + W_X);
    const size_t np = (size_t)TP_ * 256, nt = (size_t)T_ * 256;
    for (size_t i = (size_t)blockIdx.x * NTHR + tid; i < nt; i += (size_t)G * NTHR)
      X[i] = (i < np) ? xp[i] : xs[i - np];
  }
  float* tile = (float*)smem;
  int toff = 0;
  for (int jn = 0; jn < N_TJOBS; ++jn) {
    const TJob tj = get_tjob(p, jn);
    const int nkt = tj.K >> 6, nnt = (tj.N + 63) >> 6;
    const int ntiles = nkt * nnt;
    const int start = (((int)blockIdx.x - (toff % G)) + G) % G;
    for (int t = start; t < ntiles; t += G) {
      const int kt = t / nnt, nt = t - kt * nnt;
      const int k0 = kt * 64, n0 = nt * 64;
      __syncthreads();
#pragma unroll 4
      for (int i = 0; i < 16; ++i) {
        const int k = i * 4 + (tid >> 6), n = tid & 63;
        float v = 0.f;
        if (n0 + n < tj.N) v = tj.src[(size_t)(k0 + k) * tj.src_ld + n0 + n];
        tile[k * 65 + n] = v;
      }
      __syncthreads();
      const int n = tid >> 2, kq = tid & 3;
      if (n0 + n < tj.N) {
        int nrow = n0 + n;
        if (tj.kind) {
          const int ch = tj.n_off + n0 + n;
          nrow = (ch >> 6) * 128 + ((ch >> 5) & 1) * 64 + (tj.kind - 1) * 32 + (ch & 31);
        }
        float f[8], g[8];
#pragma unroll
        for (int e = 0; e < 8; ++e) { f[e] = tile[(kq * 16 + e) * 65 + n]; g[e] = tile[(kq * 16 + 8 + e) * 65 + n]; }
        uint4* d = (uint4*)(tj.dst + (size_t)nrow * tj.K + k0 + kq * 16);
        d[0] = pack8(f); d[1] = pack8(g);
      }
    }
    toff += ntiles;
  }
}

DI void ph_rmsnorm(const Params& p, int mode, const float* w) {
  const int tid_ = TIDX; const int lane = tid_ & 63;
  const int gw = blockIdx.x * 4 + (tid_ >> 6), nw = gridDim.x * 4;
  const float* X = (const float*)(p.ws + W_X);
  bf16_t* U = (bf16_t*)(p.ws + W_U);
  bf16_t* UP = (bf16_t*)(p.ws + SC_UP);
  float4 wv[4];
#pragma unroll
  for (int i = 0; i < 4; ++i) wv[i] = ((const float4*)w)[lane + 64 * i];
  for (int row = gw; row < T_; row += nw) {
    const float4* xr = (const float4*)(X + (size_t)row * 1024);
    float4 v[4]; float ss = 0.f;
#pragma unroll
    for (int i = 0; i < 4; ++i) { v[i] = xr[lane + 64 * i]; ss += v[i].x * v[i].x + v[i].y * v[i].y + v[i].z * v[i].z + v[i].w * v[i].w; }
    ss = wave_sum(ss);
    const float rstd = rsqrtf(ss * (1.f / 1024.f) + 1e-6f);
    int seq, l, L; tok_info(row, seq, l, L);
#pragma unroll
    for (int i = 0; i < 4; ++i) {
      const int c = 4 * (lane + 64 * i);
      float4 y = make_float4(v[i].x * rstd * wv[i].x, v[i].y * rstd * wv[i].y, v[i].z * rstd * wv[i].z, v[i].w * rstd * wv[i].w);
      if (mode == 2) {
        *(float4*)(p.out + O_Y + (size_t)row * 1024 + c) = y;
      } else {
        uint2 pk = make_uint2(pack2(y.x, y.y), pack2(y.z, y.w));
        *(uint2*)(U + (size_t)row * 1024 + c) = pk;
        if (mode == 1) {
          if (l + 1 < L) *(uint2*)(UP + (size_t)(row + 1) * 1024 + c) = pk;
          if (l == 0) {
            uint2 pz = make_uint2(0, 0);
            if (seq >= 8) { float4 s = *(const float4*)(p.in[I_ST_RS] + (size_t)(seq - 8) * 1024 + c); pz = make_uint2(pack2(s.x, s.y), pack2(s.z, s.w)); }
            *(uint2*)(UP + (size_t)row * 1024 + c) = pz;
          }
          if (l == L - 1) {
            float* o = (seq < 8) ? (p.out + O_RS_P + (size_t)seq * 1024 + c) : (p.out + O_RS_S + (size_t)(seq - 8) * 1024 + c);
            *(float4*)o = y;
          }
        }
      }
    }
  }
}

template <int C, bool SILU>
DI void ph_conv(const bf16_t* src, bf16_t* dst, const float* cw, const float* cb, const float* state,
                float* out_p, float* out_s) {
  constexpr int GR = C / 8;
  const size_t total = (size_t)T_ * GR;
  for (size_t idx = (size_t)blockIdx.x * NTHR + TIDX; idx < total; idx += (size_t)gridDim.x * NTHR) {
    const int t = (int)(idx / GR), c = (int)(idx % GR) * 8;
    int seq, l, L; tok_info(t, seq, l, L);
    float acc[8]; load8f(cb + c, acc);
    float xcur[8];
#pragma unroll
    for (int jj = 0; jj < 4; ++jj) {
      const int ls = l - 3 + jj;
      float xv[8];
      if (ls >= 0) { unpack8(*(const uint4*)(src + (size_t)(t - 3 + jj) * C + c), xv); }
      else if (seq >= 8) { load8f(state + ((size_t)(seq - 8) * 3 + (ls + 3)) * C + c, xv); }
      else {
#pragma unroll
        for (int e = 0; e < 8; ++e) xv[e] = 0.f;
      }
      float w8[8]; load8f(cw + (size_t)jj * C + c, w8);
#pragma unroll
      for (int e = 0; e < 8; ++e) acc[e] += w8[e] * xv[e];
      if (jj == 3) {
#pragma unroll
        for (int e = 0; e < 8; ++e) xcur[e] = xv[e];
      }
    }
    if (SILU) {
#pragma unroll
      for (int e = 0; e < 8; ++e) acc[e] = siluf_(acc[e]);
    }
    *(uint4*)(dst + (size_t)t * C + c) = pack8(acc);
    if (l >= L - 3) {
      const int r = l - (L - 3);
      float* o = (seq < 8) ? (out_p + ((size_t)seq * 3 + r) * C + c) : (out_s + ((size_t)(seq - 8) * 3 + r) * C + c);
      store8f(o, xcur);
    }
  }
}

DI void ph_lru_scan1(const Params& p) {
  const float* AA = (const float*)(p.ws + SA_AA);
  const float* BB = (const float*)(p.ws + SA_BB);
  float* CP = (float*)(p.ws + SA_CP);
  float* CS = (float*)(p.ws + SA_CS);
  const int total = 8 * 64 * 1024;
  for (int idx = blockIdx.x * NTHR + TIDX; idx < total; idx += gridDim.x * NTHR) {
    const int ch = idx & 1023, c = (idx >> 10) & 63, b = idx >> 16;
    const size_t base = ((size_t)b * 2048 + c * 32) * 1024 + ch;
    float P = 1.f, S = 0.f;
#pragma unroll 8
    for (int s = 0; s < 32; ++s) {
      const float a = AA[base + (size_t)s * 1024], bb = BB[base + (size_t)s * 1024];
      S = a * S + bb; P *= a;
    }
    CP[idx] = P; CS[idx] = S;
  }
}
DI void ph_lru_scan2(const Params& p, int ia) {
  const float* AA = (const float*)(p.ws + SA_AA);
  const float* BB = (const float*)(p.ws + SA_BB);
  const float* CP = (const float*)(p.ws + SA_CP);
  const float* CS = (const float*)(p.ws + SA_CS);
  bf16_t* GT = (bf16_t*)(p.ws + SA_GT);
  const int nP = 8 * 64 * 1024, total = nP + 128 * 1024;
  for (int idx = blockIdx.x * NTHR + TIDX; idx < total; idx += gridDim.x * NTHR) {
    if (idx < nP) {
      const int ch = idx & 1023, c = (idx >> 10) & 63, b = idx >> 16;
      float h = 0.f;
      for (int c2 = 0; c2 < c; ++c2) {
        const int ci = ((b * 64 + c2) << 10) + ch;
        h = CP[ci] * h + CS[ci];
      }
      const size_t base = ((size_t)b * 2048 + c * 32) * 1024 + ch;
#pragma unroll 8
      for (int s = 0; s < 32; ++s) {
        const size_t o = base + (size_t)s * 1024;
        h = AA[o] * h + BB[o];
        GT[o] = f2bf(h * bf2f(GT[o]));
      }
      if (c == 63) p.out[O_LH_P + ((size_t)ia * 8 + b) * 1024 + ch] = h;
    } else {
      const int u = idx - nP; const int ch = u & 1023, s = u >> 10;
      float h = p.in[I_ST_LH][((size_t)ia * 128 + s) * 1024 + ch];
      const size_t base = ((size_t)TP_ + s * 8) * 1024 + ch;
#pragma unroll
      for (int q = 0; q < 8; ++q) {
        const size_t o = base + (size_t)q * 1024;
        h = AA[o] * h + BB[o];
        GT[o] = f2bf(h * bf2f(GT[o]));
      }
      p.out[O_LH_S + ((size_t)ia * 128 + s) * 1024 + ch] = h;
    }
  }
}

DI void ssd_item(const Params& p, char* smem, int seq, int h) {
  const int tid = TIDX, lane = tid & 63, w = tid >> 6, r32 = lane & 31, hh = lane >> 5;
  bf16_t* Cs = (bf16_t*)smem;
  bf16_t* Bs = Cs + 64 * 136;
  bf16_t* Sb = Bs + 64 * 136;
  bf16_t* Xt = Sb + 64 * 136;
  bf16_t* Btr = Xt + 64 * 72;
  float* dts = (float*)(Btr + 128 * 72);
  float* acs = dts + 64;
  bf16_t* Ws = Bs;
  const bf16_t* XBC = (const bf16_t*)(p.ws + SB_XBC);
  const float* DT = (const float*)(p.ws + SB_DT);
  bf16_t* Y = (bf16_t*)(p.ws + SB_Y);
  const bool prompt = seq < 8;
  const int nchunk = prompt ? 32 : 1, Lv = prompt ? 64 : 8;
  const int tbase = prompt ? seq * 2048 : TP_ + (seq - 8) * 8;
  const int g = h >> 2;
  const float Ah = -__expf(p.in[I_SSM_ALOG][h]);
  const float Dh = p.in[I_SSM_D][h];
  f32x16 accS[2];
  {
    const float* s0 = p.in[I_ST_SS] + ((size_t)(seq - 8) * 32 + h) * 64 * 128;
#pragma unroll
    for (int mi = 0; mi < 2; ++mi)
#pragma unroll
      for (int r = 0; r < 16; ++r) {
        const int prow = mi * 32 + (r & 3) + 8 * (r >> 2) + 4 * hh, n = 32 * w + r32;
        accS[mi][r] = prompt ? 0.f : s0[(size_t)prow * 128 + n];
      }
  }
  __syncthreads();
#pragma unroll
  for (int mi = 0; mi < 2; ++mi)
#pragma unroll
    for (int r = 0; r < 16; ++r) {
      const int prow = mi * 32 + (r & 3) + 8 * (r >> 2) + 4 * hh, n = 32 * w + r32;
      Sb[prow * 136 + n] = f2bf(accS[mi][r]);
    }
  for (int c = 0; c < nchunk; ++c) {
    const int t0 = tbase + c * 64;
    __syncthreads();
    if (tid < 64) {
      const float dtv = (tid < Lv) ? DT[(size_t)(t0 + tid) * 32 + h] : 0.f;
      float x = dtv * Ah;
#pragma unroll
      for (int o = 1; o < 64; o <<= 1) { const float y = __shfl_up(x, o, 64); if (lane >= o) x += y; }
      dts[tid] = dtv; acs[tid] = x;
    }
    __syncthreads();
    const float aend = acs[63];
#pragma unroll
    for (int i = 0; i < 4; ++i) {
      const int id = tid + 256 * i, row = id >> 4, ch = id & 15;
      uint4 cv = make_uint4(0, 0, 0, 0), bv = make_uint4(0, 0, 0, 0);
      if (row < Lv) {
        const bf16_t* src = XBC + (size_t)(t0 + row) * 4096 + g * 128 + ch * 8;
        bv = *(const uint4*)(src + 2048);
        cv = *(const uint4*)(src + 3072);
      }
      *(uint4*)(Cs + row * 136 + ch * 8) = cv;
      *(uint4*)(Bs + row * 136 + ch * 8) = bv;
      float f[8]; unpack8(bv, f);
      const float sc = __expf(aend - acs[row]);
#pragma unroll
      for (int e = 0; e < 8; ++e) Btr[(ch * 8 + e) * 72 + row] = f2bf(f[e] * sc);
    }
#pragma unroll
    for (int i = 0; i < 2; ++i) {
      const int id = tid + 256 * i, row = id >> 3, ch = id & 7;
      uint4 xv = make_uint4(0, 0, 0, 0);
      if (row < Lv) xv = *(const uint4*)(XBC + (size_t)(t0 + row) * 4096 + h * 64 + ch * 8);
      float f[8]; unpack8(xv, f);
      const float sc = dts[row];
#pragma unroll
      for (int e = 0; e < 8; ++e) Xt[(ch * 8 + e) * 72 + row] = f2bf(f[e] * sc);
    }
    __syncthreads();
    const int it = w >> 1, jt = w & 1;
    f32x16 cb;
#pragma unroll
    for (int r = 0; r < 16; ++r) cb[r] = 0.f;
    if (jt <= it) {
#pragma unroll
      for (int ks = 0; ks < 8; ++ks) {
        bf16x8 a = *(const bf16x8*)(Cs + (it * 32 + r32) * 136 + ks * 16 + hh * 8);
        bf16x8 b = *(const bf16x8*)(Bs + (jt * 32 + r32) * 136 + ks * 16 + hh * 8);
        cb = mfma32(a, b, cb);
      }
    }
    __syncthreads();
    {
      const int jj = jt * 32 + r32; const float aj = acs[jj];
#pragma unroll
      for (int r = 0; r < 16; ++r) {
        const int ii = it * 32 + (r & 3) + 8 * (r >> 2) + 4 * hh;
        const float v = (jj <= ii) ? cb[r] * __expf(acs[ii] - aj) : 0.f;
        Ws[ii * 72 + jj] = f2bf(v);
      }
    }
    __syncthreads();
    {
      const int pt = w & 1;
      f32x16 yd, yo;
#pragma unroll
      for (int r = 0; r < 16; ++r) { yd[r] = 0.f; yo[r] = 0.f; }
#pragma unroll
      for (int ks = 0; ks < 4; ++ks) {
        bf16x8 a = *(const bf16x8*)(Ws + (it * 32 + r32) * 72 + ks * 16 + hh * 8);
        bf16x8 b = *(const bf16x8*)(Xt + (pt * 32 + r32) * 72 + ks * 16 + hh * 8);
        yd = mfma32(a, b, yd);
      }
#pragma unroll
      for (int ks = 0; ks < 8; ++ks) {
        bf16x8 a = *(const bf16x8*)(Cs + (it * 32 + r32) * 136 + ks * 16 + hh * 8);
        bf16x8 b = *(const bf16x8*)(Sb + (pt * 32 + r32) * 136 + ks * 16 + hh * 8);
        yo = mfma32(a, b, yo);
      }
      const int pp = pt * 32 + r32;
#pragma unroll
      for (int r = 0; r < 16; ++r) {
        const int ii = it * 32 + (r & 3) + 8 * (r >> 2) + 4 * hh;
        if (ii < Lv) {
          const size_t t = (size_t)(t0 + ii);
          const float xv = bf2f(XBC[t * 4096 + h * 64 + pp]);
          const float yv = yd[r] + __expf(acs[ii]) * yo[r] + Dh * xv;
          Y[t * 2048 + h * 64 + pp] = f2bf(yv);
        }
      }
    }
    {
      const float dec = __expf(aend);
#pragma unroll
      for (int mi = 0; mi < 2; ++mi)
#pragma unroll
        for (int r = 0; r < 16; ++r) accS[mi][r] *= dec;
#pragma unroll
      for (int ks = 0; ks < 4; ++ks) {
        bf16x8 b = *(const bf16x8*)(Btr + (32 * w + r32) * 72 + ks * 16 + hh * 8);
        bf16x8 a0 = *(const bf16x8*)(Xt + (r32) * 72 + ks * 16 + hh * 8);
        bf16x8 a1 = *(const bf16x8*)(Xt + (32 + r32) * 72 + ks * 16 + hh * 8);
        accS[0] = mfma32(a0, b, accS[0]);
        accS[1] = mfma32(a1, b, accS[1]);
      }
    }
    __syncthreads();
#pragma unroll
    for (int mi = 0; mi < 2; ++mi)
#pragma unroll
      for (int r = 0; r < 16; ++r) {
        const int prow = mi * 32 + (r & 3) + 8 * (r >> 2) + 4 * hh, n = 32 * w + r32;
        Sb[prow * 136 + n] = f2bf(accS[mi][r]);
      }
  }
  float* dst = prompt ? (p.out + O_SS_P + ((size_t)seq * 32 + h) * 64 * 128)
                      : (p.out + O_SS_S + ((size_t)(seq - 8) * 32 + h) * 64 * 128);
#pragma unroll
  for (int mi = 0; mi < 2; ++mi)
#pragma unroll
    for (int r = 0; r < 16; ++r) {
      const int prow = mi * 32 + (r & 3) + 8 * (r >> 2) + 4 * hh, n = 32 * w + r32;
      dst[(size_t)prow * 128 + n] = accS[mi][r];
    }
}

DI void ph_ssd(const Params& p, char* smem) {
  const int G = gridDim.x, bid = blockIdx.x;
  int it = bid, step = G;
  if (G >= 512) { if (bid < 256) { step = 1 << 30; } else { step = G - 256; } }
#pragma nounroll
  for (; it < 256 + 4096; it += step) {
    const int seq = (it < 256) ? (it >> 5) : (8 + ((it - 256) >> 5));
    ssd_item(p, smem, seq, it & 31);
  }
}

DI void ph_gnorm(const Params& p) {
  const int tid_ = TIDX; const int lane = tid_ & 63;
  const int gw = blockIdx.x * 4 + (tid_ >> 6), nw = gridDim.x * 4;
  bf16_t* Y = (bf16_t*)(p.ws + SB_Y);
  const float* nwt = p.in[I_SSM_NW];
  for (int item = gw; item < T_ * 8; item += nw) {
    const int t = item >> 3, g = item & 7;
    bf16_t* yp = Y + (size_t)t * 2048 + g * 256 + lane * 4;
    const uint2 v = *(const uint2*)yp;
    const float f0 = __uint_as_float(v.x << 16), f1 = __uint_as_float(v.x & 0xFFFF0000u);
    const float f2 = __uint_as_float(v.y << 16), f3 = __uint_as_float(v.y & 0xFFFF0000u);
    const float ss = wave_sum(f0 * f0 + f1 * f1 + f2 * f2 + f3 * f3);
    const float rstd = rsqrtf(ss * (1.f / 256.f) + 1e-5f);
    const float4 wv = *(const float4*)(nwt + g * 256 + lane * 4);
    *(uint2*)yp = make_uint2(pack2(f0 * rstd * wv.x, f1 * rstd * wv.y), pack2(f2 * rstd * wv.z, f3 * rstd * wv.w));
  }
}

template <int LPR>
DI void wkv_item(const Params& p, char* smem, int seq, int head, int part) {
  constexpr int ROWS = 256 / LPR, KPL = 64 / LPR;
  const int tid = TIDX;
  float* sR = (float*)smem;
  float* sK = sR + 2048;
  float* sKK = sK + 2048;
  float* sBB = sKK + 2048;
  float* sW = sBB + 2048;
  float* sV = sW + 2048;
  float* sO = sV + 2048;
  const bf16_t* R = (const bf16_t*)(p.ws + SC_R);
  const bf16_t* K = (const bf16_t*)(p.ws + SC_K);
  const bf16_t* V = (const bf16_t*)(p.ws + SC_V);
  const bf16_t* AAc = (const bf16_t*)(p.ws + SC_AA);
  const float* WD = (const float*)(p.ws + SC_WD);
  bf16_t* O = (bf16_t*)(p.ws + SC_O);
  const bool prompt = seq < 8;
  const int nch = prompt ? 64 : 1, nvalid = prompt ? 32 : 8;
  const int tbase = prompt ? seq * 2048 : TP_ + (seq - 8) * 8;
  const int row_l = tid / LPR, q = tid % LPR, row = part * ROWS + row_l;
  float S[KPL];
  {
    const float* s0 = p.in[I_ST_RW] + (((size_t)(seq - 8) * 16 + head) * 64 + row) * 64 + q * KPL;
#pragma unroll
    for (int e = 0; e < KPL; ++e) S[e] = prompt ? 0.f : s0[e];
  }
  const int pst = tid >> 3, pk0 = (tid & 7) * 8, pcol = head * 64 + pk0;
  float kk8[8], ka8[8];
  load8f(p.in[I_RW_KK] + pcol, kk8);
  load8f(p.in[I_RW_KA] + pcol, ka8);
  for (int c = 0; c < nch; ++c) {
    const int t0 = tbase + c * 32;
    __syncthreads();
    if (pst < nvalid) {
      const size_t o = (size_t)(t0 + pst) * 1024 + pcol;
      float r8[8], k8[8], v8[8], a8[8], w8[8];
      unpack8(*(const uint4*)(R + o), r8);
      unpack8(*(const uint4*)(K + o), k8);
      unpack8(*(const uint4*)(V + o), v8);
      unpack8(*(const uint4*)(AAc + o), a8);
      load8f(WD + o, w8);
      float kr[8], ss = 0.f;
#pragma unroll
      for (int e = 0; e < 8; ++e) { kr[e] = k8[e] * kk8[e]; ss += kr[e] * kr[e]; }
      ss = red_lanes<8>(ss);
      const float inv = 1.f / fmaxf(sqrtf(ss), 1e-12f);
      float kp[8], bb[8];
#pragma unroll
      for (int e = 0; e < 8; ++e) { kr[e] *= inv; kp[e] = k8[e] * (1.f + (a8[e] - 1.f) * ka8[e]); bb[e] = kr[e] * a8[e]; }
      const int lo = pst * 64 + pk0;
      store8f(sR + lo, r8); store8f(sK + lo, kp); store8f(sKK + lo, kr); store8f(sBB + lo, bb);
      store8f(sW + lo, w8); store8f(sV + lo, v8);
    }
    __syncthreads();
    for (int st = 0; st < nvalid; ++st) {
      const int lo = st * 64 + q * KPL;
      float kk[KPL], ww[KPL], bb[KPL], kp[KPL], rr[KPL];
#pragma unroll
      for (int e = 0; e < KPL; e += 4) {
        const float4 a = *(const float4*)(sKK + lo + e); kk[e] = a.x; kk[e + 1] = a.y; kk[e + 2] = a.z; kk[e + 3] = a.w;
        const float4 b = *(const float4*)(sW + lo + e); ww[e] = b.x; ww[e + 1] = b.y; ww[e + 2] = b.z; ww[e + 3] = b.w;
        const float4 d = *(const float4*)(sBB + lo + e); bb[e] = d.x; bb[e + 1] = d.y; bb[e + 2] = d.z; bb[e + 3] = d.w;
        const float4 f = *(const float4*)(sK + lo + e); kp[e] = f.x; kp[e + 1] = f.y; kp[e + 2] = f.z; kp[e + 3] = f.w;
        const float4 g = *(const float4*)(sR + lo + e); rr[e] = g.x; rr[e + 1] = g.y; rr[e + 2] = g.z; rr[e + 3] = g.w;
      }
      const float vv = sV[st * 64 + row];
      float sa = 0.f;
#pragma unroll
      for (int e = 0; e < KPL; ++e) sa += S[e] * kk[e];
      sa = red_lanes<LPR>(sa);
      float oo = 0.f;
#pragma unroll
      for (int e = 0; e < KPL; ++e) {
        S[e] = S[e] * ww[e] - sa * bb[e] + vv * kp[e];
        oo += S[e] * rr[e];
      }
      oo = red_lanes<LPR>(oo);
      if (q == 0) sO[st * ROWS + row_l] = oo;
    }
    __syncthreads();
    for (int i = tid; i < nvalid * ROWS; i += NTHR) {
      const int st = i / ROWS, rr = i % ROWS;
      O[(size_t)(t0 + st) * 1024 + head * 64 + part * ROWS + rr] = f2bf(sO[i]);
    }
  }
  float* dst = prompt ? (p.out + O_RW_P + (((size_t)seq * 16 + head) * 64 + row) * 64 + q * KPL)
                      : (p.out + O_RW_S + (((size_t)(seq - 8) * 16 + head) * 64 + row) * 64 + q * KPL);
#pragma unroll
  for (int e = 0; e < KPL; ++e) dst[e] = S[e];
}

template <int LPR>
DI void ph_wkv(const Params& p, char* smem) {
  constexpr int NPART = 64 / (256 / LPR);
  const int G = gridDim.x, bid = blockIdx.x;
  const int nP = 128 * NPART, nS = 2048 * NPART;
  for (int it = bid; it < nP + nS; it += G) {
    int seq, head, part;
    if (it < nP) { part = it % NPART; const int sh = it / NPART; seq = sh >> 4; head = sh & 15; }
    else { const int u = it - nP; part = u % NPART; const int sh = u / NPART; seq = 8 + (sh >> 4); head = sh & 15; }
    wkv_item<LPR>(p, smem, seq, head, part);
  }
}

DI void ph_wkv_post(const Params& p) {
  const int tid_ = TIDX; const int lane = tid_ & 63;
  const int gw = blockIdx.x * 4 + (tid_ >> 6), nw = gridDim.x * 4;
  const bf16_t* R = (const bf16_t*)(p.ws + SC_R);
  const bf16_t* K = (const bf16_t*)(p.ws + SC_K);
  const bf16_t* V = (const bf16_t*)(p.ws + SC_V);
  const bf16_t* AAc = (const bf16_t*)(p.ws + SC_AA);
  const bf16_t* Gg = (const bf16_t*)(p.ws + SC_G);
  const bf16_t* O = (const bf16_t*)(p.ws + SC_O);
  bf16_t* U = (bf16_t*)(p.ws + W_U);
  for (int item = gw; item < T_ * 16; item += nw) {
    const int t = item >> 4, head = item & 15, col = head * 64 + lane;
    const size_t o = (size_t)t * 1024 + col;
    const float ov = bf2f(O[o]);
    const float mean = wave_sum(ov) * (1.f / 64.f);
    const float d = ov - mean;
    const float var = wave_sum(d * d) * (1.f / 64.f);
    const float on = d * rsqrtf(var + 64e-5f) * p.in[I_RW_LNW][col] + p.in[I_RW_LNB][col];
    const float r = bf2f(R[o]), k = bf2f(K[o]), a = bf2f(AAc[o]), v = bf2f(V[o]);
    const float kp = k * (1.f + (a - 1.f) * p.in[I_RW_KA][col]);
    const float s = wave_sum(r * kp * p.in[I_RW_RK][col]);
    U[o] = f2bf((on + s * v) * bf2f(Gg[o]));
  }
}

constexpr int NPH = 40;
#ifndef REP_GEMM
#define REP_GEMM 1
#endif
#ifndef REP_SSD
#define REP_SSD 1
#endif
#ifndef REP_WKV
#define REP_WKV 1
#endif
#ifndef REP_MISC
#define REP_MISC 1
#endif

__global__ void __launch_bounds__(NTHR, 2) mega(Params p) {
  __shared__ __attribute__((aligned(16))) char smem[SMEM_BYTES];
  __shared__ uint4 xb_words;
  cg::grid_group grid = cg::this_grid();
  if (threadIdx.x == 0) xb_words = make_uint4(0u, 0u, 0u, 0u);
  __syncthreads();
  XcdBarrier xb = xcd_barrier_post((unsigned*)(p.ws + W_BAR), (volatile LAS unsigned*)&xb_words);
  int ph = 0;
#define PH(...)                                                     \
  {                                                                 \
    if (ph >= p.ph_begin && ph < p.ph_end) {                        \
      __VA_ARGS__;                                                  \
      xcd_barrier(xb);                                              \
    }                                                               \
    ++ph;                                                           \
  }
#define PHR(rep, ...)                                               \
  {                                                                 \
    if (ph >= p.ph_begin && ph < p.ph_end) {                        \
      for (int rep_ = 0; rep_ < (rep); ++rep_) {                    \
        __VA_ARGS__;                                                \
        xcd_barrier(xb);                                            \
      }                                                             \
    }                                                               \
    ++ph;                                                           \
  }
#define PH_LAST(...)                                                \
  {                                                                 \
    if (ph >= p.ph_begin && ph < p.ph_end) { __VA_ARGS__; }         \
    ++ph;                                                           \
  }
  bf16_t* wt = (bf16_t*)(p.ws + W_WT);
  bf16_t* U = (bf16_t*)(p.ws + W_U);
  float* X = (float*)(p.ws + W_X);

  {
    if (ph >= p.ph_begin && ph < p.ph_end) { ph_prologue(p, smem); grid.sync(); }
    ++ph;
  }

#pragma nounroll
  for (int layer = 0; layer < 4; ++layer) {
    const int kind = layer % 3;
    PHR(REP_MISC, ph_rmsnorm(p, kind == 2 ? 1 : 0, p.in[I_NMIX] + layer * 1024));
    if (kind == 0) {
      const int ia = layer / 3;
      PHR(REP_GEMM, {
        GJob j = mkjob(U, 1024, wt + WA_IN + (size_t)ia * 2048 * 1024, 1024, 1024, 2048);
        j.o0 = p.ws + SA_XB; j.o1 = p.ws + SA_GT;
        int toff = 0; gemm_run<EPI_LRU_IN, false>(j, 16, toff, smem);
      });
      PHR(REP_MISC, (ph_conv<1024, false>((const bf16_t*)(p.ws + SA_XB), (bf16_t*)(p.ws + SA_XC),
                               p.in[I_LRU_CW] + (size_t)ia * 4 * 1024, p.in[I_LRU_CB] + (size_t)ia * 1024,
                               p.in[I_ST_LC] + (size_t)ia * 128 * 3 * 1024,
                               p.out + O_LC_P + (size_t)ia * 8 * 3 * 1024, p.out + O_LC_S + (size_t)ia * 128 * 3 * 1024)));
      PHR(REP_GEMM, {
        const int G = gridDim.x;
        for (int tile = blockIdx.x; tile < MT_ * 16; tile += G) {
          const int mt = tile >> 4, jt = tile & 15;
          GJob j = mkjob((const bf16_t*)(p.ws + SA_XC) + (jt >> 1) * 128, 1024,
                         wt + WA_G + (size_t)ia * 2048 * 128, 128, 128, 2048);
          j.o0 = p.ws + SA_AA; j.o1 = p.ws + SA_XC;
          j.x0 = p.in[I_LRU_BR] + ia * 1024; j.x1 = p.in[I_LRU_BI] + ia * 1024; j.x2 = p.in[I_LRU_LAM] + ia * 1024;
          gemm_tile<EPI_GATES, false>(j, mt * 128, jt * 128, 0, 2, smem);
        }
      });
      PHR(REP_MISC, ph_lru_scan1(p));
      PH(ph_lru_scan2(p, ia));
      PH({
        GJob j = mkjob((const bf16_t*)(p.ws + SA_GT), 1024, wt + WA_OUT + (size_t)ia * 1024 * 1024, 1024, 1024, 1024);
        j.o0 = X;
        gemm_streamk<EPI_RESID>(j, 8, smem);
      });
    } else if (kind == 1) {
      PHR(REP_GEMM, {
        GJob j = mkjob(U, 1024, wt + WB_XBC, 1024, 1024, 4128);
        j.o0 = p.ws + SB_XBCP; j.o1 = p.ws + SB_DT; j.x0 = p.in[I_SSM_DTB];
        int toff = 0; gemm_run<EPI_SSM_XBC, false>(j, 33, toff, smem);
      });
      PHR(REP_MISC, (ph_conv<4096, true>((const bf16_t*)(p.ws + SB_XBCP), (bf16_t*)(p.ws + SB_XBC),
                              p.in[I_SSM_CW], p.in[I_SSM_CB], p.in[I_ST_SC],
                              p.out + O_SC_P, p.out + O_SC_S)));
      PHR(REP_SSD, ph_ssd(p, smem));
      PH({
        GJob j = mkjob(U, 1024, wt + WB_Z, 1024, 1024, 2048);
        j.o0 = p.ws + SB_Y;
        int toff = 0; gemm_run<EPI_SSM_Z, false>(j, 16, toff, smem);
      });
      PH(ph_gnorm(p));
      PH({
        GJob j = mkjob((const bf16_t*)(p.ws + SB_Y), 2048, wt + WB_OUT, 2048, 2048, 1024);
        j.o0 = X;
        gemm_streamk<EPI_RESID>(j, 8, smem);
      });
    } else {
      PHR(REP_GEMM, {
        int toff = 0;
        for (int s = 0; s < 3; ++s) {
          GJob j = mkjob(U, 1024, wt + WC_RKV + (size_t)s * 1024 * 1024, 1024, 1024, 1024);
          j.A2 = (const bf16_t*)(p.ws + SC_UP); j.mu = p.in[I_RW_MU] + s * 1024;
          j.o0 = p.ws + SC_R + (size_t)s * SZ_TD2; j.ldo = 1024; j.act = 0;
          gemm_run<EPI_ST, true>(j, 8, toff, smem);
        }
        for (int s = 0; s < 3; ++s) {
          const int nv = (s == 2) ? 128 : 64;
          GJob j = mkjob(U, 1024, wt + WC_L1 + (size_t)s * 64 * 1024, 1024, 1024, nv);
          j.A2 = (const bf16_t*)(p.ws + SC_UP); j.mu = p.in[I_RW_MU] + (3 + s) * 1024;
          j.o0 = p.ws + SC_LH + (size_t)s * 64 * 2; j.ldo = 256; j.act = (s == 0) ? 1 : (s == 2 ? 2 : 0);
          gemm_run<EPI_ST, true>(j, 1, toff, smem);
        }
      });
      PHR(REP_GEMM, {
        int toff = 0;
        const bf16_t* LH = (const bf16_t*)(p.ws + SC_LH);
        {
          GJob j = mkjob(LH, 256, wt + WC_W2, 64, 64, 1024);
          j.o0 = p.ws + SC_WD; j.x0 = p.in[I_RW_W0];
          gemm_run<EPI_DECAY, false>(j, 8, toff, smem);
        }
        {
          GJob j = mkjob(LH + 64, 256, wt + WC_A2, 64, 64, 1024);
          j.o0 = p.ws + SC_AA; j.x0 = p.in[I_RW_A0];
          gemm_run<EPI_SIGB, false>(j, 8, toff, smem);
        }
        {
          GJob j = mkjob(LH + 128, 256, wt + WC_G2, 128, 128, 1024);
          j.o0 = p.ws + SC_G; j.ldo = 1024; j.act = 0;
          gemm_run<EPI_ST, false>(j, 8, toff, smem);
        }
      });
      PHR(REP_WKV, ph_wkv<8>(p, smem));
      PHR(REP_MISC, ph_wkv_post(p));
      PH({
        GJob j = mkjob(U, 1024, wt + WC_OUT, 1024, 1024, 1024);
        j.o0 = X;
        gemm_streamk<EPI_RESID>(j, 8, smem);
      });
    }
    PHR(REP_MISC, ph_rmsnorm(p, 0, p.in[I_NFFN] + layer * 1024));
    PHR(REP_GEMM, {
      GJob j = mkjob(U, 1024, wt + WF_1 + (size_t)layer * 4096 * 1024, 1024, 1024, 4096);
      j.o0 = p.ws + S_HB;
      int toff = 0; gemm_run<EPI_FFN1, false>(j, 32, toff, smem);
    });
    PH({
      GJob j = mkjob((const bf16_t*)(p.ws + S_HB), 4096, wt + WF_2 + (size_t)layer * 4096 * 1024, 4096, 4096, 1024);
      j.o0 = X;
      gemm_streamk<EPI_RESID>(j, 8, smem);
    });
  }
  PH_LAST(ph_rmsnorm(p, 2, p.in[I_NFIN]));
#undef PH
#undef PH_LAST
}

extern "C" void kernel_launch(void* const* d_in, const int* in_sizes, int n_in, void* d_out, int out_size,
                              void* d_ws, size_t ws_size, hipStream_t stream) {
  Params p;
  memset(&p, 0, sizeof(p));
  for (int i = 0; i < N_IN; ++i) p.in[i] = (const float*)d_in[i];
  p.out = (float*)d_out;
  p.ws = (char*)d_ws;
  p.ph_begin = 0;
  p.ph_end = 1000;
  static int grid_blocks = 0;
  if (!grid_blocks) {
    int dev = 0, cus = 0, per_cu = 0;
    hipGetDevice(&dev);
    hipDeviceGetAttribute(&cus, hipDeviceAttributeMultiprocessorCount, dev);
    hipOccupancyMaxActiveBlocksPerMultiprocessor(&per_cu, mega, NTHR, 0);
    if (per_cu > 2) per_cu = 2;
    if (per_cu < 1) per_cu = 1;
    grid_blocks = cus * per_cu;
  }
  if (ws_size < (size_t)536870912) fprintf(stderr, "workspace too small: %zu\n", ws_size);
  (void)hipMemsetAsync((char*)d_ws + W_BAR, 0, XCD_BAR_WORDS * 4, stream);
  void* args[] = {&p};
  hipError_t e = hipLaunchCooperativeKernel((void*)mega, dim3(grid_blocks), dim3(NTHR), args, 0, stream);
  if (e != hipSuccess) fprintf(stderr, "cooperative launch failed: %s (grid %d)\n", hipGetErrorString(e), grid_blocks);
}
```

```cpp
#include <hip/hip_runtime.h>
#include <hip/hip_cooperative_groups.h>
#include <stdint.h>
#include <stdio.h>
#include <string.h>
namespace cg = cooperative_groups;

typedef unsigned short bf16_t;
typedef __attribute__((ext_vector_type(8))) short bf16x8;
typedef __attribute__((ext_vector_type(16))) float f32x16;

#define DI __device__ __forceinline__

constexpr int T_ = 17408;
constexpr int TP_ = 16384;
constexpr int NTHR = 256;
constexpr int MT_ = T_ / 128;

enum {
  I_XP = 0, I_XS, I_ST_LC, I_ST_LH, I_ST_SC, I_ST_SS, I_ST_RS, I_ST_RW,
  I_NMIX, I_NFFN, I_NFIN,
  I_LRU_WIN, I_LRU_CW, I_LRU_CB, I_LRU_WR, I_LRU_BR, I_LRU_WI, I_LRU_BI, I_LRU_LAM, I_LRU_WOUT,
  I_SSM_WIN, I_SSM_CW, I_SSM_CB, I_SSM_DTB, I_SSM_ALOG, I_SSM_D, I_SSM_NW, I_SSM_WOUT,
  I_RW_MU, I_RW_WRKV, I_RW_W0, I_RW_WW1, I_RW_WW2, I_RW_A0, I_RW_WA1, I_RW_WA2, I_RW_WG1, I_RW_WG2,
  I_RW_KK, I_RW_KA, I_RW_RK, I_RW_LNW, I_RW_LNB, I_RW_WOUT,
  I_FFN_W1, I_FFN_W2, N_IN
};

constexpr size_t O_Y = 0;
constexpr size_t O_LC_P = O_Y + (size_t)T_ * 1024;
constexpr size_t O_LC_S = O_LC_P + 2 * 8 * 3 * 1024;
constexpr size_t O_LH_P = O_LC_S + 2 * 128 * 3 * 1024;
constexpr size_t O_LH_S = O_LH_P + 2 * 8 * 1024;
constexpr size_t O_SC_P = O_LH_S + 2 * 128 * 1024;
constexpr size_t O_SC_S = O_SC_P + 8 * 3 * 4096;
constexpr size_t O_SS_P = O_SC_S + 128 * 3 * 4096;
constexpr size_t O_SS_S = O_SS_P + (size_t)8 * 32 * 64 * 128;
constexpr size_t O_RS_P = O_SS_S + (size_t)128 * 32 * 64 * 128;
constexpr size_t O_RS_S = O_RS_P + 8 * 1024;
constexpr size_t O_RW_P = O_RS_S + 128 * 1024;
constexpr size_t O_RW_S = O_RW_P + 8 * 16 * 64 * 64;

constexpr size_t W_X = 0;
constexpr size_t W_U = W_X + (size_t)T_ * 1024 * 4;
constexpr size_t W_WT = W_U + (size_t)T_ * 1024 * 2;
constexpr size_t WA_IN = 0;
constexpr size_t WA_G = WA_IN + 2 * 2048 * 1024;
constexpr size_t WA_OUT = WA_G + 2 * 2048 * 128;
constexpr size_t WB_XBC = WA_OUT + 2 * 1024 * 1024;
constexpr size_t WB_Z = WB_XBC + 4128 * 1024;
constexpr size_t WB_OUT = WB_Z + 2048 * 1024;
constexpr size_t WC_RKV = WB_OUT + 1024 * 2048;
constexpr size_t WC_L1 = WC_RKV + 3 * 1024 * 1024;
constexpr size_t WC_W2 = WC_L1 + 256 * 1024;
constexpr size_t WC_A2 = WC_W2 + 1024 * 64;
constexpr size_t WC_G2 = WC_A2 + 1024 * 64;
constexpr size_t WC_OUT = WC_G2 + 1024 * 128;
constexpr size_t WF_1 = WC_OUT + 1024 * 1024;
constexpr size_t WF_2 = WF_1 + (size_t)4 * 4096 * 1024;
constexpr size_t W_WT_ELEMS = WF_2 + (size_t)4 * 4096 * 1024;
constexpr size_t W_S = W_WT + W_WT_ELEMS * 2;
constexpr size_t SZ_TD2 = (size_t)T_ * 1024 * 2;
constexpr size_t SZ_TD4 = (size_t)T_ * 1024 * 4;
constexpr size_t S_HB = W_S;
constexpr size_t SA_XB = W_S;
constexpr size_t SA_GT = SA_XB + SZ_TD2;
constexpr size_t SA_XC = SA_GT + SZ_TD2;
constexpr size_t SA_AA = SA_XC + SZ_TD2;
constexpr size_t SA_BB = SA_AA + SZ_TD4;
constexpr size_t SA_CP = SA_BB + SZ_TD4;
constexpr size_t SA_CS = SA_CP + 8 * 64 * 1024 * 4;
constexpr size_t SB_XBCP = W_S;
constexpr size_t SB_Y = W_S;
constexpr size_t SB_XBC = SB_XBCP + SZ_TD2 * 4;
constexpr size_t SB_DT = SB_XBC + SZ_TD2 * 4;
constexpr size_t SC_UP = W_S;
constexpr size_t SC_O = W_S;
constexpr size_t SC_R = SC_UP + SZ_TD2;
constexpr size_t SC_K = SC_R + SZ_TD2;
constexpr size_t SC_V = SC_K + SZ_TD2;
constexpr size_t SC_LH = SC_V + SZ_TD2;
constexpr size_t SC_WD = SC_LH + (size_t)T_ * 256 * 2;
constexpr size_t SC_AA = SC_WD + SZ_TD4;
constexpr size_t SC_G = SC_AA + SZ_TD2;
constexpr size_t SC_END = SC_G + SZ_TD2;
static_assert(SC_END <= (size_t)536870912, "ws overflow C");
static_assert(SB_DT + (size_t)T_ * 32 * 4 <= (size_t)536870912, "ws overflow B");
static_assert(SA_CS + 8 * 64 * 1024 * 4 <= (size_t)536870912, "ws overflow A");

constexpr int SMEM_BYTES = 80384;
constexpr size_t W_BAR = (size_t)536870912 - 65536;

struct Params {
  const float* in[N_IN];
  float* out;
  char* ws;
  int ph_begin, ph_end;
};

DI float bf2f(bf16_t h) { return __uint_as_float(((unsigned)h) << 16); }
DI bf16_t f2bf(float f) {
  unsigned u = __float_as_uint(f);
  u += 0x7FFFu + ((u >> 16) & 1u);
  return (bf16_t)(u >> 16);
}
DI unsigned pack2(float a, float b) { return (unsigned)f2bf(a) | ((unsigned)f2bf(b) << 16); }
DI void unpack8(const uint4 v, float (&f)[8]) {
  f[0] = __uint_as_float(v.x << 16); f[1] = __uint_as_float(v.x & 0xFFFF0000u);
  f[2] = __uint_as_float(v.y << 16); f[3] = __uint_as_float(v.y & 0xFFFF0000u);
  f[4] = __uint_as_float(v.z << 16); f[5] = __uint_as_float(v.z & 0xFFFF0000u);
  f[6] = __uint_as_float(v.w << 16); f[7] = __uint_as_float(v.w & 0xFFFF0000u);
}
DI uint4 pack8(const float (&f)[8]) {
  return make_uint4(pack2(f[0], f[1]), pack2(f[2], f[3]), pack2(f[4], f[5]), pack2(f[6], f[7]));
}
DI void load8f(const float* p, float (&f)[8]) {
  float4 a = *(const float4*)p, b = *(const float4*)(p + 4);
  f[0] = a.x; f[1] = a.y; f[2] = a.z; f[3] = a.w; f[4] = b.x; f[5] = b.y; f[6] = b.z; f[7] = b.w;
}
DI void store8f(float* p, const float (&f)[8]) {
  *(float4*)p = make_float4(f[0], f[1], f[2], f[3]);
  *(float4*)(p + 4) = make_float4(f[4], f[5], f[6], f[7]);
}
DI float sigmoidf_(float x) { return 1.f / (1.f + __expf(-x)); }
DI float siluf_(float x) { return x / (1.f + __expf(-x)); }
DI float tanhf_(float y) { return 1.f - 2.f / (1.f + __expf(2.f * y)); }
DI float geluf_(float x) { return 0.5f * x * (1.f + tanhf_(0.7978845608028654f * (x + 0.044715f * x * x * x))); }
DI float softplusf_(float x) { return fmaxf(x, 0.f) + log1pf(__expf(-fabsf(x))); }
DI float wave_sum(float v) {
#pragma unroll
  for (int o = 32; o >= 1; o >>= 1) v += __shfl_xor(v, o, 64);
  return v;
}
template <int CTRL> DI float dppf(float x) {
  return __int_as_float(__builtin_amdgcn_update_dpp(0, __float_as_int(x), CTRL, 0xf, 0xf, false));
}
template <int N> DI float red_lanes(float x) {
  x += dppf<0xB1>(x);
  x += dppf<0x4E>(x);
  if (N >= 8) x += dppf<0x141>(x);
  if (N >= 16) x += dppf<0x140>(x);
  return x;
}
DI void tok_info(int t, int& seq, int& l, int& L) {
  if (t < TP_) { seq = t >> 11; l = t & 2047; L = 2048; }
  else { int u = t - TP_; seq = 8 + (u >> 3); l = u & 7; L = 8; }
}
DI int opq(int x) { asm volatile("" : "+v"(x)); return x; }
#define TIDX opq((int)threadIdx.x)
DI f32x16 mfma32(bf16x8 a, bf16x8 b, f32x16 c) { return __builtin_amdgcn_mfma_f32_32x32x16_bf16(a, b, c, 0, 0, 0); }


#define XB_TMO      128
#define XB_XCNT(j)  (256  + 64 * (j))
#define XB_XSUB(j)  (1280 + 64 * (j))
#define XB_XGEN(j)  (2304 + 64 * (j))
#define XB_TOP      3328
#define XB_TOPGEN   3392
#define XCD_BAR_WORDS 3456
#define XB_SPIN_CAP (1u << 22)
#define LAS __attribute__((address_space(3)))
DI unsigned xb_ld(unsigned* p) { return __hip_atomic_load(p, __ATOMIC_RELAXED, __HIP_MEMORY_SCOPE_AGENT); }
DI unsigned xb_add(unsigned* p, unsigned v) { return __hip_atomic_fetch_add(p, v, __ATOMIC_RELAXED, __HIP_MEMORY_SCOPE_AGENT); }
DI unsigned xb_xcc_id() { return (unsigned)__builtin_amdgcn_s_getreg((3 << 11) | 20) & 0xFu; }
#define XB_SPIN(cond, bar) do { unsigned _sp = 0; while (cond) { __builtin_amdgcn_s_sleep(1); \
    if ((++_sp & 255u) == 0u) { if (xb_ld(&(bar)[XB_TMO])) break; if (_sp > XB_SPIN_CAP) { atomicAdd(&(bar)[XB_TMO], 1u); break; } } } } while (0)
struct XcdBarrier { unsigned* bar; unsigned x; volatile LAS unsigned* st; };
DI XcdBarrier xcd_barrier_post(unsigned* bar, volatile LAS unsigned* st) {
  XcdBarrier b; b.bar = bar; b.x = xb_xcc_id(); b.st = st;
  if (threadIdx.x == 0) st[2] = xb_add(&bar[XB_XCNT(b.x)], 1u);
  return b;
}
DI void xcd_barrier_complete(unsigned* bar, unsigned x, unsigned& nloc, unsigned& nx) {
  const unsigned G = gridDim.x * gridDim.y * gridDim.z;
  unsigned sum, cnt, mine, sp = 0u;
  for (;;) {
    sum = 0u; cnt = 0u; mine = 0u;
#pragma unroll
    for (unsigned j = 0; j < 16; ++j) { const unsigned c = xb_ld(&bar[XB_XCNT(j)]); sum += c; cnt += (c > 0u) ? 1u : 0u; mine = (j == x) ? c : mine; }
    if (sum == G) break;
    __builtin_amdgcn_s_sleep(1);
    if ((++sp & 255u) == 0u) { if (xb_ld(&bar[XB_TMO])) break; if (sp > XB_SPIN_CAP) { atomicAdd(&bar[XB_TMO], 1u); break; } }
  }
  nloc = mine > 0u ? mine : 1u; nx = cnt > 0u ? cnt : 1u;
}
DI void xcd_barrier(const XcdBarrier& b) {
  asm volatile("s_waitcnt vmcnt(0)" ::: "memory");
  __syncthreads();
  if (threadIdx.x == 0) {
    unsigned* bar = b.bar;
    __builtin_amdgcn_s_waitcnt(0);
    unsigned nloc = b.st[0], nx = b.st[1];
    if (nloc == 0u) { xcd_barrier_complete(bar, b.x, nloc, nx); b.st[0] = nloc; b.st[1] = nx; }
    const unsigned old = xb_add(&bar[XB_XSUB(b.x)], 1u);
    const unsigned gen = old / nloc;
    if (old + 1u == (gen + 1u) * nloc) {
      __builtin_amdgcn_fence(__ATOMIC_RELEASE, "agent");
      asm volatile("s_waitcnt vmcnt(0)" ::: "memory");
      const unsigned og = xb_add(&bar[XB_TOP], 1u);
      const unsigned tg = og / nx;
      if (og + 1u == (tg + 1u) * nx) xb_add(&bar[XB_TOPGEN], 1u);
      else XB_SPIN(xb_ld(&bar[XB_TOPGEN]) == tg, bar);
      __builtin_amdgcn_fence(__ATOMIC_ACQUIRE, "agent");
      xb_add(&bar[XB_XGEN(b.x)], 1u);
      asm volatile("s_waitcnt vmcnt(0)" ::: "memory");
    } else {
      XB_SPIN(xb_ld(&bar[XB_XGEN(b.x)]) == gen, bar);
      __builtin_amdgcn_fence(__ATOMIC_ACQUIRE, "agent");
      asm volatile("s_waitcnt vmcnt(0)" ::: "memory");
    }
  }
  __syncthreads();
}

struct GJob {
  const bf16_t* A; const bf16_t* A2; const float* mu; const bf16_t* Bt;
  int lda, ldb, K, nvalid;
  void* o0; void* o1; const float* x0; const float* x1; const float* x2;
  int ldo, act;
};
enum { EPI_LRU_IN = 0, EPI_GATES, EPI_RESID, EPI_SSM_XBC, EPI_SSM_Z, EPI_FFN1, EPI_ST, EPI_DECAY, EPI_SIGB };

template <int EPI> DI void epi_elem(const GJob& j, int row, int col, float v) {
  if (EPI == EPI_LRU_IN) {
    if (col < 1024) ((bf16_t*)j.o0)[(size_t)row * 1024 + col] = f2bf(v);
    else ((bf16_t*)j.o1)[(size_t)row * 1024 + col - 1024] = f2bf(geluf_(v));
  } else if (EPI == EPI_RESID) {
    unsafeAtomicAdd((float*)j.o0 + (size_t)row * 1024 + col, v);
  } else if (EPI == EPI_SSM_XBC) {
    if (col < 4096) ((bf16_t*)j.o0)[(size_t)row * 4096 + col] = f2bf(v);
  } else if (EPI == EPI_SSM_Z) {
    bf16_t* y = (bf16_t*)j.o0 + (size_t)row * 2048 + col;
    *y = f2bf(bf2f(*y) * siluf_(v));
  } else if (EPI == EPI_FFN1) {
    float r = fmaxf(v, 0.f);
    ((bf16_t*)j.o0)[(size_t)row * 4096 + col] = f2bf(r * r);
  } else if (EPI == EPI_ST) {
    if (col < j.nvalid) {
      float r = v;
      if (j.act == 1) r = tanhf_(v); else if (j.act == 2) r = sigmoidf_(v);
      ((bf16_t*)j.o0)[(size_t)row * j.ldo + col] = f2bf(r);
    }
  } else if (EPI == EPI_DECAY) {
    float wl = -softplusf_(-(j.x0[col] + v)) - 0.5f;
    ((float*)j.o0)[(size_t)row * 1024 + col] = __expf(-__expf(wl));
  } else if (EPI == EPI_SIGB) {
    ((bf16_t*)j.o0)[(size_t)row * 1024 + col] = f2bf(sigmoidf_(j.x0[col] + v));
  }
}

template <int EPI, bool MIX>
DI void gemm_tile(const GJob& j, int m0, int n0, int kt0, int kt1, char* smem) {
  const int tid = TIDX, lane = tid & 63, w = tid >> 6;
  const int wm = w >> 1, wn = w & 1, r32 = lane & 31, hh = lane >> 5;
  const int lrow = tid >> 3, kc = tid & 7;
  f32x16 acc[2][2];
#pragma unroll
  for (int a = 0; a < 2; ++a)
#pragma unroll
    for (int b = 0; b < 2; ++b)
#pragma unroll
      for (int r = 0; r < 16; ++r) acc[a][b][r] = 0.f;
  uint4 qa00, qa01, qa02, qa03, qb00, qb01, qb02, qb03, qc00, qc01, qc02, qc03;
  uint4 qa10, qa11, qa12, qa13, qb10, qb11, qb12, qb13, qc10, qc11, qc12, qc13;
  qc00 = qc01 = qc02 = qc03 = qc10 = qc11 = qc12 = qc13 = make_uint4(0, 0, 0, 0);
  const int nk = kt1 - kt0;
  const bf16_t* Ap = j.A + (size_t)(m0 + lrow) * j.lda + kc * 8 + (size_t)kt0 * 64;
  const bf16_t* A2p = MIX ? (j.A2 + (size_t)(m0 + lrow) * j.lda + kc * 8 + (size_t)kt0 * 64) : nullptr;
  const bf16_t* Bp = j.Bt + (size_t)(n0 + lrow) * j.ldb + kc * 8 + (size_t)kt0 * 64;
  const size_t astep = (size_t)32 * j.lda, bstep = (size_t)32 * j.ldb;
  const bool bv0 = (n0 + lrow) < j.nvalid, bv1 = (n0 + lrow + 32) < j.nvalid;
  const bool bv2 = (n0 + lrow + 64) < j.nvalid, bv3 = (n0 + lrow + 96) < j.nvalid;
  const uint4 z4 = make_uint4(0, 0, 0, 0);

#define LD1(s, i, kt)                                                                 \
  qa##s##i = *(const uint4*)(Ap + i * astep + (kt) * 64);                             \
  if (MIX) qc##s##i = *(const uint4*)(A2p + i * astep + (kt) * 64);                   \
  qb##s##i = z4;                                                                      \
  if (bv##i) qb##s##i = *(const uint4*)(Bp + i * bstep + (kt) * 64);
#define GLOAD(s, kt) { LD1(s, 0, kt) LD1(s, 1, kt) LD1(s, 2, kt) LD1(s, 3, kt) }
#define ST1(s, i, As_, Bs_)                                                           \
  if (MIX) {                                                                          \
    float f1[8], f2[8]; unpack8(qa##s##i, f1); unpack8(qc##s##i, f2);                 \
    _Pragma("unroll") for (int e = 0; e < 8; ++e) f1[e] = f1[e] + (f2[e] - f1[e]) * mu8[e]; \
    qa##s##i = pack8(f1);                                                             \
  }                                                                                   \
  *(uint4*)(As_ + (lrow + 32 * i) * 144 + kc * 16) = qa##s##i;                        \
  *(uint4*)(Bs_ + (lrow + 32 * i) * 144 + kc * 16) = qb##s##i;
#define SSTORE(s, kt, buf)                                                            \
  {                                                                                   \
    char* As_ = smem + (buf) * 36864; char* Bs_ = As_ + 18432;                        \
    float mu8[8];                                                                     \
    if (MIX) load8f(j.mu + (kt0 + (kt)) * 64 + kc * 8, mu8);                          \
    ST1(s, 0, As_, Bs_) ST1(s, 1, As_, Bs_) ST1(s, 2, As_, Bs_) ST1(s, 3, As_, Bs_)   \
  }
#define LOADF(F, ks)                                                                  \
  bf16x8 F##a0 = *(const bf16x8*)(ap + (ks) * 32);                                    \
  bf16x8 F##a1 = *(const bf16x8*)(ap + 32 * 144 + (ks) * 32);                         \
  bf16x8 F##b0 = *(const bf16x8*)(bp + (ks) * 32);                                    \
  bf16x8 F##b1 = *(const bf16x8*)(bp + 32 * 144 + (ks) * 32);
#define MFMA4(F)                                                                      \
  acc[0][0] = mfma32(F##a0, F##b0, acc[0][0]);                                        \
  acc[0][1] = mfma32(F##a0, F##b1, acc[0][1]);                                        \
  acc[1][0] = mfma32(F##a1, F##b0, acc[1][0]);                                        \
  acc[1][1] = mfma32(F##a1, F##b1, acc[1][1]);
#define COMPUTE(buf)                                                                  \
  {                                                                                   \
    const char* As_ = smem + (buf) * 36864; const char* Bs_ = As_ + 18432;            \
    const char* ap = As_ + (wm * 64 + r32) * 144 + hh * 16;                           \
    const char* bp = Bs_ + (wn * 64 + r32) * 144 + hh * 16;                           \
    LOADF(f0, 0) LOADF(f1, 1)                                                         \
    __builtin_amdgcn_sched_barrier(0);                                                \
    MFMA4(f0)                                                                         \
    LOADF(f2, 2)                                                                      \
    __builtin_amdgcn_sched_barrier(0);                                                \
    MFMA4(f1)                                                                         \
    LOADF(f3, 3)                                                                      \
    __builtin_amdgcn_sched_barrier(0);                                                \
    MFMA4(f2)                                                                         \
    __builtin_amdgcn_sched_barrier(0);                                                \
    MFMA4(f3)                                                                         \
    __builtin_amdgcn_sched_barrier(0);                                                \
  }

  qa10 = qa11 = qa12 = qa13 = qb10 = qb11 = qb12 = qb13 = z4;
  if (MIX) {
    GLOAD(0, 0);
    SSTORE(0, 0, 0);
    __syncthreads();
    for (int i = 0; i < nk; ++i) {
      if (i + 1 < nk) GLOAD(0, i + 1);
      if (i & 1) { COMPUTE(1); } else { COMPUTE(0); }
      if (i + 1 < nk) { if (i & 1) { SSTORE(0, i + 1, 0); } else { SSTORE(0, i + 1, 1); } }
      __syncthreads();
    }
  } else if (nk == 1) {
    GLOAD(0, 0);
    SSTORE(0, 0, 0);
    __syncthreads();
    COMPUTE(0);
    __syncthreads();
  } else {
    GLOAD(0, 0);
    GLOAD(1, 1);
    SSTORE(0, 0, 0);
    __syncthreads();
#pragma unroll 1
    for (int i = 0; i + 2 < nk; i += 2) {
      GLOAD(0, i + 2);
      COMPUTE(0);
      SSTORE(1, i + 1, 1);
      __syncthreads();
      GLOAD(1, i + 3);
      COMPUTE(1);
      SSTORE(0, i + 2, 0);
      __syncthreads();
    }
    COMPUTE(0);
    SSTORE(1, nk - 1, 1);
    __syncthreads();
    COMPUTE(1);
    __syncthreads();
  }
#undef LD1
#undef ST1
#undef LOADF
#undef MFMA4
#undef GLOAD
#undef SSTORE
#undef COMPUTE

  if (EPI == EPI_GATES) {
    const int ch = (n0 >> 7) * 64 + wn * 32 + r32;
    const float br = j.x0[ch], bi = j.x1[ch];
    const float spl = softplusf_(-j.x2[ch]);
    const bf16_t* XC = (const bf16_t*)j.o1;
    float* AA = (float*)j.o0;
    float* BBp = AA + (size_t)T_ * 1024;
#pragma unroll
    for (int mi = 0; mi < 2; ++mi)
#pragma unroll
      for (int r = 0; r < 16; ++r) {
        const int row = m0 + wm * 64 + mi * 32 + (r & 3) + 8 * (r >> 2) + 4 * hh;
        const float rg = sigmoidf_(acc[mi][0][r] + br);
        const float ig = sigmoidf_(acc[mi][1][r] + bi);
        const float la = -8.f * rg * spl;
        const float xc = bf2f(XC[(size_t)row * 1024 + ch]);
        const bool reset = (row < TP_) && ((row & 2047) == 0);
        const float a = reset ? 0.f : __expf(la);
        const float mult = reset ? 1.f : sqrtf(fmaxf(-expm1f(2.f * la), 0.f));
        AA[(size_t)row * 1024 + ch] = a;
        BBp[(size_t)row * 1024 + ch] = mult * ig * xc;
      }
  } else {
#pragma unroll
    for (int mi = 0; mi < 2; ++mi)
#pragma unroll
      for (int ni = 0; ni < 2; ++ni)
#pragma unroll
        for (int r = 0; r < 16; ++r) {
          const int row = m0 + wm * 64 + mi * 32 + (r & 3) + 8 * (r >> 2) + 4 * hh;
          const int col = n0 + wn * 64 + ni * 32 + r32;
          epi_elem<EPI>(j, row, col, acc[mi][ni][r]);
          if ((r & 7) == 7) __builtin_amdgcn_sched_barrier(0);
        }
  }
}

constexpr int DSLOT = 24576;
template <int EPI>
DI void gemm_tile_dma(const GJob& j, int m0, int n0, int k0, int k1, char* smem, unsigned* wflag = nullptr, unsigned epoch = 0u) {
  const int tid = TIDX, lane = tid & 63, w = tid >> 6;
  const int wm = w >> 1, wn = w & 1, r32 = lane & 31, hh = lane >> 5;
  f32x16 acc[2][4];
#pragma unroll
  for (int a = 0; a < 2; ++a)
#pragma unroll
    for (int b = 0; b < 4; ++b)
#pragma unroll
      for (int r = 0; r < 16; ++r) acc[a][b][r] = 0.f;
  const int nk = k1 - k0;
  const int dr = lane >> 2;
  const int dc = (lane & 3) ^ ((lane >> 4) & 3);
  const int nlim = j.nvalid - 1;
  const size_t kofs = (size_t)k0 * 32 + dc * 8;
  const bf16_t* gA0 = j.A + (size_t)(m0 + 32 * w + dr) * j.lda + kofs;
  const bf16_t* gA1 = j.A + (size_t)(m0 + 32 * w + 16 + dr) * j.lda + kofs;
  const bf16_t* gB0 = j.Bt + (size_t)min(n0 + 64 * w + dr, nlim) * j.ldb + kofs;
  const bf16_t* gB1 = j.Bt + (size_t)min(n0 + 64 * w + 16 + dr, nlim) * j.ldb + kofs;
  const bf16_t* gB2 = j.Bt + (size_t)min(n0 + 64 * w + 32 + dr, nlim) * j.ldb + kofs;
  const bf16_t* gB3 = j.Bt + (size_t)min(n0 + 64 * w + 48 + dr, nlim) * j.ldb + kofs;
  char* ldsA = smem + (2 * w) * 1024 + lane * 16;
  char* ldsB = smem + 8192 + (4 * w) * 1024 + lane * 16;
  const unsigned lbase = (unsigned)(unsigned long long)(LAS char*)smem;
  const int fsw = (r32 >> 2) & 3;
  const unsigned pa = (unsigned)((wm * 64 + r32) * 64), pb = (unsigned)(8192 + (wn * 128 + r32) * 64);
  const unsigned po0 = (unsigned)(((hh) ^ fsw) * 16), po1 = (unsigned)(((2 + hh) ^ fsw) * 16);

#define ISSUE(kt, slot)                                                                          \
  {                                                                                              \
    const int ko_ = (kt) * 32;                                                                   \
    char* la_ = ldsA + (slot) * DSLOT; char* lb_ = ldsB + (slot) * DSLOT;                        \
    __builtin_amdgcn_global_load_lds((const unsigned*)(gA0 + ko_), (unsigned*)(la_), 16, 0, 0);  \
    __builtin_amdgcn_global_load_lds((const unsigned*)(gA1 + ko_), (unsigned*)(la_ + 1024), 16, 0, 0); \
    __builtin_amdgcn_global_load_lds((const unsigned*)(gB0 + ko_), (unsigned*)(lb_), 16, 0, 0);  \
    __builtin_amdgcn_global_load_lds((const unsigned*)(gB1 + ko_), (unsigned*)(lb_ + 1024), 16, 0, 0); \
    __builtin_amdgcn_global_load_lds((const unsigned*)(gB2 + ko_), (unsigned*)(lb_ + 2048), 16, 0, 0); \
    __builtin_amdgcn_global_load_lds((const unsigned*)(gB3 + ko_), (unsigned*)(lb_ + 3072), 16, 0, 0); \
  }

  asm volatile("s_waitcnt vmcnt(0)" ::: "memory");
  const int last = nk - 1;
  ISSUE(0, 0);
  { const int t1 = min(1, last); ISSUE(t1, 1); }
  int sl_r = 0, sl_w = 2;
#pragma unroll 1
  for (int i = 0; i < nk; ++i) {
    asm volatile("s_waitcnt vmcnt(6)" ::: "memory");
    __builtin_amdgcn_s_barrier();
    { const int t2 = min(i + 2, last); ISSUE(t2, sl_w); }
    const unsigned sl = lbase + (unsigned)(sl_r * DSLOT);
    sl_r = (sl_r == 2) ? 0 : sl_r + 1;
    sl_w = (sl_w == 2) ? 0 : sl_w + 1;
    bf16x8 a00, a10, a01, a11, b00, b10, b20, b30, b01, b11, b21, b31;
    const unsigned aA0 = sl + pa + po0, aB0 = sl + pb + po0, aA1 = sl + pa + po1, aB1 = sl + pb + po1;
    asm volatile("ds_read_b128 %0, %1" : "=v"(a00) : "v"(aA0));
    asm volatile("ds_read_b128 %0, %1 offset:2048" : "=v"(a10) : "v"(aA0));
    asm volatile("ds_read_b128 %0, %1" : "=v"(b00) : "v"(aB0));
    asm volatile("ds_read_b128 %0, %1 offset:2048" : "=v"(b10) : "v"(aB0));
    asm volatile("ds_read_b128 %0, %1 offset:4096" : "=v"(b20) : "v"(aB0));
    asm volatile("ds_read_b128 %0, %1 offset:6144" : "=v"(b30) : "v"(aB0));
    asm volatile("ds_read_b128 %0, %1" : "=v"(a01) : "v"(aA1));
    asm volatile("ds_read_b128 %0, %1 offset:2048" : "=v"(a11) : "v"(aA1));
    asm volatile("ds_read_b128 %0, %1" : "=v"(b01) : "v"(aB1));
    asm volatile("ds_read_b128 %0, %1 offset:2048" : "=v"(b11) : "v"(aB1));
    asm volatile("ds_read_b128 %0, %1 offset:4096" : "=v"(b21) : "v"(aB1));
    asm volatile("ds_read_b128 %0, %1 offset:6144" : "=v"(b31) : "v"(aB1));
    asm volatile("s_waitcnt lgkmcnt(0)" : "+v"(a00), "+v"(a10), "+v"(b00), "+v"(b10), "+v"(b20), "+v"(b30),
                 "+v"(a01), "+v"(a11), "+v"(b01), "+v"(b11), "+v"(b21), "+v"(b31) :: "memory");
    acc[0][0] = mfma32(a00, b00, acc[0][0]);
    acc[0][1] = mfma32(a00, b10, acc[0][1]);
    acc[0][2] = mfma32(a00, b20, acc[0][2]);
    acc[0][3] = mfma32(a00, b30, acc[0][3]);
    acc[1][0] = mfma32(a10, b00, acc[1][0]);
    acc[1][1] = mfma32(a10, b10, acc[1][1]);
    acc[1][2] = mfma32(a10, b20, acc[1][2]);
    acc[1][3] = mfma32(a10, b30, acc[1][3]);
    acc[0][0] = mfma32(a01, b01, acc[0][0]);
    acc[0][1] = mfma32(a01, b11, acc[0][1]);
    acc[0][2] = mfma32(a01, b21, acc[0][2]);
    acc[0][3] = mfma32(a01, b31, acc[0][3]);
    acc[1][0] = mfma32(a11, b01, acc[1][0]);
    acc[1][1] = mfma32(a11, b11, acc[1][1]);
    acc[1][2] = mfma32(a11, b21, acc[1][2]);
    acc[1][3] = mfma32(a11, b31, acc[1][3]);
  }
  asm volatile("s_waitcnt vmcnt(0)" ::: "memory");
  __builtin_amdgcn_s_barrier();
#undef ISSUE
  if (wflag) {
    if (threadIdx.x == 0) {
      unsigned sp = 0;
      while (xb_ld(wflag) != epoch) { __builtin_amdgcn_s_sleep(1); if (++sp > (1u << 24)) break; }
      __builtin_amdgcn_fence(__ATOMIC_ACQUIRE, "agent");
      asm volatile("s_waitcnt vmcnt(0)" ::: "memory");
    }
    __syncthreads();
  }

  if (EPI == EPI_GATES) {
    const bf16_t* XC = (const bf16_t*)j.o1;
    float* AA = (float*)j.o0;
    float* BBp = AA + (size_t)T_ * 1024;
#pragma unroll
    for (int g = 0; g < 2; ++g) {
      const int ch = (n0 >> 8) * 128 + wn * 64 + g * 32 + r32;
      const float br = j.x0[ch], bi = j.x1[ch];
      const float spl = softplusf_(-j.x2[ch]);
#pragma unroll
      for (int mi = 0; mi < 2; ++mi)
#pragma unroll
        for (int r = 0; r < 16; ++r) {
          const int row = m0 + wm * 64 + mi * 32 + (r & 3) + 8 * (r >> 2) + 4 * hh;
          const float rg = sigmoidf_(acc[mi][2 * g][r] + br);
          const float ig = sigmoidf_(acc[mi][2 * g + 1][r] + bi);
          const float la = -8.f * rg * spl;
          const float xc = bf2f(XC[(size_t)row * 1024 + ch]);
          const bool reset = (row < TP_) && ((row & 2047) == 0);
          const float a = reset ? 0.f : __expf(la);
          const float mult = reset ? 1.f : sqrtf(fmaxf(-expm1f(2.f * la), 0.f));
          AA[(size_t)row * 1024 + ch] = a;
          BBp[(size_t)row * 1024 + ch] = mult * ig * xc;
        }
    }
  } else {
#pragma unroll
    for (int mi = 0; mi < 2; ++mi)
#pragma unroll
      for (int ni = 0; ni < 4; ++ni)
#pragma unroll
        for (int r = 0; r < 16; ++r) {
          const int row = m0 + wm * 64 + mi * 32 + (r & 3) + 8 * (r >> 2) + 4 * hh;
          const int col = n0 + wn * 128 + ni * 32 + r32;
          epi_elem<EPI>(j, row, col, acc[mi][ni][r]);
        }
    if (EPI == EPI_SSM_XBC) {
      if (n0 + wn * 128 == 4096) {
        const float dtb = j.x0[r32];
#pragma unroll
        for (int mi = 0; mi < 2; ++mi)
#pragma unroll
          for (int r = 0; r < 16; ++r) {
            const int row = m0 + wm * 64 + mi * 32 + (r & 3) + 8 * (r >> 2) + 4 * hh;
            ((float*)j.o1)[(size_t)row * 32 + r32] = softplusf_(acc[mi][0][r] + dtb);
          }
      }
    }
  }
}

#define VBLOCK() ((int)(((volatile LAS unsigned*)&xb_words)[3]))
DI void tile_map(int L, int ntn, int& mt, int& nt) {
  const int gw = ((ntn & 7) == 0) ? 8 : (((ntn & 3) == 0) ? 4 : 0);
  if (gw) {
    const int gs = 8 * gw, grp = L / gs, loc = L - grp * gs, gpr = ntn / gw;
    const int gm = grp / gpr, gn = grp - gm * gpr;
    mt = gm * 8 + loc / gw; nt = gn * gw + (loc - (loc / gw) * gw);
  } else { mt = L / ntn; nt = L - mt * ntn; }
}

template <int EPI, bool MIX>
DI void gemm_run(const GJob& j, int ntn, int& toff, char* smem, int vb_) {
  const int G = gridDim.x;
  const int ntiles = MT_ * ntn;
  const int start = (int)((vb_ - (toff % G) + G) % G);
  const int nk = j.K >> 6;
  for (int tile = start; tile < ntiles; tile += G) {
    int mt, nt; tile_map(tile, ntn, mt, nt);
    if (MIX) gemm_tile<EPI, MIX>(j, mt * 128, nt * 128, 0, nk, smem);
    else gemm_tile_dma<EPI>(j, mt * 128, nt * 256, 0, nk * 2, smem);
  }
  toff += ntiles;
}

template <int EPI>
DI void gemm_streamk(const GJob& j, int ntn, char* smem, int vb_, unsigned* flags, unsigned epoch) {
  const int G = gridDim.x;
  const int nk = j.K >> 5;
  const int total = MT_ * ntn * nk;
  int per = (total + G - 1) / G;
  if (per < nk) per = nk;
  int s0 = vb_ * per;
  const int s1 = min(s0 + per, total);
  while (s0 < s1) {
    const int tile = s0 / nk, k0 = s0 - tile * nk;
    const int k1 = min(nk, k0 + (s1 - s0));
    int mt, nt; tile_map(tile, ntn, mt, nt);
    unsigned* wf = (k0 == 0 && k1 < nk) ? (flags + tile) : nullptr;
    gemm_tile_dma<EPI>(j, mt * 128, nt * 256, k0, k1, smem, wf, epoch);
    if (k0 > 0) {
      asm volatile("s_waitcnt vmcnt(0)" ::: "memory");
      __syncthreads();
      if (threadIdx.x == 0) {
        __builtin_amdgcn_fence(__ATOMIC_RELEASE, "agent");
        asm volatile("s_waitcnt vmcnt(0)" ::: "memory");
        __hip_atomic_store(flags + tile, epoch, __ATOMIC_RELAXED, __HIP_MEMORY_SCOPE_AGENT);
      }
    }
    s0 += k1 - k0;
  }
}

template <int EPI, int SPLIT, int NKC>
DI void gemm_splitk(const GJob& j, int ntn, char* smem, int vb_) {
  const int G = gridDim.x;
  const int nitems = MT_ * ntn * SPLIT;
  for (int it = vb_; it < nitems; it += G) {
    const int tile = it / SPLIT, sp = it - tile * SPLIT;
    int mt, nt; tile_map(tile, ntn, mt, nt);
    gemm_tile<EPI, false>(j, mt * 128, nt * 128, sp * NKC, sp * NKC + NKC, smem);
  }
}

DI GJob mkjob(const bf16_t* A, int lda, const bf16_t* Bt, int ldb, int K, int nvalid) {
  GJob j;
  j.A = A; j.A2 = nullptr; j.mu = nullptr; j.Bt = Bt; j.lda = lda; j.ldb = ldb; j.K = K; j.nvalid = nvalid;
  j.o0 = nullptr; j.o1 = nullptr; j.x0 = nullptr; j.x1 = nullptr; j.x2 = nullptr; j.ldo = 0; j.act = 0;
  return j;
}

struct TJob { const float* src; bf16_t* dst; int K, N, src_ld, kind, n_off; };

DI TJob get_tjob(const Params& p, int j) {
  bf16_t* wt = (bf16_t*)(p.ws + W_WT);
  TJob o; o.kind = 0; o.n_off = 0;
  if (j < 36) {
    const int ia = j / 18, r = j % 18;
    if (r == 0) { o.src = p.in[I_LRU_WIN] + (size_t)ia * 1024 * 2048; o.dst = wt + WA_IN + (size_t)ia * 2048 * 1024; o.K = 1024; o.N = 2048; o.src_ld = 2048; }
    else if (r == 1) { o.src = p.in[I_LRU_WOUT] + (size_t)ia * 1024 * 1024; o.dst = wt + WA_OUT + (size_t)ia * 1024 * 1024; o.K = 1024; o.N = 1024; o.src_ld = 1024; }
    else {
      const int isI = (r >= 10) ? 1 : 0; const int h = (r - 2) & 7;
      o.src = p.in[isI ? I_LRU_WI : I_LRU_WR] + ((size_t)ia * 8 + h) * 128 * 128;
      o.dst = wt + WA_G + (size_t)ia * 2048 * 128; o.K = 128; o.N = 128; o.src_ld = 128; o.kind = 1 + isI; o.n_off = h * 128;
    }
  } else if (j == 36) { o.src = p.in[I_SSM_WIN] + 2048; o.dst = wt + WB_XBC; o.K = 1024; o.N = 4128; o.src_ld = 6176; }
  else if (j == 37) { o.src = p.in[I_SSM_WIN]; o.dst = wt + WB_Z; o.K = 1024; o.N = 2048; o.src_ld = 6176; }
  else if (j == 38) { o.src = p.in[I_SSM_WOUT]; o.dst = wt + WB_OUT; o.K = 2048; o.N = 1024; o.src_ld = 1024; }
  else if (j < 42) { const int s = j - 39; o.src = p.in[I_RW_WRKV] + (size_t)s * 1024 * 1024; o.dst = wt + WC_RKV + (size_t)s * 1024 * 1024; o.K = 1024; o.N = 1024; o.src_ld = 1024; }
  else if (j == 42) { o.src = p.in[I_RW_WW1]; o.dst = wt + WC_L1; o.K = 1024; o.N = 64; o.src_ld = 64; }
  else if (j == 43) { o.src = p.in[I_RW_WA1]; o.dst = wt + WC_L1 + 64 * 1024; o.K = 1024; o.N = 64; o.src_ld = 64; }
  else if (j == 44) { o.src = p.in[I_RW_WG1]; o.dst = wt + WC_L1 + 128 * 1024; o.K = 1024; o.N = 128; o.src_ld = 128; }
  else if (j == 45) { o.src = p.in[I_RW_WW2]; o.dst = wt + WC_W2; o.K = 64; o.N = 1024; o.src_ld = 1024; }
  else if (j == 46) { o.src = p.in[I_RW_WA2]; o.dst = wt + WC_A2; o.K = 64; o.N = 1024; o.src_ld = 1024; }
  else if (j == 47) { o.src = p.in[I_RW_WG2]; o.dst = wt + WC_G2; o.K = 128; o.N = 1024; o.src_ld = 1024; }
  else if (j == 48) { o.src = p.in[I_RW_WOUT]; o.dst = wt + WC_OUT; o.K = 1024; o.N = 1024; o.src_ld = 1024; }
  else {
    const int l = (j - 49) >> 1, which = (j - 49) & 1;
    if (!which) { o.src = p.in[I_FFN_W1] + (size_t)l * 1024 * 4096; o.dst = wt + WF_1 + (size_t)l * 4096 * 1024; o.K = 1024; o.N = 4096; o.src_ld = 4096; }
    else { o.src = p.in[I_FFN_W2] + (size_t)l * 4096 * 1024; o.dst = wt + WF_2 + (size_t)l * 4096 * 1024; o.K = 4096; o.N = 1024; o.src_ld = 1024; }
  }
  return o;
}
constexpr int N_TJOBS = 57;

DI void ph_prologue(const Params& p, char* smem) {
  const int tid = TIDX, G = gridDim.x;
  {
    const float4* xp = (const float4*)p.in[I_XP];
    const float4* xs = (const float4*)p.in[I_XS];
    float4* X = (float4*)(p.ws + W_X);
    const size_t np = (size_t)TP_ * 256, nt = (size_t)T_ * 256;
    for (size_t i = (size_t)blockIdx.x * NTHR + tid; i < nt; i += (size_t)G * NTHR)
      X[i] = (i < np) ? xp[i] : xs[i - np];
  }
  float* tile = (float*)smem;
  int toff = 0;
  for (int jn = 0; jn < N_TJOBS; ++jn) {
    const TJob tj = get_tjob(p, jn);
    const int nkt = tj.K >> 6, nnt = (tj.N + 63) >> 6;
    const int ntiles = nkt * nnt;
    const int start = (((int)blockIdx.x - (toff % G)) + G) % G;
    for (int t = start; t < ntiles; t += G) {
      const int kt = t / nnt, nt = t - kt * nnt;
      const int k0 = kt * 64, n0 = nt * 64;
      __syncthreads();
#pragma unroll 4
      for (int i = 0; i < 16; ++i) {
        const int k = i * 4 + (tid >> 6), n = tid & 63;
        float v = 0.f;
        if (n0 + n < tj.N) v = tj.src[(size_t)(k0 + k) * tj.src_ld + n0 + n];
        tile[k * 65 + n] = v;
      }
      __syncthreads();
      const int n = tid >> 2, kq = tid & 3;
      if (n0 + n < tj.N) {
        int nrow = n0 + n;
        if (tj.kind) {
          const int ch = tj.n_off + n0 + n;
          nrow = (ch >> 6) * 128 + ((ch >> 5) & 1) * 64 + (tj.kind - 1) * 32 + (ch & 31);
        }
        float f[8], g[8];
#pragma unroll
        for (int e = 0; e < 8; ++e) { f[e] = tile[(kq * 16 + e) * 65 + n]; g[e] = tile[(kq * 16 + 8 + e) * 65 + n]; }
        uint4* d = (uint4*)(tj.dst + (size_t)nrow * tj.K + k0 + kq * 16);
        d[0] = pack8(f); d[1] = pack8(g);
      }
    }
    toff += ntiles;
  }
}

DI void ph_rmsnorm(const Params& p, int mode, const float* w) {
  const int tid_ = TIDX; const int lane = tid_ & 63;
  const int gw = blockIdx.x * 4 + (tid_ >> 6), nw = gridDim.x * 4;
  const float* X = (const float*)(p.ws + W_X);
  bf16_t* U = (bf16_t*)(p.ws + W_U);
  bf16_t* UP = (bf16_t*)(p.ws + SC_UP);
  float4 wv[4];
#pragma unroll
  for (int i = 0; i < 4; ++i) wv[i] = ((const float4*)w)[lane + 64 * i];
  for (int row = gw; row < T_; row += nw) {
    const float4* xr = (const float4*)(X + (size_t)row * 1024);
    float4 v[4]; float ss = 0.f;
#pragma unroll
    for (int i = 0; i < 4; ++i) { v[i] = xr[lane + 64 * i]; ss += v[i].x * v[i].x + v[i].y * v[i].y + v[i].z * v[i].z + v[i].w * v[i].w; }
    ss = wave_sum(ss);
    const float rstd = rsqrtf(ss * (1.f / 1024.f) + 1e-6f);
    int seq, l, L; tok_info(row, seq, l, L);
#pragma unroll
    for (int i = 0; i < 4; ++i) {
      const int c = 4 * (lane + 64 * i);
      float4 y = make_float4(v[i].x * rstd * wv[i].x, v[i].y * rstd * wv[i].y, v[i].z * rstd * wv[i].z, v[i].w * rstd * wv[i].w);
      if (mode == 2) {
        *(float4*)(p.out + O_Y + (size_t)row * 1024 + c) = y;
      } else {
        uint2 pk = make_uint2(pack2(y.x, y.y), pack2(y.z, y.w));
        *(uint2*)(U + (size_t)row * 1024 + c) = pk;
        if (mode == 1) {
          if (l + 1 < L) *(uint2*)(UP + (size_t)(row + 1) * 1024 + c) = pk;
          if (l == 0) {
            uint2 pz = make_uint2(0, 0);
            if (seq >= 8) { float4 s = *(const float4*)(p.in[I_ST_RS] + (size_t)(seq - 8) * 1024 + c); pz = make_uint2(pack2(s.x, s.y), pack2(s.z, s.w)); }
            *(uint2*)(UP + (size_t)row * 1024 + c) = pz;
          }
          if (l == L - 1) {
            float* o = (seq < 8) ? (p.out + O_RS_P + (size_t)seq * 1024 + c) : (p.out + O_RS_S + (size_t)(seq - 8) * 1024 + c);
            *(float4*)o = y;
          }
        }
      }
    }
  }
}

template <int C, bool SILU>
DI void ph_conv(const bf16_t* src, bf16_t* dst, const float* cw, const float* cb, const float* state,
                float* out_p, float* out_s) {
  constexpr int GR = C / 8;
  const size_t total = (size_t)T_ * GR;
  for (size_t idx = (size_t)blockIdx.x * NTHR + TIDX; idx < total; idx += (size_t)gridDim.x * NTHR) {
    const int t = (int)(idx / GR), c = (int)(idx % GR) * 8;
    int seq, l, L; tok_info(t, seq, l, L);
    float acc[8]; load8f(cb + c, acc);
    float xcur[8];
#pragma unroll
    for (int jj = 0; jj < 4; ++jj) {
      const int ls = l - 3 + jj;
      float xv[8];
      if (ls >= 0) { unpack8(*(const uint4*)(src + (size_t)(t - 3 + jj) * C + c), xv); }
      else if (seq >= 8) { load8f(state + ((size_t)(seq - 8) * 3 + (ls + 3)) * C + c, xv); }
      else {
#pragma unroll
        for (int e = 0; e < 8; ++e) xv[e] = 0.f;
      }
      float w8[8]; load8f(cw + (size_t)jj * C + c, w8);
#pragma unroll
      for (int e = 0; e < 8; ++e) acc[e] += w8[e] * xv[e];
      if (jj == 3) {
#pragma unroll
        for (int e = 0; e < 8; ++e) xcur[e] = xv[e];
      }
    }
    if (SILU) {
#pragma unroll
      for (int e = 0; e < 8; ++e) acc[e] = siluf_(acc[e]);
    }
    *(uint4*)(dst + (size_t)t * C + c) = pack8(acc);
    if (l >= L - 3) {
      const int r = l - (L - 3);
      float* o = (seq < 8) ? (out_p + ((size_t)seq * 3 + r) * C + c) : (out_s + ((size_t)(seq - 8) * 3 + r) * C + c);
      store8f(o, xcur);
    }
  }
}

DI void ph_lru_scan1(const Params& p) {
  const float* AA = (const float*)(p.ws + SA_AA);
  const float* BB = (const float*)(p.ws + SA_BB);
  float* CP = (float*)(p.ws + SA_CP);
  float* CS = (float*)(p.ws + SA_CS);
  const int total = 8 * 64 * 1024;
  for (int idx = blockIdx.x * NTHR + TIDX; idx < total; idx += gridDim.x * NTHR) {
    const int ch = idx & 1023, c = (idx >> 10) & 63, b = idx >> 16;
    const size_t base = ((size_t)b * 2048 + c * 32) * 1024 + ch;
    float P = 1.f, S = 0.f;
#pragma unroll 8
    for (int s = 0; s < 32; ++s) {
      const float a = AA[base + (size_t)s * 1024], bb = BB[base + (size_t)s * 1024];
      S = a * S + bb; P *= a;
    }
    CP[idx] = P; CS[idx] = S;
  }
}
DI void ph_lru_scan2(const Params& p, int ia) {
  const float* AA = (const float*)(p.ws + SA_AA);
  const float* BB = (const float*)(p.ws + SA_BB);
  const float* CP = (const float*)(p.ws + SA_CP);
  const float* CS = (const float*)(p.ws + SA_CS);
  bf16_t* GT = (bf16_t*)(p.ws + SA_GT);
  const int nP = 8 * 64 * 1024, total = nP + 128 * 1024;
  for (int idx = blockIdx.x * NTHR + TIDX; idx < total; idx += gridDim.x * NTHR) {
    if (idx < nP) {
      const int ch = idx & 1023, c = (idx >> 10) & 63, b = idx >> 16;
      float h = 0.f;
      for (int c2 = 0; c2 < c; ++c2) {
        const int ci = ((b * 64 + c2) << 10) + ch;
        h = CP[ci] * h + CS[ci];
      }
      const size_t base = ((size_t)b * 2048 + c * 32) * 1024 + ch;
#pragma unroll 8
      for (int s = 0; s < 32; ++s) {
        const size_t o = base + (size_t)s * 1024;
        h = AA[o] * h + BB[o];
        GT[o] = f2bf(h * bf2f(GT[o]));
      }
      if (c == 63) p.out[O_LH_P + ((size_t)ia * 8 + b) * 1024 + ch] = h;
    } else {
      const int u = idx - nP; const int ch = u & 1023, s = u >> 10;
      float h = p.in[I_ST_LH][((size_t)ia * 128 + s) * 1024 + ch];
      const size_t base = ((size_t)TP_ + s * 8) * 1024 + ch;
#pragma unroll
      for (int q = 0; q < 8; ++q) {
        const size_t o = base + (size_t)q * 1024;
        h = AA[o] * h + BB[o];
        GT[o] = f2bf(h * bf2f(GT[o]));
      }
      p.out[O_LH_S + ((size_t)ia * 128 + s) * 1024 + ch] = h;
    }
  }
}

DI void ssd_item(const Params& p, char* smem, int seq, int h) {
  const int tid = TIDX, lane = tid & 63, w = tid >> 6, r32 = lane & 31, hh = lane >> 5;
  bf16_t* Cs = (bf16_t*)smem;
  bf16_t* Bs = Cs + 64 * 136;
  bf16_t* Sb = Bs + 64 * 136;
  bf16_t* Xt = Sb + 64 * 136;
  bf16_t* Btr = Xt + 64 * 72;
  float* dts = (float*)(Btr + 128 * 72);
  float* acs = dts + 64;
  bf16_t* Ws = Bs;
  const bf16_t* XBC = (const bf16_t*)(p.ws + SB_XBC);
  const float* DT = (const float*)(p.ws + SB_DT);
  bf16_t* Y = (bf16_t*)(p.ws + SB_Y);
  const bool prompt = seq < 8;
  const int nchunk = prompt ? 32 : 1, Lv = prompt ? 64 : 8;
  const int tbase = prompt ? seq * 2048 : TP_ + (seq - 8) * 8;
  const int g = h >> 2;
  const float Ah = -__expf(p.in[I_SSM_ALOG][h]);
  const float Dh = p.in[I_SSM_D][h];
  f32x16 accS[2];
  {
    const float* s0 = p.in[I_ST_SS] + ((size_t)(seq - 8) * 32 + h) * 64 * 128;
#pragma unroll
    for (int mi = 0; mi < 2; ++mi)
#pragma unroll
      for (int r = 0; r < 16; ++r) {
        const int prow = mi * 32 + (r & 3) + 8 * (r >> 2) + 4 * hh, n = 32 * w + r32;
        accS[mi][r] = prompt ? 0.f : s0[(size_t)prow * 128 + n];
      }
  }
  __syncthreads();
#pragma unroll
  for (int mi = 0; mi < 2; ++mi)
#pragma unroll
    for (int r = 0; r < 16; ++r) {
      const int prow = mi * 32 + (r & 3) + 8 * (r >> 2) + 4 * hh, n = 32 * w + r32;
      Sb[prow * 136 + n] = f2bf(accS[mi][r]);
    }
  for (int c = 0; c < nchunk; ++c) {
    const int t0 = tbase + c * 64;
    __syncthreads();
    if (tid < 64) {
      const float dtv = (tid < Lv) ? DT[(size_t)(t0 + tid) * 32 + h] : 0.f;
      float x = dtv * Ah;
#pragma unroll
      for (int o = 1; o < 64; o <<= 1) { const float y = __shfl_up(x, o, 64); if (lane >= o) x += y; }
      dts[tid] = dtv; acs[tid] = x;
    }
    __syncthreads();
    const float aend = acs[63];
#pragma unroll
    for (int i = 0; i < 4; ++i) {
      const int id = tid + 256 * i, row = id >> 4, ch = id & 15;
      uint4 cv = make_uint4(0, 0, 0, 0), bv = make_uint4(0, 0, 0, 0);
      if (row < Lv) {
        const bf16_t* src = XBC + (size_t)(t0 + row) * 4096 + g * 128 + ch * 8;
        bv = *(const uint4*)(src + 2048);
        cv = *(const uint4*)(src + 3072);
      }
      *(uint4*)(Cs + row * 136 + ch * 8) = cv;
      *(uint4*)(Bs + row * 136 + ch * 8) = bv;
      float f[8]; unpack8(bv, f);
      const float sc = __expf(aend - acs[row]);
#pragma unroll
      for (int e = 0; e < 8; ++e) Btr[(ch * 8 + e) * 72 + row] = f2bf(f[e] * sc);
    }
#pragma unroll
    for (int i = 0; i < 2; ++i) {
      const int id = tid + 256 * i, row = id >> 3, ch = id & 7;
      uint4 xv = make_uint4(0, 0, 0, 0);
      if (row < Lv) xv = *(const uint4*)(XBC + (size_t)(t0 + row) * 4096 + h * 64 + ch * 8);
      float f[8]; unpack8(xv, f);
      const float sc = dts[row];
#pragma unroll
      for (int e = 0; e < 8; ++e) Xt[(ch * 8 + e) * 72 + row] = f2bf(f[e] * sc);
    }
    __syncthreads();
    const int it = w >> 1, jt = w & 1;
    f32x16 cb;
#pragma unroll
    for (int r = 0; r < 16; ++r) cb[r] = 0.f;
    if (jt <= it) {
#pragma unroll
      for (int ks = 0; ks < 8; ++ks) {
        bf16x8 a = *(const bf16x8*)(Cs + (it * 32 + r32) * 136 + ks * 16 + hh * 8);
        bf16x8 b = *(const bf16x8*)(Bs + (jt * 32 + r32) * 136 + ks * 16 + hh * 8);
        cb = mfma32(a, b, cb);
      }
    }
    __syncthreads();
    {
      const int jj = jt * 32 + r32; const float aj = acs[jj];
#pragma unroll
      for (int r = 0; r < 16; ++r) {
        const int ii = it * 32 + (r & 3) + 8 * (r >> 2) + 4 * hh;
        const float v = (jj <= ii) ? cb[r] * __expf(acs[ii] - aj) : 0.f;
        Ws[ii * 72 + jj] = f2bf(v);
      }
    }
    __syncthreads();
    {
      const int pt = w & 1;
      f32x16 yd, yo;
#pragma unroll
      for (int r = 0; r < 16; ++r) { yd[r] = 0.f; yo[r] = 0.f; }
#pragma unroll
      for (int ks = 0; ks < 4; ++ks) {
        bf16x8 a = *(const bf16x8*)(Ws + (it * 32 + r32) * 72 + ks * 16 + hh * 8);
        bf16x8 b = *(const bf16x8*)(Xt + (pt * 32 + r32) * 72 + ks * 16 + hh * 8);
        yd = mfma32(a, b, yd);
      }
#pragma unroll
      for (int ks = 0; ks < 8; ++ks) {
        bf16x8 a = *(const bf16x8*)(Cs + (it * 32 + r32) * 136 + ks * 16 + hh * 8);
        bf16x8 b = *(const bf16x8*)(Sb + (pt * 32 + r32) * 136 + ks * 16 + hh * 8);
        yo = mfma32(a, b, yo);
      }
      const int pp = pt * 32 + r32;
#pragma unroll
      for (int r = 0; r < 16; ++r) {
        const int ii = it * 32 + (r & 3) + 8 * (r >> 2) + 4 * hh;
        if (ii < Lv) {
          const size_t t = (size_t)(t0 + ii);
          const float xv = bf2f(XBC[t * 4096 + h * 64 + pp]);
          const float yv = yd[r] + __expf(acs[ii]) * yo[r] + Dh * xv;
          Y[t * 2048 + h * 64 + pp] = f2bf(yv);
        }
      }
    }
    {
      const float dec = __expf(aend);
#pragma unroll
      for (int mi = 0; mi < 2; ++mi)
#pragma unroll
        for (int r = 0; r < 16; ++r) accS[mi][r] *= dec;
#pragma unroll
      for (int ks = 0; ks < 4; ++ks) {
        bf16x8 b = *(const bf16x8*)(Btr + (32 * w + r32) * 72 + ks * 16 + hh * 8);
        bf16x8 a0 = *(const bf16x8*)(Xt + (r32) * 72 + ks * 16 + hh * 8);
        bf16x8 a1 = *(const bf16x8*)(Xt + (32 + r32) * 72 + ks * 16 + hh * 8);
        accS[0] = mfma32(a0, b, accS[0]);
        accS[1] = mfma32(a1, b, accS[1]);
      }
    }
    __syncthreads();
#pragma unroll
    for (int mi = 0; mi < 2; ++mi)
#pragma unroll
      for (int r = 0; r < 16; ++r) {
        const int prow = mi * 32 + (r & 3) + 8 * (r >> 2) + 4 * hh, n = 32 * w + r32;
        Sb[prow * 136 + n] = f2bf(accS[mi][r]);
      }
  }
  float* dst = prompt ? (p.out + O_SS_P + ((size_t)seq * 32 + h) * 64 * 128)
                      : (p.out + O_SS_S + ((size_t)(seq - 8) * 32 + h) * 64 * 128);
#pragma unroll
  for (int mi = 0; mi < 2; ++mi)
#pragma unroll
    for (int r = 0; r < 16; ++r) {
      const int prow = mi * 32 + (r & 3) + 8 * (r >> 2) + 4 * hh, n = 32 * w + r32;
      dst[(size_t)prow * 128 + n] = accS[mi][r];
    }
}

DI void ph_ssd(const Params& p, char* smem) {
  const int G = gridDim.x, bid = blockIdx.x;
  int it = bid, step = G;
  if (G >= 512) { if (bid < 256) { step = 1 << 30; } else { step = G - 256; } }
#pragma nounroll
  for (; it < 256 + 4096; it += step) {
    const int seq = (it < 256) ? (it >> 5) : (8 + ((it - 256) >> 5));
    ssd_item(p, smem, seq, it & 31);
  }
}

DI void ph_gnorm(const Params& p) {
  const int tid_ = TIDX; const int lane = tid_ & 63;
  const int gw = blockIdx.x * 4 + (tid_ >> 6), nw = gridDim.x * 4;
  bf16_t* Y = (bf16_t*)(p.ws + SB_Y);
  const float* nwt = p.in[I_SSM_NW];
  for (int item = gw; item < T_ * 8; item += nw) {
    const int t = item >> 3, g = item & 7;
    bf16_t* yp = Y + (size_t)t * 2048 + g * 256 + lane * 4;
    const uint2 v = *(const uint2*)yp;
    const float f0 = __uint_as_float(v.x << 16), f1 = __uint_as_float(v.x & 0xFFFF0000u);
    const float f2 = __uint_as_float(v.y << 16), f3 = __uint_as_float(v.y & 0xFFFF0000u);
    const float ss = wave_sum(f0 * f0 + f1 * f1 + f2 * f2 + f3 * f3);
    const float rstd = rsqrtf(ss * (1.f / 256.f) + 1e-5f);
    const float4 wv = *(const float4*)(nwt + g * 256 + lane * 4);
    *(uint2*)yp = make_uint2(pack2(f0 * rstd * wv.x, f1 * rstd * wv.y), pack2(f2 * rstd * wv.z, f3 * rstd * wv.w));
  }
}

template <int LPR>
DI void wkv_item(const Params& p, char* smem, int seq, int head, int part) {
  constexpr int ROWS = 256 / LPR, KPL = 64 / LPR;
  const int tid = TIDX;
  float* sR = (float*)smem;
  float* sK = sR + 2048;
  float* sKK = sK + 2048;
  float* sBB = sKK + 2048;
  float* sW = sBB + 2048;
  float* sV = sW + 2048;
  float* sO = sV + 2048;
  const bf16_t* R = (const bf16_t*)(p.ws + SC_R);
  const bf16_t* K = (const bf16_t*)(p.ws + SC_K);
  const bf16_t* V = (const bf16_t*)(p.ws + SC_V);
  const bf16_t* AAc = (const bf16_t*)(p.ws + SC_AA);
  const float* WD = (const float*)(p.ws + SC_WD);
  bf16_t* O = (bf16_t*)(p.ws + SC_O);
  const bool prompt = seq < 8;
  const int nch = prompt ? 64 : 1, nvalid = prompt ? 32 : 8;
  const int tbase = prompt ? seq * 2048 : TP_ + (seq - 8) * 8;
  const int row_l = tid / LPR, q = tid % LPR, row = part * ROWS + row_l;
  float S[KPL];
  {
    const float* s0 = p.in[I_ST_RW] + (((size_t)(seq - 8) * 16 + head) * 64 + row) * 64 + q * KPL;
#pragma unroll
    for (int e = 0; e < KPL; ++e) S[e] = prompt ? 0.f : s0[e];
  }
  const int pst = tid >> 3, pk0 = (tid & 7) * 8, pcol = head * 64 + pk0;
  float kk8[8], ka8[8];
  load8f(p.in[I_RW_KK] + pcol, kk8);
  load8f(p.in[I_RW_KA] + pcol, ka8);
  for (int c = 0; c < nch; ++c) {
    const int t0 = tbase + c * 32;
    __syncthreads();
    if (pst < nvalid) {
      const size_t o = (size_t)(t0 + pst) * 1024 + pcol;
      float r8[8], k8[8], v8[8], a8[8], w8[8];
      unpack8(*(const uint4*)(R + o), r8);
      unpack8(*(const uint4*)(K + o), k8);
      unpack8(*(const uint4*)(V + o), v8);
      unpack8(*(const uint4*)(AAc + o), a8);
      load8f(WD + o, w8);
      float kr[8], ss = 0.f;
#pragma unroll
      for (int e = 0; e < 8; ++e) { kr[e] = k8[e] * kk8[e]; ss += kr[e] * kr[e]; }
      ss = red_lanes<8>(ss);
      const float inv = 1.f / fmaxf(sqrtf(ss), 1e-12f);
      float kp[8], bb[8];
#pragma unroll
      for (int e = 0; e < 8; ++e) { kr[e] *= inv; kp[e] = k8[e] * (1.f + (a8[e] - 1.f) * ka8[e]); bb[e] = kr[e] * a8[e]; }
      const int lo = pst * 64 + pk0;
      store8f(sR + lo, r8); store8f(sK + lo, kp); store8f(sKK + lo, kr); store8f(sBB + lo, bb);
      store8f(sW + lo, w8); store8f(sV + lo, v8);
    }
    __syncthreads();
    for (int st = 0; st < nvalid; ++st) {
      const int lo = st * 64 + q * KPL;
      float kk[KPL], ww[KPL], bb[KPL], kp[KPL], rr[KPL];
#pragma unroll
      for (int e = 0; e < KPL; e += 4) {
        const float4 a = *(const float4*)(sKK + lo + e); kk[e] = a.x; kk[e + 1] = a.y; kk[e + 2] = a.z; kk[e + 3] = a.w;
        const float4 b = *(const float4*)(sW + lo + e); ww[e] = b.x; ww[e + 1] = b.y; ww[e + 2] = b.z; ww[e + 3] = b.w;
        const float4 d = *(const float4*)(sBB + lo + e); bb[e] = d.x; bb[e + 1] = d.y; bb[e + 2] = d.z; bb[e + 3] = d.w;
        const float4 f = *(const float4*)(sK + lo + e); kp[e] = f.x; kp[e + 1] = f.y; kp[e + 2] = f.z; kp[e + 3] = f.w;
        const float4 g = *(const float4*)(sR + lo + e); rr[e] = g.x; rr[e + 1] = g.y; rr[e + 2] = g.z; rr[e + 3] = g.w;
      }
      const float vv = sV[st * 64 + row];
      float sa = 0.f;
#pragma unroll
      for (int e = 0; e < KPL; ++e) sa += S[e] * kk[e];
      sa = red_lanes<LPR>(sa);
      float oo = 0.f;
#pragma unroll
      for (int e = 0; e < KPL; ++e) {
        S[e] = S[e] * ww[e] - sa * bb[e] + vv * kp[e];
        oo += S[e] * rr[e];
      }
      oo = red_lanes<LPR>(oo);
      if (q == 0) sO[st * ROWS + row_l] = oo;
    }
    __syncthreads();
    for (int i = tid; i < nvalid * ROWS; i += NTHR) {
      const int st = i / ROWS, rr = i % ROWS;
      O[(size_t)(t0 + st) * 1024 + head * 64 + part * ROWS + rr] = f2bf(sO[i]);
    }
  }
  float* dst = prompt ? (p.out + O_RW_P + (((size_t)seq * 16 + head) * 64 + row) * 64 + q * KPL)
                      : (p.out + O_RW_S + (((size_t)(seq - 8) * 16 + head) * 64 + row) * 64 + q * KPL);
#pragma unroll
  for (int e = 0; e < KPL; ++e) dst[e] = S[e];
}

template <int LPR>
DI void ph_wkv(const Params& p, char* smem) {
  constexpr int NPART = 64 / (256 / LPR);
  const int G = gridDim.x, bid = blockIdx.x;
  const int nP = 128 * NPART, nS = 2048 * NPART;
  for (int it = bid; it < nP + nS; it += G) {
    int seq, head, part;
    if (it < nP) { part = it % NPART; const int sh = it / NPART; seq = sh >> 4; head = sh & 15; }
    else { const int u = it - nP; part = u % NPART; const int sh = u / NPART; seq = 8 + (sh >> 4); head = sh & 15; }
    wkv_item<LPR>(p, smem, seq, head, part);
  }
}

DI void ph_wkv_post(const Params& p) {
  const int tid_ = TIDX; const int lane = tid_ & 63;
  const int gw = blockIdx.x * 4 + (tid_ >> 6), nw = gridDim.x * 4;
  const bf16_t* R = (const bf16_t*)(p.ws + SC_R);
  const bf16_t* K = (const bf16_t*)(p.ws + SC_K);
  const bf16_t* V = (const bf16_t*)(p.ws + SC_V);
  const bf16_t* AAc = (const bf16_t*)(p.ws + SC_AA);
  const bf16_t* Gg = (const bf16_t*)(p.ws + SC_G);
  const bf16_t* O = (const bf16_t*)(p.ws + SC_O);
  bf16_t* U = (bf16_t*)(p.ws + W_U);
  for (int item = gw; item < T_ * 16; item += nw) {
    const int t = item >> 4, head = item & 15, col = head * 64 + lane;
    const size_t o = (size_t)t * 1024 + col;
    const float ov = bf2f(O[o]);
    const float mean = wave_sum(ov) * (1.f / 64.f);
    const float d = ov - mean;
    const float var = wave_sum(d * d) * (1.f / 64.f);
    const float on = d * rsqrtf(var + 64e-5f) * p.in[I_RW_LNW][col] + p.in[I_RW_LNB][col];
    const float r = bf2f(R[o]), k = bf2f(K[o]), a = bf2f(AAc[o]), v = bf2f(V[o]);
    const float kp = k * (1.f + (a - 1.f) * p.in[I_RW_KA][col]);
    const float s = wave_sum(r * kp * p.in[I_RW_RK][col]);
    U[o] = f2bf((on + s * v) * bf2f(Gg[o]));
  }
}

constexpr int NPH = 40;
#ifndef REP_GEMM
#define REP_GEMM 1
#endif
#ifndef REP_SSD
#define REP_SSD 1
#endif
#ifndef REP_WKV
#define REP_WKV 1
#endif
#ifndef REP_MISC
#define REP_MISC 1
#endif

__global__ void __launch_bounds__(NTHR, 2) mega(Params p) {
  __shared__ __attribute__((aligned(16))) char smem[SMEM_BYTES];
  __shared__ uint4 xb_words;
  cg::grid_group grid = cg::this_grid();
  if (threadIdx.x == 0) xb_words = make_uint4(0u, 0u, 0u, 0u);
  __syncthreads();
  XcdBarrier xb = xcd_barrier_post((unsigned*)(p.ws + W_BAR), (volatile LAS unsigned*)&xb_words);
  int ph = 0;
#define PH(...)                                                     \
  {                                                                 \
    if (ph >= p.ph_begin && ph < p.ph_end) {                        \
      __VA_ARGS__;                                                  \
      xcd_barrier(xb);                                              \
    }                                                               \
    ++ph;                                                           \
  }
#define PHR(rep, ...)                                               \
  {                                                                 \
    if (ph >= p.ph_begin && ph < p.ph_end) {                        \
      for (int rep_ = 0; rep_ < (rep); ++rep_) {                    \
        __VA_ARGS__;                                                \
        xcd_barrier(xb);                                            \
      }                                                             \
    }                                                               \
    ++ph;                                                           \
  }
#define PH_LAST(...)                                                \
  {                                                                 \
    if (ph >= p.ph_begin && ph < p.ph_end) { __VA_ARGS__; }         \
    ++ph;                                                           \
  }
  bf16_t* wt = (bf16_t*)(p.ws + W_WT);
  bf16_t* U = (bf16_t*)(p.ws + W_U);
  float* X = (float*)(p.ws + W_X);

  {
    if (ph >= p.ph_begin && ph < p.ph_end) { ph_prologue(p, smem); grid.sync(); }
    ++ph;
    if (threadIdx.x == 0) {
      unsigned* bar = (unsigned*)(p.ws + W_BAR);
      unsigned base = 0;
      for (unsigned jx = 0; jx < 16; ++jx) { const unsigned c = xb_ld(&bar[XB_XCNT(jx)]); base += (jx < xb.x) ? c : 0u; }
      volatile LAS unsigned* st = (volatile LAS unsigned*)&xb_words;
      st[3] = base + st[2];
    }
    __syncthreads();
  }

#pragma nounroll
  for (int layer = 0; layer < 4; ++layer) {
    const int kind = layer % 3;
    PHR(REP_MISC, ph_rmsnorm(p, kind == 2 ? 1 : 0, p.in[I_NMIX] + layer * 1024));
    if (kind == 0) {
      const int ia = layer / 3;
      PHR(REP_GEMM, {
        GJob j = mkjob(U, 1024, wt + WA_IN + (size_t)ia * 2048 * 1024, 1024, 1024, 2048);
        j.o0 = p.ws + SA_XB; j.o1 = p.ws + SA_GT;
        int toff = 0; gemm_run<EPI_LRU_IN, false>(j, 8, toff, smem, VBLOCK());
      });
      PHR(REP_MISC, (ph_conv<1024, false>((const bf16_t*)(p.ws + SA_XB), (bf16_t*)(p.ws + SA_XC),
                               p.in[I_LRU_CW] + (size_t)ia * 4 * 1024, p.in[I_LRU_CB] + (size_t)ia * 1024,
                               p.in[I_ST_LC] + (size_t)ia * 128 * 3 * 1024,
                               p.out + O_LC_P + (size_t)ia * 8 * 3 * 1024, p.out + O_LC_S + (size_t)ia * 128 * 3 * 1024)));
      PHR(REP_GEMM, {
        const int G = gridDim.x;
        for (int tile = VBLOCK(); tile < MT_ * 8; tile += G) {
          const int mt = tile >> 3, jt = tile & 7;
          GJob j = mkjob((const bf16_t*)(p.ws + SA_XC) + jt * 128, 1024,
                         wt + WA_G + (size_t)ia * 2048 * 128, 128, 128, 2048);
          j.o0 = p.ws + SA_AA; j.o1 = p.ws + SA_XC;
          j.x0 = p.in[I_LRU_BR] + ia * 1024; j.x1 = p.in[I_LRU_BI] + ia * 1024; j.x2 = p.in[I_LRU_LAM] + ia * 1024;
          gemm_tile_dma<EPI_GATES>(j, mt * 128, jt * 256, 0, 4, smem);
        }
      });
      PHR(REP_MISC, ph_lru_scan1(p));
      PH(ph_lru_scan2(p, ia));
      PH({
        GJob j = mkjob((const bf16_t*)(p.ws + SA_GT), 1024, wt + WA_OUT + (size_t)ia * 1024 * 1024, 1024, 1024, 1024);
        j.o0 = X;
        gemm_streamk<EPI_RESID>(j, 4, smem, VBLOCK(), (unsigned*)(p.ws + W_BAR) + 4096, (unsigned)(layer * 2 + 1));
      });
    } else if (kind == 1) {
      PHR(REP_GEMM, {
        GJob j = mkjob(U, 1024, wt + WB_XBC, 1024, 1024, 4128);
        j.o0 = p.ws + SB_XBCP; j.o1 = p.ws + SB_DT; j.x0 = p.in[I_SSM_DTB];
        int toff = 0; gemm_run<EPI_SSM_XBC, false>(j, 17, toff, smem, VBLOCK());
      });
      PHR(REP_MISC, (ph_conv<4096, true>((const bf16_t*)(p.ws + SB_XBCP), (bf16_t*)(p.ws + SB_XBC),
                              p.in[I_SSM_CW], p.in[I_SSM_CB], p.in[I_ST_SC],
                              p.out + O_SC_P, p.out + O_SC_S)));
      PHR(REP_SSD, ph_ssd(p, smem));
      PH({
        GJob j = mkjob(U, 1024, wt + WB_Z, 1024, 1024, 2048);
        j.o0 = p.ws + SB_Y;
        int toff = 0; gemm_run<EPI_SSM_Z, false>(j, 8, toff, smem, VBLOCK());
      });
      PH(ph_gnorm(p));
      PH({
        GJob j = mkjob((const bf16_t*)(p.ws + SB_Y), 2048, wt + WB_OUT, 2048, 2048, 1024);
        j.o0 = X;
        gemm_streamk<EPI_RESID>(j, 4, smem, VBLOCK(), (unsigned*)(p.ws + W_BAR) + 4096, (unsigned)(layer * 2 + 1));
      });
    } else {
      PHR(REP_GEMM, {
        int toff = 0;
        for (int s = 0; s < 3; ++s) {
          GJob j = mkjob(U, 1024, wt + WC_RKV + (size_t)s * 1024 * 1024, 1024, 1024, 1024);
          j.A2 = (const bf16_t*)(p.ws + SC_UP); j.mu = p.in[I_RW_MU] + s * 1024;
          j.o0 = p.ws + SC_R + (size_t)s * SZ_TD2; j.ldo = 1024; j.act = 0;
          gemm_run<EPI_ST, true>(j, 8, toff, smem, VBLOCK());
        }
        for (int s = 0; s < 3; ++s) {
          const int nv = (s == 2) ? 128 : 64;
          GJob j = mkjob(U, 1024, wt + WC_L1 + (size_t)s * 64 * 1024, 1024, 1024, nv);
          j.A2 = (const bf16_t*)(p.ws + SC_UP); j.mu = p.in[I_RW_MU] + (3 + s) * 1024;
          j.o0 = p.ws + SC_LH + (size_t)s * 64 * 2; j.ldo = 256; j.act = (s == 0) ? 1 : (s == 2 ? 2 : 0);
          gemm_run<EPI_ST, true>(j, 1, toff, smem, VBLOCK());
        }
      });
      PHR(REP_GEMM, {
        int toff = 0;
        const bf16_t* LH = (const bf16_t*)(p.ws + SC_LH);
        {
          GJob j = mkjob(LH, 256, wt + WC_W2, 64, 64, 1024);
          j.o0 = p.ws + SC_WD; j.x0 = p.in[I_RW_W0];
          gemm_run<EPI_DECAY, false>(j, 4, toff, smem, VBLOCK());
        }
        {
          GJob j = mkjob(LH + 64, 256, wt + WC_A2, 64, 64, 1024);
          j.o0 = p.ws + SC_AA; j.x0 = p.in[I_RW_A0];
          gemm_run<EPI_SIGB, false>(j, 4, toff, smem, VBLOCK());
        }
        {
          GJob j = mkjob(LH + 128, 256, wt + WC_G2, 128, 128, 1024);
          j.o0 = p.ws + SC_G; j.ldo = 1024; j.act = 0;
          gemm_run<EPI_ST, false>(j, 4, toff, smem, VBLOCK());
        }
      });
      PHR(REP_WKV, ph_wkv<8>(p, smem));
      PHR(REP_MISC, ph_wkv_post(p));
      PH({
        GJob j = mkjob(U, 1024, wt + WC_OUT, 1024, 1024, 1024);
        j.o0 = X;
        gemm_streamk<EPI_RESID>(j, 4, smem, VBLOCK(), (unsigned*)(p.ws + W_BAR) + 4096, (unsigned)(layer * 2 + 1));
      });
    }
    PHR(REP_MISC, ph_rmsnorm(p, 0, p.in[I_NFFN] + layer * 1024));
    PHR(REP_GEMM, {
      GJob j = mkjob(U, 1024, wt + WF_1 + (size_t)layer * 4096 * 1024, 1024, 1024, 4096);
      j.o0 = p.ws + S_HB;
      int toff = 0; gemm_run<EPI_FFN1, false>(j, 16, toff, smem, VBLOCK());
    });
    PH({
      GJob j = mkjob((const bf16_t*)(p.ws + S_HB), 4096, wt + WF_2 + (size_t)layer * 4096 * 1024, 4096, 4096, 1024);
      j.o0 = X;
      gemm_streamk<EPI_RESID>(j, 4, smem, VBLOCK(), (unsigned*)(p.ws + W_BAR) + 4096, (unsigned)(layer * 2 + 2));
    });
  }
  PH_LAST(ph_rmsnorm(p, 2, p.in[I_NFIN]));
#undef PH
#undef PH_LAST
}

extern "C" void kernel_launch(void* const* d_in, const int* in_sizes, int n_in, void* d_out, int out_size,
                              void* d_ws, size_t ws_size, hipStream_t stream) {
  Params p;
  memset(&p, 0, sizeof(p));
  for (int i = 0; i < N_IN; ++i) p.in[i] = (const float*)d_in[i];
  p.out = (float*)d_out;
  p.ws = (char*)d_ws;
  p.ph_begin = 0;
  p.ph_end = 1000;
  static int grid_blocks = 0;
  if (!grid_blocks) {
    int dev = 0, cus = 0, per_cu = 0;
    hipGetDevice(&dev);
    hipDeviceGetAttribute(&cus, hipDeviceAttributeMultiprocessorCount, dev);
    hipOccupancyMaxActiveBlocksPerMultiprocessor(&per_cu, mega, NTHR, 0);
    if (per_cu > 2) per_cu = 2;
    if (per_cu < 1) per_cu = 1;
    grid_blocks = cus * per_cu;
  }
  if (ws_size < (size_t)536870912) fprintf(stderr, "workspace too small: %zu\n", ws_size);
  (void)hipMemsetAsync((char*)d_ws + W_BAR, 0, (4096 + 1024) * 4, stream);
  void* args[] = {&p};
  hipError_t e = hipLaunchCooperativeKernel((void*)mega, dim3(grid_blocks), dim3(NTHR), args, 0, stream);
  if (e != hipSuccess) fprintf(stderr, "cooperative launch failed: %s (grid %d)\n", hipGetErrorString(e), grid_blocks);
}
```

```cpp
#include <hip/hip_runtime.h>
#include <hip/hip_cooperative_groups.h>
#include <stdint.h>
#include <stdio.h>
#include <string.h>
namespace cg = cooperative_groups;

typedef unsigned short bf16_t;
typedef __attribute__((ext_vector_type(8))) short bf16x8;
typedef __attribute__((ext_vector_type(16))) float f32x16;

#define DI __device__ __forceinline__

constexpr int T_ = 17408;
constexpr int TP_ = 16384;
constexpr int NTHR = 256;
constexpr int MT_ = T_ / 128;

enum {
  I_XP = 0, I_XS, I_ST_LC, I_ST_LH, I_ST_SC, I_ST_SS, I_ST_RS, I_ST_RW,
  I_NMIX, I_NFFN, I_NFIN,
  I_LRU_WIN, I_LRU_CW, I_LRU_CB, I_LRU_WR, I_LRU_BR, I_LRU_WI, I_LRU_BI, I_LRU_LAM, I_LRU_WOUT,
  I_SSM_WIN, I_SSM_CW, I_SSM_CB, I_SSM_DTB, I_SSM_ALOG, I_SSM_D, I_SSM_NW, I_SSM_WOUT,
  I_RW_MU, I_RW_WRKV, I_RW_W0, I_RW_WW1, I_RW_WW2, I_RW_A0, I_RW_WA1, I_RW_WA2, I_RW_WG1, I_RW_WG2,
  I_RW_KK, I_RW_KA, I_RW_RK, I_RW_LNW, I_RW_LNB, I_RW_WOUT,
  I_FFN_W1, I_FFN_W2, N_IN
};

constexpr size_t O_Y = 0;
constexpr size_t O_LC_P = O_Y + (size_t)T_ * 1024;
constexpr size_t O_LC_S = O_LC_P + 2 * 8 * 3 * 1024;
constexpr size_t O_LH_P = O_LC_S + 2 * 128 * 3 * 1024;
constexpr size_t O_LH_S = O_LH_P + 2 * 8 * 1024;
constexpr size_t O_SC_P = O_LH_S + 2 * 128 * 1024;
constexpr size_t O_SC_S = O_SC_P + 8 * 3 * 4096;
constexpr size_t O_SS_P = O_SC_S + 128 * 3 * 4096;
constexpr size_t O_SS_S = O_SS_P + (size_t)8 * 32 * 64 * 128;
constexpr size_t O_RS_P = O_SS_S + (size_t)128 * 32 * 64 * 128;
constexpr size_t O_RS_S = O_RS_P + 8 * 1024;
constexpr size_t O_RW_P = O_RS_S + 128 * 1024;
constexpr size_t O_RW_S = O_RW_P + 8 * 16 * 64 * 64;

constexpr size_t W_X = 0;
constexpr size_t W_U = W_X + (size_t)T_ * 1024 * 4;
constexpr size_t W_WT = W_U + (size_t)T_ * 1024 * 2;
constexpr size_t WA_IN = 0;
constexpr size_t WA_G = WA_IN + 2 * 2048 * 1024;
constexpr size_t WA_OUT = WA_G + 2 * 2048 * 128;
constexpr size_t WB_XBC = WA_OUT + 2 * 1024 * 1024;
constexpr size_t WB_Z = WB_XBC + 4128 * 1024;
constexpr size_t WB_OUT = WB_Z + 2048 * 1024;
constexpr size_t WC_RKV = WB_OUT + 1024 * 2048;
constexpr size_t WC_L1 = WC_RKV + 3 * 1024 * 1024;
constexpr size_t WC_W2 = WC_L1 + 256 * 1024;
constexpr size_t WC_A2 = WC_W2 + 1024 * 64;
constexpr size_t WC_G2 = WC_A2 + 1024 * 64;
constexpr size_t WC_OUT = WC_G2 + 1024 * 128;
constexpr size_t WF_1 = WC_OUT + 1024 * 1024;
constexpr size_t WF_2 = WF_1 + (size_t)4 * 4096 * 1024;
constexpr size_t W_WT_ELEMS = WF_2 + (size_t)4 * 4096 * 1024;
constexpr size_t W_S = W_WT + W_WT_ELEMS * 2;
constexpr size_t SZ_TD2 = (size_t)T_ * 1024 * 2;
constexpr size_t SZ_TD4 = (size_t)T_ * 1024 * 4;
constexpr size_t S_HB = W_S;
constexpr size_t SA_XB = W_S;
constexpr size_t SA_GT = SA_XB + SZ_TD2;
constexpr size_t SA_XC = SA_GT + SZ_TD2;
constexpr size_t SA_AA = SA_XC + SZ_TD2;
constexpr size_t SA_BB = SA_AA + SZ_TD4;
constexpr size_t SA_CP = SA_BB + SZ_TD4;
constexpr size_t SA_CS = SA_CP + 8 * 64 * 1024 * 4;
constexpr size_t SB_XBCP = W_S;
constexpr size_t SB_Y = W_S;
constexpr size_t SB_XBC = SB_XBCP + SZ_TD2 * 4;
constexpr size_t SB_DT = SB_XBC + SZ_TD2 * 4;
constexpr size_t SC_UP = W_S;
constexpr size_t SC_O = W_S;
constexpr size_t SC_R = SC_UP + SZ_TD2;
constexpr size_t SC_K = SC_R + SZ_TD2;
constexpr size_t SC_V = SC_K + SZ_TD2;
constexpr size_t SC_LH = SC_V + SZ_TD2;
constexpr size_t SC_WD = SC_LH + (size_t)T_ * 256 * 2;
constexpr size_t SC_AA = SC_WD + SZ_TD4;
constexpr size_t SC_G = SC_AA + SZ_TD2;
constexpr size_t SC_END = SC_G + SZ_TD2;
static_assert(SC_END <= (size_t)536870912, "ws overflow C");
static_assert(SB_DT + (size_t)T_ * 32 * 4 <= (size_t)536870912, "ws overflow B");
static_assert(SA_CS + 8 * 64 * 1024 * 4 <= (size_t)536870912, "ws overflow A");

constexpr int SMEM_BYTES = 80384;
constexpr size_t W_BAR = (size_t)536870912 - 65536;

struct Params {
  const float* in[N_IN];
  float* out;
  char* ws;
  int ph_begin, ph_end;
};

DI float bf2f(bf16_t h) { return __uint_as_float(((unsigned)h) << 16); }
DI bf16_t f2bf(float f) {
  unsigned u = __float_as_uint(f);
  u += 0x7FFFu + ((u >> 16) & 1u);
  return (bf16_t)(u >> 16);
}
DI unsigned pack2(float a, float b) { return (unsigned)f2bf(a) | ((unsigned)f2bf(b) << 16); }
DI void unpack8(const uint4 v, float (&f)[8]) {
  f[0] = __uint_as_float(v.x << 16); f[1] = __uint_as_float(v.x & 0xFFFF0000u);
  f[2] = __uint_as_float(v.y << 16); f[3] = __uint_as_float(v.y & 0xFFFF0000u);
  f[4] = __uint_as_float(v.z << 16); f[5] = __uint_as_float(v.z & 0xFFFF0000u);
  f[6] = __uint_as_float(v.w << 16); f[7] = __uint_as_float(v.w & 0xFFFF0000u);
}
DI void unpack4(const uint2 v, float (&f)[4]) {
  f[0] = __uint_as_float(v.x << 16); f[1] = __uint_as_float(v.x & 0xFFFF0000u);
  f[2] = __uint_as_float(v.y << 16); f[3] = __uint_as_float(v.y & 0xFFFF0000u);
}
DI uint4 pack8(const float (&f)[8]) {
  return make_uint4(pack2(f[0], f[1]), pack2(f[2], f[3]), pack2(f[4], f[5]), pack2(f[6], f[7]));
}
DI void load8f(const float* p, float (&f)[8]) {
  float4 a = *(const float4*)p, b = *(const float4*)(p + 4);
  f[0] = a.x; f[1] = a.y; f[2] = a.z; f[3] = a.w; f[4] = b.x; f[5] = b.y; f[6] = b.z; f[7] = b.w;
}
DI void store8f(float* p, const float (&f)[8]) {
  *(float4*)p = make_float4(f[0], f[1], f[2], f[3]);
  *(float4*)(p + 4) = make_float4(f[4], f[5], f[6], f[7]);
}
DI float sigmoidf_(float x) { return 1.f / (1.f + __expf(-x)); }
DI float siluf_(float x) { return x / (1.f + __expf(-x)); }
DI float tanhf_(float y) { return 1.f - 2.f / (1.f + __expf(2.f * y)); }
DI float geluf_(float x) { return 0.5f * x * (1.f + tanhf_(0.7978845608028654f * (x + 0.044715f * x * x * x))); }
DI float softplusf_(float x) { return fmaxf(x, 0.f) + log1pf(__expf(-fabsf(x))); }
DI float wave_sum(float v) {
#pragma unroll
  for (int o = 32; o >= 1; o >>= 1) v += __shfl_xor(v, o, 64);
  return v;
}
template <int CTRL> DI float dppf(float x) {
  return __int_as_float(__builtin_amdgcn_update_dpp(0, __float_as_int(x), CTRL, 0xf, 0xf, false));
}
template <int N> DI float red_lanes(float x) {
  x += dppf<0xB1>(x);
  x += dppf<0x4E>(x);
  if (N >= 8) x += dppf<0x141>(x);
  if (N >= 16) x += dppf<0x140>(x);
  return x;
}
DI void tok_info(int t, int& seq, int& l, int& L) {
  if (t < TP_) { seq = t >> 11; l = t & 2047; L = 2048; }
  else { int u = t - TP_; seq = 8 + (u >> 3); l = u & 7; L = 8; }
}
DI int opq(int x) { asm volatile("" : "+v"(x)); return x; }
#define TIDX opq((int)threadIdx.x)
DI f32x16 mfma32(bf16x8 a, bf16x8 b, f32x16 c) { return __builtin_amdgcn_mfma_f32_32x32x16_bf16(a, b, c, 0, 0, 0); }


#define XB_TMO      128
#define XB_XCNT(j)  (256  + 64 * (j))
#define XB_XSUB(j)  (1280 + 64 * (j))
#define XB_XGEN(j)  (2304 + 64 * (j))
#define XB_TOP      3328
#define XB_TOPGEN   3392
#define XCD_BAR_WORDS 3456
#define XB_SPIN_CAP (1u << 22)
#define LAS __attribute__((address_space(3)))
DI unsigned xb_ld(unsigned* p) { return __hip_atomic_load(p, __ATOMIC_RELAXED, __HIP_MEMORY_SCOPE_AGENT); }
DI unsigned xb_add(unsigned* p, unsigned v) { return __hip_atomic_fetch_add(p, v, __ATOMIC_RELAXED, __HIP_MEMORY_SCOPE_AGENT); }
DI unsigned xb_xcc_id() { return (unsigned)__builtin_amdgcn_s_getreg((3 << 11) | 20) & 0xFu; }
#define XB_SPIN(cond, bar) do { unsigned _sp = 0; while (cond) { __builtin_amdgcn_s_sleep(1); \
    if ((++_sp & 255u) == 0u) { if (xb_ld(&(bar)[XB_TMO])) break; if (_sp > XB_SPIN_CAP) { atomicAdd(&(bar)[XB_TMO], 1u); break; } } } } while (0)
struct XcdBarrier { unsigned* bar; unsigned x; volatile LAS unsigned* st; };
DI XcdBarrier xcd_barrier_post(unsigned* bar, volatile LAS unsigned* st) {
  XcdBarrier b; b.bar = bar; b.x = xb_xcc_id(); b.st = st;
  if (threadIdx.x == 0) st[2] = xb_add(&bar[XB_XCNT(b.x)], 1u);
  return b;
}
DI void xcd_barrier_complete(unsigned* bar, unsigned x, unsigned& nloc, unsigned& nx) {
  const unsigned G = gridDim.x * gridDim.y * gridDim.z;
  unsigned sum, cnt, mine, sp = 0u;
  for (;;) {
    sum = 0u; cnt = 0u; mine = 0u;
#pragma unroll
    for (unsigned j = 0; j < 16; ++j) { const unsigned c = xb_ld(&bar[XB_XCNT(j)]); sum += c; cnt += (c > 0u) ? 1u : 0u; mine = (j == x) ? c : mine; }
    if (sum == G) break;
    __builtin_amdgcn_s_sleep(1);
    if ((++sp & 255u) == 0u) { if (xb_ld(&bar[XB_TMO])) break; if (sp > XB_SPIN_CAP) { atomicAdd(&bar[XB_TMO], 1u); break; } }
  }
  nloc = mine > 0u ? mine : 1u; nx = cnt > 0u ? cnt : 1u;
}
DI void xcd_barrier(const XcdBarrier& b) {
  asm volatile("s_waitcnt vmcnt(0)" ::: "memory");
  __syncthreads();
  if (threadIdx.x == 0) {
    unsigned* bar = b.bar;
    __builtin_amdgcn_s_waitcnt(0);
    unsigned nloc = b.st[0], nx = b.st[1];
    if (nloc == 0u) { xcd_barrier_complete(bar, b.x, nloc, nx); b.st[0] = nloc; b.st[1] = nx; }
    const unsigned old = xb_add(&bar[XB_XSUB(b.x)], 1u);
    const unsigned gen = old / nloc;
    if (old + 1u == (gen + 1u) * nloc) {
      __builtin_amdgcn_fence(__ATOMIC_RELEASE, "agent");
      asm volatile("s_waitcnt vmcnt(0)" ::: "memory");
      const unsigned og = xb_add(&bar[XB_TOP], 1u);
      const unsigned tg = og / nx;
      if (og + 1u == (tg + 1u) * nx) xb_add(&bar[XB_TOPGEN], 1u);
      else XB_SPIN(xb_ld(&bar[XB_TOPGEN]) == tg, bar);
      __builtin_amdgcn_fence(__ATOMIC_ACQUIRE, "agent");
      xb_add(&bar[XB_XGEN(b.x)], 1u);
      asm volatile("s_waitcnt vmcnt(0)" ::: "memory");
    } else {
      XB_SPIN(xb_ld(&bar[XB_XGEN(b.x)]) == gen, bar);
      __builtin_amdgcn_fence(__ATOMIC_ACQUIRE, "agent");
      asm volatile("s_waitcnt vmcnt(0)" ::: "memory");
    }
  }
  __syncthreads();
}

struct GJob {
  const bf16_t* A; const bf16_t* A2; const float* mu; const bf16_t* Bt;
  int lda, ldb, K, nvalid;
  void* o0; void* o1; const float* x0; const float* x1; const float* x2;
  int ldo, act;
};
enum { EPI_LRU_IN = 0, EPI_GATES, EPI_RESID, EPI_SSM_XBC, EPI_SSM_Z, EPI_FFN1, EPI_ST, EPI_DECAY, EPI_SIGB };

template <int EPI> DI void epi_elem(const GJob& j, int row, int col, float v) {
  if (EPI == EPI_LRU_IN) {
    if (col < 1024) ((bf16_t*)j.o0)[(size_t)row * 1024 + col] = f2bf(v);
    else ((bf16_t*)j.o1)[(size_t)row * 1024 + col - 1024] = f2bf(geluf_(v));
  } else if (EPI == EPI_RESID) {
    unsafeAtomicAdd((float*)j.o0 + (size_t)row * 1024 + col, v);
  } else if (EPI == EPI_SSM_XBC) {
    if (col < 4096) ((bf16_t*)j.o0)[(size_t)row * 4096 + col] = f2bf(v);
  } else if (EPI == EPI_SSM_Z) {
    bf16_t* y = (bf16_t*)j.o0 + (size_t)row * 2048 + col;
    *y = f2bf(bf2f(*y) * siluf_(v));
  } else if (EPI == EPI_FFN1) {
    float r = fmaxf(v, 0.f);
    ((bf16_t*)j.o0)[(size_t)row * 4096 + col] = f2bf(r * r);
  } else if (EPI == EPI_ST) {
    if (col < j.nvalid) {
      float r = v;
      if (j.act == 1) r = tanhf_(v); else if (j.act == 2) r = sigmoidf_(v);
      ((bf16_t*)j.o0)[(size_t)row * j.ldo + col] = f2bf(r);
    }
  } else if (EPI == EPI_DECAY) {
    float wl = -softplusf_(-(j.x0[col] + v)) - 0.5f;
    ((float*)j.o0)[(size_t)row * 1024 + col] = __expf(-__expf(wl));
  } else if (EPI == EPI_SIGB) {
    ((bf16_t*)j.o0)[(size_t)row * 1024 + col] = f2bf(sigmoidf_(j.x0[col] + v));
  }
}

template <int EPI, bool MIX>
DI void gemm_tile(const GJob& j, int m0, int n0, int kt0, int kt1, char* smem) {
  const int tid = TIDX, lane = tid & 63, w = tid >> 6;
  const int wm = w >> 1, wn = w & 1, r32 = lane & 31, hh = lane >> 5;
  const int lrow = tid >> 3, kc = tid & 7;
  f32x16 acc[2][2];
#pragma unroll
  for (int a = 0; a < 2; ++a)
#pragma unroll
    for (int b = 0; b < 2; ++b)
#pragma unroll
      for (int r = 0; r < 16; ++r) acc[a][b][r] = 0.f;
  uint4 qa00, qa01, qa02, qa03, qb00, qb01, qb02, qb03, qc00, qc01, qc02, qc03;
  uint4 qa10, qa11, qa12, qa13, qb10, qb11, qb12, qb13, qc10, qc11, qc12, qc13;
  qc00 = qc01 = qc02 = qc03 = qc10 = qc11 = qc12 = qc13 = make_uint4(0, 0, 0, 0);
  const int nk = kt1 - kt0;
  const bf16_t* Ap = j.A + (size_t)(m0 + lrow) * j.lda + kc * 8 + (size_t)kt0 * 64;
  const bf16_t* A2p = MIX ? (j.A2 + (size_t)(m0 + lrow) * j.lda + kc * 8 + (size_t)kt0 * 64) : nullptr;
  const bf16_t* Bp = j.Bt + (size_t)(n0 + lrow) * j.ldb + kc * 8 + (size_t)kt0 * 64;
  const size_t astep = (size_t)32 * j.lda, bstep = (size_t)32 * j.ldb;
  const bool bv0 = (n0 + lrow) < j.nvalid, bv1 = (n0 + lrow + 32) < j.nvalid;
  const bool bv2 = (n0 + lrow + 64) < j.nvalid, bv3 = (n0 + lrow + 96) < j.nvalid;
  const uint4 z4 = make_uint4(0, 0, 0, 0);

#define LD1(s, i, kt)                                                                 \
  qa##s##i = *(const uint4*)(Ap + i * astep + (kt) * 64);                             \
  if (MIX) qc##s##i = *(const uint4*)(A2p + i * astep + (kt) * 64);                   \
  qb##s##i = z4;                                                                      \
  if (bv##i) qb##s##i = *(const uint4*)(Bp + i * bstep + (kt) * 64);
#define GLOAD(s, kt) { LD1(s, 0, kt) LD1(s, 1, kt) LD1(s, 2, kt) LD1(s, 3, kt) }
#define ST1(s, i, As_, Bs_)                                                           \
  if (MIX) {                                                                          \
    float f1[8], f2[8]; unpack8(qa##s##i, f1); unpack8(qc##s##i, f2);                 \
    _Pragma("unroll") for (int e = 0; e < 8; ++e) f1[e] = f1[e] + (f2[e] - f1[e]) * mu8[e]; \
    qa##s##i = pack8(f1);                                                             \
  }                                                                                   \
  *(uint4*)(As_ + (lrow + 32 * i) * 144 + kc * 16) = qa##s##i;                        \
  *(uint4*)(Bs_ + (lrow + 32 * i) * 144 + kc * 16) = qb##s##i;
#define SSTORE(s, kt, buf)                                                            \
  {                                                                                   \
    char* As_ = smem + (buf) * 36864; char* Bs_ = As_ + 18432;                        \
    float mu8[8];                                                                     \
    if (MIX) load8f(j.mu + (kt0 + (kt)) * 64 + kc * 8, mu8);                          \
    ST1(s, 0, As_, Bs_) ST1(s, 1, As_, Bs_) ST1(s, 2, As_, Bs_) ST1(s, 3, As_, Bs_)   \
  }
#define LOADF(F, ks)                                                                  \
  bf16x8 F##a0 = *(const bf16x8*)(ap + (ks) * 32);                                    \
  bf16x8 F##a1 = *(const bf16x8*)(ap + 32 * 144 + (ks) * 32);                         \
  bf16x8 F##b0 = *(const bf16x8*)(bp + (ks) * 32);                                    \
  bf16x8 F##b1 = *(const bf16x8*)(bp + 32 * 144 + (ks) * 32);
#define MFMA4(F)                                                                      \
  acc[0][0] = mfma32(F##a0, F##b0, acc[0][0]);                                        \
  acc[0][1] = mfma32(F##a0, F##b1, acc[0][1]);                                        \
  acc[1][0] = mfma32(F##a1, F##b0, acc[1][0]);                                        \
  acc[1][1] = mfma32(F##a1, F##b1, acc[1][1]);
#define COMPUTE(buf)                                                                  \
  {                                                                                   \
    const char* As_ = smem + (buf) * 36864; const char* Bs_ = As_ + 18432;            \
    const char* ap = As_ + (wm * 64 + r32) * 144 + hh * 16;                           \
    const char* bp = Bs_ + (wn * 64 + r32) * 144 + hh * 16;                           \
    LOADF(f0, 0) LOADF(f1, 1)                                                         \
    __builtin_amdgcn_sched_barrier(0);                                                \
    MFMA4(f0)                                                                         \
    LOADF(f2, 2)                                                                      \
    __builtin_amdgcn_sched_barrier(0);                                                \
    MFMA4(f1)                                                                         \
    LOADF(f3, 3)                                                                      \
    __builtin_amdgcn_sched_barrier(0);                                                \
    MFMA4(f2)                                                                         \
    __builtin_amdgcn_sched_barrier(0);                                                \
    MFMA4(f3)                                                                         \
    __builtin_amdgcn_sched_barrier(0);                                                \
  }

  qa10 = qa11 = qa12 = qa13 = qb10 = qb11 = qb12 = qb13 = z4;
  if (MIX) {
    GLOAD(0, 0);
    SSTORE(0, 0, 0);
    __syncthreads();
    for (int i = 0; i < nk; ++i) {
      if (i + 1 < nk) GLOAD(0, i + 1);
      if (i & 1) { COMPUTE(1); } else { COMPUTE(0); }
      if (i + 1 < nk) { if (i & 1) { SSTORE(0, i + 1, 0); } else { SSTORE(0, i + 1, 1); } }
      __syncthreads();
    }
  } else if (nk == 1) {
    GLOAD(0, 0);
    SSTORE(0, 0, 0);
    __syncthreads();
    COMPUTE(0);
    __syncthreads();
  } else {
    GLOAD(0, 0);
    GLOAD(1, 1);
    SSTORE(0, 0, 0);
    __syncthreads();
#pragma unroll 1
    for (int i = 0; i + 2 < nk; i += 2) {
      GLOAD(0, i + 2);
      COMPUTE(0);
      SSTORE(1, i + 1, 1);
      __syncthreads();
      GLOAD(1, i + 3);
      COMPUTE(1);
      SSTORE(0, i + 2, 0);
      __syncthreads();
    }
    COMPUTE(0);
    SSTORE(1, nk - 1, 1);
    __syncthreads();
    COMPUTE(1);
    __syncthreads();
  }
#undef LD1
#undef ST1
#undef LOADF
#undef MFMA4
#undef GLOAD
#undef SSTORE
#undef COMPUTE

  if (EPI == EPI_GATES) {
    const int ch = (n0 >> 7) * 64 + wn * 32 + r32;
    const float br = j.x0[ch], bi = j.x1[ch];
    const float spl = softplusf_(-j.x2[ch]);
    const bf16_t* XC = (const bf16_t*)j.o1;
    float* AA = (float*)j.o0;
    float* BBp = AA + (size_t)T_ * 1024;
#pragma unroll
    for (int mi = 0; mi < 2; ++mi)
#pragma unroll
      for (int r = 0; r < 16; ++r) {
        const int row = m0 + wm * 64 + mi * 32 + (r & 3) + 8 * (r >> 2) + 4 * hh;
        const float rg = sigmoidf_(acc[mi][0][r] + br);
        const float ig = sigmoidf_(acc[mi][1][r] + bi);
        const float la = -8.f * rg * spl;
        const float xc = bf2f(XC[(size_t)row * 1024 + ch]);
        const bool reset = (row < TP_) && ((row & 2047) == 0);
        const float a = reset ? 0.f : __expf(la);
        const float mult = reset ? 1.f : sqrtf(fmaxf(-expm1f(2.f * la), 0.f));
        AA[(size_t)row * 1024 + ch] = a;
        BBp[(size_t)row * 1024 + ch] = mult * ig * xc;
      }
  } else {
#pragma unroll
    for (int mi = 0; mi < 2; ++mi)
#pragma unroll
      for (int ni = 0; ni < 2; ++ni)
#pragma unroll
        for (int r = 0; r < 16; ++r) {
          const int row = m0 + wm * 64 + mi * 32 + (r & 3) + 8 * (r >> 2) + 4 * hh;
          const int col = n0 + wn * 64 + ni * 32 + r32;
          epi_elem<EPI>(j, row, col, acc[mi][ni][r]);
          if ((r & 7) == 7) __builtin_amdgcn_sched_barrier(0);
        }
  }
}

constexpr int DSLOT = 24576;
template <int EPI>
DI void gemm_tile_dma(const GJob& j, int m0, int n0, int k0, int k1, char* smem, unsigned* wflag = nullptr, unsigned epoch = 0u) {
  const int tid = TIDX, lane = tid & 63, w = tid >> 6;
  const int wm = w >> 1, wn = w & 1, r32 = lane & 31, hh = lane >> 5;
  f32x16 acc[2][4];
#pragma unroll
  for (int a = 0; a < 2; ++a)
#pragma unroll
    for (int b = 0; b < 4; ++b)
#pragma unroll
      for (int r = 0; r < 16; ++r) acc[a][b][r] = 0.f;
  const int nk = k1 - k0;
  const int dr = lane >> 2;
  const int dc = (lane & 3) ^ ((lane >> 4) & 3);
  const int nlim = j.nvalid - 1;
  const size_t kofs = (size_t)k0 * 32 + dc * 8;
  const bf16_t* gA0 = j.A + (size_t)(m0 + 32 * w + dr) * j.lda + kofs;
  const bf16_t* gA1 = j.A + (size_t)(m0 + 32 * w + 16 + dr) * j.lda + kofs;
  const bf16_t* gB0 = j.Bt + (size_t)min(n0 + 64 * w + dr, nlim) * j.ldb + kofs;
  const bf16_t* gB1 = j.Bt + (size_t)min(n0 + 64 * w + 16 + dr, nlim) * j.ldb + kofs;
  const bf16_t* gB2 = j.Bt + (size_t)min(n0 + 64 * w + 32 + dr, nlim) * j.ldb + kofs;
  const bf16_t* gB3 = j.Bt + (size_t)min(n0 + 64 * w + 48 + dr, nlim) * j.ldb + kofs;
  char* ldsA = smem + (2 * w) * 1024 + lane * 16;
  char* ldsB = smem + 8192 + (4 * w) * 1024 + lane * 16;
  const unsigned lbase = (unsigned)(unsigned long long)(LAS char*)smem;
  const int fsw = (r32 >> 2) & 3;
  const unsigned pa = (unsigned)((wm * 64 + r32) * 64), pb = (unsigned)(8192 + (wn * 128 + r32) * 64);
  const unsigned po0 = (unsigned)(((hh) ^ fsw) * 16), po1 = (unsigned)(((2 + hh) ^ fsw) * 16);

#define ISSUE(kt, slot)                                                                          \
  {                                                                                              \
    const int ko_ = (kt) * 32;                                                                   \
    char* la_ = ldsA + (slot) * DSLOT; char* lb_ = ldsB + (slot) * DSLOT;                        \
    __builtin_amdgcn_global_load_lds((const unsigned*)(gA0 + ko_), (unsigned*)(la_), 16, 0, 0);  \
    __builtin_amdgcn_global_load_lds((const unsigned*)(gA1 + ko_), (unsigned*)(la_ + 1024), 16, 0, 0); \
    __builtin_amdgcn_global_load_lds((const unsigned*)(gB0 + ko_), (unsigned*)(lb_), 16, 0, 0);  \
    __builtin_amdgcn_global_load_lds((const unsigned*)(gB1 + ko_), (unsigned*)(lb_ + 1024), 16, 0, 0); \
    __builtin_amdgcn_global_load_lds((const unsigned*)(gB2 + ko_), (unsigned*)(lb_ + 2048), 16, 0, 0); \
    __builtin_amdgcn_global_load_lds((const unsigned*)(gB3 + ko_), (unsigned*)(lb_ + 3072), 16, 0, 0); \
  }

  asm volatile("s_waitcnt vmcnt(0)" ::: "memory");
  const int last = nk - 1;
  ISSUE(0, 0);
  { const int t1 = min(1, last); ISSUE(t1, 1); }
  int sl_r = 0, sl_w = 2;
#pragma unroll 1
  for (int i = 0; i < nk; ++i) {
    asm volatile("s_waitcnt vmcnt(6)" ::: "memory");
    __builtin_amdgcn_s_barrier();
    { const int t2 = min(i + 2, last); ISSUE(t2, sl_w); }
    const unsigned sl = lbase + (unsigned)(sl_r * DSLOT);
    sl_r = (sl_r == 2) ? 0 : sl_r + 1;
    sl_w = (sl_w == 2) ? 0 : sl_w + 1;
    bf16x8 a00, a10, a01, a11, b00, b10, b20, b30, b01, b11, b21, b31;
    const unsigned aA0 = sl + pa + po0, aB0 = sl + pb + po0, aA1 = sl + pa + po1, aB1 = sl + pb + po1;
    asm volatile("ds_read_b128 %0, %1" : "=v"(a00) : "v"(aA0));
    asm volatile("ds_read_b128 %0, %1 offset:2048" : "=v"(a10) : "v"(aA0));
    asm volatile("ds_read_b128 %0, %1" : "=v"(b00) : "v"(aB0));
    asm volatile("ds_read_b128 %0, %1 offset:2048" : "=v"(b10) : "v"(aB0));
    asm volatile("ds_read_b128 %0, %1 offset:4096" : "=v"(b20) : "v"(aB0));
    asm volatile("ds_read_b128 %0, %1 offset:6144" : "=v"(b30) : "v"(aB0));
    asm volatile("ds_read_b128 %0, %1" : "=v"(a01) : "v"(aA1));
    asm volatile("ds_read_b128 %0, %1 offset:2048" : "=v"(a11) : "v"(aA1));
    asm volatile("ds_read_b128 %0, %1" : "=v"(b01) : "v"(aB1));
    asm volatile("ds_read_b128 %0, %1 offset:2048" : "=v"(b11) : "v"(aB1));
    asm volatile("ds_read_b128 %0, %1 offset:4096" : "=v"(b21) : "v"(aB1));
    asm volatile("ds_read_b128 %0, %1 offset:6144" : "=v"(b31) : "v"(aB1));
    asm volatile("s_waitcnt lgkmcnt(0)" : "+v"(a00), "+v"(a10), "+v"(b00), "+v"(b10), "+v"(b20), "+v"(b30),
                 "+v"(a01), "+v"(a11), "+v"(b01), "+v"(b11), "+v"(b21), "+v"(b31) :: "memory");
    acc[0][0] = mfma32(a00, b00, acc[0][0]);
    acc[0][1] = mfma32(a00, b10, acc[0][1]);
    acc[0][2] = mfma32(a00, b20, acc[0][2]);
    acc[0][3] = mfma32(a00, b30, acc[0][3]);
    acc[1][0] = mfma32(a10, b00, acc[1][0]);
    acc[1][1] = mfma32(a10, b10, acc[1][1]);
    acc[1][2] = mfma32(a10, b20, acc[1][2]);
    acc[1][3] = mfma32(a10, b30, acc[1][3]);
    acc[0][0] = mfma32(a01, b01, acc[0][0]);
    acc[0][1] = mfma32(a01, b11, acc[0][1]);
    acc[0][2] = mfma32(a01, b21, acc[0][2]);
    acc[0][3] = mfma32(a01, b31, acc[0][3]);
    acc[1][0] = mfma32(a11, b01, acc[1][0]);
    acc[1][1] = mfma32(a11, b11, acc[1][1]);
    acc[1][2] = mfma32(a11, b21, acc[1][2]);
    acc[1][3] = mfma32(a11, b31, acc[1][3]);
  }
  asm volatile("s_waitcnt vmcnt(0)" ::: "memory");
  __builtin_amdgcn_s_barrier();
#undef ISSUE
  if (wflag) {
    if (threadIdx.x == 0) {
      unsigned sp = 0;
      while (xb_ld(wflag) != epoch) { __builtin_amdgcn_s_sleep(1); if (++sp > (1u << 24)) break; }
      __builtin_amdgcn_fence(__ATOMIC_ACQUIRE, "agent");
      asm volatile("s_waitcnt vmcnt(0)" ::: "memory");
    }
    __syncthreads();
  }

  if (EPI == EPI_GATES) {
    const bf16_t* XC = (const bf16_t*)j.o1;
    float* AA = (float*)j.o0;
    float* BBp = AA + (size_t)T_ * 1024;
#pragma unroll
    for (int g = 0; g < 2; ++g) {
      const int ch = (n0 >> 8) * 128 + wn * 64 + g * 32 + r32;
      const float br = j.x0[ch], bi = j.x1[ch];
      const float spl = softplusf_(-j.x2[ch]);
#pragma unroll
      for (int mi = 0; mi < 2; ++mi)
#pragma unroll
        for (int r = 0; r < 16; ++r) {
          const int row = m0 + wm * 64 + mi * 32 + (r & 3) + 8 * (r >> 2) + 4 * hh;
          const float rg = sigmoidf_(acc[mi][2 * g][r] + br);
          const float ig = sigmoidf_(acc[mi][2 * g + 1][r] + bi);
          const float la = -8.f * rg * spl;
          const float xc = bf2f(XC[(size_t)row * 1024 + ch]);
          const bool reset = (row < TP_) && ((row & 2047) == 0);
          const float a = reset ? 0.f : __expf(la);
          const float mult = reset ? 1.f : sqrtf(fmaxf(-expm1f(2.f * la), 0.f));
          AA[(size_t)row * 1024 + ch] = a;
          BBp[(size_t)row * 1024 + ch] = mult * ig * xc;
        }
    }
  } else {
#pragma unroll
    for (int mi = 0; mi < 2; ++mi)
#pragma unroll
      for (int ni = 0; ni < 4; ++ni)
#pragma unroll
        for (int r = 0; r < 16; ++r) {
          const int row = m0 + wm * 64 + mi * 32 + (r & 3) + 8 * (r >> 2) + 4 * hh;
          const int col = n0 + wn * 128 + ni * 32 + r32;
          epi_elem<EPI>(j, row, col, acc[mi][ni][r]);
        }
    if (EPI == EPI_SSM_XBC) {
      if (n0 + wn * 128 == 4096) {
        const float dtb = j.x0[r32];
#pragma unroll
        for (int mi = 0; mi < 2; ++mi)
#pragma unroll
          for (int r = 0; r < 16; ++r) {
            const int row = m0 + wm * 64 + mi * 32 + (r & 3) + 8 * (r >> 2) + 4 * hh;
            ((float*)j.o1)[(size_t)row * 32 + r32] = softplusf_(acc[mi][0][r] + dtb);
          }
      }
    }
  }
}

#define VBLOCK() ((int)(((volatile LAS unsigned*)&xb_words)[3]))
DI void tile_map(int L, int ntn, int& mt, int& nt) {
  const int gw = ((ntn & 7) == 0) ? 8 : (((ntn & 3) == 0) ? 4 : 0);
  if (gw) {
    const int gs = 8 * gw, grp = L / gs, loc = L - grp * gs, gpr = ntn / gw;
    const int gm = grp / gpr, gn = grp - gm * gpr;
    mt = gm * 8 + loc / gw; nt = gn * gw + (loc - (loc / gw) * gw);
  } else { mt = L / ntn; nt = L - mt * ntn; }
}

template <int EPI, bool MIX>
DI void gemm_run(const GJob& j, int ntn, int& toff, char* smem, int vb_) {
  const int G = gridDim.x;
  const int ntiles = MT_ * ntn;
  const int start = (int)((vb_ - (toff % G) + G) % G);
  const int nk = j.K >> 6;
  for (int tile = start; tile < ntiles; tile += G) {
    int mt, nt; tile_map(tile, ntn, mt, nt);
    if (MIX) gemm_tile<EPI, MIX>(j, mt * 128, nt * 128, 0, nk, smem);
    else gemm_tile_dma<EPI>(j, mt * 128, nt * 256, 0, nk * 2, smem);
  }
  toff += ntiles;
}

template <int EPI>
DI void gemm_streamk(const GJob& j, int ntn, char* smem, int vb_, unsigned* flags, unsigned epoch) {
  const int G = gridDim.x;
  const int nk = j.K >> 5;
  const int total = MT_ * ntn * nk;
  int per = (total + G - 1) / G;
  if (per < nk) per = nk;
  int s0 = vb_ * per;
  const int s1 = min(s0 + per, total);
  while (s0 < s1) {
    const int tile = s0 / nk, k0 = s0 - tile * nk;
    const int k1 = min(nk, k0 + (s1 - s0));
    int mt, nt; tile_map(tile, ntn, mt, nt);
    unsigned* wf = (k0 == 0 && k1 < nk) ? (flags + tile) : nullptr;
    gemm_tile_dma<EPI>(j, mt * 128, nt * 256, k0, k1, smem, wf, epoch);
    if (k0 > 0) {
      asm volatile("s_waitcnt vmcnt(0)" ::: "memory");
      __syncthreads();
      if (threadIdx.x == 0) {
        __builtin_amdgcn_fence(__ATOMIC_RELEASE, "agent");
        asm volatile("s_waitcnt vmcnt(0)" ::: "memory");
        __hip_atomic_store(flags + tile, epoch, __ATOMIC_RELAXED, __HIP_MEMORY_SCOPE_AGENT);
      }
    }
    s0 += k1 - k0;
  }
}

template <int EPI, int SPLIT, int NKC>
DI void gemm_splitk(const GJob& j, int ntn, char* smem, int vb_) {
  const int G = gridDim.x;
  const int nitems = MT_ * ntn * SPLIT;
  for (int it = vb_; it < nitems; it += G) {
    const int tile = it / SPLIT, sp = it - tile * SPLIT;
    int mt, nt; tile_map(tile, ntn, mt, nt);
    gemm_tile<EPI, false>(j, mt * 128, nt * 128, sp * NKC, sp * NKC + NKC, smem);
  }
}

DI GJob mkjob(const bf16_t* A, int lda, const bf16_t* Bt, int ldb, int K, int nvalid) {
  GJob j;
  j.A = A; j.A2 = nullptr; j.mu = nullptr; j.Bt = Bt; j.lda = lda; j.ldb = ldb; j.K = K; j.nvalid = nvalid;
  j.o0 = nullptr; j.o1 = nullptr; j.x0 = nullptr; j.x1 = nullptr; j.x2 = nullptr; j.ldo = 0; j.act = 0;
  return j;
}

struct TJob { const float* src; bf16_t* dst; int K, N, src_ld, kind, n_off; };

DI TJob get_tjob(const Params& p, int j) {
  bf16_t* wt = (bf16_t*)(p.ws + W_WT);
  TJob o; o.kind = 0; o.n_off = 0;
  if (j < 36) {
    const int ia = j / 18, r = j % 18;
    if (r == 0) { o.src = p.in[I_LRU_WIN] + (size_t)ia * 1024 * 2048; o.dst = wt + WA_IN + (size_t)ia * 2048 * 1024; o.K = 1024; o.N = 2048; o.src_ld = 2048; }
    else if (r == 1) { o.src = p.in[I_LRU_WOUT] + (size_t)ia * 1024 * 1024; o.dst = wt + WA_OUT + (size_t)ia * 1024 * 1024; o.K = 1024; o.N = 1024; o.src_ld = 1024; }
    else {
      const int isI = (r >= 10) ? 1 : 0; const int h = (r - 2) & 7;
      o.src = p.in[isI ? I_LRU_WI : I_LRU_WR] + ((size_t)ia * 8 + h) * 128 * 128;
      o.dst = wt + WA_G + (size_t)ia * 2048 * 128; o.K = 128; o.N = 128; o.src_ld = 128; o.kind = 1 + isI; o.n_off = h * 128;
    }
  } else if (j == 36) { o.src = p.in[I_SSM_WIN] + 2048; o.dst = wt + WB_XBC; o.K = 1024; o.N = 4128; o.src_ld = 6176; }
  else if (j == 37) { o.src = p.in[I_SSM_WIN]; o.dst = wt + WB_Z; o.K = 1024; o.N = 2048; o.src_ld = 6176; }
  else if (j == 38) { o.src = p.in[I_SSM_WOUT]; o.dst = wt + WB_OUT; o.K = 2048; o.N = 1024; o.src_ld = 1024; }
  else if (j < 42) { const int s = j - 39; o.src = p.in[I_RW_WRKV] + (size_t)s * 1024 * 1024; o.dst = wt + WC_RKV + (size_t)s * 1024 * 1024; o.K = 1024; o.N = 1024; o.src_ld = 1024; }
  else if (j == 42) { o.src = p.in[I_RW_WW1]; o.dst = wt + WC_L1; o.K = 1024; o.N = 64; o.src_ld = 64; }
  else if (j == 43) { o.src = p.in[I_RW_WA1]; o.dst = wt + WC_L1 + 64 * 1024; o.K = 1024; o.N = 64; o.src_ld = 64; }
  else if (j == 44) { o.src = p.in[I_RW_WG1]; o.dst = wt + WC_L1 + 128 * 1024; o.K = 1024; o.N = 128; o.src_ld = 128; }
  else if (j == 45) { o.src = p.in[I_RW_WW2]; o.dst = wt + WC_W2; o.K = 64; o.N = 1024; o.src_ld = 1024; }
  else if (j == 46) { o.src = p.in[I_RW_WA2]; o.dst = wt + WC_A2; o.K = 64; o.N = 1024; o.src_ld = 1024; }
  else if (j == 47) { o.src = p.in[I_RW_WG2]; o.dst = wt + WC_G2; o.K = 128; o.N = 1024; o.src_ld = 1024; }
  else if (j == 48) { o.src = p.in[I_RW_WOUT]; o.dst = wt + WC_OUT; o.K = 1024; o.N = 1024; o.src_ld = 1024; }
  else {
    const int l = (j - 49) >> 1, which = (j - 49) & 1;
    if (!which) { o.src = p.in[I_FFN_W1] + (size_t)l * 1024 * 4096; o.dst = wt + WF_1 + (size_t)l * 4096 * 1024; o.K = 1024; o.N = 4096; o.src_ld = 4096; }
    else { o.src = p.in[I_FFN_W2] + (size_t)l * 4096 * 1024; o.dst = wt + WF_2 + (size_t)l * 4096 * 1024; o.K = 4096; o.N = 1024; o.src_ld = 1024; }
  }
  return o;
}
constexpr int N_TJOBS = 57;

DI void ph_prologue(const Params& p, char* smem) {
  const int tid = TIDX, G = gridDim.x;
  {
    const float4* xp = (const float4*)p.in[I_XP];
    const float4* xs = (const float4*)p.in[I_XS];
    float4* X = (float4*)(p.ws + W_X);
    const size_t np = (size_t)TP_ * 256, nt = (size_t)T_ * 256;
    for (size_t i = (size_t)blockIdx.x * NTHR + tid; i < nt; i += (size_t)G * NTHR)
      X[i] = (i < np) ? xp[i] : xs[i - np];
  }
  float* tile = (float*)smem;
  int toff = 0;
  for (int jn = 0; jn < N_TJOBS; ++jn) {
    const TJob tj = get_tjob(p, jn);
    const int nkt = tj.K >> 6, nnt = (tj.N + 63) >> 6;
    const int ntiles = nkt * nnt;
    const int start = (((int)blockIdx.x - (toff % G)) + G) % G;
    for (int t = start; t < ntiles; t += G) {
      const int kt = t / nnt, nt = t - kt * nnt;
      const int k0 = kt * 64, n0 = nt * 64;
      __syncthreads();
#pragma unroll 4
      for (int i = 0; i < 16; ++i) {
        const int k = i * 4 + (tid >> 6), n = tid & 63;
        float v = 0.f;
        if (n0 + n < tj.N) v = tj.src[(size_t)(k0 + k) * tj.src_ld + n0 + n];
        tile[k * 65 + n] = v;
      }
      __syncthreads();
      const int n = tid >> 2, kq = tid & 3;
      if (n0 + n < tj.N) {
        int nrow = n0 + n;
        if (tj.kind) {
          const int ch = tj.n_off + n0 + n;
          nrow = (ch >> 6) * 128 + ((ch >> 5) & 1) * 64 + (tj.kind - 1) * 32 + (ch & 31);
        }
        float f[8], g[8];
#pragma unroll
        for (int e = 0; e < 8; ++e) { f[e] = tile[(kq * 16 + e) * 65 + n]; g[e] = tile[(kq * 16 + 8 + e) * 65 + n]; }
        uint4* d = (uint4*)(tj.dst + (size_t)nrow * tj.K + k0 + kq * 16);
        d[0] = pack8(f); d[1] = pack8(g);
      }
    }
    toff += ntiles;
  }
}

DI void ph_rmsnorm(const Params& p, int mode, const float* w) {
  const int tid_ = TIDX; const int lane = tid_ & 63;
  const int gw = blockIdx.x * 4 + (tid_ >> 6), nw = gridDim.x * 4;
  const float* X = (const float*)(p.ws + W_X);
  bf16_t* U = (bf16_t*)(p.ws + W_U);
  bf16_t* UP = (bf16_t*)(p.ws + SC_UP);
  float4 wv[4];
#pragma unroll
  for (int i = 0; i < 4; ++i) wv[i] = ((const float4*)w)[lane + 64 * i];
  for (int row = gw; row < T_; row += nw) {
    const float4* xr = (const float4*)(X + (size_t)row * 1024);
    float4 v[4]; float ss = 0.f;
#pragma unroll
    for (int i = 0; i < 4; ++i) { v[i] = xr[lane + 64 * i]; ss += v[i].x * v[i].x + v[i].y * v[i].y + v[i].z * v[i].z + v[i].w * v[i].w; }
    ss = wave_sum(ss);
    const float rstd = rsqrtf(ss * (1.f / 1024.f) + 1e-6f);
    int seq, l, L; tok_info(row, seq, l, L);
#pragma unroll
    for (int i = 0; i < 4; ++i) {
      const int c = 4 * (lane + 64 * i);
      float4 y = make_float4(v[i].x * rstd * wv[i].x, v[i].y * rstd * wv[i].y, v[i].z * rstd * wv[i].z, v[i].w * rstd * wv[i].w);
      if (mode == 2) {
        *(float4*)(p.out + O_Y + (size_t)row * 1024 + c) = y;
      } else {
        uint2 pk = make_uint2(pack2(y.x, y.y), pack2(y.z, y.w));
        *(uint2*)(U + (size_t)row * 1024 + c) = pk;
        if (mode == 1) {
          if (l + 1 < L) *(uint2*)(UP + (size_t)(row + 1) * 1024 + c) = pk;
          if (l == 0) {
            uint2 pz = make_uint2(0, 0);
            if (seq >= 8) { float4 s = *(const float4*)(p.in[I_ST_RS] + (size_t)(seq - 8) * 1024 + c); pz = make_uint2(pack2(s.x, s.y), pack2(s.z, s.w)); }
            *(uint2*)(UP + (size_t)row * 1024 + c) = pz;
          }
          if (l == L - 1) {
            float* o = (seq < 8) ? (p.out + O_RS_P + (size_t)seq * 1024 + c) : (p.out + O_RS_S + (size_t)(seq - 8) * 1024 + c);
            *(float4*)o = y;
          }
        }
      }
    }
  }
}

template <int C, bool SILU>
DI void ph_conv(const bf16_t* __restrict__ src, bf16_t* __restrict__ dst, const float* __restrict__ cw,
                const float* __restrict__ cb, const float* __restrict__ state,
                float* __restrict__ out_p, float* __restrict__ out_s) {
  constexpr int GR = C / 8;
  const size_t total = (size_t)T_ * GR;
#pragma unroll 2
  for (size_t idx = (size_t)blockIdx.x * NTHR + TIDX; idx < total; idx += (size_t)gridDim.x * NTHR) {
    const int t = (int)(idx / GR), c = (int)(idx % GR) * 8;
    int seq, l, L; tok_info(t, seq, l, L);
    float acc[8]; load8f(cb + c, acc);
    float xcur[8];
#pragma unroll
    for (int jj = 0; jj < 4; ++jj) {
      const int ls = l - 3 + jj;
      float xv[8];
      if (ls >= 0) { unpack8(*(const uint4*)(src + (size_t)(t - 3 + jj) * C + c), xv); }
      else if (seq >= 8) { load8f(state + ((size_t)(seq - 8) * 3 + (ls + 3)) * C + c, xv); }
      else {
#pragma unroll
        for (int e = 0; e < 8; ++e) xv[e] = 0.f;
      }
      float w8[8]; load8f(cw + (size_t)jj * C + c, w8);
#pragma unroll
      for (int e = 0; e < 8; ++e) acc[e] += w8[e] * xv[e];
      if (jj == 3) {
#pragma unroll
        for (int e = 0; e < 8; ++e) xcur[e] = xv[e];
      }
    }
    if (SILU) {
#pragma unroll
      for (int e = 0; e < 8; ++e) acc[e] = siluf_(acc[e]);
    }
    *(uint4*)(dst + (size_t)t * C + c) = pack8(acc);
    if (l >= L - 3) {
      const int r = l - (L - 3);
      float* o = (seq < 8) ? (out_p + ((size_t)seq * 3 + r) * C + c) : (out_s + ((size_t)(seq - 8) * 3 + r) * C + c);
      store8f(o, xcur);
    }
  }
}

DI void ph_lru_scan1(const Params& p) {
  const float* AA = (const float*)(p.ws + SA_AA);
  const float* BB = (const float*)(p.ws + SA_BB);
  float* CP = (float*)(p.ws + SA_CP);
  float* CS = (float*)(p.ws + SA_CS);
  const int total = 8 * 64 * 1024;
  for (int idx = blockIdx.x * NTHR + TIDX; idx < total; idx += gridDim.x * NTHR) {
    const int ch = idx & 1023, c = (idx >> 10) & 63, b = idx >> 16;
    const size_t base = ((size_t)b * 2048 + c * 32) * 1024 + ch;
    float P = 1.f, S = 0.f;
    float av[32], bv[32];
#pragma unroll
    for (int s = 0; s < 32; ++s) { av[s] = AA[base + (size_t)s * 1024]; bv[s] = BB[base + (size_t)s * 1024]; }
#pragma unroll
    for (int s = 0; s < 32; ++s) { S = av[s] * S + bv[s]; P *= av[s]; }
    CP[idx] = P; CS[idx] = S;
  }
}
DI void ph_lru_scan2(const Params& p, int ia) {
  const float* AA = (const float*)(p.ws + SA_AA);
  const float* BB = (const float*)(p.ws + SA_BB);
  const float* CP = (const float*)(p.ws + SA_CP);
  const float* CS = (const float*)(p.ws + SA_CS);
  bf16_t* GT = (bf16_t*)(p.ws + SA_GT);
  const int nP = 8 * 64 * 1024, total = nP + 128 * 1024;
  for (int idx = blockIdx.x * NTHR + TIDX; idx < total; idx += gridDim.x * NTHR) {
    if (idx < nP) {
      const int ch = idx & 1023, c = (idx >> 10) & 63, b = idx >> 16;
      const size_t base = ((size_t)b * 2048 + c * 32) * 1024 + ch;
      float av[32], bv[32]; bf16_t gv[32];
#pragma unroll
      for (int s = 0; s < 32; ++s) { const size_t o = base + (size_t)s * 1024; av[s] = AA[o]; bv[s] = BB[o]; gv[s] = GT[o]; }
      float h = 0.f;
#pragma unroll 8
      for (int c2 = 0; c2 < c; ++c2) {
        const int ci = ((b * 64 + c2) << 10) + ch;
        h = CP[ci] * h + CS[ci];
      }
#pragma unroll
      for (int s = 0; s < 32; ++s) {
        const size_t o = base + (size_t)s * 1024;
        h = av[s] * h + bv[s];
        GT[o] = f2bf(h * bf2f(gv[s]));
      }
      if (c == 63) p.out[O_LH_P + ((size_t)ia * 8 + b) * 1024 + ch] = h;
    } else {
      const int u = idx - nP; const int ch = u & 1023, s = u >> 10;
      float h = p.in[I_ST_LH][((size_t)ia * 128 + s) * 1024 + ch];
      const size_t base = ((size_t)TP_ + s * 8) * 1024 + ch;
#pragma unroll
      for (int q = 0; q < 8; ++q) {
        const size_t o = base + (size_t)q * 1024;
        h = AA[o] * h + BB[o];
        GT[o] = f2bf(h * bf2f(GT[o]));
      }
      p.out[O_LH_S + ((size_t)ia * 128 + s) * 1024 + ch] = h;
    }
  }
}

DI void ssd_item(const Params& p, char* smem, int seq, int h) {
  const int tid = TIDX, lane = tid & 63, w = tid >> 6, r32 = lane & 31, hh = lane >> 5;
  bf16_t* Cs = (bf16_t*)smem;
  bf16_t* Bs = Cs + 64 * 136;
  bf16_t* Sb = Bs + 64 * 136;
  bf16_t* Xt = Sb + 64 * 136;
  bf16_t* Btr = Xt + 64 * 72;
  float* dts = (float*)(Btr + 128 * 72);
  float* acs = dts + 64;
  bf16_t* Ws = Bs;
  const bf16_t* XBC = (const bf16_t*)(p.ws + SB_XBC);
  const float* DT = (const float*)(p.ws + SB_DT);
  bf16_t* Y = (bf16_t*)(p.ws + SB_Y);
  const bool prompt = seq < 8;
  const int nchunk = prompt ? 32 : 1, Lv = prompt ? 64 : 8;
  const int tbase = prompt ? seq * 2048 : TP_ + (seq - 8) * 8;
  const int g = h >> 2;
  const float Ah = -__expf(p.in[I_SSM_ALOG][h]);
  const float Dh = p.in[I_SSM_D][h];
  f32x16 accS[2];
  {
    const float* s0 = p.in[I_ST_SS] + ((size_t)(seq - 8) * 32 + h) * 64 * 128;
#pragma unroll
    for (int mi = 0; mi < 2; ++mi)
#pragma unroll
      for (int r = 0; r < 16; ++r) {
        const int prow = mi * 32 + (r & 3) + 8 * (r >> 2) + 4 * hh, n = 32 * w + r32;
        accS[mi][r] = prompt ? 0.f : s0[(size_t)prow * 128 + n];
      }
  }
  __syncthreads();
#pragma unroll
  for (int mi = 0; mi < 2; ++mi)
#pragma unroll
    for (int r = 0; r < 16; ++r) {
      const int prow = mi * 32 + (r & 3) + 8 * (r >> 2) + 4 * hh, n = 32 * w + r32;
      Sb[prow * 136 + n] = f2bf(accS[mi][r]);
    }
  for (int c = 0; c < nchunk; ++c) {
    const int t0 = tbase + c * 64;
    __syncthreads();
    if (tid < 64) {
      const float dtv = (tid < Lv) ? DT[(size_t)(t0 + tid) * 32 + h] : 0.f;
      float x = dtv * Ah;
#pragma unroll
      for (int o = 1; o < 64; o <<= 1) { const float y = __shfl_up(x, o, 64); if (lane >= o) x += y; }
      dts[tid] = dtv; acs[tid] = x;
    }
    __syncthreads();
    const float aend = acs[63];
#pragma unroll
    for (int i = 0; i < 4; ++i) {
      const int id = tid + 256 * i, row = id >> 4, ch = id & 15;
      uint4 cv = make_uint4(0, 0, 0, 0), bv = make_uint4(0, 0, 0, 0);
      if (row < Lv) {
        const bf16_t* src = XBC + (size_t)(t0 + row) * 4096 + g * 128 + ch * 8;
        bv = *(const uint4*)(src + 2048);
        cv = *(const uint4*)(src + 3072);
      }
      *(uint4*)(Cs + row * 136 + ch * 8) = cv;
      *(uint4*)(Bs + row * 136 + ch * 8) = bv;
      float f[8]; unpack8(bv, f);
      const float sc = __expf(aend - acs[row]);
#pragma unroll
      for (int e = 0; e < 8; ++e) Btr[(ch * 8 + e) * 72 + row] = f2bf(f[e] * sc);
    }
#pragma unroll
    for (int i = 0; i < 2; ++i) {
      const int id = tid + 256 * i, row = id >> 3, ch = id & 7;
      uint4 xv = make_uint4(0, 0, 0, 0);
      if (row < Lv) xv = *(const uint4*)(XBC + (size_t)(t0 + row) * 4096 + h * 64 + ch * 8);
      float f[8]; unpack8(xv, f);
      const float sc = dts[row];
#pragma unroll
      for (int e = 0; e < 8; ++e) Xt[(ch * 8 + e) * 72 + row] = f2bf(f[e] * sc);
    }
    __syncthreads();
    const int it = w >> 1, jt = w & 1;
    f32x16 cb;
#pragma unroll
    for (int r = 0; r < 16; ++r) cb[r] = 0.f;
    if (jt <= it) {
#pragma unroll
      for (int ks = 0; ks < 8; ++ks) {
        bf16x8 a = *(const bf16x8*)(Cs + (it * 32 + r32) * 136 + ks * 16 + hh * 8);
        bf16x8 b = *(const bf16x8*)(Bs + (jt * 32 + r32) * 136 + ks * 16 + hh * 8);
        cb = mfma32(a, b, cb);
      }
    }
    __syncthreads();
    {
      const int jj = jt * 32 + r32; const float aj = acs[jj];
#pragma unroll
      for (int r = 0; r < 16; ++r) {
        const int ii = it * 32 + (r & 3) + 8 * (r >> 2) + 4 * hh;
        const float v = (jj <= ii) ? cb[r] * __expf(acs[ii] - aj) : 0.f;
        Ws[ii * 72 + jj] = f2bf(v);
      }
    }
    __syncthreads();
    {
      const int pt = w & 1;
      f32x16 yd, yo;
#pragma unroll
      for (int r = 0; r < 16; ++r) { yd[r] = 0.f; yo[r] = 0.f; }
#pragma unroll
      for (int ks = 0; ks < 4; ++ks) {
        bf16x8 a = *(const bf16x8*)(Ws + (it * 32 + r32) * 72 + ks * 16 + hh * 8);
        bf16x8 b = *(const bf16x8*)(Xt + (pt * 32 + r32) * 72 + ks * 16 + hh * 8);
        yd = mfma32(a, b, yd);
      }
#pragma unroll
      for (int ks = 0; ks < 8; ++ks) {
        bf16x8 a = *(const bf16x8*)(Cs + (it * 32 + r32) * 136 + ks * 16 + hh * 8);
        bf16x8 b = *(const bf16x8*)(Sb + (pt * 32 + r32) * 136 + ks * 16 + hh * 8);
        yo = mfma32(a, b, yo);
      }
      const int pp = pt * 32 + r32;
#pragma unroll
      for (int r = 0; r < 16; ++r) {
        const int ii = it * 32 + (r & 3) + 8 * (r >> 2) + 4 * hh;
        if (ii < Lv) {
          const size_t t = (size_t)(t0 + ii);
          const float xv = bf2f(XBC[t * 4096 + h * 64 + pp]);
          const float yv = yd[r] + __expf(acs[ii]) * yo[r] + Dh * xv;
          Y[t * 2048 + h * 64 + pp] = f2bf(yv);
        }
      }
    }
    {
      const float dec = __expf(aend);
#pragma unroll
      for (int mi = 0; mi < 2; ++mi)
#pragma unroll
        for (int r = 0; r < 16; ++r) accS[mi][r] *= dec;
#pragma unroll
      for (int ks = 0; ks < 4; ++ks) {
        bf16x8 b = *(const bf16x8*)(Btr + (32 * w + r32) * 72 + ks * 16 + hh * 8);
        bf16x8 a0 = *(const bf16x8*)(Xt + (r32) * 72 + ks * 16 + hh * 8);
        bf16x8 a1 = *(const bf16x8*)(Xt + (32 + r32) * 72 + ks * 16 + hh * 8);
        accS[0] = mfma32(a0, b, accS[0]);
        accS[1] = mfma32(a1, b, accS[1]);
      }
    }
    __syncthreads();
#pragma unroll
    for (int mi = 0; mi < 2; ++mi)
#pragma unroll
      for (int r = 0; r < 16; ++r) {
        const int prow = mi * 32 + (r & 3) + 8 * (r >> 2) + 4 * hh, n = 32 * w + r32;
        Sb[prow * 136 + n] = f2bf(accS[mi][r]);
      }
  }
  float* dst = prompt ? (p.out + O_SS_P + ((size_t)seq * 32 + h) * 64 * 128)
                      : (p.out + O_SS_S + ((size_t)(seq - 8) * 32 + h) * 64 * 128);
#pragma unroll
  for (int mi = 0; mi < 2; ++mi)
#pragma unroll
    for (int r = 0; r < 16; ++r) {
      const int prow = mi * 32 + (r & 3) + 8 * (r >> 2) + 4 * hh, n = 32 * w + r32;
      dst[(size_t)prow * 128 + n] = accS[mi][r];
    }
}

DI void ph_ssd(const Params& p, char* smem) {
  const int G = gridDim.x, bid = blockIdx.x;
  int it = bid, step = G;
  if (G >= 512) { if (bid < 256) { step = 1 << 30; } else { step = G - 256; } }
#pragma nounroll
  for (; it < 256 + 4096; it += step) {
    const int seq = (it < 256) ? (it >> 5) : (8 + ((it - 256) >> 5));
    ssd_item(p, smem, seq, it & 31);
  }
}

DI void ph_gnorm(const Params& p) {
  const int tid_ = TIDX; const int lane = tid_ & 63;
  const int gw = blockIdx.x * 4 + (tid_ >> 6), nw = gridDim.x * 4;
  bf16_t* Y = (bf16_t*)(p.ws + SB_Y);
  const float* nwt = p.in[I_SSM_NW];
  for (int item = gw; item < T_ * 8; item += 2 * nw) {
    const int item2 = item + nw; const bool v2 = item2 < T_ * 8;
    bf16_t* yp1 = Y + (size_t)(item >> 3) * 2048 + (item & 7) * 256 + lane * 4;
    bf16_t* yp2 = Y + (size_t)((v2 ? item2 : item) >> 3) * 2048 + ((v2 ? item2 : item) & 7) * 256 + lane * 4;
    const uint2 a = *(const uint2*)yp1; const uint2 b = *(const uint2*)yp2;
    float f[4], g[4]; unpack4(a, f); unpack4(b, g);
    const float ss1 = wave_sum(f[0] * f[0] + f[1] * f[1] + f[2] * f[2] + f[3] * f[3]);
    const float ss2 = wave_sum(g[0] * g[0] + g[1] * g[1] + g[2] * g[2] + g[3] * g[3]);
    const float r1 = rsqrtf(ss1 * (1.f / 256.f) + 1e-5f), r2 = rsqrtf(ss2 * (1.f / 256.f) + 1e-5f);
    const float4 w1 = *(const float4*)(nwt + (item & 7) * 256 + lane * 4);
    const float4 w2 = *(const float4*)(nwt + ((v2 ? item2 : item) & 7) * 256 + lane * 4);
    *(uint2*)yp1 = make_uint2(pack2(f[0] * r1 * w1.x, f[1] * r1 * w1.y), pack2(f[2] * r1 * w1.z, f[3] * r1 * w1.w));
    if (v2) *(uint2*)yp2 = make_uint2(pack2(g[0] * r2 * w2.x, g[1] * r2 * w2.y), pack2(g[2] * r2 * w2.z, g[3] * r2 * w2.w));
  }
}

template <int LPR>
DI void wkv_item(const Params& p, char* smem, int seq, int head, int part) {
  constexpr int ROWS = 256 / LPR, KPL = 64 / LPR;
  const int tid = TIDX;
  float* sR = (float*)smem;
  float* sK = sR + 2048;
  float* sKK = sK + 2048;
  float* sBB = sKK + 2048;
  float* sW = sBB + 2048;
  float* sV = sW + 2048;
  float* sO = sV + 2048;
  const bf16_t* R = (const bf16_t*)(p.ws + SC_R);
  const bf16_t* K = (const bf16_t*)(p.ws + SC_K);
  const bf16_t* V = (const bf16_t*)(p.ws + SC_V);
  const bf16_t* AAc = (const bf16_t*)(p.ws + SC_AA);
  const float* WD = (const float*)(p.ws + SC_WD);
  bf16_t* O = (bf16_t*)(p.ws + SC_O);
  const bool prompt = seq < 8;
  const int nch = prompt ? 64 : 1, nvalid = prompt ? 32 : 8;
  const int tbase = prompt ? seq * 2048 : TP_ + (seq - 8) * 8;
  const int row_l = tid / LPR, q = tid % LPR, row = part * ROWS + row_l;
  float S[KPL];
  {
    const float* s0 = p.in[I_ST_RW] + (((size_t)(seq - 8) * 16 + head) * 64 + row) * 64 + q * KPL;
#pragma unroll
    for (int e = 0; e < KPL; ++e) S[e] = prompt ? 0.f : s0[e];
  }
  const int pst = tid >> 3, pk0 = (tid & 7) * 8, pcol = head * 64 + pk0;
  float kk8[8], ka8[8];
  load8f(p.in[I_RW_KK] + pcol, kk8);
  load8f(p.in[I_RW_KA] + pcol, ka8);
  for (int c = 0; c < nch; ++c) {
    const int t0 = tbase + c * 32;
    __syncthreads();
    if (pst < nvalid) {
      const size_t o = (size_t)(t0 + pst) * 1024 + pcol;
      float r8[8], k8[8], v8[8], a8[8], w8[8];
      unpack8(*(const uint4*)(R + o), r8);
      unpack8(*(const uint4*)(K + o), k8);
      unpack8(*(const uint4*)(V + o), v8);
      unpack8(*(const uint4*)(AAc + o), a8);
      load8f(WD + o, w8);
      float kr[8], ss = 0.f;
#pragma unroll
      for (int e = 0; e < 8; ++e) { kr[e] = k8[e] * kk8[e]; ss += kr[e] * kr[e]; }
      ss = red_lanes<8>(ss);
      const float inv = 1.f / fmaxf(sqrtf(ss), 1e-12f);
      float kp[8], bb[8];
#pragma unroll
      for (int e = 0; e < 8; ++e) { kr[e] *= inv; kp[e] = k8[e] * (1.f + (a8[e] - 1.f) * ka8[e]); bb[e] = kr[e] * a8[e]; }
      const int lo = pst * 64 + pk0;
      store8f(sR + lo, r8); store8f(sK + lo, kp); store8f(sKK + lo, kr); store8f(sBB + lo, bb);
      store8f(sW + lo, w8); store8f(sV + lo, v8);
    }
    __syncthreads();
    for (int st = 0; st < nvalid; ++st) {
      const int lo = st * 64 + q * KPL;
      float kk[KPL], ww[KPL], bb[KPL], kp[KPL], rr[KPL];
#pragma unroll
      for (int e = 0; e < KPL; e += 4) {
        const float4 a = *(const float4*)(sKK + lo + e); kk[e] = a.x; kk[e + 1] = a.y; kk[e + 2] = a.z; kk[e + 3] = a.w;
        const float4 b = *(const float4*)(sW + lo + e); ww[e] = b.x; ww[e + 1] = b.y; ww[e + 2] = b.z; ww[e + 3] = b.w;
        const float4 d = *(const float4*)(sBB + lo + e); bb[e] = d.x; bb[e + 1] = d.y; bb[e + 2] = d.z; bb[e + 3] = d.w;
        const float4 f = *(const float4*)(sK + lo + e); kp[e] = f.x; kp[e + 1] = f.y; kp[e + 2] = f.z; kp[e + 3] = f.w;
        const float4 g = *(const float4*)(sR + lo + e); rr[e] = g.x; rr[e + 1] = g.y; rr[e + 2] = g.z; rr[e + 3] = g.w;
      }
      const float vv = sV[st * 64 + row];
      float sa = 0.f;
#pragma unroll
      for (int e = 0; e < KPL; ++e) sa += S[e] * kk[e];
      sa = red_lanes<LPR>(sa);
      float oo = 0.f;
#pragma unroll
      for (int e = 0; e < KPL; ++e) {
        S[e] = S[e] * ww[e] - sa * bb[e] + vv * kp[e];
        oo += S[e] * rr[e];
      }
      oo = red_lanes<LPR>(oo);
      if (q == 0) sO[st * ROWS + row_l] = oo;
    }
    __syncthreads();
    for (int i = tid; i < nvalid * ROWS; i += NTHR) {
      const int st = i / ROWS, rr = i % ROWS;
      O[(size_t)(t0 + st) * 1024 + head * 64 + part * ROWS + rr] = f2bf(sO[i]);
    }
  }
  float* dst = prompt ? (p.out + O_RW_P + (((size_t)seq * 16 + head) * 64 + row) * 64 + q * KPL)
                      : (p.out + O_RW_S + (((size_t)(seq - 8) * 16 + head) * 64 + row) * 64 + q * KPL);
#pragma unroll
  for (int e = 0; e < KPL; ++e) dst[e] = S[e];
}

template <int LPR>
DI void ph_wkv(const Params& p, char* smem) {
  constexpr int NPART = 64 / (256 / LPR);
  const int G = gridDim.x, bid = blockIdx.x;
  const int nP = 128 * NPART, nS = 2048 * NPART;
  for (int it = bid; it < nP + nS; it += G) {
    int seq, head, part;
    if (it < nP) { part = it % NPART; const int sh = it / NPART; seq = sh >> 4; head = sh & 15; }
    else { const int u = it - nP; part = u % NPART; const int sh = u / NPART; seq = 8 + (sh >> 4); head = sh & 15; }
    wkv_item<LPR>(p, smem, seq, head, part);
  }
}

DI void ph_wkv_post(const Params& p) {
  const int tid_ = TIDX; const int lane = tid_ & 63;
  const int gw = blockIdx.x * 4 + (tid_ >> 6), nw = gridDim.x * 4;
  const bf16_t* __restrict__ R = (const bf16_t*)(p.ws + SC_R);
  const bf16_t* __restrict__ K = (const bf16_t*)(p.ws + SC_K);
  const bf16_t* __restrict__ V = (const bf16_t*)(p.ws + SC_V);
  const bf16_t* __restrict__ AAc = (const bf16_t*)(p.ws + SC_AA);
  const bf16_t* __restrict__ Gg = (const bf16_t*)(p.ws + SC_G);
  const bf16_t* __restrict__ O = (const bf16_t*)(p.ws + SC_O);
  bf16_t* __restrict__ U = (bf16_t*)(p.ws + W_U);
#pragma unroll 2
  for (int item = gw; item < T_ * 4; item += nw) {
    const int t = item >> 2, col = (item & 3) * 256 + lane * 4;
    const size_t o = (size_t)t * 1024 + col;
    float ov[4], rv[4], kv[4], av[4], vv[4], gv[4];
    unpack4(*(const uint2*)(O + o), ov); unpack4(*(const uint2*)(R + o), rv); unpack4(*(const uint2*)(K + o), kv);
    unpack4(*(const uint2*)(AAc + o), av); unpack4(*(const uint2*)(V + o), vv); unpack4(*(const uint2*)(Gg + o), gv);
    const float4 lw = *(const float4*)(p.in[I_RW_LNW] + col), lb = *(const float4*)(p.in[I_RW_LNB] + col);
    const float4 ka = *(const float4*)(p.in[I_RW_KA] + col), rk = *(const float4*)(p.in[I_RW_RK] + col);
    const float lwv[4] = {lw.x, lw.y, lw.z, lw.w}, lbv[4] = {lb.x, lb.y, lb.z, lb.w};
    const float kav[4] = {ka.x, ka.y, ka.z, ka.w}, rkv[4] = {rk.x, rk.y, rk.z, rk.w};
    const float mean = red_lanes<16>(ov[0] + ov[1] + ov[2] + ov[3]) * (1.f / 64.f);
    float d[4], s2 = 0.f, s3 = 0.f;
#pragma unroll
    for (int e = 0; e < 4; ++e) {
      d[e] = ov[e] - mean; s2 += d[e] * d[e];
      const float kp = kv[e] * (1.f + (av[e] - 1.f) * kav[e]);
      s3 += rv[e] * kp * rkv[e];
    }
    s2 = red_lanes<16>(s2); s3 = red_lanes<16>(s3);
    const float rs = rsqrtf(s2 * (1.f / 64.f) + 64e-5f);
    float y[4];
#pragma unroll
    for (int e = 0; e < 4; ++e) y[e] = (d[e] * rs * lwv[e] + lbv[e] + s3 * vv[e]) * gv[e];
    *(uint2*)(U + o) = make_uint2(pack2(y[0], y[1]), pack2(y[2], y[3]));
  }
}

constexpr int NPH = 40;
#ifndef REP_GEMM
#define REP_GEMM 1
#endif
#ifndef REP_SSD
#define REP_SSD 1
#endif
#ifndef REP_WKV
#define REP_WKV 1
#endif
#ifndef REP_MISC
#define REP_MISC 1
#endif

__global__ void __launch_bounds__(NTHR, 2) mega(Params p) {
  __shared__ __attribute__((aligned(16))) char smem[SMEM_BYTES];
  __shared__ uint4 xb_words;
  cg::grid_group grid = cg::this_grid();
  if (threadIdx.x == 0) xb_words = make_uint4(0u, 0u, 0u, 0u);
  __syncthreads();
  XcdBarrier xb = xcd_barrier_post((unsigned*)(p.ws + W_BAR), (volatile LAS unsigned*)&xb_words);
  int ph = 0;
#define PH(...)                                                     \
  {                                                                 \
    if (ph >= p.ph_begin && ph < p.ph_end) {                        \
      __VA_ARGS__;                                                  \
      xcd_barrier(xb);                                              \
    }                                                               \
    ++ph;                                                           \
  }
#define PHR(rep, ...)                                               \
  {                                                                 \
    if (ph >= p.ph_begin && ph < p.ph_end) {                        \
      for (int rep_ = 0; rep_ < (rep); ++rep_) {                    \
        __VA_ARGS__;                                                \
        xcd_barrier(xb);                                            \
      }                                                             \
    }                                                               \
    ++ph;                                                           \
  }
#define PH_LAST(...)                                                \
  {                                                                 \
    if (ph >= p.ph_begin && ph < p.ph_end) { __VA_ARGS__; }         \
    ++ph;                                                           \
  }
  bf16_t* wt = (bf16_t*)(p.ws + W_WT);
  bf16_t* U = (bf16_t*)(p.ws + W_U);
  float* X = (float*)(p.ws + W_X);

  {
    if (ph >= p.ph_begin && ph < p.ph_end) { ph_prologue(p, smem); grid.sync(); }
    ++ph;
    if (threadIdx.x == 0) {
      unsigned* bar = (unsigned*)(p.ws + W_BAR);
      unsigned base = 0;
      for (unsigned jx = 0; jx < 16; ++jx) { const unsigned c = xb_ld(&bar[XB_XCNT(jx)]); base += (jx < xb.x) ? c : 0u; }
      volatile LAS unsigned* st = (volatile LAS unsigned*)&xb_words;
      st[3] = base + st[2];
    }
    __syncthreads();
  }

#pragma nounroll
  for (int layer = 0; layer < 4; ++layer) {
    const int kind = layer % 3;
    PHR(REP_MISC, ph_rmsnorm(p, kind == 2 ? 1 : 0, p.in[I_NMIX] + layer * 1024));
    if (kind == 0) {
      const int ia = layer / 3;
      PHR(REP_GEMM, {
        GJob j = mkjob(U, 1024, wt + WA_IN + (size_t)ia * 2048 * 1024, 1024, 1024, 2048);
        j.o0 = p.ws + SA_XB; j.o1 = p.ws + SA_GT;
        int toff = 0; gemm_run<EPI_LRU_IN, false>(j, 8, toff, smem, VBLOCK());
      });
      PHR(REP_MISC, (ph_conv<1024, false>((const bf16_t*)(p.ws + SA_XB), (bf16_t*)(p.ws + SA_XC),
                               p.in[I_LRU_CW] + (size_t)ia * 4 * 1024, p.in[I_LRU_CB] + (size_t)ia * 1024,
                               p.in[I_ST_LC] + (size_t)ia * 128 * 3 * 1024,
                               p.out + O_LC_P + (size_t)ia * 8 * 3 * 1024, p.out + O_LC_S + (size_t)ia * 128 * 3 * 1024)));
      PHR(REP_GEMM, {
        const int G = gridDim.x;
        for (int tile = VBLOCK(); tile < MT_ * 8; tile += G) {
          const int mt = tile >> 3, jt = tile & 7;
          GJob j = mkjob((const bf16_t*)(p.ws + SA_XC) + jt * 128, 1024,
                         wt + WA_G + (size_t)ia * 2048 * 128, 128, 128, 2048);
          j.o0 = p.ws + SA_AA; j.o1 = p.ws + SA_XC;
          j.x0 = p.in[I_LRU_BR] + ia * 1024; j.x1 = p.in[I_LRU_BI] + ia * 1024; j.x2 = p.in[I_LRU_LAM] + ia * 1024;
          gemm_tile_dma<EPI_GATES>(j, mt * 128, jt * 256, 0, 4, smem);
        }
      });
      PHR(REP_MISC, ph_lru_scan1(p));
      PH(ph_lru_scan2(p, ia));
      PH({
        GJob j = mkjob((const bf16_t*)(p.ws + SA_GT), 1024, wt + WA_OUT + (size_t)ia * 1024 * 1024, 1024, 1024, 1024);
        j.o0 = X;
        gemm_streamk<EPI_RESID>(j, 4, smem, VBLOCK(), (unsigned*)(p.ws + W_BAR) + 4096, (unsigned)(layer * 2 + 1));
      });
    } else if (kind == 1) {
      PHR(REP_GEMM, {
        GJob j = mkjob(U, 1024, wt + WB_XBC, 1024, 1024, 4128);
        j.o0 = p.ws + SB_XBCP; j.o1 = p.ws + SB_DT; j.x0 = p.in[I_SSM_DTB];
        int toff = 0; gemm_run<EPI_SSM_XBC, false>(j, 17, toff, smem, VBLOCK());
      });
      PHR(REP_MISC, (ph_conv<4096, true>((const bf16_t*)(p.ws + SB_XBCP), (bf16_t*)(p.ws + SB_XBC),
                              p.in[I_SSM_CW], p.in[I_SSM_CB], p.in[I_ST_SC],
                              p.out + O_SC_P, p.out + O_SC_S)));
      PHR(REP_SSD, ph_ssd(p, smem));
      PH({
        GJob j = mkjob(U, 1024, wt + WB_Z, 1024, 1024, 2048);
        j.o0 = p.ws + SB_Y;
        int toff = 0; gemm_run<EPI_SSM_Z, false>(j, 8, toff, smem, VBLOCK());
      });
      PH(ph_gnorm(p));
      PH({
        GJob j = mkjob((const bf16_t*)(p.ws + SB_Y), 2048, wt + WB_OUT, 2048, 2048, 1024);
        j.o0 = X;
        gemm_streamk<EPI_RESID>(j, 4, smem, VBLOCK(), (unsigned*)(p.ws + W_BAR) + 4096, (unsigned)(layer * 2 + 1));
      });
    } else {
      PHR(REP_GEMM, {
        int toff = 0;
        for (int s = 0; s < 3; ++s) {
          GJob j = mkjob(U, 1024, wt + WC_RKV + (size_t)s * 1024 * 1024, 1024, 1024, 1024);
          j.A2 = (const bf16_t*)(p.ws + SC_UP); j.mu = p.in[I_RW_MU] + s * 1024;
          j.o0 = p.ws + SC_R + (size_t)s * SZ_TD2; j.ldo = 1024; j.act = 0;
          gemm_run<EPI_ST, true>(j, 8, toff, smem, VBLOCK());
        }
        for (int s = 0; s < 3; ++s) {
          const int nv = (s == 2) ? 128 : 64;
          GJob j = mkjob(U, 1024, wt + WC_L1 + (size_t)s * 64 * 1024, 1024, 1024, nv);
          j.A2 = (const bf16_t*)(p.ws + SC_UP); j.mu = p.in[I_RW_MU] + (3 + s) * 1024;
          j.o0 = p.ws + SC_LH + (size_t)s * 64 * 2; j.ldo = 256; j.act = (s == 0) ? 1 : (s == 2 ? 2 : 0);
          gemm_run<EPI_ST, true>(j, 1, toff, smem, VBLOCK());
        }
      });
      PHR(REP_GEMM, {
        int toff = 0;
        const bf16_t* LH = (const bf16_t*)(p.ws + SC_LH);
        {
          GJob j = mkjob(LH, 256, wt + WC_W2, 64, 64, 1024);
          j.o0 = p.ws + SC_WD; j.x0 = p.in[I_RW_W0];
          gemm_run<EPI_DECAY, false>(j, 4, toff, smem, VBLOCK());
        }
        {
          GJob j = mkjob(LH + 64, 256, wt + WC_A2, 64, 64, 1024);
          j.o0 = p.ws + SC_AA; j.x0 = p.in[I_RW_A0];
          gemm_run<EPI_SIGB, false>(j, 4, toff, smem, VBLOCK());
        }
        {
          GJob j = mkjob(LH + 128, 256, wt + WC_G2, 128, 128, 1024);
          j.o0 = p.ws + SC_G; j.ldo = 1024; j.act = 0;
          gemm_run<EPI_ST, false>(j, 4, toff, smem, VBLOCK());
        }
      });
      PHR(REP_WKV, ph_wkv<16>(p, smem));
      PHR(REP_MISC, ph_wkv_post(p));
      PH({
        GJob j = mkjob(U, 1024, wt + WC_OUT, 1024, 1024, 1024);
        j.o0 = X;
        gemm_streamk<EPI_RESID>(j, 4, smem, VBLOCK(), (unsigned*)(p.ws + W_BAR) + 4096, (unsigned)(layer * 2 + 1));
      });
    }
    PHR(REP_MISC, ph_rmsnorm(p, 0, p.in[I_NFFN] + layer * 1024));
    PHR(REP_GEMM, {
      GJob j = mkjob(U, 1024, wt + WF_1 + (size_t)layer * 4096 * 1024, 1024, 1024, 4096);
      j.o0 = p.ws + S_HB;
      int toff = 0; gemm_run<EPI_FFN1, false>(j, 16, toff, smem, VBLOCK());
    });
    PH({
      GJob j = mkjob((const bf16_t*)(p.ws + S_HB), 4096, wt + WF_2 + (size_t)layer * 4096 * 1024, 4096, 4096, 1024);
      j.o0 = X;
      gemm_streamk<EPI_RESID>(j, 4, smem, VBLOCK(), (unsigned*)(p.ws + W_BAR) + 4096, (unsigned)(layer * 2 + 2));
    });
  }
  PH_LAST(ph_rmsnorm(p, 2, p.in[I_NFIN]));
#undef PH
#undef PH_LAST
}

extern "C" void kernel_launch(void* const* d_in, const int* in_sizes, int n_in, void* d_out, int out_size,
                              void* d_ws, size_t ws_size, hipStream_t stream) {
  Params p;
  memset(&p, 0, sizeof(p));
  for (int i = 0; i < N_IN; ++i) p.in[i] = (const float*)d_in[i];
  p.out = (float*)d_out;
  p.ws = (char*)d_ws;
  p.ph_begin = 0;
  p.ph_end = 1000;
  static int grid_blocks = 0;
  if (!grid_blocks) {
    int dev = 0, cus = 0, per_cu = 0;
    hipGetDevice(&dev);
    hipDeviceGetAttribute(&cus, hipDeviceAttributeMultiprocessorCount, dev);
    hipOccupancyMaxActiveBlocksPerMultiprocessor(&per_cu, mega, NTHR, 0);
    if (per_cu > 2) per_cu = 2;
    if (per_cu < 1) per_cu = 1;
    grid_blocks = cus * per_cu;
  }
  if (ws_size < (size_t)536870912) fprintf(stderr, "workspace too small: %zu\n", ws_size);
  (void)hipMemsetAsync((char*)d_ws + W_BAR, 0, (4096 + 1024) * 4, stream);
  void* args[] = {&p};
  hipError_t e = hipLaunchCooperativeKernel((void*)mega, dim3(grid_blocks), dim3(NTHR), args, 0, stream);
  if (e != hipSuccess) fprintf(stderr, "cooperative launch failed: %s (grid %d)\n", hipGetErrorString(e), grid_blocks);
}
```

```cpp
#include <hip/hip_runtime.h>
#include <hip/hip_cooperative_groups.h>
#include <stdint.h>
#include <stdio.h>
#include <string.h>
namespace cg = cooperative_groups;

typedef unsigned short bf16_t;
typedef __attribute__((ext_vector_type(8))) short bf16x8;
typedef __attribute__((ext_vector_type(16))) float f32x16;

#define DI __device__ __forceinline__

constexpr int T_ = 17408;
constexpr int TP_ = 16384;
constexpr int NTHR = 256;
constexpr int MT_ = T_ / 128;

enum {
  I_XP = 0, I_XS, I_ST_LC, I_ST_LH, I_ST_SC, I_ST_SS, I_ST_RS, I_ST_RW,
  I_NMIX, I_NFFN, I_NFIN,
  I_LRU_WIN, I_LRU_CW, I_LRU_CB, I_LRU_WR, I_LRU_BR, I_LRU_WI, I_LRU_BI, I_LRU_LAM, I_LRU_WOUT,
  I_SSM_WIN, I_SSM_CW, I_SSM_CB, I_SSM_DTB, I_SSM_ALOG, I_SSM_D, I_SSM_NW, I_SSM_WOUT,
  I_RW_MU, I_RW_WRKV, I_RW_W0, I_RW_WW1, I_RW_WW2, I_RW_A0, I_RW_WA1, I_RW_WA2, I_RW_WG1, I_RW_WG2,
  I_RW_KK, I_RW_KA, I_RW_RK, I_RW_LNW, I_RW_LNB, I_RW_WOUT,
  I_FFN_W1, I_FFN_W2, N_IN
};

constexpr size_t O_Y = 0;
constexpr size_t O_LC_P = O_Y + (size_t)T_ * 1024;
constexpr size_t O_LC_S = O_LC_P + 2 * 8 * 3 * 1024;
constexpr size_t O_LH_P = O_LC_S + 2 * 128 * 3 * 1024;
constexpr size_t O_LH_S = O_LH_P + 2 * 8 * 1024;
constexpr size_t O_SC_P = O_LH_S + 2 * 128 * 1024;
constexpr size_t O_SC_S = O_SC_P + 8 * 3 * 4096;
constexpr size_t O_SS_P = O_SC_S + 128 * 3 * 4096;
constexpr size_t O_SS_S = O_SS_P + (size_t)8 * 32 * 64 * 128;
constexpr size_t O_RS_P = O_SS_S + (size_t)128 * 32 * 64 * 128;
constexpr size_t O_RS_S = O_RS_P + 8 * 1024;
constexpr size_t O_RW_P = O_RS_S + 128 * 1024;
constexpr size_t O_RW_S = O_RW_P + 8 * 16 * 64 * 64;

constexpr size_t W_X = 0;
constexpr size_t W_U = W_X + (size_t)T_ * 1024 * 4;
constexpr size_t W_WT = W_U + (size_t)T_ * 1024 * 2;
constexpr size_t WA_IN = 0;
constexpr size_t WA_G = WA_IN + 2 * 2048 * 1024;
constexpr size_t WA_OUT = WA_G + 2 * 2048 * 128;
constexpr size_t WB_XBC = WA_OUT + 2 * 1024 * 1024;
constexpr size_t WB_Z = WB_XBC + 4128 * 1024;
constexpr size_t WB_OUT = WB_Z + 2048 * 1024;
constexpr size_t WC_RKV = WB_OUT + 1024 * 2048;
constexpr size_t WC_L1 = WC_RKV + 3 * 1024 * 1024;
constexpr size_t WC_W2 = WC_L1 + 256 * 1024;
constexpr size_t WC_A2 = WC_W2 + 1024 * 64;
constexpr size_t WC_G2 = WC_A2 + 1024 * 64;
constexpr size_t WC_OUT = WC_G2 + 1024 * 128;
constexpr size_t WF_1 = WC_OUT + 1024 * 1024;
constexpr size_t WF_2 = WF_1 + (size_t)4 * 4096 * 1024;
constexpr size_t W_WT_ELEMS = WF_2 + (size_t)4 * 4096 * 1024;
constexpr size_t W_S = W_WT + W_WT_ELEMS * 2;
constexpr size_t SZ_TD2 = (size_t)T_ * 1024 * 2;
constexpr size_t SZ_TD4 = (size_t)T_ * 1024 * 4;
constexpr size_t S_HB = W_S;
constexpr size_t SA_XB = W_S;
constexpr size_t SA_GT = SA_XB + SZ_TD2;
constexpr size_t SA_XC = SA_GT + SZ_TD2;
constexpr size_t SA_AA = SA_XC + SZ_TD2;
constexpr size_t SA_BB = SA_AA + SZ_TD4;
constexpr size_t SA_CP = SA_BB + SZ_TD4;
constexpr size_t SA_CS = SA_CP + 8 * 64 * 1024 * 4;
constexpr size_t SB_XBCP = W_S;
constexpr size_t SB_Y = W_S;
constexpr size_t SB_XBC = SB_XBCP + SZ_TD2 * 4;
constexpr size_t SB_DT = SB_XBC + SZ_TD2 * 4;
constexpr size_t SC_UP = W_S;
constexpr size_t SC_O = W_S;
constexpr size_t SC_R = SC_UP + SZ_TD2;
constexpr size_t SC_K = SC_R + SZ_TD2;
constexpr size_t SC_V = SC_K + SZ_TD2;
constexpr size_t SC_LH = SC_V + SZ_TD2;
constexpr size_t SC_WD = SC_LH + (size_t)T_ * 256 * 2;
constexpr size_t SC_AA = SC_WD + SZ_TD4;
constexpr size_t SC_G = SC_AA + SZ_TD2;
constexpr size_t SC_END = SC_G + SZ_TD2;
static_assert(SC_END <= (size_t)536870912, "ws overflow C");
static_assert(SB_DT + (size_t)T_ * 32 * 4 <= (size_t)536870912, "ws overflow B");
static_assert(SA_CS + 8 * 64 * 1024 * 4 <= (size_t)536870912, "ws overflow A");

constexpr int SMEM_BYTES = 80384;
constexpr size_t W_BAR = (size_t)536870912 - 65536;

struct Params {
  const float* in[N_IN];
  float* out;
  char* ws;
  int ph_begin, ph_end;
};

DI float bf2f(bf16_t h) { return __uint_as_float(((unsigned)h) << 16); }
DI bf16_t f2bf(float f) {
  unsigned u = __float_as_uint(f);
  u += 0x7FFFu + ((u >> 16) & 1u);
  return (bf16_t)(u >> 16);
}
DI unsigned pack2(float a, float b) { return (unsigned)f2bf(a) | ((unsigned)f2bf(b) << 16); }
DI void unpack8(const uint4 v, float (&f)[8]) {
  f[0] = __uint_as_float(v.x << 16); f[1] = __uint_as_float(v.x & 0xFFFF0000u);
  f[2] = __uint_as_float(v.y << 16); f[3] = __uint_as_float(v.y & 0xFFFF0000u);
  f[4] = __uint_as_float(v.z << 16); f[5] = __uint_as_float(v.z & 0xFFFF0000u);
  f[6] = __uint_as_float(v.w << 16); f[7] = __uint_as_float(v.w & 0xFFFF0000u);
}
DI void unpack4(const uint2 v, float (&f)[4]) {
  f[0] = __uint_as_float(v.x << 16); f[1] = __uint_as_float(v.x & 0xFFFF0000u);
  f[2] = __uint_as_float(v.y << 16); f[3] = __uint_as_float(v.y & 0xFFFF0000u);
}
DI uint4 pack8(const float (&f)[8]) {
  return make_uint4(pack2(f[0], f[1]), pack2(f[2], f[3]), pack2(f[4], f[5]), pack2(f[6], f[7]));
}
DI void load8f(const float* p, float (&f)[8]) {
  float4 a = *(const float4*)p, b = *(const float4*)(p + 4);
  f[0] = a.x; f[1] = a.y; f[2] = a.z; f[3] = a.w; f[4] = b.x; f[5] = b.y; f[6] = b.z; f[7] = b.w;
}
DI void store8f(float* p, const float (&f)[8]) {
  *(float4*)p = make_float4(f[0], f[1], f[2], f[3]);
  *(float4*)(p + 4) = make_float4(f[4], f[5], f[6], f[7]);
}
DI float sigmoidf_(float x) { return 1.f / (1.f + __expf(-x)); }
DI float siluf_(float x) { return x / (1.f + __expf(-x)); }
DI float tanhf_(float y) { return 1.f - 2.f / (1.f + __expf(2.f * y)); }
DI float geluf_(float x) { return 0.5f * x * (1.f + tanhf_(0.7978845608028654f * (x + 0.044715f * x * x * x))); }
DI float softplusf_(float x) { return fmaxf(x, 0.f) + log1pf(__expf(-fabsf(x))); }
DI float wave_sum(float v) {
#pragma unroll
  for (int o = 32; o >= 1; o >>= 1) v += __shfl_xor(v, o, 64);
  return v;
}
template <int CTRL> DI float dppf(float x) {
  return __int_as_float(__builtin_amdgcn_update_dpp(0, __float_as_int(x), CTRL, 0xf, 0xf, false));
}
template <int N> DI float red_lanes(float x) {
  x += dppf<0xB1>(x);
  x += dppf<0x4E>(x);
  if (N >= 8) x += dppf<0x141>(x);
  if (N >= 16) x += dppf<0x140>(x);
  return x;
}
DI void tok_info(int t, int& seq, int& l, int& L) {
  if (t < TP_) { seq = t >> 11; l = t & 2047; L = 2048; }
  else { int u = t - TP_; seq = 8 + (u >> 3); l = u & 7; L = 8; }
}
DI int opq(int x) { asm volatile("" : "+v"(x)); return x; }
#define TIDX opq((int)threadIdx.x)
DI f32x16 mfma32(bf16x8 a, bf16x8 b, f32x16 c) { return __builtin_amdgcn_mfma_f32_32x32x16_bf16(a, b, c, 0, 0, 0); }


#define XB_TMO      128
#define XB_XCNT(j)  (256  + 64 * (j))
#define XB_XSUB(j)  (1280 + 64 * (j))
#define XB_XGEN(j)  (2304 + 64 * (j))
#define XB_TOP      3328
#define XB_TOPGEN   3392
#define XCD_BAR_WORDS 3456
#define XB_SPIN_CAP (1u << 22)
#define LAS __attribute__((address_space(3)))
DI unsigned xb_ld(unsigned* p) { return __hip_atomic_load(p, __ATOMIC_RELAXED, __HIP_MEMORY_SCOPE_AGENT); }
DI unsigned xb_add(unsigned* p, unsigned v) { return __hip_atomic_fetch_add(p, v, __ATOMIC_RELAXED, __HIP_MEMORY_SCOPE_AGENT); }
DI unsigned xb_xcc_id() { return (unsigned)__builtin_amdgcn_s_getreg((3 << 11) | 20) & 0xFu; }
#define XB_SPIN(cond, bar) do { unsigned _sp = 0; while (cond) { __builtin_amdgcn_s_sleep(1); \
    if ((++_sp & 255u) == 0u) { if (xb_ld(&(bar)[XB_TMO])) break; if (_sp > XB_SPIN_CAP) { atomicAdd(&(bar)[XB_TMO], 1u); break; } } } } while (0)
struct XcdBarrier { unsigned* bar; unsigned x; volatile LAS unsigned* st; };
DI XcdBarrier xcd_barrier_post(unsigned* bar, volatile LAS unsigned* st) {
  XcdBarrier b; b.bar = bar; b.x = xb_xcc_id(); b.st = st;
  if (threadIdx.x == 0) st[2] = xb_add(&bar[XB_XCNT(b.x)], 1u);
  return b;
}
DI void xcd_barrier_complete(unsigned* bar, unsigned x, unsigned& nloc, unsigned& nx) {
  const unsigned G = gridDim.x * gridDim.y * gridDim.z;
  unsigned sum, cnt, mine, sp = 0u;
  for (;;) {
    sum = 0u; cnt = 0u; mine = 0u;
#pragma unroll
    for (unsigned j = 0; j < 16; ++j) { const unsigned c = xb_ld(&bar[XB_XCNT(j)]); sum += c; cnt += (c > 0u) ? 1u : 0u; mine = (j == x) ? c : mine; }
    if (sum == G) break;
    __builtin_amdgcn_s_sleep(1);
    if ((++sp & 255u) == 0u) { if (xb_ld(&bar[XB_TMO])) break; if (sp > XB_SPIN_CAP) { atomicAdd(&bar[XB_TMO], 1u); break; } }
  }
  nloc = mine > 0u ? mine : 1u; nx = cnt > 0u ? cnt : 1u;
}
DI void xcd_barrier(const XcdBarrier& b) {
  asm volatile("s_waitcnt vmcnt(0)" ::: "memory");
  __syncthreads();
  if (threadIdx.x == 0) {
    unsigned* bar = b.bar;
    __builtin_amdgcn_s_waitcnt(0);
    unsigned nloc = b.st[0], nx = b.st[1];
    if (nloc == 0u) { xcd_barrier_complete(bar, b.x, nloc, nx); b.st[0] = nloc; b.st[1] = nx; }
    const unsigned old = xb_add(&bar[XB_XSUB(b.x)], 1u);
    const unsigned gen = old / nloc;
    if (old + 1u == (gen + 1u) * nloc) {
      __builtin_amdgcn_fence(__ATOMIC_RELEASE, "agent");
      asm volatile("s_waitcnt vmcnt(0)" ::: "memory");
      const unsigned og = xb_add(&bar[XB_TOP], 1u);
      const unsigned tg = og / nx;
      if (og + 1u == (tg + 1u) * nx) xb_add(&bar[XB_TOPGEN], 1u);
      else XB_SPIN(xb_ld(&bar[XB_TOPGEN]) == tg, bar);
      __builtin_amdgcn_fence(__ATOMIC_ACQUIRE, "agent");
      xb_add(&bar[XB_XGEN(b.x)], 1u);
      asm volatile("s_waitcnt vmcnt(0)" ::: "memory");
    } else {
      XB_SPIN(xb_ld(&bar[XB_XGEN(b.x)]) == gen, bar);
      __builtin_amdgcn_fence(__ATOMIC_ACQUIRE, "agent");
      asm volatile("s_waitcnt vmcnt(0)" ::: "memory");
    }
  }
  __syncthreads();
}

struct GJob {
  const bf16_t* A; const bf16_t* A2; const float* mu; const bf16_t* Bt;
  int lda, ldb, K, nvalid;
  void* o0; void* o1; const float* x0; const float* x1; const float* x2;
  int ldo, act;
};
enum { EPI_LRU_IN = 0, EPI_GATES, EPI_RESID, EPI_SSM_XBC, EPI_SSM_Z, EPI_FFN1, EPI_ST, EPI_DECAY, EPI_SIGB };

template <int EPI> DI void epi_elem(const GJob& j, int row, int col, float v) {
  if (EPI == EPI_LRU_IN) {
    if (col < 1024) ((bf16_t*)j.o0)[(size_t)row * 1024 + col] = f2bf(v);
    else ((bf16_t*)j.o1)[(size_t)row * 1024 + col - 1024] = f2bf(geluf_(v));
  } else if (EPI == EPI_RESID) {
    unsafeAtomicAdd((float*)j.o0 + (size_t)row * 1024 + col, v);
  } else if (EPI == EPI_SSM_XBC) {
    if (col < 4096) ((bf16_t*)j.o0)[(size_t)row * 4096 + col] = f2bf(v);
  } else if (EPI == EPI_SSM_Z) {
    bf16_t* y = (bf16_t*)j.o0 + (size_t)row * 2048 + col;
    *y = f2bf(bf2f(*y) * siluf_(v));
  } else if (EPI == EPI_FFN1) {
    float r = fmaxf(v, 0.f);
    ((bf16_t*)j.o0)[(size_t)row * 4096 + col] = f2bf(r * r);
  } else if (EPI == EPI_ST) {
    if (col < j.nvalid) {
      float r = v;
      if (j.act == 1) r = tanhf_(v); else if (j.act == 2) r = sigmoidf_(v);
      ((bf16_t*)j.o0)[(size_t)row * j.ldo + col] = f2bf(r);
    }
  } else if (EPI == EPI_DECAY) {
    float wl = -softplusf_(-(j.x0[col] + v)) - 0.5f;
    ((float*)j.o0)[(size_t)row * 1024 + col] = __expf(-__expf(wl));
  } else if (EPI == EPI_SIGB) {
    ((bf16_t*)j.o0)[(size_t)row * 1024 + col] = f2bf(sigmoidf_(j.x0[col] + v));
  }
}

template <int EPI, bool MIX>
DI void gemm_tile(const GJob& j, int m0, int n0, int kt0, int kt1, char* smem) {
  const int tid = TIDX, lane = tid & 63, w = tid >> 6;
  const int wm = w >> 1, wn = w & 1, r32 = lane & 31, hh = lane >> 5;
  const int lrow = tid >> 3, kc = tid & 7;
  f32x16 acc[2][2];
#pragma unroll
  for (int a = 0; a < 2; ++a)
#pragma unroll
    for (int b = 0; b < 2; ++b)
#pragma unroll
      for (int r = 0; r < 16; ++r) acc[a][b][r] = 0.f;
  uint4 qa00, qa01, qa02, qa03, qb00, qb01, qb02, qb03, qc00, qc01, qc02, qc03;
  uint4 qa10, qa11, qa12, qa13, qb10, qb11, qb12, qb13, qc10, qc11, qc12, qc13;
  qc00 = qc01 = qc02 = qc03 = qc10 = qc11 = qc12 = qc13 = make_uint4(0, 0, 0, 0);
  const int nk = kt1 - kt0;
  const bf16_t* Ap = j.A + (size_t)(m0 + lrow) * j.lda + kc * 8 + (size_t)kt0 * 64;
  const bf16_t* A2p = MIX ? (j.A2 + (size_t)(m0 + lrow) * j.lda + kc * 8 + (size_t)kt0 * 64) : nullptr;
  const bf16_t* Bp = j.Bt + (size_t)(n0 + lrow) * j.ldb + kc * 8 + (size_t)kt0 * 64;
  const size_t astep = (size_t)32 * j.lda, bstep = (size_t)32 * j.ldb;
  const bool bv0 = (n0 + lrow) < j.nvalid, bv1 = (n0 + lrow + 32) < j.nvalid;
  const bool bv2 = (n0 + lrow + 64) < j.nvalid, bv3 = (n0 + lrow + 96) < j.nvalid;
  const uint4 z4 = make_uint4(0, 0, 0, 0);

#define LD1(s, i, kt)                                                                 \
  qa##s##i = *(const uint4*)(Ap + i * astep + (kt) * 64);                             \
  if (MIX) qc##s##i = *(const uint4*)(A2p + i * astep + (kt) * 64);                   \
  qb##s##i = z4;                                                                      \
  if (bv##i) qb##s##i = *(const uint4*)(Bp + i * bstep + (kt) * 64);
#define GLOAD(s, kt) { LD1(s, 0, kt) LD1(s, 1, kt) LD1(s, 2, kt) LD1(s, 3, kt) }
#define ST1(s, i, As_, Bs_)                                                           \
  if (MIX) {                                                                          \
    float f1[8], f2[8]; unpack8(qa##s##i, f1); unpack8(qc##s##i, f2);                 \
    _Pragma("unroll") for (int e = 0; e < 8; ++e) f1[e] = f1[e] + (f2[e] - f1[e]) * mu8[e]; \
    qa##s##i = pack8(f1);                                                             \
  }                                                                                   \
  *(uint4*)(As_ + (lrow + 32 * i) * 144 + kc * 16) = qa##s##i;                        \
  *(uint4*)(Bs_ + (lrow + 32 * i) * 144 + kc * 16) = qb##s##i;
#define SSTORE(s, kt, buf)                                                            \
  {                                                                                   \
    char* As_ = smem + (buf) * 36864; char* Bs_ = As_ + 18432;                        \
    float mu8[8];                                                                     \
    if (MIX) load8f(j.mu + (kt0 + (kt)) * 64 + kc * 8, mu8);                          \
    ST1(s, 0, As_, Bs_) ST1(s, 1, As_, Bs_) ST1(s, 2, As_, Bs_) ST1(s, 3, As_, Bs_)   \
  }
#define LOADF(F, ks)                                                                  \
  bf16x8 F##a0 = *(const bf16x8*)(ap + (ks) * 32);                                    \
  bf16x8 F##a1 = *(const bf16x8*)(ap + 32 * 144 + (ks) * 32);                         \
  bf16x8 F##b0 = *(const bf16x8*)(bp + (ks) * 32);                                    \
  bf16x8 F##b1 = *(const bf16x8*)(bp + 32 * 144 + (ks) * 32);
#define MFMA4(F)                                                                      \
  acc[0][0] = mfma32(F##a0, F##b0, acc[0][0]);                                        \
  acc[0][1] = mfma32(F##a0, F##b1, acc[0][1]);                                        \
  acc[1][0] = mfma32(F##a1, F##b0, acc[1][0]);                                        \
  acc[1][1] = mfma32(F##a1, F##b1, acc[1][1]);
#define COMPUTE(buf)                                                                  \
  {                                                                                   \
    const char* As_ = smem + (buf) * 36864; const char* Bs_ = As_ + 18432;            \
    const char* ap = As_ + (wm * 64 + r32) * 144 + hh * 16;                           \
    const char* bp = Bs_ + (wn * 64 + r32) * 144 + hh * 16;                           \
    LOADF(f0, 0) LOADF(f1, 1)                                                         \
    __builtin_amdgcn_sched_barrier(0);                                                \
    MFMA4(f0)                                                                         \
    LOADF(f2, 2)                                                                      \
    __builtin_amdgcn_sched_barrier(0);                                                \
    MFMA4(f1)                                                                         \
    LOADF(f3, 3)                                                                      \
    __builtin_amdgcn_sched_barrier(0);                                                \
    MFMA4(f2)                                                                         \
    __builtin_amdgcn_sched_barrier(0);                                                \
    MFMA4(f3)                                                                         \
    __builtin_amdgcn_sched_barrier(0);                                                \
  }

  qa10 = qa11 = qa12 = qa13 = qb10 = qb11 = qb12 = qb13 = z4;
  if (MIX) {
    GLOAD(0, 0);
    SSTORE(0, 0, 0);
    __syncthreads();
    for (int i = 0; i < nk; ++i) {
      if (i + 1 < nk) GLOAD(0, i + 1);
      if (i & 1) { COMPUTE(1); } else { COMPUTE(0); }
      if (i + 1 < nk) { if (i & 1) { SSTORE(0, i + 1, 0); } else { SSTORE(0, i + 1, 1); } }
      __syncthreads();
    }
  } else if (nk == 1) {
    GLOAD(0, 0);
    SSTORE(0, 0, 0);
    __syncthreads();
    COMPUTE(0);
    __syncthreads();
  } else {
    GLOAD(0, 0);
    GLOAD(1, 1);
    SSTORE(0, 0, 0);
    __syncthreads();
#pragma unroll 1
    for (int i = 0; i + 2 < nk; i += 2) {
      GLOAD(0, i + 2);
      COMPUTE(0);
      SSTORE(1, i + 1, 1);
      __syncthreads();
      GLOAD(1, i + 3);
      COMPUTE(1);
      SSTORE(0, i + 2, 0);
      __syncthreads();
    }
    COMPUTE(0);
    SSTORE(1, nk - 1, 1);
    __syncthreads();
    COMPUTE(1);
    __syncthreads();
  }
#undef LD1
#undef ST1
#undef LOADF
#undef MFMA4
#undef GLOAD
#undef SSTORE
#undef COMPUTE

  if (EPI == EPI_GATES) {
    const int ch = (n0 >> 7) * 64 + wn * 32 + r32;
    const float br = j.x0[ch], bi = j.x1[ch];
    const float spl = softplusf_(-j.x2[ch]);
    const bf16_t* XC = (const bf16_t*)j.o1;
    float* AA = (float*)j.o0;
    float* BBp = AA + (size_t)T_ * 1024;
#pragma unroll
    for (int mi = 0; mi < 2; ++mi)
#pragma unroll
      for (int r = 0; r < 16; ++r) {
        const int row = m0 + wm * 64 + mi * 32 + (r & 3) + 8 * (r >> 2) + 4 * hh;
        const float rg = sigmoidf_(acc[mi][0][r] + br);
        const float ig = sigmoidf_(acc[mi][1][r] + bi);
        const float la = -8.f * rg * spl;
        const float xc = bf2f(XC[(size_t)row * 1024 + ch]);
        const bool reset = (row < TP_) && ((row & 2047) == 0);
        const float a = reset ? 0.f : __expf(la);
        const float mult = reset ? 1.f : sqrtf(fmaxf(-expm1f(2.f * la), 0.f));
        AA[(size_t)row * 1024 + ch] = a;
        BBp[(size_t)row * 1024 + ch] = mult * ig * xc;
      }
  } else {
#pragma unroll
    for (int mi = 0; mi < 2; ++mi)
#pragma unroll
      for (int ni = 0; ni < 2; ++ni)
#pragma unroll
        for (int r = 0; r < 16; ++r) {
          const int row = m0 + wm * 64 + mi * 32 + (r & 3) + 8 * (r >> 2) + 4 * hh;
          const int col = n0 + wn * 64 + ni * 32 + r32;
          epi_elem<EPI>(j, row, col, acc[mi][ni][r]);
          if ((r & 7) == 7) __builtin_amdgcn_sched_barrier(0);
        }
  }
}

constexpr int DSLOT = 24576;
template <int EPI>
DI void gemm_tile_dma(const GJob& j, int m0, int n0, int k0, int k1, char* smem, unsigned* wflag = nullptr, unsigned epoch = 0u) {
  const int tid = TIDX, lane = tid & 63, w = tid >> 6;
  const int wm = w >> 1, wn = w & 1, r32 = lane & 31, hh = lane >> 5;
  f32x16 acc[2][4];
#pragma unroll
  for (int a = 0; a < 2; ++a)
#pragma unroll
    for (int b = 0; b < 4; ++b)
#pragma unroll
      for (int r = 0; r < 16; ++r) acc[a][b][r] = 0.f;
  const int nk = k1 - k0;
  const int dr = lane >> 2;
  const int dc = (lane & 3) ^ ((lane >> 4) & 3);
  const int nlim = j.nvalid - 1;
  const size_t kofs = (size_t)k0 * 32 + dc * 8;
  const bf16_t* gA0 = j.A + (size_t)(m0 + 32 * w + dr) * j.lda + kofs;
  const bf16_t* gA1 = j.A + (size_t)(m0 + 32 * w + 16 + dr) * j.lda + kofs;
  const bf16_t* gB0 = j.Bt + (size_t)min(n0 + 64 * w + dr, nlim) * j.ldb + kofs;
  const bf16_t* gB1 = j.Bt + (size_t)min(n0 + 64 * w + 16 + dr, nlim) * j.ldb + kofs;
  const bf16_t* gB2 = j.Bt + (size_t)min(n0 + 64 * w + 32 + dr, nlim) * j.ldb + kofs;
  const bf16_t* gB3 = j.Bt + (size_t)min(n0 + 64 * w + 48 + dr, nlim) * j.ldb + kofs;
  char* ldsA = smem + (2 * w) * 1024 + lane * 16;
  char* ldsB = smem + 8192 + (4 * w) * 1024 + lane * 16;
  const unsigned lbase = (unsigned)(unsigned long long)(LAS char*)smem;
  const int fsw = (r32 >> 2) & 3;
  const unsigned pa = (unsigned)((wm * 64 + r32) * 64), pb = (unsigned)(8192 + (wn * 128 + r32) * 64);
  const unsigned po0 = (unsigned)(((hh) ^ fsw) * 16), po1 = (unsigned)(((2 + hh) ^ fsw) * 16);

#define DMA1(gp, lp) __builtin_amdgcn_global_load_lds((const unsigned*)(gp), (unsigned*)(lp), 16, 0, 0)
#define ISSUE(kt, slot)                                                                          \
  {                                                                                              \
    const int ko_ = (kt) * 32;                                                                   \
    char* la_ = ldsA + (slot) * DSLOT; char* lb_ = ldsB + (slot) * DSLOT;                        \
    DMA1(gA0 + ko_, la_); DMA1(gA1 + ko_, la_ + 1024);                                           \
    DMA1(gB0 + ko_, lb_); DMA1(gB1 + ko_, lb_ + 1024); DMA1(gB2 + ko_, lb_ + 2048); DMA1(gB3 + ko_, lb_ + 3072); \
  }
#define SB_ __builtin_amdgcn_sched_barrier(0)

  asm volatile("s_waitcnt vmcnt(0)" ::: "memory");
  const int last = nk - 1;
  ISSUE(0, 0);
  { const int t1 = min(1, last); ISSUE(t1, 1); }
  int sl_r = 0, sl_w = 2;
#pragma unroll 1
  for (int i = 0; i < nk; ++i) {
    asm volatile("s_waitcnt vmcnt(6)" ::: "memory");
    __builtin_amdgcn_s_barrier();
    const int ko2 = min(i + 2, last) * 32;
    char* la2 = ldsA + sl_w * DSLOT; char* lb2 = ldsB + sl_w * DSLOT;
    const unsigned sl = lbase + (unsigned)(sl_r * DSLOT);
    sl_r = (sl_r == 2) ? 0 : sl_r + 1;
    sl_w = (sl_w == 2) ? 0 : sl_w + 1;
    bf16x8 a00, a10, a01, a11, b00, b10, b20, b30, b01, b11, b21, b31;
    const unsigned aA0 = sl + pa + po0, aB0 = sl + pb + po0, aA1 = sl + pa + po1, aB1 = sl + pb + po1;
    asm volatile("ds_read_b128 %0, %1" : "=v"(a00) : "v"(aA0));
    asm volatile("ds_read_b128 %0, %1 offset:2048" : "=v"(a10) : "v"(aA0));
    asm volatile("ds_read_b128 %0, %1" : "=v"(b00) : "v"(aB0));
    asm volatile("ds_read_b128 %0, %1 offset:2048" : "=v"(b10) : "v"(aB0));
    asm volatile("ds_read_b128 %0, %1 offset:4096" : "=v"(b20) : "v"(aB0));
    asm volatile("ds_read_b128 %0, %1 offset:6144" : "=v"(b30) : "v"(aB0));
    asm volatile("ds_read_b128 %0, %1" : "=v"(a01) : "v"(aA1));
    asm volatile("ds_read_b128 %0, %1 offset:2048" : "=v"(a11) : "v"(aA1));
    asm volatile("ds_read_b128 %0, %1" : "=v"(b01) : "v"(aB1));
    asm volatile("ds_read_b128 %0, %1 offset:2048" : "=v"(b11) : "v"(aB1));
    asm volatile("ds_read_b128 %0, %1 offset:4096" : "=v"(b21) : "v"(aB1));
    asm volatile("ds_read_b128 %0, %1 offset:6144" : "=v"(b31) : "v"(aB1));
    DMA1(gA0 + ko2, la2);
    asm volatile("s_waitcnt lgkmcnt(0)" : "+v"(a00), "+v"(a10), "+v"(b00), "+v"(b10), "+v"(b20), "+v"(b30),
                 "+v"(a01), "+v"(a11), "+v"(b01), "+v"(b11), "+v"(b21), "+v"(b31) :: "memory");
    acc[0][0] = mfma32(a00, b00, acc[0][0]);
    acc[0][1] = mfma32(a00, b10, acc[0][1]);
    acc[0][2] = mfma32(a00, b20, acc[0][2]);
    SB_; DMA1(gA1 + ko2, la2 + 1024); SB_;
    acc[0][3] = mfma32(a00, b30, acc[0][3]);
    acc[1][0] = mfma32(a10, b00, acc[1][0]);
    acc[1][1] = mfma32(a10, b10, acc[1][1]);
    SB_; DMA1(gB0 + ko2, lb2); SB_;
    acc[1][2] = mfma32(a10, b20, acc[1][2]);
    acc[1][3] = mfma32(a10, b30, acc[1][3]);
    acc[0][0] = mfma32(a01, b01, acc[0][0]);
    SB_; DMA1(gB1 + ko2, lb2 + 1024); SB_;
    acc[0][1] = mfma32(a01, b11, acc[0][1]);
    acc[0][2] = mfma32(a01, b21, acc[0][2]);
    acc[0][3] = mfma32(a01, b31, acc[0][3]);
    SB_; DMA1(gB2 + ko2, lb2 + 2048); SB_;
    acc[1][0] = mfma32(a11, b01, acc[1][0]);
    acc[1][1] = mfma32(a11, b11, acc[1][1]);
    acc[1][2] = mfma32(a11, b21, acc[1][2]);
    SB_; DMA1(gB3 + ko2, lb2 + 3072); SB_;
    acc[1][3] = mfma32(a11, b31, acc[1][3]);
  }
  asm volatile("s_waitcnt vmcnt(0)" ::: "memory");
  __builtin_amdgcn_s_barrier();
#undef ISSUE
#undef DMA1
#undef SB_
  if (wflag) {
    if (threadIdx.x == 0) {
      unsigned sp = 0;
      while (xb_ld(wflag) != epoch) { __builtin_amdgcn_s_sleep(1); if (++sp > (1u << 24)) break; }
      __builtin_amdgcn_fence(__ATOMIC_ACQUIRE, "agent");
      asm volatile("s_waitcnt vmcnt(0)" ::: "memory");
    }
    __syncthreads();
  }

  if (EPI == EPI_GATES) {
    const bf16_t* XC = (const bf16_t*)j.o1;
    float* AA = (float*)j.o0;
    float* BBp = AA + (size_t)T_ * 1024;
#pragma unroll
    for (int g = 0; g < 2; ++g) {
      const int ch = (n0 >> 8) * 128 + wn * 64 + g * 32 + r32;
      const float br = j.x0[ch], bi = j.x1[ch];
      const float spl = softplusf_(-j.x2[ch]);
#pragma unroll
      for (int mi = 0; mi < 2; ++mi)
#pragma unroll
        for (int r = 0; r < 16; ++r) {
          const int row = m0 + wm * 64 + mi * 32 + (r & 3) + 8 * (r >> 2) + 4 * hh;
          const float rg = sigmoidf_(acc[mi][2 * g][r] + br);
          const float ig = sigmoidf_(acc[mi][2 * g + 1][r] + bi);
          const float la = -8.f * rg * spl;
          const float xc = bf2f(XC[(size_t)row * 1024 + ch]);
          const bool reset = (row < TP_) && ((row & 2047) == 0);
          const float a = reset ? 0.f : __expf(la);
          const float mult = reset ? 1.f : sqrtf(fmaxf(-expm1f(2.f * la), 0.f));
          AA[(size_t)row * 1024 + ch] = a;
          BBp[(size_t)row * 1024 + ch] = mult * ig * xc;
        }
    }
  } else {
#pragma unroll
    for (int mi = 0; mi < 2; ++mi)
#pragma unroll
      for (int ni = 0; ni < 4; ++ni)
#pragma unroll
        for (int r = 0; r < 16; ++r) {
          const int row = m0 + wm * 64 + mi * 32 + (r & 3) + 8 * (r >> 2) + 4 * hh;
          const int col = n0 + wn * 128 + ni * 32 + r32;
          epi_elem<EPI>(j, row, col, acc[mi][ni][r]);
        }
    if (EPI == EPI_SSM_XBC) {
      if (n0 + wn * 128 == 4096) {
        const float dtb = j.x0[r32];
#pragma unroll
        for (int mi = 0; mi < 2; ++mi)
#pragma unroll
          for (int r = 0; r < 16; ++r) {
            const int row = m0 + wm * 64 + mi * 32 + (r & 3) + 8 * (r >> 2) + 4 * hh;
            ((float*)j.o1)[(size_t)row * 32 + r32] = softplusf_(acc[mi][0][r] + dtb);
          }
      }
    }
  }
}

#define VBLOCK() ((int)(((volatile LAS unsigned*)&xb_words)[3]))
DI void tile_map(int L, int ntn, int& mt, int& nt) {
  const int gw = ((ntn & 7) == 0) ? 8 : (((ntn & 3) == 0) ? 4 : 0);
  if (gw) {
    const int gs = 8 * gw, grp = L / gs, loc = L - grp * gs, gpr = ntn / gw;
    const int gm = grp / gpr, gn = grp - gm * gpr;
    mt = gm * 8 + loc / gw; nt = gn * gw + (loc - (loc / gw) * gw);
  } else { mt = L / ntn; nt = L - mt * ntn; }
}

template <int EPI, bool MIX>
DI void gemm_run(const GJob& j, int ntn, int& toff, char* smem, int vb_) {
  const int G = gridDim.x;
  const int ntiles = MT_ * ntn;
  const int start = (int)((vb_ - (toff % G) + G) % G);
  const int nk = j.K >> 6;
  for (int tile = start; tile < ntiles; tile += G) {
    int mt, nt; tile_map(tile, ntn, mt, nt);
    if (MIX) gemm_tile<EPI, MIX>(j, mt * 128, nt * 128, 0, nk, smem);
    else gemm_tile_dma<EPI>(j, mt * 128, nt * 256, 0, nk * 2, smem);
  }
  toff += ntiles;
}

template <int EPI>
DI void gemm_streamk(const GJob& j, int ntn, char* smem, int vb_, unsigned* flags, unsigned epoch) {
  const int G = gridDim.x;
  const int nk = j.K >> 5;
  const int total = MT_ * ntn * nk;
  int per = (total + G - 1) / G;
  if (per < nk) per = nk;
  int s0 = vb_ * per;
  const int s1 = min(s0 + per, total);
  while (s0 < s1) {
    const int tile = s0 / nk, k0 = s0 - tile * nk;
    const int k1 = min(nk, k0 + (s1 - s0));
    int mt, nt; tile_map(tile, ntn, mt, nt);
    unsigned* wf = (k0 == 0 && k1 < nk) ? (flags + tile) : nullptr;
    gemm_tile_dma<EPI>(j, mt * 128, nt * 256, k0, k1, smem, wf, epoch);
    if (k0 > 0) {
      asm volatile("s_waitcnt vmcnt(0)" ::: "memory");
      __syncthreads();
      if (threadIdx.x == 0) {
        __builtin_amdgcn_fence(__ATOMIC_RELEASE, "agent");
        asm volatile("s_waitcnt vmcnt(0)" ::: "memory");
        __hip_atomic_store(flags + tile, epoch, __ATOMIC_RELAXED, __HIP_MEMORY_SCOPE_AGENT);
      }
    }
    s0 += k1 - k0;
  }
}

template <int EPI, int SPLIT, int NKC>
DI void gemm_splitk(const GJob& j, int ntn, char* smem, int vb_) {
  const int G = gridDim.x;
  const int nitems = MT_ * ntn * SPLIT;
  for (int it = vb_; it < nitems; it += G) {
    const int tile = it / SPLIT, sp = it - tile * SPLIT;
    int mt, nt; tile_map(tile, ntn, mt, nt);
    gemm_tile<EPI, false>(j, mt * 128, nt * 128, sp * NKC, sp * NKC + NKC, smem);
  }
}

DI GJob mkjob(const bf16_t* A, int lda, const bf16_t* Bt, int ldb, int K, int nvalid) {
  GJob j;
  j.A = A; j.A2 = nullptr; j.mu = nullptr; j.Bt = Bt; j.lda = lda; j.ldb = ldb; j.K = K; j.nvalid = nvalid;
  j.o0 = nullptr; j.o1 = nullptr; j.x0 = nullptr; j.x1 = nullptr; j.x2 = nullptr; j.ldo = 0; j.act = 0;
  return j;
}

struct TJob { const float* src; bf16_t* dst; int K, N, src_ld, kind, n_off; };

DI TJob get_tjob(const Params& p, int j) {
  bf16_t* wt = (bf16_t*)(p.ws + W_WT);
  TJob o; o.kind = 0; o.n_off = 0;
  if (j < 36) {
    const int ia = j / 18, r = j % 18;
    if (r == 0) { o.src = p.in[I_LRU_WIN] + (size_t)ia * 1024 * 2048; o.dst = wt + WA_IN + (size_t)ia * 2048 * 1024; o.K = 1024; o.N = 2048; o.src_ld = 2048; }
    else if (r == 1) { o.src = p.in[I_LRU_WOUT] + (size_t)ia * 1024 * 1024; o.dst = wt + WA_OUT + (size_t)ia * 1024 * 1024; o.K = 1024; o.N = 1024; o.src_ld = 1024; }
    else {
      const int isI = (r >= 10) ? 1 : 0; const int h = (r - 2) & 7;
      o.src = p.in[isI ? I_LRU_WI : I_LRU_WR] + ((size_t)ia * 8 + h) * 128 * 128;
      o.dst = wt + WA_G + (size_t)ia * 2048 * 128; o.K = 128; o.N = 128; o.src_ld = 128; o.kind = 1 + isI; o.n_off = h * 128;
    }
  } else if (j == 36) { o.src = p.in[I_SSM_WIN] + 2048; o.dst = wt + WB_XBC; o.K = 1024; o.N = 4128; o.src_ld = 6176; }
  else if (j == 37) { o.src = p.in[I_SSM_WIN]; o.dst = wt + WB_Z; o.K = 1024; o.N = 2048; o.src_ld = 6176; }
  else if (j == 38) { o.src = p.in[I_SSM_WOUT]; o.dst = wt + WB_OUT; o.K = 2048; o.N = 1024; o.src_ld = 1024; }
  else if (j < 42) { const int s = j - 39; o.src = p.in[I_RW_WRKV] + (size_t)s * 1024 * 1024; o.dst = wt + WC_RKV + (size_t)s * 1024 * 1024; o.K = 1024; o.N = 1024; o.src_ld = 1024; }
  else if (j == 42) { o.src = p.in[I_RW_WW1]; o.dst = wt + WC_L1; o.K = 1024; o.N = 64; o.src_ld = 64; }
  else if (j == 43) { o.src = p.in[I_RW_WA1]; o.dst = wt + WC_L1 + 64 * 1024; o.K = 1024; o.N = 64; o.src_ld = 64; }
  else if (j == 44) { o.src = p.in[I_RW_WG1]; o.dst = wt + WC_L1 + 128 * 1024; o.K = 1024; o.N = 128; o.src_ld = 128; }
  else if (j == 45) { o.src = p.in[I_RW_WW2]; o.dst = wt + WC_W2; o.K = 64; o.N = 1024; o.src_ld = 1024; }
  else if (j == 46) { o.src = p.in[I_RW_WA2]; o.dst = wt + WC_A2; o.K = 64; o.N = 1024; o.src_ld = 1024; }
  else if (j == 47) { o.src = p.in[I_RW_WG2]; o.dst = wt + WC_G2; o.K = 128; o.N = 1024; o.src_ld = 1024; }
  else if (j == 48) { o.src = p.in[I_RW_WOUT]; o.dst = wt + WC_OUT; o.K = 1024; o.N = 1024; o.src_ld = 1024; }
  else {
    const int l = (j - 49) >> 1, which = (j - 49) & 1;
    if (!which) { o.src = p.in[I_FFN_W1] + (size_t)l * 1024 * 4096; o.dst = wt + WF_1 + (size_t)l * 4096 * 1024; o.K = 1024; o.N = 4096; o.src_ld = 4096; }
    else { o.src = p.in[I_FFN_W2] + (size_t)l * 4096 * 1024; o.dst = wt + WF_2 + (size_t)l * 4096 * 1024; o.K = 4096; o.N = 1024; o.src_ld = 1024; }
  }
  return o;
}
constexpr int N_TJOBS = 57;

DI void ph_prologue(const Params& p, char* smem) {
  const int tid = TIDX, G = gridDim.x;
  {
    const float4* xp = (const float4*)p.in[I_XP];
    const float4* xs = (const float4*)p.in[I_XS];
    float4* X = (float4*)(p.ws + W_X);
    const size_t np = (size_t)TP_ * 256, nt = (size_t)T_ * 256;
    for (size_t i = (size_t)blockIdx.x * NTHR + tid; i < nt; i += (size_t)G * NTHR)
      X[i] = (i < np) ? xp[i] : xs[i - np];
  }
  float* tile = (float*)smem;
  int toff = 0;
  for (int jn = 0; jn < N_TJOBS; ++jn) {
    const TJob tj = get_tjob(p, jn);
    const int nkt = tj.K >> 6, nnt = (tj.N + 63) >> 6;
    const int ntiles = nkt * nnt;
    const int start = (((int)blockIdx.x - (toff % G)) + G) % G;
    for (int t = start; t < ntiles; t += G) {
      const int kt = t / nnt, nt = t - kt * nnt;
      const int k0 = kt * 64, n0 = nt * 64;
      __syncthreads();
#pragma unroll 4
      for (int i = 0; i < 16; ++i) {
        const int k = i * 4 + (tid >> 6), n = tid & 63;
        float v = 0.f;
        if (n0 + n < tj.N) v = tj.src[(size_t)(k0 + k) * tj.src_ld + n0 + n];
        tile[k * 65 + n] = v;
      }
      __syncthreads();
      const int n = tid >> 2, kq = tid & 3;
      if (n0 + n < tj.N) {
        int nrow = n0 + n;
        if (tj.kind) {
          const int ch = tj.n_off + n0 + n;
          nrow = (ch >> 6) * 128 + ((ch >> 5) & 1) * 64 + (tj.kind - 1) * 32 + (ch & 31);
        }
        float f[8], g[8];
#pragma unroll
        for (int e = 0; e < 8; ++e) { f[e] = tile[(kq * 16 + e) * 65 + n]; g[e] = tile[(kq * 16 + 8 + e) * 65 + n]; }
        uint4* d = (uint4*)(tj.dst + (size_t)nrow * tj.K + k0 + kq * 16);
        d[0] = pack8(f); d[1] = pack8(g);
      }
    }
    toff += ntiles;
  }
}

DI void ph_rmsnorm(const Params& p, int mode, const float* w) {
  const int tid_ = TIDX; const int lane = tid_ & 63;
  const int gw = blockIdx.x * 4 + (tid_ >> 6), nw = gridDim.x * 4;
  const float* X = (const float*)(p.ws + W_X);
  bf16_t* U = (bf16_t*)(p.ws + W_U);
  bf16_t* UP = (bf16_t*)(p.ws + SC_UP);
  float4 wv[4];
#pragma unroll
  for (int i = 0; i < 4; ++i) wv[i] = ((const float4*)w)[lane + 64 * i];
  for (int row = gw; row < T_; row += nw) {
    const float4* xr = (const float4*)(X + (size_t)row * 1024);
    float4 v[4]; float ss = 0.f;
#pragma unroll
    for (int i = 0; i < 4; ++i) { v[i] = xr[lane + 64 * i]; ss += v[i].x * v[i].x + v[i].y * v[i].y + v[i].z * v[i].z + v[i].w * v[i].w; }
    ss = wave_sum(ss);
    const float rstd = rsqrtf(ss * (1.f / 1024.f) + 1e-6f);
    int seq, l, L; tok_info(row, seq, l, L);
#pragma unroll
    for (int i = 0; i < 4; ++i) {
      const int c = 4 * (lane + 64 * i);
      float4 y = make_float4(v[i].x * rstd * wv[i].x, v[i].y * rstd * wv[i].y, v[i].z * rstd * wv[i].z, v[i].w * rstd * wv[i].w);
      if (mode == 2) {
        *(float4*)(p.out + O_Y + (size_t)row * 1024 + c) = y;
      } else {
        uint2 pk = make_uint2(pack2(y.x, y.y), pack2(y.z, y.w));
        *(uint2*)(U + (size_t)row * 1024 + c) = pk;
        if (mode == 1) {
          if (l + 1 < L) *(uint2*)(UP + (size_t)(row + 1) * 1024 + c) = pk;
          if (l == 0) {
            uint2 pz = make_uint2(0, 0);
            if (seq >= 8) { float4 s = *(const float4*)(p.in[I_ST_RS] + (size_t)(seq - 8) * 1024 + c); pz = make_uint2(pack2(s.x, s.y), pack2(s.z, s.w)); }
            *(uint2*)(UP + (size_t)row * 1024 + c) = pz;
          }
          if (l == L - 1) {
            float* o = (seq < 8) ? (p.out + O_RS_P + (size_t)seq * 1024 + c) : (p.out + O_RS_S + (size_t)(seq - 8) * 1024 + c);
            *(float4*)o = y;
          }
        }
      }
    }
  }
}

template <int C, bool SILU>
DI void ph_conv(const bf16_t* __restrict__ src, bf16_t* __restrict__ dst, const float* __restrict__ cw,
                const float* __restrict__ cb, const float* __restrict__ state,
                float* __restrict__ out_p, float* __restrict__ out_s) {
  constexpr int GR = C / 8;
  const size_t total = (size_t)T_ * GR;
#pragma unroll 2
  for (size_t idx = (size_t)blockIdx.x * NTHR + TIDX; idx < total; idx += (size_t)gridDim.x * NTHR) {
    const int t = (int)(idx / GR), c = (int)(idx % GR) * 8;
    int seq, l, L; tok_info(t, seq, l, L);
    float acc[8]; load8f(cb + c, acc);
    float xcur[8];
#pragma unroll
    for (int jj = 0; jj < 4; ++jj) {
      const int ls = l - 3 + jj;
      float xv[8];
      if (ls >= 0) { unpack8(*(const uint4*)(src + (size_t)(t - 3 + jj) * C + c), xv); }
      else if (seq >= 8) { load8f(state + ((size_t)(seq - 8) * 3 + (ls + 3)) * C + c, xv); }
      else {
#pragma unroll
        for (int e = 0; e < 8; ++e) xv[e] = 0.f;
      }
      float w8[8]; load8f(cw + (size_t)jj * C + c, w8);
#pragma unroll
      for (int e = 0; e < 8; ++e) acc[e] += w8[e] * xv[e];
      if (jj == 3) {
#pragma unroll
        for (int e = 0; e < 8; ++e) xcur[e] = xv[e];
      }
    }
    if (SILU) {
#pragma unroll
      for (int e = 0; e < 8; ++e) acc[e] = siluf_(acc[e]);
    }
    *(uint4*)(dst + (size_t)t * C + c) = pack8(acc);
    if (l >= L - 3) {
      const int r = l - (L - 3);
      float* o = (seq < 8) ? (out_p + ((size_t)seq * 3 + r) * C + c) : (out_s + ((size_t)(seq - 8) * 3 + r) * C + c);
      store8f(o, xcur);
    }
  }
}

DI void ph_lru_scan1(const Params& p) {
  const float* AA = (const float*)(p.ws + SA_AA);
  const float* BB = (const float*)(p.ws + SA_BB);
  float* CP = (float*)(p.ws + SA_CP);
  float* CS = (float*)(p.ws + SA_CS);
  const int total = 8 * 64 * 1024;
  for (int idx = blockIdx.x * NTHR + TIDX; idx < total; idx += gridDim.x * NTHR) {
    const int ch = idx & 1023, c = (idx >> 10) & 63, b = idx >> 16;
    const size_t base = ((size_t)b * 2048 + c * 32) * 1024 + ch;
    float P = 1.f, S = 0.f;
    float av[32], bv[32];
#pragma unroll
    for (int s = 0; s < 32; ++s) { av[s] = AA[base + (size_t)s * 1024]; bv[s] = BB[base + (size_t)s * 1024]; }
#pragma unroll
    for (int s = 0; s < 32; ++s) { S = av[s] * S + bv[s]; P *= av[s]; }
    CP[idx] = P; CS[idx] = S;
  }
}
DI void ph_lru_scan2(const Params& p, int ia) {
  const float* AA = (const float*)(p.ws + SA_AA);
  const float* BB = (const float*)(p.ws + SA_BB);
  const float* CP = (const float*)(p.ws + SA_CP);
  const float* CS = (const float*)(p.ws + SA_CS);
  bf16_t* GT = (bf16_t*)(p.ws + SA_GT);
  const int nP = 8 * 64 * 1024, total = nP + 128 * 1024;
  for (int idx = blockIdx.x * NTHR + TIDX; idx < total; idx += gridDim.x * NTHR) {
    if (idx < nP) {
      const int ch = idx & 1023, c = (idx >> 10) & 63, b = idx >> 16;
      const size_t base = ((size_t)b * 2048 + c * 32) * 1024 + ch;
      float av[32], bv[32]; bf16_t gv[32];
#pragma unroll
      for (int s = 0; s < 32; ++s) { const size_t o = base + (size_t)s * 1024; av[s] = AA[o]; bv[s] = BB[o]; gv[s] = GT[o]; }
      float h = 0.f;
#pragma unroll 8
      for (int c2 = 0; c2 < c; ++c2) {
        const int ci = ((b * 64 + c2) << 10) + ch;
        h = CP[ci] * h + CS[ci];
      }
#pragma unroll
      for (int s = 0; s < 32; ++s) {
        const size_t o = base + (size_t)s * 1024;
        h = av[s] * h + bv[s];
        GT[o] = f2bf(h * bf2f(gv[s]));
      }
      if (c == 63) p.out[O_LH_P + ((size_t)ia * 8 + b) * 1024 + ch] = h;
    } else {
      const int u = idx - nP; const int ch = u & 1023, s = u >> 10;
      float h = p.in[I_ST_LH][((size_t)ia * 128 + s) * 1024 + ch];
      const size_t base = ((size_t)TP_ + s * 8) * 1024 + ch;
#pragma unroll
      for (int q = 0; q < 8; ++q) {
        const size_t o = base + (size_t)q * 1024;
        h = AA[o] * h + BB[o];
        GT[o] = f2bf(h * bf2f(GT[o]));
      }
      p.out[O_LH_S + ((size_t)ia * 128 + s) * 1024 + ch] = h;
    }
  }
}

DI void ssd_item(const Params& p, char* smem, int seq, int h) {
  const int tid = TIDX, lane = tid & 63, w = tid >> 6, r32 = lane & 31, hh = lane >> 5;
  bf16_t* Cs = (bf16_t*)smem;
  bf16_t* Bs = Cs + 64 * 136;
  bf16_t* Sb = Bs + 64 * 136;
  bf16_t* Xt = Sb + 64 * 136;
  bf16_t* Btr = Xt + 64 * 72;
  float* dts = (float*)(Btr + 128 * 72);
  float* acs = dts + 64;
  bf16_t* Ws = Bs;
  const bf16_t* XBC = (const bf16_t*)(p.ws + SB_XBC);
  const float* DT = (const float*)(p.ws + SB_DT);
  bf16_t* Y = (bf16_t*)(p.ws + SB_Y);
  const bool prompt = seq < 8;
  const int nchunk = prompt ? 32 : 1, Lv = prompt ? 64 : 8;
  const int tbase = prompt ? seq * 2048 : TP_ + (seq - 8) * 8;
  const int g = h >> 2;
  const float Ah = -__expf(p.in[I_SSM_ALOG][h]);
  const float Dh = p.in[I_SSM_D][h];
  f32x16 accS[2];
  {
    const float* s0 = p.in[I_ST_SS] + ((size_t)(seq - 8) * 32 + h) * 64 * 128;
#pragma unroll
    for (int mi = 0; mi < 2; ++mi)
#pragma unroll
      for (int r = 0; r < 16; ++r) {
        const int prow = mi * 32 + (r & 3) + 8 * (r >> 2) + 4 * hh, n = 32 * w + r32;
        accS[mi][r] = prompt ? 0.f : s0[(size_t)prow * 128 + n];
      }
  }
  __syncthreads();
#pragma unroll
  for (int mi = 0; mi < 2; ++mi)
#pragma unroll
    for (int r = 0; r < 16; ++r) {
      const int prow = mi * 32 + (r & 3) + 8 * (r >> 2) + 4 * hh, n = 32 * w + r32;
      Sb[prow * 136 + n] = f2bf(accS[mi][r]);
    }
  uint4 pc0, pc1, pc2, pc3, pb0, pb1, pb2, pb3, px0, px1;
  float pdt = 0.f;
  const uint4 z4 = make_uint4(0, 0, 0, 0);
  pc0 = pc1 = pc2 = pc3 = pb0 = pb1 = pb2 = pb3 = px0 = px1 = z4;
#define SSD_LD_CB(i, t0_)                                                                  \
  { const int id_ = tid + 256 * i, row_ = id_ >> 4, ch_ = id_ & 15;                        \
    pc##i = z4; pb##i = z4;                                                                \
    if (row_ < Lv) { const bf16_t* src_ = XBC + (size_t)((t0_) + row_) * 4096 + g * 128 + ch_ * 8; \
      pb##i = *(const uint4*)(src_ + 2048); pc##i = *(const uint4*)(src_ + 3072); } }
#define SSD_LD_X(i, t0_)                                                                   \
  { const int id_ = tid + 256 * i, row_ = id_ >> 3, ch_ = id_ & 7;                         \
    px##i = z4;                                                                            \
    if (row_ < Lv) px##i = *(const uint4*)(XBC + (size_t)((t0_) + row_) * 4096 + h * 64 + ch_ * 8); }
#define SSD_ISSUE(t0_)                                                                     \
  { SSD_LD_CB(0, t0_) SSD_LD_CB(1, t0_) SSD_LD_CB(2, t0_) SSD_LD_CB(3, t0_) SSD_LD_X(0, t0_) SSD_LD_X(1, t0_) \
    pdt = (tid < Lv && tid < 64) ? DT[(size_t)((t0_) + tid) * 32 + h] : 0.f; }
#define SSD_ST_CB(i)                                                                       \
  { const int id_ = tid + 256 * i, row_ = id_ >> 4, ch_ = id_ & 15;                        \
    *(uint4*)(Cs + row_ * 136 + ch_ * 8) = pc##i;                                          \
    *(uint4*)(Bs + row_ * 136 + ch_ * 8) = pb##i;                                          \
    float f_[8]; unpack8(pb##i, f_);                                                       \
    const float sc_ = __expf(aend - acs[row_]);                                            \
    _Pragma("unroll") for (int e = 0; e < 8; ++e) Btr[(ch_ * 8 + e) * 72 + row_] = f2bf(f_[e] * sc_); }
#define SSD_ST_X(i)                                                                        \
  { const int id_ = tid + 256 * i, row_ = id_ >> 3, ch_ = id_ & 7;                         \
    float f_[8]; unpack8(px##i, f_);                                                       \
    const float sc_ = dts[row_];                                                           \
    _Pragma("unroll") for (int e = 0; e < 8; ++e) Xt[(ch_ * 8 + e) * 72 + row_] = f2bf(f_[e] * sc_); }
  SSD_ISSUE(tbase);
  for (int c = 0; c < nchunk; ++c) {
    const int t0 = tbase + c * 64;
    __syncthreads();
    if (tid < 64) {
      const float dtv = pdt;
      float x = dtv * Ah;
#pragma unroll
      for (int o = 1; o < 64; o <<= 1) { const float y = __shfl_up(x, o, 64); if (lane >= o) x += y; }
      dts[tid] = dtv; acs[tid] = x;
    }
    __syncthreads();
    const float aend = acs[63];
    SSD_ST_CB(0) SSD_ST_CB(1) SSD_ST_CB(2) SSD_ST_CB(3) SSD_ST_X(0) SSD_ST_X(1)
    if (c + 1 < nchunk) { SSD_ISSUE(t0 + 64); }
    __syncthreads();
    const int it = w >> 1, jt = w & 1;
    f32x16 cb;
#pragma unroll
    for (int r = 0; r < 16; ++r) cb[r] = 0.f;
    if (jt <= it) {
#pragma unroll
      for (int ks = 0; ks < 8; ++ks) {
        bf16x8 a = *(const bf16x8*)(Cs + (it * 32 + r32) * 136 + ks * 16 + hh * 8);
        bf16x8 b = *(const bf16x8*)(Bs + (jt * 32 + r32) * 136 + ks * 16 + hh * 8);
        cb = mfma32(a, b, cb);
      }
    }
    __syncthreads();
    {
      const int jj = jt * 32 + r32; const float aj = acs[jj];
#pragma unroll
      for (int r = 0; r < 16; ++r) {
        const int ii = it * 32 + (r & 3) + 8 * (r >> 2) + 4 * hh;
        const float v = (jj <= ii) ? cb[r] * __expf(acs[ii] - aj) : 0.f;
        Ws[ii * 72 + jj] = f2bf(v);
      }
    }
    __syncthreads();
    {
      const int pt = w & 1;
      f32x16 yd, yo;
#pragma unroll
      for (int r = 0; r < 16; ++r) { yd[r] = 0.f; yo[r] = 0.f; }
#pragma unroll
      for (int ks = 0; ks < 4; ++ks) {
        bf16x8 a = *(const bf16x8*)(Ws + (it * 32 + r32) * 72 + ks * 16 + hh * 8);
        bf16x8 b = *(const bf16x8*)(Xt + (pt * 32 + r32) * 72 + ks * 16 + hh * 8);
        yd = mfma32(a, b, yd);
      }
#pragma unroll
      for (int ks = 0; ks < 8; ++ks) {
        bf16x8 a = *(const bf16x8*)(Cs + (it * 32 + r32) * 136 + ks * 16 + hh * 8);
        bf16x8 b = *(const bf16x8*)(Sb + (pt * 32 + r32) * 136 + ks * 16 + hh * 8);
        yo = mfma32(a, b, yo);
      }
      const int pp = pt * 32 + r32;
#pragma unroll
      for (int r = 0; r < 16; ++r) {
        const int ii = it * 32 + (r & 3) + 8 * (r >> 2) + 4 * hh;
        if (ii < Lv) {
          const size_t t = (size_t)(t0 + ii);
          const float xv = bf2f(XBC[t * 4096 + h * 64 + pp]);
          const float yv = yd[r] + __expf(acs[ii]) * yo[r] + Dh * xv;
          Y[t * 2048 + h * 64 + pp] = f2bf(yv);
        }
      }
    }
    {
      const float dec = __expf(aend);
#pragma unroll
      for (int mi = 0; mi < 2; ++mi)
#pragma unroll
        for (int r = 0; r < 16; ++r) accS[mi][r] *= dec;
#pragma unroll
      for (int ks = 0; ks < 4; ++ks) {
        bf16x8 b = *(const bf16x8*)(Btr + (32 * w + r32) * 72 + ks * 16 + hh * 8);
        bf16x8 a0 = *(const bf16x8*)(Xt + (r32) * 72 + ks * 16 + hh * 8);
        bf16x8 a1 = *(const bf16x8*)(Xt + (32 + r32) * 72 + ks * 16 + hh * 8);
        accS[0] = mfma32(a0, b, accS[0]);
        accS[1] = mfma32(a1, b, accS[1]);
      }
    }
    __syncthreads();
#pragma unroll
    for (int mi = 0; mi < 2; ++mi)
#pragma unroll
      for (int r = 0; r < 16; ++r) {
        const int prow = mi * 32 + (r & 3) + 8 * (r >> 2) + 4 * hh, n = 32 * w + r32;
        Sb[prow * 136 + n] = f2bf(accS[mi][r]);
      }
  }
  float* dst = prompt ? (p.out + O_SS_P + ((size_t)seq * 32 + h) * 64 * 128)
                      : (p.out + O_SS_S + ((size_t)(seq - 8) * 32 + h) * 64 * 128);
#pragma unroll
  for (int mi = 0; mi < 2; ++mi)
#pragma unroll
    for (int r = 0; r < 16; ++r) {
      const int prow = mi * 32 + (r & 3) + 8 * (r >> 2) + 4 * hh, n = 32 * w + r32;
      dst[(size_t)prow * 128 + n] = accS[mi][r];
    }
}

#undef SSD_LD_CB
#undef SSD_LD_X
#undef SSD_ISSUE
#undef SSD_ST_CB
#undef SSD_ST_X
DI void ph_ssd(const Params& p, char* smem) {
  const int G = gridDim.x, bid = blockIdx.x;
  int it = bid, step = G;
  if (G >= 512) { if (bid < 256) { step = 1 << 30; } else { step = G - 256; } }
#pragma nounroll
  for (; it < 256 + 4096; it += step) {
    const int seq = (it < 256) ? (it >> 5) : (8 + ((it - 256) >> 5));
    ssd_item(p, smem, seq, it & 31);
  }
}

DI void ph_gnorm(const Params& p) {
  const int tid_ = TIDX; const int lane = tid_ & 63;
  const int gw = blockIdx.x * 4 + (tid_ >> 6), nw = gridDim.x * 4;
  bf16_t* Y = (bf16_t*)(p.ws + SB_Y);
  const float* nwt = p.in[I_SSM_NW];
  for (int item = gw; item < T_ * 8; item += 2 * nw) {
    const int item2 = item + nw; const bool v2 = item2 < T_ * 8;
    bf16_t* yp1 = Y + (size_t)(item >> 3) * 2048 + (item & 7) * 256 + lane * 4;
    bf16_t* yp2 = Y + (size_t)((v2 ? item2 : item) >> 3) * 2048 + ((v2 ? item2 : item) & 7) * 256 + lane * 4;
    const uint2 a = *(const uint2*)yp1; const uint2 b = *(const uint2*)yp2;
    float f[4], g[4]; unpack4(a, f); unpack4(b, g);
    const float ss1 = wave_sum(f[0] * f[0] + f[1] * f[1] + f[2] * f[2] + f[3] * f[3]);
    const float ss2 = wave_sum(g[0] * g[0] + g[1] * g[1] + g[2] * g[2] + g[3] * g[3]);
    const float r1 = rsqrtf(ss1 * (1.f / 256.f) + 1e-5f), r2 = rsqrtf(ss2 * (1.f / 256.f) + 1e-5f);
    const float4 w1 = *(const float4*)(nwt + (item & 7) * 256 + lane * 4);
    const float4 w2 = *(const float4*)(nwt + ((v2 ? item2 : item) & 7) * 256 + lane * 4);
    *(uint2*)yp1 = make_uint2(pack2(f[0] * r1 * w1.x, f[1] * r1 * w1.y), pack2(f[2] * r1 * w1.z, f[3] * r1 * w1.w));
    if (v2) *(uint2*)yp2 = make_uint2(pack2(g[0] * r2 * w2.x, g[1] * r2 * w2.y), pack2(g[2] * r2 * w2.z, g[3] * r2 * w2.w));
  }
}

template <int LPR>
DI void wkv_item(const Params& p, char* smem, int seq, int head, int part) {
  constexpr int ROWS = 256 / LPR, KPL = 64 / LPR, NV4 = KPL / 4;
  const int tid = TIDX;
  float* sR = (float*)smem;
  float* sK = sR + 2048;
  float* sKK = sK + 2048;
  float* sBB = sKK + 2048;
  float* sW = sBB + 2048;
  float* sV = sW + 2048;
  float* sO = sV + 2048;
  const bf16_t* __restrict__ R = (const bf16_t*)(p.ws + SC_R);
  const bf16_t* __restrict__ K = (const bf16_t*)(p.ws + SC_K);
  const bf16_t* __restrict__ V = (const bf16_t*)(p.ws + SC_V);
  const bf16_t* __restrict__ AAc = (const bf16_t*)(p.ws + SC_AA);
  const float* __restrict__ WD = (const float*)(p.ws + SC_WD);
  bf16_t* O = (bf16_t*)(p.ws + SC_O);
  const bool prompt = seq < 8;
  const int nch = prompt ? 64 : 1, nvalid = prompt ? 32 : 8;
  const int tbase = prompt ? seq * 2048 : TP_ + (seq - 8) * 8;
  const int row_l = tid / LPR, q = tid % LPR, row = part * ROWS + row_l;
  float S[KPL];
  {
    const float* s0 = p.in[I_ST_RW] + (((size_t)(seq - 8) * 16 + head) * 64 + row) * 64 + q * KPL;
#pragma unroll
    for (int e = 0; e < KPL; ++e) S[e] = prompt ? 0.f : s0[e];
  }
  const int pst = tid >> 3, pk0 = (tid & 7) * 8, pcol = head * 64 + pk0;
  const bool pact = pst < nvalid;
  float kk8[8], ka8[8];
  load8f(p.in[I_RW_KK] + pcol, kk8);
  load8f(p.in[I_RW_KA] + pcol, ka8);
  uint4 qr = make_uint4(0, 0, 0, 0), qk = qr, qv = qr, qa = qr;
  float4 qw0 = make_float4(0.f, 0.f, 0.f, 0.f), qw1 = qw0;
#define WKV_ISSUE(c_)                                                       \
  if (pact) {                                                               \
    const size_t o_ = (size_t)(tbase + (c_) * 32 + pst) * 1024 + pcol;      \
    qr = *(const uint4*)(R + o_); qk = *(const uint4*)(K + o_);             \
    qv = *(const uint4*)(V + o_); qa = *(const uint4*)(AAc + o_);           \
    qw0 = *(const float4*)(WD + o_); qw1 = *(const float4*)(WD + o_ + 4);   \
  }
  WKV_ISSUE(0);
  for (int c = 0; c < nch; ++c) {
    const int t0 = tbase + c * 32;
    __syncthreads();
    if (pact) {
      float r8[8], k8[8], v8[8], a8[8];
      unpack8(qr, r8); unpack8(qk, k8); unpack8(qv, v8); unpack8(qa, a8);
      const float w8[8] = {qw0.x, qw0.y, qw0.z, qw0.w, qw1.x, qw1.y, qw1.z, qw1.w};
      float kr[8], ss = 0.f;
#pragma unroll
      for (int e = 0; e < 8; ++e) { kr[e] = k8[e] * kk8[e]; ss += kr[e] * kr[e]; }
      ss = red_lanes<8>(ss);
      const float inv = 1.f / fmaxf(sqrtf(ss), 1e-12f);
      float kp[8], bb[8];
#pragma unroll
      for (int e = 0; e < 8; ++e) { kr[e] *= inv; kp[e] = k8[e] * (1.f + (a8[e] - 1.f) * ka8[e]); bb[e] = kr[e] * a8[e]; }
      const int lo = pst * 64 + pk0;
      store8f(sR + lo, r8); store8f(sK + lo, kp); store8f(sKK + lo, kr); store8f(sBB + lo, bb);
      store8f(sW + lo, w8); store8f(sV + lo, v8);
    }
    __syncthreads();
    if (c + 1 < nch) { WKV_ISSUE(c + 1); }
#define WKV_LOADV(P, st_)                                                                      \
    {                                                                                          \
      const int lo_ = (st_) * 64 + q * KPL;                                                    \
      _Pragma("unroll") for (int e = 0; e < NV4; ++e) {                                        \
        P##kk[e] = *(const float4*)(sKK + lo_ + 4 * e); P##ww[e] = *(const float4*)(sW + lo_ + 4 * e); \
        P##bb[e] = *(const float4*)(sBB + lo_ + 4 * e); P##kp[e] = *(const float4*)(sK + lo_ + 4 * e); \
        P##rr[e] = *(const float4*)(sR + lo_ + 4 * e);                                         \
      }                                                                                        \
      P##vv = sV[(st_) * 64 + row];                                                            \
    }
#define WKV_STEP(P, st_)                                                                       \
    {                                                                                          \
      float sa0 = 0.f, sa1 = 0.f;                                                              \
      _Pragma("unroll") for (int e = 0; e < NV4; ++e) {                                        \
        sa0 += S[4 * e] * P##kk[e].x + S[4 * e + 2] * P##kk[e].z;                              \
        sa1 += S[4 * e + 1] * P##kk[e].y + S[4 * e + 3] * P##kk[e].w;                          \
      }                                                                                        \
      const float sa = red_lanes<LPR>(sa0 + sa1);                                              \
      float o0 = 0.f, o1 = 0.f;                                                                \
      _Pragma("unroll") for (int e = 0; e < NV4; ++e) {                                        \
        S[4 * e] = S[4 * e] * P##ww[e].x - sa * P##bb[e].x + P##vv * P##kp[e].x;               \
        S[4 * e + 1] = S[4 * e + 1] * P##ww[e].y - sa * P##bb[e].y + P##vv * P##kp[e].y;       \
        S[4 * e + 2] = S[4 * e + 2] * P##ww[e].z - sa * P##bb[e].z + P##vv * P##kp[e].z;       \
        S[4 * e + 3] = S[4 * e + 3] * P##ww[e].w - sa * P##bb[e].w + P##vv * P##kp[e].w;       \
        o0 += S[4 * e] * P##rr[e].x + S[4 * e + 2] * P##rr[e].z;                               \
        o1 += S[4 * e + 1] * P##rr[e].y + S[4 * e + 3] * P##rr[e].w;                           \
      }                                                                                        \
      const float oo = red_lanes<LPR>(o0 + o1);                                                \
      if (q == 0) sO[(st_) * ROWS + row_l] = oo;                                               \
    }
    {
      float4 Akk[NV4], Aww[NV4], Abb[NV4], Akp[NV4], Arr[NV4]; float Avv;
      float4 Bkk[NV4], Bww[NV4], Bbb[NV4], Bkp[NV4], Brr[NV4]; float Bvv;
      if (LPR <= 4) {
#pragma unroll 1
        for (int st = 0; st < nvalid; ++st) { WKV_LOADV(A, st); WKV_STEP(A, st); }
      } else {
        WKV_LOADV(A, 0);
#pragma unroll 1
        for (int st = 0; st < nvalid; st += 2) {
          WKV_LOADV(B, st + 1);
          WKV_STEP(A, st);
          if (st + 2 < nvalid) { WKV_LOADV(A, st + 2); }
          WKV_STEP(B, st + 1);
        }
      }
    }
    __syncthreads();
    for (int i = tid; i < nvalid * ROWS; i += NTHR) {
      const int st = i / ROWS, rr = i % ROWS;
      O[(size_t)(t0 + st) * 1024 + head * 64 + part * ROWS + rr] = f2bf(sO[i]);
    }
  }
#undef WKV_ISSUE
#undef WKV_LOADV
#undef WKV_STEP
  float* dst = prompt ? (p.out + O_RW_P + (((size_t)seq * 16 + head) * 64 + row) * 64 + q * KPL)
                      : (p.out + O_RW_S + (((size_t)(seq - 8) * 16 + head) * 64 + row) * 64 + q * KPL);
#pragma unroll
  for (int e = 0; e < KPL; ++e) dst[e] = S[e];
}

template <int LPRP>
DI void ph_wkv(const Params& p, char* smem) {
  constexpr int NPART = 64 / (256 / LPRP);
  const int G = gridDim.x, bid = blockIdx.x;
  const int nP = 128 * NPART;
#pragma nounroll
  for (int it = bid; it < nP; it += G) {
    const int part = it % NPART, sh = it / NPART;
    wkv_item<LPRP>(p, smem, sh >> 4, sh & 15, part);
  }
  const int nS = 2048;
  const int first = (bid + G - (nP % G)) % G;
#pragma nounroll
  for (int it = first; it < nS; it += G) wkv_item<4>(p, smem, 8 + (it >> 4), it & 15, 0);
}

DI void ph_wkv_post(const Params& p) {
  const int tid_ = TIDX; const int lane = tid_ & 63;
  const int gw = blockIdx.x * 4 + (tid_ >> 6), nw = gridDim.x * 4;
  const bf16_t* __restrict__ R = (const bf16_t*)(p.ws + SC_R);
  const bf16_t* __restrict__ K = (const bf16_t*)(p.ws + SC_K);
  const bf16_t* __restrict__ V = (const bf16_t*)(p.ws + SC_V);
  const bf16_t* __restrict__ AAc = (const bf16_t*)(p.ws + SC_AA);
  const bf16_t* __restrict__ Gg = (const bf16_t*)(p.ws + SC_G);
  const bf16_t* __restrict__ O = (const bf16_t*)(p.ws + SC_O);
  bf16_t* __restrict__ U = (bf16_t*)(p.ws + W_U);
#pragma unroll 2
  for (int item = gw; item < T_ * 4; item += nw) {
    const int t = item >> 2, col = (item & 3) * 256 + lane * 4;
    const size_t o = (size_t)t * 1024 + col;
    float ov[4], rv[4], kv[4], av[4], vv[4], gv[4];
    unpack4(*(const uint2*)(O + o), ov); unpack4(*(const uint2*)(R + o), rv); unpack4(*(const uint2*)(K + o), kv);
    unpack4(*(const uint2*)(AAc + o), av); unpack4(*(const uint2*)(V + o), vv); unpack4(*(const uint2*)(Gg + o), gv);
    const float4 lw = *(const float4*)(p.in[I_RW_LNW] + col), lb = *(const float4*)(p.in[I_RW_LNB] + col);
    const float4 ka = *(const float4*)(p.in[I_RW_KA] + col), rk = *(const float4*)(p.in[I_RW_RK] + col);
    const float lwv[4] = {lw.x, lw.y, lw.z, lw.w}, lbv[4] = {lb.x, lb.y, lb.z, lb.w};
    const float kav[4] = {ka.x, ka.y, ka.z, ka.w}, rkv[4] = {rk.x, rk.y, rk.z, rk.w};
    const float mean = red_lanes<16>(ov[0] + ov[1] + ov[2] + ov[3]) * (1.f / 64.f);
    float d[4], s2 = 0.f, s3 = 0.f;
#pragma unroll
    for (int e = 0; e < 4; ++e) {
      d[e] = ov[e] - mean; s2 += d[e] * d[e];
      const float kp = kv[e] * (1.f + (av[e] - 1.f) * kav[e]);
      s3 += rv[e] * kp * rkv[e];
    }
    s2 = red_lanes<16>(s2); s3 = red_lanes<16>(s3);
    const float rs = rsqrtf(s2 * (1.f / 64.f) + 64e-5f);
    float y[4];
#pragma unroll
    for (int e = 0; e < 4; ++e) y[e] = (d[e] * rs * lwv[e] + lbv[e] + s3 * vv[e]) * gv[e];
    *(uint2*)(U + o) = make_uint2(pack2(y[0], y[1]), pack2(y[2], y[3]));
  }
}

constexpr int NPH = 40;
#ifndef REP_GEMM
#define REP_GEMM 1
#endif
#ifndef REP_SSD
#define REP_SSD 1
#endif
#ifndef REP_WKV
#define REP_WKV 1
#endif
#ifndef REP_MISC
#define REP_MISC 1
#endif

__global__ void __launch_bounds__(NTHR, 2) mega(Params p) {
  __shared__ __attribute__((aligned(16))) char smem[SMEM_BYTES];
  __shared__ uint4 xb_words;
  cg::grid_group grid = cg::this_grid();
  if (threadIdx.x == 0) xb_words = make_uint4(0u, 0u, 0u, 0u);
  __syncthreads();
  XcdBarrier xb = xcd_barrier_post((unsigned*)(p.ws + W_BAR), (volatile LAS unsigned*)&xb_words);
  int ph = 0;
#define PH(...)                                                     \
  {                                                                 \
    if (ph >= p.ph_begin && ph < p.ph_end) {                        \
      __VA_ARGS__;                                                  \
      xcd_barrier(xb);                                              \
    }                                                               \
    ++ph;                                                           \
  }
#define PHR(rep, ...)                                               \
  {                                                                 \
    if (ph >= p.ph_begin && ph < p.ph_end) {                        \
      for (int rep_ = 0; rep_ < (rep); ++rep_) {                    \
        __VA_ARGS__;                                                \
        xcd_barrier(xb);                                            \
      }                                                             \
    }                                                               \
    ++ph;                                                           \
  }
#define PH_LAST(...)                                                \
  {                                                                 \
    if (ph >= p.ph_begin && ph < p.ph_end) { __VA_ARGS__; }         \
    ++ph;                                                           \
  }
  bf16_t* wt = (bf16_t*)(p.ws + W_WT);
  bf16_t* U = (bf16_t*)(p.ws + W_U);
  float* X = (float*)(p.ws + W_X);

  {
    if (ph >= p.ph_begin && ph < p.ph_end) { ph_prologue(p, smem); grid.sync(); }
    ++ph;
    if (threadIdx.x == 0) {
      unsigned* bar = (unsigned*)(p.ws + W_BAR);
      unsigned base = 0;
      for (unsigned jx = 0; jx < 16; ++jx) { const unsigned c = xb_ld(&bar[XB_XCNT(jx)]); base += (jx < xb.x) ? c : 0u; }
      volatile LAS unsigned* st = (volatile LAS unsigned*)&xb_words;
      st[3] = base + st[2];
    }
    __syncthreads();
  }

#pragma nounroll
  for (int layer = 0; layer < 4; ++layer) {
    const int kind = layer % 3;
    PHR(REP_MISC, ph_rmsnorm(p, kind == 2 ? 1 : 0, p.in[I_NMIX] + layer * 1024));
    if (kind == 0) {
      const int ia = layer / 3;
      PHR(REP_GEMM, {
        GJob j = mkjob(U, 1024, wt + WA_IN + (size_t)ia * 2048 * 1024, 1024, 1024, 2048);
        j.o0 = p.ws + SA_XB; j.o1 = p.ws + SA_GT;
        int toff = 0; gemm_run<EPI_LRU_IN, false>(j, 8, toff, smem, VBLOCK());
      });
      PHR(REP_MISC, (ph_conv<1024, false>((const bf16_t*)(p.ws + SA_XB), (bf16_t*)(p.ws + SA_XC),
                               p.in[I_LRU_CW] + (size_t)ia * 4 * 1024, p.in[I_LRU_CB] + (size_t)ia * 1024,
                               p.in[I_ST_LC] + (size_t)ia * 128 * 3 * 1024,
                               p.out + O_LC_P + (size_t)ia * 8 * 3 * 1024, p.out + O_LC_S + (size_t)ia * 128 * 3 * 1024)));
      PHR(REP_GEMM, {
        const int G = gridDim.x;
        for (int tile = VBLOCK(); tile < MT_ * 8; tile += G) {
          const int mt = tile >> 3, jt = tile & 7;
          GJob j = mkjob((const bf16_t*)(p.ws + SA_XC) + jt * 128, 1024,
                         wt + WA_G + (size_t)ia * 2048 * 128, 128, 128, 2048);
          j.o0 = p.ws + SA_AA; j.o1 = p.ws + SA_XC;
          j.x0 = p.in[I_LRU_BR] + ia * 1024; j.x1 = p.in[I_LRU_BI] + ia * 1024; j.x2 = p.in[I_LRU_LAM] + ia * 1024;
          gemm_tile_dma<EPI_GATES>(j, mt * 128, jt * 256, 0, 4, smem);
        }
      });
      PHR(REP_MISC, ph_lru_scan1(p));
      PH(ph_lru_scan2(p, ia));
      PH({
        GJob j = mkjob((const bf16_t*)(p.ws + SA_GT), 1024, wt + WA_OUT + (size_t)ia * 1024 * 1024, 1024, 1024, 1024);
        j.o0 = X;
        gemm_streamk<EPI_RESID>(j, 4, smem, VBLOCK(), (unsigned*)(p.ws + W_BAR) + 4096, (unsigned)(layer * 2 + 1));
      });
    } else if (kind == 1) {
      PHR(REP_GEMM, {
        GJob j = mkjob(U, 1024, wt + WB_XBC, 1024, 1024, 4128);
        j.o0 = p.ws + SB_XBCP; j.o1 = p.ws + SB_DT; j.x0 = p.in[I_SSM_DTB];
        int toff = 0; gemm_run<EPI_SSM_XBC, false>(j, 17, toff, smem, VBLOCK());
      });
      PHR(REP_MISC, (ph_conv<4096, true>((const bf16_t*)(p.ws + SB_XBCP), (bf16_t*)(p.ws + SB_XBC),
                              p.in[I_SSM_CW], p.in[I_SSM_CB], p.in[I_ST_SC],
                              p.out + O_SC_P, p.out + O_SC_S)));
      PHR(REP_SSD, ph_ssd(p, smem));
      PH({
        GJob j = mkjob(U, 1024, wt + WB_Z, 1024, 1024, 2048);
        j.o0 = p.ws + SB_Y;
        int toff = 0; gemm_run<EPI_SSM_Z, false>(j, 8, toff, smem, VBLOCK());
      });
      PH(ph_gnorm(p));
      PH({
        GJob j = mkjob((const bf16_t*)(p.ws + SB_Y), 2048, wt + WB_OUT, 2048, 2048, 1024);
        j.o0 = X;
        gemm_streamk<EPI_RESID>(j, 4, smem, VBLOCK(), (unsigned*)(p.ws + W_BAR) + 4096, (unsigned)(layer * 2 + 1));
      });
    } else {
      PHR(REP_GEMM, {
        int toff = 0;
        for (int s = 0; s < 3; ++s) {
          GJob j = mkjob(U, 1024, wt + WC_RKV + (size_t)s * 1024 * 1024, 1024, 1024, 1024);
          j.A2 = (const bf16_t*)(p.ws + SC_UP); j.mu = p.in[I_RW_MU] + s * 1024;
          j.o0 = p.ws + SC_R + (size_t)s * SZ_TD2; j.ldo = 1024; j.act = 0;
          gemm_run<EPI_ST, true>(j, 8, toff, smem, VBLOCK());
        }
        for (int s = 0; s < 3; ++s) {
          const int nv = (s == 2) ? 128 : 64;
          GJob j = mkjob(U, 1024, wt + WC_L1 + (size_t)s * 64 * 1024, 1024, 1024, nv);
          j.A2 = (const bf16_t*)(p.ws + SC_UP); j.mu = p.in[I_RW_MU] + (3 + s) * 1024;
          j.o0 = p.ws + SC_LH + (size_t)s * 64 * 2; j.ldo = 256; j.act = (s == 0) ? 1 : (s == 2 ? 2 : 0);
          gemm_run<EPI_ST, true>(j, 1, toff, smem, VBLOCK());
        }
      });
      PHR(REP_GEMM, {
        int toff = 0;
        const bf16_t* LH = (const bf16_t*)(p.ws + SC_LH);
        {
          GJob j = mkjob(LH, 256, wt + WC_W2, 64, 64, 1024);
          j.o0 = p.ws + SC_WD; j.x0 = p.in[I_RW_W0];
          gemm_run<EPI_DECAY, false>(j, 4, toff, smem, VBLOCK());
        }
        {
          GJob j = mkjob(LH + 64, 256, wt + WC_A2, 64, 64, 1024);
          j.o0 = p.ws + SC_AA; j.x0 = p.in[I_RW_A0];
          gemm_run<EPI_SIGB, false>(j, 4, toff, smem, VBLOCK());
        }
        {
          GJob j = mkjob(LH + 128, 256, wt + WC_G2, 128, 128, 1024);
          j.o0 = p.ws + SC_G; j.ldo = 1024; j.act = 0;
          gemm_run<EPI_ST, false>(j, 4, toff, smem, VBLOCK());
        }
      });
      PHR(REP_WKV, ph_wkv<8>(p, smem));
      PHR(REP_MISC, ph_wkv_post(p));
      PH({
        GJob j = mkjob(U, 1024, wt + WC_OUT, 1024, 1024, 1024);
        j.o0 = X;
        gemm_streamk<EPI_RESID>(j, 4, smem, VBLOCK(), (unsigned*)(p.ws + W_BAR) + 4096, (unsigned)(layer * 2 + 1));
      });
    }
    PHR(REP_MISC, ph_rmsnorm(p, 0, p.in[I_NFFN] + layer * 1024));
    PHR(REP_GEMM, {
      GJob j = mkjob(U, 1024, wt + WF_1 + (size_t)layer * 4096 * 1024, 1024, 1024, 4096);
      j.o0 = p.ws + S_HB;
      int toff = 0; gemm_run<EPI_FFN1, false>(j, 16, toff, smem, VBLOCK());
    });
    PH({
      GJob j = mkjob((const bf16_t*)(p.ws + S_HB), 4096, wt + WF_2 + (size_t)layer * 4096 * 1024, 4096, 4096, 1024);
      j.o0 = X;
      gemm_streamk<EPI_RESID>(j, 4, smem, VBLOCK(), (unsigned*)(p.ws + W_BAR) + 4096, (unsigned)(layer * 2 + 2));
    });
  }
  PH_LAST(ph_rmsnorm(p, 2, p.in[I_NFIN]));
#undef PH
#undef PH_LAST
}

extern "C" void kernel_launch(void* const* d_in, const int* in_sizes, int n_in, void* d_out, int out_size,
                              void* d_ws, size_t ws_size, hipStream_t stream) {
  Params p;
  memset(&p, 0, sizeof(p));
  for (int i = 0; i < N_IN; ++i) p.in[i] = (const float*)d_in[i];
  p.out = (float*)d_out;
  p.ws = (char*)d_ws;
  p.ph_begin = 0;
  p.ph_end = 1000;
  static int grid_blocks = 0;
  if (!grid_blocks) {
    int dev = 0, cus = 0, per_cu = 0;
    hipGetDevice(&dev);
    hipDeviceGetAttribute(&cus, hipDeviceAttributeMultiprocessorCount, dev);
    hipOccupancyMaxActiveBlocksPerMultiprocessor(&per_cu, mega, NTHR, 0);
    if (per_cu > 2) per_cu = 2;
    if (per_cu < 1) per_cu = 1;
    grid_blocks = cus * per_cu;
  }
  if (ws_size < (size_t)536870912) fprintf(stderr, "workspace too small: %zu\n", ws_size);
  (void)hipMemsetAsync((char*)d_ws + W_BAR, 0, (4096 + 1024) * 4, stream);
  void* args[] = {&p};
  hipError_t e = hipLaunchCooperativeKernel((void*)mega, dim3(grid_blocks), dim3(NTHR), args, 0, stream);
  if (e != hipSuccess) fprintf(stderr, "cooperative launch failed: %s (grid %d)\n", hipGetErrorString(e), grid_blocks);
}
```

```cpp
#include <hip/hip_runtime.h>
#include <hip/hip_cooperative_groups.h>
#include <stdint.h>
#include <stdio.h>
#include <string.h>
namespace cg = cooperative_groups;

typedef unsigned short bf16_t;
typedef __attribute__((ext_vector_type(8))) short bf16x8;
typedef __attribute__((ext_vector_type(16))) float f32x16;

#define DI __device__ __forceinline__

constexpr int T_ = 17408;
constexpr int TP_ = 16384;
constexpr int NTHR = 256;
constexpr int MT_ = T_ / 128;

enum {
  I_XP = 0, I_XS, I_ST_LC, I_ST_LH, I_ST_SC, I_ST_SS, I_ST_RS, I_ST_RW,
  I_NMIX, I_NFFN, I_NFIN,
  I_LRU_WIN, I_LRU_CW, I_LRU_CB, I_LRU_WR, I_LRU_BR, I_LRU_WI, I_LRU_BI, I_LRU_LAM, I_LRU_WOUT,
  I_SSM_WIN, I_SSM_CW, I_SSM_CB, I_SSM_DTB, I_SSM_ALOG, I_SSM_D, I_SSM_NW, I_SSM_WOUT,
  I_RW_MU, I_RW_WRKV, I_RW_W0, I_RW_WW1, I_RW_WW2, I_RW_A0, I_RW_WA1, I_RW_WA2, I_RW_WG1, I_RW_WG2,
  I_RW_KK, I_RW_KA, I_RW_RK, I_RW_LNW, I_RW_LNB, I_RW_WOUT,
  I_FFN_W1, I_FFN_W2, N_IN
};

constexpr size_t O_Y = 0;
constexpr size_t O_LC_P = O_Y + (size_t)T_ * 1024;
constexpr size_t O_LC_S = O_LC_P + 2 * 8 * 3 * 1024;
constexpr size_t O_LH_P = O_LC_S + 2 * 128 * 3 * 1024;
constexpr size_t O_LH_S = O_LH_P + 2 * 8 * 1024;
constexpr size_t O_SC_P = O_LH_S + 2 * 128 * 1024;
constexpr size_t O_SC_S = O_SC_P + 8 * 3 * 4096;
constexpr size_t O_SS_P = O_SC_S + 128 * 3 * 4096;
constexpr size_t O_SS_S = O_SS_P + (size_t)8 * 32 * 64 * 128;
constexpr size_t O_RS_P = O_SS_S + (size_t)128 * 32 * 64 * 128;
constexpr size_t O_RS_S = O_RS_P + 8 * 1024;
constexpr size_t O_RW_P = O_RS_S + 128 * 1024;
constexpr size_t O_RW_S = O_RW_P + 8 * 16 * 64 * 64;

constexpr size_t W_X = 0;
constexpr size_t W_U = W_X + (size_t)T_ * 1024 * 4;
constexpr size_t W_WT = W_U + (size_t)T_ * 1024 * 2;
constexpr size_t WA_IN = 0;
constexpr size_t WA_G = WA_IN + 2 * 2048 * 1024;
constexpr size_t WA_OUT = WA_G + 2 * 2048 * 128;
constexpr size_t WB_XBC = WA_OUT + 2 * 1024 * 1024;
constexpr size_t WB_Z = WB_XBC + 4128 * 1024;
constexpr size_t WB_OUT = WB_Z + 2048 * 1024;
constexpr size_t WC_RKV = WB_OUT + 1024 * 2048;
constexpr size_t WC_L1 = WC_RKV + 3 * 1024 * 1024;
constexpr size_t WC_W2 = WC_L1 + 256 * 1024;
constexpr size_t WC_A2 = WC_W2 + 1024 * 64;
constexpr size_t WC_G2 = WC_A2 + 1024 * 64;
constexpr size_t WC_OUT = WC_G2 + 1024 * 128;
constexpr size_t WF_1 = WC_OUT + 1024 * 1024;
constexpr size_t WF_2 = WF_1 + (size_t)4 * 4096 * 1024;
constexpr size_t W_WT_ELEMS = WF_2 + (size_t)4 * 4096 * 1024;
constexpr size_t W_S = W_WT + W_WT_ELEMS * 2;
constexpr size_t SZ_TD2 = (size_t)T_ * 1024 * 2;
constexpr size_t SZ_TD4 = (size_t)T_ * 1024 * 4;
constexpr size_t S_HB = W_S;
constexpr size_t SA_XB = W_S;
constexpr size_t SA_GT = SA_XB + SZ_TD2;
constexpr size_t SA_XC = SA_GT + SZ_TD2;
constexpr size_t SA_AA = SA_XC + SZ_TD2;
constexpr size_t SA_BB = SA_AA + SZ_TD4;
constexpr size_t SA_CP = SA_BB + SZ_TD4;
constexpr size_t SA_CS = SA_CP + 8 * 64 * 1024 * 4;
constexpr size_t SB_XBCP = W_S;
constexpr size_t SB_Y = W_S;
constexpr size_t SB_XBC = SB_XBCP + SZ_TD2 * 4;
constexpr size_t SB_DT = SB_XBC + SZ_TD2 * 4;
constexpr size_t SC_UP = W_S;
constexpr size_t SC_O = W_S;
constexpr size_t SC_R = SC_UP + SZ_TD2;
constexpr size_t SC_K = SC_R + SZ_TD2;
constexpr size_t SC_V = SC_K + SZ_TD2;
constexpr size_t SC_LH = SC_V + SZ_TD2;
constexpr size_t SC_WD = SC_LH + (size_t)T_ * 256 * 2;
constexpr size_t SC_AA = SC_WD + SZ_TD4;
constexpr size_t SC_G = SC_AA + SZ_TD2;
constexpr size_t SC_END = SC_G + SZ_TD2;
static_assert(SC_END <= (size_t)536870912, "ws overflow C");
static_assert(SB_DT + (size_t)T_ * 32 * 4 <= (size_t)536870912, "ws overflow B");
static_assert(SA_CS + 8 * 64 * 1024 * 4 <= (size_t)536870912, "ws overflow A");

constexpr int SMEM_BYTES = 80384;
constexpr size_t W_BAR = (size_t)536870912 - 65536;

struct Params {
  const float* in[N_IN];
  float* out;
  char* ws;
  int ph_begin, ph_end;
};

DI float bf2f(bf16_t h) { return __uint_as_float(((unsigned)h) << 16); }
DI bf16_t f2bf(float f) {
  unsigned u = __float_as_uint(f);
  u += 0x7FFFu + ((u >> 16) & 1u);
  return (bf16_t)(u >> 16);
}
DI unsigned pack2(float a, float b) { return (unsigned)f2bf(a) | ((unsigned)f2bf(b) << 16); }
DI void unpack8(const uint4 v, float (&f)[8]) {
  f[0] = __uint_as_float(v.x << 16); f[1] = __uint_as_float(v.x & 0xFFFF0000u);
  f[2] = __uint_as_float(v.y << 16); f[3] = __uint_as_float(v.y & 0xFFFF0000u);
  f[4] = __uint_as_float(v.z << 16); f[5] = __uint_as_float(v.z & 0xFFFF0000u);
  f[6] = __uint_as_float(v.w << 16); f[7] = __uint_as_float(v.w & 0xFFFF0000u);
}
DI void unpack4(const uint2 v, float (&f)[4]) {
  f[0] = __uint_as_float(v.x << 16); f[1] = __uint_as_float(v.x & 0xFFFF0000u);
  f[2] = __uint_as_float(v.y << 16); f[3] = __uint_as_float(v.y & 0xFFFF0000u);
}
DI uint4 pack8(const float (&f)[8]) {
  return make_uint4(pack2(f[0], f[1]), pack2(f[2], f[3]), pack2(f[4], f[5]), pack2(f[6], f[7]));
}
DI void load8f(const float* p, float (&f)[8]) {
  float4 a = *(const float4*)p, b = *(const float4*)(p + 4);
  f[0] = a.x; f[1] = a.y; f[2] = a.z; f[3] = a.w; f[4] = b.x; f[5] = b.y; f[6] = b.z; f[7] = b.w;
}
DI void store8f(float* p, const float (&f)[8]) {
  *(float4*)p = make_float4(f[0], f[1], f[2], f[3]);
  *(float4*)(p + 4) = make_float4(f[4], f[5], f[6], f[7]);
}
DI float sigmoidf_(float x) { return 1.f / (1.f + __expf(-x)); }
DI float siluf_(float x) { return x / (1.f + __expf(-x)); }
DI float tanhf_(float y) { return 1.f - 2.f / (1.f + __expf(2.f * y)); }
DI float geluf_(float x) { return 0.5f * x * (1.f + tanhf_(0.7978845608028654f * (x + 0.044715f * x * x * x))); }
DI float softplusf_(float x) { return fmaxf(x, 0.f) + log1pf(__expf(-fabsf(x))); }
DI float softplus_fast(float x) { return fmaxf(x, 0.f) + __logf(1.f + __expf(-fabsf(x))); }
DI float wave_sum(float v) {
#pragma unroll
  for (int o = 32; o >= 1; o >>= 1) v += __shfl_xor(v, o, 64);
  return v;
}
template <int CTRL> DI float dppf(float x) {
  return __int_as_float(__builtin_amdgcn_update_dpp(0, __float_as_int(x), CTRL, 0xf, 0xf, false));
}
template <int N> DI float red_lanes(float x) {
  x += dppf<0xB1>(x);
  x += dppf<0x4E>(x);
  if (N >= 8) x += dppf<0x141>(x);
  if (N >= 16) x += dppf<0x140>(x);
  return x;
}
DI void tok_info(int t, int& seq, int& l, int& L) {
  if (t < TP_) { seq = t >> 11; l = t & 2047; L = 2048; }
  else { int u = t - TP_; seq = 8 + (u >> 3); l = u & 7; L = 8; }
}
DI int opq(int x) { asm volatile("" : "+v"(x)); return x; }
#define TIDX opq((int)threadIdx.x)
DI f32x16 mfma32(bf16x8 a, bf16x8 b, f32x16 c) { return __builtin_amdgcn_mfma_f32_32x32x16_bf16(a, b, c, 0, 0, 0); }


#define XB_TMO      128
#define XB_XCNT(j)  (256  + 64 * (j))
#define XB_XSUB(j)  (1280 + 64 * (j))
#define XB_XGEN(j)  (2304 + 64 * (j))
#define XB_TOP      3328
#define XB_TOPGEN   3392
#define XCD_BAR_WORDS 3456
#define XB_SPIN_CAP (1u << 22)
#define LAS __attribute__((address_space(3)))
DI unsigned xb_ld(unsigned* p) { return __hip_atomic_load(p, __ATOMIC_RELAXED, __HIP_MEMORY_SCOPE_AGENT); }
DI unsigned xb_add(unsigned* p, unsigned v) { return __hip_atomic_fetch_add(p, v, __ATOMIC_RELAXED, __HIP_MEMORY_SCOPE_AGENT); }
DI unsigned xb_xcc_id() { return (unsigned)__builtin_amdgcn_s_getreg((3 << 11) | 20) & 0xFu; }
#define XB_SPIN(cond, bar) do { unsigned _sp = 0; while (cond) { __builtin_amdgcn_s_sleep(1); \
    if ((++_sp & 255u) == 0u) { if (xb_ld(&(bar)[XB_TMO])) break; if (_sp > XB_SPIN_CAP) { atomicAdd(&(bar)[XB_TMO], 1u); break; } } } } while (0)
struct XcdBarrier { unsigned* bar; unsigned x; volatile LAS unsigned* st; };
DI XcdBarrier xcd_barrier_post(unsigned* bar, volatile LAS unsigned* st) {
  XcdBarrier b; b.bar = bar; b.x = xb_xcc_id(); b.st = st;
  if (threadIdx.x == 0) st[2] = xb_add(&bar[XB_XCNT(b.x)], 1u);
  return b;
}
DI void xcd_barrier_complete(unsigned* bar, unsigned x, unsigned& nloc, unsigned& nx) {
  const unsigned G = gridDim.x * gridDim.y * gridDim.z;
  unsigned sum, cnt, mine, sp = 0u;
  for (;;) {
    sum = 0u; cnt = 0u; mine = 0u;
#pragma unroll
    for (unsigned j = 0; j < 16; ++j) { const unsigned c = xb_ld(&bar[XB_XCNT(j)]); sum += c; cnt += (c > 0u) ? 1u : 0u; mine = (j == x) ? c : mine; }
    if (sum == G) break;
    __builtin_amdgcn_s_sleep(1);
    if ((++sp & 255u) == 0u) { if (xb_ld(&bar[XB_TMO])) break; if (sp > XB_SPIN_CAP) { atomicAdd(&bar[XB_TMO], 1u); break; } }
  }
  nloc = mine > 0u ? mine : 1u; nx = cnt > 0u ? cnt : 1u;
}
DI void xcd_barrier(const XcdBarrier& b) {
  asm volatile("s_waitcnt vmcnt(0)" ::: "memory");
  __syncthreads();
  if (threadIdx.x == 0) {
    unsigned* bar = b.bar;
    __builtin_amdgcn_s_waitcnt(0);
    unsigned nloc = b.st[0], nx = b.st[1];
    if (nloc == 0u) { xcd_barrier_complete(bar, b.x, nloc, nx); b.st[0] = nloc; b.st[1] = nx; }
    const unsigned old = xb_add(&bar[XB_XSUB(b.x)], 1u);
    const unsigned gen = old / nloc;
    if (old + 1u == (gen + 1u) * nloc) {
      __builtin_amdgcn_fence(__ATOMIC_RELEASE, "agent");
      asm volatile("s_waitcnt vmcnt(0)" ::: "memory");
      const unsigned og = xb_add(&bar[XB_TOP], 1u);
      const unsigned tg = og / nx;
      if (og + 1u == (tg + 1u) * nx) xb_add(&bar[XB_TOPGEN], 1u);
      else XB_SPIN(xb_ld(&bar[XB_TOPGEN]) == tg, bar);
      __builtin_amdgcn_fence(__ATOMIC_ACQUIRE, "agent");
      xb_add(&bar[XB_XGEN(b.x)], 1u);
      asm volatile("s_waitcnt vmcnt(0)" ::: "memory");
    } else {
      XB_SPIN(xb_ld(&bar[XB_XGEN(b.x)]) == gen, bar);
      __builtin_amdgcn_fence(__ATOMIC_ACQUIRE, "agent");
      asm volatile("s_waitcnt vmcnt(0)" ::: "memory");
    }
  }
  __syncthreads();
}

struct GJob {
  const bf16_t* A; const bf16_t* A2; const float* mu; const bf16_t* Bt;
  int lda, ldb, K, nvalid;
  void* o0; void* o1; const float* x0; const float* x1; const float* x2;
  int ldo, act;
};
enum { EPI_LRU_IN = 0, EPI_GATES, EPI_RESID, EPI_SSM_XBC, EPI_SSM_Z, EPI_FFN1, EPI_ST, EPI_DECAY, EPI_SIGB };

template <int EPI> DI void epi_elem(const GJob& j, int row, int col, float v) {
  if (EPI == EPI_LRU_IN) {
    if (col < 1024) ((bf16_t*)j.o0)[(size_t)row * 1024 + col] = f2bf(v);
    else ((bf16_t*)j.o1)[(size_t)row * 1024 + col - 1024] = f2bf(geluf_(v));
  } else if (EPI == EPI_RESID) {
    unsafeAtomicAdd((float*)j.o0 + (size_t)row * 1024 + col, v);
  } else if (EPI == EPI_SSM_XBC) {
    if (col < 4096) ((bf16_t*)j.o0)[(size_t)row * 4096 + col] = f2bf(v);
  } else if (EPI == EPI_SSM_Z) {
    bf16_t* y = (bf16_t*)j.o0 + (size_t)row * 2048 + col;
    *y = f2bf(bf2f(*y) * siluf_(v));
  } else if (EPI == EPI_FFN1) {
    float r = fmaxf(v, 0.f);
    ((bf16_t*)j.o0)[(size_t)row * 4096 + col] = f2bf(r * r);
  } else if (EPI == EPI_ST) {
    if (col < j.nvalid) {
      float r = v;
      if (j.act == 1) r = tanhf_(v); else if (j.act == 2) r = sigmoidf_(v);
      ((bf16_t*)j.o0)[(size_t)row * j.ldo + col] = f2bf(r);
    }
  } else if (EPI == EPI_DECAY) {
    float wl = -softplusf_(-(j.x0[col] + v)) - 0.5f;
    ((float*)j.o0)[(size_t)row * 1024 + col] = __expf(-__expf(wl));
  } else if (EPI == EPI_SIGB) {
    ((bf16_t*)j.o0)[(size_t)row * 1024 + col] = f2bf(sigmoidf_(j.x0[col] + v));
  }
}

DI void quad_transpose4(float (&v)[4], int l) {
  const bool o1 = l & 1, o2 = l & 2;
  {
    const float s01 = o1 ? v[0] : v[1], s23 = o1 ? v[2] : v[3];
    const float r01 = dppf<0xB1>(s01), r23 = dppf<0xB1>(s23);
    if (o1) { v[0] = r01; v[2] = r23; } else { v[1] = r01; v[3] = r23; }
  }
  {
    const float s02 = o2 ? v[0] : v[2], s13 = o2 ? v[1] : v[3];
    const float r02 = dppf<0x4E>(s02), r13 = dppf<0x4E>(s13);
    if (o2) { v[0] = r02; v[1] = r13; } else { v[2] = r02; v[3] = r13; }
  }
}
DI uint2 pack4(float a, float b, float c, float d) { return make_uint2(pack2(a, b), pack2(c, d)); }
template <int EPI> DI void epi4(const GJob& j, int row, int col, const float (&v)[4]) {
  if (EPI == EPI_LRU_IN) {
    if (col < 1024) *(uint2*)((bf16_t*)j.o0 + (size_t)row * 1024 + col) = pack4(v[0], v[1], v[2], v[3]);
    else *(uint2*)((bf16_t*)j.o1 + (size_t)row * 1024 + col - 1024) = pack4(geluf_(v[0]), geluf_(v[1]), geluf_(v[2]), geluf_(v[3]));
  } else if (EPI == EPI_RESID) {
    float4* x = (float4*)((float*)j.o0 + (size_t)row * 1024 + col);
    float4 t = *x; t.x += v[0]; t.y += v[1]; t.z += v[2]; t.w += v[3]; *x = t;
  } else if (EPI == EPI_SSM_XBC) {
    if (col < 4096) *(uint2*)((bf16_t*)j.o0 + (size_t)row * 4096 + col) = pack4(v[0], v[1], v[2], v[3]);
  } else if (EPI == EPI_SSM_Z) {
    uint2* y = (uint2*)((bf16_t*)j.o0 + (size_t)row * 2048 + col);
    float f[4]; unpack4(*y, f);
    *y = pack4(f[0] * siluf_(v[0]), f[1] * siluf_(v[1]), f[2] * siluf_(v[2]), f[3] * siluf_(v[3]));
  } else if (EPI == EPI_FFN1) {
    const float r0 = fmaxf(v[0], 0.f), r1 = fmaxf(v[1], 0.f), r2 = fmaxf(v[2], 0.f), r3 = fmaxf(v[3], 0.f);
    *(uint2*)((bf16_t*)j.o0 + (size_t)row * 4096 + col) = pack4(r0 * r0, r1 * r1, r2 * r2, r3 * r3);
  } else if (EPI == EPI_ST) {
    if (col < j.nvalid) {
      float r[4];
#pragma unroll
      for (int e = 0; e < 4; ++e) r[e] = (j.act == 1) ? tanhf_(v[e]) : ((j.act == 2) ? sigmoidf_(v[e]) : v[e]);
      *(uint2*)((bf16_t*)j.o0 + (size_t)row * j.ldo + col) = pack4(r[0], r[1], r[2], r[3]);
    }
  } else if (EPI == EPI_DECAY) {
    const float4 w0 = *(const float4*)(j.x0 + col);
    const float w[4] = {w0.x, w0.y, w0.z, w0.w};
    float r[4];
#pragma unroll
    for (int e = 0; e < 4; ++e) r[e] = __expf(-__expf(-softplus_fast(-(w[e] + v[e])) - 0.5f));
    *(float4*)((float*)j.o0 + (size_t)row * 1024 + col) = make_float4(r[0], r[1], r[2], r[3]);
  } else if (EPI == EPI_SIGB) {
    const float4 a0 = *(const float4*)(j.x0 + col);
    *(uint2*)((bf16_t*)j.o0 + (size_t)row * 1024 + col) =
        pack4(sigmoidf_(a0.x + v[0]), sigmoidf_(a0.y + v[1]), sigmoidf_(a0.z + v[2]), sigmoidf_(a0.w + v[3]));
  }
}

template <int EPI, bool MIX>
DI void gemm_tile(const GJob& j, int m0, int n0, int kt0, int kt1, char* smem) {
  const int tid = TIDX, lane = tid & 63, w = tid >> 6;
  const int wm = w >> 1, wn = w & 1, r32 = lane & 31, hh = lane >> 5;
  const int lrow = tid >> 3, kc = tid & 7;
  f32x16 acc[2][2];
#pragma unroll
  for (int a = 0; a < 2; ++a)
#pragma unroll
    for (int b = 0; b < 2; ++b)
#pragma unroll
      for (int r = 0; r < 16; ++r) acc[a][b][r] = 0.f;
  uint4 qa00, qa01, qa02, qa03, qb00, qb01, qb02, qb03, qc00, qc01, qc02, qc03;
  uint4 qa10, qa11, qa12, qa13, qb10, qb11, qb12, qb13, qc10, qc11, qc12, qc13;
  qc00 = qc01 = qc02 = qc03 = qc10 = qc11 = qc12 = qc13 = make_uint4(0, 0, 0, 0);
  const int nk = kt1 - kt0;
  const bf16_t* Ap = j.A + (size_t)(m0 + lrow) * j.lda + kc * 8 + (size_t)kt0 * 64;
  const bf16_t* A2p = MIX ? (j.A2 + (size_t)(m0 + lrow) * j.lda + kc * 8 + (size_t)kt0 * 64) : nullptr;
  const bf16_t* Bp = j.Bt + (size_t)(n0 + lrow) * j.ldb + kc * 8 + (size_t)kt0 * 64;
  const size_t astep = (size_t)32 * j.lda, bstep = (size_t)32 * j.ldb;
  const bool bv0 = (n0 + lrow) < j.nvalid, bv1 = (n0 + lrow + 32) < j.nvalid;
  const bool bv2 = (n0 + lrow + 64) < j.nvalid, bv3 = (n0 + lrow + 96) < j.nvalid;
  const uint4 z4 = make_uint4(0, 0, 0, 0);

#define LD1(s, i, kt)                                                                 \
  qa##s##i = *(const uint4*)(Ap + i * astep + (kt) * 64);                             \
  if (MIX) qc##s##i = *(const uint4*)(A2p + i * astep + (kt) * 64);                   \
  qb##s##i = z4;                                                                      \
  if (bv##i) qb##s##i = *(const uint4*)(Bp + i * bstep + (kt) * 64);
#define GLOAD(s, kt) { LD1(s, 0, kt) LD1(s, 1, kt) LD1(s, 2, kt) LD1(s, 3, kt) }
#define ST1(s, i, As_, Bs_)                                                           \
  if (MIX) {                                                                          \
    float f1[8], f2[8]; unpack8(qa##s##i, f1); unpack8(qc##s##i, f2);                 \
    _Pragma("unroll") for (int e = 0; e < 8; ++e) f1[e] = f1[e] + (f2[e] - f1[e]) * mu8[e]; \
    qa##s##i = pack8(f1);                                                             \
  }                                                                                   \
  *(uint4*)(As_ + (lrow + 32 * i) * 144 + kc * 16) = qa##s##i;                        \
  *(uint4*)(Bs_ + (lrow + 32 * i) * 144 + kc * 16) = qb##s##i;
#define SSTORE(s, kt, buf)                                                            \
  {                                                                                   \
    char* As_ = smem + (buf) * 36864; char* Bs_ = As_ + 18432;                        \
    float mu8[8];                                                                     \
    if (MIX) load8f(j.mu + (kt0 + (kt)) * 64 + kc * 8, mu8);                          \
    ST1(s, 0, As_, Bs_) ST1(s, 1, As_, Bs_) ST1(s, 2, As_, Bs_) ST1(s, 3, As_, Bs_)   \
  }
#define LOADF(F, ks)                                                                  \
  bf16x8 F##a0 = *(const bf16x8*)(ap + (ks) * 32);                                    \
  bf16x8 F##a1 = *(const bf16x8*)(ap + 32 * 144 + (ks) * 32);                         \
  bf16x8 F##b0 = *(const bf16x8*)(bp + (ks) * 32);                                    \
  bf16x8 F##b1 = *(const bf16x8*)(bp + 32 * 144 + (ks) * 32);
#define MFMA4(F)                                                                      \
  acc[0][0] = mfma32(F##a0, F##b0, acc[0][0]);                                        \
  acc[0][1] = mfma32(F##a0, F##b1, acc[0][1]);                                        \
  acc[1][0] = mfma32(F##a1, F##b0, acc[1][0]);                                        \
  acc[1][1] = mfma32(F##a1, F##b1, acc[1][1]);
#define COMPUTE(buf)                                                                  \
  {                                                                                   \
    const char* As_ = smem + (buf) * 36864; const char* Bs_ = As_ + 18432;            \
    const char* ap = As_ + (wm * 64 + r32) * 144 + hh * 16;                           \
    const char* bp = Bs_ + (wn * 64 + r32) * 144 + hh * 16;                           \
    LOADF(f0, 0) LOADF(f1, 1)                                                         \
    __builtin_amdgcn_sched_barrier(0);                                                \
    MFMA4(f0)                                                                         \
    LOADF(f2, 2)                                                                      \
    __builtin_amdgcn_sched_barrier(0);                                                \
    MFMA4(f1)                                                                         \
    LOADF(f3, 3)                                                                      \
    __builtin_amdgcn_sched_barrier(0);                                                \
    MFMA4(f2)                                                                         \
    __builtin_amdgcn_sched_barrier(0);                                                \
    MFMA4(f3)                                                                         \
    __builtin_amdgcn_sched_barrier(0);                                                \
  }

  qa10 = qa11 = qa12 = qa13 = qb10 = qb11 = qb12 = qb13 = z4;
  if (MIX) {
    GLOAD(0, 0);
    SSTORE(0, 0, 0);
    __syncthreads();
    for (int i = 0; i < nk; ++i) {
      if (i + 1 < nk) GLOAD(0, i + 1);
      if (i & 1) { COMPUTE(1); } else { COMPUTE(0); }
      if (i + 1 < nk) { if (i & 1) { SSTORE(0, i + 1, 0); } else { SSTORE(0, i + 1, 1); } }
      __syncthreads();
    }
  } else if (nk == 1) {
    GLOAD(0, 0);
    SSTORE(0, 0, 0);
    __syncthreads();
    COMPUTE(0);
    __syncthreads();
  } else {
    GLOAD(0, 0);
    GLOAD(1, 1);
    SSTORE(0, 0, 0);
    __syncthreads();
#pragma unroll 1
    for (int i = 0; i + 2 < nk; i += 2) {
      GLOAD(0, i + 2);
      COMPUTE(0);
      SSTORE(1, i + 1, 1);
      __syncthreads();
      GLOAD(1, i + 3);
      COMPUTE(1);
      SSTORE(0, i + 2, 0);
      __syncthreads();
    }
    COMPUTE(0);
    SSTORE(1, nk - 1, 1);
    __syncthreads();
    COMPUTE(1);
    __syncthreads();
  }
#undef LD1
#undef ST1
#undef LOADF
#undef MFMA4
#undef GLOAD
#undef SSTORE
#undef COMPUTE

  if (EPI == EPI_GATES) {
    const int ch = (n0 >> 7) * 64 + wn * 32 + r32;
    const float br = j.x0[ch], bi = j.x1[ch];
    const float spl = softplusf_(-j.x2[ch]);
    const bf16_t* XC = (const bf16_t*)j.o1;
    float* AA = (float*)j.o0;
    float* BBp = AA + (size_t)T_ * 1024;
#pragma unroll
    for (int mi = 0; mi < 2; ++mi)
#pragma unroll
      for (int r = 0; r < 16; ++r) {
        const int row = m0 + wm * 64 + mi * 32 + (r & 3) + 8 * (r >> 2) + 4 * hh;
        const float rg = sigmoidf_(acc[mi][0][r] + br);
        const float ig = sigmoidf_(acc[mi][1][r] + bi);
        const float la = -8.f * rg * spl;
        const float xc = bf2f(XC[(size_t)row * 1024 + ch]);
        const bool reset = (row < TP_) && ((row & 2047) == 0);
        const float a = reset ? 0.f : __expf(la);
        const float mult = reset ? 1.f : sqrtf(fmaxf(-expm1f(2.f * la), 0.f));
        AA[(size_t)row * 1024 + ch] = a;
        BBp[(size_t)row * 1024 + ch] = mult * ig * xc;
      }
  } else {
#pragma unroll
    for (int mi = 0; mi < 2; ++mi)
#pragma unroll
      for (int ni = 0; ni < 2; ++ni)
#pragma unroll
        for (int r = 0; r < 16; ++r) {
          const int row = m0 + wm * 64 + mi * 32 + (r & 3) + 8 * (r >> 2) + 4 * hh;
          const int col = n0 + wn * 64 + ni * 32 + r32;
          epi_elem<EPI>(j, row, col, acc[mi][ni][r]);
          if ((r & 7) == 7) __builtin_amdgcn_sched_barrier(0);
        }
  }
}

constexpr int DSLOT = 24576;
template <int EPI>
DI void gemm_tile_dma(const GJob& j, int m0, int n0, int k0, int k1, char* smem, unsigned* wflag = nullptr, unsigned epoch = 0u) {
  const int tid = TIDX, lane = tid & 63, w = tid >> 6;
  const int wm = w >> 1, wn = w & 1, r32 = lane & 31, hh = lane >> 5;
  f32x16 acc[2][4];
#pragma unroll
  for (int a = 0; a < 2; ++a)
#pragma unroll
    for (int b = 0; b < 4; ++b)
#pragma unroll
      for (int r = 0; r < 16; ++r) acc[a][b][r] = 0.f;
  const int nk = k1 - k0;
  const int dr = lane >> 2;
  const int dc = (lane & 3) ^ ((lane >> 4) & 3);
  const int nlim = j.nvalid - 1;
  const size_t kofs = (size_t)k0 * 32 + dc * 8;
  const bf16_t* gA0 = j.A + (size_t)(m0 + 32 * w + dr) * j.lda + kofs;
  const bf16_t* gA1 = j.A + (size_t)(m0 + 32 * w + 16 + dr) * j.lda + kofs;
  const bf16_t* gB0 = j.Bt + (size_t)min(n0 + 64 * w + dr, nlim) * j.ldb + kofs;
  const bf16_t* gB1 = j.Bt + (size_t)min(n0 + 64 * w + 16 + dr, nlim) * j.ldb + kofs;
  const bf16_t* gB2 = j.Bt + (size_t)min(n0 + 64 * w + 32 + dr, nlim) * j.ldb + kofs;
  const bf16_t* gB3 = j.Bt + (size_t)min(n0 + 64 * w + 48 + dr, nlim) * j.ldb + kofs;
  char* ldsA = smem + (2 * w) * 1024 + lane * 16;
  char* ldsB = smem + 8192 + (4 * w) * 1024 + lane * 16;
  const unsigned lbase = (unsigned)(unsigned long long)(LAS char*)smem;
  const int fsw = (r32 >> 2) & 3;
  const unsigned pa = (unsigned)((wm * 64 + r32) * 64), pb = (unsigned)(8192 + (wn * 128 + r32) * 64);
  const unsigned po0 = (unsigned)(((hh) ^ fsw) * 16), po1 = (unsigned)(((2 + hh) ^ fsw) * 16);

#define DMA1(gp, lp) __builtin_amdgcn_global_load_lds((const unsigned*)(gp), (unsigned*)(lp), 16, 0, 0)
#define ISSUE(kt, slot)                                                                          \
  {                                                                                              \
    const int ko_ = (kt) * 32;                                                                   \
    char* la_ = ldsA + (slot) * DSLOT; char* lb_ = ldsB + (slot) * DSLOT;                        \
    DMA1(gA0 + ko_, la_); DMA1(gA1 + ko_, la_ + 1024);                                           \
    DMA1(gB0 + ko_, lb_); DMA1(gB1 + ko_, lb_ + 1024); DMA1(gB2 + ko_, lb_ + 2048); DMA1(gB3 + ko_, lb_ + 3072); \
  }
#define SB_ __builtin_amdgcn_sched_barrier(0)

  asm volatile("s_waitcnt vmcnt(0)" ::: "memory");
  const int last = nk - 1;
  ISSUE(0, 0);
  { const int t1 = min(1, last); ISSUE(t1, 1); }
  int sl_r = 0, sl_w = 2;
#pragma unroll 1
  for (int i = 0; i < nk; ++i) {
    asm volatile("s_waitcnt vmcnt(6)" ::: "memory");
    __builtin_amdgcn_s_barrier();
    const int ko2 = min(i + 2, last) * 32;
    char* la2 = ldsA + sl_w * DSLOT; char* lb2 = ldsB + sl_w * DSLOT;
    const unsigned sl = lbase + (unsigned)(sl_r * DSLOT);
    sl_r = (sl_r == 2) ? 0 : sl_r + 1;
    sl_w = (sl_w == 2) ? 0 : sl_w + 1;
    bf16x8 a00, a10, a01, a11, b00, b10, b20, b30, b01, b11, b21, b31;
    const unsigned aA0 = sl + pa + po0, aB0 = sl + pb + po0, aA1 = sl + pa + po1, aB1 = sl + pb + po1;
    asm volatile("ds_read_b128 %0, %1" : "=v"(a00) : "v"(aA0));
    asm volatile("ds_read_b128 %0, %1 offset:2048" : "=v"(a10) : "v"(aA0));
    asm volatile("ds_read_b128 %0, %1" : "=v"(b00) : "v"(aB0));
    asm volatile("ds_read_b128 %0, %1 offset:2048" : "=v"(b10) : "v"(aB0));
    asm volatile("ds_read_b128 %0, %1 offset:4096" : "=v"(b20) : "v"(aB0));
    asm volatile("ds_read_b128 %0, %1 offset:6144" : "=v"(b30) : "v"(aB0));
    asm volatile("ds_read_b128 %0, %1" : "=v"(a01) : "v"(aA1));
    asm volatile("ds_read_b128 %0, %1 offset:2048" : "=v"(a11) : "v"(aA1));
    asm volatile("ds_read_b128 %0, %1" : "=v"(b01) : "v"(aB1));
    asm volatile("ds_read_b128 %0, %1 offset:2048" : "=v"(b11) : "v"(aB1));
    asm volatile("ds_read_b128 %0, %1 offset:4096" : "=v"(b21) : "v"(aB1));
    asm volatile("ds_read_b128 %0, %1 offset:6144" : "=v"(b31) : "v"(aB1));
    DMA1(gA0 + ko2, la2);
    asm volatile("s_waitcnt lgkmcnt(0)" : "+v"(a00), "+v"(a10), "+v"(b00), "+v"(b10), "+v"(b20), "+v"(b30),
                 "+v"(a01), "+v"(a11), "+v"(b01), "+v"(b11), "+v"(b21), "+v"(b31) :: "memory");
    acc[0][0] = mfma32(a00, b00, acc[0][0]);
    acc[0][1] = mfma32(a00, b10, acc[0][1]);
    acc[0][2] = mfma32(a00, b20, acc[0][2]);
    SB_; DMA1(gA1 + ko2, la2 + 1024); SB_;
    acc[0][3] = mfma32(a00, b30, acc[0][3]);
    acc[1][0] = mfma32(a10, b00, acc[1][0]);
    acc[1][1] = mfma32(a10, b10, acc[1][1]);
    SB_; DMA1(gB0 + ko2, lb2); SB_;
    acc[1][2] = mfma32(a10, b20, acc[1][2]);
    acc[1][3] = mfma32(a10, b30, acc[1][3]);
    acc[0][0] = mfma32(a01, b01, acc[0][0]);
    SB_; DMA1(gB1 + ko2, lb2 + 1024); SB_;
    acc[0][1] = mfma32(a01, b11, acc[0][1]);
    acc[0][2] = mfma32(a01, b21, acc[0][2]);
    acc[0][3] = mfma32(a01, b31, acc[0][3]);
    SB_; DMA1(gB2 + ko2, lb2 + 2048); SB_;
    acc[1][0] = mfma32(a11, b01, acc[1][0]);
    acc[1][1] = mfma32(a11, b11, acc[1][1]);
    acc[1][2] = mfma32(a11, b21, acc[1][2]);
    SB_; DMA1(gB3 + ko2, lb2 + 3072); SB_;
    acc[1][3] = mfma32(a11, b31, acc[1][3]);
  }
  asm volatile("s_waitcnt vmcnt(0)" ::: "memory");
  __builtin_amdgcn_s_barrier();
#undef ISSUE
#undef DMA1
#undef SB_
  if (wflag) {
    if (threadIdx.x == 0) {
      unsigned sp = 0;
      while (xb_ld(wflag) != epoch) { __builtin_amdgcn_s_sleep(1); if (++sp > (1u << 24)) break; }
      __builtin_amdgcn_fence(__ATOMIC_ACQUIRE, "agent");
      asm volatile("s_waitcnt vmcnt(0)" ::: "memory");
    }
    __syncthreads();
  }

  if (EPI == EPI_GATES) {
    const bf16_t* XC = (const bf16_t*)j.o1;
    float* AA = (float*)j.o0;
    float* BBp = AA + (size_t)T_ * 1024;
#pragma unroll
    for (int g = 0; g < 2; ++g) {
      const int ch = (n0 >> 8) * 128 + wn * 64 + g * 32 + r32;
      const float br = j.x0[ch], bi = j.x1[ch];
      const float spl = softplusf_(-j.x2[ch]);
#pragma unroll
      for (int mi = 0; mi < 2; ++mi)
#pragma unroll
        for (int r = 0; r < 16; ++r) {
          const int row = m0 + wm * 64 + mi * 32 + (r & 3) + 8 * (r >> 2) + 4 * hh;
          const float rg = sigmoidf_(acc[mi][2 * g][r] + br);
          const float ig = sigmoidf_(acc[mi][2 * g + 1][r] + bi);
          const float la = -8.f * rg * spl;
          const float xc = bf2f(XC[(size_t)row * 1024 + ch]);
          const bool reset = (row < TP_) && ((row & 2047) == 0);
          const float a = reset ? 0.f : __expf(la);
          const float mult = reset ? 1.f : sqrtf(fmaxf(-expm1f(2.f * la), 0.f));
          AA[(size_t)row * 1024 + ch] = a;
          BBp[(size_t)row * 1024 + ch] = mult * ig * xc;
        }
    }
  } else {
    const int lq = lane & 3;
#pragma unroll
    for (int mi = 0; mi < 2; ++mi)
#pragma unroll
      for (int ni = 0; ni < 4; ++ni)
#pragma unroll
        for (int g4 = 0; g4 < 4; ++g4) {
          float v[4] = {acc[mi][ni][4 * g4], acc[mi][ni][4 * g4 + 1], acc[mi][ni][4 * g4 + 2], acc[mi][ni][4 * g4 + 3]};
          quad_transpose4(v, lq);
          const int row = m0 + wm * 64 + mi * 32 + 8 * g4 + 4 * hh + lq;
          const int col = n0 + wn * 128 + ni * 32 + (r32 & ~3);
          epi4<EPI>(j, row, col, v);
        }
    if (EPI == EPI_SSM_XBC) {
      if (n0 + wn * 128 == 4096) {
        const float dtb = j.x0[r32];
#pragma unroll
        for (int mi = 0; mi < 2; ++mi)
#pragma unroll
          for (int r = 0; r < 16; ++r) {
            const int row = m0 + wm * 64 + mi * 32 + (r & 3) + 8 * (r >> 2) + 4 * hh;
            ((float*)j.o1)[(size_t)row * 32 + r32] = softplusf_(acc[mi][0][r] + dtb);
          }
      }
    }
  }
}

#define VBLOCK() ((int)(((volatile LAS unsigned*)&xb_words)[3]))
DI void tile_map(int L, int ntn, int& mt, int& nt) {
  const int gw = ((ntn & 7) == 0) ? 8 : (((ntn & 3) == 0) ? 4 : 0);
  if (gw) {
    const int gs = 8 * gw, grp = L / gs, loc = L - grp * gs, gpr = ntn / gw;
    const int gm = grp / gpr, gn = grp - gm * gpr;
    mt = gm * 8 + loc / gw; nt = gn * gw + (loc - (loc / gw) * gw);
  } else { mt = L / ntn; nt = L - mt * ntn; }
}

template <int EPI, bool MIX>
DI void gemm_run(const GJob& j, int ntn, int& toff, char* smem, int vb_) {
  const int G = gridDim.x;
  const int ntiles = MT_ * ntn;
  const int start = (int)((vb_ - (toff % G) + G) % G);
  const int nk = j.K >> 6;
  for (int tile = start; tile < ntiles; tile += G) {
    int mt, nt; tile_map(tile, ntn, mt, nt);
    if (MIX) gemm_tile<EPI, MIX>(j, mt * 128, nt * 128, 0, nk, smem);
    else gemm_tile_dma<EPI>(j, mt * 128, nt * 256, 0, nk * 2, smem);
  }
  toff += ntiles;
}

template <int EPI>
DI void gemm_streamk(const GJob& j, int ntn, char* smem, int vb_, unsigned* flags, unsigned epoch) {
  const int G = gridDim.x;
  const int nk = j.K >> 5;
  const int total = MT_ * ntn * nk;
  int per = (total + G - 1) / G;
  if (per < nk) per = nk;
  int s0 = vb_ * per;
  const int s1 = min(s0 + per, total);
  while (s0 < s1) {
    const int tile = s0 / nk, k0 = s0 - tile * nk;
    const int k1 = min(nk, k0 + (s1 - s0));
    int mt, nt; tile_map(tile, ntn, mt, nt);
    unsigned* wf = (k0 == 0 && k1 < nk) ? (flags + tile) : nullptr;
    gemm_tile_dma<EPI>(j, mt * 128, nt * 256, k0, k1, smem, wf, epoch);
    if (k0 > 0) {
      asm volatile("s_waitcnt vmcnt(0)" ::: "memory");
      __syncthreads();
      if (threadIdx.x == 0) {
        __builtin_amdgcn_fence(__ATOMIC_RELEASE, "agent");
        asm volatile("s_waitcnt vmcnt(0)" ::: "memory");
        __hip_atomic_store(flags + tile, epoch, __ATOMIC_RELAXED, __HIP_MEMORY_SCOPE_AGENT);
      }
    }
    s0 += k1 - k0;
  }
}

template <int EPI, int SPLIT, int NKC>
DI void gemm_splitk(const GJob& j, int ntn, char* smem, int vb_) {
  const int G = gridDim.x;
  const int nitems = MT_ * ntn * SPLIT;
  for (int it = vb_; it < nitems; it += G) {
    const int tile = it / SPLIT, sp = it - tile * SPLIT;
    int mt, nt; tile_map(tile, ntn, mt, nt);
    gemm_tile<EPI, false>(j, mt * 128, nt * 128, sp * NKC, sp * NKC + NKC, smem);
  }
}

DI GJob mkjob(const bf16_t* A, int lda, const bf16_t* Bt, int ldb, int K, int nvalid) {
  GJob j;
  j.A = A; j.A2 = nullptr; j.mu = nullptr; j.Bt = Bt; j.lda = lda; j.ldb = ldb; j.K = K; j.nvalid = nvalid;
  j.o0 = nullptr; j.o1 = nullptr; j.x0 = nullptr; j.x1 = nullptr; j.x2 = nullptr; j.ldo = 0; j.act = 0;
  return j;
}

struct TJob { const float* src; bf16_t* dst; int K, N, src_ld, kind, n_off; };

DI TJob get_tjob(const Params& p, int j) {
  bf16_t* wt = (bf16_t*)(p.ws + W_WT);
  TJob o; o.kind = 0; o.n_off = 0;
  if (j < 36) {
    const int ia = j / 18, r = j % 18;
    if (r == 0) { o.src = p.in[I_LRU_WIN] + (size_t)ia * 1024 * 2048; o.dst = wt + WA_IN + (size_t)ia * 2048 * 1024; o.K = 1024; o.N = 2048; o.src_ld = 2048; }
    else if (r == 1) { o.src = p.in[I_LRU_WOUT] + (size_t)ia * 1024 * 1024; o.dst = wt + WA_OUT + (size_t)ia * 1024 * 1024; o.K = 1024; o.N = 1024; o.src_ld = 1024; }
    else {
      const int isI = (r >= 10) ? 1 : 0; const int h = (r - 2) & 7;
      o.src = p.in[isI ? I_LRU_WI : I_LRU_WR] + ((size_t)ia * 8 + h) * 128 * 128;
      o.dst = wt + WA_G + (size_t)ia * 2048 * 128; o.K = 128; o.N = 128; o.src_ld = 128; o.kind = 1 + isI; o.n_off = h * 128;
    }
  } else if (j == 36) { o.src = p.in[I_SSM_WIN] + 2048; o.dst = wt + WB_XBC; o.K = 1024; o.N = 4128; o.src_ld = 6176; }
  else if (j == 37) { o.src = p.in[I_SSM_WIN]; o.dst = wt + WB_Z; o.K = 1024; o.N = 2048; o.src_ld = 6176; }
  else if (j == 38) { o.src = p.in[I_SSM_WOUT]; o.dst = wt + WB_OUT; o.K = 2048; o.N = 1024; o.src_ld = 1024; }
  else if (j < 42) { const int s = j - 39; o.src = p.in[I_RW_WRKV] + (size_t)s * 1024 * 1024; o.dst = wt + WC_RKV + (size_t)s * 1024 * 1024; o.K = 1024; o.N = 1024; o.src_ld = 1024; }
  else if (j == 42) { o.src = p.in[I_RW_WW1]; o.dst = wt + WC_L1; o.K = 1024; o.N = 64; o.src_ld = 64; }
  else if (j == 43) { o.src = p.in[I_RW_WA1]; o.dst = wt + WC_L1 + 64 * 1024; o.K = 1024; o.N = 64; o.src_ld = 64; }
  else if (j == 44) { o.src = p.in[I_RW_WG1]; o.dst = wt + WC_L1 + 128 * 1024; o.K = 1024; o.N = 128; o.src_ld = 128; }
  else if (j == 45) { o.src = p.in[I_RW_WW2]; o.dst = wt + WC_W2; o.K = 64; o.N = 1024; o.src_ld = 1024; }
  else if (j == 46) { o.src = p.in[I_RW_WA2]; o.dst = wt + WC_A2; o.K = 64; o.N = 1024; o.src_ld = 1024; }
  else if (j == 47) { o.src = p.in[I_RW_WG2]; o.dst = wt + WC_G2; o.K = 128; o.N = 1024; o.src_ld = 1024; }
  else if (j == 48) { o.src = p.in[I_RW_WOUT]; o.dst = wt + WC_OUT; o.K = 1024; o.N = 1024; o.src_ld = 1024; }
  else {
    const int l = (j - 49) >> 1, which = (j - 49) & 1;
    if (!which) { o.src = p.in[I_FFN_W1] + (size_t)l * 1024 * 4096; o.dst = wt + WF_1 + (size_t)l * 4096 * 1024; o.K = 1024; o.N = 4096; o.src_ld = 4096; }
    else { o.src = p.in[I_FFN_W2] + (size_t)l * 4096 * 1024; o.dst = wt + WF_2 + (size_t)l * 4096 * 1024; o.K = 4096; o.N = 1024; o.src_ld = 1024; }
  }
  return o;
}
constexpr int N_TJOBS = 57;

DI void ph_prologue(const Params& p, char* smem) {
  const int tid = TIDX, G = gridDim.x;
  {
    const float4* xp = (const float4*)p.in[I_XP];
    const float4* xs = (const float4*)p.in[I_XS];
    float4* X = (float4*)(p.ws + W_X);
    const size_t np = (size_t)TP_ * 256, nt = (size_t)T_ * 256;
    for (size_t i = (size_t)blockIdx.x * NTHR + tid; i < nt; i += (size_t)G * NTHR)
      X[i] = (i < np) ? xp[i] : xs[i - np];
  }
  float* tile = (float*)smem;
  int toff = 0;
  for (int jn = 0; jn < N_TJOBS; ++jn) {
    const TJob tj = get_tjob(p, jn);
    const int nkt = tj.K >> 6, nnt = (tj.N + 63) >> 6;
    const int ntiles = nkt * nnt;
    const int start = (((int)blockIdx.x - (toff % G)) + G) % G;
    for (int t = start; t < ntiles; t += G) {
      const int kt = t / nnt, nt = t - kt * nnt;
      const int k0 = kt * 64, n0 = nt * 64;
      __syncthreads();
#pragma unroll 4
      for (int i = 0; i < 16; ++i) {
        const int k = i * 4 + (tid >> 6), n = tid & 63;
        float v = 0.f;
        if (n0 + n < tj.N) v = tj.src[(size_t)(k0 + k) * tj.src_ld + n0 + n];
        tile[k * 65 + n] = v;
      }
      __syncthreads();
      const int n = tid >> 2, kq = tid & 3;
      if (n0 + n < tj.N) {
        int nrow = n0 + n;
        if (tj.kind) {
          const int ch = tj.n_off + n0 + n;
          nrow = (ch >> 6) * 128 + ((ch >> 5) & 1) * 64 + (tj.kind - 1) * 32 + (ch & 31);
        }
        float f[8], g[8];
#pragma unroll
        for (int e = 0; e < 8; ++e) { f[e] = tile[(kq * 16 + e) * 65 + n]; g[e] = tile[(kq * 16 + 8 + e) * 65 + n]; }
        uint4* d = (uint4*)(tj.dst + (size_t)nrow * tj.K + k0 + kq * 16);
        d[0] = pack8(f); d[1] = pack8(g);
      }
    }
    toff += ntiles;
  }
}

DI void ph_rmsnorm(const Params& p, int mode, const float* w) {
  const int tid_ = TIDX; const int lane = tid_ & 63;
  const int gw = blockIdx.x * 4 + (tid_ >> 6), nw = gridDim.x * 4;
  const float* X = (const float*)(p.ws + W_X);
  bf16_t* U = (bf16_t*)(p.ws + W_U);
  bf16_t* UP = (bf16_t*)(p.ws + SC_UP);
  float4 wv[4];
#pragma unroll
  for (int i = 0; i < 4; ++i) wv[i] = ((const float4*)w)[lane + 64 * i];
  for (int row = gw; row < T_; row += nw) {
    const float4* xr = (const float4*)(X + (size_t)row * 1024);
    float4 v[4]; float ss = 0.f;
#pragma unroll
    for (int i = 0; i < 4; ++i) { v[i] = xr[lane + 64 * i]; ss += v[i].x * v[i].x + v[i].y * v[i].y + v[i].z * v[i].z + v[i].w * v[i].w; }
    ss = wave_sum(ss);
    const float rstd = rsqrtf(ss * (1.f / 1024.f) + 1e-6f);
    int seq, l, L; tok_info(row, seq, l, L);
#pragma unroll
    for (int i = 0; i < 4; ++i) {
      const int c = 4 * (lane + 64 * i);
      float4 y = make_float4(v[i].x * rstd * wv[i].x, v[i].y * rstd * wv[i].y, v[i].z * rstd * wv[i].z, v[i].w * rstd * wv[i].w);
      if (mode == 2) {
        *(float4*)(p.out + O_Y + (size_t)row * 1024 + c) = y;
      } else {
        uint2 pk = make_uint2(pack2(y.x, y.y), pack2(y.z, y.w));
        *(uint2*)(U + (size_t)row * 1024 + c) = pk;
        if (mode == 1) {
          if (l + 1 < L) *(uint2*)(UP + (size_t)(row + 1) * 1024 + c) = pk;
          if (l == 0) {
            uint2 pz = make_uint2(0, 0);
            if (seq >= 8) { float4 s = *(const float4*)(p.in[I_ST_RS] + (size_t)(seq - 8) * 1024 + c); pz = make_uint2(pack2(s.x, s.y), pack2(s.z, s.w)); }
            *(uint2*)(UP + (size_t)row * 1024 + c) = pz;
          }
          if (l == L - 1) {
            float* o = (seq < 8) ? (p.out + O_RS_P + (size_t)seq * 1024 + c) : (p.out + O_RS_S + (size_t)(seq - 8) * 1024 + c);
            *(float4*)o = y;
          }
        }
      }
    }
  }
}

template <int C, bool SILU>
DI void ph_conv(const bf16_t* __restrict__ src, bf16_t* __restrict__ dst, const float* __restrict__ cw,
                const float* __restrict__ cb, const float* __restrict__ state,
                float* __restrict__ out_p, float* __restrict__ out_s) {
  constexpr int GR = C / 8;
  const size_t total = (size_t)T_ * GR;
#pragma unroll 2
  for (size_t idx = (size_t)blockIdx.x * NTHR + TIDX; idx < total; idx += (size_t)gridDim.x * NTHR) {
    const int t = (int)(idx / GR), c = (int)(idx % GR) * 8;
    int seq, l, L; tok_info(t, seq, l, L);
    float acc[8]; load8f(cb + c, acc);
    float xcur[8];
#pragma unroll
    for (int jj = 0; jj < 4; ++jj) {
      const int ls = l - 3 + jj;
      float xv[8];
      if (ls >= 0) { unpack8(*(const uint4*)(src + (size_t)(t - 3 + jj) * C + c), xv); }
      else if (seq >= 8) { load8f(state + ((size_t)(seq - 8) * 3 + (ls + 3)) * C + c, xv); }
      else {
#pragma unroll
        for (int e = 0; e < 8; ++e) xv[e] = 0.f;
      }
      float w8[8]; load8f(cw + (size_t)jj * C + c, w8);
#pragma unroll
      for (int e = 0; e < 8; ++e) acc[e] += w8[e] * xv[e];
      if (jj == 3) {
#pragma unroll
        for (int e = 0; e < 8; ++e) xcur[e] = xv[e];
      }
    }
    if (SILU) {
#pragma unroll
      for (int e = 0; e < 8; ++e) acc[e] = siluf_(acc[e]);
    }
    *(uint4*)(dst + (size_t)t * C + c) = pack8(acc);
    if (l >= L - 3) {
      const int r = l - (L - 3);
      float* o = (seq < 8) ? (out_p + ((size_t)seq * 3 + r) * C + c) : (out_s + ((size_t)(seq - 8) * 3 + r) * C + c);
      store8f(o, xcur);
    }
  }
}

DI void ph_lru_scan1(const Params& p) {
  const float* AA = (const float*)(p.ws + SA_AA);
  const float* BB = (const float*)(p.ws + SA_BB);
  float* CP = (float*)(p.ws + SA_CP);
  float* CS = (float*)(p.ws + SA_CS);
  const int total = 8 * 64 * 1024;
  for (int idx = blockIdx.x * NTHR + TIDX; idx < total; idx += gridDim.x * NTHR) {
    const int ch = idx & 1023, c = (idx >> 10) & 63, b = idx >> 16;
    const size_t base = ((size_t)b * 2048 + c * 32) * 1024 + ch;
    float P = 1.f, S = 0.f;
    float av[32], bv[32];
#pragma unroll
    for (int s = 0; s < 32; ++s) { av[s] = AA[base + (size_t)s * 1024]; bv[s] = BB[base + (size_t)s * 1024]; }
#pragma unroll
    for (int s = 0; s < 32; ++s) { S = av[s] * S + bv[s]; P *= av[s]; }
    CP[idx] = P; CS[idx] = S;
  }
}
DI void ph_lru_scan2(const Params& p, int ia) {
  const float* AA = (const float*)(p.ws + SA_AA);
  const float* BB = (const float*)(p.ws + SA_BB);
  const float* CP = (const float*)(p.ws + SA_CP);
  const float* CS = (const float*)(p.ws + SA_CS);
  bf16_t* GT = (bf16_t*)(p.ws + SA_GT);
  const int nP = 8 * 64 * 1024, total = nP + 128 * 1024;
  for (int idx = blockIdx.x * NTHR + TIDX; idx < total; idx += gridDim.x * NTHR) {
    if (idx < nP) {
      const int ch = idx & 1023, c = (idx >> 10) & 63, b = idx >> 16;
      const size_t base = ((size_t)b * 2048 + c * 32) * 1024 + ch;
      float av[32], bv[32]; bf16_t gv[32];
#pragma unroll
      for (int s = 0; s < 32; ++s) { const size_t o = base + (size_t)s * 1024; av[s] = AA[o]; bv[s] = BB[o]; gv[s] = GT[o]; }
      float h = 0.f;
#pragma unroll 8
      for (int c2 = 0; c2 < c; ++c2) {
        const int ci = ((b * 64 + c2) << 10) + ch;
        h = CP[ci] * h + CS[ci];
      }
#pragma unroll
      for (int s = 0; s < 32; ++s) {
        const size_t o = base + (size_t)s * 1024;
        h = av[s] * h + bv[s];
        GT[o] = f2bf(h * bf2f(gv[s]));
      }
      if (c == 63) p.out[O_LH_P + ((size_t)ia * 8 + b) * 1024 + ch] = h;
    } else {
      const int u = idx - nP; const int ch = u & 1023, s = u >> 10;
      float h = p.in[I_ST_LH][((size_t)ia * 128 + s) * 1024 + ch];
      const size_t base = ((size_t)TP_ + s * 8) * 1024 + ch;
#pragma unroll
      for (int q = 0; q < 8; ++q) {
        const size_t o = base + (size_t)q * 1024;
        h = AA[o] * h + BB[o];
        GT[o] = f2bf(h * bf2f(GT[o]));
      }
      p.out[O_LH_S + ((size_t)ia * 128 + s) * 1024 + ch] = h;
    }
  }
}

DI void ssd_item(const Params& p, char* smem, int seq, int h) {
  const int tid = TIDX, lane = tid & 63, w = tid >> 6, r32 = lane & 31, hh = lane >> 5;
  bf16_t* Cs = (bf16_t*)smem;
  bf16_t* Bs = Cs + 64 * 136;
  bf16_t* Sb = Bs + 64 * 136;
  bf16_t* Xt = Sb + 64 * 136;
  bf16_t* Btr = Xt + 64 * 72;
  float* dts = (float*)(Btr + 128 * 72);
  float* acs = dts + 64;
  bf16_t* Ws = Bs;
  const bf16_t* XBC = (const bf16_t*)(p.ws + SB_XBC);
  const float* DT = (const float*)(p.ws + SB_DT);
  bf16_t* Y = (bf16_t*)(p.ws + SB_Y);
  const bool prompt = seq < 8;
  const int nchunk = prompt ? 32 : 1, Lv = prompt ? 64 : 8;
  const int tbase = prompt ? seq * 2048 : TP_ + (seq - 8) * 8;
  const int g = h >> 2;
  const float Ah = -__expf(p.in[I_SSM_ALOG][h]);
  const float Dh = p.in[I_SSM_D][h];
  f32x16 accS[2];
  {
    const float* s0 = p.in[I_ST_SS] + ((size_t)(seq - 8) * 32 + h) * 64 * 128;
#pragma unroll
    for (int mi = 0; mi < 2; ++mi)
#pragma unroll
      for (int r = 0; r < 16; ++r) {
        const int prow = mi * 32 + (r & 3) + 8 * (r >> 2) + 4 * hh, n = 32 * w + r32;
        accS[mi][r] = prompt ? 0.f : s0[(size_t)prow * 128 + n];
      }
  }
  __syncthreads();
#pragma unroll
  for (int mi = 0; mi < 2; ++mi)
#pragma unroll
    for (int r = 0; r < 16; ++r) {
      const int prow = mi * 32 + (r & 3) + 8 * (r >> 2) + 4 * hh, n = 32 * w + r32;
      Sb[prow * 136 + n] = f2bf(accS[mi][r]);
    }
  uint4 pc0, pc1, pc2, pc3, pb0, pb1, pb2, pb3, px0, px1;
  float pdt = 0.f;
  const uint4 z4 = make_uint4(0, 0, 0, 0);
  pc0 = pc1 = pc2 = pc3 = pb0 = pb1 = pb2 = pb3 = px0 = px1 = z4;
#define SSD_LD_CB(i, t0_)                                                                  \
  { const int id_ = tid + 256 * i, row_ = id_ >> 4, ch_ = id_ & 15;                        \
    pc##i = z4; pb##i = z4;                                                                \
    if (row_ < Lv) { const bf16_t* src_ = XBC + (size_t)((t0_) + row_) * 4096 + g * 128 + ch_ * 8; \
      pb##i = *(const uint4*)(src_ + 2048); pc##i = *(const uint4*)(src_ + 3072); } }
#define SSD_LD_X(i, t0_)                                                                   \
  { const int id_ = tid + 256 * i, row_ = id_ >> 3, ch_ = id_ & 7;                         \
    px##i = z4;                                                                            \
    if (row_ < Lv) px##i = *(const uint4*)(XBC + (size_t)((t0_) + row_) * 4096 + h * 64 + ch_ * 8); }
#define SSD_ISSUE(t0_)                                                                     \
  { SSD_LD_CB(0, t0_) SSD_LD_CB(1, t0_) SSD_LD_CB(2, t0_) SSD_LD_CB(3, t0_) SSD_LD_X(0, t0_) SSD_LD_X(1, t0_) \
    pdt = (tid < Lv && tid < 64) ? DT[(size_t)((t0_) + tid) * 32 + h] : 0.f; }
#define SSD_ST_CB(i)                                                                       \
  { const int id_ = tid + 256 * i, row_ = id_ >> 4, ch_ = id_ & 15;                        \
    *(uint4*)(Cs + row_ * 136 + ch_ * 8) = pc##i;                                          \
    *(uint4*)(Bs + row_ * 136 + ch_ * 8) = pb##i;                                          \
    float f_[8]; unpack8(pb##i, f_);                                                       \
    const float sc_ = __expf(aend - acs[row_]);                                            \
    _Pragma("unroll") for (int e = 0; e < 8; ++e) Btr[(ch_ * 8 + e) * 72 + row_] = f2bf(f_[e] * sc_); }
#define SSD_ST_X(i)                                                                        \
  { const int id_ = tid + 256 * i, row_ = id_ >> 3, ch_ = id_ & 7;                         \
    float f_[8]; unpack8(px##i, f_);                                                       \
    const float sc_ = dts[row_];                                                           \
    _Pragma("unroll") for (int e = 0; e < 8; ++e) Xt[(ch_ * 8 + e) * 72 + row_] = f2bf(f_[e] * sc_); }
  SSD_ISSUE(tbase);
  for (int c = 0; c < nchunk; ++c) {
    const int t0 = tbase + c * 64;
    __syncthreads();
    if (tid < 64) {
      const float dtv = pdt;
      float x = dtv * Ah;
#pragma unroll
      for (int o = 1; o < 64; o <<= 1) { const float y = __shfl_up(x, o, 64); if (lane >= o) x += y; }
      dts[tid] = dtv; acs[tid] = x;
    }
    __syncthreads();
    const float aend = acs[63];
    SSD_ST_CB(0) SSD_ST_CB(1) SSD_ST_CB(2) SSD_ST_CB(3) SSD_ST_X(0) SSD_ST_X(1)
    if (c + 1 < nchunk) { SSD_ISSUE(t0 + 64); }
    __syncthreads();
    const int it = w >> 1, jt = w & 1;
    f32x16 cb;
#pragma unroll
    for (int r = 0; r < 16; ++r) cb[r] = 0.f;
    if (jt <= it) {
#pragma unroll
      for (int ks = 0; ks < 8; ++ks) {
        bf16x8 a = *(const bf16x8*)(Cs + (it * 32 + r32) * 136 + ks * 16 + hh * 8);
        bf16x8 b = *(const bf16x8*)(Bs + (jt * 32 + r32) * 136 + ks * 16 + hh * 8);
        cb = mfma32(a, b, cb);
      }
    }
    __syncthreads();
    {
      const int jj = jt * 32 + r32; const float aj = acs[jj];
#pragma unroll
      for (int r = 0; r < 16; ++r) {
        const int ii = it * 32 + (r & 3) + 8 * (r >> 2) + 4 * hh;
        const float v = (jj <= ii) ? cb[r] * __expf(acs[ii] - aj) : 0.f;
        Ws[ii * 72 + jj] = f2bf(v);
      }
    }
    __syncthreads();
    {
      const int pt = w & 1;
      f32x16 yd, yo;
#pragma unroll
      for (int r = 0; r < 16; ++r) { yd[r] = 0.f; yo[r] = 0.f; }
#pragma unroll
      for (int ks = 0; ks < 4; ++ks) {
        bf16x8 a = *(const bf16x8*)(Ws + (it * 32 + r32) * 72 + ks * 16 + hh * 8);
        bf16x8 b = *(const bf16x8*)(Xt + (pt * 32 + r32) * 72 + ks * 16 + hh * 8);
        yd = mfma32(a, b, yd);
      }
#pragma unroll
      for (int ks = 0; ks < 8; ++ks) {
        bf16x8 a = *(const bf16x8*)(Cs + (it * 32 + r32) * 136 + ks * 16 + hh * 8);
        bf16x8 b = *(const bf16x8*)(Sb + (pt * 32 + r32) * 136 + ks * 16 + hh * 8);
        yo = mfma32(a, b, yo);
      }
      const int pp = pt * 32 + r32;
#pragma unroll
      for (int r = 0; r < 16; ++r) {
        const int ii = it * 32 + (r & 3) + 8 * (r >> 2) + 4 * hh;
        if (ii < Lv) {
          const size_t t = (size_t)(t0 + ii);
          const float xv = bf2f(XBC[t * 4096 + h * 64 + pp]);
          const float yv = yd[r] + __expf(acs[ii]) * yo[r] + Dh * xv;
          Y[t * 2048 + h * 64 + pp] = f2bf(yv);
        }
      }
    }
    {
      const float dec = __expf(aend);
#pragma unroll
      for (int mi = 0; mi < 2; ++mi)
#pragma unroll
        for (int r = 0; r < 16; ++r) accS[mi][r] *= dec;
#pragma unroll
      for (int ks = 0; ks < 4; ++ks) {
        bf16x8 b = *(const bf16x8*)(Btr + (32 * w + r32) * 72 + ks * 16 + hh * 8);
        bf16x8 a0 = *(const bf16x8*)(Xt + (r32) * 72 + ks * 16 + hh * 8);
        bf16x8 a1 = *(const bf16x8*)(Xt + (32 + r32) * 72 + ks * 16 + hh * 8);
        accS[0] = mfma32(a0, b, accS[0]);
        accS[1] = mfma32(a1, b, accS[1]);
      }
    }
    __syncthreads();
#pragma unroll
    for (int mi = 0; mi < 2; ++mi)
#pragma unroll
      for (int r = 0; r < 16; ++r) {
        const int prow = mi * 32 + (r & 3) + 8 * (r >> 2) + 4 * hh, n = 32 * w + r32;
        Sb[prow * 136 + n] = f2bf(accS[mi][r]);
      }
  }
  float* dst = prompt ? (p.out + O_SS_P + ((size_t)seq * 32 + h) * 64 * 128)
                      : (p.out + O_SS_S + ((size_t)(seq - 8) * 32 + h) * 64 * 128);
#pragma unroll
  for (int mi = 0; mi < 2; ++mi)
#pragma unroll
    for (int r = 0; r < 16; ++r) {
      const int prow = mi * 32 + (r & 3) + 8 * (r >> 2) + 4 * hh, n = 32 * w + r32;
      dst[(size_t)prow * 128 + n] = accS[mi][r];
    }
}

#undef SSD_LD_CB
#undef SSD_LD_X
#undef SSD_ISSUE
#undef SSD_ST_CB
#undef SSD_ST_X
DI void ph_ssd(const Params& p, char* smem) {
  const int G = gridDim.x, bid = blockIdx.x;
  int it = bid, step = G;
  if (G >= 512) { if (bid < 256) { step = 1 << 30; } else { step = G - 256; } }
#pragma nounroll
  for (; it < 256 + 4096; it += step) {
    const int seq = (it < 256) ? (it >> 5) : (8 + ((it - 256) >> 5));
    ssd_item(p, smem, seq, it & 31);
  }
}

DI void ph_gnorm(const Params& p) {
  const int tid_ = TIDX; const int lane = tid_ & 63;
  const int gw = blockIdx.x * 4 + (tid_ >> 6), nw = gridDim.x * 4;
  bf16_t* Y = (bf16_t*)(p.ws + SB_Y);
  const float* nwt = p.in[I_SSM_NW];
  for (int item = gw; item < T_ * 8; item += 2 * nw) {
    const int item2 = item + nw; const bool v2 = item2 < T_ * 8;
    bf16_t* yp1 = Y + (size_t)(item >> 3) * 2048 + (item & 7) * 256 + lane * 4;
    bf16_t* yp2 = Y + (size_t)((v2 ? item2 : item) >> 3) * 2048 + ((v2 ? item2 : item) & 7) * 256 + lane * 4;
    const uint2 a = *(const uint2*)yp1; const uint2 b = *(const uint2*)yp2;
    float f[4], g[4]; unpack4(a, f); unpack4(b, g);
    const float ss1 = wave_sum(f[0] * f[0] + f[1] * f[1] + f[2] * f[2] + f[3] * f[3]);
    const float ss2 = wave_sum(g[0] * g[0] + g[1] * g[1] + g[2] * g[2] + g[3] * g[3]);
    const float r1 = rsqrtf(ss1 * (1.f / 256.f) + 1e-5f), r2 = rsqrtf(ss2 * (1.f / 256.f) + 1e-5f);
    const float4 w1 = *(const float4*)(nwt + (item & 7) * 256 + lane * 4);
    const float4 w2 = *(const float4*)(nwt + ((v2 ? item2 : item) & 7) * 256 + lane * 4);
    *(uint2*)yp1 = make_uint2(pack2(f[0] * r1 * w1.x, f[1] * r1 * w1.y), pack2(f[2] * r1 * w1.z, f[3] * r1 * w1.w));
    if (v2) *(uint2*)yp2 = make_uint2(pack2(g[0] * r2 * w2.x, g[1] * r2 * w2.y), pack2(g[2] * r2 * w2.z, g[3] * r2 * w2.w));
  }
}

template <int LPR>
DI void wkv_item(const Params& p, char* smem, int seq, int head, int part) {
  constexpr int ROWS = 256 / LPR, KPL = 64 / LPR, NV4 = KPL / 4;
  const int tid = TIDX;
  float* sR = (float*)smem;
  float* sK = sR + 2048;
  float* sKK = sK + 2048;
  float* sBB = sKK + 2048;
  float* sW = sBB + 2048;
  float* sV = sW + 2048;
  float* sO = sV + 2048;
  const bf16_t* __restrict__ R = (const bf16_t*)(p.ws + SC_R);
  const bf16_t* __restrict__ K = (const bf16_t*)(p.ws + SC_K);
  const bf16_t* __restrict__ V = (const bf16_t*)(p.ws + SC_V);
  const bf16_t* __restrict__ AAc = (const bf16_t*)(p.ws + SC_AA);
  const float* __restrict__ WD = (const float*)(p.ws + SC_WD);
  bf16_t* O = (bf16_t*)(p.ws + SC_O);
  const bool prompt = seq < 8;
  const int nch = prompt ? 64 : 1, nvalid = prompt ? 32 : 8;
  const int tbase = prompt ? seq * 2048 : TP_ + (seq - 8) * 8;
  const int row_l = tid / LPR, q = tid % LPR, row = part * ROWS + row_l;
  float S[KPL];
  {
    const float* s0 = p.in[I_ST_RW] + (((size_t)(seq - 8) * 16 + head) * 64 + row) * 64 + q * KPL;
#pragma unroll
    for (int e = 0; e < KPL; ++e) S[e] = prompt ? 0.f : s0[e];
  }
  const int pst = tid >> 3, pk0 = (tid & 7) * 8, pcol = head * 64 + pk0;
  const bool pact = pst < nvalid;
  float kk8[8], ka8[8];
  load8f(p.in[I_RW_KK] + pcol, kk8);
  load8f(p.in[I_RW_KA] + pcol, ka8);
  uint4 qr = make_uint4(0, 0, 0, 0), qk = qr, qv = qr, qa = qr;
  float4 qw0 = make_float4(0.f, 0.f, 0.f, 0.f), qw1 = qw0;
#define WKV_ISSUE(c_)                                                       \
  if (pact) {                                                               \
    const size_t o_ = (size_t)(tbase + (c_) * 32 + pst) * 1024 + pcol;      \
    qr = *(const uint4*)(R + o_); qk = *(const uint4*)(K + o_);             \
    qv = *(const uint4*)(V + o_); qa = *(const uint4*)(AAc + o_);           \
    qw0 = *(const float4*)(WD + o_); qw1 = *(const float4*)(WD + o_ + 4);   \
  }
  WKV_ISSUE(0);
  for (int c = 0; c < nch; ++c) {
    const int t0 = tbase + c * 32;
    __syncthreads();
    if (pact) {
      float r8[8], k8[8], v8[8], a8[8];
      unpack8(qr, r8); unpack8(qk, k8); unpack8(qv, v8); unpack8(qa, a8);
      const float w8[8] = {qw0.x, qw0.y, qw0.z, qw0.w, qw1.x, qw1.y, qw1.z, qw1.w};
      float kr[8], ss = 0.f;
#pragma unroll
      for (int e = 0; e < 8; ++e) { kr[e] = k8[e] * kk8[e]; ss += kr[e] * kr[e]; }
      ss = red_lanes<8>(ss);
      const float inv = 1.f / fmaxf(sqrtf(ss), 1e-12f);
      float kp[8], bb[8];
#pragma unroll
      for (int e = 0; e < 8; ++e) { kr[e] *= inv; kp[e] = k8[e] * (1.f + (a8[e] - 1.f) * ka8[e]); bb[e] = kr[e] * a8[e]; }
      const int lo = pst * 64 + pk0;
      store8f(sR + lo, r8); store8f(sK + lo, kp); store8f(sKK + lo, kr); store8f(sBB + lo, bb);
      store8f(sW + lo, w8); store8f(sV + lo, v8);
    }
    __syncthreads();
    if (c + 1 < nch) { WKV_ISSUE(c + 1); }
#define WKV_LOADV(P, st_)                                                                      \
    {                                                                                          \
      const int lo_ = (st_) * 64 + q * KPL;                                                    \
      _Pragma("unroll") for (int e = 0; e < NV4; ++e) {                                        \
        P##kk[e] = *(const float4*)(sKK + lo_ + 4 * e); P##ww[e] = *(const float4*)(sW + lo_ + 4 * e); \
        P##bb[e] = *(const float4*)(sBB + lo_ + 4 * e); P##kp[e] = *(const float4*)(sK + lo_ + 4 * e); \
        P##rr[e] = *(const float4*)(sR + lo_ + 4 * e);                                         \
      }                                                                                        \
      P##vv = sV[(st_) * 64 + row];                                                            \
    }
#define WKV_STEP(P, st_)                                                                       \
    {                                                                                          \
      float sa0 = 0.f, sa1 = 0.f;                                                              \
      _Pragma("unroll") for (int e = 0; e < NV4; ++e) {                                        \
        sa0 += S[4 * e] * P##kk[e].x + S[4 * e + 2] * P##kk[e].z;                              \
        sa1 += S[4 * e + 1] * P##kk[e].y + S[4 * e + 3] * P##kk[e].w;                          \
      }                                                                                        \
      const float sa = red_lanes<LPR>(sa0 + sa1);                                              \
      float o0 = 0.f, o1 = 0.f;                                                                \
      _Pragma("unroll") for (int e = 0; e < NV4; ++e) {                                        \
        S[4 * e] = S[4 * e] * P##ww[e].x - sa * P##bb[e].x + P##vv * P##kp[e].x;               \
        S[4 * e + 1] = S[4 * e + 1] * P##ww[e].y - sa * P##bb[e].y + P##vv * P##kp[e].y;       \
        S[4 * e + 2] = S[4 * e + 2] * P##ww[e].z - sa * P##bb[e].z + P##vv * P##kp[e].z;       \
        S[4 * e + 3] = S[4 * e + 3] * P##ww[e].w - sa * P##bb[e].w + P##vv * P##kp[e].w;       \
        o0 += S[4 * e] * P##rr[e].x + S[4 * e + 2] * P##rr[e].z;                               \
        o1 += S[4 * e + 1] * P##rr[e].y + S[4 * e + 3] * P##rr[e].w;                           \
      }                                                                                        \
      const float oo = red_lanes<LPR>(o0 + o1);                                                \
      if (q == 0) sO[(st_) * ROWS + row_l] = oo;                                               \
    }
    {
      float4 Akk[NV4], Aww[NV4], Abb[NV4], Akp[NV4], Arr[NV4]; float Avv;
      float4 Bkk[NV4], Bww[NV4], Bbb[NV4], Bkp[NV4], Brr[NV4]; float Bvv;
      if (LPR <= 4) {
#pragma unroll 1
        for (int st = 0; st < nvalid; ++st) { WKV_LOADV(A, st); WKV_STEP(A, st); }
      } else {
        WKV_LOADV(A, 0);
#pragma unroll 1
        for (int st = 0; st < nvalid; st += 2) {
          WKV_LOADV(B, st + 1);
          WKV_STEP(A, st);
          if (st + 2 < nvalid) { WKV_LOADV(A, st + 2); }
          WKV_STEP(B, st + 1);
        }
      }
    }
    __syncthreads();
    for (int i = tid; i < nvalid * ROWS; i += NTHR) {
      const int st = i / ROWS, rr = i % ROWS;
      O[(size_t)(t0 + st) * 1024 + head * 64 + part * ROWS + rr] = f2bf(sO[i]);
    }
  }
#undef WKV_ISSUE
#undef WKV_LOADV
#undef WKV_STEP
  float* dst = prompt ? (p.out + O_RW_P + (((size_t)seq * 16 + head) * 64 + row) * 64 + q * KPL)
                      : (p.out + O_RW_S + (((size_t)(seq - 8) * 16 + head) * 64 + row) * 64 + q * KPL);
#pragma unroll
  for (int e = 0; e < KPL; ++e) dst[e] = S[e];
}

template <int LPRP>
DI void ph_wkv(const Params& p, char* smem) {
  constexpr int NPART = 64 / (256 / LPRP);
  const int G = gridDim.x, bid = blockIdx.x;
  const int nP = 128 * NPART;
#pragma nounroll
  for (int it = bid; it < nP; it += G) {
    const int part = it % NPART, sh = it / NPART;
    wkv_item<LPRP>(p, smem, sh >> 4, sh & 15, part);
  }
  const int nS = 2048;
  const int first = (bid + G - (nP % G)) % G;
#pragma nounroll
  for (int it = first; it < nS; it += G) wkv_item<4>(p, smem, 8 + (it >> 4), it & 15, 0);
}

DI void ph_wkv_post(const Params& p) {
  const int tid_ = TIDX; const int lane = tid_ & 63;
  const int gw = blockIdx.x * 4 + (tid_ >> 6), nw = gridDim.x * 4;
  const bf16_t* __restrict__ R = (const bf16_t*)(p.ws + SC_R);
  const bf16_t* __restrict__ K = (const bf16_t*)(p.ws + SC_K);
  const bf16_t* __restrict__ V = (const bf16_t*)(p.ws + SC_V);
  const bf16_t* __restrict__ AAc = (const bf16_t*)(p.ws + SC_AA);
  const bf16_t* __restrict__ Gg = (const bf16_t*)(p.ws + SC_G);
  const bf16_t* __restrict__ O = (const bf16_t*)(p.ws + SC_O);
  bf16_t* __restrict__ U = (bf16_t*)(p.ws + W_U);
#pragma unroll 2
  for (int item = gw; item < T_ * 4; item += nw) {
    const int t = item >> 2, col = (item & 3) * 256 + lane * 4;
    const size_t o = (size_t)t * 1024 + col;
    float ov[4], rv[4], kv[4], av[4], vv[4], gv[4];
    unpack4(*(const uint2*)(O + o), ov); unpack4(*(const uint2*)(R + o), rv); unpack4(*(const uint2*)(K + o), kv);
    unpack4(*(const uint2*)(AAc + o), av); unpack4(*(const uint2*)(V + o), vv); unpack4(*(const uint2*)(Gg + o), gv);
    const float4 lw = *(const float4*)(p.in[I_RW_LNW] + col), lb = *(const float4*)(p.in[I_RW_LNB] + col);
    const float4 ka = *(const float4*)(p.in[I_RW_KA] + col), rk = *(const float4*)(p.in[I_RW_RK] + col);
    const float lwv[4] = {lw.x, lw.y, lw.z, lw.w}, lbv[4] = {lb.x, lb.y, lb.z, lb.w};
    const float kav[4] = {ka.x, ka.y, ka.z, ka.w}, rkv[4] = {rk.x, rk.y, rk.z, rk.w};
    const float mean = red_lanes<16>(ov[0] + ov[1] + ov[2] + ov[3]) * (1.f / 64.f);
    float d[4], s2 = 0.f, s3 = 0.f;
#pragma unroll
    for (int e = 0; e < 4; ++e) {
      d[e] = ov[e] - mean; s2 += d[e] * d[e];
      const float kp = kv[e] * (1.f + (av[e] - 1.f) * kav[e]);
      s3 += rv[e] * kp * rkv[e];
    }
    s2 = red_lanes<16>(s2); s3 = red_lanes<16>(s3);
    const float rs = rsqrtf(s2 * (1.f / 64.f) + 64e-5f);
    float y[4];
#pragma unroll
    for (int e = 0; e < 4; ++e) y[e] = (d[e] * rs * lwv[e] + lbv[e] + s3 * vv[e]) * gv[e];
    *(uint2*)(U + o) = make_uint2(pack2(y[0], y[1]), pack2(y[2], y[3]));
  }
}

constexpr int NPH = 40;
#ifndef REP_GEMM
#define REP_GEMM 1
#endif
#ifndef REP_SSD
#define REP_SSD 1
#endif
#ifndef REP_WKV
#define REP_WKV 1
#endif
#ifndef REP_MISC
#define REP_MISC 1
#endif

__global__ void __launch_bounds__(NTHR, 2) mega(Params p) {
  __shared__ __attribute__((aligned(16))) char smem[SMEM_BYTES];
  __shared__ uint4 xb_words;
  cg::grid_group grid = cg::this_grid();
  if (threadIdx.x == 0) xb_words = make_uint4(0u, 0u, 0u, 0u);
  __syncthreads();
  XcdBarrier xb = xcd_barrier_post((unsigned*)(p.ws + W_BAR), (volatile LAS unsigned*)&xb_words);
  int ph = 0;
#define PH(...)                                                     \
  {                                                                 \
    if (ph >= p.ph_begin && ph < p.ph_end) {                        \
      __VA_ARGS__;                                                  \
      xcd_barrier(xb);                                              \
    }                                                               \
    ++ph;                                                           \
  }
#define PHR(rep, ...)                                               \
  {                                                                 \
    if (ph >= p.ph_begin && ph < p.ph_end) {                        \
      for (int rep_ = 0; rep_ < (rep); ++rep_) {                    \
        __VA_ARGS__;                                                \
        xcd_barrier(xb);                                            \
      }                                                             \
    }                                                               \
    ++ph;                                                           \
  }
#define PH_LAST(...)                                                \
  {                                                                 \
    if (ph >= p.ph_begin && ph < p.ph_end) { __VA_ARGS__; }         \
    ++ph;                                                           \
  }
  bf16_t* wt = (bf16_t*)(p.ws + W_WT);
  bf16_t* U = (bf16_t*)(p.ws + W_U);
  float* X = (float*)(p.ws + W_X);

  {
    if (ph >= p.ph_begin && ph < p.ph_end) { ph_prologue(p, smem); grid.sync(); }
    ++ph;
    if (threadIdx.x == 0) {
      unsigned* bar = (unsigned*)(p.ws + W_BAR);
      unsigned base = 0;
      for (unsigned jx = 0; jx < 16; ++jx) { const unsigned c = xb_ld(&bar[XB_XCNT(jx)]); base += (jx < xb.x) ? c : 0u; }
      volatile LAS unsigned* st = (volatile LAS unsigned*)&xb_words;
      st[3] = base + st[2];
    }
    __syncthreads();
  }

#pragma nounroll
  for (int layer = 0; layer < 4; ++layer) {
    const int kind = layer % 3;
    PHR(REP_MISC, ph_rmsnorm(p, kind == 2 ? 1 : 0, p.in[I_NMIX] + layer * 1024));
    if (kind == 0) {
      const int ia = layer / 3;
      PHR(REP_GEMM, {
        GJob j = mkjob(U, 1024, wt + WA_IN + (size_t)ia * 2048 * 1024, 1024, 1024, 2048);
        j.o0 = p.ws + SA_XB; j.o1 = p.ws + SA_GT;
        int toff = 0; gemm_run<EPI_LRU_IN, false>(j, 8, toff, smem, VBLOCK());
      });
      PHR(REP_MISC, (ph_conv<1024, false>((const bf16_t*)(p.ws + SA_XB), (bf16_t*)(p.ws + SA_XC),
                               p.in[I_LRU_CW] + (size_t)ia * 4 * 1024, p.in[I_LRU_CB] + (size_t)ia * 1024,
                               p.in[I_ST_LC] + (size_t)ia * 128 * 3 * 1024,
                               p.out + O_LC_P + (size_t)ia * 8 * 3 * 1024, p.out + O_LC_S + (size_t)ia * 128 * 3 * 1024)));
      PHR(REP_GEMM, {
        const int G = gridDim.x;
        for (int tile = VBLOCK(); tile < MT_ * 8; tile += G) {
          const int mt = tile >> 3, jt = tile & 7;
          GJob j = mkjob((const bf16_t*)(p.ws + SA_XC) + jt * 128, 1024,
                         wt + WA_G + (size_t)ia * 2048 * 128, 128, 128, 2048);
          j.o0 = p.ws + SA_AA; j.o1 = p.ws + SA_XC;
          j.x0 = p.in[I_LRU_BR] + ia * 1024; j.x1 = p.in[I_LRU_BI] + ia * 1024; j.x2 = p.in[I_LRU_LAM] + ia * 1024;
          gemm_tile_dma<EPI_GATES>(j, mt * 128, jt * 256, 0, 4, smem);
        }
      });
      PHR(REP_MISC, ph_lru_scan1(p));
      PH(ph_lru_scan2(p, ia));
      PH({
        GJob j = mkjob((const bf16_t*)(p.ws + SA_GT), 1024, wt + WA_OUT + (size_t)ia * 1024 * 1024, 1024, 1024, 1024);
        j.o0 = X;
        gemm_streamk<EPI_RESID>(j, 4, smem, VBLOCK(), (unsigned*)(p.ws + W_BAR) + 4096, (unsigned)(layer * 2 + 1));
      });
    } else if (kind == 1) {
      PHR(REP_GEMM, {
        GJob j = mkjob(U, 1024, wt + WB_XBC, 1024, 1024, 4128);
        j.o0 = p.ws + SB_XBCP; j.o1 = p.ws + SB_DT; j.x0 = p.in[I_SSM_DTB];
        int toff = 0; gemm_run<EPI_SSM_XBC, false>(j, 17, toff, smem, VBLOCK());
      });
      PHR(REP_MISC, (ph_conv<4096, true>((const bf16_t*)(p.ws + SB_XBCP), (bf16_t*)(p.ws + SB_XBC),
                              p.in[I_SSM_CW], p.in[I_SSM_CB], p.in[I_ST_SC],
                              p.out + O_SC_P, p.out + O_SC_S)));
      PHR(REP_SSD, ph_ssd(p, smem));
      PH({
        GJob j = mkjob(U, 1024, wt + WB_Z, 1024, 1024, 2048);
        j.o0 = p.ws + SB_Y;
        int toff = 0; gemm_run<EPI_SSM_Z, false>(j, 8, toff, smem, VBLOCK());
      });
      PH(ph_gnorm(p));
      PH({
        GJob j = mkjob((const bf16_t*)(p.ws + SB_Y), 2048, wt + WB_OUT, 2048, 2048, 1024);
        j.o0 = X;
        gemm_streamk<EPI_RESID>(j, 4, smem, VBLOCK(), (unsigned*)(p.ws + W_BAR) + 4096, (unsigned)(layer * 2 + 1));
      });
    } else {
      PHR(REP_GEMM, {
        int toff = 0;
        for (int s = 0; s < 3; ++s) {
          GJob j = mkjob(U, 1024, wt + WC_RKV + (size_t)s * 1024 * 1024, 1024, 1024, 1024);
          j.A2 = (const bf16_t*)(p.ws + SC_UP); j.mu = p.in[I_RW_MU] + s * 1024;
          j.o0 = p.ws + SC_R + (size_t)s * SZ_TD2; j.ldo = 1024; j.act = 0;
          gemm_run<EPI_ST, true>(j, 8, toff, smem, VBLOCK());
        }
        for (int s = 0; s < 3; ++s) {
          const int nv = (s == 2) ? 128 : 64;
          GJob j = mkjob(U, 1024, wt + WC_L1 + (size_t)s * 64 * 1024, 1024, 1024, nv);
          j.A2 = (const bf16_t*)(p.ws + SC_UP); j.mu = p.in[I_RW_MU] + (3 + s) * 1024;
          j.o0 = p.ws + SC_LH + (size_t)s * 64 * 2; j.ldo = 256; j.act = (s == 0) ? 1 : (s == 2 ? 2 : 0);
          gemm_run<EPI_ST, true>(j, 1, toff, smem, VBLOCK());
        }
      });
      PHR(REP_GEMM, {
        int toff = 0;
        const bf16_t* LH = (const bf16_t*)(p.ws + SC_LH);
        {
          GJob j = mkjob(LH, 256, wt + WC_W2, 64, 64, 1024);
          j.o0 = p.ws + SC_WD; j.x0 = p.in[I_RW_W0];
          gemm_run<EPI_DECAY, false>(j, 4, toff, smem, VBLOCK());
        }
        {
          GJob j = mkjob(LH + 64, 256, wt + WC_A2, 64, 64, 1024);
          j.o0 = p.ws + SC_AA; j.x0 = p.in[I_RW_A0];
          gemm_run<EPI_SIGB, false>(j, 4, toff, smem, VBLOCK());
        }
        {
          GJob j = mkjob(LH + 128, 256, wt + WC_G2, 128, 128, 1024);
          j.o0 = p.ws + SC_G; j.ldo = 1024; j.act = 0;
          gemm_run<EPI_ST, false>(j, 4, toff, smem, VBLOCK());
        }
      });
      PHR(REP_WKV, ph_wkv<8>(p, smem));
      PHR(REP_MISC, ph_wkv_post(p));
      PH({
        GJob j = mkjob(U, 1024, wt + WC_OUT, 1024, 1024, 1024);
        j.o0 = X;
        gemm_streamk<EPI_RESID>(j, 4, smem, VBLOCK(), (unsigned*)(p.ws + W_BAR) + 4096, (unsigned)(layer * 2 + 1));
      });
    }
    PHR(REP_MISC, ph_rmsnorm(p, 0, p.in[I_NFFN] + layer * 1024));
    PHR(REP_GEMM, {
      GJob j = mkjob(U, 1024, wt + WF_1 + (size_t)layer * 4096 * 1024, 1024, 1024, 4096);
      j.o0 = p.ws + S_HB;
      int toff = 0; gemm_run<EPI_FFN1, false>(j, 16, toff, smem, VBLOCK());
    });
    PH({
      GJob j = mkjob((const bf16_t*)(p.ws + S_HB), 4096, wt + WF_2 + (size_t)layer * 4096 * 1024, 4096, 4096, 1024);
      j.o0 = X;
      gemm_streamk<EPI_RESID>(j, 4, smem, VBLOCK(), (unsigned*)(p.ws + W_BAR) + 4096, (unsigned)(layer * 2 + 2));
    });
  }
  PH_LAST(ph_rmsnorm(p, 2, p.in[I_NFIN]));
#undef PH
#undef PH_LAST
}

extern "C" void kernel_launch(void* const* d_in, const int* in_sizes, int n_in, void* d_out, int out_size,
                              void* d_ws, size_t ws_size, hipStream_t stream) {
  Params p;
  memset(&p, 0, sizeof(p));
  for (int i = 0; i < N_IN; ++i) p.in[i] = (const float*)d_in[i];
  p.out = (float*)d_out;
  p.ws = (char*)d_ws;
  p.ph_begin = 0;
  p.ph_end = 1000;
  static int grid_blocks = 0;
  if (!grid_blocks) {
    int dev = 0, cus = 0, per_cu = 0;
    hipGetDevice(&dev);
    hipDeviceGetAttribute(&cus, hipDeviceAttributeMultiprocessorCount, dev);
    hipOccupancyMaxActiveBlocksPerMultiprocessor(&per_cu, mega, NTHR, 0);
    if (per_cu > 2) per_cu = 2;
    if (per_cu < 1) per_cu = 1;
    grid_blocks = cus * per_cu;
  }
  if (ws_size < (size_t)536870912) fprintf(stderr, "workspace too small: %zu\n", ws_size);
  (void)hipMemsetAsync((char*)d_ws + W_BAR, 0, (4096 + 1024) * 4, stream);
  void* args[] = {&p};
  hipError_t e = hipLaunchCooperativeKernel((void*)mega, dim3(grid_blocks), dim3(NTHR), args, 0, stream);
  if (e != hipSuccess) fprintf(stderr, "cooperative launch failed: %s (grid %d)\n", hipGetErrorString(e), grid_blocks);
}
```

```cpp
#include <hip/hip_runtime.h>
#include <hip/hip_cooperative_groups.h>
#include <stdint.h>
#include <stdio.h>
#include <string.h>
namespace cg = cooperative_groups;

typedef unsigned short bf16_t;
typedef __attribute__((ext_vector_type(8))) short bf16x8;
typedef __attribute__((ext_vector_type(16))) float f32x16;

#define DI __device__ __forceinline__

constexpr int T_ = 17408;
constexpr int TP_ = 16384;
constexpr int NTHR = 256;
constexpr int MT_ = T_ / 128;

enum {
  I_XP = 0, I_XS, I_ST_LC, I_ST_LH, I_ST_SC, I_ST_SS, I_ST_RS, I_ST_RW,
  I_NMIX, I_NFFN, I_NFIN,
  I_LRU_WIN, I_LRU_CW, I_LRU_CB, I_LRU_WR, I_LRU_BR, I_LRU_WI, I_LRU_BI, I_LRU_LAM, I_LRU_WOUT,
  I_SSM_WIN, I_SSM_CW, I_SSM_CB, I_SSM_DTB, I_SSM_ALOG, I_SSM_D, I_SSM_NW, I_SSM_WOUT,
  I_RW_MU, I_RW_WRKV, I_RW_W0, I_RW_WW1, I_RW_WW2, I_RW_A0, I_RW_WA1, I_RW_WA2, I_RW_WG1, I_RW_WG2,
  I_RW_KK, I_RW_KA, I_RW_RK, I_RW_LNW, I_RW_LNB, I_RW_WOUT,
  I_FFN_W1, I_FFN_W2, N_IN
};

constexpr size_t O_Y = 0;
constexpr size_t O_LC_P = O_Y + (size_t)T_ * 1024;
constexpr size_t O_LC_S = O_LC_P + 2 * 8 * 3 * 1024;
constexpr size_t O_LH_P = O_LC_S + 2 * 128 * 3 * 1024;
constexpr size_t O_LH_S = O_LH_P + 2 * 8 * 1024;
constexpr size_t O_SC_P = O_LH_S + 2 * 128 * 1024;
constexpr size_t O_SC_S = O_SC_P + 8 * 3 * 4096;
constexpr size_t O_SS_P = O_SC_S + 128 * 3 * 4096;
constexpr size_t O_SS_S = O_SS_P + (size_t)8 * 32 * 64 * 128;
constexpr size_t O_RS_P = O_SS_S + (size_t)128 * 32 * 64 * 128;
constexpr size_t O_RS_S = O_RS_P + 8 * 1024;
constexpr size_t O_RW_P = O_RS_S + 128 * 1024;
constexpr size_t O_RW_S = O_RW_P + 8 * 16 * 64 * 64;

constexpr size_t W_X = 0;
constexpr size_t W_U = W_X + (size_t)T_ * 1024 * 4;
constexpr size_t W_WT = W_U + (size_t)T_ * 1024 * 2;
constexpr size_t WA_IN = 0;
constexpr size_t WA_G = WA_IN + 2 * 2048 * 1024;
constexpr size_t WA_OUT = WA_G + 2 * 2048 * 128;
constexpr size_t WB_XBC = WA_OUT + 2 * 1024 * 1024;
constexpr size_t WB_Z = WB_XBC + 4128 * 1024;
constexpr size_t WB_OUT = WB_Z + 2048 * 1024;
constexpr size_t WC_RKV = WB_OUT + 1024 * 2048;
constexpr size_t WC_L1 = WC_RKV + 3 * 1024 * 1024;
constexpr size_t WC_W2 = WC_L1 + 256 * 1024;
constexpr size_t WC_A2 = WC_W2 + 1024 * 64;
constexpr size_t WC_G2 = WC_A2 + 1024 * 64;
constexpr size_t WC_OUT = WC_G2 + 1024 * 128;
constexpr size_t WF_1 = WC_OUT + 1024 * 1024;
constexpr size_t WF_2 = WF_1 + (size_t)4 * 4096 * 1024;
constexpr size_t W_WT_ELEMS = WF_2 + (size_t)4 * 4096 * 1024;
constexpr size_t W_S = W_WT + W_WT_ELEMS * 2;
constexpr size_t SZ_TD2 = (size_t)T_ * 1024 * 2;
constexpr size_t SZ_TD4 = (size_t)T_ * 1024 * 4;
constexpr size_t S_HB = W_S;
constexpr size_t SA_XB = W_S;
constexpr size_t SA_GT = SA_XB + SZ_TD2;
constexpr size_t SA_XC = SA_GT + SZ_TD2;
constexpr size_t SA_AA = SA_XC + SZ_TD2;
constexpr size_t SA_BB = SA_AA + SZ_TD4;
constexpr size_t SA_CP = SA_BB + SZ_TD4;
constexpr size_t SA_CS = SA_CP + 8 * 64 * 1024 * 4;
constexpr size_t SB_XBCP = W_S;
constexpr size_t SB_Y = W_S;
constexpr size_t SB_XBC = SB_XBCP + SZ_TD2 * 4;
constexpr size_t SB_DT = SB_XBC + SZ_TD2 * 4;
constexpr size_t SC_UP = W_S;
constexpr size_t SC_O = W_S;
constexpr size_t SC_R = SC_UP + SZ_TD2;
constexpr size_t SC_K = SC_R + SZ_TD2;
constexpr size_t SC_V = SC_K + SZ_TD2;
constexpr size_t SC_LH = SC_V + SZ_TD2;
constexpr size_t SC_WD = SC_LH + (size_t)T_ * 256 * 2;
constexpr size_t SC_AA = SC_WD + SZ_TD4;
constexpr size_t SC_G = SC_AA + SZ_TD2;
constexpr size_t SC_END = SC_G + SZ_TD2;
static_assert(SC_END <= (size_t)536870912, "ws overflow C");
static_assert(SB_DT + (size_t)T_ * 32 * 4 <= (size_t)536870912, "ws overflow B");
static_assert(SA_CS + 8 * 64 * 1024 * 4 <= (size_t)536870912, "ws overflow A");

constexpr int SMEM_BYTES = 80384;
constexpr size_t W_BAR = (size_t)536870912 - 65536;

struct Params {
  const float* in[N_IN];
  float* out;
  char* ws;
  int ph_begin, ph_end;
};

DI float bf2f(bf16_t h) { return __uint_as_float(((unsigned)h) << 16); }
DI bf16_t f2bf(float f) {
  unsigned u = __float_as_uint(f);
  u += 0x7FFFu + ((u >> 16) & 1u);
  return (bf16_t)(u >> 16);
}
DI unsigned pack2(float a, float b) { return (unsigned)f2bf(a) | ((unsigned)f2bf(b) << 16); }
DI void unpack8(const uint4 v, float (&f)[8]) {
  f[0] = __uint_as_float(v.x << 16); f[1] = __uint_as_float(v.x & 0xFFFF0000u);
  f[2] = __uint_as_float(v.y << 16); f[3] = __uint_as_float(v.y & 0xFFFF0000u);
  f[4] = __uint_as_float(v.z << 16); f[5] = __uint_as_float(v.z & 0xFFFF0000u);
  f[6] = __uint_as_float(v.w << 16); f[7] = __uint_as_float(v.w & 0xFFFF0000u);
}
DI void unpack4(const uint2 v, float (&f)[4]) {
  f[0] = __uint_as_float(v.x << 16); f[1] = __uint_as_float(v.x & 0xFFFF0000u);
  f[2] = __uint_as_float(v.y << 16); f[3] = __uint_as_float(v.y & 0xFFFF0000u);
}
DI uint4 pack8(const float (&f)[8]) {
  return make_uint4(pack2(f[0], f[1]), pack2(f[2], f[3]), pack2(f[4], f[5]), pack2(f[6], f[7]));
}
DI void load8f(const float* p, float (&f)[8]) {
  float4 a = *(const float4*)p, b = *(const float4*)(p + 4);
  f[0] = a.x; f[1] = a.y; f[2] = a.z; f[3] = a.w; f[4] = b.x; f[5] = b.y; f[6] = b.z; f[7] = b.w;
}
DI void store8f(float* p, const float (&f)[8]) {
  *(float4*)p = make_float4(f[0], f[1], f[2], f[3]);
  *(float4*)(p + 4) = make_float4(f[4], f[5], f[6], f[7]);
}
DI float sigmoidf_(float x) { return 1.f / (1.f + __expf(-x)); }
DI float siluf_(float x) { return x / (1.f + __expf(-x)); }
DI float tanhf_(float y) { return 1.f - 2.f / (1.f + __expf(2.f * y)); }
DI float geluf_(float x) { return 0.5f * x * (1.f + tanhf_(0.7978845608028654f * (x + 0.044715f * x * x * x))); }
DI float softplusf_(float x) { return fmaxf(x, 0.f) + log1pf(__expf(-fabsf(x))); }
DI float softplus_fast(float x) { return fmaxf(x, 0.f) + __logf(1.f + __expf(-fabsf(x))); }
DI float wave_sum(float v) {
#pragma unroll
  for (int o = 32; o >= 1; o >>= 1) v += __shfl_xor(v, o, 64);
  return v;
}
template <int CTRL> DI float dppf(float x) {
  return __int_as_float(__builtin_amdgcn_update_dpp(0, __float_as_int(x), CTRL, 0xf, 0xf, false));
}
template <int N> DI float red_lanes(float x) {
  x += dppf<0xB1>(x);
  x += dppf<0x4E>(x);
  if (N >= 8) x += dppf<0x141>(x);
  if (N >= 16) x += dppf<0x140>(x);
  return x;
}
DI void tok_info(int t, int& seq, int& l, int& L) {
  if (t < TP_) { seq = t >> 11; l = t & 2047; L = 2048; }
  else { int u = t - TP_; seq = 8 + (u >> 3); l = u & 7; L = 8; }
}
DI int opq(int x) { asm volatile("" : "+v"(x)); return x; }
#define TIDX opq((int)threadIdx.x)
DI f32x16 mfma32(bf16x8 a, bf16x8 b, f32x16 c) { return __builtin_amdgcn_mfma_f32_32x32x16_bf16(a, b, c, 0, 0, 0); }


#define XB_TMO      128
#define XB_XCNT(j)  (256  + 64 * (j))
#define XB_XSUB(j)  (1280 + 64 * (j))
#define XB_XGEN(j)  (2304 + 64 * (j))
#define XB_TOP      3328
#define XB_TOPGEN   3392
#define XCD_BAR_WORDS 3456
#define XB_SPIN_CAP (1u << 22)
#define LAS __attribute__((address_space(3)))
DI unsigned xb_ld(unsigned* p) { return __hip_atomic_load(p, __ATOMIC_RELAXED, __HIP_MEMORY_SCOPE_AGENT); }
DI unsigned xb_add(unsigned* p, unsigned v) { return __hip_atomic_fetch_add(p, v, __ATOMIC_RELAXED, __HIP_MEMORY_SCOPE_AGENT); }
DI unsigned xb_xcc_id() { return (unsigned)__builtin_amdgcn_s_getreg((3 << 11) | 20) & 0xFu; }
#define XB_SPIN(cond, bar) do { unsigned _sp = 0; while (cond) { __builtin_amdgcn_s_sleep(1); \
    if ((++_sp & 255u) == 0u) { if (xb_ld(&(bar)[XB_TMO])) break; if (_sp > XB_SPIN_CAP) { atomicAdd(&(bar)[XB_TMO], 1u); break; } } } } while (0)
struct XcdBarrier { unsigned* bar; unsigned x; volatile LAS unsigned* st; };
DI XcdBarrier xcd_barrier_post(unsigned* bar, volatile LAS unsigned* st) {
  XcdBarrier b; b.bar = bar; b.x = xb_xcc_id(); b.st = st;
  if (threadIdx.x == 0) st[2] = xb_add(&bar[XB_XCNT(b.x)], 1u);
  return b;
}
DI void xcd_barrier_complete(unsigned* bar, unsigned x, unsigned& nloc, unsigned& nx) {
  const unsigned G = gridDim.x * gridDim.y * gridDim.z;
  unsigned sum, cnt, mine, sp = 0u;
  for (;;) {
    sum = 0u; cnt = 0u; mine = 0u;
#pragma unroll
    for (unsigned j = 0; j < 16; ++j) { const unsigned c = xb_ld(&bar[XB_XCNT(j)]); sum += c; cnt += (c > 0u) ? 1u : 0u; mine = (j == x) ? c : mine; }
    if (sum == G) break;
    __builtin_amdgcn_s_sleep(1);
    if ((++sp & 255u) == 0u) { if (xb_ld(&bar[XB_TMO])) break; if (sp > XB_SPIN_CAP) { atomicAdd(&bar[XB_TMO], 1u); break; } }
  }
  nloc = mine > 0u ? mine : 1u; nx = cnt > 0u ? cnt : 1u;
}
DI void xcd_barrier(const XcdBarrier& b) {
  asm volatile("s_waitcnt vmcnt(0)" ::: "memory");
  __syncthreads();
  if (threadIdx.x == 0) {
    unsigned* bar = b.bar;
    __builtin_amdgcn_s_waitcnt(0);
    unsigned nloc = b.st[0], nx = b.st[1];
    if (nloc == 0u) { xcd_barrier_complete(bar, b.x, nloc, nx); b.st[0] = nloc; b.st[1] = nx; }
    const unsigned old = xb_add(&bar[XB_XSUB(b.x)], 1u);
    const unsigned gen = old / nloc;
    if (old + 1u == (gen + 1u) * nloc) {
      __builtin_amdgcn_fence(__ATOMIC_RELEASE, "agent");
      asm volatile("s_waitcnt vmcnt(0)" ::: "memory");
      const unsigned og = xb_add(&bar[XB_TOP], 1u);
      const unsigned tg = og / nx;
      if (og + 1u == (tg + 1u) * nx) xb_add(&bar[XB_TOPGEN], 1u);
      else XB_SPIN(xb_ld(&bar[XB_TOPGEN]) == tg, bar);
      __builtin_amdgcn_fence(__ATOMIC_ACQUIRE, "agent");
      xb_add(&bar[XB_XGEN(b.x)], 1u);
      asm volatile("s_waitcnt vmcnt(0)" ::: "memory");
    } else {
      XB_SPIN(xb_ld(&bar[XB_XGEN(b.x)]) == gen, bar);
      __builtin_amdgcn_fence(__ATOMIC_ACQUIRE, "agent");
      asm volatile("s_waitcnt vmcnt(0)" ::: "memory");
    }
  }
  __syncthreads();
}

struct GJob {
  const bf16_t* A; const bf16_t* A2; const float* mu; const bf16_t* Bt;
  int lda, ldb, K, nvalid;
  void* o0; void* o1; const float* x0; const float* x1; const float* x2;
  int ldo, act;
};
enum { EPI_LRU_IN = 0, EPI_GATES, EPI_RESID, EPI_SSM_XBC, EPI_SSM_Z, EPI_FFN1, EPI_ST, EPI_DECAY, EPI_SIGB };

template <int EPI> DI void epi_elem(const GJob& j, int row, int col, float v) {
  if (EPI == EPI_LRU_IN) {
    if (col < 1024) ((bf16_t*)j.o0)[(size_t)row * 1024 + col] = f2bf(v);
    else ((bf16_t*)j.o1)[(size_t)row * 1024 + col - 1024] = f2bf(geluf_(v));
  } else if (EPI == EPI_RESID) {
    unsafeAtomicAdd((float*)j.o0 + (size_t)row * 1024 + col, v);
  } else if (EPI == EPI_SSM_XBC) {
    if (col < 4096) ((bf16_t*)j.o0)[(size_t)row * 4096 + col] = f2bf(v);
  } else if (EPI == EPI_SSM_Z) {
    bf16_t* y = (bf16_t*)j.o0 + (size_t)row * 2048 + col;
    *y = f2bf(bf2f(*y) * siluf_(v));
  } else if (EPI == EPI_FFN1) {
    float r = fmaxf(v, 0.f);
    ((bf16_t*)j.o0)[(size_t)row * 4096 + col] = f2bf(r * r);
  } else if (EPI == EPI_ST) {
    if (col < j.nvalid) {
      float r = v;
      if (j.act == 1) r = tanhf_(v); else if (j.act == 2) r = sigmoidf_(v);
      ((bf16_t*)j.o0)[(size_t)row * j.ldo + col] = f2bf(r);
    }
  } else if (EPI == EPI_DECAY) {
    float wl = -softplusf_(-(j.x0[col] + v)) - 0.5f;
    ((float*)j.o0)[(size_t)row * 1024 + col] = __expf(-__expf(wl));
  } else if (EPI == EPI_SIGB) {
    ((bf16_t*)j.o0)[(size_t)row * 1024 + col] = f2bf(sigmoidf_(j.x0[col] + v));
  }
}

DI void quad_transpose4(float (&v)[4], int l) {
  const bool o1 = l & 1, o2 = l & 2;
  {
    const float s01 = o1 ? v[0] : v[1], s23 = o1 ? v[2] : v[3];
    const float r01 = dppf<0xB1>(s01), r23 = dppf<0xB1>(s23);
    if (o1) { v[0] = r01; v[2] = r23; } else { v[1] = r01; v[3] = r23; }
  }
  {
    const float s02 = o2 ? v[0] : v[2], s13 = o2 ? v[1] : v[3];
    const float r02 = dppf<0x4E>(s02), r13 = dppf<0x4E>(s13);
    if (o2) { v[0] = r02; v[1] = r13; } else { v[2] = r02; v[3] = r13; }
  }
}
DI uint2 pack4(float a, float b, float c, float d) { return make_uint2(pack2(a, b), pack2(c, d)); }
template <int EPI> DI void epi4(const GJob& j, int row, int col, const float (&v)[4]) {
  if (EPI == EPI_LRU_IN) {
    if (col < 1024) *(uint2*)((bf16_t*)j.o0 + (size_t)row * 1024 + col) = pack4(v[0], v[1], v[2], v[3]);
    else *(uint2*)((bf16_t*)j.o1 + (size_t)row * 1024 + col - 1024) = pack4(geluf_(v[0]), geluf_(v[1]), geluf_(v[2]), geluf_(v[3]));
  } else if (EPI == EPI_RESID) {
    float4* x = (float4*)((float*)j.o0 + (size_t)row * 1024 + col);
    float4 t = *x; t.x += v[0]; t.y += v[1]; t.z += v[2]; t.w += v[3]; *x = t;
  } else if (EPI == EPI_SSM_XBC) {
    if (col < 4096) *(uint2*)((bf16_t*)j.o0 + (size_t)row * 4096 + col) = pack4(v[0], v[1], v[2], v[3]);
  } else if (EPI == EPI_SSM_Z) {
    uint2* y = (uint2*)((bf16_t*)j.o0 + (size_t)row * 2048 + col);
    float f[4]; unpack4(*y, f);
    *y = pack4(f[0] * siluf_(v[0]), f[1] * siluf_(v[1]), f[2] * siluf_(v[2]), f[3] * siluf_(v[3]));
  } else if (EPI == EPI_FFN1) {
    const float r0 = fmaxf(v[0], 0.f), r1 = fmaxf(v[1], 0.f), r2 = fmaxf(v[2], 0.f), r3 = fmaxf(v[3], 0.f);
    *(uint2*)((bf16_t*)j.o0 + (size_t)row * 4096 + col) = pack4(r0 * r0, r1 * r1, r2 * r2, r3 * r3);
  } else if (EPI == EPI_ST) {
    if (col < j.nvalid) {
      float r[4];
#pragma unroll
      for (int e = 0; e < 4; ++e) r[e] = (j.act == 1) ? tanhf_(v[e]) : ((j.act == 2) ? sigmoidf_(v[e]) : v[e]);
      *(uint2*)((bf16_t*)j.o0 + (size_t)row * j.ldo + col) = pack4(r[0], r[1], r[2], r[3]);
    }
  } else if (EPI == EPI_DECAY) {
    const float4 w0 = *(const float4*)(j.x0 + col);
    const float w[4] = {w0.x, w0.y, w0.z, w0.w};
    float r[4];
#pragma unroll
    for (int e = 0; e < 4; ++e) r[e] = __expf(-__expf(-softplus_fast(-(w[e] + v[e])) - 0.5f));
    *(float4*)((float*)j.o0 + (size_t)row * 1024 + col) = make_float4(r[0], r[1], r[2], r[3]);
  } else if (EPI == EPI_SIGB) {
    const float4 a0 = *(const float4*)(j.x0 + col);
    *(uint2*)((bf16_t*)j.o0 + (size_t)row * 1024 + col) =
        pack4(sigmoidf_(a0.x + v[0]), sigmoidf_(a0.y + v[1]), sigmoidf_(a0.z + v[2]), sigmoidf_(a0.w + v[3]));
  }
}

template <int EPI, bool MIX>
DI void gemm_tile(const GJob& j, int m0, int n0, int kt0, int kt1, char* smem) {
  const int tid = TIDX, lane = tid & 63, w = tid >> 6;
  const int wm = w >> 1, wn = w & 1, r32 = lane & 31, hh = lane >> 5;
  const int lrow = tid >> 3, kc = tid & 7;
  f32x16 acc[2][2];
#pragma unroll
  for (int a = 0; a < 2; ++a)
#pragma unroll
    for (int b = 0; b < 2; ++b)
#pragma unroll
      for (int r = 0; r < 16; ++r) acc[a][b][r] = 0.f;
  uint4 qa00, qa01, qa02, qa03, qb00, qb01, qb02, qb03, qc00, qc01, qc02, qc03;
  uint4 qa10, qa11, qa12, qa13, qb10, qb11, qb12, qb13, qc10, qc11, qc12, qc13;
  qc00 = qc01 = qc02 = qc03 = qc10 = qc11 = qc12 = qc13 = make_uint4(0, 0, 0, 0);
  const int nk = kt1 - kt0;
  const bf16_t* Ap = j.A + (size_t)(m0 + lrow) * j.lda + kc * 8 + (size_t)kt0 * 64;
  const bf16_t* A2p = MIX ? (j.A2 + (size_t)(m0 + lrow) * j.lda + kc * 8 + (size_t)kt0 * 64) : nullptr;
  const bf16_t* Bp = j.Bt + (size_t)(n0 + lrow) * j.ldb + kc * 8 + (size_t)kt0 * 64;
  const size_t astep = (size_t)32 * j.lda, bstep = (size_t)32 * j.ldb;
  const bool bv0 = (n0 + lrow) < j.nvalid, bv1 = (n0 + lrow + 32) < j.nvalid;
  const bool bv2 = (n0 + lrow + 64) < j.nvalid, bv3 = (n0 + lrow + 96) < j.nvalid;
  const uint4 z4 = make_uint4(0, 0, 0, 0);

#define LD1(s, i, kt)                                                                 \
  qa##s##i = *(const uint4*)(Ap + i * astep + (kt) * 64);                             \
  if (MIX) qc##s##i = *(const uint4*)(A2p + i * astep + (kt) * 64);                   \
  qb##s##i = z4;                                                                      \
  if (bv##i) qb##s##i = *(const uint4*)(Bp + i * bstep + (kt) * 64);
#define GLOAD(s, kt) { LD1(s, 0, kt) LD1(s, 1, kt) LD1(s, 2, kt) LD1(s, 3, kt) }
#define ST1(s, i, As_, Bs_)                                                           \
  if (MIX) {                                                                          \
    float f1[8], f2[8]; unpack8(qa##s##i, f1); unpack8(qc##s##i, f2);                 \
    _Pragma("unroll") for (int e = 0; e < 8; ++e) f1[e] = f1[e] + (f2[e] - f1[e]) * mu8[e]; \
    qa##s##i = pack8(f1);                                                             \
  }                                                                                   \
  *(uint4*)(As_ + (lrow + 32 * i) * 144 + kc * 16) = qa##s##i;                        \
  *(uint4*)(Bs_ + (lrow + 32 * i) * 144 + kc * 16) = qb##s##i;
#define SSTORE(s, kt, buf)                                                            \
  {                                                                                   \
    char* As_ = smem + (buf) * 36864; char* Bs_ = As_ + 18432;                        \
    float mu8[8];                                                                     \
    if (MIX) load8f(j.mu + (kt0 + (kt)) * 64 + kc * 8, mu8);                          \
    ST1(s, 0, As_, Bs_) ST1(s, 1, As_, Bs_) ST1(s, 2, As_, Bs_) ST1(s, 3, As_, Bs_)   \
  }
#define LOADF(F, ks)                                                                  \
  bf16x8 F##a0 = *(const bf16x8*)(ap + (ks) * 32);                                    \
  bf16x8 F##a1 = *(const bf16x8*)(ap + 32 * 144 + (ks) * 32);                         \
  bf16x8 F##b0 = *(const bf16x8*)(bp + (ks) * 32);                                    \
  bf16x8 F##b1 = *(const bf16x8*)(bp + 32 * 144 + (ks) * 32);
#define MFMA4(F)                                                                      \
  acc[0][0] = mfma32(F##a0, F##b0, acc[0][0]);                                        \
  acc[0][1] = mfma32(F##a0, F##b1, acc[0][1]);                                        \
  acc[1][0] = mfma32(F##a1, F##b0, acc[1][0]);                                        \
  acc[1][1] = mfma32(F##a1, F##b1, acc[1][1]);
#define COMPUTE(buf)                                                                  \
  {                                                                                   \
    const char* As_ = smem + (buf) * 36864; const char* Bs_ = As_ + 18432;            \
    const char* ap = As_ + (wm * 64 + r32) * 144 + hh * 16;                           \
    const char* bp = Bs_ + (wn * 64 + r32) * 144 + hh * 16;                           \
    LOADF(f0, 0) LOADF(f1, 1)                                                         \
    __builtin_amdgcn_sched_barrier(0);                                                \
    MFMA4(f0)                                                                         \
    LOADF(f2, 2)                                                                      \
    __builtin_amdgcn_sched_barrier(0);                                                \
    MFMA4(f1)                                                                         \
    LOADF(f3, 3)                                                                      \
    __builtin_amdgcn_sched_barrier(0);                                                \
    MFMA4(f2)                                                                         \
    __builtin_amdgcn_sched_barrier(0);                                                \
    MFMA4(f3)                                                                         \
    __builtin_amdgcn_sched_barrier(0);                                                \
  }

  qa10 = qa11 = qa12 = qa13 = qb10 = qb11 = qb12 = qb13 = z4;
  if (MIX) {
    GLOAD(0, 0);
    SSTORE(0, 0, 0);
    __syncthreads();
    for (int i = 0; i < nk; ++i) {
      if (i + 1 < nk) GLOAD(0, i + 1);
      if (i & 1) { COMPUTE(1); } else { COMPUTE(0); }
      if (i + 1 < nk) { if (i & 1) { SSTORE(0, i + 1, 0); } else { SSTORE(0, i + 1, 1); } }
      __syncthreads();
    }
  } else if (nk == 1) {
    GLOAD(0, 0);
    SSTORE(0, 0, 0);
    __syncthreads();
    COMPUTE(0);
    __syncthreads();
  } else {
    GLOAD(0, 0);
    GLOAD(1, 1);
    SSTORE(0, 0, 0);
    __syncthreads();
#pragma unroll 1
    for (int i = 0; i + 2 < nk; i += 2) {
      GLOAD(0, i + 2);
      COMPUTE(0);
      SSTORE(1, i + 1, 1);
      __syncthreads();
      GLOAD(1, i + 3);
      COMPUTE(1);
      SSTORE(0, i + 2, 0);
      __syncthreads();
    }
    COMPUTE(0);
    SSTORE(1, nk - 1, 1);
    __syncthreads();
    COMPUTE(1);
    __syncthreads();
  }
#undef LD1
#undef ST1
#undef LOADF
#undef MFMA4
#undef GLOAD
#undef SSTORE
#undef COMPUTE

  if (EPI == EPI_GATES) {
    const int ch = (n0 >> 7) * 64 + wn * 32 + r32;
    const float br = j.x0[ch], bi = j.x1[ch];
    const float spl = softplusf_(-j.x2[ch]);
    const bf16_t* XC = (const bf16_t*)j.o1;
    float* AA = (float*)j.o0;
    float* BBp = AA + (size_t)T_ * 1024;
#pragma unroll
    for (int mi = 0; mi < 2; ++mi)
#pragma unroll
      for (int r = 0; r < 16; ++r) {
        const int row = m0 + wm * 64 + mi * 32 + (r & 3) + 8 * (r >> 2) + 4 * hh;
        const float rg = sigmoidf_(acc[mi][0][r] + br);
        const float ig = sigmoidf_(acc[mi][1][r] + bi);
        const float la = -8.f * rg * spl;
        const float xc = bf2f(XC[(size_t)row * 1024 + ch]);
        const bool reset = (row < TP_) && ((row & 2047) == 0);
        const float a = reset ? 0.f : __expf(la);
        const float mult = reset ? 1.f : sqrtf(fmaxf(-expm1f(2.f * la), 0.f));
        AA[(size_t)row * 1024 + ch] = a;
        BBp[(size_t)row * 1024 + ch] = mult * ig * xc;
      }
  } else {
#pragma unroll
    for (int mi = 0; mi < 2; ++mi)
#pragma unroll
      for (int ni = 0; ni < 2; ++ni)
#pragma unroll
        for (int r = 0; r < 16; ++r) {
          const int row = m0 + wm * 64 + mi * 32 + (r & 3) + 8 * (r >> 2) + 4 * hh;
          const int col = n0 + wn * 64 + ni * 32 + r32;
          epi_elem<EPI>(j, row, col, acc[mi][ni][r]);
          if ((r & 7) == 7) __builtin_amdgcn_sched_barrier(0);
        }
  }
}

constexpr int DSLOT = 24576;
template <int EPI>
DI void gemm_tile_dma(const GJob& j, int m0, int n0, int k0, int k1, char* smem, unsigned* wflag = nullptr, unsigned epoch = 0u) {
  const int tid = TIDX, lane = tid & 63, w = tid >> 6;
  const int wm = w >> 1, wn = w & 1, r32 = lane & 31, hh = lane >> 5;
  f32x16 acc[2][4];
#pragma unroll
  for (int a = 0; a < 2; ++a)
#pragma unroll
    for (int b = 0; b < 4; ++b)
#pragma unroll
      for (int r = 0; r < 16; ++r) acc[a][b][r] = 0.f;
  const int nk = k1 - k0;
  const int dr = lane >> 2;
  const int dc = (lane & 3) ^ ((lane >> 4) & 3);
  const int nlim = j.nvalid - 1;
  const size_t kofs = (size_t)k0 * 32 + dc * 8;
  const bf16_t* gA0 = j.A + (size_t)(m0 + 32 * w + dr) * j.lda + kofs;
  const bf16_t* gA1 = j.A + (size_t)(m0 + 32 * w + 16 + dr) * j.lda + kofs;
  const bf16_t* gB0 = j.Bt + (size_t)min(n0 + 64 * w + dr, nlim) * j.ldb + kofs;
  const bf16_t* gB1 = j.Bt + (size_t)min(n0 + 64 * w + 16 + dr, nlim) * j.ldb + kofs;
  const bf16_t* gB2 = j.Bt + (size_t)min(n0 + 64 * w + 32 + dr, nlim) * j.ldb + kofs;
  const bf16_t* gB3 = j.Bt + (size_t)min(n0 + 64 * w + 48 + dr, nlim) * j.ldb + kofs;
  char* ldsA = smem + (2 * w) * 1024 + lane * 16;
  char* ldsB = smem + 8192 + (4 * w) * 1024 + lane * 16;
  const unsigned lbase = (unsigned)(unsigned long long)(LAS char*)smem;
  const int fsw = (r32 >> 2) & 3;
  const unsigned pa = (unsigned)((wm * 64 + r32) * 64), pb = (unsigned)(8192 + (wn * 128 + r32) * 64);
  const unsigned po0 = (unsigned)(((hh) ^ fsw) * 16), po1 = (unsigned)(((2 + hh) ^ fsw) * 16);

#define DMA1(gp, lp) __builtin_amdgcn_global_load_lds((const unsigned*)(gp), (unsigned*)(lp), 16, 0, 0)
#define ISSUE(kt, slot)                                                                          \
  {                                                                                              \
    const int ko_ = (kt) * 32;                                                                   \
    char* la_ = ldsA + (slot) * DSLOT; char* lb_ = ldsB + (slot) * DSLOT;                        \
    DMA1(gA0 + ko_, la_); DMA1(gA1 + ko_, la_ + 1024);                                           \
    DMA1(gB0 + ko_, lb_); DMA1(gB1 + ko_, lb_ + 1024); DMA1(gB2 + ko_, lb_ + 2048); DMA1(gB3 + ko_, lb_ + 3072); \
  }
#define SB_ __builtin_amdgcn_sched_barrier(0)

  asm volatile("s_waitcnt vmcnt(0)" ::: "memory");
  const int last = nk - 1;
  ISSUE(0, 0);
  { const int t1 = min(1, last); ISSUE(t1, 1); }
  int sl_r = 0, sl_w = 2;
#pragma unroll 1
  for (int i = 0; i < nk; ++i) {
    asm volatile("s_waitcnt vmcnt(6)" ::: "memory");
    __builtin_amdgcn_s_barrier();
    const int ko2 = min(i + 2, last) * 32;
    char* la2 = ldsA + sl_w * DSLOT; char* lb2 = ldsB + sl_w * DSLOT;
    const unsigned sl = lbase + (unsigned)(sl_r * DSLOT);
    sl_r = (sl_r == 2) ? 0 : sl_r + 1;
    sl_w = (sl_w == 2) ? 0 : sl_w + 1;
    bf16x8 a00, a10, a01, a11, b00, b10, b20, b30, b01, b11, b21, b31;
    const unsigned aA0 = sl + pa + po0, aB0 = sl + pb + po0, aA1 = sl + pa + po1, aB1 = sl + pb + po1;
    asm volatile("ds_read_b128 %0, %1" : "=v"(a00) : "v"(aA0));
    asm volatile("ds_read_b128 %0, %1 offset:2048" : "=v"(a10) : "v"(aA0));
    asm volatile("ds_read_b128 %0, %1" : "=v"(b00) : "v"(aB0));
    asm volatile("ds_read_b128 %0, %1 offset:2048" : "=v"(b10) : "v"(aB0));
    asm volatile("ds_read_b128 %0, %1 offset:4096" : "=v"(b20) : "v"(aB0));
    asm volatile("ds_read_b128 %0, %1 offset:6144" : "=v"(b30) : "v"(aB0));
    asm volatile("ds_read_b128 %0, %1" : "=v"(a01) : "v"(aA1));
    asm volatile("ds_read_b128 %0, %1 offset:2048" : "=v"(a11) : "v"(aA1));
    asm volatile("ds_read_b128 %0, %1" : "=v"(b01) : "v"(aB1));
    asm volatile("ds_read_b128 %0, %1 offset:2048" : "=v"(b11) : "v"(aB1));
    asm volatile("ds_read_b128 %0, %1 offset:4096" : "=v"(b21) : "v"(aB1));
    asm volatile("ds_read_b128 %0, %1 offset:6144" : "=v"(b31) : "v"(aB1));
    DMA1(gA0 + ko2, la2);
    asm volatile("s_waitcnt lgkmcnt(0)" : "+v"(a00), "+v"(a10), "+v"(b00), "+v"(b10), "+v"(b20), "+v"(b30),
                 "+v"(a01), "+v"(a11), "+v"(b01), "+v"(b11), "+v"(b21), "+v"(b31) :: "memory");
    acc[0][0] = mfma32(a00, b00, acc[0][0]);
    acc[0][1] = mfma32(a00, b10, acc[0][1]);
    acc[0][2] = mfma32(a00, b20, acc[0][2]);
    SB_; DMA1(gA1 + ko2, la2 + 1024); SB_;
    acc[0][3] = mfma32(a00, b30, acc[0][3]);
    acc[1][0] = mfma32(a10, b00, acc[1][0]);
    acc[1][1] = mfma32(a10, b10, acc[1][1]);
    SB_; DMA1(gB0 + ko2, lb2); SB_;
    acc[1][2] = mfma32(a10, b20, acc[1][2]);
    acc[1][3] = mfma32(a10, b30, acc[1][3]);
    acc[0][0] = mfma32(a01, b01, acc[0][0]);
    SB_; DMA1(gB1 + ko2, lb2 + 1024); SB_;
    acc[0][1] = mfma32(a01, b11, acc[0][1]);
    acc[0][2] = mfma32(a01, b21, acc[0][2]);
    acc[0][3] = mfma32(a01, b31, acc[0][3]);
    SB_; DMA1(gB2 + ko2, lb2 + 2048); SB_;
    acc[1][0] = mfma32(a11, b01, acc[1][0]);
    acc[1][1] = mfma32(a11, b11, acc[1][1]);
    acc[1][2] = mfma32(a11, b21, acc[1][2]);
    SB_; DMA1(gB3 + ko2, lb2 + 3072); SB_;
    acc[1][3] = mfma32(a11, b31, acc[1][3]);
  }
  asm volatile("s_waitcnt vmcnt(0)" ::: "memory");
  __builtin_amdgcn_s_barrier();
#undef ISSUE
#undef DMA1
#undef SB_
  if (wflag) {
    if (threadIdx.x == 0) {
      unsigned sp = 0;
      while (xb_ld(wflag) != epoch) { __builtin_amdgcn_s_sleep(1); if (++sp > (1u << 24)) break; }
      __builtin_amdgcn_fence(__ATOMIC_ACQUIRE, "agent");
      asm volatile("s_waitcnt vmcnt(0)" ::: "memory");
    }
    __syncthreads();
  }

  if (EPI == EPI_GATES) {
    const bf16_t* XC = (const bf16_t*)j.o1;
    float* AA = (float*)j.o0;
    float* BBp = AA + (size_t)T_ * 1024;
#pragma unroll
    for (int g = 0; g < 2; ++g) {
      const int ch = (n0 >> 8) * 128 + wn * 64 + g * 32 + r32;
      const float br = j.x0[ch], bi = j.x1[ch];
      const float spl = softplusf_(-j.x2[ch]);
#pragma unroll
      for (int mi = 0; mi < 2; ++mi)
#pragma unroll
        for (int r = 0; r < 16; ++r) {
          const int row = m0 + wm * 64 + mi * 32 + (r & 3) + 8 * (r >> 2) + 4 * hh;
          const float rg = sigmoidf_(acc[mi][2 * g][r] + br);
          const float ig = sigmoidf_(acc[mi][2 * g + 1][r] + bi);
          const float la = -8.f * rg * spl;
          const float xc = bf2f(XC[(size_t)row * 1024 + ch]);
          const bool reset = (row < TP_) && ((row & 2047) == 0);
          const float a = reset ? 0.f : __expf(la);
          const float mult = reset ? 1.f : sqrtf(fmaxf(-expm1f(2.f * la), 0.f));
          AA[(size_t)row * 1024 + ch] = a;
          BBp[(size_t)row * 1024 + ch] = mult * ig * xc;
        }
    }
  } else {
    const int lq = lane & 3;
#pragma unroll
    for (int mi = 0; mi < 2; ++mi)
#pragma unroll
      for (int ni = 0; ni < 4; ++ni)
#pragma unroll
        for (int g4 = 0; g4 < 4; ++g4) {
          float v[4] = {acc[mi][ni][4 * g4], acc[mi][ni][4 * g4 + 1], acc[mi][ni][4 * g4 + 2], acc[mi][ni][4 * g4 + 3]};
          quad_transpose4(v, lq);
          const int row = m0 + wm * 64 + mi * 32 + 8 * g4 + 4 * hh + lq;
          const int col = n0 + wn * 128 + ni * 32 + (r32 & ~3);
          epi4<EPI>(j, row, col, v);
        }
    if (EPI == EPI_SSM_XBC) {
      if (n0 + wn * 128 == 4096) {
        const float dtb = j.x0[r32];
#pragma unroll
        for (int mi = 0; mi < 2; ++mi)
#pragma unroll
          for (int r = 0; r < 16; ++r) {
            const int row = m0 + wm * 64 + mi * 32 + (r & 3) + 8 * (r >> 2) + 4 * hh;
            ((float*)j.o1)[(size_t)row * 32 + r32] = softplusf_(acc[mi][0][r] + dtb);
          }
      }
    }
  }
}

template <int EPI>
DI void gemm_tile_dma_h(const GJob& j, int m0, int n0, int nk, char* smem) {
  const int tid = TIDX, lane = tid & 63, w = tid >> 6;
  const int wm = w >> 1, wn = w & 1, r32 = lane & 31, hh = lane >> 5;
  f32x16 acc[4];
#pragma unroll
  for (int b = 0; b < 4; ++b)
#pragma unroll
    for (int r = 0; r < 16; ++r) acc[b][r] = 0.f;
  const int dr = lane >> 2;
  const int dc = (lane & 3) ^ ((lane >> 4) & 3);
  const int nlim = j.nvalid - 1;
  const size_t kofs = (size_t)dc * 8;
  const bf16_t* gA0 = j.A + (size_t)(m0 + 16 * w + dr) * j.lda + kofs;
  const bf16_t* gB0 = j.Bt + (size_t)min(n0 + 64 * w + dr, nlim) * j.ldb + kofs;
  const bf16_t* gB1 = j.Bt + (size_t)min(n0 + 64 * w + 16 + dr, nlim) * j.ldb + kofs;
  const bf16_t* gB2 = j.Bt + (size_t)min(n0 + 64 * w + 32 + dr, nlim) * j.ldb + kofs;
  const bf16_t* gB3 = j.Bt + (size_t)min(n0 + 64 * w + 48 + dr, nlim) * j.ldb + kofs;
  char* ldsA = smem + w * 1024 + lane * 16;
  char* ldsB = smem + 8192 + (4 * w) * 1024 + lane * 16;
  const unsigned lbase = (unsigned)(unsigned long long)(LAS char*)smem;
  const int fsw = (r32 >> 2) & 3;
  const unsigned pa = (unsigned)((wm * 32 + r32) * 64), pb = (unsigned)(8192 + (wn * 128 + r32) * 64);
  const unsigned po0 = (unsigned)(((hh) ^ fsw) * 16), po1 = (unsigned)(((2 + hh) ^ fsw) * 16);
#define DMA1(gp, lp) __builtin_amdgcn_global_load_lds((const unsigned*)(gp), (unsigned*)(lp), 16, 0, 0)
#define ISSUEH(kt, slot)                                                                         \
  {                                                                                              \
    const int ko_ = (kt) * 32;                                                                   \
    char* la_ = ldsA + (slot) * DSLOT; char* lb_ = ldsB + (slot) * DSLOT;                        \
    DMA1(gA0 + ko_, la_);                                                                        \
    DMA1(gB0 + ko_, lb_); DMA1(gB1 + ko_, lb_ + 1024); DMA1(gB2 + ko_, lb_ + 2048); DMA1(gB3 + ko_, lb_ + 3072); \
  }
  asm volatile("s_waitcnt vmcnt(0)" ::: "memory");
  const int last = nk - 1;
  ISSUEH(0, 0);
  { const int t1 = min(1, last); ISSUEH(t1, 1); }
  int sl_r = 0, sl_w = 2;
#pragma unroll 1
  for (int i = 0; i < nk; ++i) {
    asm volatile("s_waitcnt vmcnt(5)" ::: "memory");
    __builtin_amdgcn_s_barrier();
    { const int t2 = min(i + 2, last); ISSUEH(t2, sl_w); }
    const unsigned sl = lbase + (unsigned)(sl_r * DSLOT);
    sl_r = (sl_r == 2) ? 0 : sl_r + 1;
    sl_w = (sl_w == 2) ? 0 : sl_w + 1;
    bf16x8 a00, a01, b00, b10, b20, b30, b01, b11, b21, b31;
    const unsigned aA0 = sl + pa + po0, aB0 = sl + pb + po0, aA1 = sl + pa + po1, aB1 = sl + pb + po1;
    asm volatile("ds_read_b128 %0, %1" : "=v"(a00) : "v"(aA0));
    asm volatile("ds_read_b128 %0, %1" : "=v"(b00) : "v"(aB0));
    asm volatile("ds_read_b128 %0, %1 offset:2048" : "=v"(b10) : "v"(aB0));
    asm volatile("ds_read_b128 %0, %1 offset:4096" : "=v"(b20) : "v"(aB0));
    asm volatile("ds_read_b128 %0, %1 offset:6144" : "=v"(b30) : "v"(aB0));
    asm volatile("ds_read_b128 %0, %1" : "=v"(a01) : "v"(aA1));
    asm volatile("ds_read_b128 %0, %1" : "=v"(b01) : "v"(aB1));
    asm volatile("ds_read_b128 %0, %1 offset:2048" : "=v"(b11) : "v"(aB1));
    asm volatile("ds_read_b128 %0, %1 offset:4096" : "=v"(b21) : "v"(aB1));
    asm volatile("ds_read_b128 %0, %1 offset:6144" : "=v"(b31) : "v"(aB1));
    asm volatile("s_waitcnt lgkmcnt(0)" : "+v"(a00), "+v"(b00), "+v"(b10), "+v"(b20), "+v"(b30),
                 "+v"(a01), "+v"(b01), "+v"(b11), "+v"(b21), "+v"(b31) :: "memory");
    acc[0] = mfma32(a00, b00, acc[0]);
    acc[1] = mfma32(a00, b10, acc[1]);
    acc[2] = mfma32(a00, b20, acc[2]);
    acc[3] = mfma32(a00, b30, acc[3]);
    acc[0] = mfma32(a01, b01, acc[0]);
    acc[1] = mfma32(a01, b11, acc[1]);
    acc[2] = mfma32(a01, b21, acc[2]);
    acc[3] = mfma32(a01, b31, acc[3]);
  }
  asm volatile("s_waitcnt vmcnt(0)" ::: "memory");
  __builtin_amdgcn_s_barrier();
#undef ISSUEH
#undef DMA1
  const int lq = lane & 3;
#pragma unroll
  for (int ni = 0; ni < 4; ++ni)
#pragma unroll
    for (int g4 = 0; g4 < 4; ++g4) {
      float v[4] = {acc[ni][4 * g4], acc[ni][4 * g4 + 1], acc[ni][4 * g4 + 2], acc[ni][4 * g4 + 3]};
      quad_transpose4(v, lq);
      const int row = m0 + wm * 32 + 8 * g4 + 4 * hh + lq;
      const int col = n0 + wn * 128 + ni * 32 + (r32 & ~3);
      epi4<EPI>(j, row, col, v);
    }
  if (EPI == EPI_SSM_XBC) {
    if (n0 + wn * 128 == 4096) {
      const float dtb = j.x0[r32];
#pragma unroll
      for (int r = 0; r < 16; ++r) {
        const int row = m0 + wm * 32 + (r & 3) + 8 * (r >> 2) + 4 * hh;
        ((float*)j.o1)[(size_t)row * 32 + r32] = softplusf_(acc[0][r] + dtb);
      }
    }
  }
}

#define VBLOCK() ((int)(((volatile LAS unsigned*)&xb_words)[3]))
DI void tile_map(int L, int ntn, int& mt, int& nt) {
  const int gw = ((ntn & 7) == 0) ? 8 : (((ntn & 3) == 0) ? 4 : 0);
  if (gw) {
    const int gs = 8 * gw, grp = L / gs, loc = L - grp * gs, gpr = ntn / gw;
    const int gm = grp / gpr, gn = grp - gm * gpr;
    mt = gm * 8 + loc / gw; nt = gn * gw + (loc - (loc / gw) * gw);
  } else { mt = L / ntn; nt = L - mt * ntn; }
}

template <int EPI, bool MIX>
DI void gemm_run(const GJob& j, int ntn, int& toff, char* smem, int vb_) {
  const int G = gridDim.x;
  const int nk = j.K >> 6;
  if (MIX) {
    const int ntiles = MT_ * ntn;
    const int start = (int)((vb_ - (toff % G) + G) % G);
    for (int tile = start; tile < ntiles; tile += G) {
      int mt, nt; tile_map(tile, ntn, mt, nt);
      gemm_tile<EPI, MIX>(j, mt * 128, nt * 128, 0, nk, smem);
    }
    toff += ntiles;
  } else {
    const int nfull = 128 * ntn, nhalf = 16 * ntn, ntot = nfull + nhalf;
    const int start = (int)((vb_ - (toff % G) + G) % G);
    for (int item = start; item < ntot; item += G) {
      if (item < nfull) {
        int mt, nt; tile_map(item, ntn, mt, nt);
        gemm_tile_dma<EPI>(j, mt * 128, nt * 256, 0, nk * 2, smem);
      } else {
        const int h = item - nfull, hm = h / ntn, nt = h - hm * ntn;
        gemm_tile_dma_h<EPI>(j, TP_ + hm * 64, nt * 256, nk * 2, smem);
      }
    }
    toff += ntot;
  }
}

template <int EPI>
DI void gemm_streamk(const GJob& j, int ntn, char* smem, int vb_, unsigned* flags, unsigned epoch) {
  const int G = gridDim.x;
  const int nk = j.K >> 5;
  const int total = MT_ * ntn * nk;
  int per = (total + G - 1) / G;
  if (per < nk) per = nk;
  int s0 = vb_ * per;
  const int s1 = min(s0 + per, total);
  while (s0 < s1) {
    const int tile = s0 / nk, k0 = s0 - tile * nk;
    const int k1 = min(nk, k0 + (s1 - s0));
    int mt, nt; tile_map(tile, ntn, mt, nt);
    unsigned* wf = (k0 == 0 && k1 < nk) ? (flags + tile) : nullptr;
    gemm_tile_dma<EPI>(j, mt * 128, nt * 256, k0, k1, smem, wf, epoch);
    if (k0 > 0) {
      asm volatile("s_waitcnt vmcnt(0)" ::: "memory");
      __syncthreads();
      if (threadIdx.x == 0) {
        __builtin_amdgcn_fence(__ATOMIC_RELEASE, "agent");
        asm volatile("s_waitcnt vmcnt(0)" ::: "memory");
        __hip_atomic_store(flags + tile, epoch, __ATOMIC_RELAXED, __HIP_MEMORY_SCOPE_AGENT);
      }
    }
    s0 += k1 - k0;
  }
}

template <int EPI, int SPLIT, int NKC>
DI void gemm_splitk(const GJob& j, int ntn, char* smem, int vb_) {
  const int G = gridDim.x;
  const int nitems = MT_ * ntn * SPLIT;
  for (int it = vb_; it < nitems; it += G) {
    const int tile = it / SPLIT, sp = it - tile * SPLIT;
    int mt, nt; tile_map(tile, ntn, mt, nt);
    gemm_tile<EPI, false>(j, mt * 128, nt * 128, sp * NKC, sp * NKC + NKC, smem);
  }
}

DI GJob mkjob(const bf16_t* A, int lda, const bf16_t* Bt, int ldb, int K, int nvalid) {
  GJob j;
  j.A = A; j.A2 = nullptr; j.mu = nullptr; j.Bt = Bt; j.lda = lda; j.ldb = ldb; j.K = K; j.nvalid = nvalid;
  j.o0 = nullptr; j.o1 = nullptr; j.x0 = nullptr; j.x1 = nullptr; j.x2 = nullptr; j.ldo = 0; j.act = 0;
  return j;
}

struct TJob { const float* src; bf16_t* dst; int K, N, src_ld, kind, n_off; };

DI TJob get_tjob(const Params& p, int j) {
  bf16_t* wt = (bf16_t*)(p.ws + W_WT);
  TJob o; o.kind = 0; o.n_off = 0;
  if (j < 36) {
    const int ia = j / 18, r = j % 18;
    if (r == 0) { o.src = p.in[I_LRU_WIN] + (size_t)ia * 1024 * 2048; o.dst = wt + WA_IN + (size_t)ia * 2048 * 1024; o.K = 1024; o.N = 2048; o.src_ld = 2048; }
    else if (r == 1) { o.src = p.in[I_LRU_WOUT] + (size_t)ia * 1024 * 1024; o.dst = wt + WA_OUT + (size_t)ia * 1024 * 1024; o.K = 1024; o.N = 1024; o.src_ld = 1024; }
    else {
      const int isI = (r >= 10) ? 1 : 0; const int h = (r - 2) & 7;
      o.src = p.in[isI ? I_LRU_WI : I_LRU_WR] + ((size_t)ia * 8 + h) * 128 * 128;
      o.dst = wt + WA_G + (size_t)ia * 2048 * 128; o.K = 128; o.N = 128; o.src_ld = 128; o.kind = 1 + isI; o.n_off = h * 128;
    }
  } else if (j == 36) { o.src = p.in[I_SSM_WIN] + 2048; o.dst = wt + WB_XBC; o.K = 1024; o.N = 4128; o.src_ld = 6176; }
  else if (j == 37) { o.src = p.in[I_SSM_WIN]; o.dst = wt + WB_Z; o.K = 1024; o.N = 2048; o.src_ld = 6176; }
  else if (j == 38) { o.src = p.in[I_SSM_WOUT]; o.dst = wt + WB_OUT; o.K = 2048; o.N = 1024; o.src_ld = 1024; }
  else if (j < 42) { const int s = j - 39; o.src = p.in[I_RW_WRKV] + (size_t)s * 1024 * 1024; o.dst = wt + WC_RKV + (size_t)s * 1024 * 1024; o.K = 1024; o.N = 1024; o.src_ld = 1024; }
  else if (j == 42) { o.src = p.in[I_RW_WW1]; o.dst = wt + WC_L1; o.K = 1024; o.N = 64; o.src_ld = 64; }
  else if (j == 43) { o.src = p.in[I_RW_WA1]; o.dst = wt + WC_L1 + 64 * 1024; o.K = 1024; o.N = 64; o.src_ld = 64; }
  else if (j == 44) { o.src = p.in[I_RW_WG1]; o.dst = wt + WC_L1 + 128 * 1024; o.K = 1024; o.N = 128; o.src_ld = 128; }
  else if (j == 45) { o.src = p.in[I_RW_WW2]; o.dst = wt + WC_W2; o.K = 64; o.N = 1024; o.src_ld = 1024; }
  else if (j == 46) { o.src = p.in[I_RW_WA2]; o.dst = wt + WC_A2; o.K = 64; o.N = 1024; o.src_ld = 1024; }
  else if (j == 47) { o.src = p.in[I_RW_WG2]; o.dst = wt + WC_G2; o.K = 128; o.N = 1024; o.src_ld = 1024; }
  else if (j == 48) { o.src = p.in[I_RW_WOUT]; o.dst = wt + WC_OUT; o.K = 1024; o.N = 1024; o.src_ld = 1024; }
  else {
    const int l = (j - 49) >> 1, which = (j - 49) & 1;
    if (!which) { o.src = p.in[I_FFN_W1] + (size_t)l * 1024 * 4096; o.dst = wt + WF_1 + (size_t)l * 4096 * 1024; o.K = 1024; o.N = 4096; o.src_ld = 4096; }
    else { o.src = p.in[I_FFN_W2] + (size_t)l * 4096 * 1024; o.dst = wt + WF_2 + (size_t)l * 4096 * 1024; o.K = 4096; o.N = 1024; o.src_ld = 1024; }
  }
  return o;
}
constexpr int N_TJOBS = 57;

DI void ph_prologue(const Params& p, char* smem) {
  const int tid = TIDX, G = gridDim.x;
  {
    const float4* xp = (const float4*)p.in[I_XP];
    const float4* xs = (const float4*)p.in[I_XS];
    float4* X = (float4*)(p.ws + W_X);
    const size_t np = (size_t)TP_ * 256, nt = (size_t)T_ * 256;
    for (size_t i = (size_t)blockIdx.x * NTHR + tid; i < nt; i += (size_t)G * NTHR)
      X[i] = (i < np) ? xp[i] : xs[i - np];
  }
  float* tile = (float*)smem;
  int toff = 0;
  for (int jn = 0; jn < N_TJOBS; ++jn) {
    const TJob tj = get_tjob(p, jn);
    const int nkt = tj.K >> 6, nnt = (tj.N + 63) >> 6;
    const int ntiles = nkt * nnt;
    const int start = (((int)blockIdx.x - (toff % G)) + G) % G;
    for (int t = start; t < ntiles; t += G) {
      const int kt = t / nnt, nt = t - kt * nnt;
      const int k0 = kt * 64, n0 = nt * 64;
      __syncthreads();
#pragma unroll 4
      for (int i = 0; i < 16; ++i) {
        const int k = i * 4 + (tid >> 6), n = tid & 63;
        float v = 0.f;
        if (n0 + n < tj.N) v = tj.src[(size_t)(k0 + k) * tj.src_ld + n0 + n];
        tile[k * 65 + n] = v;
      }
      __syncthreads();
      const int n = tid >> 2, kq = tid & 3;
      if (n0 + n < tj.N) {
        int nrow = n0 + n;
        if (tj.kind) {
          const int ch = tj.n_off + n0 + n;
          nrow = (ch >> 6) * 128 + ((ch >> 5) & 1) * 64 + (tj.kind - 1) * 32 + (ch & 31);
        }
        float f[8], g[8];
#pragma unroll
        for (int e = 0; e < 8; ++e) { f[e] = tile[(kq * 16 + e) * 65 + n]; g[e] = tile[(kq * 16 + 8 + e) * 65 + n]; }
        uint4* d = (uint4*)(tj.dst + (size_t)nrow * tj.K + k0 + kq * 16);
        d[0] = pack8(f); d[1] = pack8(g);
      }
    }
    toff += ntiles;
  }
}

DI void ph_rmsnorm(const Params& p, int mode, const float* w) {
  const int tid_ = TIDX; const int lane = tid_ & 63;
  const int gw = blockIdx.x * 4 + (tid_ >> 6), nw = gridDim.x * 4;
  const float* X = (const float*)(p.ws + W_X);
  bf16_t* U = (bf16_t*)(p.ws + W_U);
  bf16_t* UP = (bf16_t*)(p.ws + SC_UP);
  float4 wv[4];
#pragma unroll
  for (int i = 0; i < 4; ++i) wv[i] = ((const float4*)w)[lane + 64 * i];
  for (int row = gw; row < T_; row += nw) {
    const float4* xr = (const float4*)(X + (size_t)row * 1024);
    float4 v[4]; float ss = 0.f;
#pragma unroll
    for (int i = 0; i < 4; ++i) { v[i] = xr[lane + 64 * i]; ss += v[i].x * v[i].x + v[i].y * v[i].y + v[i].z * v[i].z + v[i].w * v[i].w; }
    ss = wave_sum(ss);
    const float rstd = rsqrtf(ss * (1.f / 1024.f) + 1e-6f);
    int seq, l, L; tok_info(row, seq, l, L);
#pragma unroll
    for (int i = 0; i < 4; ++i) {
      const int c = 4 * (lane + 64 * i);
      float4 y = make_float4(v[i].x * rstd * wv[i].x, v[i].y * rstd * wv[i].y, v[i].z * rstd * wv[i].z, v[i].w * rstd * wv[i].w);
      if (mode == 2) {
        *(float4*)(p.out + O_Y + (size_t)row * 1024 + c) = y;
      } else {
        uint2 pk = make_uint2(pack2(y.x, y.y), pack2(y.z, y.w));
        *(uint2*)(U + (size_t)row * 1024 + c) = pk;
        if (mode == 1) {
          if (l + 1 < L) *(uint2*)(UP + (size_t)(row + 1) * 1024 + c) = pk;
          if (l == 0) {
            uint2 pz = make_uint2(0, 0);
            if (seq >= 8) { float4 s = *(const float4*)(p.in[I_ST_RS] + (size_t)(seq - 8) * 1024 + c); pz = make_uint2(pack2(s.x, s.y), pack2(s.z, s.w)); }
            *(uint2*)(UP + (size_t)row * 1024 + c) = pz;
          }
          if (l == L - 1) {
            float* o = (seq < 8) ? (p.out + O_RS_P + (size_t)seq * 1024 + c) : (p.out + O_RS_S + (size_t)(seq - 8) * 1024 + c);
            *(float4*)o = y;
          }
        }
      }
    }
  }
}

template <int C, bool SILU>
DI void ph_conv(const bf16_t* __restrict__ src, bf16_t* __restrict__ dst, const float* __restrict__ cw,
                const float* __restrict__ cb, const float* __restrict__ state,
                float* __restrict__ out_p, float* __restrict__ out_s) {
  constexpr int GR = C / 8;
  const size_t total = (size_t)T_ * GR;
#pragma unroll 2
  for (size_t idx = (size_t)blockIdx.x * NTHR + TIDX; idx < total; idx += (size_t)gridDim.x * NTHR) {
    const int t = (int)(idx / GR), c = (int)(idx % GR) * 8;
    int seq, l, L; tok_info(t, seq, l, L);
    float acc[8]; load8f(cb + c, acc);
    float xcur[8];
#pragma unroll
    for (int jj = 0; jj < 4; ++jj) {
      const int ls = l - 3 + jj;
      float xv[8];
      if (ls >= 0) { unpack8(*(const uint4*)(src + (size_t)(t - 3 + jj) * C + c), xv); }
      else if (seq >= 8) { load8f(state + ((size_t)(seq - 8) * 3 + (ls + 3)) * C + c, xv); }
      else {
#pragma unroll
        for (int e = 0; e < 8; ++e) xv[e] = 0.f;
      }
      float w8[8]; load8f(cw + (size_t)jj * C + c, w8);
#pragma unroll
      for (int e = 0; e < 8; ++e) acc[e] += w8[e] * xv[e];
      if (jj == 3) {
#pragma unroll
        for (int e = 0; e < 8; ++e) xcur[e] = xv[e];
      }
    }
    if (SILU) {
#pragma unroll
      for (int e = 0; e < 8; ++e) acc[e] = siluf_(acc[e]);
    }
    *(uint4*)(dst + (size_t)t * C + c) = pack8(acc);
    if (l >= L - 3) {
      const int r = l - (L - 3);
      float* o = (seq < 8) ? (out_p + ((size_t)seq * 3 + r) * C + c) : (out_s + ((size_t)(seq - 8) * 3 + r) * C + c);
      store8f(o, xcur);
    }
  }
}

DI void ph_lru_scan1(const Params& p) {
  const float* AA = (const float*)(p.ws + SA_AA);
  const float* BB = (const float*)(p.ws + SA_BB);
  float* CP = (float*)(p.ws + SA_CP);
  float* CS = (float*)(p.ws + SA_CS);
  const int total = 8 * 64 * 1024;
  for (int idx = blockIdx.x * NTHR + TIDX; idx < total; idx += gridDim.x * NTHR) {
    const int ch = idx & 1023, c = (idx >> 10) & 63, b = idx >> 16;
    const size_t base = ((size_t)b * 2048 + c * 32) * 1024 + ch;
    float P = 1.f, S = 0.f;
    float av[32], bv[32];
#pragma unroll
    for (int s = 0; s < 32; ++s) { av[s] = AA[base + (size_t)s * 1024]; bv[s] = BB[base + (size_t)s * 1024]; }
#pragma unroll
    for (int s = 0; s < 32; ++s) { S = av[s] * S + bv[s]; P *= av[s]; }
    CP[idx] = P; CS[idx] = S;
  }
}
DI void ph_lru_scan2(const Params& p, int ia) {
  const float* AA = (const float*)(p.ws + SA_AA);
  const float* BB = (const float*)(p.ws + SA_BB);
  const float* CP = (const float*)(p.ws + SA_CP);
  const float* CS = (const float*)(p.ws + SA_CS);
  bf16_t* GT = (bf16_t*)(p.ws + SA_GT);
  const int nP = 8 * 64 * 1024, total = nP + 128 * 1024;
  for (int idx = blockIdx.x * NTHR + TIDX; idx < total; idx += gridDim.x * NTHR) {
    if (idx < nP) {
      const int ch = idx & 1023, c = (idx >> 10) & 63, b = idx >> 16;
      const size_t base = ((size_t)b * 2048 + c * 32) * 1024 + ch;
      float av[32], bv[32]; bf16_t gv[32];
#pragma unroll
      for (int s = 0; s < 32; ++s) { const size_t o = base + (size_t)s * 1024; av[s] = AA[o]; bv[s] = BB[o]; gv[s] = GT[o]; }
      float h = 0.f;
#pragma unroll 8
      for (int c2 = 0; c2 < c; ++c2) {
        const int ci = ((b * 64 + c2) << 10) + ch;
        h = CP[ci] * h + CS[ci];
      }
#pragma unroll
      for (int s = 0; s < 32; ++s) {
        const size_t o = base + (size_t)s * 1024;
        h = av[s] * h + bv[s];
        GT[o] = f2bf(h * bf2f(gv[s]));
      }
      if (c == 63) p.out[O_LH_P + ((size_t)ia * 8 + b) * 1024 + ch] = h;
    } else {
      const int u = idx - nP; const int ch = u & 1023, s = u >> 10;
      float h = p.in[I_ST_LH][((size_t)ia * 128 + s) * 1024 + ch];
      const size_t base = ((size_t)TP_ + s * 8) * 1024 + ch;
#pragma unroll
      for (int q = 0; q < 8; ++q) {
        const size_t o = base + (size_t)q * 1024;
        h = AA[o] * h + BB[o];
        GT[o] = f2bf(h * bf2f(GT[o]));
      }
      p.out[O_LH_S + ((size_t)ia * 128 + s) * 1024 + ch] = h;
    }
  }
}

DI void ssd_item(const Params& p, char* smem, int seq, int h) {
  const int tid = TIDX, lane = tid & 63, w = tid >> 6, r32 = lane & 31, hh = lane >> 5;
  bf16_t* Cs = (bf16_t*)smem;
  bf16_t* Bs = Cs + 64 * 136;
  bf16_t* Sb = Bs + 64 * 136;
  bf16_t* Xt = Sb + 64 * 136;
  bf16_t* Btr = Xt + 64 * 72;
  float* dts = (float*)(Btr + 128 * 72);
  float* acs = dts + 64;
  bf16_t* Ws = Bs;
  const bf16_t* XBC = (const bf16_t*)(p.ws + SB_XBC);
  const float* DT = (const float*)(p.ws + SB_DT);
  bf16_t* Y = (bf16_t*)(p.ws + SB_Y);
  const bool prompt = seq < 8;
  const int nchunk = prompt ? 32 : 1, Lv = prompt ? 64 : 8;
  const int tbase = prompt ? seq * 2048 : TP_ + (seq - 8) * 8;
  const int g = h >> 2;
  const float Ah = -__expf(p.in[I_SSM_ALOG][h]);
  const float Dh = p.in[I_SSM_D][h];
  f32x16 accS[2];
  {
    const float* s0 = p.in[I_ST_SS] + ((size_t)(seq - 8) * 32 + h) * 64 * 128;
#pragma unroll
    for (int mi = 0; mi < 2; ++mi)
#pragma unroll
      for (int r = 0; r < 16; ++r) {
        const int prow = mi * 32 + (r & 3) + 8 * (r >> 2) + 4 * hh, n = 32 * w + r32;
        accS[mi][r] = prompt ? 0.f : s0[(size_t)prow * 128 + n];
      }
  }
  __syncthreads();
#pragma unroll
  for (int mi = 0; mi < 2; ++mi)
#pragma unroll
    for (int r = 0; r < 16; ++r) {
      const int prow = mi * 32 + (r & 3) + 8 * (r >> 2) + 4 * hh, n = 32 * w + r32;
      Sb[prow * 136 + n] = f2bf(accS[mi][r]);
    }
  uint4 pc0, pc1, pc2, pc3, pb0, pb1, pb2, pb3, px0, px1;
  float pdt = 0.f;
  const uint4 z4 = make_uint4(0, 0, 0, 0);
  pc0 = pc1 = pc2 = pc3 = pb0 = pb1 = pb2 = pb3 = px0 = px1 = z4;
#define SSD_LD_CB(i, t0_)                                                                  \
  { const int id_ = tid + 256 * i, row_ = id_ >> 4, ch_ = id_ & 15;                        \
    pc##i = z4; pb##i = z4;                                                                \
    if (row_ < Lv) { const bf16_t* src_ = XBC + (size_t)((t0_) + row_) * 4096 + g * 128 + ch_ * 8; \
      pb##i = *(const uint4*)(src_ + 2048); pc##i = *(const uint4*)(src_ + 3072); } }
#define SSD_LD_X(i, t0_)                                                                   \
  { const int id_ = tid + 256 * i, row_ = id_ >> 3, ch_ = id_ & 7;                         \
    px##i = z4;                                                                            \
    if (row_ < Lv) px##i = *(const uint4*)(XBC + (size_t)((t0_) + row_) * 4096 + h * 64 + ch_ * 8); }
#define SSD_ISSUE(t0_)                                                                     \
  { SSD_LD_CB(0, t0_) SSD_LD_CB(1, t0_) SSD_LD_CB(2, t0_) SSD_LD_CB(3, t0_) SSD_LD_X(0, t0_) SSD_LD_X(1, t0_) \
    pdt = (tid < Lv && tid < 64) ? DT[(size_t)((t0_) + tid) * 32 + h] : 0.f; }
#define SSD_ST_CB(i)                                                                       \
  { const int id_ = tid + 256 * i, row_ = id_ >> 4, ch_ = id_ & 15;                        \
    *(uint4*)(Cs + row_ * 136 + ch_ * 8) = pc##i;                                          \
    *(uint4*)(Bs + row_ * 136 + ch_ * 8) = pb##i;                                          \
    float f_[8]; unpack8(pb##i, f_);                                                       \
    const float sc_ = __expf(aend - acs[row_]);                                            \
    _Pragma("unroll") for (int e = 0; e < 8; ++e) Btr[(ch_ * 8 + e) * 72 + row_] = f2bf(f_[e] * sc_); }
#define SSD_ST_X(i)                                                                        \
  { const int id_ = tid + 256 * i, row_ = id_ >> 3, ch_ = id_ & 7;                         \
    float f_[8]; unpack8(px##i, f_);                                                       \
    const float sc_ = dts[row_];                                                           \
    _Pragma("unroll") for (int e = 0; e < 8; ++e) Xt[(ch_ * 8 + e) * 72 + row_] = f2bf(f_[e] * sc_); }
  SSD_ISSUE(tbase);
  for (int c = 0; c < nchunk; ++c) {
    const int t0 = tbase + c * 64;
    __syncthreads();
    if (tid < 64) {
      const float dtv = pdt;
      float x = dtv * Ah;
#pragma unroll
      for (int o = 1; o < 64; o <<= 1) { const float y = __shfl_up(x, o, 64); if (lane >= o) x += y; }
      dts[tid] = dtv; acs[tid] = x;
    }
    __syncthreads();
    const float aend = acs[63];
    SSD_ST_CB(0) SSD_ST_CB(1) SSD_ST_CB(2) SSD_ST_CB(3) SSD_ST_X(0) SSD_ST_X(1)
    if (c + 1 < nchunk) { SSD_ISSUE(t0 + 64); }
    __syncthreads();
    const int it = w >> 1, jt = w & 1;
    f32x16 cb;
#pragma unroll
    for (int r = 0; r < 16; ++r) cb[r] = 0.f;
    if (jt <= it) {
#pragma unroll
      for (int ks = 0; ks < 8; ++ks) {
        bf16x8 a = *(const bf16x8*)(Cs + (it * 32 + r32) * 136 + ks * 16 + hh * 8);
        bf16x8 b = *(const bf16x8*)(Bs + (jt * 32 + r32) * 136 + ks * 16 + hh * 8);
        cb = mfma32(a, b, cb);
      }
    }
    __syncthreads();
    {
      const int jj = jt * 32 + r32; const float aj = acs[jj];
#pragma unroll
      for (int r = 0; r < 16; ++r) {
        const int ii = it * 32 + (r & 3) + 8 * (r >> 2) + 4 * hh;
        const float v = (jj <= ii) ? cb[r] * __expf(acs[ii] - aj) : 0.f;
        Ws[ii * 72 + jj] = f2bf(v);
      }
    }
    __syncthreads();
    {
      const int pt = w & 1;
      f32x16 yd, yo;
#pragma unroll
      for (int r = 0; r < 16; ++r) { yd[r] = 0.f; yo[r] = 0.f; }
#pragma unroll
      for (int ks = 0; ks < 4; ++ks) {
        bf16x8 a = *(const bf16x8*)(Ws + (it * 32 + r32) * 72 + ks * 16 + hh * 8);
        bf16x8 b = *(const bf16x8*)(Xt + (pt * 32 + r32) * 72 + ks * 16 + hh * 8);
        yd = mfma32(a, b, yd);
      }
#pragma unroll
      for (int ks = 0; ks < 8; ++ks) {
        bf16x8 a = *(const bf16x8*)(Cs + (it * 32 + r32) * 136 + ks * 16 + hh * 8);
        bf16x8 b = *(const bf16x8*)(Sb + (pt * 32 + r32) * 136 + ks * 16 + hh * 8);
        yo = mfma32(a, b, yo);
      }
      const int pp = pt * 32 + r32;
#pragma unroll
      for (int r = 0; r < 16; ++r) {
        const int ii = it * 32 + (r & 3) + 8 * (r >> 2) + 4 * hh;
        if (ii < Lv) {
          const size_t t = (size_t)(t0 + ii);
          const float xv = bf2f(XBC[t * 4096 + h * 64 + pp]);
          const float yv = yd[r] + __expf(acs[ii]) * yo[r] + Dh * xv;
          Y[t * 2048 + h * 64 + pp] = f2bf(yv);
        }
      }
    }
    {
      const float dec = __expf(aend);
#pragma unroll
      for (int mi = 0; mi < 2; ++mi)
#pragma unroll
        for (int r = 0; r < 16; ++r) accS[mi][r] *= dec;
#pragma unroll
      for (int ks = 0; ks < 4; ++ks) {
        bf16x8 b = *(const bf16x8*)(Btr + (32 * w + r32) * 72 + ks * 16 + hh * 8);
        bf16x8 a0 = *(const bf16x8*)(Xt + (r32) * 72 + ks * 16 + hh * 8);
        bf16x8 a1 = *(const bf16x8*)(Xt + (32 + r32) * 72 + ks * 16 + hh * 8);
        accS[0] = mfma32(a0, b, accS[0]);
        accS[1] = mfma32(a1, b, accS[1]);
      }
    }
    __syncthreads();
#pragma unroll
    for (int mi = 0; mi < 2; ++mi)
#pragma unroll
      for (int r = 0; r < 16; ++r) {
        const int prow = mi * 32 + (r & 3) + 8 * (r >> 2) + 4 * hh, n = 32 * w + r32;
        Sb[prow * 136 + n] = f2bf(accS[mi][r]);
      }
  }
  float* dst = prompt ? (p.out + O_SS_P + ((size_t)seq * 32 + h) * 64 * 128)
                      : (p.out + O_SS_S + ((size_t)(seq - 8) * 32 + h) * 64 * 128);
#pragma unroll
  for (int mi = 0; mi < 2; ++mi)
#pragma unroll
    for (int r = 0; r < 16; ++r) {
      const int prow = mi * 32 + (r & 3) + 8 * (r >> 2) + 4 * hh, n = 32 * w + r32;
      dst[(size_t)prow * 128 + n] = accS[mi][r];
    }
}

#undef SSD_LD_CB
#undef SSD_LD_X
#undef SSD_ISSUE
#undef SSD_ST_CB
#undef SSD_ST_X
DI void ph_ssd(const Params& p, char* smem) {
  const int G = gridDim.x, bid = blockIdx.x;
  int it = bid, step = G;
  if (G >= 512) { if (bid < 256) { step = 1 << 30; } else { step = G - 256; } }
#pragma nounroll
  for (; it < 256 + 4096; it += step) {
    const int seq = (it < 256) ? (it >> 5) : (8 + ((it - 256) >> 5));
    ssd_item(p, smem, seq, it & 31);
  }
}

DI void ph_gnorm(const Params& p) {
  const int tid_ = TIDX; const int lane = tid_ & 63;
  const int gw = blockIdx.x * 4 + (tid_ >> 6), nw = gridDim.x * 4;
  bf16_t* Y = (bf16_t*)(p.ws + SB_Y);
  const float* nwt = p.in[I_SSM_NW];
  for (int item = gw; item < T_ * 8; item += 2 * nw) {
    const int item2 = item + nw; const bool v2 = item2 < T_ * 8;
    bf16_t* yp1 = Y + (size_t)(item >> 3) * 2048 + (item & 7) * 256 + lane * 4;
    bf16_t* yp2 = Y + (size_t)((v2 ? item2 : item) >> 3) * 2048 + ((v2 ? item2 : item) & 7) * 256 + lane * 4;
    const uint2 a = *(const uint2*)yp1; const uint2 b = *(const uint2*)yp2;
    float f[4], g[4]; unpack4(a, f); unpack4(b, g);
    const float ss1 = wave_sum(f[0] * f[0] + f[1] * f[1] + f[2] * f[2] + f[3] * f[3]);
    const float ss2 = wave_sum(g[0] * g[0] + g[1] * g[1] + g[2] * g[2] + g[3] * g[3]);
    const float r1 = rsqrtf(ss1 * (1.f / 256.f) + 1e-5f), r2 = rsqrtf(ss2 * (1.f / 256.f) + 1e-5f);
    const float4 w1 = *(const float4*)(nwt + (item & 7) * 256 + lane * 4);
    const float4 w2 = *(const float4*)(nwt + ((v2 ? item2 : item) & 7) * 256 + lane * 4);
    *(uint2*)yp1 = make_uint2(pack2(f[0] * r1 * w1.x, f[1] * r1 * w1.y), pack2(f[2] * r1 * w1.z, f[3] * r1 * w1.w));
    if (v2) *(uint2*)yp2 = make_uint2(pack2(g[0] * r2 * w2.x, g[1] * r2 * w2.y), pack2(g[2] * r2 * w2.z, g[3] * r2 * w2.w));
  }
}

template <int LPR>
DI void wkv_item(const Params& p, char* smem, int seq, int head, int part) {
  constexpr int ROWS = 256 / LPR, KPL = 64 / LPR, NV4 = KPL / 4;
  const int tid = TIDX;
  float* sR = (float*)smem;
  float* sK = sR + 2048;
  float* sKK = sK + 2048;
  float* sBB = sKK + 2048;
  float* sW = sBB + 2048;
  float* sV = sW + 2048;
  float* sO = sV + 2048;
  const bf16_t* __restrict__ R = (const bf16_t*)(p.ws + SC_R);
  const bf16_t* __restrict__ K = (const bf16_t*)(p.ws + SC_K);
  const bf16_t* __restrict__ V = (const bf16_t*)(p.ws + SC_V);
  const bf16_t* __restrict__ AAc = (const bf16_t*)(p.ws + SC_AA);
  const float* __restrict__ WD = (const float*)(p.ws + SC_WD);
  bf16_t* O = (bf16_t*)(p.ws + SC_O);
  const bool prompt = seq < 8;
  const int nch = prompt ? 64 : 1, nvalid = prompt ? 32 : 8;
  const int tbase = prompt ? seq * 2048 : TP_ + (seq - 8) * 8;
  const int row_l = tid / LPR, q = tid % LPR, row = part * ROWS + row_l;
  float S[KPL];
  {
    const float* s0 = p.in[I_ST_RW] + (((size_t)(seq - 8) * 16 + head) * 64 + row) * 64 + q * KPL;
#pragma unroll
    for (int e = 0; e < KPL; ++e) S[e] = prompt ? 0.f : s0[e];
  }
  const int pst = tid >> 3, pk0 = (tid & 7) * 8, pcol = head * 64 + pk0;
  const bool pact = pst < nvalid;
  float kk8[8], ka8[8];
  load8f(p.in[I_RW_KK] + pcol, kk8);
  load8f(p.in[I_RW_KA] + pcol, ka8);
  uint4 qr = make_uint4(0, 0, 0, 0), qk = qr, qv = qr, qa = qr;
  float4 qw0 = make_float4(0.f, 0.f, 0.f, 0.f), qw1 = qw0;
#define WKV_ISSUE(c_)                                                       \
  if (pact) {                                                               \
    const size_t o_ = (size_t)(tbase + (c_) * 32 + pst) * 1024 + pcol;      \
    qr = *(const uint4*)(R + o_); qk = *(const uint4*)(K + o_);             \
    qv = *(const uint4*)(V + o_); qa = *(const uint4*)(AAc + o_);           \
    qw0 = *(const float4*)(WD + o_); qw1 = *(const float4*)(WD + o_ + 4);   \
  }
  WKV_ISSUE(0);
  for (int c = 0; c < nch; ++c) {
    const int t0 = tbase + c * 32;
    __syncthreads();
    if (pact) {
      float r8[8], k8[8], v8[8], a8[8];
      unpack8(qr, r8); unpack8(qk, k8); unpack8(qv, v8); unpack8(qa, a8);
      const float w8[8] = {qw0.x, qw0.y, qw0.z, qw0.w, qw1.x, qw1.y, qw1.z, qw1.w};
      float kr[8], ss = 0.f;
#pragma unroll
      for (int e = 0; e < 8; ++e) { kr[e] = k8[e] * kk8[e]; ss += kr[e] * kr[e]; }
      ss = red_lanes<8>(ss);
      const float inv = 1.f / fmaxf(sqrtf(ss), 1e-12f);
      float kp[8], bb[8];
#pragma unroll
      for (int e = 0; e < 8; ++e) { kr[e] *= inv; kp[e] = k8[e] * (1.f + (a8[e] - 1.f) * ka8[e]); bb[e] = kr[e] * a8[e]; }
      const int lo = pst * 64 + pk0;
      store8f(sR + lo, r8); store8f(sK + lo, kp); store8f(sKK + lo, kr); store8f(sBB + lo, bb);
      store8f(sW + lo, w8); store8f(sV + lo, v8);
    }
    __syncthreads();
    if (c + 1 < nch) { WKV_ISSUE(c + 1); }
#define WKV_LOADV(P, st_)                                                                      \
    {                                                                                          \
      const int lo_ = (st_) * 64 + q * KPL;                                                    \
      _Pragma("unroll") for (int e = 0; e < NV4; ++e) {                                        \
        P##kk[e] = *(const float4*)(sKK + lo_ + 4 * e); P##ww[e] = *(const float4*)(sW + lo_ + 4 * e); \
        P##bb[e] = *(const float4*)(sBB + lo_ + 4 * e); P##kp[e] = *(const float4*)(sK + lo_ + 4 * e); \
        P##rr[e] = *(const float4*)(sR + lo_ + 4 * e);                                         \
      }                                                                                        \
      P##vv = sV[(st_) * 64 + row];                                                            \
    }
#define WKV_STEP(P, st_)                                                                       \
    {                                                                                          \
      float sa0 = 0.f, sa1 = 0.f;                                                              \
      _Pragma("unroll") for (int e = 0; e < NV4; ++e) {                                        \
        sa0 += S[4 * e] * P##kk[e].x + S[4 * e + 2] * P##kk[e].z;                              \
        sa1 += S[4 * e + 1] * P##kk[e].y + S[4 * e + 3] * P##kk[e].w;                          \
      }                                                                                        \
      const float sa = red_lanes<LPR>(sa0 + sa1);                                              \
      float o0 = 0.f, o1 = 0.f;                                                                \
      _Pragma("unroll") for (int e = 0; e < NV4; ++e) {                                        \
        S[4 * e] = S[4 * e] * P##ww[e].x - sa * P##bb[e].x + P##vv * P##kp[e].x;               \
        S[4 * e + 1] = S[4 * e + 1] * P##ww[e].y - sa * P##bb[e].y + P##vv * P##kp[e].y;       \
        S[4 * e + 2] = S[4 * e + 2] * P##ww[e].z - sa * P##bb[e].z + P##vv * P##kp[e].z;       \
        S[4 * e + 3] = S[4 * e + 3] * P##ww[e].w - sa * P##bb[e].w + P##vv * P##kp[e].w;       \
        o0 += S[4 * e] * P##rr[e].x + S[4 * e + 2] * P##rr[e].z;                               \
        o1 += S[4 * e + 1] * P##rr[e].y + S[4 * e + 3] * P##rr[e].w;                           \
      }                                                                                        \
      const float oo = red_lanes<LPR>(o0 + o1);                                                \
      if (q == 0) sO[(st_) * ROWS + row_l] = oo;                                               \
    }
    {
      float4 Akk[NV4], Aww[NV4], Abb[NV4], Akp[NV4], Arr[NV4]; float Avv;
      float4 Bkk[NV4], Bww[NV4], Bbb[NV4], Bkp[NV4], Brr[NV4]; float Bvv;
      if (LPR <= 4) {
#pragma unroll 1
        for (int st = 0; st < nvalid; ++st) { WKV_LOADV(A, st); WKV_STEP(A, st); }
      } else {
        WKV_LOADV(A, 0);
#pragma unroll 1
        for (int st = 0; st < nvalid; st += 2) {
          WKV_LOADV(B, st + 1);
          WKV_STEP(A, st);
          if (st + 2 < nvalid) { WKV_LOADV(A, st + 2); }
          WKV_STEP(B, st + 1);
        }
      }
    }
    __syncthreads();
    for (int i = tid; i < nvalid * ROWS; i += NTHR) {
      const int st = i / ROWS, rr = i % ROWS;
      O[(size_t)(t0 + st) * 1024 + head * 64 + part * ROWS + rr] = f2bf(sO[i]);
    }
  }
#undef WKV_ISSUE
#undef WKV_LOADV
#undef WKV_STEP
  float* dst = prompt ? (p.out + O_RW_P + (((size_t)seq * 16 + head) * 64 + row) * 64 + q * KPL)
                      : (p.out + O_RW_S + (((size_t)(seq - 8) * 16 + head) * 64 + row) * 64 + q * KPL);
#pragma unroll
  for (int e = 0; e < KPL; ++e) dst[e] = S[e];
}

template <int LPRP>
DI void ph_wkv(const Params& p, char* smem) {
  constexpr int NPART = 64 / (256 / LPRP);
  const int G = gridDim.x, bid = blockIdx.x;
  const int nP = 128 * NPART;
#pragma nounroll
  for (int it = bid; it < nP; it += G) {
    const int part = it % NPART, sh = it / NPART;
    wkv_item<LPRP>(p, smem, sh >> 4, sh & 15, part);
  }
  const int nS = 2048;
  const int first = (bid + G - (nP % G)) % G;
#pragma nounroll
  for (int it = first; it < nS; it += G) wkv_item<4>(p, smem, 8 + (it >> 4), it & 15, 0);
}

DI void ph_wkv_post(const Params& p) {
  const int tid_ = TIDX; const int lane = tid_ & 63;
  const int gw = blockIdx.x * 4 + (tid_ >> 6), nw = gridDim.x * 4;
  const bf16_t* __restrict__ R = (const bf16_t*)(p.ws + SC_R);
  const bf16_t* __restrict__ K = (const bf16_t*)(p.ws + SC_K);
  const bf16_t* __restrict__ V = (const bf16_t*)(p.ws + SC_V);
  const bf16_t* __restrict__ AAc = (const bf16_t*)(p.ws + SC_AA);
  const bf16_t* __restrict__ Gg = (const bf16_t*)(p.ws + SC_G);
  const bf16_t* __restrict__ O = (const bf16_t*)(p.ws + SC_O);
  bf16_t* __restrict__ U = (bf16_t*)(p.ws + W_U);
#pragma unroll 2
  for (int item = gw; item < T_ * 4; item += nw) {
    const int t = item >> 2, col = (item & 3) * 256 + lane * 4;
    const size_t o = (size_t)t * 1024 + col;
    float ov[4], rv[4], kv[4], av[4], vv[4], gv[4];
    unpack4(*(const uint2*)(O + o), ov); unpack4(*(const uint2*)(R + o), rv); unpack4(*(const uint2*)(K + o), kv);
    unpack4(*(const uint2*)(AAc + o), av); unpack4(*(const uint2*)(V + o), vv); unpack4(*(const uint2*)(Gg + o), gv);
    const float4 lw = *(const float4*)(p.in[I_RW_LNW] + col), lb = *(const float4*)(p.in[I_RW_LNB] + col);
    const float4 ka = *(const float4*)(p.in[I_RW_KA] + col), rk = *(const float4*)(p.in[I_RW_RK] + col);
    const float lwv[4] = {lw.x, lw.y, lw.z, lw.w}, lbv[4] = {lb.x, lb.y, lb.z, lb.w};
    const float kav[4] = {ka.x, ka.y, ka.z, ka.w}, rkv[4] = {rk.x, rk.y, rk.z, rk.w};
    const float mean = red_lanes<16>(ov[0] + ov[1] + ov[2] + ov[3]) * (1.f / 64.f);
    float d[4], s2 = 0.f, s3 = 0.f;
#pragma unroll
    for (int e = 0; e < 4; ++e) {
      d[e] = ov[e] - mean; s2 += d[e] * d[e];
      const float kp = kv[e] * (1.f + (av[e] - 1.f) * kav[e]);
      s3 += rv[e] * kp * rkv[e];
    }
    s2 = red_lanes<16>(s2); s3 = red_lanes<16>(s3);
    const float rs = rsqrtf(s2 * (1.f / 64.f) + 64e-5f);
    float y[4];
#pragma unroll
    for (int e = 0; e < 4; ++e) y[e] = (d[e] * rs * lwv[e] + lbv[e] + s3 * vv[e]) * gv[e];
    *(uint2*)(U + o) = make_uint2(pack2(y[0], y[1]), pack2(y[2], y[3]));
  }
}

constexpr int NPH = 40;
#ifndef REP_GEMM
#define REP_GEMM 1
#endif
#ifndef REP_SSD
#define REP_SSD 1
#endif
#ifndef REP_WKV
#define REP_WKV 1
#endif
#ifndef REP_MISC
#define REP_MISC 1
#endif

__global__ void __launch_bounds__(NTHR, 2) mega(Params p) {
  __shared__ __attribute__((aligned(16))) char smem[SMEM_BYTES];
  __shared__ uint4 xb_words;
  cg::grid_group grid = cg::this_grid();
  if (threadIdx.x == 0) xb_words = make_uint4(0u, 0u, 0u, 0u);
  __syncthreads();
  XcdBarrier xb = xcd_barrier_post((unsigned*)(p.ws + W_BAR), (volatile LAS unsigned*)&xb_words);
  int ph = 0;
#define PH(...)                                                     \
  {                                                                 \
    if (ph >= p.ph_begin && ph < p.ph_end) {                        \
      __VA_ARGS__;                                                  \
      xcd_barrier(xb);                                              \
    }                                                               \
    ++ph;                                                           \
  }
#define PHR(rep, ...)                                               \
  {                                                                 \
    if (ph >= p.ph_begin && ph < p.ph_end) {                        \
      for (int rep_ = 0; rep_ < (rep); ++rep_) {                    \
        __VA_ARGS__;                                                \
        xcd_barrier(xb);                                            \
      }                                                             \
    }                                                               \
    ++ph;                                                           \
  }
#define PH_LAST(...)                                                \
  {                                                                 \
    if (ph >= p.ph_begin && ph < p.ph_end) { __VA_ARGS__; }         \
    ++ph;                                                           \
  }
  bf16_t* wt = (bf16_t*)(p.ws + W_WT);
  bf16_t* U = (bf16_t*)(p.ws + W_U);
  float* X = (float*)(p.ws + W_X);

  {
    if (ph >= p.ph_begin && ph < p.ph_end) { ph_prologue(p, smem); grid.sync(); }
    ++ph;
    if (threadIdx.x == 0) {
      unsigned* bar = (unsigned*)(p.ws + W_BAR);
      unsigned base = 0;
      for (unsigned jx = 0; jx < 16; ++jx) { const unsigned c = xb_ld(&bar[XB_XCNT(jx)]); base += (jx < xb.x) ? c : 0u; }
      volatile LAS unsigned* st = (volatile LAS unsigned*)&xb_words;
      st[3] = base + st[2];
    }
    __syncthreads();
  }

#pragma nounroll
  for (int layer = 0; layer < 4; ++layer) {
    const int kind = layer % 3;
    PHR(REP_MISC, ph_rmsnorm(p, kind == 2 ? 1 : 0, p.in[I_NMIX] + layer * 1024));
    if (kind == 0) {
      const int ia = layer / 3;
      PHR(REP_GEMM, {
        GJob j = mkjob(U, 1024, wt + WA_IN + (size_t)ia * 2048 * 1024, 1024, 1024, 2048);
        j.o0 = p.ws + SA_XB; j.o1 = p.ws + SA_GT;
        int toff = 0; gemm_run<EPI_LRU_IN, false>(j, 8, toff, smem, VBLOCK());
      });
      PHR(REP_MISC, (ph_conv<1024, false>((const bf16_t*)(p.ws + SA_XB), (bf16_t*)(p.ws + SA_XC),
                               p.in[I_LRU_CW] + (size_t)ia * 4 * 1024, p.in[I_LRU_CB] + (size_t)ia * 1024,
                               p.in[I_ST_LC] + (size_t)ia * 128 * 3 * 1024,
                               p.out + O_LC_P + (size_t)ia * 8 * 3 * 1024, p.out + O_LC_S + (size_t)ia * 128 * 3 * 1024)));
      PHR(REP_GEMM, {
        const int G = gridDim.x;
        for (int tile = VBLOCK(); tile < MT_ * 8; tile += G) {
          const int mt = tile >> 3, jt = tile & 7;
          GJob j = mkjob((const bf16_t*)(p.ws + SA_XC) + jt * 128, 1024,
                         wt + WA_G + (size_t)ia * 2048 * 128, 128, 128, 2048);
          j.o0 = p.ws + SA_AA; j.o1 = p.ws + SA_XC;
          j.x0 = p.in[I_LRU_BR] + ia * 1024; j.x1 = p.in[I_LRU_BI] + ia * 1024; j.x2 = p.in[I_LRU_LAM] + ia * 1024;
          gemm_tile_dma<EPI_GATES>(j, mt * 128, jt * 256, 0, 4, smem);
        }
      });
      PHR(REP_MISC, ph_lru_scan1(p));
      PH(ph_lru_scan2(p, ia));
      PH({
        GJob j = mkjob((const bf16_t*)(p.ws + SA_GT), 1024, wt + WA_OUT + (size_t)ia * 1024 * 1024, 1024, 1024, 1024);
        j.o0 = X;
        gemm_streamk<EPI_RESID>(j, 4, smem, VBLOCK(), (unsigned*)(p.ws + W_BAR) + 4096, (unsigned)(layer * 2 + 1));
      });
    } else if (kind == 1) {
      PHR(REP_GEMM, {
        GJob j = mkjob(U, 1024, wt + WB_XBC, 1024, 1024, 4128);
        j.o0 = p.ws + SB_XBCP; j.o1 = p.ws + SB_DT; j.x0 = p.in[I_SSM_DTB];
        int toff = 0; gemm_run<EPI_SSM_XBC, false>(j, 17, toff, smem, VBLOCK());
      });
      PHR(REP_MISC, (ph_conv<4096, true>((const bf16_t*)(p.ws + SB_XBCP), (bf16_t*)(p.ws + SB_XBC),
                              p.in[I_SSM_CW], p.in[I_SSM_CB], p.in[I_ST_SC],
                              p.out + O_SC_P, p.out + O_SC_S)));
      PHR(REP_SSD, ph_ssd(p, smem));
      PH({
        GJob j = mkjob(U, 1024, wt + WB_Z, 1024, 1024, 2048);
        j.o0 = p.ws + SB_Y;
        int toff = 0; gemm_run<EPI_SSM_Z, false>(j, 8, toff, smem, VBLOCK());
      });
      PH(ph_gnorm(p));
      PH({
        GJob j = mkjob((const bf16_t*)(p.ws + SB_Y), 2048, wt + WB_OUT, 2048, 2048, 1024);
        j.o0 = X;
        gemm_streamk<EPI_RESID>(j, 4, smem, VBLOCK(), (unsigned*)(p.ws + W_BAR) + 4096, (unsigned)(layer * 2 + 1));
      });
    } else {
      PHR(REP_GEMM, {
        int toff = 0;
        for (int s = 0; s < 3; ++s) {
          GJob j = mkjob(U, 1024, wt + WC_RKV + (size_t)s * 1024 * 1024, 1024, 1024, 1024);
          j.A2 = (const bf16_t*)(p.ws + SC_UP); j.mu = p.in[I_RW_MU] + s * 1024;
          j.o0 = p.ws + SC_R + (size_t)s * SZ_TD2; j.ldo = 1024; j.act = 0;
          gemm_run<EPI_ST, true>(j, 8, toff, smem, VBLOCK());
        }
        for (int s = 0; s < 3; ++s) {
          const int nv = (s == 2) ? 128 : 64;
          GJob j = mkjob(U, 1024, wt + WC_L1 + (size_t)s * 64 * 1024, 1024, 1024, nv);
          j.A2 = (const bf16_t*)(p.ws + SC_UP); j.mu = p.in[I_RW_MU] + (3 + s) * 1024;
          j.o0 = p.ws + SC_LH + (size_t)s * 64 * 2; j.ldo = 256; j.act = (s == 0) ? 1 : (s == 2 ? 2 : 0);
          gemm_run<EPI_ST, true>(j, 1, toff, smem, VBLOCK());
        }
      });
      PHR(REP_GEMM, {
        int toff = 0;
        const bf16_t* LH = (const bf16_t*)(p.ws + SC_LH);
        {
          GJob j = mkjob(LH, 256, wt + WC_W2, 64, 64, 1024);
          j.o0 = p.ws + SC_WD; j.x0 = p.in[I_RW_W0];
          gemm_run<EPI_DECAY, false>(j, 4, toff, smem, VBLOCK());
        }
        {
          GJob j = mkjob(LH + 64, 256, wt + WC_A2, 64, 64, 1024);
          j.o0 = p.ws + SC_AA; j.x0 = p.in[I_RW_A0];
          gemm_run<EPI_SIGB, false>(j, 4, toff, smem, VBLOCK());
        }
        {
          GJob j = mkjob(LH + 128, 256, wt + WC_G2, 128, 128, 1024);
          j.o0 = p.ws + SC_G; j.ldo = 1024; j.act = 0;
          gemm_run<EPI_ST, false>(j, 4, toff, smem, VBLOCK());
        }
      });
      PHR(REP_WKV, ph_wkv<8>(p, smem));
      PHR(REP_MISC, ph_wkv_post(p));
      PH({
        GJob j = mkjob(U, 1024, wt + WC_OUT, 1024, 1024, 1024);
        j.o0 = X;
        gemm_streamk<EPI_RESID>(j, 4, smem, VBLOCK(), (unsigned*)(p.ws + W_BAR) + 4096, (unsigned)(layer * 2 + 1));
      });
    }
    PHR(REP_MISC, ph_rmsnorm(p, 0, p.in[I_NFFN] + layer * 1024));
    PHR(REP_GEMM, {
      GJob j = mkjob(U, 1024, wt + WF_1 + (size_t)layer * 4096 * 1024, 1024, 1024, 4096);
      j.o0 = p.ws + S_HB;
      int toff = 0; gemm_run<EPI_FFN1, false>(j, 16, toff, smem, VBLOCK());
    });
    PH({
      GJob j = mkjob((const bf16_t*)(p.ws + S_HB), 4096, wt + WF_2 + (size_t)layer * 4096 * 1024, 4096, 4096, 1024);
      j.o0 = X;
      gemm_streamk<EPI_RESID>(j, 4, smem, VBLOCK(), (unsigned*)(p.ws + W_BAR) + 4096, (unsigned)(layer * 2 + 2));
    });
  }
  PH_LAST(ph_rmsnorm(p, 2, p.in[I_NFIN]));
#undef PH
#undef PH_LAST
}

extern "C" void kernel_launch(void* const* d_in, const int* in_sizes, int n_in, void* d_out, int out_size,
                              void* d_ws, size_t ws_size, hipStream_t stream) {
  Params p;
  memset(&p, 0, sizeof(p));
  for (int i = 0; i < N_IN; ++i) p.in[i] = (const float*)d_in[i];
  p.out = (float*)d_out;
  p.ws = (char*)d_ws;
  p.ph_begin = 0;
  p.ph_end = 1000;
  static int grid_blocks = 0;
  if (!grid_blocks) {
    int dev = 0, cus = 0, per_cu = 0;
    hipGetDevice(&dev);
    hipDeviceGetAttribute(&cus, hipDeviceAttributeMultiprocessorCount, dev);
    hipOccupancyMaxActiveBlocksPerMultiprocessor(&per_cu, mega, NTHR, 0);
    if (per_cu > 2) per_cu = 2;
    if (per_cu < 1) per_cu = 1;
    grid_blocks = cus * per_cu;
  }
  if (ws_size < (size_t)536870912) fprintf(stderr, "workspace too small: %zu\n", ws_size);
  (void)hipMemsetAsync((char*)d_ws + W_BAR, 0, (4096 + 1024) * 4, stream);
  void* args[] = {&p};
  hipError_t e = hipLaunchCooperativeKernel((void*)mega, dim3(grid_blocks), dim3(NTHR), args, 0, stream);
  if (e != hipSuccess) fprintf(stderr, "cooperative launch failed: %s (grid %d)\n", hipGetErrorString(e), grid_blocks);
}
```

```cpp
#include <hip/hip_runtime.h>
#include <hip/hip_cooperative_groups.h>
#include <stdint.h>
#include <stdio.h>
#include <string.h>
namespace cg = cooperative_groups;

typedef unsigned short bf16_t;
typedef __attribute__((ext_vector_type(8))) short bf16x8;
typedef __attribute__((ext_vector_type(16))) float f32x16;

#define DI __device__ __forceinline__

constexpr int T_ = 17408;
constexpr int TP_ = 16384;
constexpr int NTHR = 256;
constexpr int MT_ = T_ / 128;

enum {
  I_XP = 0, I_XS, I_ST_LC, I_ST_LH, I_ST_SC, I_ST_SS, I_ST_RS, I_ST_RW,
  I_NMIX, I_NFFN, I_NFIN,
  I_LRU_WIN, I_LRU_CW, I_LRU_CB, I_LRU_WR, I_LRU_BR, I_LRU_WI, I_LRU_BI, I_LRU_LAM, I_LRU_WOUT,
  I_SSM_WIN, I_SSM_CW, I_SSM_CB, I_SSM_DTB, I_SSM_ALOG, I_SSM_D, I_SSM_NW, I_SSM_WOUT,
  I_RW_MU, I_RW_WRKV, I_RW_W0, I_RW_WW1, I_RW_WW2, I_RW_A0, I_RW_WA1, I_RW_WA2, I_RW_WG1, I_RW_WG2,
  I_RW_KK, I_RW_KA, I_RW_RK, I_RW_LNW, I_RW_LNB, I_RW_WOUT,
  I_FFN_W1, I_FFN_W2, N_IN
};

constexpr size_t O_Y = 0;
constexpr size_t O_LC_P = O_Y + (size_t)T_ * 1024;
constexpr size_t O_LC_S = O_LC_P + 2 * 8 * 3 * 1024;
constexpr size_t O_LH_P = O_LC_S + 2 * 128 * 3 * 1024;
constexpr size_t O_LH_S = O_LH_P + 2 * 8 * 1024;
constexpr size_t O_SC_P = O_LH_S + 2 * 128 * 1024;
constexpr size_t O_SC_S = O_SC_P + 8 * 3 * 4096;
constexpr size_t O_SS_P = O_SC_S + 128 * 3 * 4096;
constexpr size_t O_SS_S = O_SS_P + (size_t)8 * 32 * 64 * 128;
constexpr size_t O_RS_P = O_SS_S + (size_t)128 * 32 * 64 * 128;
constexpr size_t O_RS_S = O_RS_P + 8 * 1024;
constexpr size_t O_RW_P = O_RS_S + 128 * 1024;
constexpr size_t O_RW_S = O_RW_P + 8 * 16 * 64 * 64;

constexpr size_t W_X = 0;
constexpr size_t W_U = W_X + (size_t)T_ * 1024 * 4;
constexpr size_t W_WT = W_U + (size_t)T_ * 1024 * 2;
constexpr size_t WA_IN = 0;
constexpr size_t WA_G = WA_IN + 2 * 2048 * 1024;
constexpr size_t WA_OUT = WA_G + 2 * 2048 * 128;
constexpr size_t WB_XBC = WA_OUT + 2 * 1024 * 1024;
constexpr size_t WB_Z = WB_XBC + 4128 * 1024;
constexpr size_t WB_OUT = WB_Z + 2048 * 1024;
constexpr size_t WC_RKV = WB_OUT + 1024 * 2048;
constexpr size_t WC_L1 = WC_RKV + 3 * 1024 * 1024;
constexpr size_t WC_W2 = WC_L1 + 256 * 1024;
constexpr size_t WC_A2 = WC_W2 + 1024 * 64;
constexpr size_t WC_G2 = WC_A2 + 1024 * 64;
constexpr size_t WC_OUT = WC_G2 + 1024 * 128;
constexpr size_t WF_1 = WC_OUT + 1024 * 1024;
constexpr size_t WF_2 = WF_1 + (size_t)4 * 4096 * 1024;
constexpr size_t W_WT_ELEMS = WF_2 + (size_t)4 * 4096 * 1024;
constexpr size_t W_S = W_WT + W_WT_ELEMS * 2;
constexpr size_t SZ_TD2 = (size_t)T_ * 1024 * 2;
constexpr size_t SZ_TD4 = (size_t)T_ * 1024 * 4;
constexpr size_t S_HB = W_S;
constexpr size_t SA_XB = W_S;
constexpr size_t SA_GT = SA_XB + SZ_TD2;
constexpr size_t SA_XC = SA_GT + SZ_TD2;
constexpr size_t SA_AA = SA_XC + SZ_TD2;
constexpr size_t SA_BB = SA_AA + SZ_TD4;
constexpr size_t SA_CP = SA_BB + SZ_TD4;
constexpr size_t SA_CS = SA_CP + 8 * 64 * 1024 * 4;
constexpr size_t SB_XBCP = W_S;
constexpr size_t SB_Y = W_S;
constexpr size_t SB_XBC = SB_XBCP + SZ_TD2 * 4;
constexpr size_t SB_DT = SB_XBC + SZ_TD2 * 4;
constexpr size_t SC_UP = W_S;
constexpr size_t SC_O = W_S;
constexpr size_t SC_R = SC_UP + SZ_TD2;
constexpr size_t SC_K = SC_R + SZ_TD2;
constexpr size_t SC_V = SC_K + SZ_TD2;
constexpr size_t SC_LH = SC_V + SZ_TD2;
constexpr size_t SC_WD = SC_LH + (size_t)T_ * 256 * 2;
constexpr size_t SC_AA = SC_WD + SZ_TD4;
constexpr size_t SC_G = SC_AA + SZ_TD2;
constexpr size_t SC_END = SC_G + SZ_TD2;
static_assert(SC_END <= (size_t)536870912, "ws overflow C");
static_assert(SB_DT + (size_t)T_ * 32 * 4 <= (size_t)536870912, "ws overflow B");
static_assert(SA_CS + 8 * 64 * 1024 * 4 <= (size_t)536870912, "ws overflow A");

constexpr int SMEM_BYTES = 80384;
constexpr size_t W_BAR = (size_t)536870912 - 65536;

struct Params {
  const float* in[N_IN];
  float* out;
  char* ws;
  int ph_begin, ph_end;
};

DI float bf2f(bf16_t h) { return __uint_as_float(((unsigned)h) << 16); }
DI bf16_t f2bf(float f) {
  unsigned u = __float_as_uint(f);
  u += 0x7FFFu + ((u >> 16) & 1u);
  return (bf16_t)(u >> 16);
}
DI unsigned pack2(float a, float b) { return (unsigned)f2bf(a) | ((unsigned)f2bf(b) << 16); }
DI void unpack8(const uint4 v, float (&f)[8]) {
  f[0] = __uint_as_float(v.x << 16); f[1] = __uint_as_float(v.x & 0xFFFF0000u);
  f[2] = __uint_as_float(v.y << 16); f[3] = __uint_as_float(v.y & 0xFFFF0000u);
  f[4] = __uint_as_float(v.z << 16); f[5] = __uint_as_float(v.z & 0xFFFF0000u);
  f[6] = __uint_as_float(v.w << 16); f[7] = __uint_as_float(v.w & 0xFFFF0000u);
}
DI void unpack4(const uint2 v, float (&f)[4]) {
  f[0] = __uint_as_float(v.x << 16); f[1] = __uint_as_float(v.x & 0xFFFF0000u);
  f[2] = __uint_as_float(v.y << 16); f[3] = __uint_as_float(v.y & 0xFFFF0000u);
}
DI uint4 pack8(const float (&f)[8]) {
  return make_uint4(pack2(f[0], f[1]), pack2(f[2], f[3]), pack2(f[4], f[5]), pack2(f[6], f[7]));
}
DI void load8f(const float* p, float (&f)[8]) {
  float4 a = *(const float4*)p, b = *(const float4*)(p + 4);
  f[0] = a.x; f[1] = a.y; f[2] = a.z; f[3] = a.w; f[4] = b.x; f[5] = b.y; f[6] = b.z; f[7] = b.w;
}
DI void store8f(float* p, const float (&f)[8]) {
  *(float4*)p = make_float4(f[0], f[1], f[2], f[3]);
  *(float4*)(p + 4) = make_float4(f[4], f[5], f[6], f[7]);
}
DI float sigmoidf_(float x) { return 1.f / (1.f + __expf(-x)); }
DI float siluf_(float x) { return x / (1.f + __expf(-x)); }
DI float tanhf_(float y) { return 1.f - 2.f / (1.f + __expf(2.f * y)); }
DI float geluf_(float x) { return 0.5f * x * (1.f + tanhf_(0.7978845608028654f * (x + 0.044715f * x * x * x))); }
DI float softplusf_(float x) { return fmaxf(x, 0.f) + log1pf(__expf(-fabsf(x))); }
DI float softplus_fast(float x) { return fmaxf(x, 0.f) + __logf(1.f + __expf(-fabsf(x))); }
DI float wave_sum(float v) {
#pragma unroll
  for (int o = 32; o >= 1; o >>= 1) v += __shfl_xor(v, o, 64);
  return v;
}
template <int CTRL> DI float dppf(float x) {
  return __int_as_float(__builtin_amdgcn_update_dpp(0, __float_as_int(x), CTRL, 0xf, 0xf, false));
}
template <int N> DI float red_lanes(float x) {
  x += dppf<0xB1>(x);
  x += dppf<0x4E>(x);
  if (N >= 8) x += dppf<0x141>(x);
  if (N >= 16) x += dppf<0x140>(x);
  return x;
}
DI void tok_info(int t, int& seq, int& l, int& L) {
  if (t < TP_) { seq = t >> 11; l = t & 2047; L = 2048; }
  else { int u = t - TP_; seq = 8 + (u >> 3); l = u & 7; L = 8; }
}
DI int opq(int x) { asm volatile("" : "+v"(x)); return x; }
#define TIDX opq((int)threadIdx.x)
DI f32x16 mfma32(bf16x8 a, bf16x8 b, f32x16 c) { return __builtin_amdgcn_mfma_f32_32x32x16_bf16(a, b, c, 0, 0, 0); }


#define XB_TMO      128
#define XB_XCNT(j)  (256  + 64 * (j))
#define XB_XSUB(j)  (1280 + 64 * (j))
#define XB_XGEN(j)  (2304 + 64 * (j))
#define XB_TOP      3328
#define XB_TOPGEN   3392
#define XCD_BAR_WORDS 3456
#define XB_SPIN_CAP (1u << 22)
#define LAS __attribute__((address_space(3)))
DI unsigned xb_ld(unsigned* p) { return __hip_atomic_load(p, __ATOMIC_RELAXED, __HIP_MEMORY_SCOPE_AGENT); }
DI unsigned xb_add(unsigned* p, unsigned v) { return __hip_atomic_fetch_add(p, v, __ATOMIC_RELAXED, __HIP_MEMORY_SCOPE_AGENT); }
DI unsigned xb_xcc_id() { return (unsigned)__builtin_amdgcn_s_getreg((3 << 11) | 20) & 0xFu; }
#define XB_SPIN(cond, bar) do { unsigned _sp = 0; while (cond) { __builtin_amdgcn_s_sleep(1); \
    if ((++_sp & 255u) == 0u) { if (xb_ld(&(bar)[XB_TMO])) break; if (_sp > XB_SPIN_CAP) { atomicAdd(&(bar)[XB_TMO], 1u); break; } } } } while (0)
struct XcdBarrier { unsigned* bar; unsigned x; volatile LAS unsigned* st; };
DI XcdBarrier xcd_barrier_post(unsigned* bar, volatile LAS unsigned* st) {
  XcdBarrier b; b.bar = bar; b.x = xb_xcc_id(); b.st = st;
  if (threadIdx.x == 0) st[2] = xb_add(&bar[XB_XCNT(b.x)], 1u);
  return b;
}
DI void xcd_barrier_complete(unsigned* bar, unsigned x, unsigned& nloc, unsigned& nx) {
  const unsigned G = gridDim.x * gridDim.y * gridDim.z;
  unsigned sum, cnt, mine, sp = 0u;
  for (;;) {
    sum = 0u; cnt = 0u; mine = 0u;
#pragma unroll
    for (unsigned j = 0; j < 16; ++j) { const unsigned c = xb_ld(&bar[XB_XCNT(j)]); sum += c; cnt += (c > 0u) ? 1u : 0u; mine = (j == x) ? c : mine; }
    if (sum == G) break;
    __builtin_amdgcn_s_sleep(1);
    if ((++sp & 255u) == 0u) { if (xb_ld(&bar[XB_TMO])) break; if (sp > XB_SPIN_CAP) { atomicAdd(&bar[XB_TMO], 1u); break; } }
  }
  nloc = mine > 0u ? mine : 1u; nx = cnt > 0u ? cnt : 1u;
}
DI void xcd_barrier(const XcdBarrier& b) {
  asm volatile("s_waitcnt vmcnt(0)" ::: "memory");
  __syncthreads();
  if (threadIdx.x == 0) {
    unsigned* bar = b.bar;
    __builtin_amdgcn_s_waitcnt(0);
    unsigned nloc = b.st[0], nx = b.st[1];
    if (nloc == 0u) { xcd_barrier_complete(bar, b.x, nloc, nx); b.st[0] = nloc; b.st[1] = nx; }
    const unsigned old = xb_add(&bar[XB_XSUB(b.x)], 1u);
    const unsigned gen = old / nloc;
    if (old + 1u == (gen + 1u) * nloc) {
      __builtin_amdgcn_fence(__ATOMIC_RELEASE, "agent");
      asm volatile("s_waitcnt vmcnt(0)" ::: "memory");
      const unsigned og = xb_add(&bar[XB_TOP], 1u);
      const unsigned tg = og / nx;
      if (og + 1u == (tg + 1u) * nx) xb_add(&bar[XB_TOPGEN], 1u);
      else XB_SPIN(xb_ld(&bar[XB_TOPGEN]) == tg, bar);
      __builtin_amdgcn_fence(__ATOMIC_ACQUIRE, "agent");
      xb_add(&bar[XB_XGEN(b.x)], 1u);
      asm volatile("s_waitcnt vmcnt(0)" ::: "memory");
    } else {
      XB_SPIN(xb_ld(&bar[XB_XGEN(b.x)]) == gen, bar);
      __builtin_amdgcn_fence(__ATOMIC_ACQUIRE, "agent");
      asm volatile("s_waitcnt vmcnt(0)" ::: "memory");
    }
  }
  __syncthreads();
}

struct GJob {
  const bf16_t* A; const bf16_t* A2; const float* mu; const bf16_t* Bt;
  int lda, ldb, K, nvalid;
  void* o0; void* o1; const float* x0; const float* x1; const float* x2;
  int ldo, act;
};
enum { EPI_LRU_IN = 0, EPI_GATES, EPI_RESID, EPI_SSM_XBC, EPI_SSM_Z, EPI_FFN1, EPI_ST, EPI_DECAY, EPI_SIGB };

template <int EPI> DI void epi_elem(const GJob& j, int row, int col, float v) {
  if (EPI == EPI_LRU_IN) {
    if (col < 1024) ((bf16_t*)j.o0)[(size_t)row * 1024 + col] = f2bf(v);
    else ((bf16_t*)j.o1)[(size_t)row * 1024 + col - 1024] = f2bf(geluf_(v));
  } else if (EPI == EPI_RESID) {
    unsafeAtomicAdd((float*)j.o0 + (size_t)row * 1024 + col, v);
  } else if (EPI == EPI_SSM_XBC) {
    if (col < 4096) ((bf16_t*)j.o0)[(size_t)row * 4096 + col] = f2bf(v);
  } else if (EPI == EPI_SSM_Z) {
    bf16_t* y = (bf16_t*)j.o0 + (size_t)row * 2048 + col;
    *y = f2bf(bf2f(*y) * siluf_(v));
  } else if (EPI == EPI_FFN1) {
    float r = fmaxf(v, 0.f);
    ((bf16_t*)j.o0)[(size_t)row * 4096 + col] = f2bf(r * r);
  } else if (EPI == EPI_ST) {
    if (col < j.nvalid) {
      float r = v;
      if (j.act == 1) r = tanhf_(v); else if (j.act == 2) r = sigmoidf_(v);
      ((bf16_t*)j.o0)[(size_t)row * j.ldo + col] = f2bf(r);
    }
  } else if (EPI == EPI_DECAY) {
    float wl = -softplusf_(-(j.x0[col] + v)) - 0.5f;
    ((float*)j.o0)[(size_t)row * 1024 + col] = __expf(-__expf(wl));
  } else if (EPI == EPI_SIGB) {
    ((bf16_t*)j.o0)[(size_t)row * 1024 + col] = f2bf(sigmoidf_(j.x0[col] + v));
  }
}

DI void quad_transpose4(float (&v)[4], int l) {
  const bool o1 = l & 1, o2 = l & 2;
  {
    const float s01 = o1 ? v[0] : v[1], s23 = o1 ? v[2] : v[3];
    const float r01 = dppf<0xB1>(s01), r23 = dppf<0xB1>(s23);
    if (o1) { v[0] = r01; v[2] = r23; } else { v[1] = r01; v[3] = r23; }
  }
  {
    const float s02 = o2 ? v[0] : v[2], s13 = o2 ? v[1] : v[3];
    const float r02 = dppf<0x4E>(s02), r13 = dppf<0x4E>(s13);
    if (o2) { v[0] = r02; v[1] = r13; } else { v[2] = r02; v[3] = r13; }
  }
}
DI uint2 pack4(float a, float b, float c, float d) { return make_uint2(pack2(a, b), pack2(c, d)); }
template <int EPI> DI void epi4(const GJob& j, int row, int col, const float (&v)[4]) {
  if (EPI == EPI_LRU_IN) {
    if (col < 1024) *(uint2*)((bf16_t*)j.o0 + (size_t)row * 1024 + col) = pack4(v[0], v[1], v[2], v[3]);
    else *(uint2*)((bf16_t*)j.o1 + (size_t)row * 1024 + col - 1024) = pack4(geluf_(v[0]), geluf_(v[1]), geluf_(v[2]), geluf_(v[3]));
  } else if (EPI == EPI_RESID) {
    float4* x = (float4*)((float*)j.o0 + (size_t)row * 1024 + col);
    float4 t = *x; t.x += v[0]; t.y += v[1]; t.z += v[2]; t.w += v[3]; *x = t;
  } else if (EPI == EPI_SSM_XBC) {
    if (col < 4096) *(uint2*)((bf16_t*)j.o0 + (size_t)row * 4096 + col) = pack4(v[0], v[1], v[2], v[3]);
  } else if (EPI == EPI_SSM_Z) {
    uint2* y = (uint2*)((bf16_t*)j.o0 + (size_t)row * 2048 + col);
    float f[4]; unpack4(*y, f);
    *y = pack4(f[0] * siluf_(v[0]), f[1] * siluf_(v[1]), f[2] * siluf_(v[2]), f[3] * siluf_(v[3]));
  } else if (EPI == EPI_FFN1) {
    const float r0 = fmaxf(v[0], 0.f), r1 = fmaxf(v[1], 0.f), r2 = fmaxf(v[2], 0.f), r3 = fmaxf(v[3], 0.f);
    *(uint2*)((bf16_t*)j.o0 + (size_t)row * 4096 + col) = pack4(r0 * r0, r1 * r1, r2 * r2, r3 * r3);
  } else if (EPI == EPI_ST) {
    if (col < j.nvalid) {
      float r[4];
#pragma unroll
      for (int e = 0; e < 4; ++e) r[e] = (j.act == 1) ? tanhf_(v[e]) : ((j.act == 2) ? sigmoidf_(v[e]) : v[e]);
      *(uint2*)((bf16_t*)j.o0 + (size_t)row * j.ldo + col) = pack4(r[0], r[1], r[2], r[3]);
    }
  } else if (EPI == EPI_DECAY) {
    const float4 w0 = *(const float4*)(j.x0 + col);
    const float w[4] = {w0.x, w0.y, w0.z, w0.w};
    float r[4];
#pragma unroll
    for (int e = 0; e < 4; ++e) r[e] = __expf(-__expf(-softplus_fast(-(w[e] + v[e])) - 0.5f));
    *(float4*)((float*)j.o0 + (size_t)row * 1024 + col) = make_float4(r[0], r[1], r[2], r[3]);
  } else if (EPI == EPI_SIGB) {
    const float4 a0 = *(const float4*)(j.x0 + col);
    *(uint2*)((bf16_t*)j.o0 + (size_t)row * 1024 + col) =
        pack4(sigmoidf_(a0.x + v[0]), sigmoidf_(a0.y + v[1]), sigmoidf_(a0.z + v[2]), sigmoidf_(a0.w + v[3]));
  }
}

template <int EPI, bool MIX>
DI void gemm_tile(const GJob& j, int m0, int n0, int kt0, int kt1, char* smem) {
  const int tid = TIDX, lane = tid & 63, w = tid >> 6;
  const int wm = w >> 1, wn = w & 1, r32 = lane & 31, hh = lane >> 5;
  const int lrow = tid >> 3, kc = tid & 7;
  f32x16 acc[2][2];
#pragma unroll
  for (int a = 0; a < 2; ++a)
#pragma unroll
    for (int b = 0; b < 2; ++b)
#pragma unroll
      for (int r = 0; r < 16; ++r) acc[a][b][r] = 0.f;
  uint4 qa00, qa01, qa02, qa03, qb00, qb01, qb02, qb03, qc00, qc01, qc02, qc03;
  uint4 qa10, qa11, qa12, qa13, qb10, qb11, qb12, qb13, qc10, qc11, qc12, qc13;
  qc00 = qc01 = qc02 = qc03 = qc10 = qc11 = qc12 = qc13 = make_uint4(0, 0, 0, 0);
  const int nk = kt1 - kt0;
  const bf16_t* Ap = j.A + (size_t)(m0 + lrow) * j.lda + kc * 8 + (size_t)kt0 * 64;
  const bf16_t* A2p = MIX ? (j.A2 + (size_t)(m0 + lrow) * j.lda + kc * 8 + (size_t)kt0 * 64) : nullptr;
  const bf16_t* Bp = j.Bt + (size_t)(n0 + lrow) * j.ldb + kc * 8 + (size_t)kt0 * 64;
  const size_t astep = (size_t)32 * j.lda, bstep = (size_t)32 * j.ldb;
  const bool bv0 = (n0 + lrow) < j.nvalid, bv1 = (n0 + lrow + 32) < j.nvalid;
  const bool bv2 = (n0 + lrow + 64) < j.nvalid, bv3 = (n0 + lrow + 96) < j.nvalid;
  const uint4 z4 = make_uint4(0, 0, 0, 0);

#define LD1(s, i, kt)                                                                 \
  qa##s##i = *(const uint4*)(Ap + i * astep + (kt) * 64);                             \
  if (MIX) qc##s##i = *(const uint4*)(A2p + i * astep + (kt) * 64);                   \
  qb##s##i = z4;                                                                      \
  if (bv##i) qb##s##i = *(const uint4*)(Bp + i * bstep + (kt) * 64);
#define GLOAD(s, kt) { LD1(s, 0, kt) LD1(s, 1, kt) LD1(s, 2, kt) LD1(s, 3, kt) }
#define ST1(s, i, As_, Bs_)                                                           \
  if (MIX) {                                                                          \
    float f1[8], f2[8]; unpack8(qa##s##i, f1); unpack8(qc##s##i, f2);                 \
    _Pragma("unroll") for (int e = 0; e < 8; ++e) f1[e] = f1[e] + (f2[e] - f1[e]) * mu8[e]; \
    qa##s##i = pack8(f1);                                                             \
  }                                                                                   \
  *(uint4*)(As_ + (lrow + 32 * i) * 144 + kc * 16) = qa##s##i;                        \
  *(uint4*)(Bs_ + (lrow + 32 * i) * 144 + kc * 16) = qb##s##i;
#define SSTORE(s, kt, buf)                                                            \
  {                                                                                   \
    char* As_ = smem + (buf) * 36864; char* Bs_ = As_ + 18432;                        \
    float mu8[8];                                                                     \
    if (MIX) load8f(j.mu + (kt0 + (kt)) * 64 + kc * 8, mu8);                          \
    ST1(s, 0, As_, Bs_) ST1(s, 1, As_, Bs_) ST1(s, 2, As_, Bs_) ST1(s, 3, As_, Bs_)   \
  }
#define LOADF(F, ks)                                                                  \
  bf16x8 F##a0 = *(const bf16x8*)(ap + (ks) * 32);                                    \
  bf16x8 F##a1 = *(const bf16x8*)(ap + 32 * 144 + (ks) * 32);                         \
  bf16x8 F##b0 = *(const bf16x8*)(bp + (ks) * 32);                                    \
  bf16x8 F##b1 = *(const bf16x8*)(bp + 32 * 144 + (ks) * 32);
#define MFMA4(F)                                                                      \
  acc[0][0] = mfma32(F##a0, F##b0, acc[0][0]);                                        \
  acc[0][1] = mfma32(F##a0, F##b1, acc[0][1]);                                        \
  acc[1][0] = mfma32(F##a1, F##b0, acc[1][0]);                                        \
  acc[1][1] = mfma32(F##a1, F##b1, acc[1][1]);
#define COMPUTE(buf)                                                                  \
  {                                                                                   \
    const char* As_ = smem + (buf) * 36864; const char* Bs_ = As_ + 18432;            \
    const char* ap = As_ + (wm * 64 + r32) * 144 + hh * 16;                           \
    const char* bp = Bs_ + (wn * 64 + r32) * 144 + hh * 16;                           \
    LOADF(f0, 0) LOADF(f1, 1)                                                         \
    __builtin_amdgcn_sched_barrier(0);                                                \
    MFMA4(f0)                                                                         \
    LOADF(f2, 2)                                                                      \
    __builtin_amdgcn_sched_barrier(0);                                                \
    MFMA4(f1)                                                                         \
    LOADF(f3, 3)                                                                      \
    __builtin_amdgcn_sched_barrier(0);                                                \
    MFMA4(f2)                                                                         \
    __builtin_amdgcn_sched_barrier(0);                                                \
    MFMA4(f3)                                                                         \
    __builtin_amdgcn_sched_barrier(0);                                                \
  }

  qa10 = qa11 = qa12 = qa13 = qb10 = qb11 = qb12 = qb13 = z4;
  if (MIX) {
    GLOAD(0, 0);
    SSTORE(0, 0, 0);
    __syncthreads();
    for (int i = 0; i < nk; ++i) {
      if (i + 1 < nk) GLOAD(0, i + 1);
      if (i & 1) { COMPUTE(1); } else { COMPUTE(0); }
      if (i + 1 < nk) { if (i & 1) { SSTORE(0, i + 1, 0); } else { SSTORE(0, i + 1, 1); } }
      __syncthreads();
    }
  } else if (nk == 1) {
    GLOAD(0, 0);
    SSTORE(0, 0, 0);
    __syncthreads();
    COMPUTE(0);
    __syncthreads();
  } else {
    GLOAD(0, 0);
    GLOAD(1, 1);
    SSTORE(0, 0, 0);
    __syncthreads();
#pragma unroll 1
    for (int i = 0; i + 2 < nk; i += 2) {
      GLOAD(0, i + 2);
      COMPUTE(0);
      SSTORE(1, i + 1, 1);
      __syncthreads();
      GLOAD(1, i + 3);
      COMPUTE(1);
      SSTORE(0, i + 2, 0);
      __syncthreads();
    }
    COMPUTE(0);
    SSTORE(1, nk - 1, 1);
    __syncthreads();
    COMPUTE(1);
    __syncthreads();
  }
#undef LD1
#undef ST1
#undef LOADF
#undef MFMA4
#undef GLOAD
#undef SSTORE
#undef COMPUTE

  if (EPI == EPI_GATES) {
    const int ch = (n0 >> 7) * 64 + wn * 32 + r32;
    const float br = j.x0[ch], bi = j.x1[ch];
    const float spl = softplusf_(-j.x2[ch]);
    const bf16_t* XC = (const bf16_t*)j.o1;
    float* AA = (float*)j.o0;
    float* BBp = AA + (size_t)T_ * 1024;
#pragma unroll
    for (int mi = 0; mi < 2; ++mi)
#pragma unroll
      for (int r = 0; r < 16; ++r) {
        const int row = m0 + wm * 64 + mi * 32 + (r & 3) + 8 * (r >> 2) + 4 * hh;
        const float rg = sigmoidf_(acc[mi][0][r] + br);
        const float ig = sigmoidf_(acc[mi][1][r] + bi);
        const float la = -8.f * rg * spl;
        const float xc = bf2f(XC[(size_t)row * 1024 + ch]);
        const bool reset = (row < TP_) && ((row & 2047) == 0);
        const float a = reset ? 0.f : __expf(la);
        const float mult = reset ? 1.f : sqrtf(fmaxf(-expm1f(2.f * la), 0.f));
        AA[(size_t)row * 1024 + ch] = a;
        BBp[(size_t)row * 1024 + ch] = mult * ig * xc;
      }
  } else {
#pragma unroll
    for (int mi = 0; mi < 2; ++mi)
#pragma unroll
      for (int ni = 0; ni < 2; ++ni)
#pragma unroll
        for (int r = 0; r < 16; ++r) {
          const int row = m0 + wm * 64 + mi * 32 + (r & 3) + 8 * (r >> 2) + 4 * hh;
          const int col = n0 + wn * 64 + ni * 32 + r32;
          epi_elem<EPI>(j, row, col, acc[mi][ni][r]);
          if ((r & 7) == 7) __builtin_amdgcn_sched_barrier(0);
        }
  }
}

constexpr int DSLOT = 24576;
template <int EPI>
DI void gemm_tile_dma(const GJob& j, int m0, int n0, int k0, int k1, char* smem, unsigned* wflag = nullptr, unsigned epoch = 0u) {
  const int tid = TIDX, lane = tid & 63, w = tid >> 6;
  const int wm = w >> 1, wn = w & 1, r32 = lane & 31, hh = lane >> 5;
  f32x16 acc[2][4];
#pragma unroll
  for (int a = 0; a < 2; ++a)
#pragma unroll
    for (int b = 0; b < 4; ++b)
#pragma unroll
      for (int r = 0; r < 16; ++r) acc[a][b][r] = 0.f;
  const int nk = k1 - k0;
  const int dr = lane >> 2;
  const int dc = (lane & 3) ^ ((lane >> 4) & 3);
  const int nlim = j.nvalid - 1;
  const size_t kofs = (size_t)k0 * 32 + dc * 8;
  const bf16_t* gA0 = j.A + (size_t)(m0 + 32 * w + dr) * j.lda + kofs;
  const bf16_t* gA1 = j.A + (size_t)(m0 + 32 * w + 16 + dr) * j.lda + kofs;
  const bf16_t* gB0 = j.Bt + (size_t)min(n0 + 64 * w + dr, nlim) * j.ldb + kofs;
  const bf16_t* gB1 = j.Bt + (size_t)min(n0 + 64 * w + 16 + dr, nlim) * j.ldb + kofs;
  const bf16_t* gB2 = j.Bt + (size_t)min(n0 + 64 * w + 32 + dr, nlim) * j.ldb + kofs;
  const bf16_t* gB3 = j.Bt + (size_t)min(n0 + 64 * w + 48 + dr, nlim) * j.ldb + kofs;
  char* ldsA = smem + (2 * w) * 1024 + lane * 16;
  char* ldsB = smem + 8192 + (4 * w) * 1024 + lane * 16;
  const unsigned lbase = (unsigned)(unsigned long long)(LAS char*)smem;
  const int fsw = (r32 >> 2) & 3;
  const unsigned pa = (unsigned)((wm * 64 + r32) * 64), pb = (unsigned)(8192 + (wn * 128 + r32) * 64);
  const unsigned po0 = (unsigned)(((hh) ^ fsw) * 16), po1 = (unsigned)(((2 + hh) ^ fsw) * 16);

#define DMA1(gp, lp) __builtin_amdgcn_global_load_lds((const unsigned*)(gp), (unsigned*)(lp), 16, 0, 0)
#define ISSUE(kt, slot)                                                                          \
  {                                                                                              \
    const int ko_ = (kt) * 32;                                                                   \
    char* la_ = ldsA + (slot) * DSLOT; char* lb_ = ldsB + (slot) * DSLOT;                        \
    DMA1(gA0 + ko_, la_); DMA1(gA1 + ko_, la_ + 1024);                                           \
    DMA1(gB0 + ko_, lb_); DMA1(gB1 + ko_, lb_ + 1024); DMA1(gB2 + ko_, lb_ + 2048); DMA1(gB3 + ko_, lb_ + 3072); \
  }
#define SB_ __builtin_amdgcn_sched_barrier(0)

  asm volatile("s_waitcnt vmcnt(0)" ::: "memory");
  const int last = nk - 1;
  ISSUE(0, 0);
  { const int t1 = min(1, last); ISSUE(t1, 1); }
  int sl_r = 0, sl_w = 2;
#pragma unroll 1
  for (int i = 0; i < nk; ++i) {
    asm volatile("s_waitcnt vmcnt(6)" ::: "memory");
    __builtin_amdgcn_s_barrier();
    const int ko2 = min(i + 2, last) * 32;
    char* la2 = ldsA + sl_w * DSLOT; char* lb2 = ldsB + sl_w * DSLOT;
    const unsigned sl = lbase + (unsigned)(sl_r * DSLOT);
    sl_r = (sl_r == 2) ? 0 : sl_r + 1;
    sl_w = (sl_w == 2) ? 0 : sl_w + 1;
    bf16x8 a00, a10, a01, a11, b00, b10, b20, b30, b01, b11, b21, b31;
    const unsigned aA0 = sl + pa + po0, aB0 = sl + pb + po0, aA1 = sl + pa + po1, aB1 = sl + pb + po1;
    asm volatile("ds_read_b128 %0, %1" : "=v"(a00) : "v"(aA0));
    asm volatile("ds_read_b128 %0, %1 offset:2048" : "=v"(a10) : "v"(aA0));
    asm volatile("ds_read_b128 %0, %1" : "=v"(b00) : "v"(aB0));
    asm volatile("ds_read_b128 %0, %1 offset:2048" : "=v"(b10) : "v"(aB0));
    asm volatile("ds_read_b128 %0, %1 offset:4096" : "=v"(b20) : "v"(aB0));
    asm volatile("ds_read_b128 %0, %1 offset:6144" : "=v"(b30) : "v"(aB0));
    asm volatile("ds_read_b128 %0, %1" : "=v"(a01) : "v"(aA1));
    asm volatile("ds_read_b128 %0, %1 offset:2048" : "=v"(a11) : "v"(aA1));
    asm volatile("ds_read_b128 %0, %1" : "=v"(b01) : "v"(aB1));
    asm volatile("ds_read_b128 %0, %1 offset:2048" : "=v"(b11) : "v"(aB1));
    asm volatile("ds_read_b128 %0, %1 offset:4096" : "=v"(b21) : "v"(aB1));
    asm volatile("ds_read_b128 %0, %1 offset:6144" : "=v"(b31) : "v"(aB1));
    DMA1(gA0 + ko2, la2);
    asm volatile("s_waitcnt lgkmcnt(0)" : "+v"(a00), "+v"(a10), "+v"(b00), "+v"(b10), "+v"(b20), "+v"(b30),
                 "+v"(a01), "+v"(a11), "+v"(b01), "+v"(b11), "+v"(b21), "+v"(b31) :: "memory");
    acc[0][0] = mfma32(a00, b00, acc[0][0]);
    acc[0][1] = mfma32(a00, b10, acc[0][1]);
    acc[0][2] = mfma32(a00, b20, acc[0][2]);
    SB_; DMA1(gA1 + ko2, la2 + 1024); SB_;
    acc[0][3] = mfma32(a00, b30, acc[0][3]);
    acc[1][0] = mfma32(a10, b00, acc[1][0]);
    acc[1][1] = mfma32(a10, b10, acc[1][1]);
    SB_; DMA1(gB0 + ko2, lb2); SB_;
    acc[1][2] = mfma32(a10, b20, acc[1][2]);
    acc[1][3] = mfma32(a10, b30, acc[1][3]);
    acc[0][0] = mfma32(a01, b01, acc[0][0]);
    SB_; DMA1(gB1 + ko2, lb2 + 1024); SB_;
    acc[0][1] = mfma32(a01, b11, acc[0][1]);
    acc[0][2] = mfma32(a01, b21, acc[0][2]);
    acc[0][3] = mfma32(a01, b31, acc[0][3]);
    SB_; DMA1(gB2 + ko2, lb2 + 2048); SB_;
    acc[1][0] = mfma32(a11, b01, acc[1][0]);
    acc[1][1] = mfma32(a11, b11, acc[1][1]);
    acc[1][2] = mfma32(a11, b21, acc[1][2]);
    SB_; DMA1(gB3 + ko2, lb2 + 3072); SB_;
    acc[1][3] = mfma32(a11, b31, acc[1][3]);
  }
  asm volatile("s_waitcnt vmcnt(0)" ::: "memory");
  __builtin_amdgcn_s_barrier();
#undef ISSUE
#undef DMA1
#undef SB_
  if (wflag) {
    if (threadIdx.x == 0) {
      unsigned sp = 0;
      while (xb_ld(wflag) != epoch) { __builtin_amdgcn_s_sleep(1); if (++sp > (1u << 24)) break; }
      __builtin_amdgcn_fence(__ATOMIC_ACQUIRE, "agent");
      asm volatile("s_waitcnt vmcnt(0)" ::: "memory");
    }
    __syncthreads();
  }

  if (EPI == EPI_GATES) {
    const bf16_t* XC = (const bf16_t*)j.o1;
    float* AA = (float*)j.o0;
    float* BBp = AA + (size_t)T_ * 1024;
#pragma unroll
    for (int g = 0; g < 2; ++g) {
      const int ch = (n0 >> 8) * 128 + wn * 64 + g * 32 + r32;
      const float br = j.x0[ch], bi = j.x1[ch];
      const float spl = softplusf_(-j.x2[ch]);
#pragma unroll
      for (int mi = 0; mi < 2; ++mi)
#pragma unroll
        for (int r = 0; r < 16; ++r) {
          const int row = m0 + wm * 64 + mi * 32 + (r & 3) + 8 * (r >> 2) + 4 * hh;
          const float rg = sigmoidf_(acc[mi][2 * g][r] + br);
          const float ig = sigmoidf_(acc[mi][2 * g + 1][r] + bi);
          const float la = -8.f * rg * spl;
          const float xc = bf2f(XC[(size_t)row * 1024 + ch]);
          const bool reset = (row < TP_) && ((row & 2047) == 0);
          const float a = reset ? 0.f : __expf(la);
          const float mult = reset ? 1.f : sqrtf(fmaxf(-expm1f(2.f * la), 0.f));
          AA[(size_t)row * 1024 + ch] = a;
          BBp[(size_t)row * 1024 + ch] = mult * ig * xc;
        }
    }
  } else {
    const int lq = lane & 3;
#pragma unroll
    for (int mi = 0; mi < 2; ++mi)
#pragma unroll
      for (int ni = 0; ni < 4; ++ni)
#pragma unroll
        for (int g4 = 0; g4 < 4; ++g4) {
          float v[4] = {acc[mi][ni][4 * g4], acc[mi][ni][4 * g4 + 1], acc[mi][ni][4 * g4 + 2], acc[mi][ni][4 * g4 + 3]};
          quad_transpose4(v, lq);
          const int row = m0 + wm * 64 + mi * 32 + 8 * g4 + 4 * hh + lq;
          const int col = n0 + wn * 128 + ni * 32 + (r32 & ~3);
          epi4<EPI>(j, row, col, v);
        }
    if (EPI == EPI_SSM_XBC) {
      if (n0 + wn * 128 == 4096) {
        const float dtb = j.x0[r32];
#pragma unroll
        for (int mi = 0; mi < 2; ++mi)
#pragma unroll
          for (int r = 0; r < 16; ++r) {
            const int row = m0 + wm * 64 + mi * 32 + (r & 3) + 8 * (r >> 2) + 4 * hh;
            ((float*)j.o1)[(size_t)row * 32 + r32] = softplusf_(acc[mi][0][r] + dtb);
          }
      }
    }
  }
}

template <int EPI>
DI void gemm_tile_dma_h(const GJob& j, int m0, int n0, int nk, char* smem) {
  const int tid = TIDX, lane = tid & 63, w = tid >> 6;
  const int wm = w >> 1, wn = w & 1, r32 = lane & 31, hh = lane >> 5;
  f32x16 acc[4];
#pragma unroll
  for (int b = 0; b < 4; ++b)
#pragma unroll
    for (int r = 0; r < 16; ++r) acc[b][r] = 0.f;
  const int dr = lane >> 2;
  const int dc = (lane & 3) ^ ((lane >> 4) & 3);
  const int nlim = j.nvalid - 1;
  const size_t kofs = (size_t)dc * 8;
  const bf16_t* gA0 = j.A + (size_t)(m0 + 16 * w + dr) * j.lda + kofs;
  const bf16_t* gB0 = j.Bt + (size_t)min(n0 + 64 * w + dr, nlim) * j.ldb + kofs;
  const bf16_t* gB1 = j.Bt + (size_t)min(n0 + 64 * w + 16 + dr, nlim) * j.ldb + kofs;
  const bf16_t* gB2 = j.Bt + (size_t)min(n0 + 64 * w + 32 + dr, nlim) * j.ldb + kofs;
  const bf16_t* gB3 = j.Bt + (size_t)min(n0 + 64 * w + 48 + dr, nlim) * j.ldb + kofs;
  char* ldsA = smem + w * 1024 + lane * 16;
  char* ldsB = smem + 8192 + (4 * w) * 1024 + lane * 16;
  const unsigned lbase = (unsigned)(unsigned long long)(LAS char*)smem;
  const int fsw = (r32 >> 2) & 3;
  const unsigned pa = (unsigned)((wm * 32 + r32) * 64), pb = (unsigned)(8192 + (wn * 128 + r32) * 64);
  const unsigned po0 = (unsigned)(((hh) ^ fsw) * 16), po1 = (unsigned)(((2 + hh) ^ fsw) * 16);
#define DMA1(gp, lp) __builtin_amdgcn_global_load_lds((const unsigned*)(gp), (unsigned*)(lp), 16, 0, 0)
#define ISSUEH(kt, slot)                                                                         \
  {                                                                                              \
    const int ko_ = (kt) * 32;                                                                   \
    char* la_ = ldsA + (slot) * DSLOT; char* lb_ = ldsB + (slot) * DSLOT;                        \
    DMA1(gA0 + ko_, la_);                                                                        \
    DMA1(gB0 + ko_, lb_); DMA1(gB1 + ko_, lb_ + 1024); DMA1(gB2 + ko_, lb_ + 2048); DMA1(gB3 + ko_, lb_ + 3072); \
  }
  asm volatile("s_waitcnt vmcnt(0)" ::: "memory");
  const int last = nk - 1;
  ISSUEH(0, 0);
  { const int t1 = min(1, last); ISSUEH(t1, 1); }
  int sl_r = 0, sl_w = 2;
#pragma unroll 1
  for (int i = 0; i < nk; ++i) {
    asm volatile("s_waitcnt vmcnt(5)" ::: "memory");
    __builtin_amdgcn_s_barrier();
    { const int t2 = min(i + 2, last); ISSUEH(t2, sl_w); }
    const unsigned sl = lbase + (unsigned)(sl_r * DSLOT);
    sl_r = (sl_r == 2) ? 0 : sl_r + 1;
    sl_w = (sl_w == 2) ? 0 : sl_w + 1;
    bf16x8 a00, a01, b00, b10, b20, b30, b01, b11, b21, b31;
    const unsigned aA0 = sl + pa + po0, aB0 = sl + pb + po0, aA1 = sl + pa + po1, aB1 = sl + pb + po1;
    asm volatile("ds_read_b128 %0, %1" : "=v"(a00) : "v"(aA0));
    asm volatile("ds_read_b128 %0, %1" : "=v"(b00) : "v"(aB0));
    asm volatile("ds_read_b128 %0, %1 offset:2048" : "=v"(b10) : "v"(aB0));
    asm volatile("ds_read_b128 %0, %1 offset:4096" : "=v"(b20) : "v"(aB0));
    asm volatile("ds_read_b128 %0, %1 offset:6144" : "=v"(b30) : "v"(aB0));
    asm volatile("ds_read_b128 %0, %1" : "=v"(a01) : "v"(aA1));
    asm volatile("ds_read_b128 %0, %1" : "=v"(b01) : "v"(aB1));
    asm volatile("ds_read_b128 %0, %1 offset:2048" : "=v"(b11) : "v"(aB1));
    asm volatile("ds_read_b128 %0, %1 offset:4096" : "=v"(b21) : "v"(aB1));
    asm volatile("ds_read_b128 %0, %1 offset:6144" : "=v"(b31) : "v"(aB1));
    asm volatile("s_waitcnt lgkmcnt(0)" : "+v"(a00), "+v"(b00), "+v"(b10), "+v"(b20), "+v"(b30),
                 "+v"(a01), "+v"(b01), "+v"(b11), "+v"(b21), "+v"(b31) :: "memory");
    acc[0] = mfma32(a00, b00, acc[0]);
    acc[1] = mfma32(a00, b10, acc[1]);
    acc[2] = mfma32(a00, b20, acc[2]);
    acc[3] = mfma32(a00, b30, acc[3]);
    acc[0] = mfma32(a01, b01, acc[0]);
    acc[1] = mfma32(a01, b11, acc[1]);
    acc[2] = mfma32(a01, b21, acc[2]);
    acc[3] = mfma32(a01, b31, acc[3]);
  }
  asm volatile("s_waitcnt vmcnt(0)" ::: "memory");
  __builtin_amdgcn_s_barrier();
#undef ISSUEH
#undef DMA1
  const int lq = lane & 3;
#pragma unroll
  for (int ni = 0; ni < 4; ++ni)
#pragma unroll
    for (int g4 = 0; g4 < 4; ++g4) {
      float v[4] = {acc[ni][4 * g4], acc[ni][4 * g4 + 1], acc[ni][4 * g4 + 2], acc[ni][4 * g4 + 3]};
      quad_transpose4(v, lq);
      const int row = m0 + wm * 32 + 8 * g4 + 4 * hh + lq;
      const int col = n0 + wn * 128 + ni * 32 + (r32 & ~3);
      epi4<EPI>(j, row, col, v);
    }
  if (EPI == EPI_SSM_XBC) {
    if (n0 + wn * 128 == 4096) {
      const float dtb = j.x0[r32];
#pragma unroll
      for (int r = 0; r < 16; ++r) {
        const int row = m0 + wm * 32 + (r & 3) + 8 * (r >> 2) + 4 * hh;
        ((float*)j.o1)[(size_t)row * 32 + r32] = softplusf_(acc[0][r] + dtb);
      }
    }
  }
}

#define VBLOCK() ((int)(((volatile LAS unsigned*)&xb_words)[3]))
DI void tile_map(int L, int ntn, int& mt, int& nt) {
  const int gw = ((ntn & 7) == 0) ? 8 : (((ntn & 3) == 0) ? 4 : 0);
  if (gw) {
    const int gs = 8 * gw, grp = L / gs, loc = L - grp * gs, gpr = ntn / gw;
    const int gm = grp / gpr, gn = grp - gm * gpr;
    mt = gm * 8 + loc / gw; nt = gn * gw + (loc - (loc / gw) * gw);
  } else { mt = L / ntn; nt = L - mt * ntn; }
}

template <int EPI, bool MIX>
DI void gemm_run(const GJob& j, int ntn, int& toff, char* smem, int vb_) {
  const int G = gridDim.x;
  const int nk = j.K >> 6;
  if (MIX) {
    const int ntiles = MT_ * ntn;
    const int start = (int)((vb_ - (toff % G) + G) % G);
    for (int tile = start; tile < ntiles; tile += G) {
      int mt, nt; tile_map(tile, ntn, mt, nt);
      gemm_tile<EPI, MIX>(j, mt * 128, nt * 128, 0, nk, smem);
    }
    toff += ntiles;
  } else {
    const int nfull = 128 * ntn, nhalf = 16 * ntn, ntot = nfull + nhalf;
    const int start = (int)((vb_ - (toff % G) + G) % G);
    for (int item = start; item < ntot; item += G) {
      if (item < nfull) {
        int mt, nt; tile_map(item, ntn, mt, nt);
        gemm_tile_dma<EPI>(j, mt * 128, nt * 256, 0, nk * 2, smem);
      } else {
        const int h = item - nfull, hm = h / ntn, nt = h - hm * ntn;
        gemm_tile_dma_h<EPI>(j, TP_ + hm * 64, nt * 256, nk * 2, smem);
      }
    }
    toff += ntot;
  }
}

template <int EPI>
DI void gemm_streamk(const GJob& j, int ntn, char* smem, int vb_, unsigned* flags, unsigned epoch) {
  const int G = gridDim.x;
  const int nk = j.K >> 5;
  const int total = MT_ * ntn * nk;
  int per = (total + G - 1) / G;
  if (per < nk) per = nk;
  int s0 = vb_ * per;
  const int s1 = min(s0 + per, total);
  while (s0 < s1) {
    const int tile = s0 / nk, k0 = s0 - tile * nk;
    const int k1 = min(nk, k0 + (s1 - s0));
    int mt, nt; tile_map(tile, ntn, mt, nt);
    unsigned* wf = (k0 == 0 && k1 < nk) ? (flags + tile) : nullptr;
    gemm_tile_dma<EPI>(j, mt * 128, nt * 256, k0, k1, smem, wf, epoch);
    if (k0 > 0) {
      asm volatile("s_waitcnt vmcnt(0)" ::: "memory");
      __syncthreads();
      if (threadIdx.x == 0) {
        __builtin_amdgcn_fence(__ATOMIC_RELEASE, "agent");
        asm volatile("s_waitcnt vmcnt(0)" ::: "memory");
        __hip_atomic_store(flags + tile, epoch, __ATOMIC_RELAXED, __HIP_MEMORY_SCOPE_AGENT);
      }
    }
    s0 += k1 - k0;
  }
}

template <int EPI, int SPLIT, int NKC>
DI void gemm_splitk(const GJob& j, int ntn, char* smem, int vb_) {
  const int G = gridDim.x;
  const int nitems = MT_ * ntn * SPLIT;
  for (int it = vb_; it < nitems; it += G) {
    const int tile = it / SPLIT, sp = it - tile * SPLIT;
    int mt, nt; tile_map(tile, ntn, mt, nt);
    gemm_tile<EPI, false>(j, mt * 128, nt * 128, sp * NKC, sp * NKC + NKC, smem);
  }
}

DI GJob mkjob(const bf16_t* A, int lda, const bf16_t* Bt, int ldb, int K, int nvalid) {
  GJob j;
  j.A = A; j.A2 = nullptr; j.mu = nullptr; j.Bt = Bt; j.lda = lda; j.ldb = ldb; j.K = K; j.nvalid = nvalid;
  j.o0 = nullptr; j.o1 = nullptr; j.x0 = nullptr; j.x1 = nullptr; j.x2 = nullptr; j.ldo = 0; j.act = 0;
  return j;
}

struct TJob { const float* src; bf16_t* dst; int K, N, src_ld, kind, n_off; };

DI TJob get_tjob(const Params& p, int j) {
  bf16_t* wt = (bf16_t*)(p.ws + W_WT);
  TJob o; o.kind = 0; o.n_off = 0;
  if (j < 36) {
    const int ia = j / 18, r = j % 18;
    if (r == 0) { o.src = p.in[I_LRU_WIN] + (size_t)ia * 1024 * 2048; o.dst = wt + WA_IN + (size_t)ia * 2048 * 1024; o.K = 1024; o.N = 2048; o.src_ld = 2048; }
    else if (r == 1) { o.src = p.in[I_LRU_WOUT] + (size_t)ia * 1024 * 1024; o.dst = wt + WA_OUT + (size_t)ia * 1024 * 1024; o.K = 1024; o.N = 1024; o.src_ld = 1024; }
    else {
      const int isI = (r >= 10) ? 1 : 0; const int h = (r - 2) & 7;
      o.src = p.in[isI ? I_LRU_WI : I_LRU_WR] + ((size_t)ia * 8 + h) * 128 * 128;
      o.dst = wt + WA_G + (size_t)ia * 2048 * 128; o.K = 128; o.N = 128; o.src_ld = 128; o.kind = 1 + isI; o.n_off = h * 128;
    }
  } else if (j == 36) { o.src = p.in[I_SSM_WIN] + 2048; o.dst = wt + WB_XBC; o.K = 1024; o.N = 4128; o.src_ld = 6176; }
  else if (j == 37) { o.src = p.in[I_SSM_WIN]; o.dst = wt + WB_Z; o.K = 1024; o.N = 2048; o.src_ld = 6176; }
  else if (j == 38) { o.src = p.in[I_SSM_WOUT]; o.dst = wt + WB_OUT; o.K = 2048; o.N = 1024; o.src_ld = 1024; }
  else if (j < 42) { const int s = j - 39; o.src = p.in[I_RW_WRKV] + (size_t)s * 1024 * 1024; o.dst = wt + WC_RKV + (size_t)s * 1024 * 1024; o.K = 1024; o.N = 1024; o.src_ld = 1024; }
  else if (j == 42) { o.src = p.in[I_RW_WW1]; o.dst = wt + WC_L1; o.K = 1024; o.N = 64; o.src_ld = 64; }
  else if (j == 43) { o.src = p.in[I_RW_WA1]; o.dst = wt + WC_L1 + 64 * 1024; o.K = 1024; o.N = 64; o.src_ld = 64; }
  else if (j == 44) { o.src = p.in[I_RW_WG1]; o.dst = wt + WC_L1 + 128 * 1024; o.K = 1024; o.N = 128; o.src_ld = 128; }
  else if (j == 45) { o.src = p.in[I_RW_WW2]; o.dst = wt + WC_W2; o.K = 64; o.N = 1024; o.src_ld = 1024; }
  else if (j == 46) { o.src = p.in[I_RW_WA2]; o.dst = wt + WC_A2; o.K = 64; o.N = 1024; o.src_ld = 1024; }
  else if (j == 47) { o.src = p.in[I_RW_WG2]; o.dst = wt + WC_G2; o.K = 128; o.N = 1024; o.src_ld = 1024; }
  else if (j == 48) { o.src = p.in[I_RW_WOUT]; o.dst = wt + WC_OUT; o.K = 1024; o.N = 1024; o.src_ld = 1024; }
  else {
    const int l = (j - 49) >> 1, which = (j - 49) & 1;
    if (!which) { o.src = p.in[I_FFN_W1] + (size_t)l * 1024 * 4096; o.dst = wt + WF_1 + (size_t)l * 4096 * 1024; o.K = 1024; o.N = 4096; o.src_ld = 4096; }
    else { o.src = p.in[I_FFN_W2] + (size_t)l * 4096 * 1024; o.dst = wt + WF_2 + (size_t)l * 4096 * 1024; o.K = 4096; o.N = 1024; o.src_ld = 1024; }
  }
  return o;
}
constexpr int N_TJOBS = 57;

DI void ph_prologue(const Params& p, char* smem) {
  const int tid = TIDX, G = gridDim.x;
  {
    const float4* xp = (const float4*)p.in[I_XP];
    const float4* xs = (const float4*)p.in[I_XS];
    float4* X = (float4*)(p.ws + W_X);
    const size_t np = (size_t)TP_ * 256, nt = (size_t)T_ * 256;
    for (size_t i = (size_t)blockIdx.x * NTHR + tid; i < nt; i += (size_t)G * NTHR)
      X[i] = (i < np) ? xp[i] : xs[i - np];
  }
  float* tile = (float*)smem;
  int toff = 0;
  for (int jn = 0; jn < N_TJOBS; ++jn) {
    const TJob tj = get_tjob(p, jn);
    const int nkt = tj.K >> 6, nnt = (tj.N + 63) >> 6;
    const int ntiles = nkt * nnt;
    const int start = (((int)blockIdx.x - (toff % G)) + G) % G;
    for (int t = start; t < ntiles; t += G) {
      const int kt = t / nnt, nt = t - kt * nnt;
      const int k0 = kt * 64, n0 = nt * 64;
      __syncthreads();
#pragma unroll 4
      for (int i = 0; i < 16; ++i) {
        const int k = i * 4 + (tid >> 6), n = tid & 63;
        float v = 0.f;
        if (n0 + n < tj.N) v = tj.src[(size_t)(k0 + k) * tj.src_ld + n0 + n];
        tile[k * 65 + n] = v;
      }
      __syncthreads();
      const int n = tid >> 2, kq = tid & 3;
      if (n0 + n < tj.N) {
        int nrow = n0 + n;
        if (tj.kind) {
          const int ch = tj.n_off + n0 + n;
          nrow = (ch >> 6) * 128 + ((ch >> 5) & 1) * 64 + (tj.kind - 1) * 32 + (ch & 31);
        }
        float f[8], g[8];
#pragma unroll
        for (int e = 0; e < 8; ++e) { f[e] = tile[(kq * 16 + e) * 65 + n]; g[e] = tile[(kq * 16 + 8 + e) * 65 + n]; }
        uint4* d = (uint4*)(tj.dst + (size_t)nrow * tj.K + k0 + kq * 16);
        d[0] = pack8(f); d[1] = pack8(g);
      }
    }
    toff += ntiles;
  }
}

DI void ph_rmsnorm(const Params& p, int mode, const float* w) {
  const int tid_ = TIDX; const int lane = tid_ & 63;
  const int gw = blockIdx.x * 4 + (tid_ >> 6), nw = gridDim.x * 4;
  const float* X = (const float*)(p.ws + W_X);
  bf16_t* U = (bf16_t*)(p.ws + W_U);
  bf16_t* UP = (bf16_t*)(p.ws + SC_UP);
  float4 wv[4];
#pragma unroll
  for (int i = 0; i < 4; ++i) wv[i] = ((const float4*)w)[lane + 64 * i];
  for (int row = gw; row < T_; row += nw) {
    const float4* xr = (const float4*)(X + (size_t)row * 1024);
    float4 v[4]; float ss = 0.f;
#pragma unroll
    for (int i = 0; i < 4; ++i) { v[i] = xr[lane + 64 * i]; ss += v[i].x * v[i].x + v[i].y * v[i].y + v[i].z * v[i].z + v[i].w * v[i].w; }
    ss = wave_sum(ss);
    const float rstd = rsqrtf(ss * (1.f / 1024.f) + 1e-6f);
    int seq, l, L; tok_info(row, seq, l, L);
#pragma unroll
    for (int i = 0; i < 4; ++i) {
      const int c = 4 * (lane + 64 * i);
      float4 y = make_float4(v[i].x * rstd * wv[i].x, v[i].y * rstd * wv[i].y, v[i].z * rstd * wv[i].z, v[i].w * rstd * wv[i].w);
      if (mode == 2) {
        *(float4*)(p.out + O_Y + (size_t)row * 1024 + c) = y;
      } else {
        uint2 pk = make_uint2(pack2(y.x, y.y), pack2(y.z, y.w));
        *(uint2*)(U + (size_t)row * 1024 + c) = pk;
        if (mode == 1) {
          if (l + 1 < L) *(uint2*)(UP + (size_t)(row + 1) * 1024 + c) = pk;
          if (l == 0) {
            uint2 pz = make_uint2(0, 0);
            if (seq >= 8) { float4 s = *(const float4*)(p.in[I_ST_RS] + (size_t)(seq - 8) * 1024 + c); pz = make_uint2(pack2(s.x, s.y), pack2(s.z, s.w)); }
            *(uint2*)(UP + (size_t)row * 1024 + c) = pz;
          }
          if (l == L - 1) {
            float* o = (seq < 8) ? (p.out + O_RS_P + (size_t)seq * 1024 + c) : (p.out + O_RS_S + (size_t)(seq - 8) * 1024 + c);
            *(float4*)o = y;
          }
        }
      }
    }
  }
}

template <int C, bool SILU>
DI void ph_conv(const bf16_t* __restrict__ src, bf16_t* __restrict__ dst, const float* __restrict__ cw,
                const float* __restrict__ cb, const float* __restrict__ state,
                float* __restrict__ out_p, float* __restrict__ out_s) {
  constexpr int GR = C / 8;
  const size_t total = (size_t)T_ * GR;
#pragma unroll 2
  for (size_t idx = (size_t)blockIdx.x * NTHR + TIDX; idx < total; idx += (size_t)gridDim.x * NTHR) {
    const int t = (int)(idx / GR), c = (int)(idx % GR) * 8;
    int seq, l, L; tok_info(t, seq, l, L);
    float acc[8]; load8f(cb + c, acc);
    float xcur[8];
#pragma unroll
    for (int jj = 0; jj < 4; ++jj) {
      const int ls = l - 3 + jj;
      float xv[8];
      if (ls >= 0) { unpack8(*(const uint4*)(src + (size_t)(t - 3 + jj) * C + c), xv); }
      else if (seq >= 8) { load8f(state + ((size_t)(seq - 8) * 3 + (ls + 3)) * C + c, xv); }
      else {
#pragma unroll
        for (int e = 0; e < 8; ++e) xv[e] = 0.f;
      }
      float w8[8]; load8f(cw + (size_t)jj * C + c, w8);
#pragma unroll
      for (int e = 0; e < 8; ++e) acc[e] += w8[e] * xv[e];
      if (jj == 3) {
#pragma unroll
        for (int e = 0; e < 8; ++e) xcur[e] = xv[e];
      }
    }
    if (SILU) {
#pragma unroll
      for (int e = 0; e < 8; ++e) acc[e] = siluf_(acc[e]);
    }
    *(uint4*)(dst + (size_t)t * C + c) = pack8(acc);
    if (l >= L - 3) {
      const int r = l - (L - 3);
      float* o = (seq < 8) ? (out_p + ((size_t)seq * 3 + r) * C + c) : (out_s + ((size_t)(seq - 8) * 3 + r) * C + c);
      store8f(o, xcur);
    }
  }
}

DI void ph_lru_scan1(const Params& p) {
  const float* AA = (const float*)(p.ws + SA_AA);
  const float* BB = (const float*)(p.ws + SA_BB);
  float* CP = (float*)(p.ws + SA_CP);
  float* CS = (float*)(p.ws + SA_CS);
  const int total = 8 * 64 * 1024;
  for (int idx = blockIdx.x * NTHR + TIDX; idx < total; idx += gridDim.x * NTHR) {
    const int ch = idx & 1023, c = (idx >> 10) & 63, b = idx >> 16;
    const size_t base = ((size_t)b * 2048 + c * 32) * 1024 + ch;
    float P = 1.f, S = 0.f;
    float av[32], bv[32];
#pragma unroll
    for (int s = 0; s < 32; ++s) { av[s] = AA[base + (size_t)s * 1024]; bv[s] = BB[base + (size_t)s * 1024]; }
#pragma unroll
    for (int s = 0; s < 32; ++s) { S = av[s] * S + bv[s]; P *= av[s]; }
    CP[idx] = P; CS[idx] = S;
  }
}
DI void ph_lru_scan2(const Params& p, int ia) {
  const float* AA = (const float*)(p.ws + SA_AA);
  const float* BB = (const float*)(p.ws + SA_BB);
  const float* CP = (const float*)(p.ws + SA_CP);
  const float* CS = (const float*)(p.ws + SA_CS);
  bf16_t* GT = (bf16_t*)(p.ws + SA_GT);
  const int nP = 8 * 64 * 1024, total = nP + 128 * 1024;
  for (int idx = blockIdx.x * NTHR + TIDX; idx < total; idx += gridDim.x * NTHR) {
    if (idx < nP) {
      const int ch = idx & 1023, c = (idx >> 10) & 63, b = idx >> 16;
      const size_t base = ((size_t)b * 2048 + c * 32) * 1024 + ch;
      float av[32], bv[32]; bf16_t gv[32];
#pragma unroll
      for (int s = 0; s < 32; ++s) { const size_t o = base + (size_t)s * 1024; av[s] = AA[o]; bv[s] = BB[o]; gv[s] = GT[o]; }
      float h = 0.f;
#pragma unroll 8
      for (int c2 = 0; c2 < c; ++c2) {
        const int ci = ((b * 64 + c2) << 10) + ch;
        h = CP[ci] * h + CS[ci];
      }
#pragma unroll
      for (int s = 0; s < 32; ++s) {
        const size_t o = base + (size_t)s * 1024;
        h = av[s] * h + bv[s];
        GT[o] = f2bf(h * bf2f(gv[s]));
      }
      if (c == 63) p.out[O_LH_P + ((size_t)ia * 8 + b) * 1024 + ch] = h;
    } else {
      const int u = idx - nP; const int ch = u & 1023, s = u >> 10;
      float h = p.in[I_ST_LH][((size_t)ia * 128 + s) * 1024 + ch];
      const size_t base = ((size_t)TP_ + s * 8) * 1024 + ch;
#pragma unroll
      for (int q = 0; q < 8; ++q) {
        const size_t o = base + (size_t)q * 1024;
        h = AA[o] * h + BB[o];
        GT[o] = f2bf(h * bf2f(GT[o]));
      }
      p.out[O_LH_S + ((size_t)ia * 128 + s) * 1024 + ch] = h;
    }
  }
}

DI void ssd_item(const Params& p, char* smem, int seq, int h) {
  const int tid = TIDX, lane = tid & 63, w = tid >> 6, r32 = lane & 31, hh = lane >> 5;
  bf16_t* Cs = (bf16_t*)smem;
  bf16_t* Bs = Cs + 64 * 136;
  bf16_t* Sb = Bs + 64 * 136;
  bf16_t* Xt = Sb + 64 * 136;
  bf16_t* Btr = Xt + 64 * 72;
  float* dts = (float*)(Btr + 128 * 72);
  float* acs = dts + 64;
  bf16_t* Ws = Bs;
  const bf16_t* XBC = (const bf16_t*)(p.ws + SB_XBC);
  const float* DT = (const float*)(p.ws + SB_DT);
  bf16_t* Y = (bf16_t*)(p.ws + SB_Y);
  const bool prompt = seq < 8;
  const int nchunk = prompt ? 32 : 1, Lv = prompt ? 64 : 8;
  const int tbase = prompt ? seq * 2048 : TP_ + (seq - 8) * 8;
  const int g = h >> 2;
  const float Ah = -__expf(p.in[I_SSM_ALOG][h]);
  const float Dh = p.in[I_SSM_D][h];
  f32x16 accS[2];
  {
    const float* s0 = p.in[I_ST_SS] + ((size_t)(seq - 8) * 32 + h) * 64 * 128;
#pragma unroll
    for (int mi = 0; mi < 2; ++mi)
#pragma unroll
      for (int r = 0; r < 16; ++r) {
        const int prow = mi * 32 + (r & 3) + 8 * (r >> 2) + 4 * hh, n = 32 * w + r32;
        accS[mi][r] = prompt ? 0.f : s0[(size_t)prow * 128 + n];
      }
  }
  __syncthreads();
#pragma unroll
  for (int mi = 0; mi < 2; ++mi)
#pragma unroll
    for (int r = 0; r < 16; ++r) {
      const int prow = mi * 32 + (r & 3) + 8 * (r >> 2) + 4 * hh, n = 32 * w + r32;
      Sb[prow * 136 + n] = f2bf(accS[mi][r]);
    }
  uint4 pc0, pc1, pc2, pc3, pb0, pb1, pb2, pb3, px0, px1;
  float pdt = 0.f;
  const uint4 z4 = make_uint4(0, 0, 0, 0);
  pc0 = pc1 = pc2 = pc3 = pb0 = pb1 = pb2 = pb3 = px0 = px1 = z4;
#define SSD_LD_CB(i, t0_)                                                                  \
  { const int id_ = tid + 256 * i, row_ = id_ >> 4, ch_ = id_ & 15;                        \
    pc##i = z4; pb##i = z4;                                                                \
    if (row_ < Lv) { const bf16_t* src_ = XBC + (size_t)((t0_) + row_) * 4096 + g * 128 + ch_ * 8; \
      pb##i = *(const uint4*)(src_ + 2048); pc##i = *(const uint4*)(src_ + 3072); } }
#define SSD_LD_X(i, t0_)                                                                   \
  { const int id_ = tid + 256 * i, row_ = id_ >> 3, ch_ = id_ & 7;                         \
    px##i = z4;                                                                            \
    if (row_ < Lv) px##i = *(const uint4*)(XBC + (size_t)((t0_) + row_) * 4096 + h * 64 + ch_ * 8); }
#define SSD_ISSUE(t0_)                                                                     \
  { SSD_LD_CB(0, t0_) SSD_LD_CB(1, t0_) SSD_LD_CB(2, t0_) SSD_LD_CB(3, t0_) SSD_LD_X(0, t0_) SSD_LD_X(1, t0_) \
    pdt = (tid < Lv && tid < 64) ? DT[(size_t)((t0_) + tid) * 32 + h] : 0.f; }
#define SSD_ST_CB(i)                                                                       \
  { const int id_ = tid + 256 * i, row_ = id_ >> 4, ch_ = id_ & 15;                        \
    *(uint4*)(Cs + row_ * 136 + ch_ * 8) = pc##i;                                          \
    *(uint4*)(Bs + row_ * 136 + ch_ * 8) = pb##i;                                          \
    float f_[8]; unpack8(pb##i, f_);                                                       \
    const float sc_ = __expf(aend - acs[row_]);                                            \
    _Pragma("unroll") for (int e = 0; e < 8; ++e) Btr[(ch_ * 8 + e) * 72 + row_] = f2bf(f_[e] * sc_); }
#define SSD_ST_X(i)                                                                        \
  { const int id_ = tid + 256 * i, row_ = id_ >> 3, ch_ = id_ & 7;                         \
    float f_[8]; unpack8(px##i, f_);                                                       \
    const float sc_ = dts[row_];                                                           \
    _Pragma("unroll") for (int e = 0; e < 8; ++e) Xt[(ch_ * 8 + e) * 72 + row_] = f2bf(f_[e] * sc_); }
  SSD_ISSUE(tbase);
  for (int c = 0; c < nchunk; ++c) {
    const int t0 = tbase + c * 64;
    __syncthreads();
    if (tid < 64) {
      const float dtv = pdt;
      float x = dtv * Ah;
#pragma unroll
      for (int o = 1; o < 64; o <<= 1) { const float y = __shfl_up(x, o, 64); if (lane >= o) x += y; }
      dts[tid] = dtv; acs[tid] = x;
    }
    __syncthreads();
    const float aend = acs[63];
    SSD_ST_CB(0) SSD_ST_CB(1) SSD_ST_CB(2) SSD_ST_CB(3) SSD_ST_X(0) SSD_ST_X(1)
    if (c + 1 < nchunk) { SSD_ISSUE(t0 + 64); }
    __syncthreads();
    const int it = w >> 1, jt = w & 1;
    f32x16 cb;
#pragma unroll
    for (int r = 0; r < 16; ++r) cb[r] = 0.f;
    if (jt <= it) {
#pragma unroll
      for (int ks = 0; ks < 8; ++ks) {
        bf16x8 a = *(const bf16x8*)(Cs + (it * 32 + r32) * 136 + ks * 16 + hh * 8);
        bf16x8 b = *(const bf16x8*)(Bs + (jt * 32 + r32) * 136 + ks * 16 + hh * 8);
        cb = mfma32(a, b, cb);
      }
    }
    __syncthreads();
    {
      const int jj = jt * 32 + r32; const float aj = acs[jj];
#pragma unroll
      for (int r = 0; r < 16; ++r) {
        const int ii = it * 32 + (r & 3) + 8 * (r >> 2) + 4 * hh;
        const float v = (jj <= ii) ? cb[r] * __expf(acs[ii] - aj) : 0.f;
        Ws[ii * 72 + jj] = f2bf(v);
      }
    }
    __syncthreads();
    {
      const int pt = w & 1;
      f32x16 yd, yo;
#pragma unroll
      for (int r = 0; r < 16; ++r) { yd[r] = 0.f; yo[r] = 0.f; }
#pragma unroll
      for (int ks = 0; ks < 4; ++ks) {
        bf16x8 a = *(const bf16x8*)(Ws + (it * 32 + r32) * 72 + ks * 16 + hh * 8);
        bf16x8 b = *(const bf16x8*)(Xt + (pt * 32 + r32) * 72 + ks * 16 + hh * 8);
        yd = mfma32(a, b, yd);
      }
#pragma unroll
      for (int ks = 0; ks < 8; ++ks) {
        bf16x8 a = *(const bf16x8*)(Cs + (it * 32 + r32) * 136 + ks * 16 + hh * 8);
        bf16x8 b = *(const bf16x8*)(Sb + (pt * 32 + r32) * 136 + ks * 16 + hh * 8);
        yo = mfma32(a, b, yo);
      }
      const int pp = pt * 32 + r32;
#pragma unroll
      for (int r = 0; r < 16; ++r) {
        const int ii = it * 32 + (r & 3) + 8 * (r >> 2) + 4 * hh;
        if (ii < Lv) {
          const size_t t = (size_t)(t0 + ii);
          const float xv = bf2f(XBC[t * 4096 + h * 64 + pp]);
          const float yv = yd[r] + __expf(acs[ii]) * yo[r] + Dh * xv;
          Y[t * 2048 + h * 64 + pp] = f2bf(yv);
        }
      }
    }
    {
      const float dec = __expf(aend);
#pragma unroll
      for (int mi = 0; mi < 2; ++mi)
#pragma unroll
        for (int r = 0; r < 16; ++r) accS[mi][r] *= dec;
#pragma unroll
      for (int ks = 0; ks < 4; ++ks) {
        bf16x8 b = *(const bf16x8*)(Btr + (32 * w + r32) * 72 + ks * 16 + hh * 8);
        bf16x8 a0 = *(const bf16x8*)(Xt + (r32) * 72 + ks * 16 + hh * 8);
        bf16x8 a1 = *(const bf16x8*)(Xt + (32 + r32) * 72 + ks * 16 + hh * 8);
        accS[0] = mfma32(a0, b, accS[0]);
        accS[1] = mfma32(a1, b, accS[1]);
      }
    }
    __syncthreads();
#pragma unroll
    for (int mi = 0; mi < 2; ++mi)
#pragma unroll
      for (int r = 0; r < 16; ++r) {
        const int prow = mi * 32 + (r & 3) + 8 * (r >> 2) + 4 * hh, n = 32 * w + r32;
        Sb[prow * 136 + n] = f2bf(accS[mi][r]);
      }
  }
  float* dst = prompt ? (p.out + O_SS_P + ((size_t)seq * 32 + h) * 64 * 128)
                      : (p.out + O_SS_S + ((size_t)(seq - 8) * 32 + h) * 64 * 128);
#pragma unroll
  for (int mi = 0; mi < 2; ++mi)
#pragma unroll
    for (int r = 0; r < 16; ++r) {
      const int prow = mi * 32 + (r & 3) + 8 * (r >> 2) + 4 * hh, n = 32 * w + r32;
      dst[(size_t)prow * 128 + n] = accS[mi][r];
    }
}

#undef SSD_LD_CB
#undef SSD_LD_X
#undef SSD_ISSUE
#undef SSD_ST_CB
#undef SSD_ST_X
DI void ph_ssd(const Params& p, char* smem) {
  const int G = gridDim.x, bid = blockIdx.x;
  int it = bid, step = G;
  if (G >= 512) { if (bid < 256) { step = 1 << 30; } else { step = G - 256; } }
#pragma nounroll
  for (; it < 256 + 4096; it += step) {
    const int seq = (it < 256) ? (it >> 5) : (8 + ((it - 256) >> 5));
    ssd_item(p, smem, seq, it & 31);
  }
}

DI void ph_gnorm(const Params& p) {
  const int tid_ = TIDX; const int lane = tid_ & 63;
  const int gw = blockIdx.x * 4 + (tid_ >> 6), nw = gridDim.x * 4;
  bf16_t* Y = (bf16_t*)(p.ws + SB_Y);
  const float* nwt = p.in[I_SSM_NW];
  for (int item = gw; item < T_ * 8; item += 2 * nw) {
    const int item2 = item + nw; const bool v2 = item2 < T_ * 8;
    bf16_t* yp1 = Y + (size_t)(item >> 3) * 2048 + (item & 7) * 256 + lane * 4;
    bf16_t* yp2 = Y + (size_t)((v2 ? item2 : item) >> 3) * 2048 + ((v2 ? item2 : item) & 7) * 256 + lane * 4;
    const uint2 a = *(const uint2*)yp1; const uint2 b = *(const uint2*)yp2;
    float f[4], g[4]; unpack4(a, f); unpack4(b, g);
    const float ss1 = wave_sum(f[0] * f[0] + f[1] * f[1] + f[2] * f[2] + f[3] * f[3]);
    const float ss2 = wave_sum(g[0] * g[0] + g[1] * g[1] + g[2] * g[2] + g[3] * g[3]);
    const float r1 = rsqrtf(ss1 * (1.f / 256.f) + 1e-5f), r2 = rsqrtf(ss2 * (1.f / 256.f) + 1e-5f);
    const float4 w1 = *(const float4*)(nwt + (item & 7) * 256 + lane * 4);
    const float4 w2 = *(const float4*)(nwt + ((v2 ? item2 : item) & 7) * 256 + lane * 4);
    *(uint2*)yp1 = make_uint2(pack2(f[0] * r1 * w1.x, f[1] * r1 * w1.y), pack2(f[2] * r1 * w1.z, f[3] * r1 * w1.w));
    if (v2) *(uint2*)yp2 = make_uint2(pack2(g[0] * r2 * w2.x, g[1] * r2 * w2.y), pack2(g[2] * r2 * w2.z, g[3] * r2 * w2.w));
  }
}

template <int LPR>
DI void wkv_item(const Params& p, char* smem, int seq, int head, int part) {
  constexpr int ROWS = 256 / LPR, KPL = 64 / LPR, NV4 = KPL / 4;
  const int tid = TIDX;
  float* sR = (float*)smem;
  float* sK = sR + 2048;
  float* sKK = sK + 2048;
  float* sBB = sKK + 2048;
  float* sW = sBB + 2048;
  float* sV = sW + 2048;
  float* sO = sV + 2048;
  const bf16_t* __restrict__ R = (const bf16_t*)(p.ws + SC_R);
  const bf16_t* __restrict__ K = (const bf16_t*)(p.ws + SC_K);
  const bf16_t* __restrict__ V = (const bf16_t*)(p.ws + SC_V);
  const bf16_t* __restrict__ AAc = (const bf16_t*)(p.ws + SC_AA);
  const float* __restrict__ WD = (const float*)(p.ws + SC_WD);
  bf16_t* O = (bf16_t*)(p.ws + SC_O);
  const bool prompt = seq < 8;
  const int nch = prompt ? 64 : 1, nvalid = prompt ? 32 : 8;
  const int tbase = prompt ? seq * 2048 : TP_ + (seq - 8) * 8;
  const int row_l = tid / LPR, q = tid % LPR, row = part * ROWS + row_l;
  float S[KPL];
  {
    const float* s0 = p.in[I_ST_RW] + (((size_t)(seq - 8) * 16 + head) * 64 + row) * 64 + q * KPL;
#pragma unroll
    for (int e = 0; e < KPL; ++e) S[e] = prompt ? 0.f : s0[e];
  }
  const int pst = tid >> 3, pk0 = (tid & 7) * 8, pcol = head * 64 + pk0;
  const bool pact = pst < nvalid;
  float kk8[8], ka8[8];
  load8f(p.in[I_RW_KK] + pcol, kk8);
  load8f(p.in[I_RW_KA] + pcol, ka8);
  uint4 qr = make_uint4(0, 0, 0, 0), qk = qr, qv = qr, qa = qr;
  float4 qw0 = make_float4(0.f, 0.f, 0.f, 0.f), qw1 = qw0;
#define WKV_ISSUE(c_)                                                       \
  if (pact) {                                                               \
    const size_t o_ = (size_t)(tbase + (c_) * 32 + pst) * 1024 + pcol;      \
    qr = *(const uint4*)(R + o_); qk = *(const uint4*)(K + o_);             \
    qv = *(const uint4*)(V + o_); qa = *(const uint4*)(AAc + o_);           \
    qw0 = *(const float4*)(WD + o_); qw1 = *(const float4*)(WD + o_ + 4);   \
  }
  WKV_ISSUE(0);
  for (int c = 0; c < nch; ++c) {
    const int t0 = tbase + c * 32;
    __syncthreads();
    if (pact) {
      float r8[8], k8[8], v8[8], a8[8];
      unpack8(qr, r8); unpack8(qk, k8); unpack8(qv, v8); unpack8(qa, a8);
      const float w8[8] = {qw0.x, qw0.y, qw0.z, qw0.w, qw1.x, qw1.y, qw1.z, qw1.w};
      float kr[8], ss = 0.f;
#pragma unroll
      for (int e = 0; e < 8; ++e) { kr[e] = k8[e] * kk8[e]; ss += kr[e] * kr[e]; }
      ss = red_lanes<8>(ss);
      const float inv = 1.f / fmaxf(sqrtf(ss), 1e-12f);
      float kp[8], bb[8];
#pragma unroll
      for (int e = 0; e < 8; ++e) { kr[e] *= inv; kp[e] = k8[e] * (1.f + (a8[e] - 1.f) * ka8[e]); bb[e] = kr[e] * a8[e]; }
      const int lo = pst * 64 + pk0;
      store8f(sR + lo, r8); store8f(sK + lo, kp); store8f(sKK + lo, kr); store8f(sBB + lo, bb);
      store8f(sW + lo, w8); store8f(sV + lo, v8);
    }
    __syncthreads();
    if (c + 1 < nch) { WKV_ISSUE(c + 1); }
#define WKV_LOADV(P, st_)                                                                      \
    {                                                                                          \
      const int lo_ = (st_) * 64 + q * KPL;                                                    \
      _Pragma("unroll") for (int e = 0; e < NV4; ++e) {                                        \
        P##kk[e] = *(const float4*)(sKK + lo_ + 4 * e); P##ww[e] = *(const float4*)(sW + lo_ + 4 * e); \
        P##bb[e] = *(const float4*)(sBB + lo_ + 4 * e); P##kp[e] = *(const float4*)(sK + lo_ + 4 * e); \
        P##rr[e] = *(const float4*)(sR + lo_ + 4 * e);                                         \
      }                                                                                        \
      P##vv = sV[(st_) * 64 + row];                                                            \
    }
#define WKV_STEP(P, st_)                                                                       \
    {                                                                                          \
      float sa0 = 0.f, sa1 = 0.f;                                                              \
      _Pragma("unroll") for (int e = 0; e < NV4; ++e) {                                        \
        sa0 += S[4 * e] * P##kk[e].x + S[4 * e + 2] * P##kk[e].z;                              \
        sa1 += S[4 * e + 1] * P##kk[e].y + S[4 * e + 3] * P##kk[e].w;                          \
      }                                                                                        \
      const float sa = red_lanes<LPR>(sa0 + sa1);                                              \
      float o0 = 0.f, o1 = 0.f;                                                                \
      _Pragma("unroll") for (int e = 0; e < NV4; ++e) {                                        \
        S[4 * e] = S[4 * e] * P##ww[e].x - sa * P##bb[e].x + P##vv * P##kp[e].x;               \
        S[4 * e + 1] = S[4 * e + 1] * P##ww[e].y - sa * P##bb[e].y + P##vv * P##kp[e].y;       \
        S[4 * e + 2] = S[4 * e + 2] * P##ww[e].z - sa * P##bb[e].z + P##vv * P##kp[e].z;       \
        S[4 * e + 3] = S[4 * e + 3] * P##ww[e].w - sa * P##bb[e].w + P##vv * P##kp[e].w;       \
        o0 += S[4 * e] * P##rr[e].x + S[4 * e + 2] * P##rr[e].z;                               \
        o1 += S[4 * e + 1] * P##rr[e].y + S[4 * e + 3] * P##rr[e].w;                           \
      }                                                                                        \
      const float oo = red_lanes<LPR>(o0 + o1);                                                \
      if (q == 0) sO[(st_) * ROWS + row_l] = oo;                                               \
    }
    {
      float4 Akk[NV4], Aww[NV4], Abb[NV4], Akp[NV4], Arr[NV4]; float Avv;
      float4 Bkk[NV4], Bww[NV4], Bbb[NV4], Bkp[NV4], Brr[NV4]; float Bvv;
      if (LPR <= 4) {
#pragma unroll 1
        for (int st = 0; st < nvalid; ++st) { WKV_LOADV(A, st); WKV_STEP(A, st); }
      } else {
        WKV_LOADV(A, 0);
#pragma unroll 1
        for (int st = 0; st < nvalid; st += 2) {
          WKV_LOADV(B, st + 1);
          WKV_STEP(A, st);
          if (st + 2 < nvalid) { WKV_LOADV(A, st + 2); }
          WKV_STEP(B, st + 1);
        }
      }
    }
    __syncthreads();
    for (int i = tid; i < nvalid * ROWS; i += NTHR) {
      const int st = i / ROWS, rr = i % ROWS;
      O[(size_t)(t0 + st) * 1024 + head * 64 + part * ROWS + rr] = f2bf(sO[i]);
    }
  }
#undef WKV_ISSUE
#undef WKV_LOADV
#undef WKV_STEP
  float* dst = prompt ? (p.out + O_RW_P + (((size_t)seq * 16 + head) * 64 + row) * 64 + q * KPL)
                      : (p.out + O_RW_S + (((size_t)(seq - 8) * 16 + head) * 64 + row) * 64 + q * KPL);
#pragma unroll
  for (int e = 0; e < KPL; ++e) dst[e] = S[e];
}

template <int LPRP>
DI void ph_wkv(const Params& p, char* smem) {
  constexpr int NPART = 64 / (256 / LPRP);
  const int G = gridDim.x, bid = blockIdx.x;
  const int nP = 128 * NPART;
#pragma nounroll
  for (int it = bid; it < nP; it += G) {
    const int part = it % NPART, sh = it / NPART;
    wkv_item<LPRP>(p, smem, sh >> 4, sh & 15, part);
  }
  const int nS = 2048;
  int first, step;
  if (G > nP) { first = (bid >= nP) ? (bid - nP) : nS; step = G - nP; }
  else { first = bid; step = G; }
#pragma nounroll
  for (int it = first; it < nS; it += step) wkv_item<4>(p, smem, 8 + (it >> 4), it & 15, 0);
}

DI void ph_wkv_post(const Params& p) {
  const int tid_ = TIDX; const int lane = tid_ & 63;
  const int gw = blockIdx.x * 4 + (tid_ >> 6), nw = gridDim.x * 4;
  const bf16_t* __restrict__ R = (const bf16_t*)(p.ws + SC_R);
  const bf16_t* __restrict__ K = (const bf16_t*)(p.ws + SC_K);
  const bf16_t* __restrict__ V = (const bf16_t*)(p.ws + SC_V);
  const bf16_t* __restrict__ AAc = (const bf16_t*)(p.ws + SC_AA);
  const bf16_t* __restrict__ Gg = (const bf16_t*)(p.ws + SC_G);
  const bf16_t* __restrict__ O = (const bf16_t*)(p.ws + SC_O);
  bf16_t* __restrict__ U = (bf16_t*)(p.ws + W_U);
#pragma unroll 2
  for (int item = gw; item < T_ * 4; item += nw) {
    const int t = item >> 2, col = (item & 3) * 256 + lane * 4;
    const size_t o = (size_t)t * 1024 + col;
    float ov[4], rv[4], kv[4], av[4], vv[4], gv[4];
    unpack4(*(const uint2*)(O + o), ov); unpack4(*(const uint2*)(R + o), rv); unpack4(*(const uint2*)(K + o), kv);
    unpack4(*(const uint2*)(AAc + o), av); unpack4(*(const uint2*)(V + o), vv); unpack4(*(const uint2*)(Gg + o), gv);
    const float4 lw = *(const float4*)(p.in[I_RW_LNW] + col), lb = *(const float4*)(p.in[I_RW_LNB] + col);
    const float4 ka = *(const float4*)(p.in[I_RW_KA] + col), rk = *(const float4*)(p.in[I_RW_RK] + col);
    const float lwv[4] = {lw.x, lw.y, lw.z, lw.w}, lbv[4] = {lb.x, lb.y, lb.z, lb.w};
    const float kav[4] = {ka.x, ka.y, ka.z, ka.w}, rkv[4] = {rk.x, rk.y, rk.z, rk.w};
    const float mean = red_lanes<16>(ov[0] + ov[1] + ov[2] + ov[3]) * (1.f / 64.f);
    float d[4], s2 = 0.f, s3 = 0.f;
#pragma unroll
    for (int e = 0; e < 4; ++e) {
      d[e] = ov[e] - mean; s2 += d[e] * d[e];
      const float kp = kv[e] * (1.f + (av[e] - 1.f) * kav[e]);
      s3 += rv[e] * kp * rkv[e];
    }
    s2 = red_lanes<16>(s2); s3 = red_lanes<16>(s3);
    const float rs = rsqrtf(s2 * (1.f / 64.f) + 64e-5f);
    float y[4];
#pragma unroll
    for (int e = 0; e < 4; ++e) y[e] = (d[e] * rs * lwv[e] + lbv[e] + s3 * vv[e]) * gv[e];
    *(uint2*)(U + o) = make_uint2(pack2(y[0], y[1]), pack2(y[2], y[3]));
  }
}

constexpr int NPH = 40;
#ifndef REP_GEMM
#define REP_GEMM 1
#endif
#ifndef REP_SSD
#define REP_SSD 1
#endif
#ifndef REP_WKV
#define REP_WKV 1
#endif
#ifndef REP_MISC
#define REP_MISC 1
#endif

__global__ void __launch_bounds__(NTHR, 2) mega(Params p) {
  __shared__ __attribute__((aligned(16))) char smem[SMEM_BYTES];
  __shared__ uint4 xb_words;
  cg::grid_group grid = cg::this_grid();
  if (threadIdx.x == 0) xb_words = make_uint4(0u, 0u, 0u, 0u);
  __syncthreads();
  XcdBarrier xb = xcd_barrier_post((unsigned*)(p.ws + W_BAR), (volatile LAS unsigned*)&xb_words);
  int ph = 0;
#define PH(...)                                                     \
  {                                                                 \
    if (ph >= p.ph_begin && ph < p.ph_end) {                        \
      __VA_ARGS__;                                                  \
      xcd_barrier(xb);                                              \
    }                                                               \
    ++ph;                                                           \
  }
#define PHR(rep, ...)                                               \
  {                                                                 \
    if (ph >= p.ph_begin && ph < p.ph_end) {                        \
      for (int rep_ = 0; rep_ < (rep); ++rep_) {                    \
        __VA_ARGS__;                                                \
        xcd_barrier(xb);                                            \
      }                                                             \
    }                                                               \
    ++ph;                                                           \
  }
#define PH_LAST(...)                                                \
  {                                                                 \
    if (ph >= p.ph_begin && ph < p.ph_end) { __VA_ARGS__; }         \
    ++ph;                                                           \
  }
  bf16_t* wt = (bf16_t*)(p.ws + W_WT);
  bf16_t* U = (bf16_t*)(p.ws + W_U);
  float* X = (float*)(p.ws + W_X);

  {
    if (ph >= p.ph_begin && ph < p.ph_end) { ph_prologue(p, smem); grid.sync(); }
    ++ph;
    if (threadIdx.x == 0) {
      unsigned* bar = (unsigned*)(p.ws + W_BAR);
      unsigned base = 0;
      for (unsigned jx = 0; jx < 16; ++jx) { const unsigned c = xb_ld(&bar[XB_XCNT(jx)]); base += (jx < xb.x) ? c : 0u; }
      volatile LAS unsigned* st = (volatile LAS unsigned*)&xb_words;
      st[3] = base + st[2];
    }
    __syncthreads();
  }

#pragma nounroll
  for (int layer = 0; layer < 4; ++layer) {
    const int kind = layer % 3;
    PHR(REP_MISC, ph_rmsnorm(p, kind == 2 ? 1 : 0, p.in[I_NMIX] + layer * 1024));
    if (kind == 0) {
      const int ia = layer / 3;
      PHR(REP_GEMM, {
        GJob j = mkjob(U, 1024, wt + WA_IN + (size_t)ia * 2048 * 1024, 1024, 1024, 2048);
        j.o0 = p.ws + SA_XB; j.o1 = p.ws + SA_GT;
        int toff = 0; gemm_run<EPI_LRU_IN, false>(j, 8, toff, smem, VBLOCK());
      });
      PHR(REP_MISC, (ph_conv<1024, false>((const bf16_t*)(p.ws + SA_XB), (bf16_t*)(p.ws + SA_XC),
                               p.in[I_LRU_CW] + (size_t)ia * 4 * 1024, p.in[I_LRU_CB] + (size_t)ia * 1024,
                               p.in[I_ST_LC] + (size_t)ia * 128 * 3 * 1024,
                               p.out + O_LC_P + (size_t)ia * 8 * 3 * 1024, p.out + O_LC_S + (size_t)ia * 128 * 3 * 1024)));
      PHR(REP_GEMM, {
        const int G = gridDim.x;
        for (int tile = VBLOCK(); tile < MT_ * 8; tile += G) {
          const int mt = tile >> 3, jt = tile & 7;
          GJob j = mkjob((const bf16_t*)(p.ws + SA_XC) + jt * 128, 1024,
                         wt + WA_G + (size_t)ia * 2048 * 128, 128, 128, 2048);
          j.o0 = p.ws + SA_AA; j.o1 = p.ws + SA_XC;
          j.x0 = p.in[I_LRU_BR] + ia * 1024; j.x1 = p.in[I_LRU_BI] + ia * 1024; j.x2 = p.in[I_LRU_LAM] + ia * 1024;
          gemm_tile_dma<EPI_GATES>(j, mt * 128, jt * 256, 0, 4, smem);
        }
      });
      PHR(REP_MISC, ph_lru_scan1(p));
      PH(ph_lru_scan2(p, ia));
      PH({
        GJob j = mkjob((const bf16_t*)(p.ws + SA_GT), 1024, wt + WA_OUT + (size_t)ia * 1024 * 1024, 1024, 1024, 1024);
        j.o0 = X;
        gemm_streamk<EPI_RESID>(j, 4, smem, VBLOCK(), (unsigned*)(p.ws + W_BAR) + 4096, (unsigned)(layer * 2 + 1));
      });
    } else if (kind == 1) {
      PHR(REP_GEMM, {
        GJob j = mkjob(U, 1024, wt + WB_XBC, 1024, 1024, 4128);
        j.o0 = p.ws + SB_XBCP; j.o1 = p.ws + SB_DT; j.x0 = p.in[I_SSM_DTB];
        int toff = 0; gemm_run<EPI_SSM_XBC, false>(j, 17, toff, smem, VBLOCK());
      });
      PHR(REP_MISC, (ph_conv<4096, true>((const bf16_t*)(p.ws + SB_XBCP), (bf16_t*)(p.ws + SB_XBC),
                              p.in[I_SSM_CW], p.in[I_SSM_CB], p.in[I_ST_SC],
                              p.out + O_SC_P, p.out + O_SC_S)));
      PHR(REP_SSD, ph_ssd(p, smem));
      PH({
        GJob j = mkjob(U, 1024, wt + WB_Z, 1024, 1024, 2048);
        j.o0 = p.ws + SB_Y;
        int toff = 0; gemm_run<EPI_SSM_Z, false>(j, 8, toff, smem, VBLOCK());
      });
      PH(ph_gnorm(p));
      PH({
        GJob j = mkjob((const bf16_t*)(p.ws + SB_Y), 2048, wt + WB_OUT, 2048, 2048, 1024);
        j.o0 = X;
        gemm_streamk<EPI_RESID>(j, 4, smem, VBLOCK(), (unsigned*)(p.ws + W_BAR) + 4096, (unsigned)(layer * 2 + 1));
      });
    } else {
      PHR(REP_GEMM, {
        int toff = 0;
        for (int s = 0; s < 3; ++s) {
          GJob j = mkjob(U, 1024, wt + WC_RKV + (size_t)s * 1024 * 1024, 1024, 1024, 1024);
          j.A2 = (const bf16_t*)(p.ws + SC_UP); j.mu = p.in[I_RW_MU] + s * 1024;
          j.o0 = p.ws + SC_R + (size_t)s * SZ_TD2; j.ldo = 1024; j.act = 0;
          gemm_run<EPI_ST, true>(j, 8, toff, smem, VBLOCK());
        }
        for (int s = 0; s < 3; ++s) {
          const int nv = (s == 2) ? 128 : 64;
          GJob j = mkjob(U, 1024, wt + WC_L1 + (size_t)s * 64 * 1024, 1024, 1024, nv);
          j.A2 = (const bf16_t*)(p.ws + SC_UP); j.mu = p.in[I_RW_MU] + (3 + s) * 1024;
          j.o0 = p.ws + SC_LH + (size_t)s * 64 * 2; j.ldo = 256; j.act = (s == 0) ? 1 : (s == 2 ? 2 : 0);
          gemm_run<EPI_ST, true>(j, 1, toff, smem, VBLOCK());
        }
      });
      PHR(REP_GEMM, {
        int toff = 0;
        const bf16_t* LH = (const bf16_t*)(p.ws + SC_LH);
        {
          GJob j = mkjob(LH, 256, wt + WC_W2, 64, 64, 1024);
          j.o0 = p.ws + SC_WD; j.x0 = p.in[I_RW_W0];
          gemm_run<EPI_DECAY, false>(j, 4, toff, smem, VBLOCK());
        }
        {
          GJob j = mkjob(LH + 64, 256, wt + WC_A2, 64, 64, 1024);
          j.o0 = p.ws + SC_AA; j.x0 = p.in[I_RW_A0];
          gemm_run<EPI_SIGB, false>(j, 4, toff, smem, VBLOCK());
        }
        {
          GJob j = mkjob(LH + 128, 256, wt + WC_G2, 128, 128, 1024);
          j.o0 = p.ws + SC_G; j.ldo = 1024; j.act = 0;
          gemm_run<EPI_ST, false>(j, 4, toff, smem, VBLOCK());
        }
      });
      PHR(REP_WKV, ph_wkv<8>(p, smem));
      PHR(REP_MISC, ph_wkv_post(p));
      PH({
        GJob j = mkjob(U, 1024, wt + WC_OUT, 1024, 1024, 1024);
        j.o0 = X;
        gemm_streamk<EPI_RESID>(j, 4, smem, VBLOCK(), (unsigned*)(p.ws + W_BAR) + 4096, (unsigned)(layer * 2 + 1));
      });
    }
    PHR(REP_MISC, ph_rmsnorm(p, 0, p.in[I_NFFN] + layer * 1024));
    PHR(REP_GEMM, {
      GJob j = mkjob(U, 1024, wt + WF_1 + (size_t)layer * 4096 * 1024, 1024, 1024, 4096);
      j.o0 = p.ws + S_HB;
      int toff = 0; gemm_run<EPI_FFN1, false>(j, 16, toff, smem, VBLOCK());
    });
    PH({
      GJob j = mkjob((const bf16_t*)(p.ws + S_HB), 4096, wt + WF_2 + (size_t)layer * 4096 * 1024, 4096, 4096, 1024);
      j.o0 = X;
      gemm_streamk<EPI_RESID>(j, 4, smem, VBLOCK(), (unsigned*)(p.ws + W_BAR) + 4096, (unsigned)(layer * 2 + 2));
    });
  }
  PH_LAST(ph_rmsnorm(p, 2, p.in[I_NFIN]));
#undef PH
#undef PH_LAST
}

extern "C" void kernel_launch(void* const* d_in, const int* in_sizes, int n_in, void* d_out, int out_size,
                              void* d_ws, size_t ws_size, hipStream_t stream) {
  Params p;
  memset(&p, 0, sizeof(p));
  for (int i = 0; i < N_IN; ++i) p.in[i] = (const float*)d_in[i];
  p.out = (float*)d_out;
  p.ws = (char*)d_ws;
  p.ph_begin = 0;
  p.ph_end = 1000;
  static int grid_blocks = 0;
  if (!grid_blocks) {
    int dev = 0, cus = 0, per_cu = 0;
    hipGetDevice(&dev);
    hipDeviceGetAttribute(&cus, hipDeviceAttributeMultiprocessorCount, dev);
    hipOccupancyMaxActiveBlocksPerMultiprocessor(&per_cu, mega, NTHR, 0);
    if (per_cu > 2) per_cu = 2;
    if (per_cu < 1) per_cu = 1;
    grid_blocks = cus * per_cu;
  }
  if (ws_size < (size_t)536870912) fprintf(stderr, "workspace too small: %zu\n", ws_size);
  (void)hipMemsetAsync((char*)d_ws + W_BAR, 0, (4096 + 1024) * 4, stream);
  void* args[] = {&p};
  hipError_t e = hipLaunchCooperativeKernel((void*)mega, dim3(grid_blocks), dim3(NTHR), args, 0, stream);
  if (e != hipSuccess) fprintf(stderr, "cooperative launch failed: %s (grid %d)\n", hipGetErrorString(e), grid_blocks);
}
```

```cpp
#include <hip/hip_runtime.h>
#include <hip/hip_cooperative_groups.h>
#include <stdint.h>
#include <stdio.h>
#include <string.h>
namespace cg = cooperative_groups;

typedef unsigned short bf16_t;
typedef __attribute__((ext_vector_type(8))) short bf16x8;
typedef __attribute__((ext_vector_type(16))) float f32x16;

#define DI __device__ __forceinline__

constexpr int T_ = 17408;
constexpr int TP_ = 16384;
constexpr int NTHR = 256;
constexpr int MT_ = T_ / 128;

enum {
  I_XP = 0, I_XS, I_ST_LC, I_ST_LH, I_ST_SC, I_ST_SS, I_ST_RS, I_ST_RW,
  I_NMIX, I_NFFN, I_NFIN,
  I_LRU_WIN, I_LRU_CW, I_LRU_CB, I_LRU_WR, I_LRU_BR, I_LRU_WI, I_LRU_BI, I_LRU_LAM, I_LRU_WOUT,
  I_SSM_WIN, I_SSM_CW, I_SSM_CB, I_SSM_DTB, I_SSM_ALOG, I_SSM_D, I_SSM_NW, I_SSM_WOUT,
  I_RW_MU, I_RW_WRKV, I_RW_W0, I_RW_WW1, I_RW_WW2, I_RW_A0, I_RW_WA1, I_RW_WA2, I_RW_WG1, I_RW_WG2,
  I_RW_KK, I_RW_KA, I_RW_RK, I_RW_LNW, I_RW_LNB, I_RW_WOUT,
  I_FFN_W1, I_FFN_W2, N_IN
};

constexpr size_t O_Y = 0;
constexpr size_t O_LC_P = O_Y + (size_t)T_ * 1024;
constexpr size_t O_LC_S = O_LC_P + 2 * 8 * 3 * 1024;
constexpr size_t O_LH_P = O_LC_S + 2 * 128 * 3 * 1024;
constexpr size_t O_LH_S = O_LH_P + 2 * 8 * 1024;
constexpr size_t O_SC_P = O_LH_S + 2 * 128 * 1024;
constexpr size_t O_SC_S = O_SC_P + 8 * 3 * 4096;
constexpr size_t O_SS_P = O_SC_S + 128 * 3 * 4096;
constexpr size_t O_SS_S = O_SS_P + (size_t)8 * 32 * 64 * 128;
constexpr size_t O_RS_P = O_SS_S + (size_t)128 * 32 * 64 * 128;
constexpr size_t O_RS_S = O_RS_P + 8 * 1024;
constexpr size_t O_RW_P = O_RS_S + 128 * 1024;
constexpr size_t O_RW_S = O_RW_P + 8 * 16 * 64 * 64;

constexpr size_t W_X = 0;
constexpr size_t W_U = W_X + (size_t)T_ * 1024 * 4;
constexpr size_t W_WT = W_U + (size_t)T_ * 1024 * 2;
constexpr size_t WA_IN = 0;
constexpr size_t WA_G = WA_IN + 2 * 2048 * 1024;
constexpr size_t WA_OUT = WA_G + 2 * 2048 * 128;
constexpr size_t WB_XBC = WA_OUT + 2 * 1024 * 1024;
constexpr size_t WB_Z = WB_XBC + 4128 * 1024;
constexpr size_t WB_OUT = WB_Z + 2048 * 1024;
constexpr size_t WC_RKV = WB_OUT + 1024 * 2048;
constexpr size_t WC_L1 = WC_RKV + 3 * 1024 * 1024;
constexpr size_t WC_W2 = WC_L1 + 256 * 1024;
constexpr size_t WC_A2 = WC_W2 + 1024 * 64;
constexpr size_t WC_G2 = WC_A2 + 1024 * 64;
constexpr size_t WC_OUT = WC_G2 + 1024 * 128;
constexpr size_t WF_1 = WC_OUT + 1024 * 1024;
constexpr size_t WF_2 = WF_1 + (size_t)4 * 4096 * 1024;
constexpr size_t W_WT_ELEMS = WF_2 + (size_t)4 * 4096 * 1024;
constexpr size_t W_S = W_WT + W_WT_ELEMS * 2;
constexpr size_t SZ_TD2 = (size_t)T_ * 1024 * 2;
constexpr size_t SZ_TD4 = (size_t)T_ * 1024 * 4;
constexpr size_t S_HB = W_S;
constexpr size_t SA_XB = W_S;
constexpr size_t SA_GT = SA_XB + SZ_TD2;
constexpr size_t SA_XC = SA_GT + SZ_TD2;
constexpr size_t SA_AA = SA_XC + SZ_TD2;
constexpr size_t SA_BB = SA_AA + SZ_TD4;
constexpr size_t SA_CP = SA_BB + SZ_TD4;
constexpr size_t SA_CS = SA_CP + 8 * 64 * 1024 * 4;
constexpr size_t SB_XBCP = W_S;
constexpr size_t SB_Y = W_S;
constexpr size_t SB_XBC = SB_XBCP + SZ_TD2 * 4;
constexpr size_t SB_DT = SB_XBC + SZ_TD2 * 4;
constexpr size_t SC_UP = W_S;
constexpr size_t SC_O = W_S;
constexpr size_t SC_R = SC_UP + SZ_TD2;
constexpr size_t SC_K = SC_R + SZ_TD2;
constexpr size_t SC_V = SC_K + SZ_TD2;
constexpr size_t SC_LH = SC_V + SZ_TD2;
constexpr size_t SC_WD = SC_LH + (size_t)T_ * 256 * 2;
constexpr size_t SC_AA = SC_WD + SZ_TD4;
constexpr size_t SC_G = SC_AA + SZ_TD2;
constexpr size_t SC_END = SC_G + SZ_TD2;
static_assert(SC_END <= (size_t)536870912, "ws overflow C");
static_assert(SB_DT + (size_t)T_ * 32 * 4 <= (size_t)536870912, "ws overflow B");
static_assert(SA_CS + 8 * 64 * 1024 * 4 <= (size_t)536870912, "ws overflow A");

constexpr int SMEM_BYTES = 80384;
constexpr size_t W_BAR = (size_t)536870912 - 65536;

struct Params {
  const float* in[N_IN];
  float* out;
  char* ws;
  int ph_begin, ph_end;
};

DI float bf2f(bf16_t h) { return __uint_as_float(((unsigned)h) << 16); }
DI bf16_t f2bf(float f) {
  unsigned u = __float_as_uint(f);
  u += 0x7FFFu + ((u >> 16) & 1u);
  return (bf16_t)(u >> 16);
}
DI unsigned pack2(float a, float b) { return (unsigned)f2bf(a) | ((unsigned)f2bf(b) << 16); }
DI void unpack8(const uint4 v, float (&f)[8]) {
  f[0] = __uint_as_float(v.x << 16); f[1] = __uint_as_float(v.x & 0xFFFF0000u);
  f[2] = __uint_as_float(v.y << 16); f[3] = __uint_as_float(v.y & 0xFFFF0000u);
  f[4] = __uint_as_float(v.z << 16); f[5] = __uint_as_float(v.z & 0xFFFF0000u);
  f[6] = __uint_as_float(v.w << 16); f[7] = __uint_as_float(v.w & 0xFFFF0000u);
}
DI void unpack4(const uint2 v, float (&f)[4]) {
  f[0] = __uint_as_float(v.x << 16); f[1] = __uint_as_float(v.x & 0xFFFF0000u);
  f[2] = __uint_as_float(v.y << 16); f[3] = __uint_as_float(v.y & 0xFFFF0000u);
}
DI uint4 pack8(const float (&f)[8]) {
  return make_uint4(pack2(f[0], f[1]), pack2(f[2], f[3]), pack2(f[4], f[5]), pack2(f[6], f[7]));
}
DI void load8f(const float* p, float (&f)[8]) {
  float4 a = *(const float4*)p, b = *(const float4*)(p + 4);
  f[0] = a.x; f[1] = a.y; f[2] = a.z; f[3] = a.w; f[4] = b.x; f[5] = b.y; f[6] = b.z; f[7] = b.w;
}
DI void store8f(float* p, const float (&f)[8]) {
  *(float4*)p = make_float4(f[0], f[1], f[2], f[3]);
  *(float4*)(p + 4) = make_float4(f[4], f[5], f[6], f[7]);
}
DI float sigmoidf_(float x) { return 1.f / (1.f + __expf(-x)); }
DI float siluf_(float x) { return x / (1.f + __expf(-x)); }
DI float tanhf_(float y) { return 1.f - 2.f / (1.f + __expf(2.f * y)); }
DI float geluf_(float x) { return 0.5f * x * (1.f + tanhf_(0.7978845608028654f * (x + 0.044715f * x * x * x))); }
DI float softplusf_(float x) { return fmaxf(x, 0.f) + log1pf(__expf(-fabsf(x))); }
DI float softplus_fast(float x) { return fmaxf(x, 0.f) + __logf(1.f + __expf(-fabsf(x))); }
DI float wave_sum(float v) {
#pragma unroll
  for (int o = 32; o >= 1; o >>= 1) v += __shfl_xor(v, o, 64);
  return v;
}
template <int CTRL> DI float dppf(float x) {
  return __int_as_float(__builtin_amdgcn_update_dpp(0, __float_as_int(x), CTRL, 0xf, 0xf, false));
}
template <int N> DI float red_lanes(float x) {
  x += dppf<0xB1>(x);
  x += dppf<0x4E>(x);
  if (N >= 8) x += dppf<0x141>(x);
  if (N >= 16) x += dppf<0x140>(x);
  return x;
}
DI void tok_info(int t, int& seq, int& l, int& L) {
  if (t < TP_) { seq = t >> 11; l = t & 2047; L = 2048; }
  else { int u = t - TP_; seq = 8 + (u >> 3); l = u & 7; L = 8; }
}
DI int opq(int x) { asm volatile("" : "+v"(x)); return x; }
#define TIDX opq((int)threadIdx.x)
DI f32x16 mfma32(bf16x8 a, bf16x8 b, f32x16 c) { return __builtin_amdgcn_mfma_f32_32x32x16_bf16(a, b, c, 0, 0, 0); }


#define XB_TMO      128
#define XB_XCNT(j)  (256  + 64 * (j))
#define XB_XSUB(j)  (1280 + 64 * (j))
#define XB_XGEN(j)  (2304 + 64 * (j))
#define XB_TOP      3328
#define XB_TOPGEN   3392
#define XCD_BAR_WORDS 3456
#define XB_SPIN_CAP (1u << 22)
#define LAS __attribute__((address_space(3)))
DI unsigned xb_ld(unsigned* p) { return __hip_atomic_load(p, __ATOMIC_RELAXED, __HIP_MEMORY_SCOPE_AGENT); }
DI unsigned xb_add(unsigned* p, unsigned v) { return __hip_atomic_fetch_add(p, v, __ATOMIC_RELAXED, __HIP_MEMORY_SCOPE_AGENT); }
DI unsigned xb_xcc_id() { return (unsigned)__builtin_amdgcn_s_getreg((3 << 11) | 20) & 0xFu; }
#define XB_SPIN(cond, bar) do { unsigned _sp = 0; while (cond) { __builtin_amdgcn_s_sleep(1); \
    if ((++_sp & 255u) == 0u) { if (xb_ld(&(bar)[XB_TMO])) break; if (_sp > XB_SPIN_CAP) { atomicAdd(&(bar)[XB_TMO], 1u); break; } } } } while (0)
struct XcdBarrier { unsigned* bar; unsigned x; volatile LAS unsigned* st; };
DI XcdBarrier xcd_barrier_post(unsigned* bar, volatile LAS unsigned* st) {
  XcdBarrier b; b.bar = bar; b.x = xb_xcc_id(); b.st = st;
  if (threadIdx.x == 0) st[2] = xb_add(&bar[XB_XCNT(b.x)], 1u);
  return b;
}
DI void xcd_barrier_complete(unsigned* bar, unsigned x, unsigned& nloc, unsigned& nx) {
  const unsigned G = gridDim.x * gridDim.y * gridDim.z;
  unsigned sum, cnt, mine, sp = 0u;
  for (;;) {
    sum = 0u; cnt = 0u; mine = 0u;
#pragma unroll
    for (unsigned j = 0; j < 16; ++j) { const unsigned c = xb_ld(&bar[XB_XCNT(j)]); sum += c; cnt += (c > 0u) ? 1u : 0u; mine = (j == x) ? c : mine; }
    if (sum == G) break;
    __builtin_amdgcn_s_sleep(1);
    if ((++sp & 255u) == 0u) { if (xb_ld(&bar[XB_TMO])) break; if (sp > XB_SPIN_CAP) { atomicAdd(&bar[XB_TMO], 1u); break; } }
  }
  nloc = mine > 0u ? mine : 1u; nx = cnt > 0u ? cnt : 1u;
}
DI void xcd_barrier(const XcdBarrier& b) {
  asm volatile("s_waitcnt vmcnt(0)" ::: "memory");
  __syncthreads();
  if (threadIdx.x == 0) {
    unsigned* bar = b.bar;
    __builtin_amdgcn_s_waitcnt(0);
    unsigned nloc = b.st[0], nx = b.st[1];
    if (nloc == 0u) { xcd_barrier_complete(bar, b.x, nloc, nx); b.st[0] = nloc; b.st[1] = nx; }
    const unsigned old = xb_add(&bar[XB_XSUB(b.x)], 1u);
    const unsigned gen = old / nloc;
    if (old + 1u == (gen + 1u) * nloc) {
      __builtin_amdgcn_fence(__ATOMIC_RELEASE, "agent");
      asm volatile("s_waitcnt vmcnt(0)" ::: "memory");
      const unsigned og = xb_add(&bar[XB_TOP], 1u);
      const unsigned tg = og / nx;
      if (og + 1u == (tg + 1u) * nx) xb_add(&bar[XB_TOPGEN], 1u);
      else XB_SPIN(xb_ld(&bar[XB_TOPGEN]) == tg, bar);
      __builtin_amdgcn_fence(__ATOMIC_ACQUIRE, "agent");
      xb_add(&bar[XB_XGEN(b.x)], 1u);
      asm volatile("s_waitcnt vmcnt(0)" ::: "memory");
    } else {
      XB_SPIN(xb_ld(&bar[XB_XGEN(b.x)]) == gen, bar);
      __builtin_amdgcn_fence(__ATOMIC_ACQUIRE, "agent");
      asm volatile("s_waitcnt vmcnt(0)" ::: "memory");
    }
  }
  __syncthreads();
}

struct GJob {
  const bf16_t* A; const bf16_t* A2; const float* mu; const bf16_t* Bt;
  int lda, ldb, K, nvalid;
  void* o0; void* o1; const float* x0; const float* x1; const float* x2;
  int ldo, act;
};
enum { EPI_LRU_IN = 0, EPI_GATES, EPI_RESID, EPI_SSM_XBC, EPI_SSM_Z, EPI_FFN1, EPI_ST, EPI_DECAY, EPI_SIGB };

template <int EPI> DI void epi_elem(const GJob& j, int row, int col, float v) {
  if (EPI == EPI_LRU_IN) {
    if (col < 1024) ((bf16_t*)j.o0)[(size_t)row * 1024 + col] = f2bf(v);
    else ((bf16_t*)j.o1)[(size_t)row * 1024 + col - 1024] = f2bf(geluf_(v));
  } else if (EPI == EPI_RESID) {
    unsafeAtomicAdd((float*)j.o0 + (size_t)row * 1024 + col, v);
  } else if (EPI == EPI_SSM_XBC) {
    if (col < 4096) ((bf16_t*)j.o0)[(size_t)row * 4096 + col] = f2bf(v);
  } else if (EPI == EPI_SSM_Z) {
    bf16_t* y = (bf16_t*)j.o0 + (size_t)row * 2048 + col;
    *y = f2bf(bf2f(*y) * siluf_(v));
  } else if (EPI == EPI_FFN1) {
    float r = fmaxf(v, 0.f);
    ((bf16_t*)j.o0)[(size_t)row * 4096 + col] = f2bf(r * r);
  } else if (EPI == EPI_ST) {
    if (col < j.nvalid) {
      float r = v;
      if (j.act == 1) r = tanhf_(v); else if (j.act == 2) r = sigmoidf_(v);
      ((bf16_t*)j.o0)[(size_t)row * j.ldo + col] = f2bf(r);
    }
  } else if (EPI == EPI_DECAY) {
    float wl = -softplusf_(-(j.x0[col] + v)) - 0.5f;
    ((float*)j.o0)[(size_t)row * 1024 + col] = __expf(-__expf(wl));
  } else if (EPI == EPI_SIGB) {
    ((bf16_t*)j.o0)[(size_t)row * 1024 + col] = f2bf(sigmoidf_(j.x0[col] + v));
  }
}

DI void quad_transpose4(float (&v)[4], int l) {
  const bool o1 = l & 1, o2 = l & 2;
  {
    const float s01 = o1 ? v[0] : v[1], s23 = o1 ? v[2] : v[3];
    const float r01 = dppf<0xB1>(s01), r23 = dppf<0xB1>(s23);
    if (o1) { v[0] = r01; v[2] = r23; } else { v[1] = r01; v[3] = r23; }
  }
  {
    const float s02 = o2 ? v[0] : v[2], s13 = o2 ? v[1] : v[3];
    const float r02 = dppf<0x4E>(s02), r13 = dppf<0x4E>(s13);
    if (o2) { v[0] = r02; v[1] = r13; } else { v[2] = r02; v[3] = r13; }
  }
}
DI uint2 pack4(float a, float b, float c, float d) { return make_uint2(pack2(a, b), pack2(c, d)); }
template <int EPI> DI void epi4(const GJob& j, int row, int col, const float (&v)[4]) {
  if (EPI == EPI_LRU_IN) {
    if (col < 1024) *(uint2*)((bf16_t*)j.o0 + (size_t)row * 1024 + col) = pack4(v[0], v[1], v[2], v[3]);
    else *(uint2*)((bf16_t*)j.o1 + (size_t)row * 1024 + col - 1024) = pack4(geluf_(v[0]), geluf_(v[1]), geluf_(v[2]), geluf_(v[3]));
  } else if (EPI == EPI_RESID) {
    float4* x = (float4*)((float*)j.o0 + (size_t)row * 1024 + col);
    float4 t = *x; t.x += v[0]; t.y += v[1]; t.z += v[2]; t.w += v[3]; *x = t;
  } else if (EPI == EPI_SSM_XBC) {
    if (col < 4096) *(uint2*)((bf16_t*)j.o0 + (size_t)row * 4096 + col) = pack4(v[0], v[1], v[2], v[3]);
  } else if (EPI == EPI_SSM_Z) {
    uint2* y = (uint2*)((bf16_t*)j.o0 + (size_t)row * 2048 + col);
    float f[4]; unpack4(*y, f);
    *y = pack4(f[0] * siluf_(v[0]), f[1] * siluf_(v[1]), f[2] * siluf_(v[2]), f[3] * siluf_(v[3]));
  } else if (EPI == EPI_FFN1) {
    const float r0 = fmaxf(v[0], 0.f), r1 = fmaxf(v[1], 0.f), r2 = fmaxf(v[2], 0.f), r3 = fmaxf(v[3], 0.f);
    *(uint2*)((bf16_t*)j.o0 + (size_t)row * 4096 + col) = pack4(r0 * r0, r1 * r1, r2 * r2, r3 * r3);
  } else if (EPI == EPI_ST) {
    if (col < j.nvalid) {
      float r[4];
#pragma unroll
      for (int e = 0; e < 4; ++e) r[e] = (j.act == 1) ? tanhf_(v[e]) : ((j.act == 2) ? sigmoidf_(v[e]) : v[e]);
      *(uint2*)((bf16_t*)j.o0 + (size_t)row * j.ldo + col) = pack4(r[0], r[1], r[2], r[3]);
    }
  } else if (EPI == EPI_DECAY) {
    const float4 w0 = *(const float4*)(j.x0 + col);
    const float w[4] = {w0.x, w0.y, w0.z, w0.w};
    float r[4];
#pragma unroll
    for (int e = 0; e < 4; ++e) r[e] = __expf(-__expf(-softplus_fast(-(w[e] + v[e])) - 0.5f));
    *(float4*)((float*)j.o0 + (size_t)row * 1024 + col) = make_float4(r[0], r[1], r[2], r[3]);
  } else if (EPI == EPI_SIGB) {
    const float4 a0 = *(const float4*)(j.x0 + col);
    *(uint2*)((bf16_t*)j.o0 + (size_t)row * 1024 + col) =
        pack4(sigmoidf_(a0.x + v[0]), sigmoidf_(a0.y + v[1]), sigmoidf_(a0.z + v[2]), sigmoidf_(a0.w + v[3]));
  }
}

template <int EPI, bool MIX>
DI void gemm_tile(const GJob& j, int m0, int n0, int kt0, int kt1, char* smem) {
  const int tid = TIDX, lane = tid & 63, w = tid >> 6;
  const int wm = w >> 1, wn = w & 1, r32 = lane & 31, hh = lane >> 5;
  const int lrow = tid >> 3, kc = tid & 7;
  f32x16 acc[2][2];
#pragma unroll
  for (int a = 0; a < 2; ++a)
#pragma unroll
    for (int b = 0; b < 2; ++b)
#pragma unroll
      for (int r = 0; r < 16; ++r) acc[a][b][r] = 0.f;
  uint4 qa00, qa01, qa02, qa03, qb00, qb01, qb02, qb03, qc00, qc01, qc02, qc03;
  uint4 qa10, qa11, qa12, qa13, qb10, qb11, qb12, qb13, qc10, qc11, qc12, qc13;
  qc00 = qc01 = qc02 = qc03 = qc10 = qc11 = qc12 = qc13 = make_uint4(0, 0, 0, 0);
  const int nk = kt1 - kt0;
  const bf16_t* Ap = j.A + (size_t)(m0 + lrow) * j.lda + kc * 8 + (size_t)kt0 * 64;
  const bf16_t* A2p = MIX ? (j.A2 + (size_t)(m0 + lrow) * j.lda + kc * 8 + (size_t)kt0 * 64) : nullptr;
  const bf16_t* Bp = j.Bt + (size_t)(n0 + lrow) * j.ldb + kc * 8 + (size_t)kt0 * 64;
  const size_t astep = (size_t)32 * j.lda, bstep = (size_t)32 * j.ldb;
  const bool bv0 = (n0 + lrow) < j.nvalid, bv1 = (n0 + lrow + 32) < j.nvalid;
  const bool bv2 = (n0 + lrow + 64) < j.nvalid, bv3 = (n0 + lrow + 96) < j.nvalid;
  const uint4 z4 = make_uint4(0, 0, 0, 0);

#define LD1(s, i, kt)                                                                 \
  qa##s##i = *(const uint4*)(Ap + i * astep + (kt) * 64);                             \
  if (MIX) qc##s##i = *(const uint4*)(A2p + i * astep + (kt) * 64);                   \
  qb##s##i = z4;                                                                      \
  if (bv##i) qb##s##i = *(const uint4*)(Bp + i * bstep + (kt) * 64);
#define GLOAD(s, kt) { LD1(s, 0, kt) LD1(s, 1, kt) LD1(s, 2, kt) LD1(s, 3, kt) }
#define ST1(s, i, As_, Bs_)                                                           \
  if (MIX) {                                                                          \
    float f1[8], f2[8]; unpack8(qa##s##i, f1); unpack8(qc##s##i, f2);                 \
    _Pragma("unroll") for (int e = 0; e < 8; ++e) f1[e] = f1[e] + (f2[e] - f1[e]) * mu8[e]; \
    qa##s##i = pack8(f1);                                                             \
  }                                                                                   \
  *(uint4*)(As_ + (lrow + 32 * i) * 144 + kc * 16) = qa##s##i;                        \
  *(uint4*)(Bs_ + (lrow + 32 * i) * 144 + kc * 16) = qb##s##i;
#define SSTORE(s, kt, buf)                                                            \
  {                                                                                   \
    char* As_ = smem + (buf) * 36864; char* Bs_ = As_ + 18432;                        \
    float mu8[8];                                                                     \
    if (MIX) load8f(j.mu + (kt0 + (kt)) * 64 + kc * 8, mu8);                          \
    ST1(s, 0, As_, Bs_) ST1(s, 1, As_, Bs_) ST1(s, 2, As_, Bs_) ST1(s, 3, As_, Bs_)   \
  }
#define LOADF(F, ks)                                                                  \
  bf16x8 F##a0 = *(const bf16x8*)(ap + (ks) * 32);                                    \
  bf16x8 F##a1 = *(const bf16x8*)(ap + 32 * 144 + (ks) * 32);                         \
  bf16x8 F##b0 = *(const bf16x8*)(bp + (ks) * 32);                                    \
  bf16x8 F##b1 = *(const bf16x8*)(bp + 32 * 144 + (ks) * 32);
#define MFMA4(F)                                                                      \
  acc[0][0] = mfma32(F##a0, F##b0, acc[0][0]);                                        \
  acc[0][1] = mfma32(F##a0, F##b1, acc[0][1]);                                        \
  acc[1][0] = mfma32(F##a1, F##b0, acc[1][0]);                                        \
  acc[1][1] = mfma32(F##a1, F##b1, acc[1][1]);
#define COMPUTE(buf)                                                                  \
  {                                                                                   \
    const char* As_ = smem + (buf) * 36864; const char* Bs_ = As_ + 18432;            \
    const char* ap = As_ + (wm * 64 + r32) * 144 + hh * 16;                           \
    const char* bp = Bs_ + (wn * 64 + r32) * 144 + hh * 16;                           \
    LOADF(f0, 0) LOADF(f1, 1)                                                         \
    __builtin_amdgcn_sched_barrier(0);                                                \
    MFMA4(f0)                                                                         \
    LOADF(f2, 2)                                                                      \
    __builtin_amdgcn_sched_barrier(0);                                                \
    MFMA4(f1)                                                                         \
    LOADF(f3, 3)                                                                      \
    __builtin_amdgcn_sched_barrier(0);                                                \
    MFMA4(f2)                                                                         \
    __builtin_amdgcn_sched_barrier(0);                                                \
    MFMA4(f3)                                                                         \
    __builtin_amdgcn_sched_barrier(0);                                                \
  }

  qa10 = qa11 = qa12 = qa13 = qb10 = qb11 = qb12 = qb13 = z4;
  if (MIX) {
    GLOAD(0, 0);
    SSTORE(0, 0, 0);
    __syncthreads();
    for (int i = 0; i < nk; ++i) {
      if (i + 1 < nk) GLOAD(0, i + 1);
      if (i & 1) { COMPUTE(1); } else { COMPUTE(0); }
      if (i + 1 < nk) { if (i & 1) { SSTORE(0, i + 1, 0); } else { SSTORE(0, i + 1, 1); } }
      __syncthreads();
    }
  } else if (nk == 1) {
    GLOAD(0, 0);
    SSTORE(0, 0, 0);
    __syncthreads();
    COMPUTE(0);
    __syncthreads();
  } else {
    GLOAD(0, 0);
    GLOAD(1, 1);
    SSTORE(0, 0, 0);
    __syncthreads();
#pragma unroll 1
    for (int i = 0; i + 2 < nk; i += 2) {
      GLOAD(0, i + 2);
      COMPUTE(0);
      SSTORE(1, i + 1, 1);
      __syncthreads();
      GLOAD(1, i + 3);
      COMPUTE(1);
      SSTORE(0, i + 2, 0);
      __syncthreads();
    }
    COMPUTE(0);
    SSTORE(1, nk - 1, 1);
    __syncthreads();
    COMPUTE(1);
    __syncthreads();
  }
#undef LD1
#undef ST1
#undef LOADF
#undef MFMA4
#undef GLOAD
#undef SSTORE
#undef COMPUTE

  if (EPI == EPI_GATES) {
    const int ch = (n0 >> 7) * 64 + wn * 32 + r32;
    const float br = j.x0[ch], bi = j.x1[ch];
    const float spl = softplusf_(-j.x2[ch]);
    const bf16_t* XC = (const bf16_t*)j.o1;
    float* AA = (float*)j.o0;
    float* BBp = AA + (size_t)T_ * 1024;
#pragma unroll
    for (int mi = 0; mi < 2; ++mi)
#pragma unroll
      for (int r = 0; r < 16; ++r) {
        const int row = m0 + wm * 64 + mi * 32 + (r & 3) + 8 * (r >> 2) + 4 * hh;
        const float rg = sigmoidf_(acc[mi][0][r] + br);
        const float ig = sigmoidf_(acc[mi][1][r] + bi);
        const float la = -8.f * rg * spl;
        const float xc = bf2f(XC[(size_t)row * 1024 + ch]);
        const bool reset = (row < TP_) && ((row & 2047) == 0);
        const float a = reset ? 0.f : __expf(la);
        const float mult = reset ? 1.f : sqrtf(fmaxf(-expm1f(2.f * la), 0.f));
        AA[(size_t)row * 1024 + ch] = a;
        BBp[(size_t)row * 1024 + ch] = mult * ig * xc;
      }
  } else {
#pragma unroll
    for (int mi = 0; mi < 2; ++mi)
#pragma unroll
      for (int ni = 0; ni < 2; ++ni)
#pragma unroll
        for (int r = 0; r < 16; ++r) {
          const int row = m0 + wm * 64 + mi * 32 + (r & 3) + 8 * (r >> 2) + 4 * hh;
          const int col = n0 + wn * 64 + ni * 32 + r32;
          epi_elem<EPI>(j, row, col, acc[mi][ni][r]);
          if ((r & 7) == 7) __builtin_amdgcn_sched_barrier(0);
        }
  }
}

constexpr int DSLOT = 24576;
template <int EPI>
DI void gemm_tile_dma(const GJob& j, int m0, int n0, int k0, int k1, char* smem, unsigned* wflag = nullptr, unsigned epoch = 0u) {
  const int tid = TIDX, lane = tid & 63, w = tid >> 6;
  const int wm = w >> 1, wn = w & 1, r32 = lane & 31, hh = lane >> 5;
  f32x16 acc[2][4];
#pragma unroll
  for (int a = 0; a < 2; ++a)
#pragma unroll
    for (int b = 0; b < 4; ++b)
#pragma unroll
      for (int r = 0; r < 16; ++r) acc[a][b][r] = 0.f;
  const int nk = k1 - k0;
  const int dr = lane >> 2;
  const int dc = (lane & 3) ^ ((lane >> 4) & 3);
  const int nlim = j.nvalid - 1;
  const size_t kofs = (size_t)k0 * 32 + dc * 8;
  const bf16_t* gA0 = j.A + (size_t)(m0 + 32 * w + dr) * j.lda + kofs;
  const bf16_t* gA1 = j.A + (size_t)(m0 + 32 * w + 16 + dr) * j.lda + kofs;
  const bf16_t* gB0 = j.Bt + (size_t)min(n0 + 64 * w + dr, nlim) * j.ldb + kofs;
  const bf16_t* gB1 = j.Bt + (size_t)min(n0 + 64 * w + 16 + dr, nlim) * j.ldb + kofs;
  const bf16_t* gB2 = j.Bt + (size_t)min(n0 + 64 * w + 32 + dr, nlim) * j.ldb + kofs;
  const bf16_t* gB3 = j.Bt + (size_t)min(n0 + 64 * w + 48 + dr, nlim) * j.ldb + kofs;
  char* ldsA = smem + (2 * w) * 1024 + lane * 16;
  char* ldsB = smem + 8192 + (4 * w) * 1024 + lane * 16;
  const unsigned lbase = (unsigned)(unsigned long long)(LAS char*)smem;
  const int fsw = (r32 >> 2) & 3;
  const unsigned pa = (unsigned)((wm * 64 + r32) * 64), pb = (unsigned)(8192 + (wn * 128 + r32) * 64);
  const unsigned po0 = (unsigned)(((hh) ^ fsw) * 16), po1 = (unsigned)(((2 + hh) ^ fsw) * 16);

#define DMA1(gp, lp) __builtin_amdgcn_global_load_lds((const unsigned*)(gp), (unsigned*)(lp), 16, 0, 0)
#define ISSUE(kt, slot)                                                                          \
  {                                                                                              \
    const int ko_ = (kt) * 32;                                                                   \
    char* la_ = ldsA + (slot) * DSLOT; char* lb_ = ldsB + (slot) * DSLOT;                        \
    DMA1(gA0 + ko_, la_); DMA1(gA1 + ko_, la_ + 1024);                                           \
    DMA1(gB0 + ko_, lb_); DMA1(gB1 + ko_, lb_ + 1024); DMA1(gB2 + ko_, lb_ + 2048); DMA1(gB3 + ko_, lb_ + 3072); \
  }
#define SB_ __builtin_amdgcn_sched_barrier(0)

  asm volatile("s_waitcnt vmcnt(0)" ::: "memory");
  const int last = nk - 1;
  ISSUE(0, 0);
  { const int t1 = min(1, last); ISSUE(t1, 1); }
  int sl_r = 0, sl_w = 2;
#pragma unroll 1
  for (int i = 0; i < nk; ++i) {
    asm volatile("s_waitcnt vmcnt(6)" ::: "memory");
    __builtin_amdgcn_s_barrier();
    const int ko2 = min(i + 2, last) * 32;
    char* la2 = ldsA + sl_w * DSLOT; char* lb2 = ldsB + sl_w * DSLOT;
    const unsigned sl = lbase + (unsigned)(sl_r * DSLOT);
    sl_r = (sl_r == 2) ? 0 : sl_r + 1;
    sl_w = (sl_w == 2) ? 0 : sl_w + 1;
    bf16x8 a00, a10, a01, a11, b00, b10, b20, b30, b01, b11, b21, b31;
    const unsigned aA0 = sl + pa + po0, aB0 = sl + pb + po0, aA1 = sl + pa + po1, aB1 = sl + pb + po1;
    asm volatile("ds_read_b128 %0, %1" : "=v"(a00) : "v"(aA0));
    asm volatile("ds_read_b128 %0, %1 offset:2048" : "=v"(a10) : "v"(aA0));
    asm volatile("ds_read_b128 %0, %1" : "=v"(b00) : "v"(aB0));
    asm volatile("ds_read_b128 %0, %1 offset:2048" : "=v"(b10) : "v"(aB0));
    asm volatile("ds_read_b128 %0, %1 offset:4096" : "=v"(b20) : "v"(aB0));
    asm volatile("ds_read_b128 %0, %1 offset:6144" : "=v"(b30) : "v"(aB0));
    asm volatile("ds_read_b128 %0, %1" : "=v"(a01) : "v"(aA1));
    asm volatile("ds_read_b128 %0, %1 offset:2048" : "=v"(a11) : "v"(aA1));
    asm volatile("ds_read_b128 %0, %1" : "=v"(b01) : "v"(aB1));
    asm volatile("ds_read_b128 %0, %1 offset:2048" : "=v"(b11) : "v"(aB1));
    asm volatile("ds_read_b128 %0, %1 offset:4096" : "=v"(b21) : "v"(aB1));
    asm volatile("ds_read_b128 %0, %1 offset:6144" : "=v"(b31) : "v"(aB1));
    DMA1(gA0 + ko2, la2);
    asm volatile("s_waitcnt lgkmcnt(0)" : "+v"(a00), "+v"(a10), "+v"(b00), "+v"(b10), "+v"(b20), "+v"(b30),
                 "+v"(a01), "+v"(a11), "+v"(b01), "+v"(b11), "+v"(b21), "+v"(b31) :: "memory");
    acc[0][0] = mfma32(a00, b00, acc[0][0]);
    acc[0][1] = mfma32(a00, b10, acc[0][1]);
    acc[0][2] = mfma32(a00, b20, acc[0][2]);
    SB_; DMA1(gA1 + ko2, la2 + 1024); SB_;
    acc[0][3] = mfma32(a00, b30, acc[0][3]);
    acc[1][0] = mfma32(a10, b00, acc[1][0]);
    acc[1][1] = mfma32(a10, b10, acc[1][1]);
    SB_; DMA1(gB0 + ko2, lb2); SB_;
    acc[1][2] = mfma32(a10, b20, acc[1][2]);
    acc[1][3] = mfma32(a10, b30, acc[1][3]);
    acc[0][0] = mfma32(a01, b01, acc[0][0]);
    SB_; DMA1(gB1 + ko2, lb2 + 1024); SB_;
    acc[0][1] = mfma32(a01, b11, acc[0][1]);
    acc[0][2] = mfma32(a01, b21, acc[0][2]);
    acc[0][3] = mfma32(a01, b31, acc[0][3]);
    SB_; DMA1(gB2 + ko2, lb2 + 2048); SB_;
    acc[1][0] = mfma32(a11, b01, acc[1][0]);
    acc[1][1] = mfma32(a11, b11, acc[1][1]);
    acc[1][2] = mfma32(a11, b21, acc[1][2]);
    SB_; DMA1(gB3 + ko2, lb2 + 3072); SB_;
    acc[1][3] = mfma32(a11, b31, acc[1][3]);
  }
  asm volatile("s_waitcnt vmcnt(0)" ::: "memory");
  __builtin_amdgcn_s_barrier();
#undef ISSUE
#undef DMA1
#undef SB_
  if (wflag) {
    if (threadIdx.x == 0) {
      unsigned sp = 0;
      while (xb_ld(wflag) != epoch) { __builtin_amdgcn_s_sleep(1); if (++sp > (1u << 24)) break; }
      __builtin_amdgcn_fence(__ATOMIC_ACQUIRE, "agent");
      asm volatile("s_waitcnt vmcnt(0)" ::: "memory");
    }
    __syncthreads();
  }

  if (EPI == EPI_GATES) {
    const bf16_t* XC = (const bf16_t*)j.o1;
    float* AA = (float*)j.o0;
    float* BBp = AA + (size_t)T_ * 1024;
#pragma unroll
    for (int g = 0; g < 2; ++g) {
      const int ch = (n0 >> 8) * 128 + wn * 64 + g * 32 + r32;
      const float br = j.x0[ch], bi = j.x1[ch];
      const float spl = softplusf_(-j.x2[ch]);
#pragma unroll
      for (int mi = 0; mi < 2; ++mi)
#pragma unroll
        for (int r = 0; r < 16; ++r) {
          const int row = m0 + wm * 64 + mi * 32 + (r & 3) + 8 * (r >> 2) + 4 * hh;
          const float rg = sigmoidf_(acc[mi][2 * g][r] + br);
          const float ig = sigmoidf_(acc[mi][2 * g + 1][r] + bi);
          const float la = -8.f * rg * spl;
          const float xc = bf2f(XC[(size_t)row * 1024 + ch]);
          const bool reset = (row < TP_) && ((row & 2047) == 0);
          const float a = reset ? 0.f : __expf(la);
          const float mult = reset ? 1.f : sqrtf(fmaxf(-expm1f(2.f * la), 0.f));
          AA[(size_t)row * 1024 + ch] = a;
          BBp[(size_t)row * 1024 + ch] = mult * ig * xc;
        }
    }
  } else {
    const int lq = lane & 3;
#pragma unroll
    for (int mi = 0; mi < 2; ++mi)
#pragma unroll
      for (int ni = 0; ni < 4; ++ni)
#pragma unroll
        for (int g4 = 0; g4 < 4; ++g4) {
          float v[4] = {acc[mi][ni][4 * g4], acc[mi][ni][4 * g4 + 1], acc[mi][ni][4 * g4 + 2], acc[mi][ni][4 * g4 + 3]};
          quad_transpose4(v, lq);
          const int row = m0 + wm * 64 + mi * 32 + 8 * g4 + 4 * hh + lq;
          const int col = n0 + wn * 128 + ni * 32 + (r32 & ~3);
          epi4<EPI>(j, row, col, v);
        }
    if (EPI == EPI_SSM_XBC) {
      if (n0 + wn * 128 == 4096) {
        const float dtb = j.x0[r32];
#pragma unroll
        for (int mi = 0; mi < 2; ++mi)
#pragma unroll
          for (int r = 0; r < 16; ++r) {
            const int row = m0 + wm * 64 + mi * 32 + (r & 3) + 8 * (r >> 2) + 4 * hh;
            ((float*)j.o1)[(size_t)row * 32 + r32] = softplusf_(acc[mi][0][r] + dtb);
          }
      }
    }
  }
}

template <int EPI>
DI void gemm_tile_dma_h(const GJob& j, int m0, int n0, int nk, char* smem) {
  const int tid = TIDX, lane = tid & 63, w = tid >> 6;
  const int wm = w >> 1, wn = w & 1, r32 = lane & 31, hh = lane >> 5;
  f32x16 acc[4];
#pragma unroll
  for (int b = 0; b < 4; ++b)
#pragma unroll
    for (int r = 0; r < 16; ++r) acc[b][r] = 0.f;
  const int dr = lane >> 2;
  const int dc = (lane & 3) ^ ((lane >> 4) & 3);
  const int nlim = j.nvalid - 1;
  const size_t kofs = (size_t)dc * 8;
  const bf16_t* gA0 = j.A + (size_t)(m0 + 16 * w + dr) * j.lda + kofs;
  const bf16_t* gB0 = j.Bt + (size_t)min(n0 + 64 * w + dr, nlim) * j.ldb + kofs;
  const bf16_t* gB1 = j.Bt + (size_t)min(n0 + 64 * w + 16 + dr, nlim) * j.ldb + kofs;
  const bf16_t* gB2 = j.Bt + (size_t)min(n0 + 64 * w + 32 + dr, nlim) * j.ldb + kofs;
  const bf16_t* gB3 = j.Bt + (size_t)min(n0 + 64 * w + 48 + dr, nlim) * j.ldb + kofs;
  char* ldsA = smem + w * 1024 + lane * 16;
  char* ldsB = smem + 8192 + (4 * w) * 1024 + lane * 16;
  const unsigned lbase = (unsigned)(unsigned long long)(LAS char*)smem;
  const int fsw = (r32 >> 2) & 3;
  const unsigned pa = (unsigned)((wm * 32 + r32) * 64), pb = (unsigned)(8192 + (wn * 128 + r32) * 64);
  const unsigned po0 = (unsigned)(((hh) ^ fsw) * 16), po1 = (unsigned)(((2 + hh) ^ fsw) * 16);
#define DMA1(gp, lp) __builtin_amdgcn_global_load_lds((const unsigned*)(gp), (unsigned*)(lp), 16, 0, 0)
#define ISSUEH(kt, slot)                                                                         \
  {                                                                                              \
    const int ko_ = (kt) * 32;                                                                   \
    char* la_ = ldsA + (slot) * DSLOT; char* lb_ = ldsB + (slot) * DSLOT;                        \
    DMA1(gA0 + ko_, la_);                                                                        \
    DMA1(gB0 + ko_, lb_); DMA1(gB1 + ko_, lb_ + 1024); DMA1(gB2 + ko_, lb_ + 2048); DMA1(gB3 + ko_, lb_ + 3072); \
  }
  asm volatile("s_waitcnt vmcnt(0)" ::: "memory");
  const int last = nk - 1;
  ISSUEH(0, 0);
  { const int t1 = min(1, last); ISSUEH(t1, 1); }
  int sl_r = 0, sl_w = 2;
#pragma unroll 1
  for (int i = 0; i < nk; ++i) {
    asm volatile("s_waitcnt vmcnt(5)" ::: "memory");
    __builtin_amdgcn_s_barrier();
    { const int t2 = min(i + 2, last); ISSUEH(t2, sl_w); }
    const unsigned sl = lbase + (unsigned)(sl_r * DSLOT);
    sl_r = (sl_r == 2) ? 0 : sl_r + 1;
    sl_w = (sl_w == 2) ? 0 : sl_w + 1;
    bf16x8 a00, a01, b00, b10, b20, b30, b01, b11, b21, b31;
    const unsigned aA0 = sl + pa + po0, aB0 = sl + pb + po0, aA1 = sl + pa + po1, aB1 = sl + pb + po1;
    asm volatile("ds_read_b128 %0, %1" : "=v"(a00) : "v"(aA0));
    asm volatile("ds_read_b128 %0, %1" : "=v"(b00) : "v"(aB0));
    asm volatile("ds_read_b128 %0, %1 offset:2048" : "=v"(b10) : "v"(aB0));
    asm volatile("ds_read_b128 %0, %1 offset:4096" : "=v"(b20) : "v"(aB0));
    asm volatile("ds_read_b128 %0, %1 offset:6144" : "=v"(b30) : "v"(aB0));
    asm volatile("ds_read_b128 %0, %1" : "=v"(a01) : "v"(aA1));
    asm volatile("ds_read_b128 %0, %1" : "=v"(b01) : "v"(aB1));
    asm volatile("ds_read_b128 %0, %1 offset:2048" : "=v"(b11) : "v"(aB1));
    asm volatile("ds_read_b128 %0, %1 offset:4096" : "=v"(b21) : "v"(aB1));
    asm volatile("ds_read_b128 %0, %1 offset:6144" : "=v"(b31) : "v"(aB1));
    asm volatile("s_waitcnt lgkmcnt(0)" : "+v"(a00), "+v"(b00), "+v"(b10), "+v"(b20), "+v"(b30),
                 "+v"(a01), "+v"(b01), "+v"(b11), "+v"(b21), "+v"(b31) :: "memory");
    acc[0] = mfma32(a00, b00, acc[0]);
    acc[1] = mfma32(a00, b10, acc[1]);
    acc[2] = mfma32(a00, b20, acc[2]);
    acc[3] = mfma32(a00, b30, acc[3]);
    acc[0] = mfma32(a01, b01, acc[0]);
    acc[1] = mfma32(a01, b11, acc[1]);
    acc[2] = mfma32(a01, b21, acc[2]);
    acc[3] = mfma32(a01, b31, acc[3]);
  }
  asm volatile("s_waitcnt vmcnt(0)" ::: "memory");
  __builtin_amdgcn_s_barrier();
#undef ISSUEH
#undef DMA1
  const int lq = lane & 3;
#pragma unroll
  for (int ni = 0; ni < 4; ++ni)
#pragma unroll
    for (int g4 = 0; g4 < 4; ++g4) {
      float v[4] = {acc[ni][4 * g4], acc[ni][4 * g4 + 1], acc[ni][4 * g4 + 2], acc[ni][4 * g4 + 3]};
      quad_transpose4(v, lq);
      const int row = m0 + wm * 32 + 8 * g4 + 4 * hh + lq;
      const int col = n0 + wn * 128 + ni * 32 + (r32 & ~3);
      epi4<EPI>(j, row, col, v);
    }
  if (EPI == EPI_SSM_XBC) {
    if (n0 + wn * 128 == 4096) {
      const float dtb = j.x0[r32];
#pragma unroll
      for (int r = 0; r < 16; ++r) {
        const int row = m0 + wm * 32 + (r & 3) + 8 * (r >> 2) + 4 * hh;
        ((float*)j.o1)[(size_t)row * 32 + r32] = softplusf_(acc[0][r] + dtb);
      }
    }
  }
}

#define VBLOCK() ((int)(((volatile LAS unsigned*)&xb_words)[3]))
DI void tile_map(int L, int ntn, int& mt, int& nt) {
  const int gw = ((ntn & 7) == 0) ? 8 : (((ntn & 3) == 0) ? 4 : 0);
  if (gw) {
    const int gs = 8 * gw, grp = L / gs, loc = L - grp * gs, gpr = ntn / gw;
    const int gm = grp / gpr, gn = grp - gm * gpr;
    mt = gm * 8 + loc / gw; nt = gn * gw + (loc - (loc / gw) * gw);
  } else { mt = L / ntn; nt = L - mt * ntn; }
}

template <int EPI, bool MIX>
DI void gemm_run(const GJob& j, int ntn, int& toff, char* smem, int vb_) {
  const int G = gridDim.x;
  const int nk = j.K >> 6;
  if (MIX) {
    const int ntiles = MT_ * ntn;
    const int start = (int)((vb_ - (toff % G) + G) % G);
    for (int tile = start; tile < ntiles; tile += G) {
      int mt, nt; tile_map(tile, ntn, mt, nt);
      gemm_tile<EPI, MIX>(j, mt * 128, nt * 128, 0, nk, smem);
    }
    toff += ntiles;
  } else {
    const int nfull = 128 * ntn, nhalf = 16 * ntn, ntot = nfull + nhalf;
    const int start = (int)((vb_ - (toff % G) + G) % G);
    for (int item = start; item < ntot; item += G) {
      if (item < nfull) {
        int mt, nt; tile_map(item, ntn, mt, nt);
        gemm_tile_dma<EPI>(j, mt * 128, nt * 256, 0, nk * 2, smem);
      } else {
        const int h = item - nfull, hm = h / ntn, nt = h - hm * ntn;
        gemm_tile_dma_h<EPI>(j, TP_ + hm * 64, nt * 256, nk * 2, smem);
      }
    }
    toff += ntot;
  }
}

template <int EPI>
DI void gemm_streamk(const GJob& j, int ntn, char* smem, int vb_, unsigned* flags, unsigned epoch) {
  const int G = gridDim.x;
  const int nk = j.K >> 5;
  const int total = MT_ * ntn * nk;
  int per = (total + G - 1) / G;
  if (per < nk) per = nk;
  int s0 = vb_ * per;
  const int s1 = min(s0 + per, total);
  while (s0 < s1) {
    const int tile = s0 / nk, k0 = s0 - tile * nk;
    const int k1 = min(nk, k0 + (s1 - s0));
    int mt, nt; tile_map(tile, ntn, mt, nt);
    unsigned* wf = (k0 == 0 && k1 < nk) ? (flags + tile) : nullptr;
    gemm_tile_dma<EPI>(j, mt * 128, nt * 256, k0, k1, smem, wf, epoch);
    if (k0 > 0) {
      asm volatile("s_waitcnt vmcnt(0)" ::: "memory");
      __syncthreads();
      if (threadIdx.x == 0) {
        __builtin_amdgcn_fence(__ATOMIC_RELEASE, "agent");
        asm volatile("s_waitcnt vmcnt(0)" ::: "memory");
        __hip_atomic_store(flags + tile, epoch, __ATOMIC_RELAXED, __HIP_MEMORY_SCOPE_AGENT);
      }
    }
    s0 += k1 - k0;
  }
}

template <int EPI, int SPLIT, int NKC>
DI void gemm_splitk(const GJob& j, int ntn, char* smem, int vb_) {
  const int G = gridDim.x;
  const int nitems = MT_ * ntn * SPLIT;
  for (int it = vb_; it < nitems; it += G) {
    const int tile = it / SPLIT, sp = it - tile * SPLIT;
    int mt, nt; tile_map(tile, ntn, mt, nt);
    gemm_tile<EPI, false>(j, mt * 128, nt * 128, sp * NKC, sp * NKC + NKC, smem);
  }
}

DI GJob mkjob(const bf16_t* A, int lda, const bf16_t* Bt, int ldb, int K, int nvalid) {
  GJob j;
  j.A = A; j.A2 = nullptr; j.mu = nullptr; j.Bt = Bt; j.lda = lda; j.ldb = ldb; j.K = K; j.nvalid = nvalid;
  j.o0 = nullptr; j.o1 = nullptr; j.x0 = nullptr; j.x1 = nullptr; j.x2 = nullptr; j.ldo = 0; j.act = 0;
  return j;
}

struct TJob { const float* src; bf16_t* dst; int K, N, src_ld, kind, n_off; };

DI TJob get_tjob(const Params& p, int j) {
  bf16_t* wt = (bf16_t*)(p.ws + W_WT);
  TJob o; o.kind = 0; o.n_off = 0;
  if (j < 36) {
    const int ia = j / 18, r = j % 18;
    if (r == 0) { o.src = p.in[I_LRU_WIN] + (size_t)ia * 1024 * 2048; o.dst = wt + WA_IN + (size_t)ia * 2048 * 1024; o.K = 1024; o.N = 2048; o.src_ld = 2048; }
    else if (r == 1) { o.src = p.in[I_LRU_WOUT] + (size_t)ia * 1024 * 1024; o.dst = wt + WA_OUT + (size_t)ia * 1024 * 1024; o.K = 1024; o.N = 1024; o.src_ld = 1024; }
    else {
      const int isI = (r >= 10) ? 1 : 0; const int h = (r - 2) & 7;
      o.src = p.in[isI ? I_LRU_WI : I_LRU_WR] + ((size_t)ia * 8 + h) * 128 * 128;
      o.dst = wt + WA_G + (size_t)ia * 2048 * 128; o.K = 128; o.N = 128; o.src_ld = 128; o.kind = 1 + isI; o.n_off = h * 128;
    }
  } else if (j == 36) { o.src = p.in[I_SSM_WIN] + 2048; o.dst = wt + WB_XBC; o.K = 1024; o.N = 4128; o.src_ld = 6176; }
  else if (j == 37) { o.src = p.in[I_SSM_WIN]; o.dst = wt + WB_Z; o.K = 1024; o.N = 2048; o.src_ld = 6176; }
  else if (j == 38) { o.src = p.in[I_SSM_WOUT]; o.dst = wt + WB_OUT; o.K = 2048; o.N = 1024; o.src_ld = 1024; }
  else if (j < 42) { const int s = j - 39; o.src = p.in[I_RW_WRKV] + (size_t)s * 1024 * 1024; o.dst = wt + WC_RKV + (size_t)s * 1024 * 1024; o.K = 1024; o.N = 1024; o.src_ld = 1024; }
  else if (j == 42) { o.src = p.in[I_RW_WW1]; o.dst = wt + WC_L1; o.K = 1024; o.N = 64; o.src_ld = 64; }
  else if (j == 43) { o.src = p.in[I_RW_WA1]; o.dst = wt + WC_L1 + 64 * 1024; o.K = 1024; o.N = 64; o.src_ld = 64; }
  else if (j == 44) { o.src = p.in[I_RW_WG1]; o.dst = wt + WC_L1 + 128 * 1024; o.K = 1024; o.N = 128; o.src_ld = 128; }
  else if (j == 45) { o.src = p.in[I_RW_WW2]; o.dst = wt + WC_W2; o.K = 64; o.N = 1024; o.src_ld = 1024; }
  else if (j == 46) { o.src = p.in[I_RW_WA2]; o.dst = wt + WC_A2; o.K = 64; o.N = 1024; o.src_ld = 1024; }
  else if (j == 47) { o.src = p.in[I_RW_WG2]; o.dst = wt + WC_G2; o.K = 128; o.N = 1024; o.src_ld = 1024; }
  else if (j == 48) { o.src = p.in[I_RW_WOUT]; o.dst = wt + WC_OUT; o.K = 1024; o.N = 1024; o.src_ld = 1024; }
  else {
    const int l = (j - 49) >> 1, which = (j - 49) & 1;
    if (!which) { o.src = p.in[I_FFN_W1] + (size_t)l * 1024 * 4096; o.dst = wt + WF_1 + (size_t)l * 4096 * 1024; o.K = 1024; o.N = 4096; o.src_ld = 4096; }
    else { o.src = p.in[I_FFN_W2] + (size_t)l * 4096 * 1024; o.dst = wt + WF_2 + (size_t)l * 4096 * 1024; o.K = 4096; o.N = 1024; o.src_ld = 1024; }
  }
  return o;
}
constexpr int N_TJOBS = 57;

DI void ph_prologue(const Params& p, char* smem) {
  const int tid = TIDX, G = gridDim.x;
  {
    const float4* xp = (const float4*)p.in[I_XP];
    const float4* xs = (const float4*)p.in[I_XS];
    float4* X = (float4*)(p.ws + W_X);
    const size_t np = (size_t)TP_ * 256, nt = (size_t)T_ * 256;
    for (size_t i = (size_t)blockIdx.x * NTHR + tid; i < nt; i += (size_t)G * NTHR)
      X[i] = (i < np) ? xp[i] : xs[i - np];
  }
  float* tile = (float*)smem;
  int toff = 0;
  for (int jn = 0; jn < N_TJOBS; ++jn) {
    const TJob tj = get_tjob(p, jn);
    const int nkt = tj.K >> 6, nnt = (tj.N + 63) >> 6;
    const int ntiles = nkt * nnt;
    const int start = (((int)blockIdx.x - (toff % G)) + G) % G;
    for (int t = start; t < ntiles; t += G) {
      const int kt = t / nnt, nt = t - kt * nnt;
      const int k0 = kt * 64, n0 = nt * 64;
      __syncthreads();
      float tv[16];
      const bool nok = (n0 + (tid & 63)) < tj.N;
      const float* sp = tj.src + (size_t)(k0 + (tid >> 6)) * tj.src_ld + n0 + (tid & 63);
#pragma unroll
      for (int i = 0; i < 16; ++i) tv[i] = nok ? sp[(size_t)(i * 4) * tj.src_ld] : 0.f;
#pragma unroll
      for (int i = 0; i < 16; ++i) tile[(i * 4 + (tid >> 6)) * 65 + (tid & 63)] = tv[i];
      __syncthreads();
      const int n = tid >> 2, kq = tid & 3;
      if (n0 + n < tj.N) {
        int nrow = n0 + n;
        if (tj.kind) {
          const int ch = tj.n_off + n0 + n;
          nrow = (ch >> 6) * 128 + ((ch >> 5) & 1) * 64 + (tj.kind - 1) * 32 + (ch & 31);
        }
        float f[8], g[8];
#pragma unroll
        for (int e = 0; e < 8; ++e) { f[e] = tile[(kq * 16 + e) * 65 + n]; g[e] = tile[(kq * 16 + 8 + e) * 65 + n]; }
        uint4* d = (uint4*)(tj.dst + (size_t)nrow * tj.K + k0 + kq * 16);
        d[0] = pack8(f); d[1] = pack8(g);
      }
    }
    toff += ntiles;
  }
}

DI void ph_rmsnorm(const Params& p, int mode, const float* w) {
  const int tid_ = TIDX; const int lane = tid_ & 63;
  const int gw = blockIdx.x * 4 + (tid_ >> 6), nw = gridDim.x * 4;
  const float* X = (const float*)(p.ws + W_X);
  bf16_t* U = (bf16_t*)(p.ws + W_U);
  bf16_t* UP = (bf16_t*)(p.ws + SC_UP);
  float4 wv[4];
#pragma unroll
  for (int i = 0; i < 4; ++i) wv[i] = ((const float4*)w)[lane + 64 * i];
  for (int row = gw; row < T_; row += nw) {
    const float4* xr = (const float4*)(X + (size_t)row * 1024);
    float4 v[4]; float ss = 0.f;
#pragma unroll
    for (int i = 0; i < 4; ++i) { v[i] = xr[lane + 64 * i]; ss += v[i].x * v[i].x + v[i].y * v[i].y + v[i].z * v[i].z + v[i].w * v[i].w; }
    ss = wave_sum(ss);
    const float rstd = rsqrtf(ss * (1.f / 1024.f) + 1e-6f);
    int seq, l, L; tok_info(row, seq, l, L);
#pragma unroll
    for (int i = 0; i < 4; ++i) {
      const int c = 4 * (lane + 64 * i);
      float4 y = make_float4(v[i].x * rstd * wv[i].x, v[i].y * rstd * wv[i].y, v[i].z * rstd * wv[i].z, v[i].w * rstd * wv[i].w);
      if (mode == 2) {
        *(float4*)(p.out + O_Y + (size_t)row * 1024 + c) = y;
      } else {
        uint2 pk = make_uint2(pack2(y.x, y.y), pack2(y.z, y.w));
        *(uint2*)(U + (size_t)row * 1024 + c) = pk;
        if (mode == 1) {
          if (l + 1 < L) *(uint2*)(UP + (size_t)(row + 1) * 1024 + c) = pk;
          if (l == 0) {
            uint2 pz = make_uint2(0, 0);
            if (seq >= 8) { float4 s = *(const float4*)(p.in[I_ST_RS] + (size_t)(seq - 8) * 1024 + c); pz = make_uint2(pack2(s.x, s.y), pack2(s.z, s.w)); }
            *(uint2*)(UP + (size_t)row * 1024 + c) = pz;
          }
          if (l == L - 1) {
            float* o = (seq < 8) ? (p.out + O_RS_P + (size_t)seq * 1024 + c) : (p.out + O_RS_S + (size_t)(seq - 8) * 1024 + c);
            *(float4*)o = y;
          }
        }
      }
    }
  }
}

template <int C, bool SILU>
DI void ph_conv(const bf16_t* __restrict__ src, bf16_t* __restrict__ dst, const float* __restrict__ cw,
                const float* __restrict__ cb, const float* __restrict__ state,
                float* __restrict__ out_p, float* __restrict__ out_s) {
  constexpr int GR = C / 8;
  const size_t total = (size_t)T_ * GR;
#pragma unroll 2
  for (size_t idx = (size_t)blockIdx.x * NTHR + TIDX; idx < total; idx += (size_t)gridDim.x * NTHR) {
    const int t = (int)(idx / GR), c = (int)(idx % GR) * 8;
    int seq, l, L; tok_info(t, seq, l, L);
    float acc[8]; load8f(cb + c, acc);
    float xcur[8];
#pragma unroll
    for (int jj = 0; jj < 4; ++jj) {
      const int ls = l - 3 + jj;
      float xv[8];
      if (ls >= 0) { unpack8(*(const uint4*)(src + (size_t)(t - 3 + jj) * C + c), xv); }
      else if (seq >= 8) { load8f(state + ((size_t)(seq - 8) * 3 + (ls + 3)) * C + c, xv); }
      else {
#pragma unroll
        for (int e = 0; e < 8; ++e) xv[e] = 0.f;
      }
      float w8[8]; load8f(cw + (size_t)jj * C + c, w8);
#pragma unroll
      for (int e = 0; e < 8; ++e) acc[e] += w8[e] * xv[e];
      if (jj == 3) {
#pragma unroll
        for (int e = 0; e < 8; ++e) xcur[e] = xv[e];
      }
    }
    if (SILU) {
#pragma unroll
      for (int e = 0; e < 8; ++e) acc[e] = siluf_(acc[e]);
    }
    *(uint4*)(dst + (size_t)t * C + c) = pack8(acc);
    if (l >= L - 3) {
      const int r = l - (L - 3);
      float* o = (seq < 8) ? (out_p + ((size_t)seq * 3 + r) * C + c) : (out_s + ((size_t)(seq - 8) * 3 + r) * C + c);
      store8f(o, xcur);
    }
  }
}

DI void ph_lru_scan1(const Params& p) {
  const float* AA = (const float*)(p.ws + SA_AA);
  const float* BB = (const float*)(p.ws + SA_BB);
  float* CP = (float*)(p.ws + SA_CP);
  float* CS = (float*)(p.ws + SA_CS);
  const int total = 8 * 64 * 1024;
  for (int idx = blockIdx.x * NTHR + TIDX; idx < total; idx += gridDim.x * NTHR) {
    const int ch = idx & 1023, c = (idx >> 10) & 63, b = idx >> 16;
    const size_t base = ((size_t)b * 2048 + c * 32) * 1024 + ch;
    float P = 1.f, S = 0.f;
    float av[32], bv[32];
#pragma unroll
    for (int s = 0; s < 32; ++s) { av[s] = AA[base + (size_t)s * 1024]; bv[s] = BB[base + (size_t)s * 1024]; }
#pragma unroll
    for (int s = 0; s < 32; ++s) { S = av[s] * S + bv[s]; P *= av[s]; }
    CP[idx] = P; CS[idx] = S;
  }
}
DI void ph_lru_scan2(const Params& p, int ia) {
  const float* AA = (const float*)(p.ws + SA_AA);
  const float* BB = (const float*)(p.ws + SA_BB);
  const float* CP = (const float*)(p.ws + SA_CP);
  const float* CS = (const float*)(p.ws + SA_CS);
  bf16_t* GT = (bf16_t*)(p.ws + SA_GT);
  const int nP = 8 * 64 * 1024, total = nP + 128 * 1024;
  for (int idx = blockIdx.x * NTHR + TIDX; idx < total; idx += gridDim.x * NTHR) {
    if (idx < nP) {
      const int ch = idx & 1023, c = (idx >> 10) & 63, b = idx >> 16;
      const size_t base = ((size_t)b * 2048 + c * 32) * 1024 + ch;
      float av[32], bv[32]; bf16_t gv[32];
#pragma unroll
      for (int s = 0; s < 32; ++s) { const size_t o = base + (size_t)s * 1024; av[s] = AA[o]; bv[s] = BB[o]; gv[s] = GT[o]; }
      float h = 0.f;
#pragma unroll 8
      for (int c2 = 0; c2 < c; ++c2) {
        const int ci = ((b * 64 + c2) << 10) + ch;
        h = CP[ci] * h + CS[ci];
      }
#pragma unroll
      for (int s = 0; s < 32; ++s) {
        const size_t o = base + (size_t)s * 1024;
        h = av[s] * h + bv[s];
        GT[o] = f2bf(h * bf2f(gv[s]));
      }
      if (c == 63) p.out[O_LH_P + ((size_t)ia * 8 + b) * 1024 + ch] = h;
    } else {
      const int u = idx - nP; const int ch = u & 1023, s = u >> 10;
      float h = p.in[I_ST_LH][((size_t)ia * 128 + s) * 1024 + ch];
      const size_t base = ((size_t)TP_ + s * 8) * 1024 + ch;
#pragma unroll
      for (int q = 0; q < 8; ++q) {
        const size_t o = base + (size_t)q * 1024;
        h = AA[o] * h + BB[o];
        GT[o] = f2bf(h * bf2f(GT[o]));
      }
      p.out[O_LH_S + ((size_t)ia * 128 + s) * 1024 + ch] = h;
    }
  }
}

DI void ssd_item(const Params& p, char* smem, int seq, int h) {
  const int tid = TIDX, lane = tid & 63, w = tid >> 6, r32 = lane & 31, hh = lane >> 5;
  bf16_t* Cs = (bf16_t*)smem;
  bf16_t* Bs = Cs + 64 * 136;
  bf16_t* Sb = Bs + 64 * 136;
  bf16_t* Xt = Sb + 64 * 136;
  bf16_t* Btr = Xt + 64 * 72;
  float* dts = (float*)(Btr + 128 * 72);
  float* acs = dts + 64;
  bf16_t* Ws = Bs;
  const bf16_t* XBC = (const bf16_t*)(p.ws + SB_XBC);
  const float* DT = (const float*)(p.ws + SB_DT);
  bf16_t* Y = (bf16_t*)(p.ws + SB_Y);
  const bool prompt = seq < 8;
  const int nchunk = prompt ? 32 : 1, Lv = prompt ? 64 : 8;
  const int tbase = prompt ? seq * 2048 : TP_ + (seq - 8) * 8;
  const int g = h >> 2;
  const float Ah = -__expf(p.in[I_SSM_ALOG][h]);
  const float Dh = p.in[I_SSM_D][h];
  f32x16 accS[2];
  {
    const float* s0 = p.in[I_ST_SS] + ((size_t)(seq - 8) * 32 + h) * 64 * 128;
#pragma unroll
    for (int mi = 0; mi < 2; ++mi)
#pragma unroll
      for (int r = 0; r < 16; ++r) {
        const int prow = mi * 32 + (r & 3) + 8 * (r >> 2) + 4 * hh, n = 32 * w + r32;
        accS[mi][r] = prompt ? 0.f : s0[(size_t)prow * 128 + n];
      }
  }
  __syncthreads();
#pragma unroll
  for (int mi = 0; mi < 2; ++mi)
#pragma unroll
    for (int r = 0; r < 16; ++r) {
      const int prow = mi * 32 + (r & 3) + 8 * (r >> 2) + 4 * hh, n = 32 * w + r32;
      Sb[prow * 136 + n] = f2bf(accS[mi][r]);
    }
  uint4 pc0, pc1, pc2, pc3, pb0, pb1, pb2, pb3, px0, px1;
  float pdt = 0.f;
  const uint4 z4 = make_uint4(0, 0, 0, 0);
  pc0 = pc1 = pc2 = pc3 = pb0 = pb1 = pb2 = pb3 = px0 = px1 = z4;
#define SSD_LD_CB(i, t0_)                                                                  \
  { const int id_ = tid + 256 * i, row_ = id_ >> 4, ch_ = id_ & 15;                        \
    pc##i = z4; pb##i = z4;                                                                \
    if (row_ < Lv) { const bf16_t* src_ = XBC + (size_t)((t0_) + row_) * 4096 + g * 128 + ch_ * 8; \
      pb##i = *(const uint4*)(src_ + 2048); pc##i = *(const uint4*)(src_ + 3072); } }
#define SSD_LD_X(i, t0_)                                                                   \
  { const int id_ = tid + 256 * i, row_ = id_ >> 3, ch_ = id_ & 7;                         \
    px##i = z4;                                                                            \
    if (row_ < Lv) px##i = *(const uint4*)(XBC + (size_t)((t0_) + row_) * 4096 + h * 64 + ch_ * 8); }
#define SSD_ISSUE(t0_)                                                                     \
  { SSD_LD_CB(0, t0_) SSD_LD_CB(1, t0_) SSD_LD_CB(2, t0_) SSD_LD_CB(3, t0_) SSD_LD_X(0, t0_) SSD_LD_X(1, t0_) \
    pdt = (tid < Lv && tid < 64) ? DT[(size_t)((t0_) + tid) * 32 + h] : 0.f; }
#define SSD_ST_CB(i)                                                                       \
  { const int id_ = tid + 256 * i, row_ = id_ >> 4, ch_ = id_ & 15;                        \
    *(uint4*)(Cs + row_ * 136 + ch_ * 8) = pc##i;                                          \
    *(uint4*)(Bs + row_ * 136 + ch_ * 8) = pb##i;                                          \
    float f_[8]; unpack8(pb##i, f_);                                                       \
    const float sc_ = __expf(aend - acs[row_]);                                            \
    _Pragma("unroll") for (int e = 0; e < 8; ++e) Btr[(ch_ * 8 + e) * 72 + row_] = f2bf(f_[e] * sc_); }
#define SSD_ST_X(i)                                                                        \
  { const int id_ = tid + 256 * i, row_ = id_ >> 3, ch_ = id_ & 7;                         \
    float f_[8]; unpack8(px##i, f_);                                                       \
    const float sc_ = dts[row_];                                                           \
    _Pragma("unroll") for (int e = 0; e < 8; ++e) Xt[(ch_ * 8 + e) * 72 + row_] = f2bf(f_[e] * sc_); }
  SSD_ISSUE(tbase);
  for (int c = 0; c < nchunk; ++c) {
    const int t0 = tbase + c * 64;
    __syncthreads();
    if (tid < 64) {
      const float dtv = pdt;
      float x = dtv * Ah;
#pragma unroll
      for (int o = 1; o < 64; o <<= 1) { const float y = __shfl_up(x, o, 64); if (lane >= o) x += y; }
      dts[tid] = dtv; acs[tid] = x;
    }
    __syncthreads();
    const float aend = acs[63];
    SSD_ST_CB(0) SSD_ST_CB(1) SSD_ST_CB(2) SSD_ST_CB(3) SSD_ST_X(0) SSD_ST_X(1)
    if (c + 1 < nchunk) { SSD_ISSUE(t0 + 64); }
    __syncthreads();
    const int it = w >> 1, jt = w & 1;
    f32x16 cb;
#pragma unroll
    for (int r = 0; r < 16; ++r) cb[r] = 0.f;
    if (jt <= it) {
#pragma unroll
      for (int ks = 0; ks < 8; ++ks) {
        bf16x8 a = *(const bf16x8*)(Cs + (it * 32 + r32) * 136 + ks * 16 + hh * 8);
        bf16x8 b = *(const bf16x8*)(Bs + (jt * 32 + r32) * 136 + ks * 16 + hh * 8);
        cb = mfma32(a, b, cb);
      }
    }
    __syncthreads();
    {
      const int jj = jt * 32 + r32; const float aj = acs[jj];
#pragma unroll
      for (int r = 0; r < 16; ++r) {
        const int ii = it * 32 + (r & 3) + 8 * (r >> 2) + 4 * hh;
        const float v = (jj <= ii) ? cb[r] * __expf(acs[ii] - aj) : 0.f;
        Ws[ii * 72 + jj] = f2bf(v);
      }
    }
    __syncthreads();
    {
      const int pt = w & 1;
      f32x16 yd, yo;
#pragma unroll
      for (int r = 0; r < 16; ++r) { yd[r] = 0.f; yo[r] = 0.f; }
#pragma unroll
      for (int ks = 0; ks < 4; ++ks) {
        bf16x8 a = *(const bf16x8*)(Ws + (it * 32 + r32) * 72 + ks * 16 + hh * 8);
        bf16x8 b = *(const bf16x8*)(Xt + (pt * 32 + r32) * 72 + ks * 16 + hh * 8);
        yd = mfma32(a, b, yd);
      }
#pragma unroll
      for (int ks = 0; ks < 8; ++ks) {
        bf16x8 a = *(const bf16x8*)(Cs + (it * 32 + r32) * 136 + ks * 16 + hh * 8);
        bf16x8 b = *(const bf16x8*)(Sb + (pt * 32 + r32) * 136 + ks * 16 + hh * 8);
        yo = mfma32(a, b, yo);
      }
      const int pp = pt * 32 + r32;
#pragma unroll
      for (int r = 0; r < 16; ++r) {
        const int ii = it * 32 + (r & 3) + 8 * (r >> 2) + 4 * hh;
        if (ii < Lv) {
          const size_t t = (size_t)(t0 + ii);
          const float xv = bf2f(XBC[t * 4096 + h * 64 + pp]);
          const float yv = yd[r] + __expf(acs[ii]) * yo[r] + Dh * xv;
          Y[t * 2048 + h * 64 + pp] = f2bf(yv);
        }
      }
    }
    {
      const float dec = __expf(aend);
#pragma unroll
      for (int mi = 0; mi < 2; ++mi)
#pragma unroll
        for (int r = 0; r < 16; ++r) accS[mi][r] *= dec;
#pragma unroll
      for (int ks = 0; ks < 4; ++ks) {
        bf16x8 b = *(const bf16x8*)(Btr + (32 * w + r32) * 72 + ks * 16 + hh * 8);
        bf16x8 a0 = *(const bf16x8*)(Xt + (r32) * 72 + ks * 16 + hh * 8);
        bf16x8 a1 = *(const bf16x8*)(Xt + (32 + r32) * 72 + ks * 16 + hh * 8);
        accS[0] = mfma32(a0, b, accS[0]);
        accS[1] = mfma32(a1, b, accS[1]);
      }
    }
    __syncthreads();
#pragma unroll
    for (int mi = 0; mi < 2; ++mi)
#pragma unroll
      for (int r = 0; r < 16; ++r) {
        const int prow = mi * 32 + (r & 3) + 8 * (r >> 2) + 4 * hh, n = 32 * w + r32;
        Sb[prow * 136 + n] = f2bf(accS[mi][r]);
      }
  }
  float* dst = prompt ? (p.out + O_SS_P + ((size_t)seq * 32 + h) * 64 * 128)
                      : (p.out + O_SS_S + ((size_t)(seq - 8) * 32 + h) * 64 * 128);
#pragma unroll
  for (int mi = 0; mi < 2; ++mi)
#pragma unroll
    for (int r = 0; r < 16; ++r) {
      const int prow = mi * 32 + (r & 3) + 8 * (r >> 2) + 4 * hh, n = 32 * w + r32;
      dst[(size_t)prow * 128 + n] = accS[mi][r];
    }
}

#undef SSD_LD_CB
#undef SSD_LD_X
#undef SSD_ISSUE
#undef SSD_ST_CB
#undef SSD_ST_X
DI void ph_ssd(const Params& p, char* smem) {
  const int G = gridDim.x, bid = blockIdx.x;
  int it = bid, step = G;
  if (G >= 512) { if (bid < 256) { step = 1 << 30; } else { step = G - 256; } }
#pragma nounroll
  for (; it < 256 + 4096; it += step) {
    const int seq = (it < 256) ? (it >> 5) : (8 + ((it - 256) >> 5));
    ssd_item(p, smem, seq, it & 31);
  }
}

DI void ph_gnorm(const Params& p) {
  const int tid_ = TIDX; const int lane = tid_ & 63;
  const int gw = blockIdx.x * 4 + (tid_ >> 6), nw = gridDim.x * 4;
  bf16_t* Y = (bf16_t*)(p.ws + SB_Y);
  const float* nwt = p.in[I_SSM_NW];
  for (int item = gw; item < T_ * 8; item += 2 * nw) {
    const int item2 = item + nw; const bool v2 = item2 < T_ * 8;
    bf16_t* yp1 = Y + (size_t)(item >> 3) * 2048 + (item & 7) * 256 + lane * 4;
    bf16_t* yp2 = Y + (size_t)((v2 ? item2 : item) >> 3) * 2048 + ((v2 ? item2 : item) & 7) * 256 + lane * 4;
    const uint2 a = *(const uint2*)yp1; const uint2 b = *(const uint2*)yp2;
    float f[4], g[4]; unpack4(a, f); unpack4(b, g);
    const float ss1 = wave_sum(f[0] * f[0] + f[1] * f[1] + f[2] * f[2] + f[3] * f[3]);
    const float ss2 = wave_sum(g[0] * g[0] + g[1] * g[1] + g[2] * g[2] + g[3] * g[3]);
    const float r1 = rsqrtf(ss1 * (1.f / 256.f) + 1e-5f), r2 = rsqrtf(ss2 * (1.f / 256.f) + 1e-5f);
    const float4 w1 = *(const float4*)(nwt + (item & 7) * 256 + lane * 4);
    const float4 w2 = *(const float4*)(nwt + ((v2 ? item2 : item) & 7) * 256 + lane * 4);
    *(uint2*)yp1 = make_uint2(pack2(f[0] * r1 * w1.x, f[1] * r1 * w1.y), pack2(f[2] * r1 * w1.z, f[3] * r1 * w1.w));
    if (v2) *(uint2*)yp2 = make_uint2(pack2(g[0] * r2 * w2.x, g[1] * r2 * w2.y), pack2(g[2] * r2 * w2.z, g[3] * r2 * w2.w));
  }
}

template <int LPR>
DI void wkv_item(const Params& p, char* smem, int seq, int head, int part) {
  constexpr int ROWS = 256 / LPR, KPL = 64 / LPR, NV4 = KPL / 4;
  const int tid = TIDX;
  float* sR = (float*)smem;
  float* sK = sR + 2048;
  float* sKK = sK + 2048;
  float* sBB = sKK + 2048;
  float* sW = sBB + 2048;
  float* sV = sW + 2048;
  float* sO = sV + 2048;
  const bf16_t* __restrict__ R = (const bf16_t*)(p.ws + SC_R);
  const bf16_t* __restrict__ K = (const bf16_t*)(p.ws + SC_K);
  const bf16_t* __restrict__ V = (const bf16_t*)(p.ws + SC_V);
  const bf16_t* __restrict__ AAc = (const bf16_t*)(p.ws + SC_AA);
  const float* __restrict__ WD = (const float*)(p.ws + SC_WD);
  bf16_t* O = (bf16_t*)(p.ws + SC_O);
  const bool prompt = seq < 8;
  const int nch = prompt ? 64 : 1, nvalid = prompt ? 32 : 8;
  const int tbase = prompt ? seq * 2048 : TP_ + (seq - 8) * 8;
  const int row_l = tid / LPR, q = tid % LPR, row = part * ROWS + row_l;
  float S[KPL];
  {
    const float* s0 = p.in[I_ST_RW] + (((size_t)(seq - 8) * 16 + head) * 64 + row) * 64 + q * KPL;
#pragma unroll
    for (int e = 0; e < KPL; ++e) S[e] = prompt ? 0.f : s0[e];
  }
  const int pst = tid >> 3, pk0 = (tid & 7) * 8, pcol = head * 64 + pk0;
  const bool pact = pst < nvalid;
  float kk8[8], ka8[8];
  load8f(p.in[I_RW_KK] + pcol, kk8);
  load8f(p.in[I_RW_KA] + pcol, ka8);
  uint4 qr = make_uint4(0, 0, 0, 0), qk = qr, qv = qr, qa = qr;
  float4 qw0 = make_float4(0.f, 0.f, 0.f, 0.f), qw1 = qw0;
#define WKV_ISSUE(c_)                                                       \
  if (pact) {                                                               \
    const size_t o_ = (size_t)(tbase + (c_) * 32 + pst) * 1024 + pcol;      \
    qr = *(const uint4*)(R + o_); qk = *(const uint4*)(K + o_);             \
    qv = *(const uint4*)(V + o_); qa = *(const uint4*)(AAc + o_);           \
    qw0 = *(const float4*)(WD + o_); qw1 = *(const float4*)(WD + o_ + 4);   \
  }
  WKV_ISSUE(0);
  for (int c = 0; c < nch; ++c) {
    const int t0 = tbase + c * 32;
    __syncthreads();
    if (pact) {
      float r8[8], k8[8], v8[8], a8[8];
      unpack8(qr, r8); unpack8(qk, k8); unpack8(qv, v8); unpack8(qa, a8);
      const float w8[8] = {qw0.x, qw0.y, qw0.z, qw0.w, qw1.x, qw1.y, qw1.z, qw1.w};
      float kr[8], ss = 0.f;
#pragma unroll
      for (int e = 0; e < 8; ++e) { kr[e] = k8[e] * kk8[e]; ss += kr[e] * kr[e]; }
      ss = red_lanes<8>(ss);
      const float inv = 1.f / fmaxf(sqrtf(ss), 1e-12f);
      float kp[8], bb[8];
#pragma unroll
      for (int e = 0; e < 8; ++e) { kr[e] *= inv; kp[e] = k8[e] * (1.f + (a8[e] - 1.f) * ka8[e]); bb[e] = kr[e] * a8[e]; }
      const int lo = pst * 64 + pk0;
      store8f(sR + lo, r8); store8f(sK + lo, kp); store8f(sKK + lo, kr); store8f(sBB + lo, bb);
      store8f(sW + lo, w8); store8f(sV + lo, v8);
    }
    __syncthreads();
    if (c + 1 < nch) { WKV_ISSUE(c + 1); }
#define WKV_LOADV(P, st_)                                                                      \
    {                                                                                          \
      const int lo_ = (st_) * 64 + q * KPL;                                                    \
      _Pragma("unroll") for (int e = 0; e < NV4; ++e) {                                        \
        P##kk[e] = *(const float4*)(sKK + lo_ + 4 * e); P##ww[e] = *(const float4*)(sW + lo_ + 4 * e); \
        P##bb[e] = *(const float4*)(sBB + lo_ + 4 * e); P##kp[e] = *(const float4*)(sK + lo_ + 4 * e); \
        P##rr[e] = *(const float4*)(sR + lo_ + 4 * e);                                         \
      }                                                                                        \
      P##vv = sV[(st_) * 64 + row];                                                            \
    }
#define WKV_STEP(P, st_)                                                                       \
    {                                                                                          \
      float sa0 = 0.f, sa1 = 0.f;                                                              \
      _Pragma("unroll") for (int e = 0; e < NV4; ++e) {                                        \
        sa0 += S[4 * e] * P##kk[e].x + S[4 * e + 2] * P##kk[e].z;                              \
        sa1 += S[4 * e + 1] * P##kk[e].y + S[4 * e + 3] * P##kk[e].w;                          \
      }                                                                                        \
      const float sa = red_lanes<LPR>(sa0 + sa1);                                              \
      float o0 = 0.f, o1 = 0.f;                                                                \
      _Pragma("unroll") for (int e = 0; e < NV4; ++e) {                                        \
        S[4 * e] = S[4 * e] * P##ww[e].x - sa * P##bb[e].x + P##vv * P##kp[e].x;               \
        S[4 * e + 1] = S[4 * e + 1] * P##ww[e].y - sa * P##bb[e].y + P##vv * P##kp[e].y;       \
        S[4 * e + 2] = S[4 * e + 2] * P##ww[e].z - sa * P##bb[e].z + P##vv * P##kp[e].z;       \
        S[4 * e + 3] = S[4 * e + 3] * P##ww[e].w - sa * P##bb[e].w + P##vv * P##kp[e].w;       \
        o0 += S[4 * e] * P##rr[e].x + S[4 * e + 2] * P##rr[e].z;                               \
        o1 += S[4 * e + 1] * P##rr[e].y + S[4 * e + 3] * P##rr[e].w;                           \
      }                                                                                        \
      const float oo = red_lanes<LPR>(o0 + o1);                                                \
      if (q == 0) sO[(st_) * ROWS + row_l] = oo;                                               \
    }
    {
      float4 Akk[NV4], Aww[NV4], Abb[NV4], Akp[NV4], Arr[NV4]; float Avv;
      float4 Bkk[NV4], Bww[NV4], Bbb[NV4], Bkp[NV4], Brr[NV4]; float Bvv;
      if (LPR <= 4) {
#pragma unroll 1
        for (int st = 0; st < nvalid; ++st) { WKV_LOADV(A, st); WKV_STEP(A, st); }
      } else {
        WKV_LOADV(A, 0);
#pragma unroll 1
        for (int st = 0; st < nvalid; st += 2) {
          WKV_LOADV(B, st + 1);
          WKV_STEP(A, st);
          if (st + 2 < nvalid) { WKV_LOADV(A, st + 2); }
          WKV_STEP(B, st + 1);
        }
      }
    }
    __syncthreads();
    for (int i = tid; i < nvalid * ROWS; i += NTHR) {
      const int st = i / ROWS, rr = i % ROWS;
      O[(size_t)(t0 + st) * 1024 + head * 64 + part * ROWS + rr] = f2bf(sO[i]);
    }
  }
#undef WKV_ISSUE
#undef WKV_LOADV
#undef WKV_STEP
  float* dst = prompt ? (p.out + O_RW_P + (((size_t)seq * 16 + head) * 64 + row) * 64 + q * KPL)
                      : (p.out + O_RW_S + (((size_t)(seq - 8) * 16 + head) * 64 + row) * 64 + q * KPL);
#pragma unroll
  for (int e = 0; e < KPL; ++e) dst[e] = S[e];
}

template <int LPRP>
DI void ph_wkv(const Params& p, char* smem) {
  constexpr int NPART = 64 / (256 / LPRP);
  const int G = gridDim.x, bid = blockIdx.x;
  const int nP = 128 * NPART;
#pragma nounroll
  for (int it = bid; it < nP; it += G) {
    const int part = it % NPART, sh = it / NPART;
    wkv_item<LPRP>(p, smem, sh >> 4, sh & 15, part);
  }
  const int nS = 2048;
  int first, step;
  if (G > nP) { first = (bid >= nP) ? (bid - nP) : nS; step = G - nP; }
  else { first = bid; step = G; }
#pragma nounroll
  for (int it = first; it < nS; it += step) wkv_item<4>(p, smem, 8 + (it >> 4), it & 15, 0);
}

DI void ph_wkv_post(const Params& p) {
  const int tid_ = TIDX; const int lane = tid_ & 63;
  const int gw = blockIdx.x * 4 + (tid_ >> 6), nw = gridDim.x * 4;
  const bf16_t* __restrict__ R = (const bf16_t*)(p.ws + SC_R);
  const bf16_t* __restrict__ K = (const bf16_t*)(p.ws + SC_K);
  const bf16_t* __restrict__ V = (const bf16_t*)(p.ws + SC_V);
  const bf16_t* __restrict__ AAc = (const bf16_t*)(p.ws + SC_AA);
  const bf16_t* __restrict__ Gg = (const bf16_t*)(p.ws + SC_G);
  const bf16_t* __restrict__ O = (const bf16_t*)(p.ws + SC_O);
  bf16_t* __restrict__ U = (bf16_t*)(p.ws + W_U);
#pragma unroll 2
  for (int item = gw; item < T_ * 4; item += nw) {
    const int t = item >> 2, col = (item & 3) * 256 + lane * 4;
    const size_t o = (size_t)t * 1024 + col;
    float ov[4], rv[4], kv[4], av[4], vv[4], gv[4];
    unpack4(*(const uint2*)(O + o), ov); unpack4(*(const uint2*)(R + o), rv); unpack4(*(const uint2*)(K + o), kv);
    unpack4(*(const uint2*)(AAc + o), av); unpack4(*(const uint2*)(V + o), vv); unpack4(*(const uint2*)(Gg + o), gv);
    const float4 lw = *(const float4*)(p.in[I_RW_LNW] + col), lb = *(const float4*)(p.in[I_RW_LNB] + col);
    const float4 ka = *(const float4*)(p.in[I_RW_KA] + col), rk = *(const float4*)(p.in[I_RW_RK] + col);
    const float lwv[4] = {lw.x, lw.y, lw.z, lw.w}, lbv[4] = {lb.x, lb.y, lb.z, lb.w};
    const float kav[4] = {ka.x, ka.y, ka.z, ka.w}, rkv[4] = {rk.x, rk.y, rk.z, rk.w};
    const float mean = red_lanes<16>(ov[0] + ov[1] + ov[2] + ov[3]) * (1.f / 64.f);
    float d[4], s2 = 0.f, s3 = 0.f;
#pragma unroll
    for (int e = 0; e < 4; ++e) {
      d[e] = ov[e] - mean; s2 += d[e] * d[e];
      const float kp = kv[e] * (1.f + (av[e] - 1.f) * kav[e]);
      s3 += rv[e] * kp * rkv[e];
    }
    s2 = red_lanes<16>(s2); s3 = red_lanes<16>(s3);
    const float rs = rsqrtf(s2 * (1.f / 64.f) + 64e-5f);
    float y[4];
#pragma unroll
    for (int e = 0; e < 4; ++e) y[e] = (d[e] * rs * lwv[e] + lbv[e] + s3 * vv[e]) * gv[e];
    *(uint2*)(U + o) = make_uint2(pack2(y[0], y[1]), pack2(y[2], y[3]));
  }
}

constexpr int NPH = 40;
#ifndef REP_GEMM
#define REP_GEMM 1
#endif
#ifndef REP_SSD
#define REP_SSD 1
#endif
#ifndef REP_WKV
#define REP_WKV 1
#endif
#ifndef REP_MISC
#define REP_MISC 1
#endif

__global__ void __launch_bounds__(NTHR, 2) mega(Params p) {
  __shared__ __attribute__((aligned(16))) char smem[SMEM_BYTES];
  __shared__ uint4 xb_words;
  cg::grid_group grid = cg::this_grid();
  if (threadIdx.x == 0) xb_words = make_uint4(0u, 0u, 0u, 0u);
  __syncthreads();
  XcdBarrier xb = xcd_barrier_post((unsigned*)(p.ws + W_BAR), (volatile LAS unsigned*)&xb_words);
  int ph = 0;
#define PH(...)                                                     \
  {                                                                 \
    if (ph >= p.ph_begin && ph < p.ph_end) {                        \
      __VA_ARGS__;                                                  \
      xcd_barrier(xb);                                              \
    }                                                               \
    ++ph;                                                           \
  }
#define PHR(rep, ...)                                               \
  {                                                                 \
    if (ph >= p.ph_begin && ph < p.ph_end) {                        \
      for (int rep_ = 0; rep_ < (rep); ++rep_) {                    \
        __VA_ARGS__;                                                \
        xcd_barrier(xb);                                            \
      }                                                             \
    }                                                               \
    ++ph;                                                           \
  }
#define PH_LAST(...)                                                \
  {                                                                 \
    if (ph >= p.ph_begin && ph < p.ph_end) { __VA_ARGS__; }         \
    ++ph;                                                           \
  }
  bf16_t* wt = (bf16_t*)(p.ws + W_WT);
  bf16_t* U = (bf16_t*)(p.ws + W_U);
  float* X = (float*)(p.ws + W_X);

  {
    if (ph >= p.ph_begin && ph < p.ph_end) { ph_prologue(p, smem); grid.sync(); }
    ++ph;
    if (threadIdx.x == 0) {
      unsigned* bar = (unsigned*)(p.ws + W_BAR);
      unsigned base = 0;
      for (unsigned jx = 0; jx < 16; ++jx) { const unsigned c = xb_ld(&bar[XB_XCNT(jx)]); base += (jx < xb.x) ? c : 0u; }
      volatile LAS unsigned* st = (volatile LAS unsigned*)&xb_words;
      st[3] = base + st[2];
    }
    __syncthreads();
  }

#pragma nounroll
  for (int layer = 0; layer < 4; ++layer) {
    const int kind = layer % 3;
    PHR(REP_MISC, ph_rmsnorm(p, kind == 2 ? 1 : 0, p.in[I_NMIX] + layer * 1024));
    if (kind == 0) {
      const int ia = layer / 3;
      PHR(REP_GEMM, {
        GJob j = mkjob(U, 1024, wt + WA_IN + (size_t)ia * 2048 * 1024, 1024, 1024, 2048);
        j.o0 = p.ws + SA_XB; j.o1 = p.ws + SA_GT;
        int toff = 0; gemm_run<EPI_LRU_IN, false>(j, 8, toff, smem, VBLOCK());
      });
      PHR(REP_MISC, (ph_conv<1024, false>((const bf16_t*)(p.ws + SA_XB), (bf16_t*)(p.ws + SA_XC),
                               p.in[I_LRU_CW] + (size_t)ia * 4 * 1024, p.in[I_LRU_CB] + (size_t)ia * 1024,
                               p.in[I_ST_LC] + (size_t)ia * 128 * 3 * 1024,
                               p.out + O_LC_P + (size_t)ia * 8 * 3 * 1024, p.out + O_LC_S + (size_t)ia * 128 * 3 * 1024)));
      PHR(REP_GEMM, {
        const int G = gridDim.x;
        for (int tile = VBLOCK(); tile < MT_ * 8; tile += G) {
          const int mt = tile >> 3, jt = tile & 7;
          GJob j = mkjob((const bf16_t*)(p.ws + SA_XC) + jt * 128, 1024,
                         wt + WA_G + (size_t)ia * 2048 * 128, 128, 128, 2048);
          j.o0 = p.ws + SA_AA; j.o1 = p.ws + SA_XC;
          j.x0 = p.in[I_LRU_BR] + ia * 1024; j.x1 = p.in[I_LRU_BI] + ia * 1024; j.x2 = p.in[I_LRU_LAM] + ia * 1024;
          gemm_tile_dma<EPI_GATES>(j, mt * 128, jt * 256, 0, 4, smem);
        }
      });
      PHR(REP_MISC, ph_lru_scan1(p));
      PH(ph_lru_scan2(p, ia));
      PH({
        GJob j = mkjob((const bf16_t*)(p.ws + SA_GT), 1024, wt + WA_OUT + (size_t)ia * 1024 * 1024, 1024, 1024, 1024);
        j.o0 = X;
        gemm_streamk<EPI_RESID>(j, 4, smem, VBLOCK(), (unsigned*)(p.ws + W_BAR) + 4096, (unsigned)(layer * 2 + 1));
      });
    } else if (kind == 1) {
      PHR(REP_GEMM, {
        GJob j = mkjob(U, 1024, wt + WB_XBC, 1024, 1024, 4128);
        j.o0 = p.ws + SB_XBCP; j.o1 = p.ws + SB_DT; j.x0 = p.in[I_SSM_DTB];
        int toff = 0; gemm_run<EPI_SSM_XBC, false>(j, 17, toff, smem, VBLOCK());
      });
      PHR(REP_MISC, (ph_conv<4096, true>((const bf16_t*)(p.ws + SB_XBCP), (bf16_t*)(p.ws + SB_XBC),
                              p.in[I_SSM_CW], p.in[I_SSM_CB], p.in[I_ST_SC],
                              p.out + O_SC_P, p.out + O_SC_S)));
      PHR(REP_SSD, ph_ssd(p, smem));
      PH({
        GJob j = mkjob(U, 1024, wt + WB_Z, 1024, 1024, 2048);
        j.o0 = p.ws + SB_Y;
        int toff = 0; gemm_run<EPI_SSM_Z, false>(j, 8, toff, smem, VBLOCK());
      });
      PH(ph_gnorm(p));
      PH({
        GJob j = mkjob((const bf16_t*)(p.ws + SB_Y), 2048, wt + WB_OUT, 2048, 2048, 1024);
        j.o0 = X;
        gemm_streamk<EPI_RESID>(j, 4, smem, VBLOCK(), (unsigned*)(p.ws + W_BAR) + 4096, (unsigned)(layer * 2 + 1));
      });
    } else {
      PHR(REP_GEMM, {
        int toff = 0;
        for (int s = 0; s < 3; ++s) {
          GJob j = mkjob(U, 1024, wt + WC_RKV + (size_t)s * 1024 * 1024, 1024, 1024, 1024);
          j.A2 = (const bf16_t*)(p.ws + SC_UP); j.mu = p.in[I_RW_MU] + s * 1024;
          j.o0 = p.ws + SC_R + (size_t)s * SZ_TD2; j.ldo = 1024; j.act = 0;
          gemm_run<EPI_ST, true>(j, 8, toff, smem, VBLOCK());
        }
        for (int s = 0; s < 3; ++s) {
          const int nv = (s == 2) ? 128 : 64;
          GJob j = mkjob(U, 1024, wt + WC_L1 + (size_t)s * 64 * 1024, 1024, 1024, nv);
          j.A2 = (const bf16_t*)(p.ws + SC_UP); j.mu = p.in[I_RW_MU] + (3 + s) * 1024;
          j.o0 = p.ws + SC_LH + (size_t)s * 64 * 2; j.ldo = 256; j.act = (s == 0) ? 1 : (s == 2 ? 2 : 0);
          gemm_run<EPI_ST, true>(j, 1, toff, smem, VBLOCK());
        }
      });
      PHR(REP_GEMM, {
        int toff = 0;
        const bf16_t* LH = (const bf16_t*)(p.ws + SC_LH);
        {
          GJob j = mkjob(LH, 256, wt + WC_W2, 64, 64, 1024);
          j.o0 = p.ws + SC_WD; j.x0 = p.in[I_RW_W0];
          gemm_run<EPI_DECAY, false>(j, 4, toff, smem, VBLOCK());
        }
        {
          GJob j = mkjob(LH + 64, 256, wt + WC_A2, 64, 64, 1024);
          j.o0 = p.ws + SC_AA; j.x0 = p.in[I_RW_A0];
          gemm_run<EPI_SIGB, false>(j, 4, toff, smem, VBLOCK());
        }
        {
          GJob j = mkjob(LH + 128, 256, wt + WC_G2, 128, 128, 1024);
          j.o0 = p.ws + SC_G; j.ldo = 1024; j.act = 0;
          gemm_run<EPI_ST, false>(j, 4, toff, smem, VBLOCK());
        }
      });
      PHR(REP_WKV, ph_wkv<8>(p, smem));
      PHR(REP_MISC, ph_wkv_post(p));
      PH({
        GJob j = mkjob(U, 1024, wt + WC_OUT, 1024, 1024, 1024);
        j.o0 = X;
        gemm_streamk<EPI_RESID>(j, 4, smem, VBLOCK(), (unsigned*)(p.ws + W_BAR) + 4096, (unsigned)(layer * 2 + 1));
      });
    }
    PHR(REP_MISC, ph_rmsnorm(p, 0, p.in[I_NFFN] + layer * 1024));
    PHR(REP_GEMM, {
      GJob j = mkjob(U, 1024, wt + WF_1 + (size_t)layer * 4096 * 1024, 1024, 1024, 4096);
      j.o0 = p.ws + S_HB;
      int toff = 0; gemm_run<EPI_FFN1, false>(j, 16, toff, smem, VBLOCK());
    });
    PH({
      GJob j = mkjob((const bf16_t*)(p.ws + S_HB), 4096, wt + WF_2 + (size_t)layer * 4096 * 1024, 4096, 4096, 1024);
      j.o0 = X;
      gemm_streamk<EPI_RESID>(j, 4, smem, VBLOCK(), (unsigned*)(p.ws + W_BAR) + 4096, (unsigned)(layer * 2 + 2));
    });
  }
  PH_LAST(ph_rmsnorm(p, 2, p.in[I_NFIN]));
#undef PH
#undef PH_LAST
}

extern "C" void kernel_launch(void* const* d_in, const int* in_sizes, int n_in, void* d_out, int out_size,
                              void* d_ws, size_t ws_size, hipStream_t stream) {
  Params p;
  memset(&p, 0, sizeof(p));
  for (int i = 0; i < N_IN; ++i) p.in[i] = (const float*)d_in[i];
  p.out = (float*)d_out;
  p.ws = (char*)d_ws;
  p.ph_begin = 0;
  p.ph_end = 1000;
  static int grid_blocks = 0;
  if (!grid_blocks) {
    int dev = 0, cus = 0, per_cu = 0;
    hipGetDevice(&dev);
    hipDeviceGetAttribute(&cus, hipDeviceAttributeMultiprocessorCount, dev);
    hipOccupancyMaxActiveBlocksPerMultiprocessor(&per_cu, mega, NTHR, 0);
    if (per_cu > 2) per_cu = 2;
    if (per_cu < 1) per_cu = 1;
    grid_blocks = cus * per_cu;
  }
  if (ws_size < (size_t)536870912) fprintf(stderr, "workspace too small: %zu\n", ws_size);
  (void)hipMemsetAsync((char*)d_ws + W_BAR, 0, (4096 + 1024) * 4, stream);
  void* args[] = {&p};
  hipError_t e = hipLaunchCooperativeKernel((void*)mega, dim3(grid_blocks), dim3(NTHR), args, 0, stream);
  if (e != hipSuccess) fprintf(stderr, "cooperative launch failed: %s (grid %d)\n", hipGetErrorString(e), grid_blocks);
}
```

```cpp
#include <hip/hip_runtime.h>
#include <hip/hip_cooperative_groups.h>
#include <stdint.h>
#include <stdio.h>
#include <string.h>
namespace cg = cooperative_groups;

typedef unsigned short bf16_t;
typedef __attribute__((ext_vector_type(8))) short bf16x8;
typedef __attribute__((ext_vector_type(16))) float f32x16;

#define DI __device__ __forceinline__

constexpr int T_ = 17408;
constexpr int TP_ = 16384;
constexpr int NTHR = 256;
constexpr int MT_ = T_ / 128;

enum {
  I_XP = 0, I_XS, I_ST_LC, I_ST_LH, I_ST_SC, I_ST_SS, I_ST_RS, I_ST_RW,
  I_NMIX, I_NFFN, I_NFIN,
  I_LRU_WIN, I_LRU_CW, I_LRU_CB, I_LRU_WR, I_LRU_BR, I_LRU_WI, I_LRU_BI, I_LRU_LAM, I_LRU_WOUT,
  I_SSM_WIN, I_SSM_CW, I_SSM_CB, I_SSM_DTB, I_SSM_ALOG, I_SSM_D, I_SSM_NW, I_SSM_WOUT,
  I_RW_MU, I_RW_WRKV, I_RW_W0, I_RW_WW1, I_RW_WW2, I_RW_A0, I_RW_WA1, I_RW_WA2, I_RW_WG1, I_RW_WG2,
  I_RW_KK, I_RW_KA, I_RW_RK, I_RW_LNW, I_RW_LNB, I_RW_WOUT,
  I_FFN_W1, I_FFN_W2, N_IN
};

constexpr size_t O_Y = 0;
constexpr size_t O_LC_P = O_Y + (size_t)T_ * 1024;
constexpr size_t O_LC_S = O_LC_P + 2 * 8 * 3 * 1024;
constexpr size_t O_LH_P = O_LC_S + 2 * 128 * 3 * 1024;
constexpr size_t O_LH_S = O_LH_P + 2 * 8 * 1024;
constexpr size_t O_SC_P = O_LH_S + 2 * 128 * 1024;
constexpr size_t O_SC_S = O_SC_P + 8 * 3 * 4096;
constexpr size_t O_SS_P = O_SC_S + 128 * 3 * 4096;
constexpr size_t O_SS_S = O_SS_P + (size_t)8 * 32 * 64 * 128;
constexpr size_t O_RS_P = O_SS_S + (size_t)128 * 32 * 64 * 128;
constexpr size_t O_RS_S = O_RS_P + 8 * 1024;
constexpr size_t O_RW_P = O_RS_S + 128 * 1024;
constexpr size_t O_RW_S = O_RW_P + 8 * 16 * 64 * 64;

constexpr size_t W_X = 0;
constexpr size_t W_U = W_X + (size_t)T_ * 1024 * 4;
constexpr size_t W_WT = W_U + (size_t)T_ * 1024 * 2;
constexpr size_t WA_IN = 0;
constexpr size_t WA_G = WA_IN + 2 * 2048 * 1024;
constexpr size_t WA_OUT = WA_G + 2 * 2048 * 128;
constexpr size_t WB_XBC = WA_OUT + 2 * 1024 * 1024;
constexpr size_t WB_Z = WB_XBC + 4128 * 1024;
constexpr size_t WB_OUT = WB_Z + 2048 * 1024;
constexpr size_t WC_RKV = WB_OUT + 1024 * 2048;
constexpr size_t WC_L1 = WC_RKV + 3 * 1024 * 1024;
constexpr size_t WC_W2 = WC_L1 + 256 * 1024;
constexpr size_t WC_A2 = WC_W2 + 1024 * 64;
constexpr size_t WC_G2 = WC_A2 + 1024 * 64;
constexpr size_t WC_OUT = WC_G2 + 1024 * 128;
constexpr size_t WF_1 = WC_OUT + 1024 * 1024;
constexpr size_t WF_2 = WF_1 + (size_t)4 * 4096 * 1024;
constexpr size_t W_WT_ELEMS = WF_2 + (size_t)4 * 4096 * 1024;
constexpr size_t W_S = W_WT + W_WT_ELEMS * 2;
constexpr size_t SZ_TD2 = (size_t)T_ * 1024 * 2;
constexpr size_t SZ_TD4 = (size_t)T_ * 1024 * 4;
constexpr size_t S_HB = W_S;
constexpr size_t SA_XB = W_S;
constexpr size_t SA_GT = SA_XB + SZ_TD2;
constexpr size_t SA_XC = SA_GT + SZ_TD2;
constexpr size_t SA_AA = SA_XC + SZ_TD2;
constexpr size_t SA_BB = SA_AA + SZ_TD4;
constexpr size_t SA_CP = SA_BB + SZ_TD4;
constexpr size_t SA_CS = SA_CP + 8 * 64 * 1024 * 4;
constexpr size_t SB_XBCP = W_S;
constexpr size_t SB_Y = W_S;
constexpr size_t SB_XBC = SB_XBCP + SZ_TD2 * 4;
constexpr size_t SB_DT = SB_XBC + SZ_TD2 * 4;
constexpr size_t SC_UP = W_S;
constexpr size_t SC_O = W_S;
constexpr size_t SC_R = SC_UP + SZ_TD2;
constexpr size_t SC_K = SC_R + SZ_TD2;
constexpr size_t SC_V = SC_K + SZ_TD2;
constexpr size_t SC_LH = SC_V + SZ_TD2;
constexpr size_t SC_WD = SC_LH + (size_t)T_ * 256 * 2;
constexpr size_t SC_AA = SC_WD + SZ_TD4;
constexpr size_t SC_G = SC_AA + SZ_TD2;
constexpr size_t SC_END = SC_G + SZ_TD2;
static_assert(SC_END <= (size_t)536870912, "ws overflow C");
static_assert(SB_DT + (size_t)T_ * 32 * 4 <= (size_t)536870912, "ws overflow B");
static_assert(SA_CS + 8 * 64 * 1024 * 4 <= (size_t)536870912, "ws overflow A");

constexpr int SMEM_BYTES = 80384;
constexpr size_t W_BAR = (size_t)536870912 - 65536;

struct Params {
  const float* in[N_IN];
  float* out;
  char* ws;
  int ph_begin, ph_end;
};

DI float bf2f(bf16_t h) { return __uint_as_float(((unsigned)h) << 16); }
DI bf16_t f2bf(float f) {
  unsigned u = __float_as_uint(f);
  u += 0x7FFFu + ((u >> 16) & 1u);
  return (bf16_t)(u >> 16);
}
DI unsigned pack2(float a, float b) { return (unsigned)f2bf(a) | ((unsigned)f2bf(b) << 16); }
DI void unpack8(const uint4 v, float (&f)[8]) {
  f[0] = __uint_as_float(v.x << 16); f[1] = __uint_as_float(v.x & 0xFFFF0000u);
  f[2] = __uint_as_float(v.y << 16); f[3] = __uint_as_float(v.y & 0xFFFF0000u);
  f[4] = __uint_as_float(v.z << 16); f[5] = __uint_as_float(v.z & 0xFFFF0000u);
  f[6] = __uint_as_float(v.w << 16); f[7] = __uint_as_float(v.w & 0xFFFF0000u);
}
DI void unpack4(const uint2 v, float (&f)[4]) {
  f[0] = __uint_as_float(v.x << 16); f[1] = __uint_as_float(v.x & 0xFFFF0000u);
  f[2] = __uint_as_float(v.y << 16); f[3] = __uint_as_float(v.y & 0xFFFF0000u);
}
DI uint4 pack8(const float (&f)[8]) {
  return make_uint4(pack2(f[0], f[1]), pack2(f[2], f[3]), pack2(f[4], f[5]), pack2(f[6], f[7]));
}
DI void load8f(const float* p, float (&f)[8]) {
  float4 a = *(const float4*)p, b = *(const float4*)(p + 4);
  f[0] = a.x; f[1] = a.y; f[2] = a.z; f[3] = a.w; f[4] = b.x; f[5] = b.y; f[6] = b.z; f[7] = b.w;
}
DI void store8f(float* p, const float (&f)[8]) {
  *(float4*)p = make_float4(f[0], f[1], f[2], f[3]);
  *(float4*)(p + 4) = make_float4(f[4], f[5], f[6], f[7]);
}
DI float sigmoidf_(float x) { return 1.f / (1.f + __expf(-x)); }
DI float siluf_(float x) { return x / (1.f + __expf(-x)); }
DI float tanhf_(float y) { return 1.f - 2.f / (1.f + __expf(2.f * y)); }
DI float geluf_(float x) { return 0.5f * x * (1.f + tanhf_(0.7978845608028654f * (x + 0.044715f * x * x * x))); }
DI float softplusf_(float x) { return fmaxf(x, 0.f) + log1pf(__expf(-fabsf(x))); }
DI float softplus_fast(float x) { return fmaxf(x, 0.f) + __logf(1.f + __expf(-fabsf(x))); }
DI float wave_sum(float v) {
#pragma unroll
  for (int o = 32; o >= 1; o >>= 1) v += __shfl_xor(v, o, 64);
  return v;
}
template <int CTRL> DI float dppf(float x) {
  return __int_as_float(__builtin_amdgcn_update_dpp(0, __float_as_int(x), CTRL, 0xf, 0xf, false));
}
template <int N> DI float red_lanes(float x) {
  x += dppf<0xB1>(x);
  x += dppf<0x4E>(x);
  if (N >= 8) x += dppf<0x141>(x);
  if (N >= 16) x += dppf<0x140>(x);
  return x;
}
DI void tok_info(int t, int& seq, int& l, int& L) {
  if (t < TP_) { seq = t >> 11; l = t & 2047; L = 2048; }
  else { int u = t - TP_; seq = 8 + (u >> 3); l = u & 7; L = 8; }
}
DI int opq(int x) { asm volatile("" : "+v"(x)); return x; }
#define TIDX opq((int)threadIdx.x)
DI f32x16 mfma32(bf16x8 a, bf16x8 b, f32x16 c) { return __builtin_amdgcn_mfma_f32_32x32x16_bf16(a, b, c, 0, 0, 0); }


#define XB_TMO      128
#define XB_XCNT(j)  (256  + 64 * (j))
#define XB_XSUB(j)  (1280 + 64 * (j))
#define XB_XGEN(j)  (2304 + 64 * (j))
#define XB_TOP      3328
#define XB_TOPGEN   3392
#define XCD_BAR_WORDS 3456
#define XB_SPIN_CAP (1u << 22)
#define LAS __attribute__((address_space(3)))
DI unsigned xb_ld(unsigned* p) { return __hip_atomic_load(p, __ATOMIC_RELAXED, __HIP_MEMORY_SCOPE_AGENT); }
DI unsigned xb_add(unsigned* p, unsigned v) { return __hip_atomic_fetch_add(p, v, __ATOMIC_RELAXED, __HIP_MEMORY_SCOPE_AGENT); }
DI unsigned xb_xcc_id() { return (unsigned)__builtin_amdgcn_s_getreg((3 << 11) | 20) & 0xFu; }
#define XB_SPIN(cond, bar) do { unsigned _sp = 0; while (cond) { __builtin_amdgcn_s_sleep(1); \
    if ((++_sp & 255u) == 0u) { if (xb_ld(&(bar)[XB_TMO])) break; if (_sp > XB_SPIN_CAP) { atomicAdd(&(bar)[XB_TMO], 1u); break; } } } } while (0)
struct XcdBarrier { unsigned* bar; unsigned x; volatile LAS unsigned* st; };
DI XcdBarrier xcd_barrier_post(unsigned* bar, volatile LAS unsigned* st) {
  XcdBarrier b; b.bar = bar; b.x = xb_xcc_id(); b.st = st;
  if (threadIdx.x == 0) st[2] = xb_add(&bar[XB_XCNT(b.x)], 1u);
  return b;
}
DI void xcd_barrier_complete(unsigned* bar, unsigned x, unsigned& nloc, unsigned& nx) {
  const unsigned G = gridDim.x * gridDim.y * gridDim.z;
  unsigned sum, cnt, mine, sp = 0u;
  for (;;) {
    sum = 0u; cnt = 0u; mine = 0u;
#pragma unroll
    for (unsigned j = 0; j < 16; ++j) { const unsigned c = xb_ld(&bar[XB_XCNT(j)]); sum += c; cnt += (c > 0u) ? 1u : 0u; mine = (j == x) ? c : mine; }
    if (sum == G) break;
    __builtin_amdgcn_s_sleep(1);
    if ((++sp & 255u) == 0u) { if (xb_ld(&bar[XB_TMO])) break; if (sp > XB_SPIN_CAP) { atomicAdd(&bar[XB_TMO], 1u); break; } }
  }
  nloc = mine > 0u ? mine : 1u; nx = cnt > 0u ? cnt : 1u;
}
DI void xcd_barrier(const XcdBarrier& b) {
  asm volatile("s_waitcnt vmcnt(0)" ::: "memory");
  __syncthreads();
  if (threadIdx.x == 0) {
    unsigned* bar = b.bar;
    __builtin_amdgcn_s_waitcnt(0);
    unsigned nloc = b.st[0], nx = b.st[1];
    if (nloc == 0u) { xcd_barrier_complete(bar, b.x, nloc, nx); b.st[0] = nloc; b.st[1] = nx; }
    const unsigned old = xb_add(&bar[XB_XSUB(b.x)], 1u);
    const unsigned gen = old / nloc;
    if (old + 1u == (gen + 1u) * nloc) {
      __builtin_amdgcn_fence(__ATOMIC_RELEASE, "agent");
      asm volatile("s_waitcnt vmcnt(0)" ::: "memory");
      const unsigned og = xb_add(&bar[XB_TOP], 1u);
      const unsigned tg = og / nx;
      if (og + 1u == (tg + 1u) * nx) xb_add(&bar[XB_TOPGEN], 1u);
      else XB_SPIN(xb_ld(&bar[XB_TOPGEN]) == tg, bar);
      __builtin_amdgcn_fence(__ATOMIC_ACQUIRE, "agent");
      xb_add(&bar[XB_XGEN(b.x)], 1u);
      asm volatile("s_waitcnt vmcnt(0)" ::: "memory");
    } else {
      XB_SPIN(xb_ld(&bar[XB_XGEN(b.x)]) == gen, bar);
      __builtin_amdgcn_fence(__ATOMIC_ACQUIRE, "agent");
      asm volatile("s_waitcnt vmcnt(0)" ::: "memory");
    }
  }
  __syncthreads();
}

struct GJob {
  const bf16_t* A; const bf16_t* A2; const float* mu; const bf16_t* Bt;
  int lda, ldb, K, nvalid;
  void* o0; void* o1; const float* x0; const float* x1; const float* x2;
  int ldo, act;
};
enum { EPI_LRU_IN = 0, EPI_GATES, EPI_RESID, EPI_SSM_XBC, EPI_SSM_Z, EPI_FFN1, EPI_ST, EPI_DECAY, EPI_SIGB };

template <int EPI> DI void epi_elem(const GJob& j, int row, int col, float v) {
  if (EPI == EPI_LRU_IN) {
    if (col < 1024) ((bf16_t*)j.o0)[(size_t)row * 1024 + col] = f2bf(v);
    else ((bf16_t*)j.o1)[(size_t)row * 1024 + col - 1024] = f2bf(geluf_(v));
  } else if (EPI == EPI_RESID) {
    unsafeAtomicAdd((float*)j.o0 + (size_t)row * 1024 + col, v);
  } else if (EPI == EPI_SSM_XBC) {
    if (col < 4096) ((bf16_t*)j.o0)[(size_t)row * 4096 + col] = f2bf(v);
  } else if (EPI == EPI_SSM_Z) {
    bf16_t* y = (bf16_t*)j.o0 + (size_t)row * 2048 + col;
    *y = f2bf(bf2f(*y) * siluf_(v));
  } else if (EPI == EPI_FFN1) {
    float r = fmaxf(v, 0.f);
    ((bf16_t*)j.o0)[(size_t)row * 4096 + col] = f2bf(r * r);
  } else if (EPI == EPI_ST) {
    if (col < j.nvalid) {
      float r = v;
      if (j.act == 1) r = tanhf_(v); else if (j.act == 2) r = sigmoidf_(v);
      ((bf16_t*)j.o0)[(size_t)row * j.ldo + col] = f2bf(r);
    }
  } else if (EPI == EPI_DECAY) {
    float wl = -softplusf_(-(j.x0[col] + v)) - 0.5f;
    ((float*)j.o0)[(size_t)row * 1024 + col] = __expf(-__expf(wl));
  } else if (EPI == EPI_SIGB) {
    ((bf16_t*)j.o0)[(size_t)row * 1024 + col] = f2bf(sigmoidf_(j.x0[col] + v));
  }
}

DI void quad_transpose4(float (&v)[4], int l) {
  const bool o1 = l & 1, o2 = l & 2;
  {
    const float s01 = o1 ? v[0] : v[1], s23 = o1 ? v[2] : v[3];
    const float r01 = dppf<0xB1>(s01), r23 = dppf<0xB1>(s23);
    if (o1) { v[0] = r01; v[2] = r23; } else { v[1] = r01; v[3] = r23; }
  }
  {
    const float s02 = o2 ? v[0] : v[2], s13 = o2 ? v[1] : v[3];
    const float r02 = dppf<0x4E>(s02), r13 = dppf<0x4E>(s13);
    if (o2) { v[0] = r02; v[1] = r13; } else { v[2] = r02; v[3] = r13; }
  }
}
DI uint2 pack4(float a, float b, float c, float d) { return make_uint2(pack2(a, b), pack2(c, d)); }
template <int EPI> DI void epi4(const GJob& j, int row, int col, const float (&v)[4]) {
  if (EPI == EPI_LRU_IN) {
    if (col < 1024) *(uint2*)((bf16_t*)j.o0 + (size_t)row * 1024 + col) = pack4(v[0], v[1], v[2], v[3]);
    else *(uint2*)((bf16_t*)j.o1 + (size_t)row * 1024 + col - 1024) = pack4(geluf_(v[0]), geluf_(v[1]), geluf_(v[2]), geluf_(v[3]));
  } else if (EPI == EPI_RESID) {
    float4* x = (float4*)((float*)j.o0 + (size_t)row * 1024 + col);
    float4 t = *x; t.x += v[0]; t.y += v[1]; t.z += v[2]; t.w += v[3]; *x = t;
  } else if (EPI == EPI_SSM_XBC) {
    if (col < 4096) *(uint2*)((bf16_t*)j.o0 + (size_t)row * 4096 + col) = pack4(v[0], v[1], v[2], v[3]);
  } else if (EPI == EPI_SSM_Z) {
    uint2* y = (uint2*)((bf16_t*)j.o0 + (size_t)row * 2048 + col);
    float f[4]; unpack4(*y, f);
    *y = pack4(f[0] * siluf_(v[0]), f[1] * siluf_(v[1]), f[2] * siluf_(v[2]), f[3] * siluf_(v[3]));
  } else if (EPI == EPI_FFN1) {
    const float r0 = fmaxf(v[0], 0.f), r1 = fmaxf(v[1], 0.f), r2 = fmaxf(v[2], 0.f), r3 = fmaxf(v[3], 0.f);
    *(uint2*)((bf16_t*)j.o0 + (size_t)row * 4096 + col) = pack4(r0 * r0, r1 * r1, r2 * r2, r3 * r3);
  } else if (EPI == EPI_ST) {
    if (col < j.nvalid) {
      float r[4];
#pragma unroll
      for (int e = 0; e < 4; ++e) r[e] = (j.act == 1) ? tanhf_(v[e]) : ((j.act == 2) ? sigmoidf_(v[e]) : v[e]);
      *(uint2*)((bf16_t*)j.o0 + (size_t)row * j.ldo + col) = pack4(r[0], r[1], r[2], r[3]);
    }
  } else if (EPI == EPI_DECAY) {
    const float4 w0 = *(const float4*)(j.x0 + col);
    const float w[4] = {w0.x, w0.y, w0.z, w0.w};
    float r[4];
#pragma unroll
    for (int e = 0; e < 4; ++e) r[e] = __expf(-__expf(-softplus_fast(-(w[e] + v[e])) - 0.5f));
    *(float4*)((float*)j.o0 + (size_t)row * 1024 + col) = make_float4(r[0], r[1], r[2], r[3]);
  } else if (EPI == EPI_SIGB) {
    const float4 a0 = *(const float4*)(j.x0 + col);
    *(uint2*)((bf16_t*)j.o0 + (size_t)row * 1024 + col) =
        pack4(sigmoidf_(a0.x + v[0]), sigmoidf_(a0.y + v[1]), sigmoidf_(a0.z + v[2]), sigmoidf_(a0.w + v[3]));
  }
}

template <int EPI, bool MIX>
DI void gemm_tile(const GJob& j, int m0, int n0, int kt0, int kt1, char* smem) {
  const int tid = TIDX, lane = tid & 63, w = tid >> 6;
  const int wm = w >> 1, wn = w & 1, r32 = lane & 31, hh = lane >> 5;
  const int lrow = tid >> 3, kc = tid & 7;
  f32x16 acc[2][2];
#pragma unroll
  for (int a = 0; a < 2; ++a)
#pragma unroll
    for (int b = 0; b < 2; ++b)
#pragma unroll
      for (int r = 0; r < 16; ++r) acc[a][b][r] = 0.f;
  uint4 qa00, qa01, qa02, qa03, qb00, qb01, qb02, qb03, qc00, qc01, qc02, qc03;
  uint4 qa10, qa11, qa12, qa13, qb10, qb11, qb12, qb13, qc10, qc11, qc12, qc13;
  qc00 = qc01 = qc02 = qc03 = qc10 = qc11 = qc12 = qc13 = make_uint4(0, 0, 0, 0);
  const int nk = kt1 - kt0;
  const bf16_t* Ap = j.A + (size_t)(m0 + lrow) * j.lda + kc * 8 + (size_t)kt0 * 64;
  const bf16_t* A2p = MIX ? (j.A2 + (size_t)(m0 + lrow) * j.lda + kc * 8 + (size_t)kt0 * 64) : nullptr;
  const bf16_t* Bp = j.Bt + (size_t)(n0 + lrow) * j.ldb + kc * 8 + (size_t)kt0 * 64;
  const size_t astep = (size_t)32 * j.lda, bstep = (size_t)32 * j.ldb;
  const bool bv0 = (n0 + lrow) < j.nvalid, bv1 = (n0 + lrow + 32) < j.nvalid;
  const bool bv2 = (n0 + lrow + 64) < j.nvalid, bv3 = (n0 + lrow + 96) < j.nvalid;
  const uint4 z4 = make_uint4(0, 0, 0, 0);

#define LD1(s, i, kt)                                                                 \
  qa##s##i = *(const uint4*)(Ap + i * astep + (kt) * 64);                             \
  if (MIX) qc##s##i = *(const uint4*)(A2p + i * astep + (kt) * 64);                   \
  qb##s##i = z4;                                                                      \
  if (bv##i) qb##s##i = *(const uint4*)(Bp + i * bstep + (kt) * 64);
#define GLOAD(s, kt) { LD1(s, 0, kt) LD1(s, 1, kt) LD1(s, 2, kt) LD1(s, 3, kt) }
#define ST1(s, i, As_, Bs_)                                                           \
  if (MIX) {                                                                          \
    float f1[8], f2[8]; unpack8(qa##s##i, f1); unpack8(qc##s##i, f2);                 \
    _Pragma("unroll") for (int e = 0; e < 8; ++e) f1[e] = f1[e] + (f2[e] - f1[e]) * mu8[e]; \
    qa##s##i = pack8(f1);                                                             \
  }                                                                                   \
  *(uint4*)(As_ + (lrow + 32 * i) * 144 + kc * 16) = qa##s##i;                        \
  *(uint4*)(Bs_ + (lrow + 32 * i) * 144 + kc * 16) = qb##s##i;
#define SSTORE(s, kt, buf)                                                            \
  {                                                                                   \
    char* As_ = smem + (buf) * 36864; char* Bs_ = As_ + 18432;                        \
    float mu8[8];                                                                     \
    if (MIX) load8f(j.mu + (kt0 + (kt)) * 64 + kc * 8, mu8);                          \
    ST1(s, 0, As_, Bs_) ST1(s, 1, As_, Bs_) ST1(s, 2, As_, Bs_) ST1(s, 3, As_, Bs_)   \
  }
#define LOADF(F, ks)                                                                  \
  bf16x8 F##a0 = *(const bf16x8*)(ap + (ks) * 32);                                    \
  bf16x8 F##a1 = *(const bf16x8*)(ap + 32 * 144 + (ks) * 32);                         \
  bf16x8 F##b0 = *(const bf16x8*)(bp + (ks) * 32);                                    \
  bf16x8 F##b1 = *(const bf16x8*)(bp + 32 * 144 + (ks) * 32);
#define MFMA4(F)                                                                      \
  acc[0][0] = mfma32(F##a0, F##b0, acc[0][0]);                                        \
  acc[0][1] = mfma32(F##a0, F##b1, acc[0][1]);                                        \
  acc[1][0] = mfma32(F##a1, F##b0, acc[1][0]);                                        \
  acc[1][1] = mfma32(F##a1, F##b1, acc[1][1]);
#define COMPUTE(buf)                                                                  \
  {                                                                                   \
    const char* As_ = smem + (buf) * 36864; const char* Bs_ = As_ + 18432;            \
    const char* ap = As_ + (wm * 64 + r32) * 144 + hh * 16;                           \
    const char* bp = Bs_ + (wn * 64 + r32) * 144 + hh * 16;                           \
    LOADF(f0, 0) LOADF(f1, 1)                                                         \
    __builtin_amdgcn_sched_barrier(0);                                                \
    MFMA4(f0)                                                                         \
    LOADF(f2, 2)                                                                      \
    __builtin_amdgcn_sched_barrier(0);                                                \
    MFMA4(f1)                                                                         \
    LOADF(f3, 3)                                                                      \
    __builtin_amdgcn_sched_barrier(0);                                                \
    MFMA4(f2)                                                                         \
    __builtin_amdgcn_sched_barrier(0);                                                \
    MFMA4(f3)                                                                         \
    __builtin_amdgcn_sched_barrier(0);                                                \
  }

  qa10 = qa11 = qa12 = qa13 = qb10 = qb11 = qb12 = qb13 = z4;
  if (MIX) {
    GLOAD(0, 0);
    SSTORE(0, 0, 0);
    __syncthreads();
    for (int i = 0; i < nk; ++i) {
      if (i + 1 < nk) GLOAD(0, i + 1);
      if (i & 1) { COMPUTE(1); } else { COMPUTE(0); }
      if (i + 1 < nk) { if (i & 1) { SSTORE(0, i + 1, 0); } else { SSTORE(0, i + 1, 1); } }
      __syncthreads();
    }
  } else if (nk == 1) {
    GLOAD(0, 0);
    SSTORE(0, 0, 0);
    __syncthreads();
    COMPUTE(0);
    __syncthreads();
  } else {
    GLOAD(0, 0);
    GLOAD(1, 1);
    SSTORE(0, 0, 0);
    __syncthreads();
#pragma unroll 1
    for (int i = 0; i + 2 < nk; i += 2) {
      GLOAD(0, i + 2);
      COMPUTE(0);
      SSTORE(1, i + 1, 1);
      __syncthreads();
      GLOAD(1, i + 3);
      COMPUTE(1);
      SSTORE(0, i + 2, 0);
      __syncthreads();
    }
    COMPUTE(0);
    SSTORE(1, nk - 1, 1);
    __syncthreads();
    COMPUTE(1);
    __syncthreads();
  }
#undef LD1
#undef ST1
#undef LOADF
#undef MFMA4
#undef GLOAD
#undef SSTORE
#undef COMPUTE

  if (EPI == EPI_GATES) {
    const int ch = (n0 >> 7) * 64 + wn * 32 + r32;
    const float br = j.x0[ch], bi = j.x1[ch];
    const float spl = softplusf_(-j.x2[ch]);
    const bf16_t* XC = (const bf16_t*)j.o1;
    float* AA = (float*)j.o0;
    float* BBp = AA + (size_t)T_ * 1024;
#pragma unroll
    for (int mi = 0; mi < 2; ++mi)
#pragma unroll
      for (int r = 0; r < 16; ++r) {
        const int row = m0 + wm * 64 + mi * 32 + (r & 3) + 8 * (r >> 2) + 4 * hh;
        const float rg = sigmoidf_(acc[mi][0][r] + br);
        const float ig = sigmoidf_(acc[mi][1][r] + bi);
        const float la = -8.f * rg * spl;
        const float xc = bf2f(XC[(size_t)row * 1024 + ch]);
        const bool reset = (row < TP_) && ((row & 2047) == 0);
        const float a = reset ? 0.f : __expf(la);
        const float mult = reset ? 1.f : sqrtf(fmaxf(-expm1f(2.f * la), 0.f));
        AA[(size_t)row * 1024 + ch] = a;
        BBp[(size_t)row * 1024 + ch] = mult * ig * xc;
      }
  } else {
#pragma unroll
    for (int mi = 0; mi < 2; ++mi)
#pragma unroll
      for (int ni = 0; ni < 2; ++ni)
#pragma unroll
        for (int r = 0; r < 16; ++r) {
          const int row = m0 + wm * 64 + mi * 32 + (r & 3) + 8 * (r >> 2) + 4 * hh;
          const int col = n0 + wn * 64 + ni * 32 + r32;
          epi_elem<EPI>(j, row, col, acc[mi][ni][r]);
          if ((r & 7) == 7) __builtin_amdgcn_sched_barrier(0);
        }
  }
}

constexpr int DSLOT = 24576;
template <int EPI>
DI void gemm_tile_dma(const GJob& j, int m0, int n0, int k0, int k1, char* smem, unsigned* wflag = nullptr, unsigned epoch = 0u) {
  const int tid = TIDX, lane = tid & 63, w = tid >> 6;
  const int wm = w >> 1, wn = w & 1, r32 = lane & 31, hh = lane >> 5;
  f32x16 acc[2][4];
#pragma unroll
  for (int a = 0; a < 2; ++a)
#pragma unroll
    for (int b = 0; b < 4; ++b)
#pragma unroll
      for (int r = 0; r < 16; ++r) acc[a][b][r] = 0.f;
  const int nk = k1 - k0;
  const int dr = lane >> 2;
  const int dc = (lane & 3) ^ ((lane >> 4) & 3);
  const int nlim = j.nvalid - 1;
  const size_t kofs = (size_t)k0 * 32 + dc * 8;
  const bf16_t* gA0 = j.A + (size_t)(m0 + 32 * w + dr) * j.lda + kofs;
  const bf16_t* gA1 = j.A + (size_t)(m0 + 32 * w + 16 + dr) * j.lda + kofs;
  const bf16_t* gB0 = j.Bt + (size_t)min(n0 + 64 * w + dr, nlim) * j.ldb + kofs;
  const bf16_t* gB1 = j.Bt + (size_t)min(n0 + 64 * w + 16 + dr, nlim) * j.ldb + kofs;
  const bf16_t* gB2 = j.Bt + (size_t)min(n0 + 64 * w + 32 + dr, nlim) * j.ldb + kofs;
  const bf16_t* gB3 = j.Bt + (size_t)min(n0 + 64 * w + 48 + dr, nlim) * j.ldb + kofs;
  char* ldsA = smem + (2 * w) * 1024 + lane * 16;
  char* ldsB = smem + 8192 + (4 * w) * 1024 + lane * 16;
  const unsigned lbase = (unsigned)(unsigned long long)(LAS char*)smem;
  const int fsw = (r32 >> 2) & 3;
  const unsigned pa = (unsigned)((wm * 64 + r32) * 64), pb = (unsigned)(8192 + (wn * 128 + r32) * 64);
  const unsigned po0 = (unsigned)(((hh) ^ fsw) * 16), po1 = (unsigned)(((2 + hh) ^ fsw) * 16);

#define DMA1(gp, lp) __builtin_amdgcn_global_load_lds((const unsigned*)(gp), (unsigned*)(lp), 16, 0, 0)
#define ISSUE(kt, slot)                                                                          \
  {                                                                                              \
    const int ko_ = (kt) * 32;                                                                   \
    char* la_ = ldsA + (slot) * DSLOT; char* lb_ = ldsB + (slot) * DSLOT;                        \
    DMA1(gA0 + ko_, la_); DMA1(gA1 + ko_, la_ + 1024);                                           \
    DMA1(gB0 + ko_, lb_); DMA1(gB1 + ko_, lb_ + 1024); DMA1(gB2 + ko_, lb_ + 2048); DMA1(gB3 + ko_, lb_ + 3072); \
  }
#define SB_ __builtin_amdgcn_sched_barrier(0)

  asm volatile("s_waitcnt vmcnt(0)" ::: "memory");
  const int last = nk - 1;
  ISSUE(0, 0);
  { const int t1 = min(1, last); ISSUE(t1, 1); }
  int sl_r = 0, sl_w = 2;
#pragma unroll 1
  for (int i = 0; i < nk; ++i) {
    asm volatile("s_waitcnt vmcnt(6)" ::: "memory");
    __builtin_amdgcn_s_barrier();
    const int ko2 = min(i + 2, last) * 32;
    char* la2 = ldsA + sl_w * DSLOT; char* lb2 = ldsB + sl_w * DSLOT;
    const unsigned sl = lbase + (unsigned)(sl_r * DSLOT);
    sl_r = (sl_r == 2) ? 0 : sl_r + 1;
    sl_w = (sl_w == 2) ? 0 : sl_w + 1;
    bf16x8 a00, a10, a01, a11, b00, b10, b20, b30, b01, b11, b21, b31;
    const unsigned aA0 = sl + pa + po0, aB0 = sl + pb + po0, aA1 = sl + pa + po1, aB1 = sl + pb + po1;
    asm volatile("ds_read_b128 %0, %1" : "=v"(a00) : "v"(aA0));
    asm volatile("ds_read_b128 %0, %1 offset:2048" : "=v"(a10) : "v"(aA0));
    asm volatile("ds_read_b128 %0, %1" : "=v"(b00) : "v"(aB0));
    asm volatile("ds_read_b128 %0, %1 offset:2048" : "=v"(b10) : "v"(aB0));
    asm volatile("ds_read_b128 %0, %1 offset:4096" : "=v"(b20) : "v"(aB0));
    asm volatile("ds_read_b128 %0, %1 offset:6144" : "=v"(b30) : "v"(aB0));
    asm volatile("ds_read_b128 %0, %1" : "=v"(a01) : "v"(aA1));
    asm volatile("ds_read_b128 %0, %1 offset:2048" : "=v"(a11) : "v"(aA1));
    asm volatile("ds_read_b128 %0, %1" : "=v"(b01) : "v"(aB1));
    asm volatile("ds_read_b128 %0, %1 offset:2048" : "=v"(b11) : "v"(aB1));
    asm volatile("ds_read_b128 %0, %1 offset:4096" : "=v"(b21) : "v"(aB1));
    asm volatile("ds_read_b128 %0, %1 offset:6144" : "=v"(b31) : "v"(aB1));
    DMA1(gA0 + ko2, la2);
    asm volatile("s_waitcnt lgkmcnt(0)" : "+v"(a00), "+v"(a10), "+v"(b00), "+v"(b10), "+v"(b20), "+v"(b30),
                 "+v"(a01), "+v"(a11), "+v"(b01), "+v"(b11), "+v"(b21), "+v"(b31) :: "memory");
    acc[0][0] = mfma32(a00, b00, acc[0][0]);
    acc[0][1] = mfma32(a00, b10, acc[0][1]);
    acc[0][2] = mfma32(a00, b20, acc[0][2]);
    SB_; DMA1(gA1 + ko2, la2 + 1024); SB_;
    acc[0][3] = mfma32(a00, b30, acc[0][3]);
    acc[1][0] = mfma32(a10, b00, acc[1][0]);
    acc[1][1] = mfma32(a10, b10, acc[1][1]);
    SB_; DMA1(gB0 + ko2, lb2); SB_;
    acc[1][2] = mfma32(a10, b20, acc[1][2]);
    acc[1][3] = mfma32(a10, b30, acc[1][3]);
    acc[0][0] = mfma32(a01, b01, acc[0][0]);
    SB_; DMA1(gB1 + ko2, lb2 + 1024); SB_;
    acc[0][1] = mfma32(a01, b11, acc[0][1]);
    acc[0][2] = mfma32(a01, b21, acc[0][2]);
    acc[0][3] = mfma32(a01, b31, acc[0][3]);
    SB_; DMA1(gB2 + ko2, lb2 + 2048); SB_;
    acc[1][0] = mfma32(a11, b01, acc[1][0]);
    acc[1][1] = mfma32(a11, b11, acc[1][1]);
    acc[1][2] = mfma32(a11, b21, acc[1][2]);
    SB_; DMA1(gB3 + ko2, lb2 + 3072); SB_;
    acc[1][3] = mfma32(a11, b31, acc[1][3]);
  }
  asm volatile("s_waitcnt vmcnt(0)" ::: "memory");
  __builtin_amdgcn_s_barrier();
#undef ISSUE
#undef DMA1
#undef SB_
  if (wflag) {
    if (threadIdx.x == 0) {
      unsigned sp = 0;
      while (xb_ld(wflag) != epoch) { __builtin_amdgcn_s_sleep(1); if (++sp > (1u << 24)) break; }
      __builtin_amdgcn_fence(__ATOMIC_ACQUIRE, "agent");
      asm volatile("s_waitcnt vmcnt(0)" ::: "memory");
    }
    __syncthreads();
  }

  if (EPI == EPI_GATES) {
    const bf16_t* XC = (const bf16_t*)j.o1;
    float* AA = (float*)j.o0;
    float* BBp = AA + (size_t)T_ * 1024;
#pragma unroll
    for (int g = 0; g < 2; ++g) {
      const int ch = (n0 >> 8) * 128 + wn * 64 + g * 32 + r32;
      const float br = j.x0[ch], bi = j.x1[ch];
      const float spl = softplusf_(-j.x2[ch]);
#pragma unroll
      for (int mi = 0; mi < 2; ++mi)
#pragma unroll
        for (int r = 0; r < 16; ++r) {
          const int row = m0 + wm * 64 + mi * 32 + (r & 3) + 8 * (r >> 2) + 4 * hh;
          const float rg = sigmoidf_(acc[mi][2 * g][r] + br);
          const float ig = sigmoidf_(acc[mi][2 * g + 1][r] + bi);
          const float la = -8.f * rg * spl;
          const float xc = bf2f(XC[(size_t)row * 1024 + ch]);
          const bool reset = (row < TP_) && ((row & 2047) == 0);
          const float a = reset ? 0.f : __expf(la);
          const float mult = reset ? 1.f : sqrtf(fmaxf(-expm1f(2.f * la), 0.f));
          AA[(size_t)row * 1024 + ch] = a;
          BBp[(size_t)row * 1024 + ch] = mult * ig * xc;
        }
    }
  } else {
    const int lq = lane & 3;
#pragma unroll
    for (int mi = 0; mi < 2; ++mi)
#pragma unroll
      for (int ni = 0; ni < 4; ++ni)
#pragma unroll
        for (int g4 = 0; g4 < 4; ++g4) {
          float v[4] = {acc[mi][ni][4 * g4], acc[mi][ni][4 * g4 + 1], acc[mi][ni][4 * g4 + 2], acc[mi][ni][4 * g4 + 3]};
          quad_transpose4(v, lq);
          const int row = m0 + wm * 64 + mi * 32 + 8 * g4 + 4 * hh + lq;
          const int col = n0 + wn * 128 + ni * 32 + (r32 & ~3);
          epi4<EPI>(j, row, col, v);
        }
    if (EPI == EPI_SSM_XBC) {
      if (n0 + wn * 128 == 4096) {
        const float dtb = j.x0[r32];
#pragma unroll
        for (int mi = 0; mi < 2; ++mi)
#pragma unroll
          for (int r = 0; r < 16; ++r) {
            const int row = m0 + wm * 64 + mi * 32 + (r & 3) + 8 * (r >> 2) + 4 * hh;
            ((float*)j.o1)[(size_t)row * 32 + r32] = softplusf_(acc[mi][0][r] + dtb);
          }
      }
    }
  }
}

template <int EPI>
DI void gemm_tile_dma_h(const GJob& j, int m0, int n0, int nk, char* smem) {
  const int tid = TIDX, lane = tid & 63, w = tid >> 6;
  const int wm = w >> 1, wn = w & 1, r32 = lane & 31, hh = lane >> 5;
  f32x16 acc[4];
#pragma unroll
  for (int b = 0; b < 4; ++b)
#pragma unroll
    for (int r = 0; r < 16; ++r) acc[b][r] = 0.f;
  const int dr = lane >> 2;
  const int dc = (lane & 3) ^ ((lane >> 4) & 3);
  const int nlim = j.nvalid - 1;
  const size_t kofs = (size_t)dc * 8;
  const bf16_t* gA0 = j.A + (size_t)(m0 + 16 * w + dr) * j.lda + kofs;
  const bf16_t* gB0 = j.Bt + (size_t)min(n0 + 64 * w + dr, nlim) * j.ldb + kofs;
  const bf16_t* gB1 = j.Bt + (size_t)min(n0 + 64 * w + 16 + dr, nlim) * j.ldb + kofs;
  const bf16_t* gB2 = j.Bt + (size_t)min(n0 + 64 * w + 32 + dr, nlim) * j.ldb + kofs;
  const bf16_t* gB3 = j.Bt + (size_t)min(n0 + 64 * w + 48 + dr, nlim) * j.ldb + kofs;
  char* ldsA = smem + w * 1024 + lane * 16;
  char* ldsB = smem + 8192 + (4 * w) * 1024 + lane * 16;
  const unsigned lbase = (unsigned)(unsigned long long)(LAS char*)smem;
  const int fsw = (r32 >> 2) & 3;
  const unsigned pa = (unsigned)((wm * 32 + r32) * 64), pb = (unsigned)(8192 + (wn * 128 + r32) * 64);
  const unsigned po0 = (unsigned)(((hh) ^ fsw) * 16), po1 = (unsigned)(((2 + hh) ^ fsw) * 16);
#define DMA1(gp, lp) __builtin_amdgcn_global_load_lds((const unsigned*)(gp), (unsigned*)(lp), 16, 0, 0)
#define ISSUEH(kt, slot)                                                                         \
  {                                                                                              \
    const int ko_ = (kt) * 32;                                                                   \
    char* la_ = ldsA + (slot) * DSLOT; char* lb_ = ldsB + (slot) * DSLOT;                        \
    DMA1(gA0 + ko_, la_);                                                                        \
    DMA1(gB0 + ko_, lb_); DMA1(gB1 + ko_, lb_ + 1024); DMA1(gB2 + ko_, lb_ + 2048); DMA1(gB3 + ko_, lb_ + 3072); \
  }
  asm volatile("s_waitcnt vmcnt(0)" ::: "memory");
  const int last = nk - 1;
  ISSUEH(0, 0);
  { const int t1 = min(1, last); ISSUEH(t1, 1); }
  int sl_r = 0, sl_w = 2;
#pragma unroll 1
  for (int i = 0; i < nk; ++i) {
    asm volatile("s_waitcnt vmcnt(5)" ::: "memory");
    __builtin_amdgcn_s_barrier();
    { const int t2 = min(i + 2, last); ISSUEH(t2, sl_w); }
    const unsigned sl = lbase + (unsigned)(sl_r * DSLOT);
    sl_r = (sl_r == 2) ? 0 : sl_r + 1;
    sl_w = (sl_w == 2) ? 0 : sl_w + 1;
    bf16x8 a00, a01, b00, b10, b20, b30, b01, b11, b21, b31;
    const unsigned aA0 = sl + pa + po0, aB0 = sl + pb + po0, aA1 = sl + pa + po1, aB1 = sl + pb + po1;
    asm volatile("ds_read_b128 %0, %1" : "=v"(a00) : "v"(aA0));
    asm volatile("ds_read_b128 %0, %1" : "=v"(b00) : "v"(aB0));
    asm volatile("ds_read_b128 %0, %1 offset:2048" : "=v"(b10) : "v"(aB0));
    asm volatile("ds_read_b128 %0, %1 offset:4096" : "=v"(b20) : "v"(aB0));
    asm volatile("ds_read_b128 %0, %1 offset:6144" : "=v"(b30) : "v"(aB0));
    asm volatile("ds_read_b128 %0, %1" : "=v"(a01) : "v"(aA1));
    asm volatile("ds_read_b128 %0, %1" : "=v"(b01) : "v"(aB1));
    asm volatile("ds_read_b128 %0, %1 offset:2048" : "=v"(b11) : "v"(aB1));
    asm volatile("ds_read_b128 %0, %1 offset:4096" : "=v"(b21) : "v"(aB1));
    asm volatile("ds_read_b128 %0, %1 offset:6144" : "=v"(b31) : "v"(aB1));
    asm volatile("s_waitcnt lgkmcnt(0)" : "+v"(a00), "+v"(b00), "+v"(b10), "+v"(b20), "+v"(b30),
                 "+v"(a01), "+v"(b01), "+v"(b11), "+v"(b21), "+v"(b31) :: "memory");
    acc[0] = mfma32(a00, b00, acc[0]);
    acc[1] = mfma32(a00, b10, acc[1]);
    acc[2] = mfma32(a00, b20, acc[2]);
    acc[3] = mfma32(a00, b30, acc[3]);
    acc[0] = mfma32(a01, b01, acc[0]);
    acc[1] = mfma32(a01, b11, acc[1]);
    acc[2] = mfma32(a01, b21, acc[2]);
    acc[3] = mfma32(a01, b31, acc[3]);
  }
  asm volatile("s_waitcnt vmcnt(0)" ::: "memory");
  __builtin_amdgcn_s_barrier();
#undef ISSUEH
#undef DMA1
  const int lq = lane & 3;
#pragma unroll
  for (int ni = 0; ni < 4; ++ni)
#pragma unroll
    for (int g4 = 0; g4 < 4; ++g4) {
      float v[4] = {acc[ni][4 * g4], acc[ni][4 * g4 + 1], acc[ni][4 * g4 + 2], acc[ni][4 * g4 + 3]};
      quad_transpose4(v, lq);
      const int row = m0 + wm * 32 + 8 * g4 + 4 * hh + lq;
      const int col = n0 + wn * 128 + ni * 32 + (r32 & ~3);
      epi4<EPI>(j, row, col, v);
    }
  if (EPI == EPI_SSM_XBC) {
    if (n0 + wn * 128 == 4096) {
      const float dtb = j.x0[r32];
#pragma unroll
      for (int r = 0; r < 16; ++r) {
        const int row = m0 + wm * 32 + (r & 3) + 8 * (r >> 2) + 4 * hh;
        ((float*)j.o1)[(size_t)row * 32 + r32] = softplusf_(acc[0][r] + dtb);
      }
    }
  }
}

#define VBLOCK() ((int)(((volatile LAS unsigned*)&xb_words)[3]))
DI void tile_map(int L, int ntn, int& mt, int& nt) {
  const int gw = ((ntn & 7) == 0) ? 8 : (((ntn & 3) == 0) ? 4 : 0);
  if (gw) {
    const int gs = 8 * gw, grp = L / gs, loc = L - grp * gs, gpr = ntn / gw;
    const int gm = grp / gpr, gn = grp - gm * gpr;
    mt = gm * 8 + loc / gw; nt = gn * gw + (loc - (loc / gw) * gw);
  } else { mt = L / ntn; nt = L - mt * ntn; }
}

template <int EPI, bool MIX>
DI void gemm_run(const GJob& j, int ntn, int& toff, char* smem, int vb_) {
  const int G = gridDim.x;
  const int nk = j.K >> 6;
  if (MIX) {
    const int ntiles = MT_ * ntn;
    const int start = (int)((vb_ - (toff % G) + G) % G);
    for (int tile = start; tile < ntiles; tile += G) {
      int mt, nt; tile_map(tile, ntn, mt, nt);
      gemm_tile<EPI, MIX>(j, mt * 128, nt * 128, 0, nk, smem);
    }
    toff += ntiles;
  } else {
    const int nfull = 128 * ntn, nhalf = 16 * ntn, ntot = nfull + nhalf;
    const int start = (int)((vb_ - (toff % G) + G) % G);
    for (int item = start; item < ntot; item += G) {
      if (item < nfull) {
        int mt, nt; tile_map(item, ntn, mt, nt);
        gemm_tile_dma<EPI>(j, mt * 128, nt * 256, 0, nk * 2, smem);
      } else {
        const int h = item - nfull, hm = h / ntn, nt = h - hm * ntn;
        gemm_tile_dma_h<EPI>(j, TP_ + hm * 64, nt * 256, nk * 2, smem);
      }
    }
    toff += ntot;
  }
}

template <int EPI>
DI void gemm_streamk(const GJob& j, int ntn, char* smem, int vb_, unsigned* flags, unsigned epoch) {
  const int G = gridDim.x;
  const int nk = j.K >> 5;
  const int total = MT_ * ntn * nk;
  int per = (total + G - 1) / G;
  if (per < nk) per = nk;
  int s0 = vb_ * per;
  const int s1 = min(s0 + per, total);
  while (s0 < s1) {
    const int tile = s0 / nk, k0 = s0 - tile * nk;
    const int k1 = min(nk, k0 + (s1 - s0));
    int mt, nt; tile_map(tile, ntn, mt, nt);
    unsigned* wf = (k0 == 0 && k1 < nk) ? (flags + tile) : nullptr;
    gemm_tile_dma<EPI>(j, mt * 128, nt * 256, k0, k1, smem, wf, epoch);
    if (k0 > 0) {
      asm volatile("s_waitcnt vmcnt(0)" ::: "memory");
      __syncthreads();
      if (threadIdx.x == 0) {
        __builtin_amdgcn_fence(__ATOMIC_RELEASE, "agent");
        asm volatile("s_waitcnt vmcnt(0)" ::: "memory");
        __hip_atomic_store(flags + tile, epoch, __ATOMIC_RELAXED, __HIP_MEMORY_SCOPE_AGENT);
      }
    }
    s0 += k1 - k0;
  }
}

template <int EPI, int SPLIT, int NKC>
DI void gemm_splitk(const GJob& j, int ntn, char* smem, int vb_) {
  const int G = gridDim.x;
  const int nitems = MT_ * ntn * SPLIT;
  for (int it = vb_; it < nitems; it += G) {
    const int tile = it / SPLIT, sp = it - tile * SPLIT;
    int mt, nt; tile_map(tile, ntn, mt, nt);
    gemm_tile<EPI, false>(j, mt * 128, nt * 128, sp * NKC, sp * NKC + NKC, smem);
  }
}

DI GJob mkjob(const bf16_t* A, int lda, const bf16_t* Bt, int ldb, int K, int nvalid) {
  GJob j;
  j.A = A; j.A2 = nullptr; j.mu = nullptr; j.Bt = Bt; j.lda = lda; j.ldb = ldb; j.K = K; j.nvalid = nvalid;
  j.o0 = nullptr; j.o1 = nullptr; j.x0 = nullptr; j.x1 = nullptr; j.x2 = nullptr; j.ldo = 0; j.act = 0;
  return j;
}

struct TJob { const float* src; bf16_t* dst; int K, N, src_ld, kind, n_off; };

DI TJob get_tjob(const Params& p, int j) {
  bf16_t* wt = (bf16_t*)(p.ws + W_WT);
  TJob o; o.kind = 0; o.n_off = 0;
  if (j < 36) {
    const int ia = j / 18, r = j % 18;
    if (r == 0) { o.src = p.in[I_LRU_WIN] + (size_t)ia * 1024 * 2048; o.dst = wt + WA_IN + (size_t)ia * 2048 * 1024; o.K = 1024; o.N = 2048; o.src_ld = 2048; }
    else if (r == 1) { o.src = p.in[I_LRU_WOUT] + (size_t)ia * 1024 * 1024; o.dst = wt + WA_OUT + (size_t)ia * 1024 * 1024; o.K = 1024; o.N = 1024; o.src_ld = 1024; }
    else {
      const int isI = (r >= 10) ? 1 : 0; const int h = (r - 2) & 7;
      o.src = p.in[isI ? I_LRU_WI : I_LRU_WR] + ((size_t)ia * 8 + h) * 128 * 128;
      o.dst = wt + WA_G + (size_t)ia * 2048 * 128; o.K = 128; o.N = 128; o.src_ld = 128; o.kind = 1 + isI; o.n_off = h * 128;
    }
  } else if (j == 36) { o.src = p.in[I_SSM_WIN] + 2048; o.dst = wt + WB_XBC; o.K = 1024; o.N = 4128; o.src_ld = 6176; }
  else if (j == 37) { o.src = p.in[I_SSM_WIN]; o.dst = wt + WB_Z; o.K = 1024; o.N = 2048; o.src_ld = 6176; }
  else if (j == 38) { o.src = p.in[I_SSM_WOUT]; o.dst = wt + WB_OUT; o.K = 2048; o.N = 1024; o.src_ld = 1024; }
  else if (j < 42) { const int s = j - 39; o.src = p.in[I_RW_WRKV] + (size_t)s * 1024 * 1024; o.dst = wt + WC_RKV + (size_t)s * 1024 * 1024; o.K = 1024; o.N = 1024; o.src_ld = 1024; }
  else if (j == 42) { o.src = p.in[I_RW_WW1]; o.dst = wt + WC_L1; o.K = 1024; o.N = 64; o.src_ld = 64; }
  else if (j == 43) { o.src = p.in[I_RW_WA1]; o.dst = wt + WC_L1 + 64 * 1024; o.K = 1024; o.N = 64; o.src_ld = 64; }
  else if (j == 44) { o.src = p.in[I_RW_WG1]; o.dst = wt + WC_L1 + 128 * 1024; o.K = 1024; o.N = 128; o.src_ld = 128; }
  else if (j == 45) { o.src = p.in[I_RW_WW2]; o.dst = wt + WC_W2; o.K = 64; o.N = 1024; o.src_ld = 1024; }
  else if (j == 46) { o.src = p.in[I_RW_WA2]; o.dst = wt + WC_A2; o.K = 64; o.N = 1024; o.src_ld = 1024; }
  else if (j == 47) { o.src = p.in[I_RW_WG2]; o.dst = wt + WC_G2; o.K = 128; o.N = 1024; o.src_ld = 1024; }
  else if (j == 48) { o.src = p.in[I_RW_WOUT]; o.dst = wt + WC_OUT; o.K = 1024; o.N = 1024; o.src_ld = 1024; }
  else {
    const int l = (j - 49) >> 1, which = (j - 49) & 1;
    if (!which) { o.src = p.in[I_FFN_W1] + (size_t)l * 1024 * 4096; o.dst = wt + WF_1 + (size_t)l * 4096 * 1024; o.K = 1024; o.N = 4096; o.src_ld = 4096; }
    else { o.src = p.in[I_FFN_W2] + (size_t)l * 4096 * 1024; o.dst = wt + WF_2 + (size_t)l * 4096 * 1024; o.K = 4096; o.N = 1024; o.src_ld = 1024; }
  }
  return o;
}
constexpr int N_TJOBS = 57;

DI void ph_prologue(const Params& p, char* smem) {
  const int tid = TIDX, G = gridDim.x;
  {
    const float4* xp = (const float4*)p.in[I_XP];
    const float4* xs = (const float4*)p.in[I_XS];
    float4* X = (float4*)(p.ws + W_X);
    const size_t np = (size_t)TP_ * 256, nt = (size_t)T_ * 256;
    for (size_t i = (size_t)blockIdx.x * NTHR + tid; i < nt; i += (size_t)G * NTHR)
      X[i] = (i < np) ? xp[i] : xs[i - np];
  }
  float* tile = (float*)smem;
  int toff = 0;
  for (int jn = 0; jn < N_TJOBS; ++jn) {
    const TJob tj = get_tjob(p, jn);
    const int nkt = tj.K >> 6, nnt = (tj.N + 63) >> 6;
    const int ntiles = nkt * nnt;
    const int start = (((int)blockIdx.x - (toff % G)) + G) % G;
    for (int t = start; t < ntiles; t += G) {
      const int kt = t / nnt, nt = t - kt * nnt;
      const int k0 = kt * 64, n0 = nt * 64;
      __syncthreads();
      float tv[16];
      const bool nok = (n0 + (tid & 63)) < tj.N;
      const float* sp = tj.src + (size_t)(k0 + (tid >> 6)) * tj.src_ld + n0 + (tid & 63);
#pragma unroll
      for (int i = 0; i < 16; ++i) tv[i] = nok ? sp[(size_t)(i * 4) * tj.src_ld] : 0.f;
#pragma unroll
      for (int i = 0; i < 16; ++i) tile[(i * 4 + (tid >> 6)) * 65 + (tid & 63)] = tv[i];
      __syncthreads();
      const int n = tid >> 2, kq = tid & 3;
      if (n0 + n < tj.N) {
        int nrow = n0 + n;
        if (tj.kind) {
          const int ch = tj.n_off + n0 + n;
          nrow = (ch >> 6) * 128 + ((ch >> 5) & 1) * 64 + (tj.kind - 1) * 32 + (ch & 31);
        }
        float f[8], g[8];
#pragma unroll
        for (int e = 0; e < 8; ++e) { f[e] = tile[(kq * 16 + e) * 65 + n]; g[e] = tile[(kq * 16 + 8 + e) * 65 + n]; }
        uint4* d = (uint4*)(tj.dst + (size_t)nrow * tj.K + k0 + kq * 16);
        d[0] = pack8(f); d[1] = pack8(g);
      }
    }
    toff += ntiles;
  }
}

DI void ph_rmsnorm(const Params& p, int mode, const float* w) {
  const int tid_ = TIDX; const int lane = tid_ & 63;
  const int gw = blockIdx.x * 4 + (tid_ >> 6), nw = gridDim.x * 4;
  const float* X = (const float*)(p.ws + W_X);
  bf16_t* U = (bf16_t*)(p.ws + W_U);
  bf16_t* UP = (bf16_t*)(p.ws + SC_UP);
  float4 wv[4];
#pragma unroll
  for (int i = 0; i < 4; ++i) wv[i] = ((const float4*)w)[lane + 64 * i];
  for (int row = gw; row < T_; row += nw) {
    const float4* xr = (const float4*)(X + (size_t)row * 1024);
    float4 v[4]; float ss = 0.f;
#pragma unroll
    for (int i = 0; i < 4; ++i) { v[i] = xr[lane + 64 * i]; ss += v[i].x * v[i].x + v[i].y * v[i].y + v[i].z * v[i].z + v[i].w * v[i].w; }
    ss = wave_sum(ss);
    const float rstd = rsqrtf(ss * (1.f / 1024.f) + 1e-6f);
    int seq, l, L; tok_info(row, seq, l, L);
#pragma unroll
    for (int i = 0; i < 4; ++i) {
      const int c = 4 * (lane + 64 * i);
      float4 y = make_float4(v[i].x * rstd * wv[i].x, v[i].y * rstd * wv[i].y, v[i].z * rstd * wv[i].z, v[i].w * rstd * wv[i].w);
      if (mode == 2) {
        *(float4*)(p.out + O_Y + (size_t)row * 1024 + c) = y;
      } else {
        uint2 pk = make_uint2(pack2(y.x, y.y), pack2(y.z, y.w));
        *(uint2*)(U + (size_t)row * 1024 + c) = pk;
        if (mode == 1) {
          if (l + 1 < L) *(uint2*)(UP + (size_t)(row + 1) * 1024 + c) = pk;
          if (l == 0) {
            uint2 pz = make_uint2(0, 0);
            if (seq >= 8) { float4 s = *(const float4*)(p.in[I_ST_RS] + (size_t)(seq - 8) * 1024 + c); pz = make_uint2(pack2(s.x, s.y), pack2(s.z, s.w)); }
            *(uint2*)(UP + (size_t)row * 1024 + c) = pz;
          }
          if (l == L - 1) {
            float* o = (seq < 8) ? (p.out + O_RS_P + (size_t)seq * 1024 + c) : (p.out + O_RS_S + (size_t)(seq - 8) * 1024 + c);
            *(float4*)o = y;
          }
        }
      }
    }
  }
}

template <int C, bool SILU>
DI void ph_conv(const bf16_t* __restrict__ src, bf16_t* __restrict__ dst, const float* __restrict__ cw,
                const float* __restrict__ cb, const float* __restrict__ state,
                float* __restrict__ out_p, float* __restrict__ out_s) {
  constexpr int GR = C / 8;
  const size_t total = (size_t)T_ * GR;
#pragma unroll 2
  for (size_t idx = (size_t)blockIdx.x * NTHR + TIDX; idx < total; idx += (size_t)gridDim.x * NTHR) {
    const int t = (int)(idx / GR), c = (int)(idx % GR) * 8;
    int seq, l, L; tok_info(t, seq, l, L);
    float acc[8]; load8f(cb + c, acc);
    float xcur[8];
#pragma unroll
    for (int jj = 0; jj < 4; ++jj) {
      const int ls = l - 3 + jj;
      float xv[8];
      if (ls >= 0) { unpack8(*(const uint4*)(src + (size_t)(t - 3 + jj) * C + c), xv); }
      else if (seq >= 8) { load8f(state + ((size_t)(seq - 8) * 3 + (ls + 3)) * C + c, xv); }
      else {
#pragma unroll
        for (int e = 0; e < 8; ++e) xv[e] = 0.f;
      }
      float w8[8]; load8f(cw + (size_t)jj * C + c, w8);
#pragma unroll
      for (int e = 0; e < 8; ++e) acc[e] += w8[e] * xv[e];
      if (jj == 3) {
#pragma unroll
        for (int e = 0; e < 8; ++e) xcur[e] = xv[e];
      }
    }
    if (SILU) {
#pragma unroll
      for (int e = 0; e < 8; ++e) acc[e] = siluf_(acc[e]);
    }
    *(uint4*)(dst + (size_t)t * C + c) = pack8(acc);
    if (l >= L - 3) {
      const int r = l - (L - 3);
      float* o = (seq < 8) ? (out_p + ((size_t)seq * 3 + r) * C + c) : (out_s + ((size_t)(seq - 8) * 3 + r) * C + c);
      store8f(o, xcur);
    }
  }
}

DI void ph_lru_scan1(const Params& p) {
  const float* AA = (const float*)(p.ws + SA_AA);
  const float* BB = (const float*)(p.ws + SA_BB);
  float* CP = (float*)(p.ws + SA_CP);
  float* CS = (float*)(p.ws + SA_CS);
  const int total = 8 * 64 * 1024;
  for (int idx = blockIdx.x * NTHR + TIDX; idx < total; idx += gridDim.x * NTHR) {
    const int ch = idx & 1023, c = (idx >> 10) & 63, b = idx >> 16;
    const size_t base = ((size_t)b * 2048 + c * 32) * 1024 + ch;
    float P = 1.f, S = 0.f;
    float av[32], bv[32];
#pragma unroll
    for (int s = 0; s < 32; ++s) { av[s] = AA[base + (size_t)s * 1024]; bv[s] = BB[base + (size_t)s * 1024]; }
#pragma unroll
    for (int s = 0; s < 32; ++s) { S = av[s] * S + bv[s]; P *= av[s]; }
    CP[idx] = P; CS[idx] = S;
  }
}
DI void ph_lru_scan2(const Params& p, int ia) {
  const float* AA = (const float*)(p.ws + SA_AA);
  const float* BB = (const float*)(p.ws + SA_BB);
  const float* CP = (const float*)(p.ws + SA_CP);
  const float* CS = (const float*)(p.ws + SA_CS);
  bf16_t* GT = (bf16_t*)(p.ws + SA_GT);
  const int nP = 8 * 64 * 1024, total = nP + 128 * 1024;
  for (int idx = blockIdx.x * NTHR + TIDX; idx < total; idx += gridDim.x * NTHR) {
    if (idx < nP) {
      const int ch = idx & 1023, c = (idx >> 10) & 63, b = idx >> 16;
      const size_t base = ((size_t)b * 2048 + c * 32) * 1024 + ch;
      float av[32], bv[32]; bf16_t gv[32];
#pragma unroll
      for (int s = 0; s < 32; ++s) { const size_t o = base + (size_t)s * 1024; av[s] = AA[o]; bv[s] = BB[o]; gv[s] = GT[o]; }
      float h = 0.f;
#pragma unroll 8
      for (int c2 = 0; c2 < c; ++c2) {
        const int ci = ((b * 64 + c2) << 10) + ch;
        h = CP[ci] * h + CS[ci];
      }
#pragma unroll
      for (int s = 0; s < 32; ++s) {
        const size_t o = base + (size_t)s * 1024;
        h = av[s] * h + bv[s];
        GT[o] = f2bf(h * bf2f(gv[s]));
      }
      if (c == 63) p.out[O_LH_P + ((size_t)ia * 8 + b) * 1024 + ch] = h;
    } else {
      const int u = idx - nP; const int ch = u & 1023, s = u >> 10;
      float h = p.in[I_ST_LH][((size_t)ia * 128 + s) * 1024 + ch];
      const size_t base = ((size_t)TP_ + s * 8) * 1024 + ch;
#pragma unroll
      for (int q = 0; q < 8; ++q) {
        const size_t o = base + (size_t)q * 1024;
        h = AA[o] * h + BB[o];
        GT[o] = f2bf(h * bf2f(GT[o]));
      }
      p.out[O_LH_S + ((size_t)ia * 128 + s) * 1024 + ch] = h;
    }
  }
}

DI void ssd_item(const Params& p, char* smem, int seq, int h) {
  const int tid = TIDX, lane = tid & 63, w = tid >> 6, r32 = lane & 31, hh = lane >> 5;
  bf16_t* Cs = (bf16_t*)smem;
  bf16_t* Bs = Cs + 64 * 136;
  bf16_t* Sb = Bs + 64 * 136;
  bf16_t* Xt = Sb + 64 * 136;
  bf16_t* Btr = Xt + 64 * 72;
  float* dts = (float*)(Btr + 128 * 72);
  float* acs = dts + 64;
  bf16_t* Ws = Bs;
  const bf16_t* XBC = (const bf16_t*)(p.ws + SB_XBC);
  const float* DT = (const float*)(p.ws + SB_DT);
  bf16_t* Y = (bf16_t*)(p.ws + SB_Y);
  const bool prompt = seq < 8;
  const int nchunk = prompt ? 32 : 1, Lv = prompt ? 64 : 8;
  const int tbase = prompt ? seq * 2048 : TP_ + (seq - 8) * 8;
  const int g = h >> 2;
  const float Ah = -__expf(p.in[I_SSM_ALOG][h]);
  const float Dh = p.in[I_SSM_D][h];
  f32x16 accS[2];
  {
    const float* s0 = p.in[I_ST_SS] + ((size_t)(seq - 8) * 32 + h) * 64 * 128;
#pragma unroll
    for (int mi = 0; mi < 2; ++mi)
#pragma unroll
      for (int r = 0; r < 16; ++r) {
        const int prow = mi * 32 + (r & 3) + 8 * (r >> 2) + 4 * hh, n = 32 * w + r32;
        accS[mi][r] = prompt ? 0.f : s0[(size_t)prow * 128 + n];
      }
  }
  __syncthreads();
#pragma unroll
  for (int mi = 0; mi < 2; ++mi)
#pragma unroll
    for (int r = 0; r < 16; ++r) {
      const int prow = mi * 32 + (r & 3) + 8 * (r >> 2) + 4 * hh, n = 32 * w + r32;
      Sb[prow * 136 + n] = f2bf(accS[mi][r]);
    }
  uint4 pc0, pc1, pc2, pc3, pb0, pb1, pb2, pb3, px0, px1;
  float pdt = 0.f;
  const uint4 z4 = make_uint4(0, 0, 0, 0);
  pc0 = pc1 = pc2 = pc3 = pb0 = pb1 = pb2 = pb3 = px0 = px1 = z4;
#define SSD_LD_CB(i, t0_)                                                                  \
  { const int id_ = tid + 256 * i, row_ = id_ >> 4, ch_ = id_ & 15;                        \
    pc##i = z4; pb##i = z4;                                                                \
    if (row_ < Lv) { const bf16_t* src_ = XBC + (size_t)((t0_) + row_) * 4096 + g * 128 + ch_ * 8; \
      pb##i = *(const uint4*)(src_ + 2048); pc##i = *(const uint4*)(src_ + 3072); } }
#define SSD_LD_X(i, t0_)                                                                   \
  { const int id_ = tid + 256 * i, row_ = id_ >> 3, ch_ = id_ & 7;                         \
    px##i = z4;                                                                            \
    if (row_ < Lv) px##i = *(const uint4*)(XBC + (size_t)((t0_) + row_) * 4096 + h * 64 + ch_ * 8); }
#define SSD_ISSUE(t0_)                                                                     \
  { SSD_LD_CB(0, t0_) SSD_LD_CB(1, t0_) SSD_LD_CB(2, t0_) SSD_LD_CB(3, t0_) SSD_LD_X(0, t0_) SSD_LD_X(1, t0_) \
    pdt = (tid < Lv && tid < 64) ? DT[(size_t)((t0_) + tid) * 32 + h] : 0.f; }
#define SSD_ST_CB(i)                                                                       \
  { const int id_ = tid + 256 * i, row_ = id_ >> 4, ch_ = id_ & 15;                        \
    *(uint4*)(Cs + row_ * 136 + ch_ * 8) = pc##i;                                          \
    *(uint4*)(Bs + row_ * 136 + ch_ * 8) = pb##i;                                          \
    float f_[8]; unpack8(pb##i, f_);                                                       \
    const float sc_ = __expf(aend - acs[row_]);                                            \
    _Pragma("unroll") for (int e = 0; e < 8; ++e) Btr[(ch_ * 8 + e) * 72 + row_] = f2bf(f_[e] * sc_); }
#define SSD_ST_X(i)                                                                        \
  { const int id_ = tid + 256 * i, row_ = id_ >> 3, ch_ = id_ & 7;                         \
    float f_[8]; unpack8(px##i, f_);                                                       \
    const float sc_ = dts[row_];                                                           \
    _Pragma("unroll") for (int e = 0; e < 8; ++e) Xt[(ch_ * 8 + e) * 72 + row_] = f2bf(f_[e] * sc_); }
  SSD_ISSUE(tbase);
  for (int c = 0; c < nchunk; ++c) {
    const int t0 = tbase + c * 64;
    __syncthreads();
    if (tid < 64) {
      const float dtv = pdt;
      float x = dtv * Ah;
#pragma unroll
      for (int o = 1; o < 64; o <<= 1) { const float y = __shfl_up(x, o, 64); if (lane >= o) x += y; }
      dts[tid] = dtv; acs[tid] = x;
    }
    __syncthreads();
    const float aend = acs[63];
    SSD_ST_CB(0) SSD_ST_CB(1) SSD_ST_CB(2) SSD_ST_CB(3) SSD_ST_X(0) SSD_ST_X(1)
    if (c + 1 < nchunk) { SSD_ISSUE(t0 + 64); }
    __syncthreads();
    const int it = w >> 1, jt = w & 1;
    f32x16 cb;
#pragma unroll
    for (int r = 0; r < 16; ++r) cb[r] = 0.f;
    if (jt <= it) {
#pragma unroll
      for (int ks = 0; ks < 8; ++ks) {
        bf16x8 a = *(const bf16x8*)(Cs + (it * 32 + r32) * 136 + ks * 16 + hh * 8);
        bf16x8 b = *(const bf16x8*)(Bs + (jt * 32 + r32) * 136 + ks * 16 + hh * 8);
        cb = mfma32(a, b, cb);
      }
    }
    __syncthreads();
    {
      const int jj = jt * 32 + r32; const float aj = acs[jj];
#pragma unroll
      for (int r = 0; r < 16; ++r) {
        const int ii = it * 32 + (r & 3) + 8 * (r >> 2) + 4 * hh;
        const float v = (jj <= ii) ? cb[r] * __expf(acs[ii] - aj) : 0.f;
        Ws[ii * 72 + jj] = f2bf(v);
      }
    }
    __syncthreads();
    {
      const int pt = w & 1;
      f32x16 yd, yo;
#pragma unroll
      for (int r = 0; r < 16; ++r) { yd[r] = 0.f; yo[r] = 0.f; }
#pragma unroll
      for (int ks = 0; ks < 4; ++ks) {
        bf16x8 a = *(const bf16x8*)(Ws + (it * 32 + r32) * 72 + ks * 16 + hh * 8);
        bf16x8 b = *(const bf16x8*)(Xt + (pt * 32 + r32) * 72 + ks * 16 + hh * 8);
        yd = mfma32(a, b, yd);
      }
#pragma unroll
      for (int ks = 0; ks < 8; ++ks) {
        bf16x8 a = *(const bf16x8*)(Cs + (it * 32 + r32) * 136 + ks * 16 + hh * 8);
        bf16x8 b = *(const bf16x8*)(Sb + (pt * 32 + r32) * 136 + ks * 16 + hh * 8);
        yo = mfma32(a, b, yo);
      }
      const int pp = pt * 32 + r32;
#pragma unroll
      for (int r = 0; r < 16; ++r) {
        const int ii = it * 32 + (r & 3) + 8 * (r >> 2) + 4 * hh;
        if (ii < Lv) {
          const size_t t = (size_t)(t0 + ii);
          const float xv = bf2f(XBC[t * 4096 + h * 64 + pp]);
          const float yv = yd[r] + __expf(acs[ii]) * yo[r] + Dh * xv;
          Y[t * 2048 + h * 64 + pp] = f2bf(yv);
        }
      }
    }
    {
      const float dec = __expf(aend);
#pragma unroll
      for (int mi = 0; mi < 2; ++mi)
#pragma unroll
        for (int r = 0; r < 16; ++r) accS[mi][r] *= dec;
#pragma unroll
      for (int ks = 0; ks < 4; ++ks) {
        bf16x8 b = *(const bf16x8*)(Btr + (32 * w + r32) * 72 + ks * 16 + hh * 8);
        bf16x8 a0 = *(const bf16x8*)(Xt + (r32) * 72 + ks * 16 + hh * 8);
        bf16x8 a1 = *(const bf16x8*)(Xt + (32 + r32) * 72 + ks * 16 + hh * 8);
        accS[0] = mfma32(a0, b, accS[0]);
        accS[1] = mfma32(a1, b, accS[1]);
      }
    }
    __syncthreads();
#pragma unroll
    for (int mi = 0; mi < 2; ++mi)
#pragma unroll
      for (int r = 0; r < 16; ++r) {
        const int prow = mi * 32 + (r & 3) + 8 * (r >> 2) + 4 * hh, n = 32 * w + r32;
        Sb[prow * 136 + n] = f2bf(accS[mi][r]);
      }
  }
  float* dst = prompt ? (p.out + O_SS_P + ((size_t)seq * 32 + h) * 64 * 128)
                      : (p.out + O_SS_S + ((size_t)(seq - 8) * 32 + h) * 64 * 128);
#pragma unroll
  for (int mi = 0; mi < 2; ++mi)
#pragma unroll
    for (int r = 0; r < 16; ++r) {
      const int prow = mi * 32 + (r & 3) + 8 * (r >> 2) + 4 * hh, n = 32 * w + r32;
      dst[(size_t)prow * 128 + n] = accS[mi][r];
    }
}

#undef SSD_LD_CB
#undef SSD_LD_X
#undef SSD_ISSUE
#undef SSD_ST_CB
#undef SSD_ST_X
DI void ph_ssd(const Params& p, char* smem) {
  const int G = gridDim.x, bid = blockIdx.x;
  int it = bid, step = G;
  if (G >= 512) { if (bid < 256) { step = 1 << 30; } else { step = G - 256; } }
#pragma nounroll
  for (; it < 256 + 4096; it += step) {
    const int seq = (it < 256) ? (it >> 5) : (8 + ((it - 256) >> 5));
    ssd_item(p, smem, seq, it & 31);
  }
}

DI void ph_gnorm(const Params& p) {
  const int tid_ = TIDX; const int lane = tid_ & 63;
  const int gw = blockIdx.x * 4 + (tid_ >> 6), nw = gridDim.x * 4;
  bf16_t* Y = (bf16_t*)(p.ws + SB_Y);
  const float* nwt = p.in[I_SSM_NW];
  for (int item = gw; item < T_ * 8; item += 2 * nw) {
    const int item2 = item + nw; const bool v2 = item2 < T_ * 8;
    bf16_t* yp1 = Y + (size_t)(item >> 3) * 2048 + (item & 7) * 256 + lane * 4;
    bf16_t* yp2 = Y + (size_t)((v2 ? item2 : item) >> 3) * 2048 + ((v2 ? item2 : item) & 7) * 256 + lane * 4;
    const uint2 a = *(const uint2*)yp1; const uint2 b = *(const uint2*)yp2;
    float f[4], g[4]; unpack4(a, f); unpack4(b, g);
    const float ss1 = wave_sum(f[0] * f[0] + f[1] * f[1] + f[2] * f[2] + f[3] * f[3]);
    const float ss2 = wave_sum(g[0] * g[0] + g[1] * g[1] + g[2] * g[2] + g[3] * g[3]);
    const float r1 = rsqrtf(ss1 * (1.f / 256.f) + 1e-5f), r2 = rsqrtf(ss2 * (1.f / 256.f) + 1e-5f);
    const float4 w1 = *(const float4*)(nwt + (item & 7) * 256 + lane * 4);
    const float4 w2 = *(const float4*)(nwt + ((v2 ? item2 : item) & 7) * 256 + lane * 4);
    *(uint2*)yp1 = make_uint2(pack2(f[0] * r1 * w1.x, f[1] * r1 * w1.y), pack2(f[2] * r1 * w1.z, f[3] * r1 * w1.w));
    if (v2) *(uint2*)yp2 = make_uint2(pack2(g[0] * r2 * w2.x, g[1] * r2 * w2.y), pack2(g[2] * r2 * w2.z, g[3] * r2 * w2.w));
  }
}

template <int LPR>
DI void wkv_item(const Params& p, char* smem, int seq, int head, int part) {
  constexpr int ROWS = 256 / LPR, KPL = 64 / LPR, NV4 = KPL / 4;
  const int tid = TIDX;
  float* sR = (float*)smem;
  float* sK = sR + 2048;
  float* sKK = sK + 2048;
  float* sBB = sKK + 2048;
  float* sW = sBB + 2048;
  float* sV = sW + 2048;
  float* sO = sV + 2048;
  const bf16_t* __restrict__ R = (const bf16_t*)(p.ws + SC_R);
  const bf16_t* __restrict__ K = (const bf16_t*)(p.ws + SC_K);
  const bf16_t* __restrict__ V = (const bf16_t*)(p.ws + SC_V);
  const bf16_t* __restrict__ AAc = (const bf16_t*)(p.ws + SC_AA);
  const float* __restrict__ WD = (const float*)(p.ws + SC_WD);
  bf16_t* O = (bf16_t*)(p.ws + SC_O);
  const bool prompt = seq < 8;
  const int nch = prompt ? 64 : 1, nvalid = prompt ? 32 : 8;
  const int tbase = prompt ? seq * 2048 : TP_ + (seq - 8) * 8;
  const int row_l = tid / LPR, q = tid % LPR, row = part * ROWS + row_l;
  float S[KPL];
  {
    const float* s0 = p.in[I_ST_RW] + (((size_t)(seq - 8) * 16 + head) * 64 + row) * 64 + q * KPL;
#pragma unroll
    for (int e = 0; e < KPL; ++e) S[e] = prompt ? 0.f : s0[e];
  }
  const int pst = tid >> 3, pk0 = (tid & 7) * 8, pcol = head * 64 + pk0;
  const bool pact = pst < nvalid;
  float kk8[8], ka8[8];
  load8f(p.in[I_RW_KK] + pcol, kk8);
  load8f(p.in[I_RW_KA] + pcol, ka8);
  uint4 qr = make_uint4(0, 0, 0, 0), qk = qr, qv = qr, qa = qr;
  float4 qw0 = make_float4(0.f, 0.f, 0.f, 0.f), qw1 = qw0;
#define WKV_ISSUE(c_)                                                       \
  if (pact) {                                                               \
    const size_t o_ = (size_t)(tbase + (c_) * 32 + pst) * 1024 + pcol;      \
    qr = *(const uint4*)(R + o_); qk = *(const uint4*)(K + o_);             \
    qv = *(const uint4*)(V + o_); qa = *(const uint4*)(AAc + o_);           \
    qw0 = *(const float4*)(WD + o_); qw1 = *(const float4*)(WD + o_ + 4);   \
  }
  WKV_ISSUE(0);
  for (int c = 0; c < nch; ++c) {
    const int t0 = tbase + c * 32;
    __syncthreads();
    if (pact) {
      float r8[8], k8[8], v8[8], a8[8];
      unpack8(qr, r8); unpack8(qk, k8); unpack8(qv, v8); unpack8(qa, a8);
      const float w8[8] = {qw0.x, qw0.y, qw0.z, qw0.w, qw1.x, qw1.y, qw1.z, qw1.w};
      float kr[8], ss = 0.f;
#pragma unroll
      for (int e = 0; e < 8; ++e) { kr[e] = k8[e] * kk8[e]; ss += kr[e] * kr[e]; }
      ss = red_lanes<8>(ss);
      const float inv = 1.f / fmaxf(sqrtf(ss), 1e-12f);
      float kp[8], bb[8];
#pragma unroll
      for (int e = 0; e < 8; ++e) { kr[e] *= inv; kp[e] = k8[e] * (1.f + (a8[e] - 1.f) * ka8[e]); bb[e] = kr[e] * a8[e]; }
      const int lo = pst * 64 + pk0;
      store8f(sR + lo, r8); store8f(sK + lo, kp); store8f(sKK + lo, kr); store8f(sBB + lo, bb);
      store8f(sW + lo, w8); store8f(sV + lo, v8);
    }
    __syncthreads();
    if (c + 1 < nch) { WKV_ISSUE(c + 1); }
#define WKV_LOADV(P, st_)                                                                      \
    {                                                                                          \
      const int lo_ = (st_) * 64 + q * KPL;                                                    \
      _Pragma("unroll") for (int e = 0; e < NV4; ++e) {                                        \
        P##kk[e] = *(const float4*)(sKK + lo_ + 4 * e); P##ww[e] = *(const float4*)(sW + lo_ + 4 * e); \
        P##bb[e] = *(const float4*)(sBB + lo_ + 4 * e); P##kp[e] = *(const float4*)(sK + lo_ + 4 * e); \
        P##rr[e] = *(const float4*)(sR + lo_ + 4 * e);                                         \
      }                                                                                        \
      P##vv = sV[(st_) * 64 + row];                                                            \
    }
#define WKV_STEP(P, st_)                                                                       \
    {                                                                                          \
      float sa0 = 0.f, sa1 = 0.f;                                                              \
      _Pragma("unroll") for (int e = 0; e < NV4; ++e) {                                        \
        sa0 += S[4 * e] * P##kk[e].x + S[4 * e + 2] * P##kk[e].z;                              \
        sa1 += S[4 * e + 1] * P##kk[e].y + S[4 * e + 3] * P##kk[e].w;                          \
      }                                                                                        \
      const float sa = red_lanes<LPR>(sa0 + sa1);                                              \
      float o0 = 0.f, o1 = 0.f;                                                                \
      _Pragma("unroll") for (int e = 0; e < NV4; ++e) {                                        \
        S[4 * e] = S[4 * e] * P##ww[e].x - sa * P##bb[e].x + P##vv * P##kp[e].x;               \
        S[4 * e + 1] = S[4 * e + 1] * P##ww[e].y - sa * P##bb[e].y + P##vv * P##kp[e].y;       \
        S[4 * e + 2] = S[4 * e + 2] * P##ww[e].z - sa * P##bb[e].z + P##vv * P##kp[e].z;       \
        S[4 * e + 3] = S[4 * e + 3] * P##ww[e].w - sa * P##bb[e].w + P##vv * P##kp[e].w;       \
        o0 += S[4 * e] * P##rr[e].x + S[4 * e + 2] * P##rr[e].z;                               \
        o1 += S[4 * e + 1] * P##rr[e].y + S[4 * e + 3] * P##rr[e].w;                           \
      }                                                                                        \
      const float oo = red_lanes<LPR>(o0 + o1);                                                \
      if (q == 0) sO[(st_) * ROWS + row_l] = oo;                                               \
    }
    {
      float4 Akk[NV4], Aww[NV4], Abb[NV4], Akp[NV4], Arr[NV4]; float Avv;
      float4 Bkk[NV4], Bww[NV4], Bbb[NV4], Bkp[NV4], Brr[NV4]; float Bvv;
      if (LPR <= 4) {
#pragma unroll 1
        for (int st = 0; st < nvalid; ++st) { WKV_LOADV(A, st); WKV_STEP(A, st); }
      } else {
        WKV_LOADV(A, 0);
#pragma unroll 1
        for (int st = 0; st < nvalid; st += 2) {
          WKV_LOADV(B, st + 1);
          WKV_STEP(A, st);
          if (st + 2 < nvalid) { WKV_LOADV(A, st + 2); }
          WKV_STEP(B, st + 1);
        }
      }
    }
    __syncthreads();
    for (int i = tid; i < nvalid * ROWS; i += NTHR) {
      const int st = i / ROWS, rr = i % ROWS;
      O[(size_t)(t0 + st) * 1024 + head * 64 + part * ROWS + rr] = f2bf(sO[i]);
    }
  }
#undef WKV_ISSUE
#undef WKV_LOADV
#undef WKV_STEP
  float* dst = prompt ? (p.out + O_RW_P + (((size_t)seq * 16 + head) * 64 + row) * 64 + q * KPL)
                      : (p.out + O_RW_S + (((size_t)(seq - 8) * 16 + head) * 64 + row) * 64 + q * KPL);
#pragma unroll
  for (int e = 0; e < KPL; ++e) dst[e] = S[e];
}

template <int LPRP>
DI void ph_wkv(const Params& p, char* smem) {
  constexpr int NPART = 64 / (256 / LPRP);
  const int G = gridDim.x, bid = blockIdx.x;
  const int nP = 128 * NPART;
#pragma nounroll
  for (int it = bid; it < nP; it += G) {
    const int part = it % NPART, sh = it / NPART;
    wkv_item<LPRP>(p, smem, sh >> 4, sh & 15, part);
  }
  const int nS = 2048;
  int first, step;
  if (G > nP) { first = (bid >= nP) ? (bid - nP) : nS; step = G - nP; }
  else { first = bid; step = G; }
#pragma nounroll
  for (int it = first; it < nS; it += step) wkv_item<4>(p, smem, 8 + (it >> 4), it & 15, 0);
}

DI void ph_wkv_post(const Params& p) {
  const int tid_ = TIDX; const int lane = tid_ & 63;
  const int gw = blockIdx.x * 4 + (tid_ >> 6), nw = gridDim.x * 4;
  const bf16_t* __restrict__ R = (const bf16_t*)(p.ws + SC_R);
  const bf16_t* __restrict__ K = (const bf16_t*)(p.ws + SC_K);
  const bf16_t* __restrict__ V = (const bf16_t*)(p.ws + SC_V);
  const bf16_t* __restrict__ AAc = (const bf16_t*)(p.ws + SC_AA);
  const bf16_t* __restrict__ Gg = (const bf16_t*)(p.ws + SC_G);
  const bf16_t* __restrict__ O = (const bf16_t*)(p.ws + SC_O);
  bf16_t* __restrict__ U = (bf16_t*)(p.ws + W_U);
#pragma unroll 2
  for (int item = gw; item < T_ * 4; item += nw) {
    const int t = item >> 2, col = (item & 3) * 256 + lane * 4;
    const size_t o = (size_t)t * 1024 + col;
    float ov[4], rv[4], kv[4], av[4], vv[4], gv[4];
    unpack4(*(const uint2*)(O + o), ov); unpack4(*(const uint2*)(R + o), rv); unpack4(*(const uint2*)(K + o), kv);
    unpack4(*(const uint2*)(AAc + o), av); unpack4(*(const uint2*)(V + o), vv); unpack4(*(const uint2*)(Gg + o), gv);
    const float4 lw = *(const float4*)(p.in[I_RW_LNW] + col), lb = *(const float4*)(p.in[I_RW_LNB] + col);
    const float4 ka = *(const float4*)(p.in[I_RW_KA] + col), rk = *(const float4*)(p.in[I_RW_RK] + col);
    const float lwv[4] = {lw.x, lw.y, lw.z, lw.w}, lbv[4] = {lb.x, lb.y, lb.z, lb.w};
    const float kav[4] = {ka.x, ka.y, ka.z, ka.w}, rkv[4] = {rk.x, rk.y, rk.z, rk.w};
    const float mean = red_lanes<16>(ov[0] + ov[1] + ov[2] + ov[3]) * (1.f / 64.f);
    float d[4], s2 = 0.f, s3 = 0.f;
#pragma unroll
    for (int e = 0; e < 4; ++e) {
      d[e] = ov[e] - mean; s2 += d[e] * d[e];
      const float kp = kv[e] * (1.f + (av[e] - 1.f) * kav[e]);
      s3 += rv[e] * kp * rkv[e];
    }
    s2 = red_lanes<16>(s2); s3 = red_lanes<16>(s3);
    const float rs = rsqrtf(s2 * (1.f / 64.f) + 64e-5f);
    float y[4];
#pragma unroll
    for (int e = 0; e < 4; ++e) y[e] = (d[e] * rs * lwv[e] + lbv[e] + s3 * vv[e]) * gv[e];
    *(uint2*)(U + o) = make_uint2(pack2(y[0], y[1]), pack2(y[2], y[3]));
  }
}

constexpr int NPH = 40;
#ifndef REP_GEMM
#define REP_GEMM 1
#endif
#ifndef REP_SSD
#define REP_SSD 1
#endif
#ifndef REP_WKV
#define REP_WKV 1
#endif
#ifndef REP_MISC
#define REP_MISC 1
#endif

__global__ void __launch_bounds__(NTHR, 2) mega(Params p) {
  __shared__ __attribute__((aligned(16))) char smem[SMEM_BYTES];
  __shared__ uint4 xb_words;
  cg::grid_group grid = cg::this_grid();
  if (threadIdx.x == 0) xb_words = make_uint4(0u, 0u, 0u, 0u);
  __syncthreads();
  XcdBarrier xb = xcd_barrier_post((unsigned*)(p.ws + W_BAR), (volatile LAS unsigned*)&xb_words);
  int ph = 0;
#define PH(...)                                                     \
  {                                                                 \
    if (ph >= p.ph_begin && ph < p.ph_end) {                        \
      __VA_ARGS__;                                                  \
      xcd_barrier(xb);                                              \
    }                                                               \
    ++ph;                                                           \
  }
#define PHR(rep, ...)                                               \
  {                                                                 \
    if (ph >= p.ph_begin && ph < p.ph_end) {                        \
      for (int rep_ = 0; rep_ < (rep); ++rep_) {                    \
        __VA_ARGS__;                                                \
        xcd_barrier(xb);                                            \
      }                                                             \
    }                                                               \
    ++ph;                                                           \
  }
#define PH_LAST(...)                                                \
  {                                                                 \
    if (ph >= p.ph_begin && ph < p.ph_end) { __VA_ARGS__; }         \
    ++ph;                                                           \
  }
  bf16_t* wt = (bf16_t*)(p.ws + W_WT);
  bf16_t* U = (bf16_t*)(p.ws + W_U);
  float* X = (float*)(p.ws + W_X);

  {
    if (ph >= p.ph_begin && ph < p.ph_end) { ph_prologue(p, smem); grid.sync(); }
    ++ph;
    if (threadIdx.x == 0) {
      unsigned* bar = (unsigned*)(p.ws + W_BAR);
      unsigned base = 0;
      for (unsigned jx = 0; jx < 16; ++jx) { const unsigned c = xb_ld(&bar[XB_XCNT(jx)]); base += (jx < xb.x) ? c : 0u; }
      volatile LAS unsigned* st = (volatile LAS unsigned*)&xb_words;
      st[3] = base + st[2];
    }
    __syncthreads();
  }

#pragma nounroll
  for (int layer = 0; layer < 4; ++layer) {
    const int kind = layer % 3;
    PHR(REP_MISC, ph_rmsnorm(p, kind == 2 ? 1 : 0, p.in[I_NMIX] + layer * 1024));
    if (kind == 0) {
      const int ia = layer / 3;
      PHR(REP_GEMM, {
        GJob j = mkjob(U, 1024, wt + WA_IN + (size_t)ia * 2048 * 1024, 1024, 1024, 2048);
        j.o0 = p.ws + SA_XB; j.o1 = p.ws + SA_GT;
        int toff = 0; gemm_run<EPI_LRU_IN, false>(j, 8, toff, smem, VBLOCK());
      });
      PHR(REP_MISC, (ph_conv<1024, false>((const bf16_t*)(p.ws + SA_XB), (bf16_t*)(p.ws + SA_XC),
                               p.in[I_LRU_CW] + (size_t)ia * 4 * 1024, p.in[I_LRU_CB] + (size_t)ia * 1024,
                               p.in[I_ST_LC] + (size_t)ia * 128 * 3 * 1024,
                               p.out + O_LC_P + (size_t)ia * 8 * 3 * 1024, p.out + O_LC_S + (size_t)ia * 128 * 3 * 1024)));
      PHR(REP_GEMM, {
        const int G = gridDim.x;
        for (int tile = VBLOCK(); tile < MT_ * 8; tile += G) {
          const int mt = tile >> 3, jt = tile & 7;
          GJob j = mkjob((const bf16_t*)(p.ws + SA_XC) + jt * 128, 1024,
                         wt + WA_G + (size_t)ia * 2048 * 128, 128, 128, 2048);
          j.o0 = p.ws + SA_AA; j.o1 = p.ws + SA_XC;
          j.x0 = p.in[I_LRU_BR] + ia * 1024; j.x1 = p.in[I_LRU_BI] + ia * 1024; j.x2 = p.in[I_LRU_LAM] + ia * 1024;
          gemm_tile_dma<EPI_GATES>(j, mt * 128, jt * 256, 0, 4, smem);
        }
      });
      PHR(REP_MISC, ph_lru_scan1(p));
      PH(ph_lru_scan2(p, ia));
      PH({
        GJob j = mkjob((const bf16_t*)(p.ws + SA_GT), 1024, wt + WA_OUT + (size_t)ia * 1024 * 1024, 1024, 1024, 1024);
        j.o0 = X;
        int toff = 0; gemm_run<EPI_RESID, false>(j, 4, toff, smem, VBLOCK());
      });
    } else if (kind == 1) {
      PHR(REP_GEMM, {
        GJob j = mkjob(U, 1024, wt + WB_XBC, 1024, 1024, 4128);
        j.o0 = p.ws + SB_XBCP; j.o1 = p.ws + SB_DT; j.x0 = p.in[I_SSM_DTB];
        int toff = 0; gemm_run<EPI_SSM_XBC, false>(j, 17, toff, smem, VBLOCK());
      });
      PHR(REP_MISC, (ph_conv<4096, true>((const bf16_t*)(p.ws + SB_XBCP), (bf16_t*)(p.ws + SB_XBC),
                              p.in[I_SSM_CW], p.in[I_SSM_CB], p.in[I_ST_SC],
                              p.out + O_SC_P, p.out + O_SC_S)));
      PHR(REP_SSD, ph_ssd(p, smem));
      PH({
        GJob j = mkjob(U, 1024, wt + WB_Z, 1024, 1024, 2048);
        j.o0 = p.ws + SB_Y;
        int toff = 0; gemm_run<EPI_SSM_Z, false>(j, 8, toff, smem, VBLOCK());
      });
      PH(ph_gnorm(p));
      PH({
        GJob j = mkjob((const bf16_t*)(p.ws + SB_Y), 2048, wt + WB_OUT, 2048, 2048, 1024);
        j.o0 = X;
        gemm_streamk<EPI_RESID>(j, 4, smem, VBLOCK(), (unsigned*)(p.ws + W_BAR) + 4096, (unsigned)(layer * 2 + 1));
      });
    } else {
      PHR(REP_GEMM, {
        int toff = 0;
        for (int s = 0; s < 3; ++s) {
          GJob j = mkjob(U, 1024, wt + WC_RKV + (size_t)s * 1024 * 1024, 1024, 1024, 1024);
          j.A2 = (const bf16_t*)(p.ws + SC_UP); j.mu = p.in[I_RW_MU] + s * 1024;
          j.o0 = p.ws + SC_R + (size_t)s * SZ_TD2; j.ldo = 1024; j.act = 0;
          gemm_run<EPI_ST, true>(j, 8, toff, smem, VBLOCK());
        }
        for (int s = 0; s < 3; ++s) {
          const int nv = (s == 2) ? 128 : 64;
          GJob j = mkjob(U, 1024, wt + WC_L1 + (size_t)s * 64 * 1024, 1024, 1024, nv);
          j.A2 = (const bf16_t*)(p.ws + SC_UP); j.mu = p.in[I_RW_MU] + (3 + s) * 1024;
          j.o0 = p.ws + SC_LH + (size_t)s * 64 * 2; j.ldo = 256; j.act = (s == 0) ? 1 : (s == 2 ? 2 : 0);
          gemm_run<EPI_ST, true>(j, 1, toff, smem, VBLOCK());
        }
      });
      PHR(REP_GEMM, {
        int toff = 0;
        const bf16_t* LH = (const bf16_t*)(p.ws + SC_LH);
        {
          GJob j = mkjob(LH, 256, wt + WC_W2, 64, 64, 1024);
          j.o0 = p.ws + SC_WD; j.x0 = p.in[I_RW_W0];
          gemm_run<EPI_DECAY, false>(j, 4, toff, smem, VBLOCK());
        }
        {
          GJob j = mkjob(LH + 64, 256, wt + WC_A2, 64, 64, 1024);
          j.o0 = p.ws + SC_AA; j.x0 = p.in[I_RW_A0];
          gemm_run<EPI_SIGB, false>(j, 4, toff, smem, VBLOCK());
        }
        {
          GJob j = mkjob(LH + 128, 256, wt + WC_G2, 128, 128, 1024);
          j.o0 = p.ws + SC_G; j.ldo = 1024; j.act = 0;
          gemm_run<EPI_ST, false>(j, 4, toff, smem, VBLOCK());
        }
      });
      PHR(REP_WKV, ph_wkv<8>(p, smem));
      PHR(REP_MISC, ph_wkv_post(p));
      PH({
        GJob j = mkjob(U, 1024, wt + WC_OUT, 1024, 1024, 1024);
        j.o0 = X;
        int toff = 0; gemm_run<EPI_RESID, false>(j, 4, toff, smem, VBLOCK());
      });
    }
    PHR(REP_MISC, ph_rmsnorm(p, 0, p.in[I_NFFN] + layer * 1024));
    PHR(REP_GEMM, {
      GJob j = mkjob(U, 1024, wt + WF_1 + (size_t)layer * 4096 * 1024, 1024, 1024, 4096);
      j.o0 = p.ws + S_HB;
      int toff = 0; gemm_run<EPI_FFN1, false>(j, 16, toff, smem, VBLOCK());
    });
    PH({
      GJob j = mkjob((const bf16_t*)(p.ws + S_HB), 4096, wt + WF_2 + (size_t)layer * 4096 * 1024, 4096, 4096, 1024);
      j.o0 = X;
      gemm_streamk<EPI_RESID>(j, 4, smem, VBLOCK(), (unsigned*)(p.ws + W_BAR) + 4096, (unsigned)(layer * 2 + 2));
    });
  }
  PH_LAST(ph_rmsnorm(p, 2, p.in[I_NFIN]));
#undef PH
#undef PH_LAST
}

extern "C" void kernel_launch(void* const* d_in, const int* in_sizes, int n_in, void* d_out, int out_size,
                              void* d_ws, size_t ws_size, hipStream_t stream) {
  Params p;
  memset(&p, 0, sizeof(p));
  for (int i = 0; i < N_IN; ++i) p.in[i] = (const float*)d_in[i];
  p.out = (float*)d_out;
  p.ws = (char*)d_ws;
  p.ph_begin = 0;
  p.ph_end = 1000;
  static int grid_blocks = 0;
  if (!grid_blocks) {
    int dev = 0, cus = 0, per_cu = 0;
    hipGetDevice(&dev);
    hipDeviceGetAttribute(&cus, hipDeviceAttributeMultiprocessorCount, dev);
    hipOccupancyMaxActiveBlocksPerMultiprocessor(&per_cu, mega, NTHR, 0);
    if (per_cu > 2) per_cu = 2;
    if (per_cu < 1) per_cu = 1;
    grid_blocks = cus * per_cu;
  }
  if (ws_size < (size_t)536870912) fprintf(stderr, "workspace too small: %zu\n", ws_size);
  (void)hipMemsetAsync((char*)d_ws + W_BAR, 0, (4096 + 1024) * 4, stream);
  void* args[] = {&p};
  hipError_t e = hipLaunchCooperativeKernel((void*)mega, dim3(grid_blocks), dim3(NTHR), args, 0, stream);
  if (e != hipSuccess) fprintf(stderr, "cooperative launch failed: %s (grid %d)\n", hipGetErrorString(e), grid_blocks);
}
```

```cpp
#include <hip/hip_runtime.h>
#include <hip/hip_cooperative_groups.h>
#include <stdint.h>
#include <stdio.h>
#include <string.h>
namespace cg = cooperative_groups;

typedef unsigned short bf16_t;
typedef __attribute__((ext_vector_type(8))) short bf16x8;
typedef __attribute__((ext_vector_type(16))) float f32x16;

#define DI __device__ __forceinline__

constexpr int T_ = 17408;
constexpr int TP_ = 16384;
constexpr int NTHR = 256;
constexpr int MT_ = T_ / 128;

enum {
  I_XP = 0, I_XS, I_ST_LC, I_ST_LH, I_ST_SC, I_ST_SS, I_ST_RS, I_ST_RW,
  I_NMIX, I_NFFN, I_NFIN,
  I_LRU_WIN, I_LRU_CW, I_LRU_CB, I_LRU_WR, I_LRU_BR, I_LRU_WI, I_LRU_BI, I_LRU_LAM, I_LRU_WOUT,
  I_SSM_WIN, I_SSM_CW, I_SSM_CB, I_SSM_DTB, I_SSM_ALOG, I_SSM_D, I_SSM_NW, I_SSM_WOUT,
  I_RW_MU, I_RW_WRKV, I_RW_W0, I_RW_WW1, I_RW_WW2, I_RW_A0, I_RW_WA1, I_RW_WA2, I_RW_WG1, I_RW_WG2,
  I_RW_KK, I_RW_KA, I_RW_RK, I_RW_LNW, I_RW_LNB, I_RW_WOUT,
  I_FFN_W1, I_FFN_W2, N_IN
};

constexpr size_t O_Y = 0;
constexpr size_t O_LC_P = O_Y + (size_t)T_ * 1024;
constexpr size_t O_LC_S = O_LC_P + 2 * 8 * 3 * 1024;
constexpr size_t O_LH_P = O_LC_S + 2 * 128 * 3 * 1024;
constexpr size_t O_LH_S = O_LH_P + 2 * 8 * 1024;
constexpr size_t O_SC_P = O_LH_S + 2 * 128 * 1024;
constexpr size_t O_SC_S = O_SC_P + 8 * 3 * 4096;
constexpr size_t O_SS_P = O_SC_S + 128 * 3 * 4096;
constexpr size_t O_SS_S = O_SS_P + (size_t)8 * 32 * 64 * 128;
constexpr size_t O_RS_P = O_SS_S + (size_t)128 * 32 * 64 * 128;
constexpr size_t O_RS_S = O_RS_P + 8 * 1024;
constexpr size_t O_RW_P = O_RS_S + 128 * 1024;
constexpr size_t O_RW_S = O_RW_P + 8 * 16 * 64 * 64;

constexpr size_t W_X = 0;
constexpr size_t W_U = W_X + (size_t)T_ * 1024 * 4;
constexpr size_t W_WT = W_U + (size_t)T_ * 1024 * 2;
constexpr size_t WA_IN = 0;
constexpr size_t WA_G = WA_IN + 2 * 2048 * 1024;
constexpr size_t WA_OUT = WA_G + 2 * 2048 * 128;
constexpr size_t WB_XBC = WA_OUT + 2 * 1024 * 1024;
constexpr size_t WB_Z = WB_XBC + 4128 * 1024;
constexpr size_t WB_OUT = WB_Z + 2048 * 1024;
constexpr size_t WC_RKV = WB_OUT + 1024 * 2048;
constexpr size_t WC_L1 = WC_RKV + 3 * 1024 * 1024;
constexpr size_t WC_W2 = WC_L1 + 256 * 1024;
constexpr size_t WC_A2 = WC_W2 + 1024 * 64;
constexpr size_t WC_G2 = WC_A2 + 1024 * 64;
constexpr size_t WC_OUT = WC_G2 + 1024 * 128;
constexpr size_t WF_1 = WC_OUT + 1024 * 1024;
constexpr size_t WF_2 = WF_1 + (size_t)4 * 4096 * 1024;
constexpr size_t W_WT_ELEMS = WF_2 + (size_t)4 * 4096 * 1024;
constexpr size_t W_S = W_WT + W_WT_ELEMS * 2;
constexpr size_t SZ_TD2 = (size_t)T_ * 1024 * 2;
constexpr size_t SZ_TD4 = (size_t)T_ * 1024 * 4;
constexpr size_t S_HB = W_S;
constexpr size_t SA_XB = W_S;
constexpr size_t SA_GT = SA_XB + SZ_TD2;
constexpr size_t SA_XC = SA_GT + SZ_TD2;
constexpr size_t SA_AA = SA_XC + SZ_TD2;
constexpr size_t SA_BB = SA_AA + SZ_TD4;
constexpr size_t SA_CP = SA_BB + SZ_TD4;
constexpr size_t SA_CS = SA_CP + 8 * 64 * 1024 * 4;
constexpr size_t SB_XBCP = W_S;
constexpr size_t SB_Y = W_S;
constexpr size_t SB_XBC = SB_XBCP + SZ_TD2 * 4;
constexpr size_t SB_DT = SB_XBC + SZ_TD2 * 4;
constexpr size_t SC_UP = W_S;
constexpr size_t SC_O = W_S;
constexpr size_t SC_R = SC_UP + SZ_TD2;
constexpr size_t SC_K = SC_R + SZ_TD2;
constexpr size_t SC_V = SC_K + SZ_TD2;
constexpr size_t SC_LH = SC_V + SZ_TD2;
constexpr size_t SC_WD = SC_LH + (size_t)T_ * 256 * 2;
constexpr size_t SC_AA = SC_WD + SZ_TD4;
constexpr size_t SC_G = SC_AA + SZ_TD2;
constexpr size_t SC_END = SC_G + SZ_TD2;
static_assert(SC_END <= (size_t)536870912, "ws overflow C");
static_assert(SB_DT + (size_t)T_ * 32 * 4 <= (size_t)536870912, "ws overflow B");
static_assert(SA_CS + 8 * 64 * 1024 * 4 <= (size_t)536870912, "ws overflow A");

constexpr int SMEM_BYTES = 80384;
constexpr size_t W_BAR = (size_t)536870912 - 65536;

struct Params {
  const float* in[N_IN];
  float* out;
  char* ws;
  int ph_begin, ph_end;
};

DI float bf2f(bf16_t h) { return __uint_as_float(((unsigned)h) << 16); }
DI bf16_t f2bf(float f) {
  unsigned u = __float_as_uint(f);
  u += 0x7FFFu + ((u >> 16) & 1u);
  return (bf16_t)(u >> 16);
}
DI unsigned pack2(float a, float b) { return (unsigned)f2bf(a) | ((unsigned)f2bf(b) << 16); }
DI void unpack8(const uint4 v, float (&f)[8]) {
  f[0] = __uint_as_float(v.x << 16); f[1] = __uint_as_float(v.x & 0xFFFF0000u);
  f[2] = __uint_as_float(v.y << 16); f[3] = __uint_as_float(v.y & 0xFFFF0000u);
  f[4] = __uint_as_float(v.z << 16); f[5] = __uint_as_float(v.z & 0xFFFF0000u);
  f[6] = __uint_as_float(v.w << 16); f[7] = __uint_as_float(v.w & 0xFFFF0000u);
}
DI void unpack4(const uint2 v, float (&f)[4]) {
  f[0] = __uint_as_float(v.x << 16); f[1] = __uint_as_float(v.x & 0xFFFF0000u);
  f[2] = __uint_as_float(v.y << 16); f[3] = __uint_as_float(v.y & 0xFFFF0000u);
}
DI uint4 pack8(const float (&f)[8]) {
  return make_uint4(pack2(f[0], f[1]), pack2(f[2], f[3]), pack2(f[4], f[5]), pack2(f[6], f[7]));
}
DI void load8f(const float* p, float (&f)[8]) {
  float4 a = *(const float4*)p, b = *(const float4*)(p + 4);
  f[0] = a.x; f[1] = a.y; f[2] = a.z; f[3] = a.w; f[4] = b.x; f[5] = b.y; f[6] = b.z; f[7] = b.w;
}
DI void store8f(float* p, const float (&f)[8]) {
  *(float4*)p = make_float4(f[0], f[1], f[2], f[3]);
  *(float4*)(p + 4) = make_float4(f[4], f[5], f[6], f[7]);
}
DI float sigmoidf_(float x) { return 1.f / (1.f + __expf(-x)); }
DI float siluf_(float x) { return x / (1.f + __expf(-x)); }
DI float tanhf_(float y) { return 1.f - 2.f / (1.f + __expf(2.f * y)); }
DI float geluf_(float x) { return 0.5f * x * (1.f + tanhf_(0.7978845608028654f * (x + 0.044715f * x * x * x))); }
DI float softplusf_(float x) { return fmaxf(x, 0.f) + log1pf(__expf(-fabsf(x))); }
DI float softplus_fast(float x) { return fmaxf(x, 0.f) + __logf(1.f + __expf(-fabsf(x))); }
DI float wave_sum(float v) {
#pragma unroll
  for (int o = 32; o >= 1; o >>= 1) v += __shfl_xor(v, o, 64);
  return v;
}
template <int CTRL> DI float dppf(float x) {
  return __int_as_float(__builtin_amdgcn_update_dpp(0, __float_as_int(x), CTRL, 0xf, 0xf, false));
}
template <int N> DI float red_lanes(float x) {
  x += dppf<0xB1>(x);
  x += dppf<0x4E>(x);
  if (N >= 8) x += dppf<0x141>(x);
  if (N >= 16) x += dppf<0x140>(x);
  return x;
}
DI void tok_info(int t, int& seq, int& l, int& L) {
  if (t < TP_) { seq = t >> 11; l = t & 2047; L = 2048; }
  else { int u = t - TP_; seq = 8 + (u >> 3); l = u & 7; L = 8; }
}
DI int opq(int x) { asm volatile("" : "+v"(x)); return x; }
#define TIDX opq((int)threadIdx.x)
DI f32x16 mfma32(bf16x8 a, bf16x8 b, f32x16 c) { return __builtin_amdgcn_mfma_f32_32x32x16_bf16(a, b, c, 0, 0, 0); }


#define XB_TMO      128
#define XB_XCNT(j)  (256  + 64 * (j))
#define XB_XSUB(j)  (1280 + 64 * (j))
#define XB_XGEN(j)  (2304 + 64 * (j))
#define XB_TOP      3328
#define XB_TOPGEN   3392
#define XCD_BAR_WORDS 3456
#define XB_SPIN_CAP (1u << 22)
#define LAS __attribute__((address_space(3)))
DI unsigned xb_ld(unsigned* p) { return __hip_atomic_load(p, __ATOMIC_RELAXED, __HIP_MEMORY_SCOPE_AGENT); }
DI unsigned xb_add(unsigned* p, unsigned v) { return __hip_atomic_fetch_add(p, v, __ATOMIC_RELAXED, __HIP_MEMORY_SCOPE_AGENT); }
DI unsigned xb_xcc_id() { return (unsigned)__builtin_amdgcn_s_getreg((3 << 11) | 20) & 0xFu; }
#define XB_SPIN(cond, bar) do { unsigned _sp = 0; while (cond) { __builtin_amdgcn_s_sleep(1); \
    if ((++_sp & 255u) == 0u) { if (xb_ld(&(bar)[XB_TMO])) break; if (_sp > XB_SPIN_CAP) { atomicAdd(&(bar)[XB_TMO], 1u); break; } } } } while (0)
struct XcdBarrier { unsigned* bar; unsigned x; volatile LAS unsigned* st; };
DI XcdBarrier xcd_barrier_post(unsigned* bar, volatile LAS unsigned* st) {
  XcdBarrier b; b.bar = bar; b.x = xb_xcc_id(); b.st = st;
  if (threadIdx.x == 0) st[2] = xb_add(&bar[XB_XCNT(b.x)], 1u);
  return b;
}
DI void xcd_barrier_complete(unsigned* bar, unsigned x, unsigned& nloc, unsigned& nx) {
  const unsigned G = gridDim.x * gridDim.y * gridDim.z;
  unsigned sum, cnt, mine, sp = 0u;
  for (;;) {
    sum = 0u; cnt = 0u; mine = 0u;
#pragma unroll
    for (unsigned j = 0; j < 16; ++j) { const unsigned c = xb_ld(&bar[XB_XCNT(j)]); sum += c; cnt += (c > 0u) ? 1u : 0u; mine = (j == x) ? c : mine; }
    if (sum == G) break;
    __builtin_amdgcn_s_sleep(1);
    if ((++sp & 255u) == 0u) { if (xb_ld(&bar[XB_TMO])) break; if (sp > XB_SPIN_CAP) { atomicAdd(&bar[XB_TMO], 1u); break; } }
  }
  nloc = mine > 0u ? mine : 1u; nx = cnt > 0u ? cnt : 1u;
}
DI void xcd_barrier(const XcdBarrier& b) {
  asm volatile("s_waitcnt vmcnt(0)" ::: "memory");
  __syncthreads();
  if (threadIdx.x == 0) {
    unsigned* bar = b.bar;
    __builtin_amdgcn_s_waitcnt(0);
    unsigned nloc = b.st[0], nx = b.st[1];
    if (nloc == 0u) { xcd_barrier_complete(bar, b.x, nloc, nx); b.st[0] = nloc; b.st[1] = nx; }
    const unsigned old = xb_add(&bar[XB_XSUB(b.x)], 1u);
    const unsigned gen = old / nloc;
    if (old + 1u == (gen + 1u) * nloc) {
      __builtin_amdgcn_fence(__ATOMIC_RELEASE, "agent");
      asm volatile("s_waitcnt vmcnt(0)" ::: "memory");
      const unsigned og = xb_add(&bar[XB_TOP], 1u);
      const unsigned tg = og / nx;
      if (og + 1u == (tg + 1u) * nx) xb_add(&bar[XB_TOPGEN], 1u);
      else XB_SPIN(xb_ld(&bar[XB_TOPGEN]) == tg, bar);
      __builtin_amdgcn_fence(__ATOMIC_ACQUIRE, "agent");
      xb_add(&bar[XB_XGEN(b.x)], 1u);
      asm volatile("s_waitcnt vmcnt(0)" ::: "memory");
    } else {
      XB_SPIN(xb_ld(&bar[XB_XGEN(b.x)]) == gen, bar);
      __builtin_amdgcn_fence(__ATOMIC_ACQUIRE, "agent");
      asm volatile("s_waitcnt vmcnt(0)" ::: "memory");
    }
  }
  __syncthreads();
}

struct GJob {
  const bf16_t* A; const bf16_t* A2; const float* mu; const bf16_t* Bt;
  int lda, ldb, K, nvalid;
  void* o0; void* o1; const float* x0; const float* x1; const float* x2;
  int ldo, act;
};
enum { EPI_LRU_IN = 0, EPI_GATES, EPI_RESID, EPI_SSM_XBC, EPI_SSM_Z, EPI_FFN1, EPI_ST, EPI_DECAY, EPI_SIGB };

template <int EPI> DI void epi_elem(const GJob& j, int row, int col, float v) {
  if (EPI == EPI_LRU_IN) {
    if (col < 1024) ((bf16_t*)j.o0)[(size_t)row * 1024 + col] = f2bf(v);
    else ((bf16_t*)j.o1)[(size_t)row * 1024 + col - 1024] = f2bf(geluf_(v));
  } else if (EPI == EPI_RESID) {
    unsafeAtomicAdd((float*)j.o0 + (size_t)row * 1024 + col, v);
  } else if (EPI == EPI_SSM_XBC) {
    if (col < 4096) ((bf16_t*)j.o0)[(size_t)row * 4096 + col] = f2bf(v);
  } else if (EPI == EPI_SSM_Z) {
    bf16_t* y = (bf16_t*)j.o0 + (size_t)row * 2048 + col;
    *y = f2bf(bf2f(*y) * siluf_(v));
  } else if (EPI == EPI_FFN1) {
    float r = fmaxf(v, 0.f);
    ((bf16_t*)j.o0)[(size_t)row * 4096 + col] = f2bf(r * r);
  } else if (EPI == EPI_ST) {
    if (col < j.nvalid) {
      float r = v;
      if (j.act == 1) r = tanhf_(v); else if (j.act == 2) r = sigmoidf_(v);
      ((bf16_t*)j.o0)[(size_t)row * j.ldo + col] = f2bf(r);
    }
  } else if (EPI == EPI_DECAY) {
    float wl = -softplusf_(-(j.x0[col] + v)) - 0.5f;
    ((float*)j.o0)[(size_t)row * 1024 + col] = __expf(-__expf(wl));
  } else if (EPI == EPI_SIGB) {
    ((bf16_t*)j.o0)[(size_t)row * 1024 + col] = f2bf(sigmoidf_(j.x0[col] + v));
  }
}

DI void quad_transpose4(float (&v)[4], int l) {
  const bool o1 = l & 1, o2 = l & 2;
  {
    const float s01 = o1 ? v[0] : v[1], s23 = o1 ? v[2] : v[3];
    const float r01 = dppf<0xB1>(s01), r23 = dppf<0xB1>(s23);
    if (o1) { v[0] = r01; v[2] = r23; } else { v[1] = r01; v[3] = r23; }
  }
  {
    const float s02 = o2 ? v[0] : v[2], s13 = o2 ? v[1] : v[3];
    const float r02 = dppf<0x4E>(s02), r13 = dppf<0x4E>(s13);
    if (o2) { v[0] = r02; v[1] = r13; } else { v[2] = r02; v[3] = r13; }
  }
}
DI uint2 pack4(float a, float b, float c, float d) { return make_uint2(pack2(a, b), pack2(c, d)); }
template <int EPI> DI void epi4(const GJob& j, int row, int col, const float (&v)[4]) {
  if (EPI == EPI_LRU_IN) {
    if (col < 1024) *(uint2*)((bf16_t*)j.o0 + (size_t)row * 1024 + col) = pack4(v[0], v[1], v[2], v[3]);
    else *(uint2*)((bf16_t*)j.o1 + (size_t)row * 1024 + col - 1024) = pack4(geluf_(v[0]), geluf_(v[1]), geluf_(v[2]), geluf_(v[3]));
  } else if (EPI == EPI_RESID) {
    float4* x = (float4*)((float*)j.o0 + (size_t)row * 1024 + col);
    float4 t = *x; t.x += v[0]; t.y += v[1]; t.z += v[2]; t.w += v[3]; *x = t;
  } else if (EPI == EPI_SSM_XBC) {
    if (col < 4096) *(uint2*)((bf16_t*)j.o0 + (size_t)row * 4096 + col) = pack4(v[0], v[1], v[2], v[3]);
  } else if (EPI == EPI_SSM_Z) {
    uint2* y = (uint2*)((bf16_t*)j.o0 + (size_t)row * 2048 + col);
    float f[4]; unpack4(*y, f);
    *y = pack4(f[0] * siluf_(v[0]), f[1] * siluf_(v[1]), f[2] * siluf_(v[2]), f[3] * siluf_(v[3]));
  } else if (EPI == EPI_FFN1) {
    const float r0 = fmaxf(v[0], 0.f), r1 = fmaxf(v[1], 0.f), r2 = fmaxf(v[2], 0.f), r3 = fmaxf(v[3], 0.f);
    *(uint2*)((bf16_t*)j.o0 + (size_t)row * 4096 + col) = pack4(r0 * r0, r1 * r1, r2 * r2, r3 * r3);
  } else if (EPI == EPI_ST) {
    if (col < j.nvalid) {
      float r[4];
#pragma unroll
      for (int e = 0; e < 4; ++e) r[e] = (j.act == 1) ? tanhf_(v[e]) : ((j.act == 2) ? sigmoidf_(v[e]) : v[e]);
      *(uint2*)((bf16_t*)j.o0 + (size_t)row * j.ldo + col) = pack4(r[0], r[1], r[2], r[3]);
    }
  } else if (EPI == EPI_DECAY) {
    const float4 w0 = *(const float4*)(j.x0 + col);
    const float w[4] = {w0.x, w0.y, w0.z, w0.w};
    float r[4];
#pragma unroll
    for (int e = 0; e < 4; ++e) r[e] = __expf(-__expf(-softplus_fast(-(w[e] + v[e])) - 0.5f));
    *(float4*)((float*)j.o0 + (size_t)row * 1024 + col) = make_float4(r[0], r[1], r[2], r[3]);
  } else if (EPI == EPI_SIGB) {
    const float4 a0 = *(const float4*)(j.x0 + col);
    *(uint2*)((bf16_t*)j.o0 + (size_t)row * 1024 + col) =
        pack4(sigmoidf_(a0.x + v[0]), sigmoidf_(a0.y + v[1]), sigmoidf_(a0.z + v[2]), sigmoidf_(a0.w + v[3]));
  }
}

template <int EPI, bool MIX>
DI void gemm_tile(const GJob& j, int m0, int n0, int kt0, int kt1, char* smem) {
  const int tid = TIDX, lane = tid & 63, w = tid >> 6;
  const int wm = w >> 1, wn = w & 1, r32 = lane & 31, hh = lane >> 5;
  const int lrow = tid >> 3, kc = tid & 7;
  f32x16 acc[2][2];
#pragma unroll
  for (int a = 0; a < 2; ++a)
#pragma unroll
    for (int b = 0; b < 2; ++b)
#pragma unroll
      for (int r = 0; r < 16; ++r) acc[a][b][r] = 0.f;
  uint4 qa00, qa01, qa02, qa03, qb00, qb01, qb02, qb03, qc00, qc01, qc02, qc03;
  uint4 qa10, qa11, qa12, qa13, qb10, qb11, qb12, qb13, qc10, qc11, qc12, qc13;
  qc00 = qc01 = qc02 = qc03 = qc10 = qc11 = qc12 = qc13 = make_uint4(0, 0, 0, 0);
  const int nk = kt1 - kt0;
  const bf16_t* Ap = j.A + (size_t)(m0 + lrow) * j.lda + kc * 8 + (size_t)kt0 * 64;
  const bf16_t* A2p = MIX ? (j.A2 + (size_t)(m0 + lrow) * j.lda + kc * 8 + (size_t)kt0 * 64) : nullptr;
  const bf16_t* Bp = j.Bt + (size_t)(n0 + lrow) * j.ldb + kc * 8 + (size_t)kt0 * 64;
  const size_t astep = (size_t)32 * j.lda, bstep = (size_t)32 * j.ldb;
  const bool bv0 = (n0 + lrow) < j.nvalid, bv1 = (n0 + lrow + 32) < j.nvalid;
  const bool bv2 = (n0 + lrow + 64) < j.nvalid, bv3 = (n0 + lrow + 96) < j.nvalid;
  const uint4 z4 = make_uint4(0, 0, 0, 0);

#define LD1(s, i, kt)                                                                 \
  qa##s##i = *(const uint4*)(Ap + i * astep + (kt) * 64);                             \
  if (MIX) qc##s##i = *(const uint4*)(A2p + i * astep + (kt) * 64);                   \
  qb##s##i = z4;                                                                      \
  if (bv##i) qb##s##i = *(const uint4*)(Bp + i * bstep + (kt) * 64);
#define GLOAD(s, kt) { LD1(s, 0, kt) LD1(s, 1, kt) LD1(s, 2, kt) LD1(s, 3, kt) }
#define ST1(s, i, As_, Bs_)                                                           \
  if (MIX) {                                                                          \
    float f1[8], f2[8]; unpack8(qa##s##i, f1); unpack8(qc##s##i, f2);                 \
    _Pragma("unroll") for (int e = 0; e < 8; ++e) f1[e] = f1[e] + (f2[e] - f1[e]) * mu8[e]; \
    qa##s##i = pack8(f1);                                                             \
  }                                                                                   \
  *(uint4*)(As_ + (lrow + 32 * i) * 144 + kc * 16) = qa##s##i;                        \
  *(uint4*)(Bs_ + (lrow + 32 * i) * 144 + kc * 16) = qb##s##i;
#define SSTORE(s, kt, buf)                                                            \
  {                                                                                   \
    char* As_ = smem + (buf) * 36864; char* Bs_ = As_ + 18432;                        \
    float mu8[8];                                                                     \
    if (MIX) load8f(j.mu + (kt0 + (kt)) * 64 + kc * 8, mu8);                          \
    ST1(s, 0, As_, Bs_) ST1(s, 1, As_, Bs_) ST1(s, 2, As_, Bs_) ST1(s, 3, As_, Bs_)   \
  }
#define LOADF(F, ks)                                                                  \
  bf16x8 F##a0 = *(const bf16x8*)(ap + (ks) * 32);                                    \
  bf16x8 F##a1 = *(const bf16x8*)(ap + 32 * 144 + (ks) * 32);                         \
  bf16x8 F##b0 = *(const bf16x8*)(bp + (ks) * 32);                                    \
  bf16x8 F##b1 = *(const bf16x8*)(bp + 32 * 144 + (ks) * 32);
#define MFMA4(F)                                                                      \
  acc[0][0] = mfma32(F##a0, F##b0, acc[0][0]);                                        \
  acc[0][1] = mfma32(F##a0, F##b1, acc[0][1]);                                        \
  acc[1][0] = mfma32(F##a1, F##b0, acc[1][0]);                                        \
  acc[1][1] = mfma32(F##a1, F##b1, acc[1][1]);
#define COMPUTE(buf)                                                                  \
  {                                                                                   \
    const char* As_ = smem + (buf) * 36864; const char* Bs_ = As_ + 18432;            \
    const char* ap = As_ + (wm * 64 + r32) * 144 + hh * 16;                           \
    const char* bp = Bs_ + (wn * 64 + r32) * 144 + hh * 16;                           \
    LOADF(f0, 0) LOADF(f1, 1)                                                         \
    __builtin_amdgcn_sched_barrier(0);                                                \
    MFMA4(f0)                                                                         \
    LOADF(f2, 2)                                                                      \
    __builtin_amdgcn_sched_barrier(0);                                                \
    MFMA4(f1)                                                                         \
    LOADF(f3, 3)                                                                      \
    __builtin_amdgcn_sched_barrier(0);                                                \
    MFMA4(f2)                                                                         \
    __builtin_amdgcn_sched_barrier(0);                                                \
    MFMA4(f3)                                                                         \
    __builtin_amdgcn_sched_barrier(0);                                                \
  }

  qa10 = qa11 = qa12 = qa13 = qb10 = qb11 = qb12 = qb13 = z4;
  if (MIX) {
    GLOAD(0, 0);
    SSTORE(0, 0, 0);
    __syncthreads();
    for (int i = 0; i < nk; ++i) {
      if (i + 1 < nk) GLOAD(0, i + 1);
      if (i & 1) { COMPUTE(1); } else { COMPUTE(0); }
      if (i + 1 < nk) { if (i & 1) { SSTORE(0, i + 1, 0); } else { SSTORE(0, i + 1, 1); } }
      __syncthreads();
    }
  } else if (nk == 1) {
    GLOAD(0, 0);
    SSTORE(0, 0, 0);
    __syncthreads();
    COMPUTE(0);
    __syncthreads();
  } else {
    GLOAD(0, 0);
    GLOAD(1, 1);
    SSTORE(0, 0, 0);
    __syncthreads();
#pragma unroll 1
    for (int i = 0; i + 2 < nk; i += 2) {
      GLOAD(0, i + 2);
      COMPUTE(0);
      SSTORE(1, i + 1, 1);
      __syncthreads();
      GLOAD(1, i + 3);
      COMPUTE(1);
      SSTORE(0, i + 2, 0);
      __syncthreads();
    }
    COMPUTE(0);
    SSTORE(1, nk - 1, 1);
    __syncthreads();
    COMPUTE(1);
    __syncthreads();
  }
#undef LD1
#undef ST1
#undef LOADF
#undef MFMA4
#undef GLOAD
#undef SSTORE
#undef COMPUTE

  if (EPI == EPI_GATES) {
    const int ch = (n0 >> 7) * 64 + wn * 32 + r32;
    const float br = j.x0[ch], bi = j.x1[ch];
    const float spl = softplusf_(-j.x2[ch]);
    const bf16_t* XC = (const bf16_t*)j.o1;
    float* AA = (float*)j.o0;
    float* BBp = AA + (size_t)T_ * 1024;
#pragma unroll
    for (int mi = 0; mi < 2; ++mi)
#pragma unroll
      for (int r = 0; r < 16; ++r) {
        const int row = m0 + wm * 64 + mi * 32 + (r & 3) + 8 * (r >> 2) + 4 * hh;
        const float rg = sigmoidf_(acc[mi][0][r] + br);
        const float ig = sigmoidf_(acc[mi][1][r] + bi);
        const float la = -8.f * rg * spl;
        const float xc = bf2f(XC[(size_t)row * 1024 + ch]);
        const bool reset = (row < TP_) && ((row & 2047) == 0);
        const float a = reset ? 0.f : __expf(la);
        const float mult = reset ? 1.f : sqrtf(fmaxf(-expm1f(2.f * la), 0.f));
        AA[(size_t)row * 1024 + ch] = a;
        BBp[(size_t)row * 1024 + ch] = mult * ig * xc;
      }
  } else {
#pragma unroll
    for (int mi = 0; mi < 2; ++mi)
#pragma unroll
      for (int ni = 0; ni < 2; ++ni)
#pragma unroll
        for (int r = 0; r < 16; ++r) {
          const int row = m0 + wm * 64 + mi * 32 + (r & 3) + 8 * (r >> 2) + 4 * hh;
          const int col = n0 + wn * 64 + ni * 32 + r32;
          epi_elem<EPI>(j, row, col, acc[mi][ni][r]);
          if ((r & 7) == 7) __builtin_amdgcn_sched_barrier(0);
        }
  }
}

constexpr int DSLOT = 24576;
template <int EPI>
DI void gemm_tile_dma(const GJob& j, int m0, int n0, int k0, int k1, char* smem, unsigned* wflag = nullptr, unsigned epoch = 0u) {
  const int tid = TIDX, lane = tid & 63, w = tid >> 6;
  const int wm = w >> 1, wn = w & 1, r32 = lane & 31, hh = lane >> 5;
  f32x16 acc[2][4];
#pragma unroll
  for (int a = 0; a < 2; ++a)
#pragma unroll
    for (int b = 0; b < 4; ++b)
#pragma unroll
      for (int r = 0; r < 16; ++r) acc[a][b][r] = 0.f;
  const int nk = k1 - k0;
  const int dr = lane >> 2;
  const int dc = (lane & 3) ^ ((lane >> 4) & 3);
  const int nlim = j.nvalid - 1;
  const size_t kofs = (size_t)k0 * 32 + dc * 8;
  const bf16_t* gA0 = j.A + (size_t)(m0 + 32 * w + dr) * j.lda + kofs;
  const bf16_t* gA1 = j.A + (size_t)(m0 + 32 * w + 16 + dr) * j.lda + kofs;
  const bf16_t* gB0 = j.Bt + (size_t)min(n0 + 64 * w + dr, nlim) * j.ldb + kofs;
  const bf16_t* gB1 = j.Bt + (size_t)min(n0 + 64 * w + 16 + dr, nlim) * j.ldb + kofs;
  const bf16_t* gB2 = j.Bt + (size_t)min(n0 + 64 * w + 32 + dr, nlim) * j.ldb + kofs;
  const bf16_t* gB3 = j.Bt + (size_t)min(n0 + 64 * w + 48 + dr, nlim) * j.ldb + kofs;
  char* ldsA = smem + (2 * w) * 1024 + lane * 16;
  char* ldsB = smem + 8192 + (4 * w) * 1024 + lane * 16;
  const unsigned lbase = (unsigned)(unsigned long long)(LAS char*)smem;
  const int fsw = (r32 >> 2) & 3;
  const unsigned pa = (unsigned)((wm * 64 + r32) * 64), pb = (unsigned)(8192 + (wn * 128 + r32) * 64);
  const unsigned po0 = (unsigned)(((hh) ^ fsw) * 16), po1 = (unsigned)(((2 + hh) ^ fsw) * 16);

#define DMA1(gp, lp) __builtin_amdgcn_global_load_lds((const unsigned*)(gp), (unsigned*)(lp), 16, 0, 0)
#define ISSUE(kt, slot)                                                                          \
  {                                                                                              \
    const int ko_ = (kt) * 32;                                                                   \
    char* la_ = ldsA + (slot) * DSLOT; char* lb_ = ldsB + (slot) * DSLOT;                        \
    DMA1(gA0 + ko_, la_); DMA1(gA1 + ko_, la_ + 1024);                                           \
    DMA1(gB0 + ko_, lb_); DMA1(gB1 + ko_, lb_ + 1024); DMA1(gB2 + ko_, lb_ + 2048); DMA1(gB3 + ko_, lb_ + 3072); \
  }
#define SB_ __builtin_amdgcn_sched_barrier(0)

  asm volatile("s_waitcnt vmcnt(0)" ::: "memory");
  const int last = nk - 1;
  ISSUE(0, 0);
  { const int t1 = min(1, last); ISSUE(t1, 1); }
  int sl_r = 0, sl_w = 2;
#pragma unroll 1
  for (int i = 0; i < nk; ++i) {
    asm volatile("s_waitcnt vmcnt(6)" ::: "memory");
    __builtin_amdgcn_s_barrier();
    const int ko2 = min(i + 2, last) * 32;
    char* la2 = ldsA + sl_w * DSLOT; char* lb2 = ldsB + sl_w * DSLOT;
    const unsigned sl = lbase + (unsigned)(sl_r * DSLOT);
    sl_r = (sl_r == 2) ? 0 : sl_r + 1;
    sl_w = (sl_w == 2) ? 0 : sl_w + 1;
    bf16x8 a00, a10, a01, a11, b00, b10, b20, b30, b01, b11, b21, b31;
    const unsigned aA0 = sl + pa + po0, aB0 = sl + pb + po0, aA1 = sl + pa + po1, aB1 = sl + pb + po1;
    asm volatile("ds_read_b128 %0, %1" : "=v"(a00) : "v"(aA0));
    asm volatile("ds_read_b128 %0, %1 offset:2048" : "=v"(a10) : "v"(aA0));
    asm volatile("ds_read_b128 %0, %1" : "=v"(b00) : "v"(aB0));
    asm volatile("ds_read_b128 %0, %1 offset:2048" : "=v"(b10) : "v"(aB0));
    asm volatile("ds_read_b128 %0, %1 offset:4096" : "=v"(b20) : "v"(aB0));
    asm volatile("ds_read_b128 %0, %1 offset:6144" : "=v"(b30) : "v"(aB0));
    asm volatile("ds_read_b128 %0, %1" : "=v"(a01) : "v"(aA1));
    asm volatile("ds_read_b128 %0, %1 offset:2048" : "=v"(a11) : "v"(aA1));
    asm volatile("ds_read_b128 %0, %1" : "=v"(b01) : "v"(aB1));
    asm volatile("ds_read_b128 %0, %1 offset:2048" : "=v"(b11) : "v"(aB1));
    asm volatile("ds_read_b128 %0, %1 offset:4096" : "=v"(b21) : "v"(aB1));
    asm volatile("ds_read_b128 %0, %1 offset:6144" : "=v"(b31) : "v"(aB1));
    DMA1(gA0 + ko2, la2);
    asm volatile("s_waitcnt lgkmcnt(0)" : "+v"(a00), "+v"(a10), "+v"(b00), "+v"(b10), "+v"(b20), "+v"(b30),
                 "+v"(a01), "+v"(a11), "+v"(b01), "+v"(b11), "+v"(b21), "+v"(b31) :: "memory");
    acc[0][0] = mfma32(a00, b00, acc[0][0]);
    acc[0][1] = mfma32(a00, b10, acc[0][1]);
    acc[0][2] = mfma32(a00, b20, acc[0][2]);
    SB_; DMA1(gA1 + ko2, la2 + 1024); SB_;
    acc[0][3] = mfma32(a00, b30, acc[0][3]);
    acc[1][0] = mfma32(a10, b00, acc[1][0]);
    acc[1][1] = mfma32(a10, b10, acc[1][1]);
    SB_; DMA1(gB0 + ko2, lb2); SB_;
    acc[1][2] = mfma32(a10, b20, acc[1][2]);
    acc[1][3] = mfma32(a10, b30, acc[1][3]);
    acc[0][0] = mfma32(a01, b01, acc[0][0]);
    SB_; DMA1(gB1 + ko2, lb2 + 1024); SB_;
    acc[0][1] = mfma32(a01, b11, acc[0][1]);
    acc[0][2] = mfma32(a01, b21, acc[0][2]);
    acc[0][3] = mfma32(a01, b31, acc[0][3]);
    SB_; DMA1(gB2 + ko2, lb2 + 2048); SB_;
    acc[1][0] = mfma32(a11, b01, acc[1][0]);
    acc[1][1] = mfma32(a11, b11, acc[1][1]);
    acc[1][2] = mfma32(a11, b21, acc[1][2]);
    SB_; DMA1(gB3 + ko2, lb2 + 3072); SB_;
    acc[1][3] = mfma32(a11, b31, acc[1][3]);
  }
  asm volatile("s_waitcnt vmcnt(0)" ::: "memory");
  __builtin_amdgcn_s_barrier();
#undef ISSUE
#undef DMA1
#undef SB_
  if (wflag) {
    if (threadIdx.x == 0) {
      unsigned sp = 0;
      while (xb_ld(wflag) != epoch) { __builtin_amdgcn_s_sleep(1); if (++sp > (1u << 24)) break; }
      __builtin_amdgcn_fence(__ATOMIC_ACQUIRE, "agent");
      asm volatile("s_waitcnt vmcnt(0)" ::: "memory");
    }
    __syncthreads();
  }

  if (EPI == EPI_GATES) {
    const bf16_t* XC = (const bf16_t*)j.o1;
    float* AA = (float*)j.o0;
    float* BBp = AA + (size_t)T_ * 1024;
#pragma unroll
    for (int g = 0; g < 2; ++g) {
      const int ch = (n0 >> 8) * 128 + wn * 64 + g * 32 + r32;
      const float br = j.x0[ch], bi = j.x1[ch];
      const float spl = softplusf_(-j.x2[ch]);
#pragma unroll
      for (int mi = 0; mi < 2; ++mi)
#pragma unroll
        for (int r = 0; r < 16; ++r) {
          const int row = m0 + wm * 64 + mi * 32 + (r & 3) + 8 * (r >> 2) + 4 * hh;
          const float rg = sigmoidf_(acc[mi][2 * g][r] + br);
          const float ig = sigmoidf_(acc[mi][2 * g + 1][r] + bi);
          const float la = -8.f * rg * spl;
          const float xc = bf2f(XC[(size_t)row * 1024 + ch]);
          const bool reset = (row < TP_) && ((row & 2047) == 0);
          const float a = reset ? 0.f : __expf(la);
          const float mult = reset ? 1.f : sqrtf(fmaxf(-expm1f(2.f * la), 0.f));
          AA[(size_t)row * 1024 + ch] = a;
          BBp[(size_t)row * 1024 + ch] = mult * ig * xc;
        }
    }
  } else {
    const int lq = lane & 3;
#pragma unroll
    for (int mi = 0; mi < 2; ++mi)
#pragma unroll
      for (int ni = 0; ni < 4; ++ni)
#pragma unroll
        for (int g4 = 0; g4 < 4; ++g4) {
          float v[4] = {acc[mi][ni][4 * g4], acc[mi][ni][4 * g4 + 1], acc[mi][ni][4 * g4 + 2], acc[mi][ni][4 * g4 + 3]};
          quad_transpose4(v, lq);
          const int row = m0 + wm * 64 + mi * 32 + 8 * g4 + 4 * hh + lq;
          const int col = n0 + wn * 128 + ni * 32 + (r32 & ~3);
          epi4<EPI>(j, row, col, v);
        }
    if (EPI == EPI_SSM_XBC) {
      if (n0 + wn * 128 == 4096) {
        const float dtb = j.x0[r32];
#pragma unroll
        for (int mi = 0; mi < 2; ++mi)
#pragma unroll
          for (int r = 0; r < 16; ++r) {
            const int row = m0 + wm * 64 + mi * 32 + (r & 3) + 8 * (r >> 2) + 4 * hh;
            ((float*)j.o1)[(size_t)row * 32 + r32] = softplusf_(acc[mi][0][r] + dtb);
          }
      }
    }
  }
}

template <int EPI>
DI void gemm_tile_dma_h(const GJob& j, int m0, int n0, int nk, char* smem) {
  const int tid = TIDX, lane = tid & 63, w = tid >> 6;
  const int wm = w >> 1, wn = w & 1, r32 = lane & 31, hh = lane >> 5;
  f32x16 acc[4];
#pragma unroll
  for (int b = 0; b < 4; ++b)
#pragma unroll
    for (int r = 0; r < 16; ++r) acc[b][r] = 0.f;
  const int dr = lane >> 2;
  const int dc = (lane & 3) ^ ((lane >> 4) & 3);
  const int nlim = j.nvalid - 1;
  const size_t kofs = (size_t)dc * 8;
  const bf16_t* gA0 = j.A + (size_t)(m0 + 16 * w + dr) * j.lda + kofs;
  const bf16_t* gB0 = j.Bt + (size_t)min(n0 + 64 * w + dr, nlim) * j.ldb + kofs;
  const bf16_t* gB1 = j.Bt + (size_t)min(n0 + 64 * w + 16 + dr, nlim) * j.ldb + kofs;
  const bf16_t* gB2 = j.Bt + (size_t)min(n0 + 64 * w + 32 + dr, nlim) * j.ldb + kofs;
  const bf16_t* gB3 = j.Bt + (size_t)min(n0 + 64 * w + 48 + dr, nlim) * j.ldb + kofs;
  char* ldsA = smem + w * 1024 + lane * 16;
  char* ldsB = smem + 8192 + (4 * w) * 1024 + lane * 16;
  const unsigned lbase = (unsigned)(unsigned long long)(LAS char*)smem;
  const int fsw = (r32 >> 2) & 3;
  const unsigned pa = (unsigned)((wm * 32 + r32) * 64), pb = (unsigned)(8192 + (wn * 128 + r32) * 64);
  const unsigned po0 = (unsigned)(((hh) ^ fsw) * 16), po1 = (unsigned)(((2 + hh) ^ fsw) * 16);
#define DMA1(gp, lp) __builtin_amdgcn_global_load_lds((const unsigned*)(gp), (unsigned*)(lp), 16, 0, 0)
#define ISSUEH(kt, slot)                                                                         \
  {                                                                                              \
    const int ko_ = (kt) * 32;                                                                   \
    char* la_ = ldsA + (slot) * DSLOT; char* lb_ = ldsB + (slot) * DSLOT;                        \
    DMA1(gA0 + ko_, la_);                                                                        \
    DMA1(gB0 + ko_, lb_); DMA1(gB1 + ko_, lb_ + 1024); DMA1(gB2 + ko_, lb_ + 2048); DMA1(gB3 + ko_, lb_ + 3072); \
  }
  asm volatile("s_waitcnt vmcnt(0)" ::: "memory");
  const int last = nk - 1;
  ISSUEH(0, 0);
  { const int t1 = min(1, last); ISSUEH(t1, 1); }
  int sl_r = 0, sl_w = 2;
#pragma unroll 1
  for (int i = 0; i < nk; ++i) {
    asm volatile("s_waitcnt vmcnt(5)" ::: "memory");
    __builtin_amdgcn_s_barrier();
    { const int t2 = min(i + 2, last); ISSUEH(t2, sl_w); }
    const unsigned sl = lbase + (unsigned)(sl_r * DSLOT);
    sl_r = (sl_r == 2) ? 0 : sl_r + 1;
    sl_w = (sl_w == 2) ? 0 : sl_w + 1;
    bf16x8 a00, a01, b00, b10, b20, b30, b01, b11, b21, b31;
    const unsigned aA0 = sl + pa + po0, aB0 = sl + pb + po0, aA1 = sl + pa + po1, aB1 = sl + pb + po1;
    asm volatile("ds_read_b128 %0, %1" : "=v"(a00) : "v"(aA0));
    asm volatile("ds_read_b128 %0, %1" : "=v"(b00) : "v"(aB0));
    asm volatile("ds_read_b128 %0, %1 offset:2048" : "=v"(b10) : "v"(aB0));
    asm volatile("ds_read_b128 %0, %1 offset:4096" : "=v"(b20) : "v"(aB0));
    asm volatile("ds_read_b128 %0, %1 offset:6144" : "=v"(b30) : "v"(aB0));
    asm volatile("ds_read_b128 %0, %1" : "=v"(a01) : "v"(aA1));
    asm volatile("ds_read_b128 %0, %1" : "=v"(b01) : "v"(aB1));
    asm volatile("ds_read_b128 %0, %1 offset:2048" : "=v"(b11) : "v"(aB1));
    asm volatile("ds_read_b128 %0, %1 offset:4096" : "=v"(b21) : "v"(aB1));
    asm volatile("ds_read_b128 %0, %1 offset:6144" : "=v"(b31) : "v"(aB1));
    asm volatile("s_waitcnt lgkmcnt(0)" : "+v"(a00), "+v"(b00), "+v"(b10), "+v"(b20), "+v"(b30),
                 "+v"(a01), "+v"(b01), "+v"(b11), "+v"(b21), "+v"(b31) :: "memory");
    acc[0] = mfma32(a00, b00, acc[0]);
    acc[1] = mfma32(a00, b10, acc[1]);
    acc[2] = mfma32(a00, b20, acc[2]);
    acc[3] = mfma32(a00, b30, acc[3]);
    acc[0] = mfma32(a01, b01, acc[0]);
    acc[1] = mfma32(a01, b11, acc[1]);
    acc[2] = mfma32(a01, b21, acc[2]);
    acc[3] = mfma32(a01, b31, acc[3]);
  }
  asm volatile("s_waitcnt vmcnt(0)" ::: "memory");
  __builtin_amdgcn_s_barrier();
#undef ISSUEH
#undef DMA1
  const int lq = lane & 3;
#pragma unroll
  for (int ni = 0; ni < 4; ++ni)
#pragma unroll
    for (int g4 = 0; g4 < 4; ++g4) {
      float v[4] = {acc[ni][4 * g4], acc[ni][4 * g4 + 1], acc[ni][4 * g4 + 2], acc[ni][4 * g4 + 3]};
      quad_transpose4(v, lq);
      const int row = m0 + wm * 32 + 8 * g4 + 4 * hh + lq;
      const int col = n0 + wn * 128 + ni * 32 + (r32 & ~3);
      epi4<EPI>(j, row, col, v);
    }
  if (EPI == EPI_SSM_XBC) {
    if (n0 + wn * 128 == 4096) {
      const float dtb = j.x0[r32];
#pragma unroll
      for (int r = 0; r < 16; ++r) {
        const int row = m0 + wm * 32 + (r & 3) + 8 * (r >> 2) + 4 * hh;
        ((float*)j.o1)[(size_t)row * 32 + r32] = softplusf_(acc[0][r] + dtb);
      }
    }
  }
}

#define VBLOCK() ((int)(((volatile LAS unsigned*)&xb_words)[3]))
DI void tile_map(int L, int ntn, int& mt, int& nt) {
  const int gw = ((ntn & 7) == 0) ? 8 : (((ntn & 3) == 0) ? 4 : 0);
  if (gw) {
    const int gs = 8 * gw, grp = L / gs, loc = L - grp * gs, gpr = ntn / gw;
    const int gm = grp / gpr, gn = grp - gm * gpr;
    mt = gm * 8 + loc / gw; nt = gn * gw + (loc - (loc / gw) * gw);
  } else { mt = L / ntn; nt = L - mt * ntn; }
}

template <int EPI, bool MIX>
DI void gemm_run(const GJob& j, int ntn, int& toff, char* smem, int vb_) {
  const int G = gridDim.x;
  const int nk = j.K >> 6;
  if (MIX) {
    const int ntiles = MT_ * ntn;
    const int start = (int)((vb_ - (toff % G) + G) % G);
    for (int tile = start; tile < ntiles; tile += G) {
      int mt, nt; tile_map(tile, ntn, mt, nt);
      gemm_tile<EPI, MIX>(j, mt * 128, nt * 128, 0, nk, smem);
    }
    toff += ntiles;
  } else {
    const int nfull = 128 * ntn, nhalf = 16 * ntn, ntot = nfull + nhalf;
    const int start = (int)((vb_ - (toff % G) + G) % G);
    for (int item = start; item < ntot; item += G) {
      if (item < nfull) {
        int mt, nt; tile_map(item, ntn, mt, nt);
        gemm_tile_dma<EPI>(j, mt * 128, nt * 256, 0, nk * 2, smem);
      } else {
        const int h = item - nfull, hm = h / ntn, nt = h - hm * ntn;
        gemm_tile_dma_h<EPI>(j, TP_ + hm * 64, nt * 256, nk * 2, smem);
      }
    }
    toff += ntot;
  }
}

template <int EPI>
DI void gemm_streamk(const GJob& j, int ntn, char* smem, int vb_, unsigned* flags, unsigned epoch) {
  const int G = gridDim.x;
  const int nk = j.K >> 5;
  const int total = MT_ * ntn * nk;
  int per = (total + G - 1) / G;
  if (per < nk) per = nk;
  int s0 = vb_ * per;
  const int s1 = min(s0 + per, total);
  while (s0 < s1) {
    const int tile = s0 / nk, k0 = s0 - tile * nk;
    const int k1 = min(nk, k0 + (s1 - s0));
    int mt, nt; tile_map(tile, ntn, mt, nt);
    unsigned* wf = (k0 == 0 && k1 < nk) ? (flags + tile) : nullptr;
    gemm_tile_dma<EPI>(j, mt * 128, nt * 256, k0, k1, smem, wf, epoch);
    if (k0 > 0) {
      asm volatile("s_waitcnt vmcnt(0)" ::: "memory");
      __syncthreads();
      if (threadIdx.x == 0) {
        __builtin_amdgcn_fence(__ATOMIC_RELEASE, "agent");
        asm volatile("s_waitcnt vmcnt(0)" ::: "memory");
        __hip_atomic_store(flags + tile, epoch, __ATOMIC_RELAXED, __HIP_MEMORY_SCOPE_AGENT);
      }
    }
    s0 += k1 - k0;
  }
}

template <int EPI, int SPLIT, int NKC>
DI void gemm_splitk(const GJob& j, int ntn, char* smem, int vb_) {
  const int G = gridDim.x;
  const int nitems = MT_ * ntn * SPLIT;
  for (int it = vb_; it < nitems; it += G) {
    const int tile = it / SPLIT, sp = it - tile * SPLIT;
    int mt, nt; tile_map(tile, ntn, mt, nt);
    gemm_tile<EPI, false>(j, mt * 128, nt * 128, sp * NKC, sp * NKC + NKC, smem);
  }
}

DI GJob mkjob(const bf16_t* A, int lda, const bf16_t* Bt, int ldb, int K, int nvalid) {
  GJob j;
  j.A = A; j.A2 = nullptr; j.mu = nullptr; j.Bt = Bt; j.lda = lda; j.ldb = ldb; j.K = K; j.nvalid = nvalid;
  j.o0 = nullptr; j.o1 = nullptr; j.x0 = nullptr; j.x1 = nullptr; j.x2 = nullptr; j.ldo = 0; j.act = 0;
  return j;
}

struct TJob { const float* src; bf16_t* dst; int K, N, src_ld, kind, n_off; };

DI TJob get_tjob(const Params& p, int j) {
  bf16_t* wt = (bf16_t*)(p.ws + W_WT);
  TJob o; o.kind = 0; o.n_off = 0;
  if (j < 36) {
    const int ia = j / 18, r = j % 18;
    if (r == 0) { o.src = p.in[I_LRU_WIN] + (size_t)ia * 1024 * 2048; o.dst = wt + WA_IN + (size_t)ia * 2048 * 1024; o.K = 1024; o.N = 2048; o.src_ld = 2048; }
    else if (r == 1) { o.src = p.in[I_LRU_WOUT] + (size_t)ia * 1024 * 1024; o.dst = wt + WA_OUT + (size_t)ia * 1024 * 1024; o.K = 1024; o.N = 1024; o.src_ld = 1024; }
    else {
      const int isI = (r >= 10) ? 1 : 0; const int h = (r - 2) & 7;
      o.src = p.in[isI ? I_LRU_WI : I_LRU_WR] + ((size_t)ia * 8 + h) * 128 * 128;
      o.dst = wt + WA_G + (size_t)ia * 2048 * 128; o.K = 128; o.N = 128; o.src_ld = 128; o.kind = 1 + isI; o.n_off = h * 128;
    }
  } else if (j == 36) { o.src = p.in[I_SSM_WIN] + 2048; o.dst = wt + WB_XBC; o.K = 1024; o.N = 4128; o.src_ld = 6176; }
  else if (j == 37) { o.src = p.in[I_SSM_WIN]; o.dst = wt + WB_Z; o.K = 1024; o.N = 2048; o.src_ld = 6176; }
  else if (j == 38) { o.src = p.in[I_SSM_WOUT]; o.dst = wt + WB_OUT; o.K = 2048; o.N = 1024; o.src_ld = 1024; }
  else if (j < 42) { const int s = j - 39; o.src = p.in[I_RW_WRKV] + (size_t)s * 1024 * 1024; o.dst = wt + WC_RKV + (size_t)s * 1024 * 1024; o.K = 1024; o.N = 1024; o.src_ld = 1024; }
  else if (j == 42) { o.src = p.in[I_RW_WW1]; o.dst = wt + WC_L1; o.K = 1024; o.N = 64; o.src_ld = 64; }
  else if (j == 43) { o.src = p.in[I_RW_WA1]; o.dst = wt + WC_L1 + 64 * 1024; o.K = 1024; o.N = 64; o.src_ld = 64; }
  else if (j == 44) { o.src = p.in[I_RW_WG1]; o.dst = wt + WC_L1 + 128 * 1024; o.K = 1024; o.N = 128; o.src_ld = 128; }
  else if (j == 45) { o.src = p.in[I_RW_WW2]; o.dst = wt + WC_W2; o.K = 64; o.N = 1024; o.src_ld = 1024; }
  else if (j == 46) { o.src = p.in[I_RW_WA2]; o.dst = wt + WC_A2; o.K = 64; o.N = 1024; o.src_ld = 1024; }
  else if (j == 47) { o.src = p.in[I_RW_WG2]; o.dst = wt + WC_G2; o.K = 128; o.N = 1024; o.src_ld = 1024; }
  else if (j == 48) { o.src = p.in[I_RW_WOUT]; o.dst = wt + WC_OUT; o.K = 1024; o.N = 1024; o.src_ld = 1024; }
  else {
    const int l = (j - 49) >> 1, which = (j - 49) & 1;
    if (!which) { o.src = p.in[I_FFN_W1] + (size_t)l * 1024 * 4096; o.dst = wt + WF_1 + (size_t)l * 4096 * 1024; o.K = 1024; o.N = 4096; o.src_ld = 4096; }
    else { o.src = p.in[I_FFN_W2] + (size_t)l * 4096 * 1024; o.dst = wt + WF_2 + (size_t)l * 4096 * 1024; o.K = 4096; o.N = 1024; o.src_ld = 1024; }
  }
  return o;
}
constexpr int N_TJOBS = 57;

DI void ph_prologue(const Params& p, char* smem) {
  const int tid = TIDX, G = gridDim.x;
  {
    const float4* xp = (const float4*)p.in[I_XP];
    const float4* xs = (const float4*)p.in[I_XS];
    float4* X = (float4*)(p.ws + W_X);
    const size_t np = (size_t)TP_ * 256, nt = (size_t)T_ * 256;
    for (size_t i = (size_t)blockIdx.x * NTHR + tid; i < nt; i += (size_t)G * NTHR)
      X[i] = (i < np) ? xp[i] : xs[i - np];
  }
  float* tile = (float*)smem;
  int toff = 0;
  for (int jn = 0; jn < N_TJOBS; ++jn) {
    const TJob tj = get_tjob(p, jn);
    const int nkt = tj.K >> 6, nnt = (tj.N + 63) >> 6;
    const int ntiles = nkt * nnt;
    const int start = (((int)blockIdx.x - (toff % G)) + G) % G;
    for (int t = start; t < ntiles; t += G) {
      const int kt = t / nnt, nt = t - kt * nnt;
      const int k0 = kt * 64, n0 = nt * 64;
      __syncthreads();
      float tv[16];
      const bool nok = (n0 + (tid & 63)) < tj.N;
      const float* sp = tj.src + (size_t)(k0 + (tid >> 6)) * tj.src_ld + n0 + (tid & 63);
#pragma unroll
      for (int i = 0; i < 16; ++i) tv[i] = nok ? sp[(size_t)(i * 4) * tj.src_ld] : 0.f;
#pragma unroll
      for (int i = 0; i < 16; ++i) tile[(i * 4 + (tid >> 6)) * 65 + (tid & 63)] = tv[i];
      __syncthreads();
      const int n = tid >> 2, kq = tid & 3;
      if (n0 + n < tj.N) {
        int nrow = n0 + n;
        if (tj.kind) {
          const int ch = tj.n_off + n0 + n;
          nrow = (ch >> 6) * 128 + ((ch >> 5) & 1) * 64 + (tj.kind - 1) * 32 + (ch & 31);
        }
        float f[8], g[8];
#pragma unroll
        for (int e = 0; e < 8; ++e) { f[e] = tile[(kq * 16 + e) * 65 + n]; g[e] = tile[(kq * 16 + 8 + e) * 65 + n]; }
        uint4* d = (uint4*)(tj.dst + (size_t)nrow * tj.K + k0 + kq * 16);
        d[0] = pack8(f); d[1] = pack8(g);
      }
    }
    toff += ntiles;
  }
}

DI void ph_rmsnorm(const Params& p, int mode, const float* w) {
  const int tid_ = TIDX; const int lane = tid_ & 63;
  const int gw = blockIdx.x * 4 + (tid_ >> 6), nw = gridDim.x * 4;
  const float* X = (const float*)(p.ws + W_X);
  bf16_t* U = (bf16_t*)(p.ws + W_U);
  bf16_t* UP = (bf16_t*)(p.ws + SC_UP);
  float4 wv[4];
#pragma unroll
  for (int i = 0; i < 4; ++i) wv[i] = ((const float4*)w)[lane + 64 * i];
  for (int row = gw; row < T_; row += nw) {
    const float4* xr = (const float4*)(X + (size_t)row * 1024);
    float4 v[4]; float ss = 0.f;
#pragma unroll
    for (int i = 0; i < 4; ++i) { v[i] = xr[lane + 64 * i]; ss += v[i].x * v[i].x + v[i].y * v[i].y + v[i].z * v[i].z + v[i].w * v[i].w; }
    ss = wave_sum(ss);
    const float rstd = rsqrtf(ss * (1.f / 1024.f) + 1e-6f);
    int seq, l, L; tok_info(row, seq, l, L);
#pragma unroll
    for (int i = 0; i < 4; ++i) {
      const int c = 4 * (lane + 64 * i);
      float4 y = make_float4(v[i].x * rstd * wv[i].x, v[i].y * rstd * wv[i].y, v[i].z * rstd * wv[i].z, v[i].w * rstd * wv[i].w);
      if (mode == 2) {
        *(float4*)(p.out + O_Y + (size_t)row * 1024 + c) = y;
      } else {
        uint2 pk = make_uint2(pack2(y.x, y.y), pack2(y.z, y.w));
        *(uint2*)(U + (size_t)row * 1024 + c) = pk;
        if (mode == 1) {
          if (l + 1 < L) *(uint2*)(UP + (size_t)(row + 1) * 1024 + c) = pk;
          if (l == 0) {
            uint2 pz = make_uint2(0, 0);
            if (seq >= 8) { float4 s = *(const float4*)(p.in[I_ST_RS] + (size_t)(seq - 8) * 1024 + c); pz = make_uint2(pack2(s.x, s.y), pack2(s.z, s.w)); }
            *(uint2*)(UP + (size_t)row * 1024 + c) = pz;
          }
          if (l == L - 1) {
            float* o = (seq < 8) ? (p.out + O_RS_P + (size_t)seq * 1024 + c) : (p.out + O_RS_S + (size_t)(seq - 8) * 1024 + c);
            *(float4*)o = y;
          }
        }
      }
    }
  }
}

template <int C, bool SILU>
DI void ph_conv(const bf16_t* __restrict__ src, bf16_t* __restrict__ dst, const float* __restrict__ cw,
                const float* __restrict__ cb, const float* __restrict__ state,
                float* __restrict__ out_p, float* __restrict__ out_s) {
  constexpr int GR = C / 8;
  const size_t total = (size_t)T_ * GR;
#pragma unroll 2
  for (size_t idx = (size_t)blockIdx.x * NTHR + TIDX; idx < total; idx += (size_t)gridDim.x * NTHR) {
    const int t = (int)(idx / GR), c = (int)(idx % GR) * 8;
    int seq, l, L; tok_info(t, seq, l, L);
    float acc[8]; load8f(cb + c, acc);
    float xcur[8];
#pragma unroll
    for (int jj = 0; jj < 4; ++jj) {
      const int ls = l - 3 + jj;
      float xv[8];
      if (ls >= 0) { unpack8(*(const uint4*)(src + (size_t)(t - 3 + jj) * C + c), xv); }
      else if (seq >= 8) { load8f(state + ((size_t)(seq - 8) * 3 + (ls + 3)) * C + c, xv); }
      else {
#pragma unroll
        for (int e = 0; e < 8; ++e) xv[e] = 0.f;
      }
      float w8[8]; load8f(cw + (size_t)jj * C + c, w8);
#pragma unroll
      for (int e = 0; e < 8; ++e) acc[e] += w8[e] * xv[e];
      if (jj == 3) {
#pragma unroll
        for (int e = 0; e < 8; ++e) xcur[e] = xv[e];
      }
    }
    if (SILU) {
#pragma unroll
      for (int e = 0; e < 8; ++e) acc[e] = siluf_(acc[e]);
    }
    *(uint4*)(dst + (size_t)t * C + c) = pack8(acc);
    if (l >= L - 3) {
      const int r = l - (L - 3);
      float* o = (seq < 8) ? (out_p + ((size_t)seq * 3 + r) * C + c) : (out_s + ((size_t)(seq - 8) * 3 + r) * C + c);
      store8f(o, xcur);
    }
  }
}

DI void ph_lru_scan1(const Params& p) {
  const float* AA = (const float*)(p.ws + SA_AA);
  const float* BB = (const float*)(p.ws + SA_BB);
  float* CP = (float*)(p.ws + SA_CP);
  float* CS = (float*)(p.ws + SA_CS);
  const int total = 8 * 64 * 1024;
  for (int idx = blockIdx.x * NTHR + TIDX; idx < total; idx += gridDim.x * NTHR) {
    const int ch = idx & 1023, c = (idx >> 10) & 63, b = idx >> 16;
    const size_t base = ((size_t)b * 2048 + c * 32) * 1024 + ch;
    float P = 1.f, S = 0.f;
    float av[32], bv[32];
#pragma unroll
    for (int s = 0; s < 32; ++s) { av[s] = AA[base + (size_t)s * 1024]; bv[s] = BB[base + (size_t)s * 1024]; }
#pragma unroll
    for (int s = 0; s < 32; ++s) { S = av[s] * S + bv[s]; P *= av[s]; }
    CP[idx] = P; CS[idx] = S;
  }
}
DI void ph_lru_scan2(const Params& p, int ia) {
  const float* AA = (const float*)(p.ws + SA_AA);
  const float* BB = (const float*)(p.ws + SA_BB);
  const float* CP = (const float*)(p.ws + SA_CP);
  const float* CS = (const float*)(p.ws + SA_CS);
  bf16_t* GT = (bf16_t*)(p.ws + SA_GT);
  const int nP = 8 * 64 * 1024, total = nP + 128 * 1024;
  for (int idx = blockIdx.x * NTHR + TIDX; idx < total; idx += gridDim.x * NTHR) {
    if (idx < nP) {
      const int ch = idx & 1023, c = (idx >> 10) & 63, b = idx >> 16;
      const size_t base = ((size_t)b * 2048 + c * 32) * 1024 + ch;
      float av[32], bv[32]; bf16_t gv[32];
#pragma unroll
      for (int s = 0; s < 32; ++s) { const size_t o = base + (size_t)s * 1024; av[s] = AA[o]; bv[s] = BB[o]; gv[s] = GT[o]; }
      float h = 0.f;
#pragma unroll 8
      for (int c2 = 0; c2 < c; ++c2) {
        const int ci = ((b * 64 + c2) << 10) + ch;
        h = CP[ci] * h + CS[ci];
      }
#pragma unroll
      for (int s = 0; s < 32; ++s) {
        const size_t o = base + (size_t)s * 1024;
        h = av[s] * h + bv[s];
        GT[o] = f2bf(h * bf2f(gv[s]));
      }
      if (c == 63) p.out[O_LH_P + ((size_t)ia * 8 + b) * 1024 + ch] = h;
    } else {
      const int u = idx - nP; const int ch = u & 1023, s = u >> 10;
      float h = p.in[I_ST_LH][((size_t)ia * 128 + s) * 1024 + ch];
      const size_t base = ((size_t)TP_ + s * 8) * 1024 + ch;
#pragma unroll
      for (int q = 0; q < 8; ++q) {
        const size_t o = base + (size_t)q * 1024;
        h = AA[o] * h + BB[o];
        GT[o] = f2bf(h * bf2f(GT[o]));
      }
      p.out[O_LH_S + ((size_t)ia * 128 + s) * 1024 + ch] = h;
    }
  }
}

DI void ssd_item(const Params& p, char* smem, int seq, int h) {
  const int tid = TIDX, lane = tid & 63, w = tid >> 6, r32 = lane & 31, hh = lane >> 5;
  bf16_t* Cs = (bf16_t*)smem;
  bf16_t* Bs = Cs + 64 * 136;
  bf16_t* Sb = Bs + 64 * 136;
  bf16_t* Xt = Sb + 64 * 136;
  bf16_t* Btr = Xt + 64 * 72;
  float* dts = (float*)(Btr + 128 * 72);
  float* acs = dts + 64;
  bf16_t* Ws = Bs;
  const bf16_t* XBC = (const bf16_t*)(p.ws + SB_XBC);
  const float* DT = (const float*)(p.ws + SB_DT);
  bf16_t* Y = (bf16_t*)(p.ws + SB_Y);
  const bool prompt = seq < 8;
  const int nchunk = prompt ? 32 : 1, Lv = prompt ? 64 : 8;
  const int tbase = prompt ? seq * 2048 : TP_ + (seq - 8) * 8;
  const int g = h >> 2;
  const float Ah = -__expf(p.in[I_SSM_ALOG][h]);
  const float Dh = p.in[I_SSM_D][h];
  f32x16 accS[2];
  {
    const float* s0 = p.in[I_ST_SS] + ((size_t)(seq - 8) * 32 + h) * 64 * 128;
#pragma unroll
    for (int mi = 0; mi < 2; ++mi)
#pragma unroll
      for (int r = 0; r < 16; ++r) {
        const int prow = mi * 32 + (r & 3) + 8 * (r >> 2) + 4 * hh, n = 32 * w + r32;
        accS[mi][r] = prompt ? 0.f : s0[(size_t)prow * 128 + n];
      }
  }
  __syncthreads();
#pragma unroll
  for (int mi = 0; mi < 2; ++mi)
#pragma unroll
    for (int r = 0; r < 16; ++r) {
      const int prow = mi * 32 + (r & 3) + 8 * (r >> 2) + 4 * hh, n = 32 * w + r32;
      Sb[prow * 136 + n] = f2bf(accS[mi][r]);
    }
  uint4 pc0, pc1, pc2, pc3, pb0, pb1, pb2, pb3, px0, px1;
  float pdt = 0.f;
  const uint4 z4 = make_uint4(0, 0, 0, 0);
  pc0 = pc1 = pc2 = pc3 = pb0 = pb1 = pb2 = pb3 = px0 = px1 = z4;
#define SSD_LD_CB(i, t0_)                                                                  \
  { const int row_ = tid >> 2, ch_ = (tid & 3) + 4 * i;      \
    pc##i = z4; pb##i = z4;                                                                \
    if (row_ < Lv) { const bf16_t* src_ = XBC + (size_t)((t0_) + row_) * 4096 + g * 128 + ch_ * 8; \
      pb##i = *(const uint4*)(src_ + 2048); pc##i = *(const uint4*)(src_ + 3072); } }
#define SSD_LD_X(i, t0_)                                                                   \
  { const int row_ = tid >> 2, ch_ = (tid & 3) + 4 * i;                                    \
    px##i = z4;                                                                            \
    if (row_ < Lv) px##i = *(const uint4*)(XBC + (size_t)((t0_) + row_) * 4096 + h * 64 + ch_ * 8); }
#define SSD_ISSUE(t0_)                                                                     \
  { SSD_LD_CB(0, t0_) SSD_LD_CB(1, t0_) SSD_LD_CB(2, t0_) SSD_LD_CB(3, t0_) SSD_LD_X(0, t0_) SSD_LD_X(1, t0_) \
    pdt = (tid < Lv && tid < 64) ? DT[(size_t)((t0_) + tid) * 32 + h] : 0.f; }
#define SSD_ST_CB(i)                                                                       \
  { const int row_ = tid >> 2, ch_ = (tid & 3) + 4 * i;                                    \
    *(uint4*)(Cs + row_ * 136 + ch_ * 8) = pc##i;                                          \
    *(uint4*)(Bs + row_ * 136 + ch_ * 8) = pb##i;                                          \
    float f_[8]; unpack8(pb##i, f_);                                                       \
    const float sc_ = __expf(aend - acs[row_]);                                            \
    _Pragma("unroll") for (int e = 0; e < 8; ++e) Btr[(ch_ * 8 + e) * 72 + row_] = f2bf(f_[e] * sc_); }
#define SSD_ST_X(i)                                                                        \
  { const int row_ = tid >> 2, ch_ = (tid & 3) + 4 * i;                                    \
    float f_[8]; unpack8(px##i, f_);                                                       \
    const float sc_ = dts[row_];                                                           \
    _Pragma("unroll") for (int e = 0; e < 8; ++e) Xt[(ch_ * 8 + e) * 72 + row_] = f2bf(f_[e] * sc_); }
  SSD_ISSUE(tbase);
  for (int c = 0; c < nchunk; ++c) {
    const int t0 = tbase + c * 64;
    __syncthreads();
    if (tid < 64) {
      const float dtv = pdt;
      float x = dtv * Ah;
#pragma unroll
      for (int o = 1; o < 64; o <<= 1) { const float y = __shfl_up(x, o, 64); if (lane >= o) x += y; }
      dts[tid] = dtv; acs[tid] = x;
    }
    __syncthreads();
    const float aend = acs[63];
    SSD_ST_CB(0) SSD_ST_CB(1) SSD_ST_CB(2) SSD_ST_CB(3) SSD_ST_X(0) SSD_ST_X(1)
    if (c + 1 < nchunk) { SSD_ISSUE(t0 + 64); }
    __syncthreads();
    const int it = w >> 1, jt = w & 1;
    f32x16 cb;
#pragma unroll
    for (int r = 0; r < 16; ++r) cb[r] = 0.f;
    if (jt <= it) {
#pragma unroll
      for (int ks = 0; ks < 8; ++ks) {
        bf16x8 a = *(const bf16x8*)(Cs + (it * 32 + r32) * 136 + ks * 16 + hh * 8);
        bf16x8 b = *(const bf16x8*)(Bs + (jt * 32 + r32) * 136 + ks * 16 + hh * 8);
        cb = mfma32(a, b, cb);
      }
    }
    __syncthreads();
    {
      const int jj = jt * 32 + r32; const float aj = acs[jj];
#pragma unroll
      for (int r = 0; r < 16; ++r) {
        const int ii = it * 32 + (r & 3) + 8 * (r >> 2) + 4 * hh;
        const float v = (jj <= ii) ? cb[r] * __expf(acs[ii] - aj) : 0.f;
        Ws[ii * 72 + jj] = f2bf(v);
      }
    }
    __syncthreads();
    {
      const int pt = w & 1;
      f32x16 yd, yo;
#pragma unroll
      for (int r = 0; r < 16; ++r) { yd[r] = 0.f; yo[r] = 0.f; }
#pragma unroll
      for (int ks = 0; ks < 4; ++ks) {
        bf16x8 a = *(const bf16x8*)(Ws + (it * 32 + r32) * 72 + ks * 16 + hh * 8);
        bf16x8 b = *(const bf16x8*)(Xt + (pt * 32 + r32) * 72 + ks * 16 + hh * 8);
        yd = mfma32(a, b, yd);
      }
#pragma unroll
      for (int ks = 0; ks < 8; ++ks) {
        bf16x8 a = *(const bf16x8*)(Cs + (it * 32 + r32) * 136 + ks * 16 + hh * 8);
        bf16x8 b = *(const bf16x8*)(Sb + (pt * 32 + r32) * 136 + ks * 16 + hh * 8);
        yo = mfma32(a, b, yo);
      }
      const int pp = pt * 32 + r32;
#pragma unroll
      for (int r = 0; r < 16; ++r) {
        const int ii = it * 32 + (r & 3) + 8 * (r >> 2) + 4 * hh;
        if (ii < Lv) {
          const size_t t = (size_t)(t0 + ii);
          const float xv = bf2f(XBC[t * 4096 + h * 64 + pp]);
          const float yv = yd[r] + __expf(acs[ii]) * yo[r] + Dh * xv;
          Y[t * 2048 + h * 64 + pp] = f2bf(yv);
        }
      }
    }
    {
      const float dec = __expf(aend);
#pragma unroll
      for (int mi = 0; mi < 2; ++mi)
#pragma unroll
        for (int r = 0; r < 16; ++r) accS[mi][r] *= dec;
#pragma unroll
      for (int ks = 0; ks < 4; ++ks) {
        bf16x8 b = *(const bf16x8*)(Btr + (32 * w + r32) * 72 + ks * 16 + hh * 8);
        bf16x8 a0 = *(const bf16x8*)(Xt + (r32) * 72 + ks * 16 + hh * 8);
        bf16x8 a1 = *(const bf16x8*)(Xt + (32 + r32) * 72 + ks * 16 + hh * 8);
        accS[0] = mfma32(a0, b, accS[0]);
        accS[1] = mfma32(a1, b, accS[1]);
      }
    }
    __syncthreads();
#pragma unroll
    for (int mi = 0; mi < 2; ++mi)
#pragma unroll
      for (int r = 0; r < 16; ++r) {
        const int prow = mi * 32 + (r & 3) + 8 * (r >> 2) + 4 * hh, n = 32 * w + r32;
        Sb[prow * 136 + n] = f2bf(accS[mi][r]);
      }
  }
  float* dst = prompt ? (p.out + O_SS_P + ((size_t)seq * 32 + h) * 64 * 128)
                      : (p.out + O_SS_S + ((size_t)(seq - 8) * 32 + h) * 64 * 128);
#pragma unroll
  for (int mi = 0; mi < 2; ++mi)
#pragma unroll
    for (int r = 0; r < 16; ++r) {
      const int prow = mi * 32 + (r & 3) + 8 * (r >> 2) + 4 * hh, n = 32 * w + r32;
      dst[(size_t)prow * 128 + n] = accS[mi][r];
    }
}

#undef SSD_LD_CB
#undef SSD_LD_X
#undef SSD_ISSUE
#undef SSD_ST_CB
#undef SSD_ST_X
DI void ph_ssd(const Params& p, char* smem) {
  const int G = gridDim.x, bid = blockIdx.x;
  int it = bid, step = G;
  if (G >= 512) { if (bid < 256) { step = 1 << 30; } else { step = G - 256; } }
#pragma nounroll
  for (; it < 256 + 4096; it += step) {
    const int seq = (it < 256) ? (it >> 5) : (8 + ((it - 256) >> 5));
    ssd_item(p, smem, seq, it & 31);
  }
}

DI void ph_gnorm(const Params& p) {
  const int tid_ = TIDX; const int lane = tid_ & 63;
  const int gw = blockIdx.x * 4 + (tid_ >> 6), nw = gridDim.x * 4;
  bf16_t* Y = (bf16_t*)(p.ws + SB_Y);
  const float* nwt = p.in[I_SSM_NW];
  for (int item = gw; item < T_ * 8; item += 2 * nw) {
    const int item2 = item + nw; const bool v2 = item2 < T_ * 8;
    bf16_t* yp1 = Y + (size_t)(item >> 3) * 2048 + (item & 7) * 256 + lane * 4;
    bf16_t* yp2 = Y + (size_t)((v2 ? item2 : item) >> 3) * 2048 + ((v2 ? item2 : item) & 7) * 256 + lane * 4;
    const uint2 a = *(const uint2*)yp1; const uint2 b = *(const uint2*)yp2;
    float f[4], g[4]; unpack4(a, f); unpack4(b, g);
    const float ss1 = wave_sum(f[0] * f[0] + f[1] * f[1] + f[2] * f[2] + f[3] * f[3]);
    const float ss2 = wave_sum(g[0] * g[0] + g[1] * g[1] + g[2] * g[2] + g[3] * g[3]);
    const float r1 = rsqrtf(ss1 * (1.f / 256.f) + 1e-5f), r2 = rsqrtf(ss2 * (1.f / 256.f) + 1e-5f);
    const float4 w1 = *(const float4*)(nwt + (item & 7) * 256 + lane * 4);
    const float4 w2 = *(const float4*)(nwt + ((v2 ? item2 : item) & 7) * 256 + lane * 4);
    *(uint2*)yp1 = make_uint2(pack2(f[0] * r1 * w1.x, f[1] * r1 * w1.y), pack2(f[2] * r1 * w1.z, f[3] * r1 * w1.w));
    if (v2) *(uint2*)yp2 = make_uint2(pack2(g[0] * r2 * w2.x, g[1] * r2 * w2.y), pack2(g[2] * r2 * w2.z, g[3] * r2 * w2.w));
  }
}

template <int LPR>
DI void wkv_item(const Params& p, char* smem, int seq, int head, int part) {
  constexpr int ROWS = 256 / LPR, KPL = 64 / LPR, NV4 = KPL / 4;
  const int tid = TIDX;
  float* sR = (float*)smem;
  float* sK = sR + 2048;
  float* sKK = sK + 2048;
  float* sBB = sKK + 2048;
  float* sW = sBB + 2048;
  float* sV = sW + 2048;
  float* sO = sV + 2048;
  const bf16_t* __restrict__ R = (const bf16_t*)(p.ws + SC_R);
  const bf16_t* __restrict__ K = (const bf16_t*)(p.ws + SC_K);
  const bf16_t* __restrict__ V = (const bf16_t*)(p.ws + SC_V);
  const bf16_t* __restrict__ AAc = (const bf16_t*)(p.ws + SC_AA);
  const float* __restrict__ WD = (const float*)(p.ws + SC_WD);
  bf16_t* O = (bf16_t*)(p.ws + SC_O);
  const bool prompt = seq < 8;
  const int nch = prompt ? 64 : 1, nvalid = prompt ? 32 : 8;
  const int tbase = prompt ? seq * 2048 : TP_ + (seq - 8) * 8;
  const int row_l = tid / LPR, q = tid % LPR, row = part * ROWS + row_l;
  float S[KPL];
  {
    const float* s0 = p.in[I_ST_RW] + (((size_t)(seq - 8) * 16 + head) * 64 + row) * 64 + q * KPL;
#pragma unroll
    for (int e = 0; e < KPL; ++e) S[e] = prompt ? 0.f : s0[e];
  }
  const int pst = tid >> 3, pk0 = (tid & 7) * 8, pcol = head * 64 + pk0;
  const bool pact = pst < nvalid;
  float kk8[8], ka8[8];
  load8f(p.in[I_RW_KK] + pcol, kk8);
  load8f(p.in[I_RW_KA] + pcol, ka8);
  uint4 qr = make_uint4(0, 0, 0, 0), qk = qr, qv = qr, qa = qr;
  float4 qw0 = make_float4(0.f, 0.f, 0.f, 0.f), qw1 = qw0;
#define WKV_ISSUE(c_)                                                       \
  if (pact) {                                                               \
    const size_t o_ = (size_t)(tbase + (c_) * 32 + pst) * 1024 + pcol;      \
    qr = *(const uint4*)(R + o_); qk = *(const uint4*)(K + o_);             \
    qv = *(const uint4*)(V + o_); qa = *(const uint4*)(AAc + o_);           \
    qw0 = *(const float4*)(WD + o_); qw1 = *(const float4*)(WD + o_ + 4);   \
  }
  WKV_ISSUE(0);
  for (int c = 0; c < nch; ++c) {
    const int t0 = tbase + c * 32;
    __syncthreads();
    if (pact) {
      float r8[8], k8[8], v8[8], a8[8];
      unpack8(qr, r8); unpack8(qk, k8); unpack8(qv, v8); unpack8(qa, a8);
      const float w8[8] = {qw0.x, qw0.y, qw0.z, qw0.w, qw1.x, qw1.y, qw1.z, qw1.w};
      float kr[8], ss = 0.f;
#pragma unroll
      for (int e = 0; e < 8; ++e) { kr[e] = k8[e] * kk8[e]; ss += kr[e] * kr[e]; }
      ss = red_lanes<8>(ss);
      const float inv = 1.f / fmaxf(sqrtf(ss), 1e-12f);
      float kp[8], bb[8];
#pragma unroll
      for (int e = 0; e < 8; ++e) { kr[e] *= inv; kp[e] = k8[e] * (1.f + (a8[e] - 1.f) * ka8[e]); bb[e] = kr[e] * a8[e]; }
      const int lo = pst * 64 + pk0;
      store8f(sR + lo, r8); store8f(sK + lo, kp); store8f(sKK + lo, kr); store8f(sBB + lo, bb);
      store8f(sW + lo, w8); store8f(sV + lo, v8);
    }
    __syncthreads();
    if (c + 1 < nch) { WKV_ISSUE(c + 1); }
#define WKV_LOADV(P, st_)                                                                      \
    {                                                                                          \
      const int lo_ = (st_) * 64 + q * KPL;                                                    \
      _Pragma("unroll") for (int e = 0; e < NV4; ++e) {                                        \
        P##kk[e] = *(const float4*)(sKK + lo_ + 4 * e); P##ww[e] = *(const float4*)(sW + lo_ + 4 * e); \
        P##bb[e] = *(const float4*)(sBB + lo_ + 4 * e); P##kp[e] = *(const float4*)(sK + lo_ + 4 * e); \
        P##rr[e] = *(const float4*)(sR + lo_ + 4 * e);                                         \
      }                                                                                        \
      P##vv = sV[(st_) * 64 + row];                                                            \
    }
#define WKV_STEP(P, st_)                                                                       \
    {                                                                                          \
      float sa0 = 0.f, sa1 = 0.f;                                                              \
      _Pragma("unroll") for (int e = 0; e < NV4; ++e) {                                        \
        sa0 += S[4 * e] * P##kk[e].x + S[4 * e + 2] * P##kk[e].z;                              \
        sa1 += S[4 * e + 1] * P##kk[e].y + S[4 * e + 3] * P##kk[e].w;                          \
      }                                                                                        \
      const float sa = red_lanes<LPR>(sa0 + sa1);                                              \
      float o0 = 0.f, o1 = 0.f;                                                                \
      _Pragma("unroll") for (int e = 0; e < NV4; ++e) {                                        \
        S[4 * e] = S[4 * e] * P##ww[e].x - sa * P##bb[e].x + P##vv * P##kp[e].x;               \
        S[4 * e + 1] = S[4 * e + 1] * P##ww[e].y - sa * P##bb[e].y + P##vv * P##kp[e].y;       \
        S[4 * e + 2] = S[4 * e + 2] * P##ww[e].z - sa * P##bb[e].z + P##vv * P##kp[e].z;       \
        S[4 * e + 3] = S[4 * e + 3] * P##ww[e].w - sa * P##bb[e].w + P##vv * P##kp[e].w;       \
        o0 += S[4 * e] * P##rr[e].x + S[4 * e + 2] * P##rr[e].z;                               \
        o1 += S[4 * e + 1] * P##rr[e].y + S[4 * e + 3] * P##rr[e].w;                           \
      }                                                                                        \
      const float oo = red_lanes<LPR>(o0 + o1);                                                \
      if (q == 0) sO[(st_) * ROWS + row_l] = oo;                                               \
    }
    {
      float4 Akk[NV4], Aww[NV4], Abb[NV4], Akp[NV4], Arr[NV4]; float Avv;
      float4 Bkk[NV4], Bww[NV4], Bbb[NV4], Bkp[NV4], Brr[NV4]; float Bvv;
      if (LPR <= 4) {
#pragma unroll 1
        for (int st = 0; st < nvalid; ++st) { WKV_LOADV(A, st); WKV_STEP(A, st); }
      } else {
        WKV_LOADV(A, 0);
#pragma unroll 1
        for (int st = 0; st < nvalid; st += 2) {
          WKV_LOADV(B, st + 1);
          WKV_STEP(A, st);
          if (st + 2 < nvalid) { WKV_LOADV(A, st + 2); }
          WKV_STEP(B, st + 1);
        }
      }
    }
    __syncthreads();
    for (int i = tid; i < nvalid * ROWS; i += NTHR) {
      const int st = i / ROWS, rr = i % ROWS;
      O[(size_t)(t0 + st) * 1024 + head * 64 + part * ROWS + rr] = f2bf(sO[i]);
    }
  }
#undef WKV_ISSUE
#undef WKV_LOADV
#undef WKV_STEP
  float* dst = prompt ? (p.out + O_RW_P + (((size_t)seq * 16 + head) * 64 + row) * 64 + q * KPL)
                      : (p.out + O_RW_S + (((size_t)(seq - 8) * 16 + head) * 64 + row) * 64 + q * KPL);
#pragma unroll
  for (int e = 0; e < KPL; ++e) dst[e] = S[e];
}

template <int LPRP>
DI void ph_wkv(const Params& p, char* smem) {
  constexpr int NPART = 64 / (256 / LPRP);
  const int G = gridDim.x, bid = blockIdx.x;
  const int nP = 128 * NPART;
#pragma nounroll
  for (int it = bid; it < nP; it += G) {
    const int part = it % NPART, sh = it / NPART;
    wkv_item<LPRP>(p, smem, sh >> 4, sh & 15, part);
  }
  const int nS = 2048;
  int first, step;
  if (G > nP) { first = (bid >= nP) ? (bid - nP) : nS; step = G - nP; }
  else { first = bid; step = G; }
#pragma nounroll
  for (int it = first; it < nS; it += step) wkv_item<4>(p, smem, 8 + (it >> 4), it & 15, 0);
}

DI void ph_wkv_post(const Params& p) {
  const int tid_ = TIDX; const int lane = tid_ & 63;
  const int gw = blockIdx.x * 4 + (tid_ >> 6), nw = gridDim.x * 4;
  const bf16_t* __restrict__ R = (const bf16_t*)(p.ws + SC_R);
  const bf16_t* __restrict__ K = (const bf16_t*)(p.ws + SC_K);
  const bf16_t* __restrict__ V = (const bf16_t*)(p.ws + SC_V);
  const bf16_t* __restrict__ AAc = (const bf16_t*)(p.ws + SC_AA);
  const bf16_t* __restrict__ Gg = (const bf16_t*)(p.ws + SC_G);
  const bf16_t* __restrict__ O = (const bf16_t*)(p.ws + SC_O);
  bf16_t* __restrict__ U = (bf16_t*)(p.ws + W_U);
#pragma unroll 2
  for (int item = gw; item < T_ * 4; item += nw) {
    const int t = item >> 2, col = (item & 3) * 256 + lane * 4;
    const size_t o = (size_t)t * 1024 + col;
    float ov[4], rv[4], kv[4], av[4], vv[4], gv[4];
    unpack4(*(const uint2*)(O + o), ov); unpack4(*(const uint2*)(R + o), rv); unpack4(*(const uint2*)(K + o), kv);
    unpack4(*(const uint2*)(AAc + o), av); unpack4(*(const uint2*)(V + o), vv); unpack4(*(const uint2*)(Gg + o), gv);
    const float4 lw = *(const float4*)(p.in[I_RW_LNW] + col), lb = *(const float4*)(p.in[I_RW_LNB] + col);
    const float4 ka = *(const float4*)(p.in[I_RW_KA] + col), rk = *(const float4*)(p.in[I_RW_RK] + col);
    const float lwv[4] = {lw.x, lw.y, lw.z, lw.w}, lbv[4] = {lb.x, lb.y, lb.z, lb.w};
    const float kav[4] = {ka.x, ka.y, ka.z, ka.w}, rkv[4] = {rk.x, rk.y, rk.z, rk.w};
    const float mean = red_lanes<16>(ov[0] + ov[1] + ov[2] + ov[3]) * (1.f / 64.f);
    float d[4], s2 = 0.f, s3 = 0.f;
#pragma unroll
    for (int e = 0; e < 4; ++e) {
      d[e] = ov[e] - mean; s2 += d[e] * d[e];
      const float kp = kv[e] * (1.f + (av[e] - 1.f) * kav[e]);
      s3 += rv[e] * kp * rkv[e];
    }
    s2 = red_lanes<16>(s2); s3 = red_lanes<16>(s3);
    const float rs = rsqrtf(s2 * (1.f / 64.f) + 64e-5f);
    float y[4];
#pragma unroll
    for (int e = 0; e < 4; ++e) y[e] = (d[e] * rs * lwv[e] + lbv[e] + s3 * vv[e]) * gv[e];
    *(uint2*)(U + o) = make_uint2(pack2(y[0], y[1]), pack2(y[2], y[3]));
  }
}

constexpr int NPH = 40;
#ifndef REP_GEMM
#define REP_GEMM 1
#endif
#ifndef REP_SSD
#define REP_SSD 1
#endif
#ifndef REP_WKV
#define REP_WKV 1
#endif
#ifndef REP_MISC
#define REP_MISC 1
#endif

__global__ void __launch_bounds__(NTHR, 2) mega(Params p) {
  __shared__ __attribute__((aligned(16))) char smem[SMEM_BYTES];
  __shared__ uint4 xb_words;
  cg::grid_group grid = cg::this_grid();
  if (threadIdx.x == 0) xb_words = make_uint4(0u, 0u, 0u, 0u);
  __syncthreads();
  XcdBarrier xb = xcd_barrier_post((unsigned*)(p.ws + W_BAR), (volatile LAS unsigned*)&xb_words);
  int ph = 0;
#define PH(...)                                                     \
  {                                                                 \
    if (ph >= p.ph_begin && ph < p.ph_end) {                        \
      __VA_ARGS__;                                                  \
      xcd_barrier(xb);                                              \
    }                                                               \
    ++ph;                                                           \
  }
#define PHR(rep, ...)                                               \
  {                                                                 \
    if (ph >= p.ph_begin && ph < p.ph_end) {                        \
      for (int rep_ = 0; rep_ < (rep); ++rep_) {                    \
        __VA_ARGS__;                                                \
        xcd_barrier(xb);                                            \
      }                                                             \
    }                                                               \
    ++ph;                                                           \
  }
#define PH_LAST(...)                                                \
  {                                                                 \
    if (ph >= p.ph_begin && ph < p.ph_end) { __VA_ARGS__; }         \
    ++ph;                                                           \
  }
  bf16_t* wt = (bf16_t*)(p.ws + W_WT);
  bf16_t* U = (bf16_t*)(p.ws + W_U);
  float* X = (float*)(p.ws + W_X);

  {
    if (ph >= p.ph_begin && ph < p.ph_end) { ph_prologue(p, smem); grid.sync(); }
    ++ph;
    if (threadIdx.x == 0) {
      unsigned* bar = (unsigned*)(p.ws + W_BAR);
      unsigned base = 0;
      for (unsigned jx = 0; jx < 16; ++jx) { const unsigned c = xb_ld(&bar[XB_XCNT(jx)]); base += (jx < xb.x) ? c : 0u; }
      volatile LAS unsigned* st = (volatile LAS unsigned*)&xb_words;
      st[3] = base + st[2];
    }
    __syncthreads();
  }

#pragma nounroll
  for (int layer = 0; layer < 4; ++layer) {
    const int kind = layer % 3;
    PHR(REP_MISC, ph_rmsnorm(p, kind == 2 ? 1 : 0, p.in[I_NMIX] + layer * 1024));
    if (kind == 0) {
      const int ia = layer / 3;
      PHR(REP_GEMM, {
        GJob j = mkjob(U, 1024, wt + WA_IN + (size_t)ia * 2048 * 1024, 1024, 1024, 2048);
        j.o0 = p.ws + SA_XB; j.o1 = p.ws + SA_GT;
        int toff = 0; gemm_run<EPI_LRU_IN, false>(j, 8, toff, smem, VBLOCK());
      });
      PHR(REP_MISC, (ph_conv<1024, false>((const bf16_t*)(p.ws + SA_XB), (bf16_t*)(p.ws + SA_XC),
                               p.in[I_LRU_CW] + (size_t)ia * 4 * 1024, p.in[I_LRU_CB] + (size_t)ia * 1024,
                               p.in[I_ST_LC] + (size_t)ia * 128 * 3 * 1024,
                               p.out + O_LC_P + (size_t)ia * 8 * 3 * 1024, p.out + O_LC_S + (size_t)ia * 128 * 3 * 1024)));
      PHR(REP_GEMM, {
        const int G = gridDim.x;
        for (int tile = VBLOCK(); tile < MT_ * 8; tile += G) {
          const int mt = tile >> 3, jt = tile & 7;
          GJob j = mkjob((const bf16_t*)(p.ws + SA_XC) + jt * 128, 1024,
                         wt + WA_G + (size_t)ia * 2048 * 128, 128, 128, 2048);
          j.o0 = p.ws + SA_AA; j.o1 = p.ws + SA_XC;
          j.x0 = p.in[I_LRU_BR] + ia * 1024; j.x1 = p.in[I_LRU_BI] + ia * 1024; j.x2 = p.in[I_LRU_LAM] + ia * 1024;
          gemm_tile_dma<EPI_GATES>(j, mt * 128, jt * 256, 0, 4, smem);
        }
      });
      PHR(REP_MISC, ph_lru_scan1(p));
      PH(ph_lru_scan2(p, ia));
      PH({
        GJob j = mkjob((const bf16_t*)(p.ws + SA_GT), 1024, wt + WA_OUT + (size_t)ia * 1024 * 1024, 1024, 1024, 1024);
        j.o0 = X;
        int toff = 0; gemm_run<EPI_RESID, false>(j, 4, toff, smem, VBLOCK());
      });
    } else if (kind == 1) {
      PHR(REP_GEMM, {
        GJob j = mkjob(U, 1024, wt + WB_XBC, 1024, 1024, 4128);
        j.o0 = p.ws + SB_XBCP; j.o1 = p.ws + SB_DT; j.x0 = p.in[I_SSM_DTB];
        int toff = 0; gemm_run<EPI_SSM_XBC, false>(j, 17, toff, smem, VBLOCK());
      });
      PHR(REP_MISC, (ph_conv<4096, true>((const bf16_t*)(p.ws + SB_XBCP), (bf16_t*)(p.ws + SB_XBC),
                              p.in[I_SSM_CW], p.in[I_SSM_CB], p.in[I_ST_SC],
                              p.out + O_SC_P, p.out + O_SC_S)));
      PHR(REP_SSD, ph_ssd(p, smem));
      PH({
        GJob j = mkjob(U, 1024, wt + WB_Z, 1024, 1024, 2048);
        j.o0 = p.ws + SB_Y;
        int toff = 0; gemm_run<EPI_SSM_Z, false>(j, 8, toff, smem, VBLOCK());
      });
      PH(ph_gnorm(p));
      PH({
        GJob j = mkjob((const bf16_t*)(p.ws + SB_Y), 2048, wt + WB_OUT, 2048, 2048, 1024);
        j.o0 = X;
        gemm_streamk<EPI_RESID>(j, 4, smem, VBLOCK(), (unsigned*)(p.ws + W_BAR) + 4096, (unsigned)(layer * 2 + 1));
      });
    } else {
      PHR(REP_GEMM, {
        int toff = 0;
        for (int s = 0; s < 3; ++s) {
          GJob j = mkjob(U, 1024, wt + WC_RKV + (size_t)s * 1024 * 1024, 1024, 1024, 1024);
          j.A2 = (const bf16_t*)(p.ws + SC_UP); j.mu = p.in[I_RW_MU] + s * 1024;
          j.o0 = p.ws + SC_R + (size_t)s * SZ_TD2; j.ldo = 1024; j.act = 0;
          gemm_run<EPI_ST, true>(j, 8, toff, smem, VBLOCK());
        }
        for (int s = 0; s < 3; ++s) {
          const int nv = (s == 2) ? 128 : 64;
          GJob j = mkjob(U, 1024, wt + WC_L1 + (size_t)s * 64 * 1024, 1024, 1024, nv);
          j.A2 = (const bf16_t*)(p.ws + SC_UP); j.mu = p.in[I_RW_MU] + (3 + s) * 1024;
          j.o0 = p.ws + SC_LH + (size_t)s * 64 * 2; j.ldo = 256; j.act = (s == 0) ? 1 : (s == 2 ? 2 : 0);
          gemm_run<EPI_ST, true>(j, 1, toff, smem, VBLOCK());
        }
      });
      PHR(REP_GEMM, {
        int toff = 0;
        const bf16_t* LH = (const bf16_t*)(p.ws + SC_LH);
        {
          GJob j = mkjob(LH, 256, wt + WC_W2, 64, 64, 1024);
          j.o0 = p.ws + SC_WD; j.x0 = p.in[I_RW_W0];
          gemm_run<EPI_DECAY, false>(j, 4, toff, smem, VBLOCK());
        }
        {
          GJob j = mkjob(LH + 64, 256, wt + WC_A2, 64, 64, 1024);
          j.o0 = p.ws + SC_AA; j.x0 = p.in[I_RW_A0];
          gemm_run<EPI_SIGB, false>(j, 4, toff, smem, VBLOCK());
        }
        {
          GJob j = mkjob(LH + 128, 256, wt + WC_G2, 128, 128, 1024);
          j.o0 = p.ws + SC_G; j.ldo = 1024; j.act = 0;
          gemm_run<EPI_ST, false>(j, 4, toff, smem, VBLOCK());
        }
      });
      PHR(REP_WKV, ph_wkv<8>(p, smem));
      PHR(REP_MISC, ph_wkv_post(p));
      PH({
        GJob j = mkjob(U, 1024, wt + WC_OUT, 1024, 1024, 1024);
        j.o0 = X;
        int toff = 0; gemm_run<EPI_RESID, false>(j, 4, toff, smem, VBLOCK());
      });
    }
    PHR(REP_MISC, ph_rmsnorm(p, 0, p.in[I_NFFN] + layer * 1024));
    PHR(REP_GEMM, {
      GJob j = mkjob(U, 1024, wt + WF_1 + (size_t)layer * 4096 * 1024, 1024, 1024, 4096);
      j.o0 = p.ws + S_HB;
      int toff = 0; gemm_run<EPI_FFN1, false>(j, 16, toff, smem, VBLOCK());
    });
    PH({
      GJob j = mkjob((const bf16_t*)(p.ws + S_HB), 4096, wt + WF_2 + (size_t)layer * 4096 * 1024, 4096, 4096, 1024);
      j.o0 = X;
      gemm_streamk<EPI_RESID>(j, 4, smem, VBLOCK(), (unsigned*)(p.ws + W_BAR) + 4096, (unsigned)(layer * 2 + 2));
    });
  }
  PH_LAST(ph_rmsnorm(p, 2, p.in[I_NFIN]));
#undef PH
#undef PH_LAST
}

extern "C" void kernel_launch(void* const* d_in, const int* in_sizes, int n_in, void* d_out, int out_size,
                              void* d_ws, size_t ws_size, hipStream_t stream) {
  Params p;
  memset(&p, 0, sizeof(p));
  for (int i = 0; i < N_IN; ++i) p.in[i] = (const float*)d_in[i];
  p.out = (float*)d_out;
  p.ws = (char*)d_ws;
  p.ph_begin = 0;
  p.ph_end = 1000;
  static int grid_blocks = 0;
  if (!grid_blocks) {
    int dev = 0, cus = 0, per_cu = 0;
    hipGetDevice(&dev);
    hipDeviceGetAttribute(&cus, hipDeviceAttributeMultiprocessorCount, dev);
    hipOccupancyMaxActiveBlocksPerMultiprocessor(&per_cu, mega, NTHR, 0);
    if (per_cu > 2) per_cu = 2;
    if (per_cu < 1) per_cu = 1;
    grid_blocks = cus * per_cu;
  }
  if (ws_size < (size_t)536870912) fprintf(stderr, "workspace too small: %zu\n", ws_size);
  (void)hipMemsetAsync((char*)d_ws + W_BAR, 0, (4096 + 1024) * 4, stream);
  void* args[] = {&p};
  hipError_t e = hipLaunchCooperativeKernel((void*)mega, dim3(grid_blocks), dim3(NTHR), args, 0, stream);
  if (e != hipSuccess) fprintf(stderr, "cooperative launch failed: %s (grid %d)\n", hipGetErrorString(e), grid_blocks);
}
```

```cpp
#include <hip/hip_runtime.h>
#include <hip/hip_cooperative_groups.h>
#include <stdint.h>
#include <stdio.h>
#include <string.h>
namespace cg = cooperative_groups;

typedef unsigned short bf16_t;
typedef __attribute__((ext_vector_type(8))) short bf16x8;
typedef __attribute__((ext_vector_type(16))) float f32x16;

#define DI __device__ __forceinline__

constexpr int T_ = 17408;
constexpr int TP_ = 16384;
constexpr int NTHR = 256;
constexpr int MT_ = T_ / 128;

enum {
  I_XP = 0, I_XS, I_ST_LC, I_ST_LH, I_ST_SC, I_ST_SS, I_ST_RS, I_ST_RW,
  I_NMIX, I_NFFN, I_NFIN,
  I_LRU_WIN, I_LRU_CW, I_LRU_CB, I_LRU_WR, I_LRU_BR, I_LRU_WI, I_LRU_BI, I_LRU_LAM, I_LRU_WOUT,
  I_SSM_WIN, I_SSM_CW, I_SSM_CB, I_SSM_DTB, I_SSM_ALOG, I_SSM_D, I_SSM_NW, I_SSM_WOUT,
  I_RW_MU, I_RW_WRKV, I_RW_W0, I_RW_WW1, I_RW_WW2, I_RW_A0, I_RW_WA1, I_RW_WA2, I_RW_WG1, I_RW_WG2,
  I_RW_KK, I_RW_KA, I_RW_RK, I_RW_LNW, I_RW_LNB, I_RW_WOUT,
  I_FFN_W1, I_FFN_W2, N_IN
};

constexpr size_t O_Y = 0;
constexpr size_t O_LC_P = O_Y + (size_t)T_ * 1024;
constexpr size_t O_LC_S = O_LC_P + 2 * 8 * 3 * 1024;
constexpr size_t O_LH_P = O_LC_S + 2 * 128 * 3 * 1024;
constexpr size_t O_LH_S = O_LH_P + 2 * 8 * 1024;
constexpr size_t O_SC_P = O_LH_S + 2 * 128 * 1024;
constexpr size_t O_SC_S = O_SC_P + 8 * 3 * 4096;
constexpr size_t O_SS_P = O_SC_S + 128 * 3 * 4096;
constexpr size_t O_SS_S = O_SS_P + (size_t)8 * 32 * 64 * 128;
constexpr size_t O_RS_P = O_SS_S + (size_t)128 * 32 * 64 * 128;
constexpr size_t O_RS_S = O_RS_P + 8 * 1024;
constexpr size_t O_RW_P = O_RS_S + 128 * 1024;
constexpr size_t O_RW_S = O_RW_P + 8 * 16 * 64 * 64;

constexpr size_t W_X = 0;
constexpr size_t W_U = W_X + (size_t)T_ * 1024 * 4;
constexpr size_t W_WT = W_U + (size_t)T_ * 1024 * 2;
constexpr size_t WA_IN = 0;
constexpr size_t WA_G = WA_IN + 2 * 2048 * 1024;
constexpr size_t WA_OUT = WA_G + 2 * 2048 * 128;
constexpr size_t WB_XBC = WA_OUT + 2 * 1024 * 1024;
constexpr size_t WB_Z = WB_XBC + 4128 * 1024;
constexpr size_t WB_OUT = WB_Z + 2048 * 1024;
constexpr size_t WC_RKV = WB_OUT + 1024 * 2048;
constexpr size_t WC_L1 = WC_RKV + 3 * 1024 * 1024;
constexpr size_t WC_W2 = WC_L1 + 256 * 1024;
constexpr size_t WC_A2 = WC_W2 + 1024 * 64;
constexpr size_t WC_G2 = WC_A2 + 1024 * 64;
constexpr size_t WC_OUT = WC_G2 + 1024 * 128;
constexpr size_t WF_1 = WC_OUT + 1024 * 1024;
constexpr size_t WF_2 = WF_1 + (size_t)4 * 4096 * 1024;
constexpr size_t W_WT_ELEMS = WF_2 + (size_t)4 * 4096 * 1024;
constexpr size_t W_S = W_WT + W_WT_ELEMS * 2;
constexpr size_t SZ_TD2 = (size_t)T_ * 1024 * 2;
constexpr size_t SZ_TD4 = (size_t)T_ * 1024 * 4;
constexpr size_t S_HB = W_S;
constexpr size_t SA_XB = W_S;
constexpr size_t SA_GT = SA_XB + SZ_TD2;
constexpr size_t SA_XC = SA_GT + SZ_TD2;
constexpr size_t SA_AA = SA_XC + SZ_TD2;
constexpr size_t SA_BB = SA_AA + SZ_TD4;
constexpr size_t SA_CP = SA_BB + SZ_TD4;
constexpr size_t SA_CS = SA_CP + 8 * 64 * 1024 * 4;
constexpr size_t SB_XBCP = W_S;
constexpr size_t SB_Y = W_S;
constexpr size_t SB_XBC = SB_XBCP + SZ_TD2 * 4;
constexpr size_t SB_DT = SB_XBC + SZ_TD2 * 4;
constexpr size_t SC_UP = W_S;
constexpr size_t SC_O = W_S;
constexpr size_t SC_R = SC_UP + SZ_TD2;
constexpr size_t SC_K = SC_R + SZ_TD2;
constexpr size_t SC_V = SC_K + SZ_TD2;
constexpr size_t SC_LH = SC_V + SZ_TD2;
constexpr size_t SC_WD = SC_LH + (size_t)T_ * 256 * 2;
constexpr size_t SC_AA = SC_WD + SZ_TD4;
constexpr size_t SC_G = SC_AA + SZ_TD2;
constexpr size_t SC_END = SC_G + SZ_TD2;
static_assert(SC_END <= (size_t)536870912, "ws overflow C");
static_assert(SB_DT + (size_t)T_ * 32 * 4 <= (size_t)536870912, "ws overflow B");
static_assert(SA_CS + 8 * 64 * 1024 * 4 <= (size_t)536870912, "ws overflow A");

constexpr int SMEM_BYTES = 80384;
constexpr size_t W_BAR = (size_t)536870912 - 65536;

struct Params {
  const float* in[N_IN];
  float* out;
  char* ws;
  int ph_begin, ph_end;
};

DI float bf2f(bf16_t h) { return __uint_as_float(((unsigned)h) << 16); }
DI bf16_t f2bf(float f) {
  unsigned u = __float_as_uint(f);
  u += 0x7FFFu + ((u >> 16) & 1u);
  return (bf16_t)(u >> 16);
}
DI unsigned pack2(float a, float b) { return (unsigned)f2bf(a) | ((unsigned)f2bf(b) << 16); }
DI void unpack8(const uint4 v, float (&f)[8]) {
  f[0] = __uint_as_float(v.x << 16); f[1] = __uint_as_float(v.x & 0xFFFF0000u);
  f[2] = __uint_as_float(v.y << 16); f[3] = __uint_as_float(v.y & 0xFFFF0000u);
  f[4] = __uint_as_float(v.z << 16); f[5] = __uint_as_float(v.z & 0xFFFF0000u);
  f[6] = __uint_as_float(v.w << 16); f[7] = __uint_as_float(v.w & 0xFFFF0000u);
}
DI void unpack4(const uint2 v, float (&f)[4]) {
  f[0] = __uint_as_float(v.x << 16); f[1] = __uint_as_float(v.x & 0xFFFF0000u);
  f[2] = __uint_as_float(v.y << 16); f[3] = __uint_as_float(v.y & 0xFFFF0000u);
}
DI uint4 pack8(const float (&f)[8]) {
  return make_uint4(pack2(f[0], f[1]), pack2(f[2], f[3]), pack2(f[4], f[5]), pack2(f[6], f[7]));
}
DI void load8f(const float* p, float (&f)[8]) {
  float4 a = *(const float4*)p, b = *(const float4*)(p + 4);
  f[0] = a.x; f[1] = a.y; f[2] = a.z; f[3] = a.w; f[4] = b.x; f[5] = b.y; f[6] = b.z; f[7] = b.w;
}
DI void store8f(float* p, const float (&f)[8]) {
  *(float4*)p = make_float4(f[0], f[1], f[2], f[3]);
  *(float4*)(p + 4) = make_float4(f[4], f[5], f[6], f[7]);
}
DI float sigmoidf_(float x) { return 1.f / (1.f + __expf(-x)); }
DI float siluf_(float x) { return x / (1.f + __expf(-x)); }
DI float tanhf_(float y) { return 1.f - 2.f / (1.f + __expf(2.f * y)); }
DI float geluf_(float x) { return 0.5f * x * (1.f + tanhf_(0.7978845608028654f * (x + 0.044715f * x * x * x))); }
DI float softplusf_(float x) { return fmaxf(x, 0.f) + log1pf(__expf(-fabsf(x))); }
DI float softplus_fast(float x) { return fmaxf(x, 0.f) + __logf(1.f + __expf(-fabsf(x))); }
DI float wave_sum(float v) {
#pragma unroll
  for (int o = 32; o >= 1; o >>= 1) v += __shfl_xor(v, o, 64);
  return v;
}
template <int CTRL> DI float dppf(float x) {
  return __int_as_float(__builtin_amdgcn_update_dpp(0, __float_as_int(x), CTRL, 0xf, 0xf, false));
}
template <int N> DI float red_lanes(float x) {
  x += dppf<0xB1>(x);
  x += dppf<0x4E>(x);
  if (N >= 8) x += dppf<0x141>(x);
  if (N >= 16) x += dppf<0x140>(x);
  return x;
}
DI void tok_info(int t, int& seq, int& l, int& L) {
  if (t < TP_) { seq = t >> 11; l = t & 2047; L = 2048; }
  else { int u = t - TP_; seq = 8 + (u >> 3); l = u & 7; L = 8; }
}
DI int opq(int x) { asm volatile("" : "+v"(x)); return x; }
#define TIDX opq((int)threadIdx.x)
DI f32x16 mfma32(bf16x8 a, bf16x8 b, f32x16 c) { return __builtin_amdgcn_mfma_f32_32x32x16_bf16(a, b, c, 0, 0, 0); }


#define XB_TMO      128
#define XB_XCNT(j)  (256  + 64 * (j))
#define XB_XSUB(j)  (1280 + 64 * (j))
#define XB_XGEN(j)  (2304 + 64 * (j))
#define XB_TOP      3328
#define XB_TOPGEN   3392
#define XCD_BAR_WORDS 3456
#define XB_SPIN_CAP (1u << 22)
#define LAS __attribute__((address_space(3)))
DI unsigned xb_ld(unsigned* p) { return __hip_atomic_load(p, __ATOMIC_RELAXED, __HIP_MEMORY_SCOPE_AGENT); }
DI unsigned xb_add(unsigned* p, unsigned v) { return __hip_atomic_fetch_add(p, v, __ATOMIC_RELAXED, __HIP_MEMORY_SCOPE_AGENT); }
DI unsigned xb_xcc_id() { return (unsigned)__builtin_amdgcn_s_getreg((3 << 11) | 20) & 0xFu; }
#define XB_SPIN(cond, bar) do { unsigned _sp = 0; while (cond) { __builtin_amdgcn_s_sleep(1); \
    if ((++_sp & 255u) == 0u) { if (xb_ld(&(bar)[XB_TMO])) break; if (_sp > XB_SPIN_CAP) { atomicAdd(&(bar)[XB_TMO], 1u); break; } } } } while (0)
struct XcdBarrier { unsigned* bar; unsigned x; volatile LAS unsigned* st; };
DI XcdBarrier xcd_barrier_post(unsigned* bar, volatile LAS unsigned* st) {
  XcdBarrier b; b.bar = bar; b.x = xb_xcc_id(); b.st = st;
  if (threadIdx.x == 0) st[2] = xb_add(&bar[XB_XCNT(b.x)], 1u);
  return b;
}
DI void xcd_barrier_complete(unsigned* bar, unsigned x, unsigned& nloc, unsigned& nx) {
  const unsigned G = gridDim.x * gridDim.y * gridDim.z;
  unsigned sum, cnt, mine, sp = 0u;
  for (;;) {
    sum = 0u; cnt = 0u; mine = 0u;
#pragma unroll
    for (unsigned j = 0; j < 16; ++j) { const unsigned c = xb_ld(&bar[XB_XCNT(j)]); sum += c; cnt += (c > 0u) ? 1u : 0u; mine = (j == x) ? c : mine; }
    if (sum == G) break;
    __builtin_amdgcn_s_sleep(1);
    if ((++sp & 255u) == 0u) { if (xb_ld(&bar[XB_TMO])) break; if (sp > XB_SPIN_CAP) { atomicAdd(&bar[XB_TMO], 1u); break; } }
  }
  nloc = mine > 0u ? mine : 1u; nx = cnt > 0u ? cnt : 1u;
}
DI void xcd_barrier(const XcdBarrier& b) {
  asm volatile("s_waitcnt vmcnt(0)" ::: "memory");
  __syncthreads();
  if (threadIdx.x == 0) {
    unsigned* bar = b.bar;
    __builtin_amdgcn_s_waitcnt(0);
    unsigned nloc = b.st[0], nx = b.st[1];
    if (nloc == 0u) { xcd_barrier_complete(bar, b.x, nloc, nx); b.st[0] = nloc; b.st[1] = nx; }
    const unsigned old = xb_add(&bar[XB_XSUB(b.x)], 1u);
    const unsigned gen = old / nloc;
    if (old + 1u == (gen + 1u) * nloc) {
      __builtin_amdgcn_fence(__ATOMIC_RELEASE, "agent");
      asm volatile("s_waitcnt vmcnt(0)" ::: "memory");
      const unsigned og = xb_add(&bar[XB_TOP], 1u);
      const unsigned tg = og / nx;
      if (og + 1u == (tg + 1u) * nx) xb_add(&bar[XB_TOPGEN], 1u);
      else XB_SPIN(xb_ld(&bar[XB_TOPGEN]) == tg, bar);
      __builtin_amdgcn_fence(__ATOMIC_ACQUIRE, "agent");
      xb_add(&bar[XB_XGEN(b.x)], 1u);
      asm volatile("s_waitcnt vmcnt(0)" ::: "memory");
    } else {
      XB_SPIN(xb_ld(&bar[XB_XGEN(b.x)]) == gen, bar);
      __builtin_amdgcn_fence(__ATOMIC_ACQUIRE, "agent");
      asm volatile("s_waitcnt vmcnt(0)" ::: "memory");
    }
  }
  __syncthreads();
}

struct GJob {
  const bf16_t* A; const bf16_t* A2; const float* mu; const bf16_t* Bt;
  int lda, ldb, K, nvalid;
  void* o0; void* o1; const float* x0; const float* x1; const float* x2;
  int ldo, act;
};
enum { EPI_LRU_IN = 0, EPI_GATES, EPI_RESID, EPI_SSM_XBC, EPI_SSM_Z, EPI_FFN1, EPI_ST, EPI_DECAY, EPI_SIGB };

template <int EPI> DI void epi_elem(const GJob& j, int row, int col, float v) {
  if (EPI == EPI_LRU_IN) {
    if (col < 1024) ((bf16_t*)j.o0)[(size_t)row * 1024 + col] = f2bf(v);
    else ((bf16_t*)j.o1)[(size_t)row * 1024 + col - 1024] = f2bf(geluf_(v));
  } else if (EPI == EPI_RESID) {
    unsafeAtomicAdd((float*)j.o0 + (size_t)row * 1024 + col, v);
  } else if (EPI == EPI_SSM_XBC) {
    if (col < 4096) ((bf16_t*)j.o0)[(size_t)row * 4096 + col] = f2bf(v);
  } else if (EPI == EPI_SSM_Z) {
    bf16_t* y = (bf16_t*)j.o0 + (size_t)row * 2048 + col;
    *y = f2bf(bf2f(*y) * siluf_(v));
  } else if (EPI == EPI_FFN1) {
    float r = fmaxf(v, 0.f);
    ((bf16_t*)j.o0)[(size_t)row * 4096 + col] = f2bf(r * r);
  } else if (EPI == EPI_ST) {
    if (col < j.nvalid) {
      float r = v;
      if (j.act == 1) r = tanhf_(v); else if (j.act == 2) r = sigmoidf_(v);
      ((bf16_t*)j.o0)[(size_t)row * j.ldo + col] = f2bf(r);
    }
  } else if (EPI == EPI_DECAY) {
    float wl = -softplusf_(-(j.x0[col] + v)) - 0.5f;
    ((float*)j.o0)[(size_t)row * 1024 + col] = __expf(-__expf(wl));
  } else if (EPI == EPI_SIGB) {
    ((bf16_t*)j.o0)[(size_t)row * 1024 + col] = f2bf(sigmoidf_(j.x0[col] + v));
  }
}

DI void quad_transpose4(float (&v)[4], int l) {
  const bool o1 = l & 1, o2 = l & 2;
  {
    const float s01 = o1 ? v[0] : v[1], s23 = o1 ? v[2] : v[3];
    const float r01 = dppf<0xB1>(s01), r23 = dppf<0xB1>(s23);
    if (o1) { v[0] = r01; v[2] = r23; } else { v[1] = r01; v[3] = r23; }
  }
  {
    const float s02 = o2 ? v[0] : v[2], s13 = o2 ? v[1] : v[3];
    const float r02 = dppf<0x4E>(s02), r13 = dppf<0x4E>(s13);
    if (o2) { v[0] = r02; v[1] = r13; } else { v[2] = r02; v[3] = r13; }
  }
}
DI uint2 pack4(float a, float b, float c, float d) { return make_uint2(pack2(a, b), pack2(c, d)); }
template <int EPI> DI void epi4(const GJob& j, int row, int col, const float (&v)[4]) {
  if (EPI == EPI_LRU_IN) {
    if (col < 1024) *(uint2*)((bf16_t*)j.o0 + (size_t)row * 1024 + col) = pack4(v[0], v[1], v[2], v[3]);
    else *(uint2*)((bf16_t*)j.o1 + (size_t)row * 1024 + col - 1024) = pack4(geluf_(v[0]), geluf_(v[1]), geluf_(v[2]), geluf_(v[3]));
  } else if (EPI == EPI_RESID) {
    float4* x = (float4*)((float*)j.o0 + (size_t)row * 1024 + col);
    float4 t = *x; t.x += v[0]; t.y += v[1]; t.z += v[2]; t.w += v[3]; *x = t;
  } else if (EPI == EPI_SSM_XBC) {
    if (col < 4096) *(uint2*)((bf16_t*)j.o0 + (size_t)row * 4096 + col) = pack4(v[0], v[1], v[2], v[3]);
  } else if (EPI == EPI_SSM_Z) {
    uint2* y = (uint2*)((bf16_t*)j.o0 + (size_t)row * 2048 + col);
    float f[4]; unpack4(*y, f);
    *y = pack4(f[0] * siluf_(v[0]), f[1] * siluf_(v[1]), f[2] * siluf_(v[2]), f[3] * siluf_(v[3]));
  } else if (EPI == EPI_FFN1) {
    const float r0 = fmaxf(v[0], 0.f), r1 = fmaxf(v[1], 0.f), r2 = fmaxf(v[2], 0.f), r3 = fmaxf(v[3], 0.f);
    *(uint2*)((bf16_t*)j.o0 + (size_t)row * 4096 + col) = pack4(r0 * r0, r1 * r1, r2 * r2, r3 * r3);
  } else if (EPI == EPI_ST) {
    if (col < j.nvalid) {
      float r[4];
#pragma unroll
      for (int e = 0; e < 4; ++e) r[e] = (j.act == 1) ? tanhf_(v[e]) : ((j.act == 2) ? sigmoidf_(v[e]) : v[e]);
      *(uint2*)((bf16_t*)j.o0 + (size_t)row * j.ldo + col) = pack4(r[0], r[1], r[2], r[3]);
    }
  } else if (EPI == EPI_DECAY) {
    const float4 w0 = *(const float4*)(j.x0 + col);
    const float w[4] = {w0.x, w0.y, w0.z, w0.w};
    float r[4];
#pragma unroll
    for (int e = 0; e < 4; ++e) r[e] = __expf(-__expf(-softplus_fast(-(w[e] + v[e])) - 0.5f));
    *(float4*)((float*)j.o0 + (size_t)row * 1024 + col) = make_float4(r[0], r[1], r[2], r[3]);
  } else if (EPI == EPI_SIGB) {
    const float4 a0 = *(const float4*)(j.x0 + col);
    *(uint2*)((bf16_t*)j.o0 + (size_t)row * 1024 + col) =
        pack4(sigmoidf_(a0.x + v[0]), sigmoidf_(a0.y + v[1]), sigmoidf_(a0.z + v[2]), sigmoidf_(a0.w + v[3]));
  }
}

template <int EPI, bool MIX>
DI void gemm_tile(const GJob& j, int m0, int n0, int kt0, int kt1, char* smem) {
  const int tid = TIDX, lane = tid & 63, w = tid >> 6;
  const int wm = w >> 1, wn = w & 1, r32 = lane & 31, hh = lane >> 5;
  const int lrow = tid >> 3, kc = tid & 7;
  f32x16 acc[2][2];
#pragma unroll
  for (int a = 0; a < 2; ++a)
#pragma unroll
    for (int b = 0; b < 2; ++b)
#pragma unroll
      for (int r = 0; r < 16; ++r) acc[a][b][r] = 0.f;
  uint4 qa00, qa01, qa02, qa03, qb00, qb01, qb02, qb03, qc00, qc01, qc02, qc03;
  uint4 qa10, qa11, qa12, qa13, qb10, qb11, qb12, qb13, qc10, qc11, qc12, qc13;
  qc00 = qc01 = qc02 = qc03 = qc10 = qc11 = qc12 = qc13 = make_uint4(0, 0, 0, 0);
  const int nk = kt1 - kt0;
  const bf16_t* Ap = j.A + (size_t)(m0 + lrow) * j.lda + kc * 8 + (size_t)kt0 * 64;
  const bf16_t* A2p = MIX ? (j.A2 + (size_t)(m0 + lrow) * j.lda + kc * 8 + (size_t)kt0 * 64) : nullptr;
  const bf16_t* Bp = j.Bt + (size_t)(n0 + lrow) * j.ldb + kc * 8 + (size_t)kt0 * 64;
  const size_t astep = (size_t)32 * j.lda, bstep = (size_t)32 * j.ldb;
  const bool bv0 = (n0 + lrow) < j.nvalid, bv1 = (n0 + lrow + 32) < j.nvalid;
  const bool bv2 = (n0 + lrow + 64) < j.nvalid, bv3 = (n0 + lrow + 96) < j.nvalid;
  const uint4 z4 = make_uint4(0, 0, 0, 0);

#define LD1(s, i, kt)                                                                 \
  qa##s##i = *(const uint4*)(Ap + i * astep + (kt) * 64);                             \
  if (MIX) qc##s##i = *(const uint4*)(A2p + i * astep + (kt) * 64);                   \
  qb##s##i = z4;                                                                      \
  if (bv##i) qb##s##i = *(const uint4*)(Bp + i * bstep + (kt) * 64);
#define GLOAD(s, kt) { LD1(s, 0, kt) LD1(s, 1, kt) LD1(s, 2, kt) LD1(s, 3, kt) }
#define ST1(s, i, As_, Bs_)                                                           \
  if (MIX) {                                                                          \
    float f1[8], f2[8]; unpack8(qa##s##i, f1); unpack8(qc##s##i, f2);                 \
    _Pragma("unroll") for (int e = 0; e < 8; ++e) f1[e] = f1[e] + (f2[e] - f1[e]) * mu8[e]; \
    qa##s##i = pack8(f1);                                                             \
  }                                                                                   \
  *(uint4*)(As_ + (lrow + 32 * i) * 144 + kc * 16) = qa##s##i;                        \
  *(uint4*)(Bs_ + (lrow + 32 * i) * 144 + kc * 16) = qb##s##i;
#define SSTORE(s, kt, buf)                                                            \
  {                                                                                   \
    char* As_ = smem + (buf) * 36864; char* Bs_ = As_ + 18432;                        \
    float mu8[8];                                                                     \
    if (MIX) load8f(j.mu + (kt0 + (kt)) * 64 + kc * 8, mu8);                          \
    ST1(s, 0, As_, Bs_) ST1(s, 1, As_, Bs_) ST1(s, 2, As_, Bs_) ST1(s, 3, As_, Bs_)   \
  }
#define LOADF(F, ks)                                                                  \
  bf16x8 F##a0 = *(const bf16x8*)(ap + (ks) * 32);                                    \
  bf16x8 F##a1 = *(const bf16x8*)(ap + 32 * 144 + (ks) * 32);                         \
  bf16x8 F##b0 = *(const bf16x8*)(bp + (ks) * 32);                                    \
  bf16x8 F##b1 = *(const bf16x8*)(bp + 32 * 144 + (ks) * 32);
#define MFMA4(F)                                                                      \
  acc[0][0] = mfma32(F##a0, F##b0, acc[0][0]);                                        \
  acc[0][1] = mfma32(F##a0, F##b1, acc[0][1]);                                        \
  acc[1][0] = mfma32(F##a1, F##b0, acc[1][0]);                                        \
  acc[1][1] = mfma32(F##a1, F##b1, acc[1][1]);
#define COMPUTE(buf)                                                                  \
  {                                                                                   \
    const char* As_ = smem + (buf) * 36864; const char* Bs_ = As_ + 18432;            \
    const char* ap = As_ + (wm * 64 + r32) * 144 + hh * 16;                           \
    const char* bp = Bs_ + (wn * 64 + r32) * 144 + hh * 16;                           \
    LOADF(f0, 0) LOADF(f1, 1)                                                         \
    __builtin_amdgcn_sched_barrier(0);                                                \
    MFMA4(f0)                                                                         \
    LOADF(f2, 2)                                                                      \
    __builtin_amdgcn_sched_barrier(0);                                                \
    MFMA4(f1)                                                                         \
    LOADF(f3, 3)                                                                      \
    __builtin_amdgcn_sched_barrier(0);                                                \
    MFMA4(f2)                                                                         \
    __builtin_amdgcn_sched_barrier(0);                                                \
    MFMA4(f3)                                                                         \
    __builtin_amdgcn_sched_barrier(0);                                                \
  }

  qa10 = qa11 = qa12 = qa13 = qb10 = qb11 = qb12 = qb13 = z4;
  if (MIX) {
    GLOAD(0, 0);
    SSTORE(0, 0, 0);
    __syncthreads();
    for (int i = 0; i < nk; ++i) {
      if (i + 1 < nk) GLOAD(0, i + 1);
      if (i & 1) { COMPUTE(1); } else { COMPUTE(0); }
      if (i + 1 < nk) { if (i & 1) { SSTORE(0, i + 1, 0); } else { SSTORE(0, i + 1, 1); } }
      __syncthreads();
    }
  } else if (nk == 1) {
    GLOAD(0, 0);
    SSTORE(0, 0, 0);
    __syncthreads();
    COMPUTE(0);
    __syncthreads();
  } else {
    GLOAD(0, 0);
    GLOAD(1, 1);
    SSTORE(0, 0, 0);
    __syncthreads();
#pragma unroll 1
    for (int i = 0; i + 2 < nk; i += 2) {
      GLOAD(0, i + 2);
      COMPUTE(0);
      SSTORE(1, i + 1, 1);
      __syncthreads();
      GLOAD(1, i + 3);
      COMPUTE(1);
      SSTORE(0, i + 2, 0);
      __syncthreads();
    }
    COMPUTE(0);
    SSTORE(1, nk - 1, 1);
    __syncthreads();
    COMPUTE(1);
    __syncthreads();
  }
#undef LD1
#undef ST1
#undef LOADF
#undef MFMA4
#undef GLOAD
#undef SSTORE
#undef COMPUTE

  if (EPI == EPI_GATES) {
    const int ch = (n0 >> 7) * 64 + wn * 32 + r32;
    const float br = j.x0[ch], bi = j.x1[ch];
    const float spl = softplusf_(-j.x2[ch]);
    const bf16_t* XC = (const bf16_t*)j.o1;
    float* AA = (float*)j.o0;
    float* BBp = AA + (size_t)T_ * 1024;
#pragma unroll
    for (int mi = 0; mi < 2; ++mi)
#pragma unroll
      for (int r = 0; r < 16; ++r) {
        const int row = m0 + wm * 64 + mi * 32 + (r & 3) + 8 * (r >> 2) + 4 * hh;
        const float rg = sigmoidf_(acc[mi][0][r] + br);
        const float ig = sigmoidf_(acc[mi][1][r] + bi);
        const float la = -8.f * rg * spl;
        const float xc = bf2f(XC[(size_t)row * 1024 + ch]);
        const bool reset = (row < TP_) && ((row & 2047) == 0);
        const float a = reset ? 0.f : __expf(la);
        const float mult = reset ? 1.f : sqrtf(fmaxf(-expm1f(2.f * la), 0.f));
        AA[(size_t)row * 1024 + ch] = a;
        BBp[(size_t)row * 1024 + ch] = mult * ig * xc;
      }
  } else {
#pragma unroll
    for (int mi = 0; mi < 2; ++mi)
#pragma unroll
      for (int ni = 0; ni < 2; ++ni)
#pragma unroll
        for (int r = 0; r < 16; ++r) {
          const int row = m0 + wm * 64 + mi * 32 + (r & 3) + 8 * (r >> 2) + 4 * hh;
          const int col = n0 + wn * 64 + ni * 32 + r32;
          epi_elem<EPI>(j, row, col, acc[mi][ni][r]);
          if ((r & 7) == 7) __builtin_amdgcn_sched_barrier(0);
        }
  }
}

constexpr int DSLOT = 24576;
template <int EPI>
DI void gemm_tile_dma(const GJob& j, int m0, int n0, int k0, int k1, char* smem, unsigned* wflag = nullptr, unsigned epoch = 0u) {
  const int tid = TIDX, lane = tid & 63, w = tid >> 6;
  const int wm = w >> 1, wn = w & 1, r32 = lane & 31, hh = lane >> 5;
  f32x16 acc[2][4];
#pragma unroll
  for (int a = 0; a < 2; ++a)
#pragma unroll
    for (int b = 0; b < 4; ++b)
#pragma unroll
      for (int r = 0; r < 16; ++r) acc[a][b][r] = 0.f;
  const int nk = k1 - k0;
  const int dr = lane >> 2;
  const int dc = (lane & 3) ^ ((lane >> 4) & 3);
  const int nlim = j.nvalid - 1;
  const size_t kofs = (size_t)k0 * 32 + dc * 8;
  const bf16_t* gA0 = j.A + (size_t)(m0 + 32 * w + dr) * j.lda + kofs;
  const bf16_t* gA1 = j.A + (size_t)(m0 + 32 * w + 16 + dr) * j.lda + kofs;
  const bf16_t* gB0 = j.Bt + (size_t)min(n0 + 64 * w + dr, nlim) * j.ldb + kofs;
  const bf16_t* gB1 = j.Bt + (size_t)min(n0 + 64 * w + 16 + dr, nlim) * j.ldb + kofs;
  const bf16_t* gB2 = j.Bt + (size_t)min(n0 + 64 * w + 32 + dr, nlim) * j.ldb + kofs;
  const bf16_t* gB3 = j.Bt + (size_t)min(n0 + 64 * w + 48 + dr, nlim) * j.ldb + kofs;
  char* ldsA = smem + (2 * w) * 1024 + lane * 16;
  char* ldsB = smem + 8192 + (4 * w) * 1024 + lane * 16;
  const unsigned lbase = (unsigned)(unsigned long long)(LAS char*)smem;
  const int fsw = (r32 >> 2) & 3;
  const unsigned pa = (unsigned)((wm * 64 + r32) * 64), pb = (unsigned)(8192 + (wn * 128 + r32) * 64);
  const unsigned po0 = (unsigned)(((hh) ^ fsw) * 16), po1 = (unsigned)(((2 + hh) ^ fsw) * 16);

#define DMA1(gp, lp) __builtin_amdgcn_global_load_lds((const unsigned*)(gp), (unsigned*)(lp), 16, 0, 0)
#define ISSUE(kt, slot)                                                                          \
  {                                                                                              \
    const int ko_ = (kt) * 32;                                                                   \
    char* la_ = ldsA + (slot) * DSLOT; char* lb_ = ldsB + (slot) * DSLOT;                        \
    DMA1(gA0 + ko_, la_); DMA1(gA1 + ko_, la_ + 1024);                                           \
    DMA1(gB0 + ko_, lb_); DMA1(gB1 + ko_, lb_ + 1024); DMA1(gB2 + ko_, lb_ + 2048); DMA1(gB3 + ko_, lb_ + 3072); \
  }
#define SB_ __builtin_amdgcn_sched_barrier(0)

  asm volatile("s_waitcnt vmcnt(0)" ::: "memory");
  const int last = nk - 1;
  ISSUE(0, 0);
  { const int t1 = min(1, last); ISSUE(t1, 1); }
  int sl_r = 0, sl_w = 2;
#pragma unroll 1
  for (int i = 0; i < nk; ++i) {
    asm volatile("s_waitcnt vmcnt(6)" ::: "memory");
    __builtin_amdgcn_s_barrier();
    const int ko2 = min(i + 2, last) * 32;
    char* la2 = ldsA + sl_w * DSLOT; char* lb2 = ldsB + sl_w * DSLOT;
    const unsigned sl = lbase + (unsigned)(sl_r * DSLOT);
    sl_r = (sl_r == 2) ? 0 : sl_r + 1;
    sl_w = (sl_w == 2) ? 0 : sl_w + 1;
    bf16x8 a00, a10, a01, a11, b00, b10, b20, b30, b01, b11, b21, b31;
    const unsigned aA0 = sl + pa + po0, aB0 = sl + pb + po0, aA1 = sl + pa + po1, aB1 = sl + pb + po1;
    asm volatile("ds_read_b128 %0, %1" : "=v"(a00) : "v"(aA0));
    asm volatile("ds_read_b128 %0, %1 offset:2048" : "=v"(a10) : "v"(aA0));
    asm volatile("ds_read_b128 %0, %1" : "=v"(b00) : "v"(aB0));
    asm volatile("ds_read_b128 %0, %1 offset:2048" : "=v"(b10) : "v"(aB0));
    asm volatile("ds_read_b128 %0, %1 offset:4096" : "=v"(b20) : "v"(aB0));
    asm volatile("ds_read_b128 %0, %1 offset:6144" : "=v"(b30) : "v"(aB0));
    asm volatile("ds_read_b128 %0, %1" : "=v"(a01) : "v"(aA1));
    asm volatile("ds_read_b128 %0, %1 offset:2048" : "=v"(a11) : "v"(aA1));
    asm volatile("ds_read_b128 %0, %1" : "=v"(b01) : "v"(aB1));
    asm volatile("ds_read_b128 %0, %1 offset:2048" : "=v"(b11) : "v"(aB1));
    asm volatile("ds_read_b128 %0, %1 offset:4096" : "=v"(b21) : "v"(aB1));
    asm volatile("ds_read_b128 %0, %1 offset:6144" : "=v"(b31) : "v"(aB1));
    DMA1(gA0 + ko2, la2);
    asm volatile("s_waitcnt lgkmcnt(0)" : "+v"(a00), "+v"(a10), "+v"(b00), "+v"(b10), "+v"(b20), "+v"(b30),
                 "+v"(a01), "+v"(a11), "+v"(b01), "+v"(b11), "+v"(b21), "+v"(b31) :: "memory");
    acc[0][0] = mfma32(a00, b00, acc[0][0]);
    acc[0][1] = mfma32(a00, b10, acc[0][1]);
    acc[0][2] = mfma32(a00, b20, acc[0][2]);
    SB_; DMA1(gA1 + ko2, la2 + 1024); SB_;
    acc[0][3] = mfma32(a00, b30, acc[0][3]);
    acc[1][0] = mfma32(a10, b00, acc[1][0]);
    acc[1][1] = mfma32(a10, b10, acc[1][1]);
    SB_; DMA1(gB0 + ko2, lb2); SB_;
    acc[1][2] = mfma32(a10, b20, acc[1][2]);
    acc[1][3] = mfma32(a10, b30, acc[1][3]);
    acc[0][0] = mfma32(a01, b01, acc[0][0]);
    SB_; DMA1(gB1 + ko2, lb2 + 1024); SB_;
    acc[0][1] = mfma32(a01, b11, acc[0][1]);
    acc[0][2] = mfma32(a01, b21, acc[0][2]);
    acc[0][3] = mfma32(a01, b31, acc[0][3]);
    SB_; DMA1(gB2 + ko2, lb2 + 2048); SB_;
    acc[1][0] = mfma32(a11, b01, acc[1][0]);
    acc[1][1] = mfma32(a11, b11, acc[1][1]);
    acc[1][2] = mfma32(a11, b21, acc[1][2]);
    SB_; DMA1(gB3 + ko2, lb2 + 3072); SB_;
    acc[1][3] = mfma32(a11, b31, acc[1][3]);
  }
  asm volatile("s_waitcnt vmcnt(0)" ::: "memory");
  __builtin_amdgcn_s_barrier();
#undef ISSUE
#undef DMA1
#undef SB_
  if (wflag) {
    if (threadIdx.x == 0) {
      unsigned sp = 0;
      while (xb_ld(wflag) != epoch) { __builtin_amdgcn_s_sleep(1); if (++sp > (1u << 24)) break; }
      __builtin_amdgcn_fence(__ATOMIC_ACQUIRE, "agent");
      asm volatile("s_waitcnt vmcnt(0)" ::: "memory");
    }
    __syncthreads();
  }

  if (EPI == EPI_GATES) {
    const bf16_t* XC = (const bf16_t*)j.o1;
    float* AA = (float*)j.o0;
    float* BBp = AA + (size_t)T_ * 1024;
#pragma unroll
    for (int g = 0; g < 2; ++g) {
      const int ch = (n0 >> 8) * 128 + wn * 64 + g * 32 + r32;
      const float br = j.x0[ch], bi = j.x1[ch];
      const float spl = softplusf_(-j.x2[ch]);
#pragma unroll
      for (int mi = 0; mi < 2; ++mi)
#pragma unroll
        for (int r = 0; r < 16; ++r) {
          const int row = m0 + wm * 64 + mi * 32 + (r & 3) + 8 * (r >> 2) + 4 * hh;
          const float rg = sigmoidf_(acc[mi][2 * g][r] + br);
          const float ig = sigmoidf_(acc[mi][2 * g + 1][r] + bi);
          const float la = -8.f * rg * spl;
          const float xc = bf2f(XC[(size_t)row * 1024 + ch]);
          const bool reset = (row < TP_) && ((row & 2047) == 0);
          const float a = reset ? 0.f : __expf(la);
          const float mult = reset ? 1.f : sqrtf(fmaxf(-expm1f(2.f * la), 0.f));
          AA[(size_t)row * 1024 + ch] = a;
          BBp[(size_t)row * 1024 + ch] = mult * ig * xc;
        }
    }
  } else {
    const int lq = lane & 3;
#pragma unroll
    for (int mi = 0; mi < 2; ++mi)
#pragma unroll
      for (int ni = 0; ni < 4; ++ni)
#pragma unroll
        for (int g4 = 0; g4 < 4; ++g4) {
          float v[4] = {acc[mi][ni][4 * g4], acc[mi][ni][4 * g4 + 1], acc[mi][ni][4 * g4 + 2], acc[mi][ni][4 * g4 + 3]};
          quad_transpose4(v, lq);
          const int row = m0 + wm * 64 + mi * 32 + 8 * g4 + 4 * hh + lq;
          const int col = n0 + wn * 128 + ni * 32 + (r32 & ~3);
          epi4<EPI>(j, row, col, v);
        }
    if (EPI == EPI_SSM_XBC) {
      if (n0 + wn * 128 == 4096) {
        const float dtb = j.x0[r32];
#pragma unroll
        for (int mi = 0; mi < 2; ++mi)
#pragma unroll
          for (int r = 0; r < 16; ++r) {
            const int row = m0 + wm * 64 + mi * 32 + (r & 3) + 8 * (r >> 2) + 4 * hh;
            ((float*)j.o1)[(size_t)row * 32 + r32] = softplusf_(acc[mi][0][r] + dtb);
          }
      }
    }
  }
}

template <int EPI>
DI void gemm_tile_dma_h(const GJob& j, int m0, int n0, int nk, char* smem) {
  const int tid = TIDX, lane = tid & 63, w = tid >> 6;
  const int wm = w >> 1, wn = w & 1, r32 = lane & 31, hh = lane >> 5;
  f32x16 acc[4];
#pragma unroll
  for (int b = 0; b < 4; ++b)
#pragma unroll
    for (int r = 0; r < 16; ++r) acc[b][r] = 0.f;
  const int dr = lane >> 2;
  const int dc = (lane & 3) ^ ((lane >> 4) & 3);
  const int nlim = j.nvalid - 1;
  const size_t kofs = (size_t)dc * 8;
  const bf16_t* gA0 = j.A + (size_t)(m0 + 16 * w + dr) * j.lda + kofs;
  const bf16_t* gB0 = j.Bt + (size_t)min(n0 + 64 * w + dr, nlim) * j.ldb + kofs;
  const bf16_t* gB1 = j.Bt + (size_t)min(n0 + 64 * w + 16 + dr, nlim) * j.ldb + kofs;
  const bf16_t* gB2 = j.Bt + (size_t)min(n0 + 64 * w + 32 + dr, nlim) * j.ldb + kofs;
  const bf16_t* gB3 = j.Bt + (size_t)min(n0 + 64 * w + 48 + dr, nlim) * j.ldb + kofs;
  char* ldsA = smem + w * 1024 + lane * 16;
  char* ldsB = smem + 8192 + (4 * w) * 1024 + lane * 16;
  const unsigned lbase = (unsigned)(unsigned long long)(LAS char*)smem;
  const int fsw = (r32 >> 2) & 3;
  const unsigned pa = (unsigned)((wm * 32 + r32) * 64), pb = (unsigned)(8192 + (wn * 128 + r32) * 64);
  const unsigned po0 = (unsigned)(((hh) ^ fsw) * 16), po1 = (unsigned)(((2 + hh) ^ fsw) * 16);
#define DMA1(gp, lp) __builtin_amdgcn_global_load_lds((const unsigned*)(gp), (unsigned*)(lp), 16, 0, 0)
#define ISSUEH(kt, slot)                                                                         \
  {                                                                                              \
    const int ko_ = (kt) * 32;                                                                   \
    char* la_ = ldsA + (slot) * DSLOT; char* lb_ = ldsB + (slot) * DSLOT;                        \
    DMA1(gA0 + ko_, la_);                                                                        \
    DMA1(gB0 + ko_, lb_); DMA1(gB1 + ko_, lb_ + 1024); DMA1(gB2 + ko_, lb_ + 2048); DMA1(gB3 + ko_, lb_ + 3072); \
  }
  asm volatile("s_waitcnt vmcnt(0)" ::: "memory");
  const int last = nk - 1;
  ISSUEH(0, 0);
  { const int t1 = min(1, last); ISSUEH(t1, 1); }
  int sl_r = 0, sl_w = 2;
#pragma unroll 1
  for (int i = 0; i < nk; ++i) {
    asm volatile("s_waitcnt vmcnt(5)" ::: "memory");
    __builtin_amdgcn_s_barrier();
    { const int t2 = min(i + 2, last); ISSUEH(t2, sl_w); }
    const unsigned sl = lbase + (unsigned)(sl_r * DSLOT);
    sl_r = (sl_r == 2) ? 0 : sl_r + 1;
    sl_w = (sl_w == 2) ? 0 : sl_w + 1;
    bf16x8 a00, a01, b00, b10, b20, b30, b01, b11, b21, b31;
    const unsigned aA0 = sl + pa + po0, aB0 = sl + pb + po0, aA1 = sl + pa + po1, aB1 = sl + pb + po1;
    asm volatile("ds_read_b128 %0, %1" : "=v"(a00) : "v"(aA0));
    asm volatile("ds_read_b128 %0, %1" : "=v"(b00) : "v"(aB0));
    asm volatile("ds_read_b128 %0, %1 offset:2048" : "=v"(b10) : "v"(aB0));
    asm volatile("ds_read_b128 %0, %1 offset:4096" : "=v"(b20) : "v"(aB0));
    asm volatile("ds_read_b128 %0, %1 offset:6144" : "=v"(b30) : "v"(aB0));
    asm volatile("ds_read_b128 %0, %1" : "=v"(a01) : "v"(aA1));
    asm volatile("ds_read_b128 %0, %1" : "=v"(b01) : "v"(aB1));
    asm volatile("ds_read_b128 %0, %1 offset:2048" : "=v"(b11) : "v"(aB1));
    asm volatile("ds_read_b128 %0, %1 offset:4096" : "=v"(b21) : "v"(aB1));
    asm volatile("ds_read_b128 %0, %1 offset:6144" : "=v"(b31) : "v"(aB1));
    asm volatile("s_waitcnt lgkmcnt(0)" : "+v"(a00), "+v"(b00), "+v"(b10), "+v"(b20), "+v"(b30),
                 "+v"(a01), "+v"(b01), "+v"(b11), "+v"(b21), "+v"(b31) :: "memory");
    acc[0] = mfma32(a00, b00, acc[0]);
    acc[1] = mfma32(a00, b10, acc[1]);
    acc[2] = mfma32(a00, b20, acc[2]);
    acc[3] = mfma32(a00, b30, acc[3]);
    acc[0] = mfma32(a01, b01, acc[0]);
    acc[1] = mfma32(a01, b11, acc[1]);
    acc[2] = mfma32(a01, b21, acc[2]);
    acc[3] = mfma32(a01, b31, acc[3]);
  }
  asm volatile("s_waitcnt vmcnt(0)" ::: "memory");
  __builtin_amdgcn_s_barrier();
#undef ISSUEH
#undef DMA1
  const int lq = lane & 3;
#pragma unroll
  for (int ni = 0; ni < 4; ++ni)
#pragma unroll
    for (int g4 = 0; g4 < 4; ++g4) {
      float v[4] = {acc[ni][4 * g4], acc[ni][4 * g4 + 1], acc[ni][4 * g4 + 2], acc[ni][4 * g4 + 3]};
      quad_transpose4(v, lq);
      const int row = m0 + wm * 32 + 8 * g4 + 4 * hh + lq;
      const int col = n0 + wn * 128 + ni * 32 + (r32 & ~3);
      epi4<EPI>(j, row, col, v);
    }
  if (EPI == EPI_SSM_XBC) {
    if (n0 + wn * 128 == 4096) {
      const float dtb = j.x0[r32];
#pragma unroll
      for (int r = 0; r < 16; ++r) {
        const int row = m0 + wm * 32 + (r & 3) + 8 * (r >> 2) + 4 * hh;
        ((float*)j.o1)[(size_t)row * 32 + r32] = softplusf_(acc[0][r] + dtb);
      }
    }
  }
}

#define VBLOCK() ((int)(((volatile LAS unsigned*)&xb_words)[3]))
DI void tile_map(int L, int ntn, int& mt, int& nt) {
  const int gw = ((ntn & 7) == 0) ? 8 : (((ntn & 3) == 0) ? 4 : 0);
  if (gw) {
    const int gs = 8 * gw, grp = L / gs, loc = L - grp * gs, gpr = ntn / gw;
    const int gm = grp / gpr, gn = grp - gm * gpr;
    mt = gm * 8 + loc / gw; nt = gn * gw + (loc - (loc / gw) * gw);
  } else { mt = L / ntn; nt = L - mt * ntn; }
}

template <int EPI, bool MIX>
DI void gemm_run(const GJob& j, int ntn, int& toff, char* smem, int vb_) {
  const int G = gridDim.x;
  const int nk = j.K >> 6;
  if (MIX) {
    const int ntiles = MT_ * ntn;
    const int start = (int)((vb_ - (toff % G) + G) % G);
    for (int tile = start; tile < ntiles; tile += G) {
      int mt, nt; tile_map(tile, ntn, mt, nt);
      gemm_tile<EPI, MIX>(j, mt * 128, nt * 128, 0, nk, smem);
    }
    toff += ntiles;
  } else {
    const int nfull = 128 * ntn, nhalf = 16 * ntn, ntot = nfull + nhalf;
    const int start = (int)((vb_ - (toff % G) + G) % G);
    for (int item = start; item < ntot; item += G) {
      if (item < nfull) {
        int mt, nt; tile_map(item, ntn, mt, nt);
        gemm_tile_dma<EPI>(j, mt * 128, nt * 256, 0, nk * 2, smem);
      } else {
        const int h = item - nfull, hm = h / ntn, nt = h - hm * ntn;
        gemm_tile_dma_h<EPI>(j, TP_ + hm * 64, nt * 256, nk * 2, smem);
      }
    }
    toff += ntot;
  }
}

template <int EPI>
DI void gemm_streamk(const GJob& j, int ntn, char* smem, int vb_, unsigned* flags, unsigned epoch) {
  const int G = gridDim.x;
  const int nk = j.K >> 5;
  const int total = MT_ * ntn * nk;
  int per = (total + G - 1) / G;
  if (per < nk) per = nk;
  int s0 = vb_ * per;
  const int s1 = min(s0 + per, total);
  while (s0 < s1) {
    const int tile = s0 / nk, k0 = s0 - tile * nk;
    const int k1 = min(nk, k0 + (s1 - s0));
    int mt, nt; tile_map(tile, ntn, mt, nt);
    unsigned* wf = (k0 == 0 && k1 < nk) ? (flags + tile) : nullptr;
    gemm_tile_dma<EPI>(j, mt * 128, nt * 256, k0, k1, smem, wf, epoch);
    if (k0 > 0) {
      asm volatile("s_waitcnt vmcnt(0)" ::: "memory");
      __syncthreads();
      if (threadIdx.x == 0) {
        __builtin_amdgcn_fence(__ATOMIC_RELEASE, "agent");
        asm volatile("s_waitcnt vmcnt(0)" ::: "memory");
        __hip_atomic_store(flags + tile, epoch, __ATOMIC_RELAXED, __HIP_MEMORY_SCOPE_AGENT);
      }
    }
    s0 += k1 - k0;
  }
}

template <int EPI, int SPLIT, int NKC>
DI void gemm_splitk(const GJob& j, int ntn, char* smem, int vb_) {
  const int G = gridDim.x;
  const int nitems = MT_ * ntn * SPLIT;
  for (int it = vb_; it < nitems; it += G) {
    const int tile = it / SPLIT, sp = it - tile * SPLIT;
    int mt, nt; tile_map(tile, ntn, mt, nt);
    gemm_tile<EPI, false>(j, mt * 128, nt * 128, sp * NKC, sp * NKC + NKC, smem);
  }
}

DI GJob mkjob(const bf16_t* A, int lda, const bf16_t* Bt, int ldb, int K, int nvalid) {
  GJob j;
  j.A = A; j.A2 = nullptr; j.mu = nullptr; j.Bt = Bt; j.lda = lda; j.ldb = ldb; j.K = K; j.nvalid = nvalid;
  j.o0 = nullptr; j.o1 = nullptr; j.x0 = nullptr; j.x1 = nullptr; j.x2 = nullptr; j.ldo = 0; j.act = 0;
  return j;
}

struct TJob { const float* src; bf16_t* dst; int K, N, src_ld, kind, n_off; };

DI TJob get_tjob(const Params& p, int j) {
  bf16_t* wt = (bf16_t*)(p.ws + W_WT);
  TJob o; o.kind = 0; o.n_off = 0;
  if (j < 36) {
    const int ia = j / 18, r = j % 18;
    if (r == 0) { o.src = p.in[I_LRU_WIN] + (size_t)ia * 1024 * 2048; o.dst = wt + WA_IN + (size_t)ia * 2048 * 1024; o.K = 1024; o.N = 2048; o.src_ld = 2048; }
    else if (r == 1) { o.src = p.in[I_LRU_WOUT] + (size_t)ia * 1024 * 1024; o.dst = wt + WA_OUT + (size_t)ia * 1024 * 1024; o.K = 1024; o.N = 1024; o.src_ld = 1024; }
    else {
      const int isI = (r >= 10) ? 1 : 0; const int h = (r - 2) & 7;
      o.src = p.in[isI ? I_LRU_WI : I_LRU_WR] + ((size_t)ia * 8 + h) * 128 * 128;
      o.dst = wt + WA_G + (size_t)ia * 2048 * 128; o.K = 128; o.N = 128; o.src_ld = 128; o.kind = 1 + isI; o.n_off = h * 128;
    }
  } else if (j == 36) { o.src = p.in[I_SSM_WIN] + 2048; o.dst = wt + WB_XBC; o.K = 1024; o.N = 4128; o.src_ld = 6176; }
  else if (j == 37) { o.src = p.in[I_SSM_WIN]; o.dst = wt + WB_Z; o.K = 1024; o.N = 2048; o.src_ld = 6176; }
  else if (j == 38) { o.src = p.in[I_SSM_WOUT]; o.dst = wt + WB_OUT; o.K = 2048; o.N = 1024; o.src_ld = 1024; }
  else if (j < 42) { const int s = j - 39; o.src = p.in[I_RW_WRKV] + (size_t)s * 1024 * 1024; o.dst = wt + WC_RKV + (size_t)s * 1024 * 1024; o.K = 1024; o.N = 1024; o.src_ld = 1024; }
  else if (j == 42) { o.src = p.in[I_RW_WW1]; o.dst = wt + WC_L1; o.K = 1024; o.N = 64; o.src_ld = 64; }
  else if (j == 43) { o.src = p.in[I_RW_WA1]; o.dst = wt + WC_L1 + 64 * 1024; o.K = 1024; o.N = 64; o.src_ld = 64; }
  else if (j == 44) { o.src = p.in[I_RW_WG1]; o.dst = wt + WC_L1 + 128 * 1024; o.K = 1024; o.N = 128; o.src_ld = 128; }
  else if (j == 45) { o.src = p.in[I_RW_WW2]; o.dst = wt + WC_W2; o.K = 64; o.N = 1024; o.src_ld = 1024; }
  else if (j == 46) { o.src = p.in[I_RW_WA2]; o.dst = wt + WC_A2; o.K = 64; o.N = 1024; o.src_ld = 1024; }
  else if (j == 47) { o.src = p.in[I_RW_WG2]; o.dst = wt + WC_G2; o.K = 128; o.N = 1024; o.src_ld = 1024; }
  else if (j == 48) { o.src = p.in[I_RW_WOUT]; o.dst = wt + WC_OUT; o.K = 1024; o.N = 1024; o.src_ld = 1024; }
  else {
    const int l = (j - 49) >> 1, which = (j - 49) & 1;
    if (!which) { o.src = p.in[I_FFN_W1] + (size_t)l * 1024 * 4096; o.dst = wt + WF_1 + (size_t)l * 4096 * 1024; o.K = 1024; o.N = 4096; o.src_ld = 4096; }
    else { o.src = p.in[I_FFN_W2] + (size_t)l * 4096 * 1024; o.dst = wt + WF_2 + (size_t)l * 4096 * 1024; o.K = 4096; o.N = 1024; o.src_ld = 1024; }
  }
  return o;
}
constexpr int N_TJOBS = 57;

DI void ph_prologue(const Params& p, char* smem) {
  const int tid = TIDX, G = gridDim.x;
  {
    const float4* xp = (const float4*)p.in[I_XP];
    const float4* xs = (const float4*)p.in[I_XS];
    float4* X = (float4*)(p.ws + W_X);
    const size_t np = (size_t)TP_ * 256, nt = (size_t)T_ * 256;
    for (size_t i = (size_t)blockIdx.x * NTHR + tid; i < nt; i += (size_t)G * NTHR)
      X[i] = (i < np) ? xp[i] : xs[i - np];
  }
  float* tile = (float*)smem;
  int toff = 0;
  for (int jn = 0; jn < N_TJOBS; ++jn) {
    const TJob tj = get_tjob(p, jn);
    const int nkt = tj.K >> 6, nnt = (tj.N + 63) >> 6;
    const int ntiles = nkt * nnt;
    const int start = (((int)blockIdx.x - (toff % G)) + G) % G;
    for (int t = start; t < ntiles; t += G) {
      const int kt = t / nnt, nt = t - kt * nnt;
      const int k0 = kt * 64, n0 = nt * 64;
      __syncthreads();
      float tv[16];
      const bool nok = (n0 + (tid & 63)) < tj.N;
      const float* sp = tj.src + (size_t)(k0 + (tid >> 6)) * tj.src_ld + n0 + (tid & 63);
#pragma unroll
      for (int i = 0; i < 16; ++i) tv[i] = nok ? sp[(size_t)(i * 4) * tj.src_ld] : 0.f;
#pragma unroll
      for (int i = 0; i < 16; ++i) tile[(i * 4 + (tid >> 6)) * 65 + (tid & 63)] = tv[i];
      __syncthreads();
      const int n = tid >> 2, kq = tid & 3;
      if (n0 + n < tj.N) {
        int nrow = n0 + n;
        if (tj.kind) {
          const int ch = tj.n_off + n0 + n;
          nrow = (ch >> 6) * 128 + ((ch >> 5) & 1) * 64 + (tj.kind - 1) * 32 + (ch & 31);
        }
        float f[8], g[8];
#pragma unroll
        for (int e = 0; e < 8; ++e) { f[e] = tile[(kq * 16 + e) * 65 + n]; g[e] = tile[(kq * 16 + 8 + e) * 65 + n]; }
        uint4* d = (uint4*)(tj.dst + (size_t)nrow * tj.K + k0 + kq * 16);
        d[0] = pack8(f); d[1] = pack8(g);
      }
    }
    toff += ntiles;
  }
}

DI void ph_rmsnorm(const Params& p, int mode, const float* w) {
  const int tid_ = TIDX; const int lane = tid_ & 63;
  const int gw = blockIdx.x * 4 + (tid_ >> 6), nw = gridDim.x * 4;
  const float* X = (const float*)(p.ws + W_X);
  bf16_t* U = (bf16_t*)(p.ws + W_U);
  bf16_t* UP = (bf16_t*)(p.ws + SC_UP);
  float4 wv[4];
#pragma unroll
  for (int i = 0; i < 4; ++i) wv[i] = ((const float4*)w)[lane + 64 * i];
  for (int row = gw; row < T_; row += nw) {
    const float4* xr = (const float4*)(X + (size_t)row * 1024);
    float4 v[4]; float ss = 0.f;
#pragma unroll
    for (int i = 0; i < 4; ++i) { v[i] = xr[lane + 64 * i]; ss += v[i].x * v[i].x + v[i].y * v[i].y + v[i].z * v[i].z + v[i].w * v[i].w; }
    ss = wave_sum(ss);
    const float rstd = rsqrtf(ss * (1.f / 1024.f) + 1e-6f);
    int seq, l, L; tok_info(row, seq, l, L);
#pragma unroll
    for (int i = 0; i < 4; ++i) {
      const int c = 4 * (lane + 64 * i);
      float4 y = make_float4(v[i].x * rstd * wv[i].x, v[i].y * rstd * wv[i].y, v[i].z * rstd * wv[i].z, v[i].w * rstd * wv[i].w);
      if (mode == 2) {
        *(float4*)(p.out + O_Y + (size_t)row * 1024 + c) = y;
      } else {
        uint2 pk = make_uint2(pack2(y.x, y.y), pack2(y.z, y.w));
        *(uint2*)(U + (size_t)row * 1024 + c) = pk;
        if (mode == 1) {
          if (l + 1 < L) *(uint2*)(UP + (size_t)(row + 1) * 1024 + c) = pk;
          if (l == 0) {
            uint2 pz = make_uint2(0, 0);
            if (seq >= 8) { float4 s = *(const float4*)(p.in[I_ST_RS] + (size_t)(seq - 8) * 1024 + c); pz = make_uint2(pack2(s.x, s.y), pack2(s.z, s.w)); }
            *(uint2*)(UP + (size_t)row * 1024 + c) = pz;
          }
          if (l == L - 1) {
            float* o = (seq < 8) ? (p.out + O_RS_P + (size_t)seq * 1024 + c) : (p.out + O_RS_S + (size_t)(seq - 8) * 1024 + c);
            *(float4*)o = y;
          }
        }
      }
    }
  }
}

template <int C, bool SILU>
DI void ph_conv(const bf16_t* __restrict__ src, bf16_t* __restrict__ dst, const float* __restrict__ cw,
                const float* __restrict__ cb, const float* __restrict__ state,
                float* __restrict__ out_p, float* __restrict__ out_s) {
  constexpr int GR = C / 8;
  const size_t total = (size_t)T_ * GR;
#pragma unroll 2
  for (size_t idx = (size_t)blockIdx.x * NTHR + TIDX; idx < total; idx += (size_t)gridDim.x * NTHR) {
    const int t = (int)(idx / GR), c = (int)(idx % GR) * 8;
    int seq, l, L; tok_info(t, seq, l, L);
    float acc[8]; load8f(cb + c, acc);
    float xcur[8];
#pragma unroll
    for (int jj = 0; jj < 4; ++jj) {
      const int ls = l - 3 + jj;
      float xv[8];
      if (ls >= 0) { unpack8(*(const uint4*)(src + (size_t)(t - 3 + jj) * C + c), xv); }
      else if (seq >= 8) { load8f(state + ((size_t)(seq - 8) * 3 + (ls + 3)) * C + c, xv); }
      else {
#pragma unroll
        for (int e = 0; e < 8; ++e) xv[e] = 0.f;
      }
      float w8[8]; load8f(cw + (size_t)jj * C + c, w8);
#pragma unroll
      for (int e = 0; e < 8; ++e) acc[e] += w8[e] * xv[e];
      if (jj == 3) {
#pragma unroll
        for (int e = 0; e < 8; ++e) xcur[e] = xv[e];
      }
    }
    if (SILU) {
#pragma unroll
      for (int e = 0; e < 8; ++e) acc[e] = siluf_(acc[e]);
    }
    *(uint4*)(dst + (size_t)t * C + c) = pack8(acc);
    if (l >= L - 3) {
      const int r = l - (L - 3);
      float* o = (seq < 8) ? (out_p + ((size_t)seq * 3 + r) * C + c) : (out_s + ((size_t)(seq - 8) * 3 + r) * C + c);
      store8f(o, xcur);
    }
  }
}

DI void ph_lru_scan1(const Params& p) {
  const float* AA = (const float*)(p.ws + SA_AA);
  const float* BB = (const float*)(p.ws + SA_BB);
  float* CP = (float*)(p.ws + SA_CP);
  float* CS = (float*)(p.ws + SA_CS);
  const int total = 8 * 64 * 1024;
  for (int idx = blockIdx.x * NTHR + TIDX; idx < total; idx += gridDim.x * NTHR) {
    const int ch = idx & 1023, c = (idx >> 10) & 63, b = idx >> 16;
    const size_t base = ((size_t)b * 2048 + c * 32) * 1024 + ch;
    float P = 1.f, S = 0.f;
    float av[32], bv[32];
#pragma unroll
    for (int s = 0; s < 32; ++s) { av[s] = AA[base + (size_t)s * 1024]; bv[s] = BB[base + (size_t)s * 1024]; }
#pragma unroll
    for (int s = 0; s < 32; ++s) { S = av[s] * S + bv[s]; P *= av[s]; }
    CP[idx] = P; CS[idx] = S;
  }
}
DI void ph_lru_scan2(const Params& p, int ia) {
  const float* AA = (const float*)(p.ws + SA_AA);
  const float* BB = (const float*)(p.ws + SA_BB);
  const float* CP = (const float*)(p.ws + SA_CP);
  const float* CS = (const float*)(p.ws + SA_CS);
  bf16_t* GT = (bf16_t*)(p.ws + SA_GT);
  const int nP = 8 * 64 * 1024, total = nP + 128 * 1024;
  for (int idx = blockIdx.x * NTHR + TIDX; idx < total; idx += gridDim.x * NTHR) {
    if (idx < nP) {
      const int ch = idx & 1023, c = (idx >> 10) & 63, b = idx >> 16;
      const size_t base = ((size_t)b * 2048 + c * 32) * 1024 + ch;
      float av[32], bv[32]; bf16_t gv[32];
#pragma unroll
      for (int s = 0; s < 32; ++s) { const size_t o = base + (size_t)s * 1024; av[s] = AA[o]; bv[s] = BB[o]; gv[s] = GT[o]; }
      float h = 0.f;
#pragma unroll 8
      for (int c2 = 0; c2 < c; ++c2) {
        const int ci = ((b * 64 + c2) << 10) + ch;
        h = CP[ci] * h + CS[ci];
      }
#pragma unroll
      for (int s = 0; s < 32; ++s) {
        const size_t o = base + (size_t)s * 1024;
        h = av[s] * h + bv[s];
        GT[o] = f2bf(h * bf2f(gv[s]));
      }
      if (c == 63) p.out[O_LH_P + ((size_t)ia * 8 + b) * 1024 + ch] = h;
    } else {
      const int u = idx - nP; const int ch = u & 1023, s = u >> 10;
      float h = p.in[I_ST_LH][((size_t)ia * 128 + s) * 1024 + ch];
      const size_t base = ((size_t)TP_ + s * 8) * 1024 + ch;
#pragma unroll
      for (int q = 0; q < 8; ++q) {
        const size_t o = base + (size_t)q * 1024;
        h = AA[o] * h + BB[o];
        GT[o] = f2bf(h * bf2f(GT[o]));
      }
      p.out[O_LH_S + ((size_t)ia * 128 + s) * 1024 + ch] = h;
    }
  }
}

DI void ssd_item(const Params& p, char* smem, int seq, int h) {
  const int tid = TIDX, lane = tid & 63, w = tid >> 6, r32 = lane & 31, hh = lane >> 5;
  bf16_t* Cs = (bf16_t*)smem;
  bf16_t* Bs = Cs + 64 * 136;
  bf16_t* Sb = Bs + 64 * 136;
  bf16_t* Xt = Sb + 64 * 136;
  bf16_t* Btr = Xt + 64 * 72;
  float* dts = (float*)(Btr + 128 * 72);
  float* acs = dts + 64;
  bf16_t* Ws = Bs;
  const bf16_t* XBC = (const bf16_t*)(p.ws + SB_XBC);
  const float* DT = (const float*)(p.ws + SB_DT);
  bf16_t* Y = (bf16_t*)(p.ws + SB_Y);
  const bool prompt = seq < 8;
  const int nchunk = prompt ? 32 : 1, Lv = prompt ? 64 : 8;
  const int tbase = prompt ? seq * 2048 : TP_ + (seq - 8) * 8;
  const int g = h >> 2;
  const float Ah = -__expf(p.in[I_SSM_ALOG][h]);
  const float Dh = p.in[I_SSM_D][h];
  f32x16 accS[2];
  {
    const float* s0 = p.in[I_ST_SS] + ((size_t)(seq - 8) * 32 + h) * 64 * 128;
#pragma unroll
    for (int mi = 0; mi < 2; ++mi)
#pragma unroll
      for (int r = 0; r < 16; ++r) {
        const int prow = mi * 32 + (r & 3) + 8 * (r >> 2) + 4 * hh, n = 32 * w + r32;
        accS[mi][r] = prompt ? 0.f : s0[(size_t)prow * 128 + n];
      }
  }
  __syncthreads();
#pragma unroll
  for (int mi = 0; mi < 2; ++mi)
#pragma unroll
    for (int r = 0; r < 16; ++r) {
      const int prow = mi * 32 + (r & 3) + 8 * (r >> 2) + 4 * hh, n = 32 * w + r32;
      Sb[prow * 136 + n] = f2bf(accS[mi][r]);
    }
  uint4 pc0, pc1, pc2, pc3, pb0, pb1, pb2, pb3, px0, px1;
  float pdt = 0.f;
  const uint4 z4 = make_uint4(0, 0, 0, 0);
  pc0 = pc1 = pc2 = pc3 = pb0 = pb1 = pb2 = pb3 = px0 = px1 = z4;
#define SSD_LD_CB(i, t0_)                                                                  \
  { const int row_ = tid >> 2, ch_ = (tid & 3) + 4 * i;      \
    pc##i = z4; pb##i = z4;                                                                \
    if (row_ < Lv) { const bf16_t* src_ = XBC + (size_t)((t0_) + row_) * 4096 + g * 128 + ch_ * 8; \
      pb##i = *(const uint4*)(src_ + 2048); pc##i = *(const uint4*)(src_ + 3072); } }
#define SSD_LD_X(i, t0_)                                                                   \
  { const int row_ = tid >> 2, ch_ = (tid & 3) + 4 * i;                                    \
    px##i = z4;                                                                            \
    if (row_ < Lv) px##i = *(const uint4*)(XBC + (size_t)((t0_) + row_) * 4096 + h * 64 + ch_ * 8); }
#define SSD_ISSUE(t0_)                                                                     \
  { SSD_LD_CB(0, t0_) SSD_LD_CB(1, t0_) SSD_LD_CB(2, t0_) SSD_LD_CB(3, t0_) SSD_LD_X(0, t0_) SSD_LD_X(1, t0_) \
    pdt = (tid < Lv && tid < 64) ? DT[(size_t)((t0_) + tid) * 32 + h] : 0.f; }
#define SSD_ST_CB(i)                                                                       \
  { const int row_ = tid >> 2, ch_ = (tid & 3) + 4 * i;                                    \
    *(uint4*)(Cs + row_ * 136 + ch_ * 8) = pc##i;                                          \
    *(uint4*)(Bs + row_ * 136 + ch_ * 8) = pb##i;                                          \
    float f_[8]; unpack8(pb##i, f_);                                                       \
    const float sc_ = __expf(aend - acs[row_]);                                            \
    _Pragma("unroll") for (int e = 0; e < 8; ++e) Btr[(ch_ * 8 + e) * 72 + row_] = f2bf(f_[e] * sc_); }
#define SSD_ST_X(i)                                                                        \
  { const int row_ = tid >> 2, ch_ = (tid & 3) + 4 * i;                                    \
    float f_[8]; unpack8(px##i, f_);                                                       \
    const float sc_ = dts[row_];                                                           \
    _Pragma("unroll") for (int e = 0; e < 8; ++e) Xt[(ch_ * 8 + e) * 72 + row_] = f2bf(f_[e] * sc_); }
  SSD_ISSUE(tbase);
  for (int c = 0; c < nchunk; ++c) {
    const int t0 = tbase + c * 64;
    __syncthreads();
    if (tid < 64) {
      const float dtv = pdt;
      float x = dtv * Ah;
#pragma unroll
      for (int o = 1; o < 64; o <<= 1) { const float y = __shfl_up(x, o, 64); if (lane >= o) x += y; }
      dts[tid] = dtv; acs[tid] = x;
    }
    __syncthreads();
    const float aend = acs[63];
    SSD_ST_CB(0) SSD_ST_CB(1) SSD_ST_CB(2) SSD_ST_CB(3) SSD_ST_X(0) SSD_ST_X(1)
    if (c + 1 < nchunk) { SSD_ISSUE(t0 + 64); }
    __syncthreads();
    const int it = w >> 1, jt = w & 1;
    f32x16 cb;
#pragma unroll
    for (int r = 0; r < 16; ++r) cb[r] = 0.f;
    if (jt <= it) {
#pragma unroll
      for (int ks = 0; ks < 8; ++ks) {
        bf16x8 a = *(const bf16x8*)(Cs + (it * 32 + r32) * 136 + ks * 16 + hh * 8);
        bf16x8 b = *(const bf16x8*)(Bs + (jt * 32 + r32) * 136 + ks * 16 + hh * 8);
        cb = mfma32(a, b, cb);
      }
    }
    __syncthreads();
    {
      const int jj = jt * 32 + r32; const float aj = acs[jj];
#pragma unroll
      for (int r = 0; r < 16; ++r) {
        const int ii = it * 32 + (r & 3) + 8 * (r >> 2) + 4 * hh;
        const float v = (jj <= ii) ? cb[r] * __expf(acs[ii] - aj) : 0.f;
        Ws[ii * 72 + jj] = f2bf(v);
      }
    }
    __syncthreads();
    {
      const int pt = w & 1;
      f32x16 yd, yo;
#pragma unroll
      for (int r = 0; r < 16; ++r) { yd[r] = 0.f; yo[r] = 0.f; }
#pragma unroll
      for (int ks = 0; ks < 4; ++ks) {
        bf16x8 a = *(const bf16x8*)(Ws + (it * 32 + r32) * 72 + ks * 16 + hh * 8);
        bf16x8 b = *(const bf16x8*)(Xt + (pt * 32 + r32) * 72 + ks * 16 + hh * 8);
        yd = mfma32(a, b, yd);
      }
#pragma unroll
      for (int ks = 0; ks < 8; ++ks) {
        bf16x8 a = *(const bf16x8*)(Cs + (it * 32 + r32) * 136 + ks * 16 + hh * 8);
        bf16x8 b = *(const bf16x8*)(Sb + (pt * 32 + r32) * 136 + ks * 16 + hh * 8);
        yo = mfma32(a, b, yo);
      }
      const int lq = lane & 3, p0 = pt * 32 + (r32 & ~3);
#pragma unroll
      for (int g4 = 0; g4 < 4; ++g4) {
        float v[4];
#pragma unroll
        for (int e = 0; e < 4; ++e) {
          const int ie = it * 32 + e + 8 * g4 + 4 * hh;
          v[e] = yd[4 * g4 + e] + __expf(acs[ie]) * yo[4 * g4 + e];
        }
        quad_transpose4(v, lq);
        const int ii = it * 32 + 8 * g4 + 4 * hh + lq;
        if (ii < Lv) {
          const size_t t = (size_t)(t0 + ii);
          float xf[4]; unpack4(*(const uint2*)(XBC + t * 4096 + h * 64 + p0), xf);
          *(uint2*)(Y + t * 2048 + h * 64 + p0) =
              pack4(v[0] + Dh * xf[0], v[1] + Dh * xf[1], v[2] + Dh * xf[2], v[3] + Dh * xf[3]);
        }
      }
    }
    {
      const float dec = __expf(aend);
#pragma unroll
      for (int mi = 0; mi < 2; ++mi)
#pragma unroll
        for (int r = 0; r < 16; ++r) accS[mi][r] *= dec;
#pragma unroll
      for (int ks = 0; ks < 4; ++ks) {
        bf16x8 b = *(const bf16x8*)(Btr + (32 * w + r32) * 72 + ks * 16 + hh * 8);
        bf16x8 a0 = *(const bf16x8*)(Xt + (r32) * 72 + ks * 16 + hh * 8);
        bf16x8 a1 = *(const bf16x8*)(Xt + (32 + r32) * 72 + ks * 16 + hh * 8);
        accS[0] = mfma32(a0, b, accS[0]);
        accS[1] = mfma32(a1, b, accS[1]);
      }
    }
    __syncthreads();
#pragma unroll
    for (int mi = 0; mi < 2; ++mi)
#pragma unroll
      for (int r = 0; r < 16; ++r) {
        const int prow = mi * 32 + (r & 3) + 8 * (r >> 2) + 4 * hh, n = 32 * w + r32;
        Sb[prow * 136 + n] = f2bf(accS[mi][r]);
      }
  }
  float* dst = prompt ? (p.out + O_SS_P + ((size_t)seq * 32 + h) * 64 * 128)
                      : (p.out + O_SS_S + ((size_t)(seq - 8) * 32 + h) * 64 * 128);
#pragma unroll
  for (int mi = 0; mi < 2; ++mi)
#pragma unroll
    for (int r = 0; r < 16; ++r) {
      const int prow = mi * 32 + (r & 3) + 8 * (r >> 2) + 4 * hh, n = 32 * w + r32;
      dst[(size_t)prow * 128 + n] = accS[mi][r];
    }
}

#undef SSD_LD_CB
#undef SSD_LD_X
#undef SSD_ISSUE
#undef SSD_ST_CB
#undef SSD_ST_X
DI void ph_ssd(const Params& p, char* smem) {
  const int G = gridDim.x, bid = blockIdx.x;
  int it = bid, step = G;
  if (G >= 512) { if (bid < 256) { step = 1 << 30; } else { step = G - 256; } }
#pragma nounroll
  for (; it < 256 + 4096; it += step) {
    const int seq = (it < 256) ? (it >> 5) : (8 + ((it - 256) >> 5));
    ssd_item(p, smem, seq, it & 31);
  }
}

DI void ph_gnorm(const Params& p) {
  const int tid_ = TIDX; const int lane = tid_ & 63;
  const int gw = blockIdx.x * 4 + (tid_ >> 6), nw = gridDim.x * 4;
  bf16_t* Y = (bf16_t*)(p.ws + SB_Y);
  const float* nwt = p.in[I_SSM_NW];
  for (int item = gw; item < T_ * 8; item += 2 * nw) {
    const int item2 = item + nw; const bool v2 = item2 < T_ * 8;
    bf16_t* yp1 = Y + (size_t)(item >> 3) * 2048 + (item & 7) * 256 + lane * 4;
    bf16_t* yp2 = Y + (size_t)((v2 ? item2 : item) >> 3) * 2048 + ((v2 ? item2 : item) & 7) * 256 + lane * 4;
    const uint2 a = *(const uint2*)yp1; const uint2 b = *(const uint2*)yp2;
    float f[4], g[4]; unpack4(a, f); unpack4(b, g);
    const float ss1 = wave_sum(f[0] * f[0] + f[1] * f[1] + f[2] * f[2] + f[3] * f[3]);
    const float ss2 = wave_sum(g[0] * g[0] + g[1] * g[1] + g[2] * g[2] + g[3] * g[3]);
    const float r1 = rsqrtf(ss1 * (1.f / 256.f) + 1e-5f), r2 = rsqrtf(ss2 * (1.f / 256.f) + 1e-5f);
    const float4 w1 = *(const float4*)(nwt + (item & 7) * 256 + lane * 4);
    const float4 w2 = *(const float4*)(nwt + ((v2 ? item2 : item) & 7) * 256 + lane * 4);
    *(uint2*)yp1 = make_uint2(pack2(f[0] * r1 * w1.x, f[1] * r1 * w1.y), pack2(f[2] * r1 * w1.z, f[3] * r1 * w1.w));
    if (v2) *(uint2*)yp2 = make_uint2(pack2(g[0] * r2 * w2.x, g[1] * r2 * w2.y), pack2(g[2] * r2 * w2.z, g[3] * r2 * w2.w));
  }
}

template <int LPR>
DI void wkv_item(const Params& p, char* smem, int seq, int head, int part) {
  constexpr int ROWS = 256 / LPR, KPL = 64 / LPR, NV4 = KPL / 4;
  const int tid = TIDX;
  float* sR = (float*)smem;
  float* sK = sR + 2048;
  float* sKK = sK + 2048;
  float* sBB = sKK + 2048;
  float* sW = sBB + 2048;
  float* sV = sW + 2048;
  float* sO = sV + 2048;
  const bf16_t* __restrict__ R = (const bf16_t*)(p.ws + SC_R);
  const bf16_t* __restrict__ K = (const bf16_t*)(p.ws + SC_K);
  const bf16_t* __restrict__ V = (const bf16_t*)(p.ws + SC_V);
  const bf16_t* __restrict__ AAc = (const bf16_t*)(p.ws + SC_AA);
  const float* __restrict__ WD = (const float*)(p.ws + SC_WD);
  bf16_t* O = (bf16_t*)(p.ws + SC_O);
  const bool prompt = seq < 8;
  const int nch = prompt ? 64 : 1, nvalid = prompt ? 32 : 8;
  const int tbase = prompt ? seq * 2048 : TP_ + (seq - 8) * 8;
  const int row_l = tid / LPR, q = tid % LPR, row = part * ROWS + row_l;
  float S[KPL];
  {
    const float* s0 = p.in[I_ST_RW] + (((size_t)(seq - 8) * 16 + head) * 64 + row) * 64 + q * KPL;
#pragma unroll
    for (int e = 0; e < KPL; ++e) S[e] = prompt ? 0.f : s0[e];
  }
  const int pst = tid >> 3, pk0 = (tid & 7) * 8, pcol = head * 64 + pk0;
  const bool pact = pst < nvalid;
  float kk8[8], ka8[8];
  load8f(p.in[I_RW_KK] + pcol, kk8);
  load8f(p.in[I_RW_KA] + pcol, ka8);
  uint4 qr = make_uint4(0, 0, 0, 0), qk = qr, qv = qr, qa = qr;
  float4 qw0 = make_float4(0.f, 0.f, 0.f, 0.f), qw1 = qw0;
#define WKV_ISSUE(c_)                                                       \
  if (pact) {                                                               \
    const size_t o_ = (size_t)(tbase + (c_) * 32 + pst) * 1024 + pcol;      \
    qr = *(const uint4*)(R + o_); qk = *(const uint4*)(K + o_);             \
    qv = *(const uint4*)(V + o_); qa = *(const uint4*)(AAc + o_);           \
    qw0 = *(const float4*)(WD + o_); qw1 = *(const float4*)(WD + o_ + 4);   \
  }
  WKV_ISSUE(0);
  for (int c = 0; c < nch; ++c) {
    const int t0 = tbase + c * 32;
    __syncthreads();
    if (pact) {
      float r8[8], k8[8], v8[8], a8[8];
      unpack8(qr, r8); unpack8(qk, k8); unpack8(qv, v8); unpack8(qa, a8);
      const float w8[8] = {qw0.x, qw0.y, qw0.z, qw0.w, qw1.x, qw1.y, qw1.z, qw1.w};
      float kr[8], ss = 0.f;
#pragma unroll
      for (int e = 0; e < 8; ++e) { kr[e] = k8[e] * kk8[e]; ss += kr[e] * kr[e]; }
      ss = red_lanes<8>(ss);
      const float inv = 1.f / fmaxf(sqrtf(ss), 1e-12f);
      float kp[8], bb[8];
#pragma unroll
      for (int e = 0; e < 8; ++e) { kr[e] *= inv; kp[e] = k8[e] * (1.f + (a8[e] - 1.f) * ka8[e]); bb[e] = kr[e] * a8[e]; }
      const int lo = pst * 64 + pk0;
      store8f(sR + lo, r8); store8f(sK + lo, kp); store8f(sKK + lo, kr); store8f(sBB + lo, bb);
      store8f(sW + lo, w8); store8f(sV + lo, v8);
    }
    __syncthreads();
    if (c + 1 < nch) { WKV_ISSUE(c + 1); }
#define WKV_LOADV(P, st_)                                                                      \
    {                                                                                          \
      const int lo_ = (st_) * 64 + q * KPL;                                                    \
      _Pragma("unroll") for (int e = 0; e < NV4; ++e) {                                        \
        P##kk[e] = *(const float4*)(sKK + lo_ + 4 * e); P##ww[e] = *(const float4*)(sW + lo_ + 4 * e); \
        P##bb[e] = *(const float4*)(sBB + lo_ + 4 * e); P##kp[e] = *(const float4*)(sK + lo_ + 4 * e); \
        P##rr[e] = *(const float4*)(sR + lo_ + 4 * e);                                         \
      }                                                                                        \
      P##vv = sV[(st_) * 64 + row];                                                            \
    }
#define WKV_STEP(P, st_)                                                                       \
    {                                                                                          \
      float sa0 = 0.f, sa1 = 0.f;                                                              \
      _Pragma("unroll") for (int e = 0; e < NV4; ++e) {                                        \
        sa0 += S[4 * e] * P##kk[e].x + S[4 * e + 2] * P##kk[e].z;                              \
        sa1 += S[4 * e + 1] * P##kk[e].y + S[4 * e + 3] * P##kk[e].w;                          \
      }                                                                                        \
      const float sa = red_lanes<LPR>(sa0 + sa1);                                              \
      float o0 = 0.f, o1 = 0.f;                                                                \
      _Pragma("unroll") for (int e = 0; e < NV4; ++e) {                                        \
        S[4 * e] = S[4 * e] * P##ww[e].x - sa * P##bb[e].x + P##vv * P##kp[e].x;               \
        S[4 * e + 1] = S[4 * e + 1] * P##ww[e].y - sa * P##bb[e].y + P##vv * P##kp[e].y;       \
        S[4 * e + 2] = S[4 * e + 2] * P##ww[e].z - sa * P##bb[e].z + P##vv * P##kp[e].z;       \
        S[4 * e + 3] = S[4 * e + 3] * P##ww[e].w - sa * P##bb[e].w + P##vv * P##kp[e].w;       \
        o0 += S[4 * e] * P##rr[e].x + S[4 * e + 2] * P##rr[e].z;                               \
        o1 += S[4 * e + 1] * P##rr[e].y + S[4 * e + 3] * P##rr[e].w;                           \
      }                                                                                        \
      const float oo = red_lanes<LPR>(o0 + o1);                                                \
      if (q == 0) sO[(st_) * ROWS + row_l] = oo;                                               \
    }
    {
      float4 Akk[NV4], Aww[NV4], Abb[NV4], Akp[NV4], Arr[NV4]; float Avv;
      float4 Bkk[NV4], Bww[NV4], Bbb[NV4], Bkp[NV4], Brr[NV4]; float Bvv;
      if (LPR <= 4) {
#pragma unroll 1
        for (int st = 0; st < nvalid; ++st) { WKV_LOADV(A, st); WKV_STEP(A, st); }
      } else {
        WKV_LOADV(A, 0);
#pragma unroll 1
        for (int st = 0; st < nvalid; st += 2) {
          WKV_LOADV(B, st + 1);
          WKV_STEP(A, st);
          if (st + 2 < nvalid) { WKV_LOADV(A, st + 2); }
          WKV_STEP(B, st + 1);
        }
      }
    }
    __syncthreads();
    for (int i = tid; i < nvalid * ROWS; i += NTHR) {
      const int st = i / ROWS, rr = i % ROWS;
      O[(size_t)(t0 + st) * 1024 + head * 64 + part * ROWS + rr] = f2bf(sO[i]);
    }
  }
#undef WKV_ISSUE
#undef WKV_LOADV
#undef WKV_STEP
  float* dst = prompt ? (p.out + O_RW_P + (((size_t)seq * 16 + head) * 64 + row) * 64 + q * KPL)
                      : (p.out + O_RW_S + (((size_t)(seq - 8) * 16 + head) * 64 + row) * 64 + q * KPL);
#pragma unroll
  for (int e = 0; e < KPL; ++e) dst[e] = S[e];
}

template <int LPRP>
DI void ph_wkv(const Params& p, char* smem) {
  constexpr int NPART = 64 / (256 / LPRP);
  const int G = gridDim.x, bid = blockIdx.x;
  const int nP = 128 * NPART;
#pragma nounroll
  for (int it = bid; it < nP; it += G) {
    const int part = it % NPART, sh = it / NPART;
    wkv_item<LPRP>(p, smem, sh >> 4, sh & 15, part);
  }
  const int nS = 2048;
  int first, step;
  if (G > nP) { first = (bid >= nP) ? (bid - nP) : nS; step = G - nP; }
  else { first = bid; step = G; }
#pragma nounroll
  for (int it = first; it < nS; it += step) wkv_item<4>(p, smem, 8 + (it >> 4), it & 15, 0);
}

DI void ph_wkv_post(const Params& p) {
  const int tid_ = TIDX; const int lane = tid_ & 63;
  const int gw = blockIdx.x * 4 + (tid_ >> 6), nw = gridDim.x * 4;
  const bf16_t* __restrict__ R = (const bf16_t*)(p.ws + SC_R);
  const bf16_t* __restrict__ K = (const bf16_t*)(p.ws + SC_K);
  const bf16_t* __restrict__ V = (const bf16_t*)(p.ws + SC_V);
  const bf16_t* __restrict__ AAc = (const bf16_t*)(p.ws + SC_AA);
  const bf16_t* __restrict__ Gg = (const bf16_t*)(p.ws + SC_G);
  const bf16_t* __restrict__ O = (const bf16_t*)(p.ws + SC_O);
  bf16_t* __restrict__ U = (bf16_t*)(p.ws + W_U);
#pragma unroll 2
  for (int item = gw; item < T_ * 4; item += nw) {
    const int t = item >> 2, col = (item & 3) * 256 + lane * 4;
    const size_t o = (size_t)t * 1024 + col;
    float ov[4], rv[4], kv[4], av[4], vv[4], gv[4];
    unpack4(*(const uint2*)(O + o), ov); unpack4(*(const uint2*)(R + o), rv); unpack4(*(const uint2*)(K + o), kv);
    unpack4(*(const uint2*)(AAc + o), av); unpack4(*(const uint2*)(V + o), vv); unpack4(*(const uint2*)(Gg + o), gv);
    const float4 lw = *(const float4*)(p.in[I_RW_LNW] + col), lb = *(const float4*)(p.in[I_RW_LNB] + col);
    const float4 ka = *(const float4*)(p.in[I_RW_KA] + col), rk = *(const float4*)(p.in[I_RW_RK] + col);
    const float lwv[4] = {lw.x, lw.y, lw.z, lw.w}, lbv[4] = {lb.x, lb.y, lb.z, lb.w};
    const float kav[4] = {ka.x, ka.y, ka.z, ka.w}, rkv[4] = {rk.x, rk.y, rk.z, rk.w};
    const float mean = red_lanes<16>(ov[0] + ov[1] + ov[2] + ov[3]) * (1.f / 64.f);
    float d[4], s2 = 0.f, s3 = 0.f;
#pragma unroll
    for (int e = 0; e < 4; ++e) {
      d[e] = ov[e] - mean; s2 += d[e] * d[e];
      const float kp = kv[e] * (1.f + (av[e] - 1.f) * kav[e]);
      s3 += rv[e] * kp * rkv[e];
    }
    s2 = red_lanes<16>(s2); s3 = red_lanes<16>(s3);
    const float rs = rsqrtf(s2 * (1.f / 64.f) + 64e-5f);
    float y[4];
#pragma unroll
    for (int e = 0; e < 4; ++e) y[e] = (d[e] * rs * lwv[e] + lbv[e] + s3 * vv[e]) * gv[e];
    *(uint2*)(U + o) = make_uint2(pack2(y[0], y[1]), pack2(y[2], y[3]));
  }
}

constexpr int NPH = 40;
#ifndef REP_GEMM
#define REP_GEMM 1
#endif
#ifndef REP_SSD
#define REP_SSD 1
#endif
#ifndef REP_WKV
#define REP_WKV 1
#endif
#ifndef REP_MISC
#define REP_MISC 1
#endif

__global__ void __launch_bounds__(NTHR, 2) mega(Params p) {
  __shared__ __attribute__((aligned(16))) char smem[SMEM_BYTES];
  __shared__ uint4 xb_words;
  cg::grid_group grid = cg::this_grid();
  if (threadIdx.x == 0) xb_words = make_uint4(0u, 0u, 0u, 0u);
  __syncthreads();
  XcdBarrier xb = xcd_barrier_post((unsigned*)(p.ws + W_BAR), (volatile LAS unsigned*)&xb_words);
  int ph = 0;
#define PH(...)                                                     \
  {                                                                 \
    if (ph >= p.ph_begin && ph < p.ph_end) {                        \
      __VA_ARGS__;                                                  \
      xcd_barrier(xb);                                              \
    }                                                               \
    ++ph;                                                           \
  }
#define PHR(rep, ...)                                               \
  {                                                                 \
    if (ph >= p.ph_begin && ph < p.ph_end) {                        \
      for (int rep_ = 0; rep_ < (rep); ++rep_) {                    \
        __VA_ARGS__;                                                \
        xcd_barrier(xb);                                            \
      }                                                             \
    }                                                               \
    ++ph;                                                           \
  }
#define PH_LAST(...)                                                \
  {                                                                 \
    if (ph >= p.ph_begin && ph < p.ph_end) { __VA_ARGS__; }         \
    ++ph;                                                           \
  }
  bf16_t* wt = (bf16_t*)(p.ws + W_WT);
  bf16_t* U = (bf16_t*)(p.ws + W_U);
  float* X = (float*)(p.ws + W_X);

  {
    if (ph >= p.ph_begin && ph < p.ph_end) { ph_prologue(p, smem); grid.sync(); }
    ++ph;
    if (threadIdx.x == 0) {
      unsigned* bar = (unsigned*)(p.ws + W_BAR);
      unsigned base = 0;
      for (unsigned jx = 0; jx < 16; ++jx) { const unsigned c = xb_ld(&bar[XB_XCNT(jx)]); base += (jx < xb.x) ? c : 0u; }
      volatile LAS unsigned* st = (volatile LAS unsigned*)&xb_words;
      st[3] = base + st[2];
    }
    __syncthreads();
  }

#pragma nounroll
  for (int layer = 0; layer < 4; ++layer) {
    const int kind = layer % 3;
    PHR(REP_MISC, ph_rmsnorm(p, kind == 2 ? 1 : 0, p.in[I_NMIX] + layer * 1024));
    if (kind == 0) {
      const int ia = layer / 3;
      PHR(REP_GEMM, {
        GJob j = mkjob(U, 1024, wt + WA_IN + (size_t)ia * 2048 * 1024, 1024, 1024, 2048);
        j.o0 = p.ws + SA_XB; j.o1 = p.ws + SA_GT;
        int toff = 0; gemm_run<EPI_LRU_IN, false>(j, 8, toff, smem, VBLOCK());
      });
      PHR(REP_MISC, (ph_conv<1024, false>((const bf16_t*)(p.ws + SA_XB), (bf16_t*)(p.ws + SA_XC),
                               p.in[I_LRU_CW] + (size_t)ia * 4 * 1024, p.in[I_LRU_CB] + (size_t)ia * 1024,
                               p.in[I_ST_LC] + (size_t)ia * 128 * 3 * 1024,
                               p.out + O_LC_P + (size_t)ia * 8 * 3 * 1024, p.out + O_LC_S + (size_t)ia * 128 * 3 * 1024)));
      PHR(REP_GEMM, {
        const int G = gridDim.x;
        for (int tile = VBLOCK(); tile < MT_ * 8; tile += G) {
          const int mt = tile >> 3, jt = tile & 7;
          GJob j = mkjob((const bf16_t*)(p.ws + SA_XC) + jt * 128, 1024,
                         wt + WA_G + (size_t)ia * 2048 * 128, 128, 128, 2048);
          j.o0 = p.ws + SA_AA; j.o1 = p.ws + SA_XC;
          j.x0 = p.in[I_LRU_BR] + ia * 1024; j.x1 = p.in[I_LRU_BI] + ia * 1024; j.x2 = p.in[I_LRU_LAM] + ia * 1024;
          gemm_tile_dma<EPI_GATES>(j, mt * 128, jt * 256, 0, 4, smem);
        }
      });
      PHR(REP_MISC, ph_lru_scan1(p));
      PH(ph_lru_scan2(p, ia));
      PH({
        GJob j = mkjob((const bf16_t*)(p.ws + SA_GT), 1024, wt + WA_OUT + (size_t)ia * 1024 * 1024, 1024, 1024, 1024);
        j.o0 = X;
        int toff = 0; gemm_run<EPI_RESID, false>(j, 4, toff, smem, VBLOCK());
      });
    } else if (kind == 1) {
      PHR(REP_GEMM, {
        GJob j = mkjob(U, 1024, wt + WB_XBC, 1024, 1024, 4128);
        j.o0 = p.ws + SB_XBCP; j.o1 = p.ws + SB_DT; j.x0 = p.in[I_SSM_DTB];
        int toff = 0; gemm_run<EPI_SSM_XBC, false>(j, 17, toff, smem, VBLOCK());
      });
      PHR(REP_MISC, (ph_conv<4096, true>((const bf16_t*)(p.ws + SB_XBCP), (bf16_t*)(p.ws + SB_XBC),
                              p.in[I_SSM_CW], p.in[I_SSM_CB], p.in[I_ST_SC],
                              p.out + O_SC_P, p.out + O_SC_S)));
      PHR(REP_SSD, ph_ssd(p, smem));
      PH({
        GJob j = mkjob(U, 1024, wt + WB_Z, 1024, 1024, 2048);
        j.o0 = p.ws + SB_Y;
        int toff = 0; gemm_run<EPI_SSM_Z, false>(j, 8, toff, smem, VBLOCK());
      });
      PH(ph_gnorm(p));
      PH({
        GJob j = mkjob((const bf16_t*)(p.ws + SB_Y), 2048, wt + WB_OUT, 2048, 2048, 1024);
        j.o0 = X;
        gemm_streamk<EPI_RESID>(j, 4, smem, VBLOCK(), (unsigned*)(p.ws + W_BAR) + 4096, (unsigned)(layer * 2 + 1));
      });
    } else {
      PHR(REP_GEMM, {
        int toff = 0;
        for (int s = 0; s < 3; ++s) {
          GJob j = mkjob(U, 1024, wt + WC_RKV + (size_t)s * 1024 * 1024, 1024, 1024, 1024);
          j.A2 = (const bf16_t*)(p.ws + SC_UP); j.mu = p.in[I_RW_MU] + s * 1024;
          j.o0 = p.ws + SC_R + (size_t)s * SZ_TD2; j.ldo = 1024; j.act = 0;
          gemm_run<EPI_ST, true>(j, 8, toff, smem, VBLOCK());
        }
        for (int s = 0; s < 3; ++s) {
          const int nv = (s == 2) ? 128 : 64;
          GJob j = mkjob(U, 1024, wt + WC_L1 + (size_t)s * 64 * 1024, 1024, 1024, nv);
          j.A2 = (const bf16_t*)(p.ws + SC_UP); j.mu = p.in[I_RW_MU] + (3 + s) * 1024;
          j.o0 = p.ws + SC_LH + (size_t)s * 64 * 2; j.ldo = 256; j.act = (s == 0) ? 1 : (s == 2 ? 2 : 0);
          gemm_run<EPI_ST, true>(j, 1, toff, smem, VBLOCK());
        }
      });
      PHR(REP_GEMM, {
        int toff = 0;
        const bf16_t* LH = (const bf16_t*)(p.ws + SC_LH);
        {
          GJob j = mkjob(LH, 256, wt + WC_W2, 64, 64, 1024);
          j.o0 = p.ws + SC_WD; j.x0 = p.in[I_RW_W0];
          gemm_run<EPI_DECAY, false>(j, 4, toff, smem, VBLOCK());
        }
        {
          GJob j = mkjob(LH + 64, 256, wt + WC_A2, 64, 64, 1024);
          j.o0 = p.ws + SC_AA; j.x0 = p.in[I_RW_A0];
          gemm_run<EPI_SIGB, false>(j, 4, toff, smem, VBLOCK());
        }
        {
          GJob j = mkjob(LH + 128, 256, wt + WC_G2, 128, 128, 1024);
          j.o0 = p.ws + SC_G; j.ldo = 1024; j.act = 0;
          gemm_run<EPI_ST, false>(j, 4, toff, smem, VBLOCK());
        }
      });
      PHR(REP_WKV, ph_wkv<8>(p, smem));
      PHR(REP_MISC, ph_wkv_post(p));
      PH({
        GJob j = mkjob(U, 1024, wt + WC_OUT, 1024, 1024, 1024);
        j.o0 = X;
        int toff = 0; gemm_run<EPI_RESID, false>(j, 4, toff, smem, VBLOCK());
      });
    }
    PHR(REP_MISC, ph_rmsnorm(p, 0, p.in[I_NFFN] + layer * 1024));
    PHR(REP_GEMM, {
      GJob j = mkjob(U, 1024, wt + WF_1 + (size_t)layer * 4096 * 1024, 1024, 1024, 4096);
      j.o0 = p.ws + S_HB;
      int toff = 0; gemm_run<EPI_FFN1, false>(j, 16, toff, smem, VBLOCK());
    });
    PH({
      GJob j = mkjob((const bf16_t*)(p.ws + S_HB), 4096, wt + WF_2 + (size_t)layer * 4096 * 1024, 4096, 4096, 1024);
      j.o0 = X;
      gemm_streamk<EPI_RESID>(j, 4, smem, VBLOCK(), (unsigned*)(p.ws + W_BAR) + 4096, (unsigned)(layer * 2 + 2));
    });
  }
  PH_LAST(ph_rmsnorm(p, 2, p.in[I_NFIN]));
#undef PH
#undef PH_LAST
}

extern "C" void kernel_launch(void* const* d_in, const int* in_sizes, int n_in, void* d_out, int out_size,
                              void* d_ws, size_t ws_size, hipStream_t stream) {
  Params p;
  memset(&p, 0, sizeof(p));
  for (int i = 0; i < N_IN; ++i) p.in[i] = (const float*)d_in[i];
  p.out = (float*)d_out;
  p.ws = (char*)d_ws;
  p.ph_begin = 0;
  p.ph_end = 1000;
  static int grid_blocks = 0;
  if (!grid_blocks) {
    int dev = 0, cus = 0, per_cu = 0;
    hipGetDevice(&dev);
    hipDeviceGetAttribute(&cus, hipDeviceAttributeMultiprocessorCount, dev);
    hipOccupancyMaxActiveBlocksPerMultiprocessor(&per_cu, mega, NTHR, 0);
    if (per_cu > 2) per_cu = 2;
    if (per_cu < 1) per_cu = 1;
    grid_blocks = cus * per_cu;
  }
  if (ws_size < (size_t)536870912) fprintf(stderr, "workspace too small: %zu\n", ws_size);
  (void)hipMemsetAsync((char*)d_ws + W_BAR, 0, (4096 + 1024) * 4, stream);
  void* args[] = {&p};
  hipError_t e = hipLaunchCooperativeKernel((void*)mega, dim3(grid_blocks), dim3(NTHR), args, 0, stream);
  if (e != hipSuccess) fprintf(stderr, "cooperative launch failed: %s (grid %d)\n", hipGetErrorString(e), grid_blocks);
}
```

```cpp
#include <hip/hip_runtime.h>
#include <hip/hip_cooperative_groups.h>
#include <stdint.h>
#include <stdio.h>
#include <string.h>
namespace cg = cooperative_groups;

typedef unsigned short bf16_t;
typedef __attribute__((ext_vector_type(8))) short bf16x8;
typedef __attribute__((ext_vector_type(16))) float f32x16;

#define DI __device__ __forceinline__

constexpr int T_ = 17408;
constexpr int TP_ = 16384;
constexpr int NTHR = 256;
constexpr int MT_ = T_ / 128;

enum {
  I_XP = 0, I_XS, I_ST_LC, I_ST_LH, I_ST_SC, I_ST_SS, I_ST_RS, I_ST_RW,
  I_NMIX, I_NFFN, I_NFIN,
  I_LRU_WIN, I_LRU_CW, I_LRU_CB, I_LRU_WR, I_LRU_BR, I_LRU_WI, I_LRU_BI, I_LRU_LAM, I_LRU_WOUT,
  I_SSM_WIN, I_SSM_CW, I_SSM_CB, I_SSM_DTB, I_SSM_ALOG, I_SSM_D, I_SSM_NW, I_SSM_WOUT,
  I_RW_MU, I_RW_WRKV, I_RW_W0, I_RW_WW1, I_RW_WW2, I_RW_A0, I_RW_WA1, I_RW_WA2, I_RW_WG1, I_RW_WG2,
  I_RW_KK, I_RW_KA, I_RW_RK, I_RW_LNW, I_RW_LNB, I_RW_WOUT,
  I_FFN_W1, I_FFN_W2, N_IN
};

constexpr size_t O_Y = 0;
constexpr size_t O_LC_P = O_Y + (size_t)T_ * 1024;
constexpr size_t O_LC_S = O_LC_P + 2 * 8 * 3 * 1024;
constexpr size_t O_LH_P = O_LC_S + 2 * 128 * 3 * 1024;
constexpr size_t O_LH_S = O_LH_P + 2 * 8 * 1024;
constexpr size_t O_SC_P = O_LH_S + 2 * 128 * 1024;
constexpr size_t O_SC_S = O_SC_P + 8 * 3 * 4096;
constexpr size_t O_SS_P = O_SC_S + 128 * 3 * 4096;
constexpr size_t O_SS_S = O_SS_P + (size_t)8 * 32 * 64 * 128;
constexpr size_t O_RS_P = O_SS_S + (size_t)128 * 32 * 64 * 128;
constexpr size_t O_RS_S = O_RS_P + 8 * 1024;
constexpr size_t O_RW_P = O_RS_S + 128 * 1024;
constexpr size_t O_RW_S = O_RW_P + 8 * 16 * 64 * 64;

constexpr size_t W_X = 0;
constexpr size_t W_U = W_X + (size_t)T_ * 1024 * 4;
constexpr size_t W_WT = W_U + (size_t)T_ * 1024 * 2;
constexpr size_t WA_IN = 0;
constexpr size_t WA_G = WA_IN + 2 * 2048 * 1024;
constexpr size_t WA_OUT = WA_G + 2 * 2048 * 128;
constexpr size_t WB_XBC = WA_OUT + 2 * 1024 * 1024;
constexpr size_t WB_Z = WB_XBC + 4128 * 1024;
constexpr size_t WB_OUT = WB_Z + 2048 * 1024;
constexpr size_t WC_RKV = WB_OUT + 1024 * 2048;
constexpr size_t WC_L1 = WC_RKV + 3 * 1024 * 1024;
constexpr size_t WC_W2 = WC_L1 + 256 * 1024;
constexpr size_t WC_A2 = WC_W2 + 1024 * 64;
constexpr size_t WC_G2 = WC_A2 + 1024 * 64;
constexpr size_t WC_OUT = WC_G2 + 1024 * 128;
constexpr size_t WF_1 = WC_OUT + 1024 * 1024;
constexpr size_t WF_2 = WF_1 + (size_t)4 * 4096 * 1024;
constexpr size_t W_WT_ELEMS = WF_2 + (size_t)4 * 4096 * 1024;
constexpr size_t W_S = W_WT + W_WT_ELEMS * 2;
constexpr size_t SZ_TD2 = (size_t)T_ * 1024 * 2;
constexpr size_t SZ_TD4 = (size_t)T_ * 1024 * 4;
constexpr size_t S_HB = W_S;
constexpr size_t SA_XB = W_S;
constexpr size_t SA_GT = SA_XB + SZ_TD2;
constexpr size_t SA_XC = SA_GT + SZ_TD2;
constexpr size_t SA_AA = SA_XC + SZ_TD2;
constexpr size_t SA_BB = SA_AA + SZ_TD4;
constexpr size_t SA_CP = SA_BB + SZ_TD4;
constexpr size_t SA_CS = SA_CP + 8 * 64 * 1024 * 4;
constexpr size_t SB_XBCP = W_S;
constexpr size_t SB_Y = W_S;
constexpr size_t SB_XBC = SB_XBCP + SZ_TD2 * 4;
constexpr size_t SB_DT = SB_XBC + SZ_TD2 * 4;
constexpr size_t SC_UP = W_S;
constexpr size_t SC_O = W_S;
constexpr size_t SC_R = SC_UP + SZ_TD2;
constexpr size_t SC_K = SC_R + SZ_TD2;
constexpr size_t SC_V = SC_K + SZ_TD2;
constexpr size_t SC_LH = SC_V + SZ_TD2;
constexpr size_t SC_WD = SC_LH + (size_t)T_ * 256 * 2;
constexpr size_t SC_AA = SC_WD + SZ_TD4;
constexpr size_t SC_G = SC_AA + SZ_TD2;
constexpr size_t SC_END = SC_G + SZ_TD2;
static_assert(SC_END <= (size_t)536870912, "ws overflow C");
static_assert(SB_DT + (size_t)T_ * 32 * 4 <= (size_t)536870912, "ws overflow B");
static_assert(SA_CS + 8 * 64 * 1024 * 4 <= (size_t)536870912, "ws overflow A");

constexpr int SMEM_BYTES = 80384;
constexpr size_t W_BAR = (size_t)536870912 - 65536;

struct Params {
  const float* in[N_IN];
  float* out;
  char* ws;
  int ph_begin, ph_end;
};

DI float bf2f(bf16_t h) { return __uint_as_float(((unsigned)h) << 16); }
DI bf16_t f2bf(float f) {
  unsigned u = __float_as_uint(f);
  u += 0x7FFFu + ((u >> 16) & 1u);
  return (bf16_t)(u >> 16);
}
DI unsigned pack2(float a, float b) { return (unsigned)f2bf(a) | ((unsigned)f2bf(b) << 16); }
DI void unpack8(const uint4 v, float (&f)[8]) {
  f[0] = __uint_as_float(v.x << 16); f[1] = __uint_as_float(v.x & 0xFFFF0000u);
  f[2] = __uint_as_float(v.y << 16); f[3] = __uint_as_float(v.y & 0xFFFF0000u);
  f[4] = __uint_as_float(v.z << 16); f[5] = __uint_as_float(v.z & 0xFFFF0000u);
  f[6] = __uint_as_float(v.w << 16); f[7] = __uint_as_float(v.w & 0xFFFF0000u);
}
DI void unpack4(const uint2 v, float (&f)[4]) {
  f[0] = __uint_as_float(v.x << 16); f[1] = __uint_as_float(v.x & 0xFFFF0000u);
  f[2] = __uint_as_float(v.y << 16); f[3] = __uint_as_float(v.y & 0xFFFF0000u);
}
DI uint4 pack8(const float (&f)[8]) {
  return make_uint4(pack2(f[0], f[1]), pack2(f[2], f[3]), pack2(f[4], f[5]), pack2(f[6], f[7]));
}
DI void load8f(const float* p, float (&f)[8]) {
  float4 a = *(const float4*)p, b = *(const float4*)(p + 4);
  f[0] = a.x; f[1] = a.y; f[2] = a.z; f[3] = a.w; f[4] = b.x; f[5] = b.y; f[6] = b.z; f[7] = b.w;
}
DI void store8f(float* p, const float (&f)[8]) {
  *(float4*)p = make_float4(f[0], f[1], f[2], f[3]);
  *(float4*)(p + 4) = make_float4(f[4], f[5], f[6], f[7]);
}
DI float sigmoidf_(float x) { return 1.f / (1.f + __expf(-x)); }
DI float siluf_(float x) { return x / (1.f + __expf(-x)); }
DI float tanhf_(float y) { return 1.f - 2.f / (1.f + __expf(2.f * y)); }
DI float geluf_(float x) { return 0.5f * x * (1.f + tanhf_(0.7978845608028654f * (x + 0.044715f * x * x * x))); }
DI float softplusf_(float x) { return fmaxf(x, 0.f) + log1pf(__expf(-fabsf(x))); }
DI float softplus_fast(float x) { return fmaxf(x, 0.f) + __logf(1.f + __expf(-fabsf(x))); }
DI float wave_sum(float v) {
#pragma unroll
  for (int o = 32; o >= 1; o >>= 1) v += __shfl_xor(v, o, 64);
  return v;
}
template <int CTRL> DI float dppf(float x) {
  return __int_as_float(__builtin_amdgcn_update_dpp(0, __float_as_int(x), CTRL, 0xf, 0xf, false));
}
template <int N> DI float red_lanes(float x) {
  x += dppf<0xB1>(x);
  x += dppf<0x4E>(x);
  if (N >= 8) x += dppf<0x141>(x);
  if (N >= 16) x += dppf<0x140>(x);
  return x;
}
DI void tok_info(int t, int& seq, int& l, int& L) {
  if (t < TP_) { seq = t >> 11; l = t & 2047; L = 2048; }
  else { int u = t - TP_; seq = 8 + (u >> 3); l = u & 7; L = 8; }
}
DI int opq(int x) { asm volatile("" : "+v"(x)); return x; }
#define TIDX opq((int)threadIdx.x)
DI f32x16 mfma32(bf16x8 a, bf16x8 b, f32x16 c) { return __builtin_amdgcn_mfma_f32_32x32x16_bf16(a, b, c, 0, 0, 0); }


#define XB_TMO      128
#define XB_XCNT(j)  (256  + 64 * (j))
#define XB_XSUB(j)  (1280 + 64 * (j))
#define XB_XGEN(j)  (2304 + 64 * (j))
#define XB_TOP      3328
#define XB_TOPGEN   3392
#define XCD_BAR_WORDS 3456
#define XB_SPIN_CAP (1u << 22)
#define LAS __attribute__((address_space(3)))
DI unsigned xb_ld(unsigned* p) { return __hip_atomic_load(p, __ATOMIC_RELAXED, __HIP_MEMORY_SCOPE_AGENT); }
DI unsigned xb_add(unsigned* p, unsigned v) { return __hip_atomic_fetch_add(p, v, __ATOMIC_RELAXED, __HIP_MEMORY_SCOPE_AGENT); }
DI unsigned xb_xcc_id() { return (unsigned)__builtin_amdgcn_s_getreg((3 << 11) | 20) & 0xFu; }
#define XB_SPIN(cond, bar) do { unsigned _sp = 0; while (cond) { __builtin_amdgcn_s_sleep(1); \
    if ((++_sp & 255u) == 0u) { if (xb_ld(&(bar)[XB_TMO])) break; if (_sp > XB_SPIN_CAP) { atomicAdd(&(bar)[XB_TMO], 1u); break; } } } } while (0)
struct XcdBarrier { unsigned* bar; unsigned x; volatile LAS unsigned* st; };
DI XcdBarrier xcd_barrier_post(unsigned* bar, volatile LAS unsigned* st) {
  XcdBarrier b; b.bar = bar; b.x = xb_xcc_id(); b.st = st;
  if (threadIdx.x == 0) st[2] = xb_add(&bar[XB_XCNT(b.x)], 1u);
  return b;
}
DI void xcd_barrier_complete(unsigned* bar, unsigned x, unsigned& nloc, unsigned& nx) {
  const unsigned G = gridDim.x * gridDim.y * gridDim.z;
  unsigned sum, cnt, mine, sp = 0u;
  for (;;) {
    sum = 0u; cnt = 0u; mine = 0u;
#pragma unroll
    for (unsigned j = 0; j < 16; ++j) { const unsigned c = xb_ld(&bar[XB_XCNT(j)]); sum += c; cnt += (c > 0u) ? 1u : 0u; mine = (j == x) ? c : mine; }
    if (sum == G) break;
    __builtin_amdgcn_s_sleep(1);
    if ((++sp & 255u) == 0u) { if (xb_ld(&bar[XB_TMO])) break; if (sp > XB_SPIN_CAP) { atomicAdd(&bar[XB_TMO], 1u); break; } }
  }
  nloc = mine > 0u ? mine : 1u; nx = cnt > 0u ? cnt : 1u;
}
DI void xcd_barrier(const XcdBarrier& b) {
  asm volatile("s_waitcnt vmcnt(0)" ::: "memory");
  __syncthreads();
  if (threadIdx.x == 0) {
    unsigned* bar = b.bar;
    __builtin_amdgcn_s_waitcnt(0);
    unsigned nloc = b.st[0], nx = b.st[1];
    if (nloc == 0u) { xcd_barrier_complete(bar, b.x, nloc, nx); b.st[0] = nloc; b.st[1] = nx; }
    const unsigned old = xb_add(&bar[XB_XSUB(b.x)], 1u);
    const unsigned gen = old / nloc;
    if (old + 1u == (gen + 1u) * nloc) {
      __builtin_amdgcn_fence(__ATOMIC_RELEASE, "agent");
      asm volatile("s_waitcnt vmcnt(0)" ::: "memory");
      const unsigned og = xb_add(&bar[XB_TOP], 1u);
      const unsigned tg = og / nx;
      if (og + 1u == (tg + 1u) * nx) xb_add(&bar[XB_TOPGEN], 1u);
      else XB_SPIN(xb_ld(&bar[XB_TOPGEN]) == tg, bar);
      __builtin_amdgcn_fence(__ATOMIC_ACQUIRE, "agent");
      xb_add(&bar[XB_XGEN(b.x)], 1u);
      asm volatile("s_waitcnt vmcnt(0)" ::: "memory");
    } else {
      XB_SPIN(xb_ld(&bar[XB_XGEN(b.x)]) == gen, bar);
      __builtin_amdgcn_fence(__ATOMIC_ACQUIRE, "agent");
      asm volatile("s_waitcnt vmcnt(0)" ::: "memory");
    }
  }
  __syncthreads();
}

struct GJob {
  const bf16_t* A; const bf16_t* A2; const float* mu; const bf16_t* Bt;
  int lda, ldb, K, nvalid;
  void* o0; void* o1; const float* x0; const float* x1; const float* x2;
  int ldo, act;
};
enum { EPI_LRU_IN = 0, EPI_GATES, EPI_RESID, EPI_SSM_XBC, EPI_SSM_Z, EPI_FFN1, EPI_ST, EPI_DECAY, EPI_SIGB };

template <int EPI> DI void epi_elem(const GJob& j, int row, int col, float v) {
  if (EPI == EPI_LRU_IN) {
    if (col < 1024) ((bf16_t*)j.o0)[(size_t)row * 1024 + col] = f2bf(v);
    else ((bf16_t*)j.o1)[(size_t)row * 1024 + col - 1024] = f2bf(geluf_(v));
  } else if (EPI == EPI_RESID) {
    unsafeAtomicAdd((float*)j.o0 + (size_t)row * 1024 + col, v);
  } else if (EPI == EPI_SSM_XBC) {
    if (col < 4096) ((bf16_t*)j.o0)[(size_t)row * 4096 + col] = f2bf(v);
  } else if (EPI == EPI_SSM_Z) {
    bf16_t* y = (bf16_t*)j.o0 + (size_t)row * 2048 + col;
    *y = f2bf(bf2f(*y) * siluf_(v));
  } else if (EPI == EPI_FFN1) {
    float r = fmaxf(v, 0.f);
    ((bf16_t*)j.o0)[(size_t)row * 4096 + col] = f2bf(r * r);
  } else if (EPI == EPI_ST) {
    if (col < j.nvalid) {
      float r = v;
      if (j.act == 1) r = tanhf_(v); else if (j.act == 2) r = sigmoidf_(v);
      ((bf16_t*)j.o0)[(size_t)row * j.ldo + col] = f2bf(r);
    }
  } else if (EPI == EPI_DECAY) {
    float wl = -softplusf_(-(j.x0[col] + v)) - 0.5f;
    ((float*)j.o0)[(size_t)row * 1024 + col] = __expf(-__expf(wl));
  } else if (EPI == EPI_SIGB) {
    ((bf16_t*)j.o0)[(size_t)row * 1024 + col] = f2bf(sigmoidf_(j.x0[col] + v));
  }
}

DI void quad_transpose4(float (&v)[4], int l) {
  const bool o1 = l & 1, o2 = l & 2;
  {
    const float s01 = o1 ? v[0] : v[1], s23 = o1 ? v[2] : v[3];
    const float r01 = dppf<0xB1>(s01), r23 = dppf<0xB1>(s23);
    if (o1) { v[0] = r01; v[2] = r23; } else { v[1] = r01; v[3] = r23; }
  }
  {
    const float s02 = o2 ? v[0] : v[2], s13 = o2 ? v[1] : v[3];
    const float r02 = dppf<0x4E>(s02), r13 = dppf<0x4E>(s13);
    if (o2) { v[0] = r02; v[1] = r13; } else { v[2] = r02; v[3] = r13; }
  }
}
DI uint2 pack4(float a, float b, float c, float d) { return make_uint2(pack2(a, b), pack2(c, d)); }
template <int EPI> DI void epi4(const GJob& j, int row, int col, const float (&v)[4]) {
  if (EPI == EPI_LRU_IN) {
    if (col < 1024) *(uint2*)((bf16_t*)j.o0 + (size_t)row * 1024 + col) = pack4(v[0], v[1], v[2], v[3]);
    else *(uint2*)((bf16_t*)j.o1 + (size_t)row * 1024 + col - 1024) = pack4(geluf_(v[0]), geluf_(v[1]), geluf_(v[2]), geluf_(v[3]));
  } else if (EPI == EPI_RESID) {
    float4* x = (float4*)((float*)j.o0 + (size_t)row * 1024 + col);
    float4 t = *x; t.x += v[0]; t.y += v[1]; t.z += v[2]; t.w += v[3]; *x = t;
  } else if (EPI == EPI_SSM_XBC) {
    if (col < 4096) *(uint2*)((bf16_t*)j.o0 + (size_t)row * 4096 + col) = pack4(v[0], v[1], v[2], v[3]);
  } else if (EPI == EPI_SSM_Z) {
    uint2* y = (uint2*)((bf16_t*)j.o0 + (size_t)row * 2048 + col);
    float f[4]; unpack4(*y, f);
    *y = pack4(f[0] * siluf_(v[0]), f[1] * siluf_(v[1]), f[2] * siluf_(v[2]), f[3] * siluf_(v[3]));
  } else if (EPI == EPI_FFN1) {
    const float r0 = fmaxf(v[0], 0.f), r1 = fmaxf(v[1], 0.f), r2 = fmaxf(v[2], 0.f), r3 = fmaxf(v[3], 0.f);
    *(uint2*)((bf16_t*)j.o0 + (size_t)row * 4096 + col) = pack4(r0 * r0, r1 * r1, r2 * r2, r3 * r3);
  } else if (EPI == EPI_ST) {
    if (col < j.nvalid) {
      float r[4];
#pragma unroll
      for (int e = 0; e < 4; ++e) r[e] = (j.act == 1) ? tanhf_(v[e]) : ((j.act == 2) ? sigmoidf_(v[e]) : v[e]);
      *(uint2*)((bf16_t*)j.o0 + (size_t)row * j.ldo + col) = pack4(r[0], r[1], r[2], r[3]);
    }
  } else if (EPI == EPI_DECAY) {
    const float4 w0 = *(const float4*)(j.x0 + col);
    const float w[4] = {w0.x, w0.y, w0.z, w0.w};
    float r[4];
#pragma unroll
    for (int e = 0; e < 4; ++e) r[e] = __expf(-__expf(-softplus_fast(-(w[e] + v[e])) - 0.5f));
    *(float4*)((float*)j.o0 + (size_t)row * 1024 + col) = make_float4(r[0], r[1], r[2], r[3]);
  } else if (EPI == EPI_SIGB) {
    const float4 a0 = *(const float4*)(j.x0 + col);
    *(uint2*)((bf16_t*)j.o0 + (size_t)row * 1024 + col) =
        pack4(sigmoidf_(a0.x + v[0]), sigmoidf_(a0.y + v[1]), sigmoidf_(a0.z + v[2]), sigmoidf_(a0.w + v[3]));
  }
}

template <int EPI, bool MIX>
DI void gemm_tile(const GJob& j, int m0, int n0, int kt0, int kt1, char* smem) {
  const int tid = TIDX, lane = tid & 63, w = tid >> 6;
  const int wm = w >> 1, wn = w & 1, r32 = lane & 31, hh = lane >> 5;
  const int lrow = tid >> 3, kc = tid & 7;
  f32x16 acc[2][2];
#pragma unroll
  for (int a = 0; a < 2; ++a)
#pragma unroll
    for (int b = 0; b < 2; ++b)
#pragma unroll
      for (int r = 0; r < 16; ++r) acc[a][b][r] = 0.f;
  uint4 qa00, qa01, qa02, qa03, qb00, qb01, qb02, qb03, qc00, qc01, qc02, qc03;
  uint4 qa10, qa11, qa12, qa13, qb10, qb11, qb12, qb13, qc10, qc11, qc12, qc13;
  qc00 = qc01 = qc02 = qc03 = qc10 = qc11 = qc12 = qc13 = make_uint4(0, 0, 0, 0);
  const int nk = kt1 - kt0;
  const bf16_t* Ap = j.A + (size_t)(m0 + lrow) * j.lda + kc * 8 + (size_t)kt0 * 64;
  const bf16_t* A2p = MIX ? (j.A2 + (size_t)(m0 + lrow) * j.lda + kc * 8 + (size_t)kt0 * 64) : nullptr;
  const bf16_t* Bp = j.Bt + (size_t)(n0 + lrow) * j.ldb + kc * 8 + (size_t)kt0 * 64;
  const size_t astep = (size_t)32 * j.lda, bstep = (size_t)32 * j.ldb;
  const bool bv0 = (n0 + lrow) < j.nvalid, bv1 = (n0 + lrow + 32) < j.nvalid;
  const bool bv2 = (n0 + lrow + 64) < j.nvalid, bv3 = (n0 + lrow + 96) < j.nvalid;
  const uint4 z4 = make_uint4(0, 0, 0, 0);

#define LD1(s, i, kt)                                                                 \
  qa##s##i = *(const uint4*)(Ap + i * astep + (kt) * 64);                             \
  if (MIX) qc##s##i = *(const uint4*)(A2p + i * astep + (kt) * 64);                   \
  qb##s##i = z4;                                                                      \
  if (bv##i) qb##s##i = *(const uint4*)(Bp + i * bstep + (kt) * 64);
#define GLOAD(s, kt) { LD1(s, 0, kt) LD1(s, 1, kt) LD1(s, 2, kt) LD1(s, 3, kt) }
#define ST1(s, i, As_, Bs_)                                                           \
  if (MIX) {                                                                          \
    float f1[8], f2[8]; unpack8(qa##s##i, f1); unpack8(qc##s##i, f2);                 \
    _Pragma("unroll") for (int e = 0; e < 8; ++e) f1[e] = f1[e] + (f2[e] - f1[e]) * mu8[e]; \
    qa##s##i = pack8(f1);                                                             \
  }                                                                                   \
  *(uint4*)(As_ + (lrow + 32 * i) * 144 + kc * 16) = qa##s##i;                        \
  *(uint4*)(Bs_ + (lrow + 32 * i) * 144 + kc * 16) = qb##s##i;
#define SSTORE(s, kt, buf)                                                            \
  {                                                                                   \
    char* As_ = smem + (buf) * 36864; char* Bs_ = As_ + 18432;                        \
    float mu8[8];                                                                     \
    if (MIX) load8f(j.mu + (kt0 + (kt)) * 64 + kc * 8, mu8);                          \
    ST1(s, 0, As_, Bs_) ST1(s, 1, As_, Bs_) ST1(s, 2, As_, Bs_) ST1(s, 3, As_, Bs_)   \
  }
#define LOADF(F, ks)                                                                  \
  bf16x8 F##a0 = *(const bf16x8*)(ap + (ks) * 32);                                    \
  bf16x8 F##a1 = *(const bf16x8*)(ap + 32 * 144 + (ks) * 32);                         \
  bf16x8 F##b0 = *(const bf16x8*)(bp + (ks) * 32);                                    \
  bf16x8 F##b1 = *(const bf16x8*)(bp + 32 * 144 + (ks) * 32);
#define MFMA4(F)                                                                      \
  acc[0][0] = mfma32(F##a0, F##b0, acc[0][0]);                                        \
  acc[0][1] = mfma32(F##a0, F##b1, acc[0][1]);                                        \
  acc[1][0] = mfma32(F##a1, F##b0, acc[1][0]);                                        \
  acc[1][1] = mfma32(F##a1, F##b1, acc[1][1]);
#define COMPUTE(buf)                                                                  \
  {                                                                                   \
    const char* As_ = smem + (buf) * 36864; const char* Bs_ = As_ + 18432;            \
    const char* ap = As_ + (wm * 64 + r32) * 144 + hh * 16;                           \
    const char* bp = Bs_ + (wn * 64 + r32) * 144 + hh * 16;                           \
    LOADF(f0, 0) LOADF(f1, 1)                                                         \
    __builtin_amdgcn_sched_barrier(0);                                                \
    MFMA4(f0)                                                                         \
    LOADF(f2, 2)                                                                      \
    __builtin_amdgcn_sched_barrier(0);                                                \
    MFMA4(f1)                                                                         \
    LOADF(f3, 3)                                                                      \
    __builtin_amdgcn_sched_barrier(0);                                                \
    MFMA4(f2)                                                                         \
    __builtin_amdgcn_sched_barrier(0);                                                \
    MFMA4(f3)                                                                         \
    __builtin_amdgcn_sched_barrier(0);                                                \
  }

  qa10 = qa11 = qa12 = qa13 = qb10 = qb11 = qb12 = qb13 = z4;
  if (MIX) {
    GLOAD(0, 0);
    SSTORE(0, 0, 0);
    __syncthreads();
    for (int i = 0; i < nk; ++i) {
      if (i + 1 < nk) GLOAD(0, i + 1);
      if (i & 1) { COMPUTE(1); } else { COMPUTE(0); }
      if (i + 1 < nk) { if (i & 1) { SSTORE(0, i + 1, 0); } else { SSTORE(0, i + 1, 1); } }
      __syncthreads();
    }
  } else if (nk == 1) {
    GLOAD(0, 0);
    SSTORE(0, 0, 0);
    __syncthreads();
    COMPUTE(0);
    __syncthreads();
  } else {
    GLOAD(0, 0);
    GLOAD(1, 1);
    SSTORE(0, 0, 0);
    __syncthreads();
#pragma unroll 1
    for (int i = 0; i + 2 < nk; i += 2) {
      GLOAD(0, i + 2);
      COMPUTE(0);
      SSTORE(1, i + 1, 1);
      __syncthreads();
      GLOAD(1, i + 3);
      COMPUTE(1);
      SSTORE(0, i + 2, 0);
      __syncthreads();
    }
    COMPUTE(0);
    SSTORE(1, nk - 1, 1);
    __syncthreads();
    COMPUTE(1);
    __syncthreads();
  }
#undef LD1
#undef ST1
#undef LOADF
#undef MFMA4
#undef GLOAD
#undef SSTORE
#undef COMPUTE

  if (EPI == EPI_GATES) {
    const int ch = (n0 >> 7) * 64 + wn * 32 + r32;
    const float br = j.x0[ch], bi = j.x1[ch];
    const float spl = softplusf_(-j.x2[ch]);
    const bf16_t* XC = (const bf16_t*)j.o1;
    float* AA = (float*)j.o0;
    float* BBp = AA + (size_t)T_ * 1024;
#pragma unroll
    for (int mi = 0; mi < 2; ++mi)
#pragma unroll
      for (int r = 0; r < 16; ++r) {
        const int row = m0 + wm * 64 + mi * 32 + (r & 3) + 8 * (r >> 2) + 4 * hh;
        const float rg = sigmoidf_(acc[mi][0][r] + br);
        const float ig = sigmoidf_(acc[mi][1][r] + bi);
        const float la = -8.f * rg * spl;
        const float xc = bf2f(XC[(size_t)row * 1024 + ch]);
        const bool reset = (row < TP_) && ((row & 2047) == 0);
        const float a = reset ? 0.f : __expf(la);
        const float mult = reset ? 1.f : sqrtf(fmaxf(-expm1f(2.f * la), 0.f));
        AA[(size_t)row * 1024 + ch] = a;
        BBp[(size_t)row * 1024 + ch] = mult * ig * xc;
      }
  } else {
#pragma unroll
    for (int mi = 0; mi < 2; ++mi)
#pragma unroll
      for (int ni = 0; ni < 2; ++ni)
#pragma unroll
        for (int r = 0; r < 16; ++r) {
          const int row = m0 + wm * 64 + mi * 32 + (r & 3) + 8 * (r >> 2) + 4 * hh;
          const int col = n0 + wn * 64 + ni * 32 + r32;
          epi_elem<EPI>(j, row, col, acc[mi][ni][r]);
          if ((r & 7) == 7) __builtin_amdgcn_sched_barrier(0);
        }
  }
}

constexpr int DSLOT = 24576;
template <int EPI>
DI void gemm_tile_dma(const GJob& j, int m0, int n0, int k0, int k1, char* smem, unsigned* wflag = nullptr, unsigned epoch = 0u) {
  const int tid = TIDX, lane = tid & 63, w = tid >> 6;
  const int wm = w >> 1, wn = w & 1, r32 = lane & 31, hh = lane >> 5;
  f32x16 acc[2][4];
#pragma unroll
  for (int a = 0; a < 2; ++a)
#pragma unroll
    for (int b = 0; b < 4; ++b)
#pragma unroll
      for (int r = 0; r < 16; ++r) acc[a][b][r] = 0.f;
  const int nk = k1 - k0;
  const int dr = lane >> 2;
  const int dc = (lane & 3) ^ ((lane >> 4) & 3);
  const int nlim = j.nvalid - 1;
  const size_t kofs = (size_t)k0 * 32 + dc * 8;
  const bf16_t* gA0 = j.A + (size_t)(m0 + 32 * w + dr) * j.lda + kofs;
  const bf16_t* gA1 = j.A + (size_t)(m0 + 32 * w + 16 + dr) * j.lda + kofs;
  const bf16_t* gB0 = j.Bt + (size_t)min(n0 + 64 * w + dr, nlim) * j.ldb + kofs;
  const bf16_t* gB1 = j.Bt + (size_t)min(n0 + 64 * w + 16 + dr, nlim) * j.ldb + kofs;
  const bf16_t* gB2 = j.Bt + (size_t)min(n0 + 64 * w + 32 + dr, nlim) * j.ldb + kofs;
  const bf16_t* gB3 = j.Bt + (size_t)min(n0 + 64 * w + 48 + dr, nlim) * j.ldb + kofs;
  char* ldsA = smem + (2 * w) * 1024 + lane * 16;
  char* ldsB = smem + 8192 + (4 * w) * 1024 + lane * 16;
  const unsigned lbase = (unsigned)(unsigned long long)(LAS char*)smem;
  const int fsw = (r32 >> 2) & 3;
  const unsigned pa = (unsigned)((wm * 64 + r32) * 64), pb = (unsigned)(8192 + (wn * 128 + r32) * 64);
  const unsigned po0 = (unsigned)(((hh) ^ fsw) * 16), po1 = (unsigned)(((2 + hh) ^ fsw) * 16);

#define DMA1(gp, lp) __builtin_amdgcn_global_load_lds((const unsigned*)(gp), (unsigned*)(lp), 16, 0, 0)
#define ISSUE(kt, slot)                                                                          \
  {                                                                                              \
    const int ko_ = (kt) * 32;                                                                   \
    char* la_ = ldsA + (slot) * DSLOT; char* lb_ = ldsB + (slot) * DSLOT;                        \
    DMA1(gA0 + ko_, la_); DMA1(gA1 + ko_, la_ + 1024);                                           \
    DMA1(gB0 + ko_, lb_); DMA1(gB1 + ko_, lb_ + 1024); DMA1(gB2 + ko_, lb_ + 2048); DMA1(gB3 + ko_, lb_ + 3072); \
  }
#define SB_ __builtin_amdgcn_sched_barrier(0)

  asm volatile("s_waitcnt vmcnt(0)" ::: "memory");
  const int last = nk - 1;
  ISSUE(0, 0);
  { const int t1 = min(1, last); ISSUE(t1, 1); }
  int sl_r = 0, sl_w = 2;
#pragma unroll 1
  for (int i = 0; i < nk; ++i) {
    asm volatile("s_waitcnt vmcnt(6)" ::: "memory");
    __builtin_amdgcn_s_barrier();
    const int ko2 = min(i + 2, last) * 32;
    char* la2 = ldsA + sl_w * DSLOT; char* lb2 = ldsB + sl_w * DSLOT;
    const unsigned sl = lbase + (unsigned)(sl_r * DSLOT);
    sl_r = (sl_r == 2) ? 0 : sl_r + 1;
    sl_w = (sl_w == 2) ? 0 : sl_w + 1;
    bf16x8 a00, a10, a01, a11, b00, b10, b20, b30, b01, b11, b21, b31;
    const unsigned aA0 = sl + pa + po0, aB0 = sl + pb + po0, aA1 = sl + pa + po1, aB1 = sl + pb + po1;
    asm volatile("ds_read_b128 %0, %1" : "=v"(a00) : "v"(aA0));
    asm volatile("ds_read_b128 %0, %1 offset:2048" : "=v"(a10) : "v"(aA0));
    asm volatile("ds_read_b128 %0, %1" : "=v"(b00) : "v"(aB0));
    asm volatile("ds_read_b128 %0, %1 offset:2048" : "=v"(b10) : "v"(aB0));
    asm volatile("ds_read_b128 %0, %1 offset:4096" : "=v"(b20) : "v"(aB0));
    asm volatile("ds_read_b128 %0, %1 offset:6144" : "=v"(b30) : "v"(aB0));
    asm volatile("ds_read_b128 %0, %1" : "=v"(a01) : "v"(aA1));
    asm volatile("ds_read_b128 %0, %1 offset:2048" : "=v"(a11) : "v"(aA1));
    asm volatile("ds_read_b128 %0, %1" : "=v"(b01) : "v"(aB1));
    asm volatile("ds_read_b128 %0, %1 offset:2048" : "=v"(b11) : "v"(aB1));
    asm volatile("ds_read_b128 %0, %1 offset:4096" : "=v"(b21) : "v"(aB1));
    asm volatile("ds_read_b128 %0, %1 offset:6144" : "=v"(b31) : "v"(aB1));
    DMA1(gA0 + ko2, la2);
    asm volatile("s_waitcnt lgkmcnt(0)" : "+v"(a00), "+v"(a10), "+v"(b00), "+v"(b10), "+v"(b20), "+v"(b30),
                 "+v"(a01), "+v"(a11), "+v"(b01), "+v"(b11), "+v"(b21), "+v"(b31) :: "memory");
    acc[0][0] = mfma32(a00, b00, acc[0][0]);
    acc[0][1] = mfma32(a00, b10, acc[0][1]);
    acc[0][2] = mfma32(a00, b20, acc[0][2]);
    SB_; DMA1(gA1 + ko2, la2 + 1024); SB_;
    acc[0][3] = mfma32(a00, b30, acc[0][3]);
    acc[1][0] = mfma32(a10, b00, acc[1][0]);
    acc[1][1] = mfma32(a10, b10, acc[1][1]);
    SB_; DMA1(gB0 + ko2, lb2); SB_;
    acc[1][2] = mfma32(a10, b20, acc[1][2]);
    acc[1][3] = mfma32(a10, b30, acc[1][3]);
    acc[0][0] = mfma32(a01, b01, acc[0][0]);
    SB_; DMA1(gB1 + ko2, lb2 + 1024); SB_;
    acc[0][1] = mfma32(a01, b11, acc[0][1]);
    acc[0][2] = mfma32(a01, b21, acc[0][2]);
    acc[0][3] = mfma32(a01, b31, acc[0][3]);
    SB_; DMA1(gB2 + ko2, lb2 + 2048); SB_;
    acc[1][0] = mfma32(a11, b01, acc[1][0]);
    acc[1][1] = mfma32(a11, b11, acc[1][1]);
    acc[1][2] = mfma32(a11, b21, acc[1][2]);
    SB_; DMA1(gB3 + ko2, lb2 + 3072); SB_;
    acc[1][3] = mfma32(a11, b31, acc[1][3]);
  }
  asm volatile("s_waitcnt vmcnt(0)" ::: "memory");
  __builtin_amdgcn_s_barrier();
#undef ISSUE
#undef DMA1
#undef SB_
  if (wflag) {
    if (threadIdx.x == 0) {
      unsigned sp = 0;
      while (xb_ld(wflag) != epoch) { __builtin_amdgcn_s_sleep(1); if (++sp > (1u << 24)) break; }
      __builtin_amdgcn_fence(__ATOMIC_ACQUIRE, "agent");
      asm volatile("s_waitcnt vmcnt(0)" ::: "memory");
    }
    __syncthreads();
  }

  if (EPI == EPI_GATES) {
    const bf16_t* XC = (const bf16_t*)j.o1;
    float* AA = (float*)j.o0;
    float* BBp = AA + (size_t)T_ * 1024;
    const int lq = lane & 3;
#pragma unroll
    for (int g = 0; g < 2; ++g) {
      const int ch = (n0 >> 8) * 128 + wn * 64 + g * 32 + r32;
      const int ch0 = (n0 >> 8) * 128 + wn * 64 + g * 32 + (r32 & ~3);
      const float br = j.x0[ch], bi = j.x1[ch];
      const float spl = softplusf_(-j.x2[ch]);
#pragma unroll
      for (int mi = 0; mi < 2; ++mi)
#pragma unroll
        for (int g4 = 0; g4 < 4; ++g4) {
          float va[4], vb[4];
#pragma unroll
          for (int e = 0; e < 4; ++e) {
            const int r = 4 * g4 + e;
            const int rowe = m0 + wm * 64 + mi * 32 + e + 8 * g4 + 4 * hh;
            const float rg = sigmoidf_(acc[mi][2 * g][r] + br);
            const float ig = sigmoidf_(acc[mi][2 * g + 1][r] + bi);
            const float la = -8.f * rg * spl;
            const bool reset = (rowe < TP_) && ((rowe & 2047) == 0);
            va[e] = reset ? 0.f : __expf(la);
            vb[e] = (reset ? 1.f : sqrtf(fmaxf(-expm1f(2.f * la), 0.f))) * ig;
          }
          quad_transpose4(va, lq);
          quad_transpose4(vb, lq);
          const size_t o = (size_t)(m0 + wm * 64 + mi * 32 + 8 * g4 + 4 * hh + lq) * 1024 + ch0;
          float xf[4]; unpack4(*(const uint2*)(XC + o), xf);
          *(float4*)(AA + o) = make_float4(va[0], va[1], va[2], va[3]);
          *(float4*)(BBp + o) = make_float4(vb[0] * xf[0], vb[1] * xf[1], vb[2] * xf[2], vb[3] * xf[3]);
        }
    }
  } else {
    const int lq = lane & 3;
#pragma unroll
    for (int mi = 0; mi < 2; ++mi)
#pragma unroll
      for (int ni = 0; ni < 4; ++ni)
#pragma unroll
        for (int g4 = 0; g4 < 4; ++g4) {
          float v[4] = {acc[mi][ni][4 * g4], acc[mi][ni][4 * g4 + 1], acc[mi][ni][4 * g4 + 2], acc[mi][ni][4 * g4 + 3]};
          quad_transpose4(v, lq);
          const int row = m0 + wm * 64 + mi * 32 + 8 * g4 + 4 * hh + lq;
          const int col = n0 + wn * 128 + ni * 32 + (r32 & ~3);
          epi4<EPI>(j, row, col, v);
        }
    if (EPI == EPI_SSM_XBC) {
      if (n0 + wn * 128 == 4096) {
        const float dtb = j.x0[r32];
#pragma unroll
        for (int mi = 0; mi < 2; ++mi)
#pragma unroll
          for (int r = 0; r < 16; ++r) {
            const int row = m0 + wm * 64 + mi * 32 + (r & 3) + 8 * (r >> 2) + 4 * hh;
            ((float*)j.o1)[(size_t)row * 32 + r32] = softplusf_(acc[mi][0][r] + dtb);
          }
      }
    }
  }
}

template <int EPI>
DI void gemm_tile_dma_h(const GJob& j, int m0, int n0, int nk, char* smem) {
  const int tid = TIDX, lane = tid & 63, w = tid >> 6;
  const int wm = w >> 1, wn = w & 1, r32 = lane & 31, hh = lane >> 5;
  f32x16 acc[4];
#pragma unroll
  for (int b = 0; b < 4; ++b)
#pragma unroll
    for (int r = 0; r < 16; ++r) acc[b][r] = 0.f;
  const int dr = lane >> 2;
  const int dc = (lane & 3) ^ ((lane >> 4) & 3);
  const int nlim = j.nvalid - 1;
  const size_t kofs = (size_t)dc * 8;
  const bf16_t* gA0 = j.A + (size_t)(m0 + 16 * w + dr) * j.lda + kofs;
  const bf16_t* gB0 = j.Bt + (size_t)min(n0 + 64 * w + dr, nlim) * j.ldb + kofs;
  const bf16_t* gB1 = j.Bt + (size_t)min(n0 + 64 * w + 16 + dr, nlim) * j.ldb + kofs;
  const bf16_t* gB2 = j.Bt + (size_t)min(n0 + 64 * w + 32 + dr, nlim) * j.ldb + kofs;
  const bf16_t* gB3 = j.Bt + (size_t)min(n0 + 64 * w + 48 + dr, nlim) * j.ldb + kofs;
  char* ldsA = smem + w * 1024 + lane * 16;
  char* ldsB = smem + 8192 + (4 * w) * 1024 + lane * 16;
  const unsigned lbase = (unsigned)(unsigned long long)(LAS char*)smem;
  const int fsw = (r32 >> 2) & 3;
  const unsigned pa = (unsigned)((wm * 32 + r32) * 64), pb = (unsigned)(8192 + (wn * 128 + r32) * 64);
  const unsigned po0 = (unsigned)(((hh) ^ fsw) * 16), po1 = (unsigned)(((2 + hh) ^ fsw) * 16);
#define DMA1(gp, lp) __builtin_amdgcn_global_load_lds((const unsigned*)(gp), (unsigned*)(lp), 16, 0, 0)
#define ISSUEH(kt, slot)                                                                         \
  {                                                                                              \
    const int ko_ = (kt) * 32;                                                                   \
    char* la_ = ldsA + (slot) * DSLOT; char* lb_ = ldsB + (slot) * DSLOT;                        \
    DMA1(gA0 + ko_, la_);                                                                        \
    DMA1(gB0 + ko_, lb_); DMA1(gB1 + ko_, lb_ + 1024); DMA1(gB2 + ko_, lb_ + 2048); DMA1(gB3 + ko_, lb_ + 3072); \
  }
  asm volatile("s_waitcnt vmcnt(0)" ::: "memory");
  const int last = nk - 1;
  ISSUEH(0, 0);
  { const int t1 = min(1, last); ISSUEH(t1, 1); }
  int sl_r = 0, sl_w = 2;
#pragma unroll 1
  for (int i = 0; i < nk; ++i) {
    asm volatile("s_waitcnt vmcnt(5)" ::: "memory");
    __builtin_amdgcn_s_barrier();
    { const int t2 = min(i + 2, last); ISSUEH(t2, sl_w); }
    const unsigned sl = lbase + (unsigned)(sl_r * DSLOT);
    sl_r = (sl_r == 2) ? 0 : sl_r + 1;
    sl_w = (sl_w == 2) ? 0 : sl_w + 1;
    bf16x8 a00, a01, b00, b10, b20, b30, b01, b11, b21, b31;
    const unsigned aA0 = sl + pa + po0, aB0 = sl + pb + po0, aA1 = sl + pa + po1, aB1 = sl + pb + po1;
    asm volatile("ds_read_b128 %0, %1" : "=v"(a00) : "v"(aA0));
    asm volatile("ds_read_b128 %0, %1" : "=v"(b00) : "v"(aB0));
    asm volatile("ds_read_b128 %0, %1 offset:2048" : "=v"(b10) : "v"(aB0));
    asm volatile("ds_read_b128 %0, %1 offset:4096" : "=v"(b20) : "v"(aB0));
    asm volatile("ds_read_b128 %0, %1 offset:6144" : "=v"(b30) : "v"(aB0));
    asm volatile("ds_read_b128 %0, %1" : "=v"(a01) : "v"(aA1));
    asm volatile("ds_read_b128 %0, %1" : "=v"(b01) : "v"(aB1));
    asm volatile("ds_read_b128 %0, %1 offset:2048" : "=v"(b11) : "v"(aB1));
    asm volatile("ds_read_b128 %0, %1 offset:4096" : "=v"(b21) : "v"(aB1));
    asm volatile("ds_read_b128 %0, %1 offset:6144" : "=v"(b31) : "v"(aB1));
    asm volatile("s_waitcnt lgkmcnt(0)" : "+v"(a00), "+v"(b00), "+v"(b10), "+v"(b20), "+v"(b30),
                 "+v"(a01), "+v"(b01), "+v"(b11), "+v"(b21), "+v"(b31) :: "memory");
    acc[0] = mfma32(a00, b00, acc[0]);
    acc[1] = mfma32(a00, b10, acc[1]);
    acc[2] = mfma32(a00, b20, acc[2]);
    acc[3] = mfma32(a00, b30, acc[3]);
    acc[0] = mfma32(a01, b01, acc[0]);
    acc[1] = mfma32(a01, b11, acc[1]);
    acc[2] = mfma32(a01, b21, acc[2]);
    acc[3] = mfma32(a01, b31, acc[3]);
  }
  asm volatile("s_waitcnt vmcnt(0)" ::: "memory");
  __builtin_amdgcn_s_barrier();
#undef ISSUEH
#undef DMA1
  const int lq = lane & 3;
#pragma unroll
  for (int ni = 0; ni < 4; ++ni)
#pragma unroll
    for (int g4 = 0; g4 < 4; ++g4) {
      float v[4] = {acc[ni][4 * g4], acc[ni][4 * g4 + 1], acc[ni][4 * g4 + 2], acc[ni][4 * g4 + 3]};
      quad_transpose4(v, lq);
      const int row = m0 + wm * 32 + 8 * g4 + 4 * hh + lq;
      const int col = n0 + wn * 128 + ni * 32 + (r32 & ~3);
      epi4<EPI>(j, row, col, v);
    }
  if (EPI == EPI_SSM_XBC) {
    if (n0 + wn * 128 == 4096) {
      const float dtb = j.x0[r32];
#pragma unroll
      for (int r = 0; r < 16; ++r) {
        const int row = m0 + wm * 32 + (r & 3) + 8 * (r >> 2) + 4 * hh;
        ((float*)j.o1)[(size_t)row * 32 + r32] = softplusf_(acc[0][r] + dtb);
      }
    }
  }
}

#define VBLOCK() ((int)(((volatile LAS unsigned*)&xb_words)[3]))
DI void tile_map(int L, int ntn, int& mt, int& nt) {
  const int gw = ((ntn & 7) == 0) ? 8 : (((ntn & 3) == 0) ? 4 : 0);
  if (gw) {
    const int gs = 8 * gw, grp = L / gs, loc = L - grp * gs, gpr = ntn / gw;
    const int gm = grp / gpr, gn = grp - gm * gpr;
    mt = gm * 8 + loc / gw; nt = gn * gw + (loc - (loc / gw) * gw);
  } else { mt = L / ntn; nt = L - mt * ntn; }
}

template <int EPI, bool MIX>
DI void gemm_run(const GJob& j, int ntn, int& toff, char* smem, int vb_) {
  const int G = gridDim.x;
  const int nk = j.K >> 6;
  if (MIX) {
    const int ntiles = MT_ * ntn;
    const int start = (int)((vb_ - (toff % G) + G) % G);
    for (int tile = start; tile < ntiles; tile += G) {
      int mt, nt; tile_map(tile, ntn, mt, nt);
      gemm_tile<EPI, MIX>(j, mt * 128, nt * 128, 0, nk, smem);
    }
    toff += ntiles;
  } else {
    const int nfull = 128 * ntn, nhalf = 16 * ntn, ntot = nfull + nhalf;
    const int start = (int)((vb_ - (toff % G) + G) % G);
    for (int item = start; item < ntot; item += G) {
      if (item < nfull) {
        int mt, nt; tile_map(item, ntn, mt, nt);
        gemm_tile_dma<EPI>(j, mt * 128, nt * 256, 0, nk * 2, smem);
      } else {
        const int h = item - nfull, hm = h / ntn, nt = h - hm * ntn;
        gemm_tile_dma_h<EPI>(j, TP_ + hm * 64, nt * 256, nk * 2, smem);
      }
    }
    toff += ntot;
  }
}

template <int EPI>
DI void gemm_streamk(const GJob& j, int ntn, char* smem, int vb_, unsigned* flags, unsigned epoch) {
  const int G = gridDim.x;
  const int nk = j.K >> 5;
  const int total = MT_ * ntn * nk;
  int per = (total + G - 1) / G;
  if (per < nk) per = nk;
  int s0 = vb_ * per;
  const int s1 = min(s0 + per, total);
  while (s0 < s1) {
    const int tile = s0 / nk, k0 = s0 - tile * nk;
    const int k1 = min(nk, k0 + (s1 - s0));
    int mt, nt; tile_map(tile, ntn, mt, nt);
    unsigned* wf = (k0 == 0 && k1 < nk) ? (flags + tile) : nullptr;
    gemm_tile_dma<EPI>(j, mt * 128, nt * 256, k0, k1, smem, wf, epoch);
    if (k0 > 0) {
      asm volatile("s_waitcnt vmcnt(0)" ::: "memory");
      __syncthreads();
      if (threadIdx.x == 0) {
        __builtin_amdgcn_fence(__ATOMIC_RELEASE, "agent");
        asm volatile("s_waitcnt vmcnt(0)" ::: "memory");
        __hip_atomic_store(flags + tile, epoch, __ATOMIC_RELAXED, __HIP_MEMORY_SCOPE_AGENT);
      }
    }
    s0 += k1 - k0;
  }
}

template <int EPI, int SPLIT, int NKC>
DI void gemm_splitk(const GJob& j, int ntn, char* smem, int vb_) {
  const int G = gridDim.x;
  const int nitems = MT_ * ntn * SPLIT;
  for (int it = vb_; it < nitems; it += G) {
    const int tile = it / SPLIT, sp = it - tile * SPLIT;
    int mt, nt; tile_map(tile, ntn, mt, nt);
    gemm_tile<EPI, false>(j, mt * 128, nt * 128, sp * NKC, sp * NKC + NKC, smem);
  }
}

DI GJob mkjob(const bf16_t* A, int lda, const bf16_t* Bt, int ldb, int K, int nvalid) {
  GJob j;
  j.A = A; j.A2 = nullptr; j.mu = nullptr; j.Bt = Bt; j.lda = lda; j.ldb = ldb; j.K = K; j.nvalid = nvalid;
  j.o0 = nullptr; j.o1 = nullptr; j.x0 = nullptr; j.x1 = nullptr; j.x2 = nullptr; j.ldo = 0; j.act = 0;
  return j;
}

struct TJob { const float* src; bf16_t* dst; int K, N, src_ld, kind, n_off; };

DI TJob get_tjob(const Params& p, int j) {
  bf16_t* wt = (bf16_t*)(p.ws + W_WT);
  TJob o; o.kind = 0; o.n_off = 0;
  if (j < 36) {
    const int ia = j / 18, r = j % 18;
    if (r == 0) { o.src = p.in[I_LRU_WIN] + (size_t)ia * 1024 * 2048; o.dst = wt + WA_IN + (size_t)ia * 2048 * 1024; o.K = 1024; o.N = 2048; o.src_ld = 2048; }
    else if (r == 1) { o.src = p.in[I_LRU_WOUT] + (size_t)ia * 1024 * 1024; o.dst = wt + WA_OUT + (size_t)ia * 1024 * 1024; o.K = 1024; o.N = 1024; o.src_ld = 1024; }
    else {
      const int isI = (r >= 10) ? 1 : 0; const int h = (r - 2) & 7;
      o.src = p.in[isI ? I_LRU_WI : I_LRU_WR] + ((size_t)ia * 8 + h) * 128 * 128;
      o.dst = wt + WA_G + (size_t)ia * 2048 * 128; o.K = 128; o.N = 128; o.src_ld = 128; o.kind = 1 + isI; o.n_off = h * 128;
    }
  } else if (j == 36) { o.src = p.in[I_SSM_WIN] + 2048; o.dst = wt + WB_XBC; o.K = 1024; o.N = 4128; o.src_ld = 6176; }
  else if (j == 37) { o.src = p.in[I_SSM_WIN]; o.dst = wt + WB_Z; o.K = 1024; o.N = 2048; o.src_ld = 6176; }
  else if (j == 38) { o.src = p.in[I_SSM_WOUT]; o.dst = wt + WB_OUT; o.K = 2048; o.N = 1024; o.src_ld = 1024; }
  else if (j < 42) { const int s = j - 39; o.src = p.in[I_RW_WRKV] + (size_t)s * 1024 * 1024; o.dst = wt + WC_RKV + (size_t)s * 1024 * 1024; o.K = 1024; o.N = 1024; o.src_ld = 1024; }
  else if (j == 42) { o.src = p.in[I_RW_WW1]; o.dst = wt + WC_L1; o.K = 1024; o.N = 64; o.src_ld = 64; }
  else if (j == 43) { o.src = p.in[I_RW_WA1]; o.dst = wt + WC_L1 + 64 * 1024; o.K = 1024; o.N = 64; o.src_ld = 64; }
  else if (j == 44) { o.src = p.in[I_RW_WG1]; o.dst = wt + WC_L1 + 128 * 1024; o.K = 1024; o.N = 128; o.src_ld = 128; }
  else if (j == 45) { o.src = p.in[I_RW_WW2]; o.dst = wt + WC_W2; o.K = 64; o.N = 1024; o.src_ld = 1024; }
  else if (j == 46) { o.src = p.in[I_RW_WA2]; o.dst = wt + WC_A2; o.K = 64; o.N = 1024; o.src_ld = 1024; }
  else if (j == 47) { o.src = p.in[I_RW_WG2]; o.dst = wt + WC_G2; o.K = 128; o.N = 1024; o.src_ld = 1024; }
  else if (j == 48) { o.src = p.in[I_RW_WOUT]; o.dst = wt + WC_OUT; o.K = 1024; o.N = 1024; o.src_ld = 1024; }
  else {
    const int l = (j - 49) >> 1, which = (j - 49) & 1;
    if (!which) { o.src = p.in[I_FFN_W1] + (size_t)l * 1024 * 4096; o.dst = wt + WF_1 + (size_t)l * 4096 * 1024; o.K = 1024; o.N = 4096; o.src_ld = 4096; }
    else { o.src = p.in[I_FFN_W2] + (size_t)l * 4096 * 1024; o.dst = wt + WF_2 + (size_t)l * 4096 * 1024; o.K = 4096; o.N = 1024; o.src_ld = 1024; }
  }
  return o;
}
constexpr int N_TJOBS = 57;

DI void ph_prologue(const Params& p, char* smem) {
  const int tid = TIDX, G = gridDim.x;
  {
    const float4* xp = (const float4*)p.in[I_XP];
    const float4* xs = (const float4*)p.in[I_XS];
    float4* X = (float4*)(p.ws + W_X);
    const size_t np = (size_t)TP_ * 256, nt = (size_t)T_ * 256;
    for (size_t i = (size_t)blockIdx.x * NTHR + tid; i < nt; i += (size_t)G * NTHR)
      X[i] = (i < np) ? xp[i] : xs[i - np];
  }
  float* tile = (float*)smem;
  int toff = 0;
  for (int jn = 0; jn < N_TJOBS; ++jn) {
    const TJob tj = get_tjob(p, jn);
    const int nkt = tj.K >> 6, nnt = (tj.N + 63) >> 6;
    const int ntiles = nkt * nnt;
    const int start = (((int)blockIdx.x - (toff % G)) + G) % G;
    for (int t = start; t < ntiles; t += G) {
      const int kt = t / nnt, nt = t - kt * nnt;
      const int k0 = kt * 64, n0 = nt * 64;
      __syncthreads();
      float tv[16];
      const bool nok = (n0 + (tid & 63)) < tj.N;
      const float* sp = tj.src + (size_t)(k0 + (tid >> 6)) * tj.src_ld + n0 + (tid & 63);
#pragma unroll
      for (int i = 0; i < 16; ++i) tv[i] = nok ? sp[(size_t)(i * 4) * tj.src_ld] : 0.f;
#pragma unroll
      for (int i = 0; i < 16; ++i) tile[(i * 4 + (tid >> 6)) * 65 + (tid & 63)] = tv[i];
      __syncthreads();
      const int n = tid >> 2, kq = tid & 3;
      if (n0 + n < tj.N) {
        int nrow = n0 + n;
        if (tj.kind) {
          const int ch = tj.n_off + n0 + n;
          nrow = (ch >> 6) * 128 + ((ch >> 5) & 1) * 64 + (tj.kind - 1) * 32 + (ch & 31);
        }
        float f[8], g[8];
#pragma unroll
        for (int e = 0; e < 8; ++e) { f[e] = tile[(kq * 16 + e) * 65 + n]; g[e] = tile[(kq * 16 + 8 + e) * 65 + n]; }
        uint4* d = (uint4*)(tj.dst + (size_t)nrow * tj.K + k0 + kq * 16);
        d[0] = pack8(f); d[1] = pack8(g);
      }
    }
    toff += ntiles;
  }
}

DI void ph_rmsnorm(const Params& p, int mode, const float* w) {
  const int tid_ = TIDX; const int lane = tid_ & 63;
  const int gw = blockIdx.x * 4 + (tid_ >> 6), nw = gridDim.x * 4;
  const float* X = (const float*)(p.ws + W_X);
  bf16_t* U = (bf16_t*)(p.ws + W_U);
  bf16_t* UP = (bf16_t*)(p.ws + SC_UP);
  float4 wv[4];
#pragma unroll
  for (int i = 0; i < 4; ++i) wv[i] = ((const float4*)w)[lane + 64 * i];
  for (int row = gw; row < T_; row += nw) {
    const float4* xr = (const float4*)(X + (size_t)row * 1024);
    float4 v[4]; float ss = 0.f;
#pragma unroll
    for (int i = 0; i < 4; ++i) { v[i] = xr[lane + 64 * i]; ss += v[i].x * v[i].x + v[i].y * v[i].y + v[i].z * v[i].z + v[i].w * v[i].w; }
    ss = wave_sum(ss);
    const float rstd = rsqrtf(ss * (1.f / 1024.f) + 1e-6f);
    int seq, l, L; tok_info(row, seq, l, L);
#pragma unroll
    for (int i = 0; i < 4; ++i) {
      const int c = 4 * (lane + 64 * i);
      float4 y = make_float4(v[i].x * rstd * wv[i].x, v[i].y * rstd * wv[i].y, v[i].z * rstd * wv[i].z, v[i].w * rstd * wv[i].w);
      if (mode == 2) {
        *(float4*)(p.out + O_Y + (size_t)row * 1024 + c) = y;
      } else {
        uint2 pk = make_uint2(pack2(y.x, y.y), pack2(y.z, y.w));
        *(uint2*)(U + (size_t)row * 1024 + c) = pk;
        if (mode == 1) {
          if (l + 1 < L) *(uint2*)(UP + (size_t)(row + 1) * 1024 + c) = pk;
          if (l == 0) {
            uint2 pz = make_uint2(0, 0);
            if (seq >= 8) { float4 s = *(const float4*)(p.in[I_ST_RS] + (size_t)(seq - 8) * 1024 + c); pz = make_uint2(pack2(s.x, s.y), pack2(s.z, s.w)); }
            *(uint2*)(UP + (size_t)row * 1024 + c) = pz;
          }
          if (l == L - 1) {
            float* o = (seq < 8) ? (p.out + O_RS_P + (size_t)seq * 1024 + c) : (p.out + O_RS_S + (size_t)(seq - 8) * 1024 + c);
            *(float4*)o = y;
          }
        }
      }
    }
  }
}

template <int C, bool SILU>
DI void ph_conv(const bf16_t* __restrict__ src, bf16_t* __restrict__ dst, const float* __restrict__ cw,
                const float* __restrict__ cb, const float* __restrict__ state,
                float* __restrict__ out_p, float* __restrict__ out_s) {
  constexpr int GR = C / 8;
  const size_t total = (size_t)T_ * GR;
#pragma unroll 2
  for (size_t idx = (size_t)blockIdx.x * NTHR + TIDX; idx < total; idx += (size_t)gridDim.x * NTHR) {
    const int t = (int)(idx / GR), c = (int)(idx % GR) * 8;
    int seq, l, L; tok_info(t, seq, l, L);
    float acc[8]; load8f(cb + c, acc);
    float xcur[8];
#pragma unroll
    for (int jj = 0; jj < 4; ++jj) {
      const int ls = l - 3 + jj;
      float xv[8];
      if (ls >= 0) { unpack8(*(const uint4*)(src + (size_t)(t - 3 + jj) * C + c), xv); }
      else if (seq >= 8) { load8f(state + ((size_t)(seq - 8) * 3 + (ls + 3)) * C + c, xv); }
      else {
#pragma unroll
        for (int e = 0; e < 8; ++e) xv[e] = 0.f;
      }
      float w8[8]; load8f(cw + (size_t)jj * C + c, w8);
#pragma unroll
      for (int e = 0; e < 8; ++e) acc[e] += w8[e] * xv[e];
      if (jj == 3) {
#pragma unroll
        for (int e = 0; e < 8; ++e) xcur[e] = xv[e];
      }
    }
    if (SILU) {
#pragma unroll
      for (int e = 0; e < 8; ++e) acc[e] = siluf_(acc[e]);
    }
    *(uint4*)(dst + (size_t)t * C + c) = pack8(acc);
    if (l >= L - 3) {
      const int r = l - (L - 3);
      float* o = (seq < 8) ? (out_p + ((size_t)seq * 3 + r) * C + c) : (out_s + ((size_t)(seq - 8) * 3 + r) * C + c);
      store8f(o, xcur);
    }
  }
}

DI void ph_lru_scan1(const Params& p) {
  const float* AA = (const float*)(p.ws + SA_AA);
  const float* BB = (const float*)(p.ws + SA_BB);
  float* CP = (float*)(p.ws + SA_CP);
  float* CS = (float*)(p.ws + SA_CS);
  const int total = 8 * 64 * 1024;
  for (int idx = blockIdx.x * NTHR + TIDX; idx < total; idx += gridDim.x * NTHR) {
    const int ch = idx & 1023, c = (idx >> 10) & 63, b = idx >> 16;
    const size_t base = ((size_t)b * 2048 + c * 32) * 1024 + ch;
    float P = 1.f, S = 0.f;
    float av[32], bv[32];
#pragma unroll
    for (int s = 0; s < 32; ++s) { av[s] = AA[base + (size_t)s * 1024]; bv[s] = BB[base + (size_t)s * 1024]; }
#pragma unroll
    for (int s = 0; s < 32; ++s) { S = av[s] * S + bv[s]; P *= av[s]; }
    CP[idx] = P; CS[idx] = S;
  }
}
DI void ph_lru_scan2(const Params& p, int ia) {
  const float* AA = (const float*)(p.ws + SA_AA);
  const float* BB = (const float*)(p.ws + SA_BB);
  const float* CP = (const float*)(p.ws + SA_CP);
  const float* CS = (const float*)(p.ws + SA_CS);
  bf16_t* GT = (bf16_t*)(p.ws + SA_GT);
  const int nP = 8 * 64 * 1024, total = nP + 128 * 1024;
  for (int idx = blockIdx.x * NTHR + TIDX; idx < total; idx += gridDim.x * NTHR) {
    if (idx < nP) {
      const int ch = idx & 1023, c = (idx >> 10) & 63, b = idx >> 16;
      const size_t base = ((size_t)b * 2048 + c * 32) * 1024 + ch;
      float av[32], bv[32]; bf16_t gv[32];
#pragma unroll
      for (int s = 0; s < 32; ++s) { const size_t o = base + (size_t)s * 1024; av[s] = AA[o]; bv[s] = BB[o]; gv[s] = GT[o]; }
      float h = 0.f;
#pragma unroll 8
      for (int c2 = 0; c2 < c; ++c2) {
        const int ci = ((b * 64 + c2) << 10) + ch;
        h = CP[ci] * h + CS[ci];
      }
#pragma unroll
      for (int s = 0; s < 32; ++s) {
        const size_t o = base + (size_t)s * 1024;
        h = av[s] * h + bv[s];
        GT[o] = f2bf(h * bf2f(gv[s]));
      }
      if (c == 63) p.out[O_LH_P + ((size_t)ia * 8 + b) * 1024 + ch] = h;
    } else {
      const int u = idx - nP; const int ch = u & 1023, s = u >> 10;
      float h = p.in[I_ST_LH][((size_t)ia * 128 + s) * 1024 + ch];
      const size_t base = ((size_t)TP_ + s * 8) * 1024 + ch;
#pragma unroll
      for (int q = 0; q < 8; ++q) {
        const size_t o = base + (size_t)q * 1024;
        h = AA[o] * h + BB[o];
        GT[o] = f2bf(h * bf2f(GT[o]));
      }
      p.out[O_LH_S + ((size_t)ia * 128 + s) * 1024 + ch] = h;
    }
  }
}

DI void ssd_item(const Params& p, char* smem, int seq, int h) {
  const int tid = TIDX, lane = tid & 63, w = tid >> 6, r32 = lane & 31, hh = lane >> 5;
  bf16_t* Cs = (bf16_t*)smem;
  bf16_t* Bs = Cs + 64 * 136;
  bf16_t* Sb = Bs + 64 * 136;
  bf16_t* Xt = Sb + 64 * 136;
  bf16_t* Btr = Xt + 64 * 72;
  float* dts = (float*)(Btr + 128 * 72);
  float* acs = dts + 64;
  bf16_t* Ws = Bs;
  const bf16_t* XBC = (const bf16_t*)(p.ws + SB_XBC);
  const float* DT = (const float*)(p.ws + SB_DT);
  bf16_t* Y = (bf16_t*)(p.ws + SB_Y);
  const bool prompt = seq < 8;
  const int nchunk = prompt ? 32 : 1, Lv = prompt ? 64 : 8;
  const int tbase = prompt ? seq * 2048 : TP_ + (seq - 8) * 8;
  const int g = h >> 2;
  const float Ah = -__expf(p.in[I_SSM_ALOG][h]);
  const float Dh = p.in[I_SSM_D][h];
  f32x16 accS[2];
  {
    const float* s0 = p.in[I_ST_SS] + ((size_t)(seq - 8) * 32 + h) * 64 * 128;
#pragma unroll
    for (int mi = 0; mi < 2; ++mi)
#pragma unroll
      for (int r = 0; r < 16; ++r) {
        const int prow = mi * 32 + (r & 3) + 8 * (r >> 2) + 4 * hh, n = 32 * w + r32;
        accS[mi][r] = prompt ? 0.f : s0[(size_t)prow * 128 + n];
      }
  }
  __syncthreads();
#pragma unroll
  for (int mi = 0; mi < 2; ++mi)
#pragma unroll
    for (int r = 0; r < 16; ++r) {
      const int prow = mi * 32 + (r & 3) + 8 * (r >> 2) + 4 * hh, n = 32 * w + r32;
      Sb[prow * 136 + n] = f2bf(accS[mi][r]);
    }
  uint4 pc0, pc1, pc2, pc3, pb0, pb1, pb2, pb3, px0, px1;
  float pdt = 0.f;
  const uint4 z4 = make_uint4(0, 0, 0, 0);
  pc0 = pc1 = pc2 = pc3 = pb0 = pb1 = pb2 = pb3 = px0 = px1 = z4;
#define SSD_LD_CB(i, t0_)                                                                  \
  { const int row_ = tid >> 2, ch_ = (tid & 3) + 4 * i;      \
    pc##i = z4; pb##i = z4;                                                                \
    if (row_ < Lv) { const bf16_t* src_ = XBC + (size_t)((t0_) + row_) * 4096 + g * 128 + ch_ * 8; \
      pb##i = *(const uint4*)(src_ + 2048); pc##i = *(const uint4*)(src_ + 3072); } }
#define SSD_LD_X(i, t0_)                                                                   \
  { const int row_ = tid >> 2, ch_ = (tid & 3) + 4 * i;                                    \
    px##i = z4;                                                                            \
    if (row_ < Lv) px##i = *(const uint4*)(XBC + (size_t)((t0_) + row_) * 4096 + h * 64 + ch_ * 8); }
#define SSD_ISSUE(t0_)                                                                     \
  { SSD_LD_CB(0, t0_) SSD_LD_CB(1, t0_) SSD_LD_CB(2, t0_) SSD_LD_CB(3, t0_) SSD_LD_X(0, t0_) SSD_LD_X(1, t0_) \
    pdt = (tid < Lv && tid < 64) ? DT[(size_t)((t0_) + tid) * 32 + h] : 0.f; }
#define SSD_ST_CB(i)                                                                       \
  { const int row_ = tid >> 2, ch_ = (tid & 3) + 4 * i;                                    \
    *(uint4*)(Cs + row_ * 136 + ch_ * 8) = pc##i;                                          \
    *(uint4*)(Bs + row_ * 136 + ch_ * 8) = pb##i;                                          \
    float f_[8]; unpack8(pb##i, f_);                                                       \
    const float sc_ = __expf(aend - acs[row_]);                                            \
    _Pragma("unroll") for (int e = 0; e < 8; ++e) Btr[(ch_ * 8 + e) * 72 + row_] = f2bf(f_[e] * sc_); }
#define SSD_ST_X(i)                                                                        \
  { const int row_ = tid >> 2, ch_ = (tid & 3) + 4 * i;                                    \
    float f_[8]; unpack8(px##i, f_);                                                       \
    const float sc_ = dts[row_];                                                           \
    _Pragma("unroll") for (int e = 0; e < 8; ++e) Xt[(ch_ * 8 + e) * 72 + row_] = f2bf(f_[e] * sc_); }
  SSD_ISSUE(tbase);
  for (int c = 0; c < nchunk; ++c) {
    const int t0 = tbase + c * 64;
    __syncthreads();
    if (tid < 64) {
      const float dtv = pdt;
      float x = dtv * Ah;
#pragma unroll
      for (int o = 1; o < 64; o <<= 1) { const float y = __shfl_up(x, o, 64); if (lane >= o) x += y; }
      dts[tid] = dtv; acs[tid] = x;
    }
    __syncthreads();
    const float aend = acs[63];
    SSD_ST_CB(0) SSD_ST_CB(1) SSD_ST_CB(2) SSD_ST_CB(3) SSD_ST_X(0) SSD_ST_X(1)
    if (c + 1 < nchunk) { SSD_ISSUE(t0 + 64); }
    __syncthreads();
    const int it = w >> 1, jt = w & 1;
    f32x16 cb;
#pragma unroll
    for (int r = 0; r < 16; ++r) cb[r] = 0.f;
    if (jt <= it) {
#pragma unroll
      for (int ks = 0; ks < 8; ++ks) {
        bf16x8 a = *(const bf16x8*)(Cs + (it * 32 + r32) * 136 + ks * 16 + hh * 8);
        bf16x8 b = *(const bf16x8*)(Bs + (jt * 32 + r32) * 136 + ks * 16 + hh * 8);
        cb = mfma32(a, b, cb);
      }
    }
    __syncthreads();
    {
      const int jj = jt * 32 + r32; const float aj = acs[jj];
#pragma unroll
      for (int r = 0; r < 16; ++r) {
        const int ii = it * 32 + (r & 3) + 8 * (r >> 2) + 4 * hh;
        const float v = (jj <= ii) ? cb[r] * __expf(acs[ii] - aj) : 0.f;
        Ws[ii * 72 + jj] = f2bf(v);
      }
    }
    __syncthreads();
    {
      const int pt = w & 1;
      f32x16 yd, yo;
#pragma unroll
      for (int r = 0; r < 16; ++r) { yd[r] = 0.f; yo[r] = 0.f; }
#pragma unroll
      for (int ks = 0; ks < 4; ++ks) {
        bf16x8 a = *(const bf16x8*)(Ws + (it * 32 + r32) * 72 + ks * 16 + hh * 8);
        bf16x8 b = *(const bf16x8*)(Xt + (pt * 32 + r32) * 72 + ks * 16 + hh * 8);
        yd = mfma32(a, b, yd);
      }
#pragma unroll
      for (int ks = 0; ks < 8; ++ks) {
        bf16x8 a = *(const bf16x8*)(Cs + (it * 32 + r32) * 136 + ks * 16 + hh * 8);
        bf16x8 b = *(const bf16x8*)(Sb + (pt * 32 + r32) * 136 + ks * 16 + hh * 8);
        yo = mfma32(a, b, yo);
      }
      const int lq = lane & 3, p0 = pt * 32 + (r32 & ~3);
#pragma unroll
      for (int g4 = 0; g4 < 4; ++g4) {
        float v[4];
#pragma unroll
        for (int e = 0; e < 4; ++e) {
          const int ie = it * 32 + e + 8 * g4 + 4 * hh;
          v[e] = yd[4 * g4 + e] + __expf(acs[ie]) * yo[4 * g4 + e];
        }
        quad_transpose4(v, lq);
        const int ii = it * 32 + 8 * g4 + 4 * hh + lq;
        if (ii < Lv) {
          const size_t t = (size_t)(t0 + ii);
          float xf[4]; unpack4(*(const uint2*)(XBC + t * 4096 + h * 64 + p0), xf);
          *(uint2*)(Y + t * 2048 + h * 64 + p0) =
              pack4(v[0] + Dh * xf[0], v[1] + Dh * xf[1], v[2] + Dh * xf[2], v[3] + Dh * xf[3]);
        }
      }
    }
    {
      const float dec = __expf(aend);
#pragma unroll
      for (int mi = 0; mi < 2; ++mi)
#pragma unroll
        for (int r = 0; r < 16; ++r) accS[mi][r] *= dec;
#pragma unroll
      for (int ks = 0; ks < 4; ++ks) {
        bf16x8 b = *(const bf16x8*)(Btr + (32 * w + r32) * 72 + ks * 16 + hh * 8);
        bf16x8 a0 = *(const bf16x8*)(Xt + (r32) * 72 + ks * 16 + hh * 8);
        bf16x8 a1 = *(const bf16x8*)(Xt + (32 + r32) * 72 + ks * 16 + hh * 8);
        accS[0] = mfma32(a0, b, accS[0]);
        accS[1] = mfma32(a1, b, accS[1]);
      }
    }
    __syncthreads();
#pragma unroll
    for (int mi = 0; mi < 2; ++mi)
#pragma unroll
      for (int r = 0; r < 16; ++r) {
        const int prow = mi * 32 + (r & 3) + 8 * (r >> 2) + 4 * hh, n = 32 * w + r32;
        Sb[prow * 136 + n] = f2bf(accS[mi][r]);
      }
  }
  float* dst = prompt ? (p.out + O_SS_P + ((size_t)seq * 32 + h) * 64 * 128)
                      : (p.out + O_SS_S + ((size_t)(seq - 8) * 32 + h) * 64 * 128);
#pragma unroll
  for (int mi = 0; mi < 2; ++mi)
#pragma unroll
    for (int r = 0; r < 16; ++r) {
      const int prow = mi * 32 + (r & 3) + 8 * (r >> 2) + 4 * hh, n = 32 * w + r32;
      dst[(size_t)prow * 128 + n] = accS[mi][r];
    }
}

#undef SSD_LD_CB
#undef SSD_LD_X
#undef SSD_ISSUE
#undef SSD_ST_CB
#undef SSD_ST_X
DI void ph_ssd(const Params& p, char* smem) {
  const int G = gridDim.x, bid = blockIdx.x;
  int it = bid, step = G;
  if (G >= 512) { if (bid < 256) { step = 1 << 30; } else { step = G - 256; } }
#pragma nounroll
  for (; it < 256 + 4096; it += step) {
    const int seq = (it < 256) ? (it >> 5) : (8 + ((it - 256) >> 5));
    ssd_item(p, smem, seq, it & 31);
  }
}

DI void ph_gnorm(const Params& p) {
  const int tid_ = TIDX; const int lane = tid_ & 63;
  const int gw = blockIdx.x * 4 + (tid_ >> 6), nw = gridDim.x * 4;
  bf16_t* Y = (bf16_t*)(p.ws + SB_Y);
  const float* nwt = p.in[I_SSM_NW];
  for (int item = gw; item < T_ * 8; item += 2 * nw) {
    const int item2 = item + nw; const bool v2 = item2 < T_ * 8;
    bf16_t* yp1 = Y + (size_t)(item >> 3) * 2048 + (item & 7) * 256 + lane * 4;
    bf16_t* yp2 = Y + (size_t)((v2 ? item2 : item) >> 3) * 2048 + ((v2 ? item2 : item) & 7) * 256 + lane * 4;
    const uint2 a = *(const uint2*)yp1; const uint2 b = *(const uint2*)yp2;
    float f[4], g[4]; unpack4(a, f); unpack4(b, g);
    const float ss1 = wave_sum(f[0] * f[0] + f[1] * f[1] + f[2] * f[2] + f[3] * f[3]);
    const float ss2 = wave_sum(g[0] * g[0] + g[1] * g[1] + g[2] * g[2] + g[3] * g[3]);
    const float r1 = rsqrtf(ss1 * (1.f / 256.f) + 1e-5f), r2 = rsqrtf(ss2 * (1.f / 256.f) + 1e-5f);
    const float4 w1 = *(const float4*)(nwt + (item & 7) * 256 + lane * 4);
    const float4 w2 = *(const float4*)(nwt + ((v2 ? item2 : item) & 7) * 256 + lane * 4);
    *(uint2*)yp1 = make_uint2(pack2(f[0] * r1 * w1.x, f[1] * r1 * w1.y), pack2(f[2] * r1 * w1.z, f[3] * r1 * w1.w));
    if (v2) *(uint2*)yp2 = make_uint2(pack2(g[0] * r2 * w2.x, g[1] * r2 * w2.y), pack2(g[2] * r2 * w2.z, g[3] * r2 * w2.w));
  }
}

template <int LPR>
DI void wkv_item(const Params& p, char* smem, int seq, int head, int part) {
  constexpr int ROWS = 256 / LPR, KPL = 64 / LPR, NV4 = KPL / 4;
  const int tid = TIDX;
  float* sR = (float*)smem;
  float* sK = sR + 2048;
  float* sKK = sK + 2048;
  float* sBB = sKK + 2048;
  float* sW = sBB + 2048;
  float* sV = sW + 2048;
  float* sO = sV + 2048;
  const bf16_t* __restrict__ R = (const bf16_t*)(p.ws + SC_R);
  const bf16_t* __restrict__ K = (const bf16_t*)(p.ws + SC_K);
  const bf16_t* __restrict__ V = (const bf16_t*)(p.ws + SC_V);
  const bf16_t* __restrict__ AAc = (const bf16_t*)(p.ws + SC_AA);
  const float* __restrict__ WD = (const float*)(p.ws + SC_WD);
  bf16_t* O = (bf16_t*)(p.ws + SC_O);
  const bool prompt = seq < 8;
  const int nch = prompt ? 64 : 1, nvalid = prompt ? 32 : 8;
  const int tbase = prompt ? seq * 2048 : TP_ + (seq - 8) * 8;
  const int row_l = tid / LPR, q = tid % LPR, row = part * ROWS + row_l;
  float S[KPL];
  {
    const float* s0 = p.in[I_ST_RW] + (((size_t)(seq - 8) * 16 + head) * 64 + row) * 64 + q * KPL;
#pragma unroll
    for (int e = 0; e < KPL; ++e) S[e] = prompt ? 0.f : s0[e];
  }
  const int pst = tid >> 3, pk0 = (tid & 7) * 8, pcol = head * 64 + pk0;
  const bool pact = pst < nvalid;
  float kk8[8], ka8[8];
  load8f(p.in[I_RW_KK] + pcol, kk8);
  load8f(p.in[I_RW_KA] + pcol, ka8);
  uint4 qr = make_uint4(0, 0, 0, 0), qk = qr, qv = qr, qa = qr;
  float4 qw0 = make_float4(0.f, 0.f, 0.f, 0.f), qw1 = qw0;
#define WKV_ISSUE(c_)                                                       \
  if (pact) {                                                               \
    const size_t o_ = (size_t)(tbase + (c_) * 32 + pst) * 1024 + pcol;      \
    qr = *(const uint4*)(R + o_); qk = *(const uint4*)(K + o_);             \
    qv = *(const uint4*)(V + o_); qa = *(const uint4*)(AAc + o_);           \
    qw0 = *(const float4*)(WD + o_); qw1 = *(const float4*)(WD + o_ + 4);   \
  }
  WKV_ISSUE(0);
  for (int c = 0; c < nch; ++c) {
    const int t0 = tbase + c * 32;
    __syncthreads();
    if (pact) {
      float r8[8], k8[8], v8[8], a8[8];
      unpack8(qr, r8); unpack8(qk, k8); unpack8(qv, v8); unpack8(qa, a8);
      const float w8[8] = {qw0.x, qw0.y, qw0.z, qw0.w, qw1.x, qw1.y, qw1.z, qw1.w};
      float kr[8], ss = 0.f;
#pragma unroll
      for (int e = 0; e < 8; ++e) { kr[e] = k8[e] * kk8[e]; ss += kr[e] * kr[e]; }
      ss = red_lanes<8>(ss);
      const float inv = 1.f / fmaxf(sqrtf(ss), 1e-12f);
      float kp[8], bb[8];
#pragma unroll
      for (int e = 0; e < 8; ++e) { kr[e] *= inv; kp[e] = k8[e] * (1.f + (a8[e] - 1.f) * ka8[e]); bb[e] = kr[e] * a8[e]; }
      const int lo = pst * 64 + pk0;
      store8f(sR + lo, r8); store8f(sK + lo, kp); store8f(sKK + lo, kr); store8f(sBB + lo, bb);
      store8f(sW + lo, w8); store8f(sV + lo, v8);
    }
    __syncthreads();
    if (c + 1 < nch) { WKV_ISSUE(c + 1); }
#define WKV_LOADV(P, st_)                                                                      \
    {                                                                                          \
      const int lo_ = (st_) * 64 + q * KPL;                                                    \
      _Pragma("unroll") for (int e = 0; e < NV4; ++e) {                                        \
        P##kk[e] = *(const float4*)(sKK + lo_ + 4 * e); P##ww[e] = *(const float4*)(sW + lo_ + 4 * e); \
        P##bb[e] = *(const float4*)(sBB + lo_ + 4 * e); P##kp[e] = *(const float4*)(sK + lo_ + 4 * e); \
        P##rr[e] = *(const float4*)(sR + lo_ + 4 * e);                                         \
      }                                                                                        \
      P##vv = sV[(st_) * 64 + row];                                                            \
    }
#define WKV_STEP(P, st_)                                                                       \
    {                                                                                          \
      float sa0 = 0.f, sa1 = 0.f;                                                              \
      _Pragma("unroll") for (int e = 0; e < NV4; ++e) {                                        \
        sa0 += S[4 * e] * P##kk[e].x + S[4 * e + 2] * P##kk[e].z;                              \
        sa1 += S[4 * e + 1] * P##kk[e].y + S[4 * e + 3] * P##kk[e].w;                          \
      }                                                                                        \
      const float sa = red_lanes<LPR>(sa0 + sa1);                                              \
      float o0 = 0.f, o1 = 0.f;                                                                \
      _Pragma("unroll") for (int e = 0; e < NV4; ++e) {                                        \
        S[4 * e] = S[4 * e] * P##ww[e].x - sa * P##bb[e].x + P##vv * P##kp[e].x;               \
        S[4 * e + 1] = S[4 * e + 1] * P##ww[e].y - sa * P##bb[e].y + P##vv * P##kp[e].y;       \
        S[4 * e + 2] = S[4 * e + 2] * P##ww[e].z - sa * P##bb[e].z + P##vv * P##kp[e].z;       \
        S[4 * e + 3] = S[4 * e + 3] * P##ww[e].w - sa * P##bb[e].w + P##vv * P##kp[e].w;       \
        o0 += S[4 * e] * P##rr[e].x + S[4 * e + 2] * P##rr[e].z;                               \
        o1 += S[4 * e + 1] * P##rr[e].y + S[4 * e + 3] * P##rr[e].w;                           \
      }                                                                                        \
      const float oo = red_lanes<LPR>(o0 + o1);                                                \
      if (q == 0) sO[(st_) * ROWS + row_l] = oo;                                               \
    }
    {
      float4 Akk[NV4], Aww[NV4], Abb[NV4], Akp[NV4], Arr[NV4]; float Avv;
      float4 Bkk[NV4], Bww[NV4], Bbb[NV4], Bkp[NV4], Brr[NV4]; float Bvv;
      if (LPR <= 4) {
#pragma unroll 1
        for (int st = 0; st < nvalid; ++st) { WKV_LOADV(A, st); WKV_STEP(A, st); }
      } else {
        WKV_LOADV(A, 0);
#pragma unroll 1
        for (int st = 0; st < nvalid; st += 2) {
          WKV_LOADV(B, st + 1);
          WKV_STEP(A, st);
          if (st + 2 < nvalid) { WKV_LOADV(A, st + 2); }
          WKV_STEP(B, st + 1);
        }
      }
    }
    __syncthreads();
    for (int i = tid; i < nvalid * ROWS; i += NTHR) {
      const int st = i / ROWS, rr = i % ROWS;
      O[(size_t)(t0 + st) * 1024 + head * 64 + part * ROWS + rr] = f2bf(sO[i]);
    }
  }
#undef WKV_ISSUE
#undef WKV_LOADV
#undef WKV_STEP
  float* dst = prompt ? (p.out + O_RW_P + (((size_t)seq * 16 + head) * 64 + row) * 64 + q * KPL)
                      : (p.out + O_RW_S + (((size_t)(seq - 8) * 16 + head) * 64 + row) * 64 + q * KPL);
#pragma unroll
  for (int e = 0; e < KPL; ++e) dst[e] = S[e];
}

template <int LPRP>
DI void ph_wkv(const Params& p, char* smem) {
  constexpr int NPART = 64 / (256 / LPRP);
  const int G = gridDim.x, bid = blockIdx.x;
  const int nP = 128 * NPART;
#pragma nounroll
  for (int it = bid; it < nP; it += G) {
    const int part = it % NPART, sh = it / NPART;
    wkv_item<LPRP>(p, smem, sh >> 4, sh & 15, part);
  }
  const int nS = 2048;
  int first, step;
  if (G > nP) { first = (bid >= nP) ? (bid - nP) : nS; step = G - nP; }
  else { first = bid; step = G; }
#pragma nounroll
  for (int it = first; it < nS; it += step) wkv_item<4>(p, smem, 8 + (it >> 4), it & 15, 0);
}

DI void ph_wkv_post(const Params& p) {
  const int tid_ = TIDX; const int lane = tid_ & 63;
  const int gw = blockIdx.x * 4 + (tid_ >> 6), nw = gridDim.x * 4;
  const bf16_t* __restrict__ R = (const bf16_t*)(p.ws + SC_R);
  const bf16_t* __restrict__ K = (const bf16_t*)(p.ws + SC_K);
  const bf16_t* __restrict__ V = (const bf16_t*)(p.ws + SC_V);
  const bf16_t* __restrict__ AAc = (const bf16_t*)(p.ws + SC_AA);
  const bf16_t* __restrict__ Gg = (const bf16_t*)(p.ws + SC_G);
  const bf16_t* __restrict__ O = (const bf16_t*)(p.ws + SC_O);
  bf16_t* __restrict__ U = (bf16_t*)(p.ws + W_U);
#pragma unroll 2
  for (int item = gw; item < T_ * 4; item += nw) {
    const int t = item >> 2, col = (item & 3) * 256 + lane * 4;
    const size_t o = (size_t)t * 1024 + col;
    float ov[4], rv[4], kv[4], av[4], vv[4], gv[4];
    unpack4(*(const uint2*)(O + o), ov); unpack4(*(const uint2*)(R + o), rv); unpack4(*(const uint2*)(K + o), kv);
    unpack4(*(const uint2*)(AAc + o), av); unpack4(*(const uint2*)(V + o), vv); unpack4(*(const uint2*)(Gg + o), gv);
    const float4 lw = *(const float4*)(p.in[I_RW_LNW] + col), lb = *(const float4*)(p.in[I_RW_LNB] + col);
    const float4 ka = *(const float4*)(p.in[I_RW_KA] + col), rk = *(const float4*)(p.in[I_RW_RK] + col);
    const float lwv[4] = {lw.x, lw.y, lw.z, lw.w}, lbv[4] = {lb.x, lb.y, lb.z, lb.w};
    const float kav[4] = {ka.x, ka.y, ka.z, ka.w}, rkv[4] = {rk.x, rk.y, rk.z, rk.w};
    const float mean = red_lanes<16>(ov[0] + ov[1] + ov[2] + ov[3]) * (1.f / 64.f);
    float d[4], s2 = 0.f, s3 = 0.f;
#pragma unroll
    for (int e = 0; e < 4; ++e) {
      d[e] = ov[e] - mean; s2 += d[e] * d[e];
      const float kp = kv[e] * (1.f + (av[e] - 1.f) * kav[e]);
      s3 += rv[e] * kp * rkv[e];
    }
    s2 = red_lanes<16>(s2); s3 = red_lanes<16>(s3);
    const float rs = rsqrtf(s2 * (1.f / 64.f) + 64e-5f);
    float y[4];
#pragma unroll
    for (int e = 0; e < 4; ++e) y[e] = (d[e] * rs * lwv[e] + lbv[e] + s3 * vv[e]) * gv[e];
    *(uint2*)(U + o) = make_uint2(pack2(y[0], y[1]), pack2(y[2], y[3]));
  }
}

constexpr int NPH = 40;
#ifndef REP_GEMM
#define REP_GEMM 1
#endif
#ifndef REP_SSD
#define REP_SSD 1
#endif
#ifndef REP_WKV
#define REP_WKV 1
#endif
#ifndef REP_MISC
#define REP_MISC 1
#endif

__global__ void __launch_bounds__(NTHR, 2) mega(Params p) {
  __shared__ __attribute__((aligned(16))) char smem[SMEM_BYTES];
  __shared__ uint4 xb_words;
  cg::grid_group grid = cg::this_grid();
  if (threadIdx.x == 0) xb_words = make_uint4(0u, 0u, 0u, 0u);
  __syncthreads();
  XcdBarrier xb = xcd_barrier_post((unsigned*)(p.ws + W_BAR), (volatile LAS unsigned*)&xb_words);
  int ph = 0;
#define PH(...)                                                     \
  {                                                                 \
    if (ph >= p.ph_begin && ph < p.ph_end) {                        \
      __VA_ARGS__;                                                  \
      xcd_barrier(xb);                                              \
    }                                                               \
    ++ph;                                                           \
  }
#define PHR(rep, ...)                                               \
  {                                                                 \
    if (ph >= p.ph_begin && ph < p.ph_end) {                        \
      for (int rep_ = 0; rep_ < (rep); ++rep_) {                    \
        __VA_ARGS__;                                                \
        xcd_barrier(xb);                                            \
      }                                                             \
    }                                                               \
    ++ph;                                                           \
  }
#define PH_LAST(...)                                                \
  {                                                                 \
    if (ph >= p.ph_begin && ph < p.ph_end) { __VA_ARGS__; }         \
    ++ph;                                                           \
  }
  bf16_t* wt = (bf16_t*)(p.ws + W_WT);
  bf16_t* U = (bf16_t*)(p.ws + W_U);
  float* X = (float*)(p.ws + W_X);

  {
    if (ph >= p.ph_begin && ph < p.ph_end) { ph_prologue(p, smem); grid.sync(); }
    ++ph;
    if (threadIdx.x == 0) {
      unsigned* bar = (unsigned*)(p.ws + W_BAR);
      unsigned base = 0;
      for (unsigned jx = 0; jx < 16; ++jx) { const unsigned c = xb_ld(&bar[XB_XCNT(jx)]); base += (jx < xb.x) ? c : 0u; }
      volatile LAS unsigned* st = (volatile LAS unsigned*)&xb_words;
      st[3] = base + st[2];
    }
    __syncthreads();
  }

#pragma nounroll
  for (int layer = 0; layer < 4; ++layer) {
    const int kind = layer % 3;
    PHR(REP_MISC, ph_rmsnorm(p, kind == 2 ? 1 : 0, p.in[I_NMIX] + layer * 1024));
    if (kind == 0) {
      const int ia = layer / 3;
      PHR(REP_GEMM, {
        GJob j = mkjob(U, 1024, wt + WA_IN + (size_t)ia * 2048 * 1024, 1024, 1024, 2048);
        j.o0 = p.ws + SA_XB; j.o1 = p.ws + SA_GT;
        int toff = 0; gemm_run<EPI_LRU_IN, false>(j, 8, toff, smem, VBLOCK());
      });
      PHR(REP_MISC, (ph_conv<1024, false>((const bf16_t*)(p.ws + SA_XB), (bf16_t*)(p.ws + SA_XC),
                               p.in[I_LRU_CW] + (size_t)ia * 4 * 1024, p.in[I_LRU_CB] + (size_t)ia * 1024,
                               p.in[I_ST_LC] + (size_t)ia * 128 * 3 * 1024,
                               p.out + O_LC_P + (size_t)ia * 8 * 3 * 1024, p.out + O_LC_S + (size_t)ia * 128 * 3 * 1024)));
      PHR(REP_GEMM, {
        const int G = gridDim.x;
        for (int tile = VBLOCK(); tile < MT_ * 8; tile += G) {
          const int mt = tile >> 3, jt = tile & 7;
          GJob j = mkjob((const bf16_t*)(p.ws + SA_XC) + jt * 128, 1024,
                         wt + WA_G + (size_t)ia * 2048 * 128, 128, 128, 2048);
          j.o0 = p.ws + SA_AA; j.o1 = p.ws + SA_XC;
          j.x0 = p.in[I_LRU_BR] + ia * 1024; j.x1 = p.in[I_LRU_BI] + ia * 1024; j.x2 = p.in[I_LRU_LAM] + ia * 1024;
          gemm_tile_dma<EPI_GATES>(j, mt * 128, jt * 256, 0, 4, smem);
        }
      });
      PHR(REP_MISC, ph_lru_scan1(p));
      PH(ph_lru_scan2(p, ia));
      PH({
        GJob j = mkjob((const bf16_t*)(p.ws + SA_GT), 1024, wt + WA_OUT + (size_t)ia * 1024 * 1024, 1024, 1024, 1024);
        j.o0 = X;
        int toff = 0; gemm_run<EPI_RESID, false>(j, 4, toff, smem, VBLOCK());
      });
    } else if (kind == 1) {
      PHR(REP_GEMM, {
        GJob j = mkjob(U, 1024, wt + WB_XBC, 1024, 1024, 4128);
        j.o0 = p.ws + SB_XBCP; j.o1 = p.ws + SB_DT; j.x0 = p.in[I_SSM_DTB];
        int toff = 0; gemm_run<EPI_SSM_XBC, false>(j, 17, toff, smem, VBLOCK());
      });
      PHR(REP_MISC, (ph_conv<4096, true>((const bf16_t*)(p.ws + SB_XBCP), (bf16_t*)(p.ws + SB_XBC),
                              p.in[I_SSM_CW], p.in[I_SSM_CB], p.in[I_ST_SC],
                              p.out + O_SC_P, p.out + O_SC_S)));
      PHR(REP_SSD, ph_ssd(p, smem));
      PH({
        GJob j = mkjob(U, 1024, wt + WB_Z, 1024, 1024, 2048);
        j.o0 = p.ws + SB_Y;
        int toff = 0; gemm_run<EPI_SSM_Z, false>(j, 8, toff, smem, VBLOCK());
      });
      PH(ph_gnorm(p));
      PH({
        GJob j = mkjob((const bf16_t*)(p.ws + SB_Y), 2048, wt + WB_OUT, 2048, 2048, 1024);
        j.o0 = X;
        gemm_streamk<EPI_RESID>(j, 4, smem, VBLOCK(), (unsigned*)(p.ws + W_BAR) + 4096, (unsigned)(layer * 2 + 1));
      });
    } else {
      PHR(REP_GEMM, {
        int toff = 0;
        for (int s = 0; s < 3; ++s) {
          GJob j = mkjob(U, 1024, wt + WC_RKV + (size_t)s * 1024 * 1024, 1024, 1024, 1024);
          j.A2 = (const bf16_t*)(p.ws + SC_UP); j.mu = p.in[I_RW_MU] + s * 1024;
          j.o0 = p.ws + SC_R + (size_t)s * SZ_TD2; j.ldo = 1024; j.act = 0;
          gemm_run<EPI_ST, true>(j, 8, toff, smem, VBLOCK());
        }
        for (int s = 0; s < 3; ++s) {
          const int nv = (s == 2) ? 128 : 64;
          GJob j = mkjob(U, 1024, wt + WC_L1 + (size_t)s * 64 * 1024, 1024, 1024, nv);
          j.A2 = (const bf16_t*)(p.ws + SC_UP); j.mu = p.in[I_RW_MU] + (3 + s) * 1024;
          j.o0 = p.ws + SC_LH + (size_t)s * 64 * 2; j.ldo = 256; j.act = (s == 0) ? 1 : (s == 2 ? 2 : 0);
          gemm_run<EPI_ST, true>(j, 1, toff, smem, VBLOCK());
        }
      });
      PHR(REP_GEMM, {
        int toff = 0;
        const bf16_t* LH = (const bf16_t*)(p.ws + SC_LH);
        {
          GJob j = mkjob(LH, 256, wt + WC_W2, 64, 64, 1024);
          j.o0 = p.ws + SC_WD; j.x0 = p.in[I_RW_W0];
          gemm_run<EPI_DECAY, false>(j, 4, toff, smem, VBLOCK());
        }
        {
          GJob j = mkjob(LH + 64, 256, wt + WC_A2, 64, 64, 1024);
          j.o0 = p.ws + SC_AA; j.x0 = p.in[I_RW_A0];
          gemm_run<EPI_SIGB, false>(j, 4, toff, smem, VBLOCK());
        }
        {
          GJob j = mkjob(LH + 128, 256, wt + WC_G2, 128, 128, 1024);
          j.o0 = p.ws + SC_G; j.ldo = 1024; j.act = 0;
          gemm_run<EPI_ST, false>(j, 4, toff, smem, VBLOCK());
        }
      });
      PHR(REP_WKV, ph_wkv<8>(p, smem));
      PHR(REP_MISC, ph_wkv_post(p));
      PH({
        GJob j = mkjob(U, 1024, wt + WC_OUT, 1024, 1024, 1024);
        j.o0 = X;
        int toff = 0; gemm_run<EPI_RESID, false>(j, 4, toff, smem, VBLOCK());
      });
    }
    PHR(REP_MISC, ph_rmsnorm(p, 0, p.in[I_NFFN] + layer * 1024));
    PHR(REP_GEMM, {
      GJob j = mkjob(U, 1024, wt + WF_1 + (size_t)layer * 4096 * 1024, 1024, 1024, 4096);
      j.o0 = p.ws + S_HB;
      int toff = 0; gemm_run<EPI_FFN1, false>(j, 16, toff, smem, VBLOCK());
    });
    PH({
      GJob j = mkjob((const bf16_t*)(p.ws + S_HB), 4096, wt + WF_2 + (size_t)layer * 4096 * 1024, 4096, 4096, 1024);
      j.o0 = X;
      gemm_streamk<EPI_RESID>(j, 4, smem, VBLOCK(), (unsigned*)(p.ws + W_BAR) + 4096, (unsigned)(layer * 2 + 2));
    });
  }
  PH_LAST(ph_rmsnorm(p, 2, p.in[I_NFIN]));
#undef PH
#undef PH_LAST
}

extern "C" void kernel_launch(void* const* d_in, const int* in_sizes, int n_in, void* d_out, int out_size,
                              void* d_ws, size_t ws_size, hipStream_t stream) {
  Params p;
  memset(&p, 0, sizeof(p));
  for (int i = 0; i < N_IN; ++i) p.in[i] = (const float*)d_in[i];
  p.out = (float*)d_out;
  p.ws = (char*)d_ws;
  p.ph_begin = 0;
  p.ph_end = 1000;
  static int grid_blocks = 0;
  if (!grid_blocks) {
    int dev = 0, cus = 0, per_cu = 0;
    hipGetDevice(&dev);
    hipDeviceGetAttribute(&cus, hipDeviceAttributeMultiprocessorCount, dev);
    hipOccupancyMaxActiveBlocksPerMultiprocessor(&per_cu, mega, NTHR, 0);
    if (per_cu > 2) per_cu = 2;
    if (per_cu < 1) per_cu = 1;
    grid_blocks = cus * per_cu;
  }
  if (ws_size < (size_t)536870912) fprintf(stderr, "workspace too small: %zu\n", ws_size);
  (void)hipMemsetAsync((char*)d_ws + W_BAR, 0, (4096 + 1024) * 4, stream);
  void* args[] = {&p};
  hipError_t e = hipLaunchCooperativeKernel((void*)mega, dim3(grid_blocks), dim3(NTHR), args, 0, stream);
  if (e != hipSuccess) fprintf(stderr, "cooperative launch failed: %s (grid %d)\n", hipGetErrorString(e), grid_blocks);
}
```
